# Optimizing an MI355X kernel written in HIP

```python
import math
import jax
import jax.numpy as jnp
from jax import lax
import numpy as np

D_MODEL = 1024
BATCH = 32
SEQ = 256
DEPTH = 4
DEC_BATCH = 8
DEC_SEQ = 2048
PAST_LEN = 256

GRID_W = 64
H_A = 4
HEAD_DIM_A = 128
A_WIDTH = H_A * HEAD_DIM_A
SHORT_CONV = 5
CHUNK = 64
S5_GROUP = 16
S5_STATE = 64
B_WIDTH = 512
S5_GROUPS = B_WIDTH // S5_GROUP
H_C = 8
QK_NOPE = 64
QK_ROPE = 32
V_HEAD = 64
Q_LORA = 384
KV_LORA = 256
C_WIDTH = H_C * V_HEAD
ROPE_BASE = 10000.0
Q_BLOCK = 128
N_BRANCH = 3
BRANCH_WIDTH = 512
D_FF = 2816
FFN_CONV = 3
NORM_EPS = 1e-6
IN_SPLITS = (3 * A_WIDTH, A_WIDTH, 2 * H_A, 2 * H_A, B_WIDTH, Q_LORA, KV_LORA, QK_ROPE, N_BRANCH * D_MODEL)
IN_WIDTH = 4 * A_WIDTH + 4 * H_A + B_WIDTH + Q_LORA + KV_LORA + QK_ROPE + N_BRANCH * D_MODEL

kernel_name = 'hybrid_diffusion_prefix_trunk_step'


def rmsnorm(x, gain):
    xf = x.astype(jnp.float32)
    y = xf * lax.rsqrt(jnp.mean(xf * xf, axis=-1, keepdims=True) + NORM_EPS)
    return y * gain.astype(jnp.float32)


def l2norm(x):
    return x * lax.rsqrt(jnp.sum(x * x, axis=-1, keepdims=True) + NORM_EPS)


def dwconv_centred(x, w):
    width = w.shape[0]
    pad = width // 2
    length = x.shape[1]
    xp = jnp.pad(x, ((0, 0), (pad, pad), (0, 0)))
    return sum(xp[:, i:i + length] * w[i] for i in range(width))


def split_columns(t, widths):
    parts, start = [], 0
    for wd in widths:
        parts.append(t[..., start:start + wd])
        start += wd
    return parts


def modulation(cvec, w_mod, b_mod):
    m = jax.nn.silu(cvec.astype(jnp.float32)) @ w_mod.astype(jnp.float32) + b_mod.astype(jnp.float32)
    return [t[:, None, :] for t in jnp.split(m, 6, axis=-1)]


def axial_rope(length):
    rows = length // GRID_W
    row = jnp.repeat(jnp.arange(rows, dtype=jnp.float32), GRID_W)
    col = (jnp.arange(length) % GRID_W).astype(jnp.float32)
    n_freq = QK_ROPE // 4
    inv_freq = 1.0 / (ROPE_BASE ** (jnp.arange(n_freq, dtype=jnp.float32) / n_freq))
    ang = jnp.concatenate([row[:, None] * inv_freq, col[:, None] * inv_freq], axis=-1)
    return jnp.cos(ang), jnp.sin(ang)


def apply_rope(x, cos, sin):
    half = x.shape[-1] // 2
    x1, x2 = x[..., :half], x[..., half:]
    return jnp.concatenate([x1 * cos - x2 * sin, x2 * cos + x1 * sin], axis=-1)


def chunk_gated_delta(q, k, v, g, beta, s0):
    bsz, length, nh, dk = q.shape
    dv = v.shape[-1]
    n = length // CHUNK

    def chunks(t):
        return t.reshape(bsz, n, CHUNK, nh, t.shape[-1]).transpose(1, 0, 3, 2, 4)

    qc, kc, vc = chunks(q * dk ** -0.5), chunks(k), chunks(v)
    gc = jnp.cumsum(chunks(g[..., None])[..., 0], axis=-1)
    bc = chunks(beta[..., None])
    lower = jnp.tril(jnp.ones((CHUNK, CHUNK), dtype=bool))
    diff = gc[..., :, None] - gc[..., None, :]
    decay = jnp.where(lower, jnp.exp(jnp.where(lower, diff, 0.0)), 0.0)
    kb = kc * bc
    a_strict = jnp.einsum('nbhcd,nbhed->nbhce', kb, kc) * decay
    rhs = jnp.concatenate([vc * bc, kb * jnp.exp(gc)[..., None]], axis=-1)
    sol = lax.linalg.triangular_solve(a_strict, rhs, left_side=True, lower=True, unit_diagonal=True)
    u, w = sol[..., :dv], sol[..., dv:]
    qk = jnp.einsum('nbhcd,nbhed->nbhce', qc, kc) * decay

    def step(state, inp):
        q_i, k_i, u_i, w_i, g_i, qk_i = inp
        v_new = u_i - jnp.einsum('bhcd,bhdv->bhcv', w_i, state)
        o_i = (jnp.einsum('bhcd,bhdv->bhcv', q_i * jnp.exp(g_i)[..., None], state)
               + jnp.einsum('bhce,bhev->bhcv', qk_i, v_new))
        g_last = g_i[..., -1:]
        state = (state * jnp.exp(g_last)[..., None]
                 + jnp.einsum('bhcd,bhcv->bhdv', k_i * jnp.exp(g_last - g_i)[..., None], v_new))
        return state, o_i

    s_final, o = lax.scan(step, s0, (qc, kc, u, w, gc, qk))
    o = o.transpose(1, 0, 3, 2, 4).reshape(bsz, length, nh, dv)
    return o, s_final


def gated_deltanet(qkv, z, beta_logit, alpha_logit, conv_w, a_log, dt_bias, g_out, s0):
    f32 = jnp.float32
    bsz, length, _ = qkv.shape
    qkv = jax.nn.silu(dwconv_centred(qkv.astype(f32), conv_w.astype(f32)))
    q, k, v = jnp.split(qkv, 3, axis=-1)

    def heads(t):
        return t.reshape(bsz, length, H_A, HEAD_DIM_A)

    q, k, v = l2norm(heads(q)), l2norm(heads(k)), heads(v)
    beta = jax.nn.sigmoid(beta_logit.astype(f32))
    g = -jnp.exp(a_log.astype(f32)) * jax.nn.softplus(alpha_logit.astype(f32) + dt_bias.astype(f32))

    def flip(t):
        return jnp.flip(t, axis=1)

    o_f, s_f = chunk_gated_delta(q, k, v, g[:, :, 0], beta[:, :, 0], s0[:, 0])
    o_b, s_b = chunk_gated_delta(flip(q), flip(k), flip(v), flip(g[:, :, 1]), flip(beta[:, :, 1]), s0[:, 1])
    o = rmsnorm(o_f + flip(o_b), g_out) * jax.nn.silu(heads(z.astype(f32)))
    return o.reshape(bsz, length, A_WIDTH), jnp.stack([s_f, s_b], axis=1)


def s5_diag_scan(u, lam_bar, b_bar, h0):
    bu = jnp.einsum('blgc,gpc->blgp', u.astype(jnp.complex64), b_bar)
    bu = bu.at[:, 0].add(lam_bar * h0)
    a = jnp.broadcast_to(lam_bar, bu.shape)

    def combine(e1, e2):
        a1, b1 = e1
        a2, b2 = e2
        return a1 * a2, a2 * b1 + b2

    _, h = lax.associative_scan(combine, (a, bu), axis=1)
    return h


def s5_mixer(u, lam_re, lam_im, log_dt, b_re, b_im, c_re, c_im, d_skip, w_glu, b_glu, h0):
    f32 = jnp.float32
    bsz, length, _ = u.shape
    uf = u.astype(f32).reshape(bsz, length, S5_GROUPS, S5_GROUP)
    lam = lax.complex(lam_re.astype(f32), lam_im.astype(f32))
    lam_bar = jnp.exp(lam * jnp.exp(log_dt.astype(f32))[..., None])
    b_bar = ((lam_bar - 1.0) / lam)[..., None] * lax.complex(b_re.astype(f32), b_im.astype(f32))

    def flip(t):
        return jnp.flip(t, axis=1)

    h_f = s5_diag_scan(uf, lam_bar[0], b_bar[0], h0[:, 0])
    h_b = flip(s5_diag_scan(flip(uf), lam_bar[1], b_bar[1], h0[:, 1]))
    c_mat = lax.complex(c_re.astype(f32), c_im.astype(f32))
    y = (jnp.real(jnp.einsum('blgp,gcp->blgc', h_f + h_b, c_mat))
         + d_skip.astype(f32).reshape(S5_GROUPS, S5_GROUP) * uf)
    y = jax.nn.gelu(y.reshape(bsz, length, B_WIDTH))
    y = y * jax.nn.sigmoid(y @ w_glu.astype(f32) + b_glu.astype(f32))
    final = jnp.stack([h_f[:, -1], h_b[:, 0]], axis=1)
    return y, final


def mla_keys(ckv, k_rope, w_kv_b):
    bsz, length, _ = ckv.shape
    kv = (ckv @ w_kv_b).reshape(bsz, length, H_C, QK_NOPE + V_HEAD)
    k_nope, v = kv[..., :QK_NOPE], kv[..., QK_NOPE:]
    k_r = jnp.broadcast_to(k_rope[:, :, None, :], (bsz, length, H_C, QK_ROPE))
    return jnp.concatenate([k_nope, k_r], axis=-1), v


def blocked_attention(q, k, v):
    bsz, lq, nh, dqk = q.shape
    nb = lq // Q_BLOCK
    qb = q.reshape(bsz, nb, Q_BLOCK, nh, dqk).transpose(1, 0, 2, 3, 4)
    scale = dqk ** -0.5

    def one_block(q_blk):
        s = jnp.einsum('bqhd,bkhd->bhqk', q_blk, k) * scale
        p = jax.nn.softmax(s, axis=-1)
        return jnp.einsum('bhqk,bkhv->bqhv', p, v)

    o = lax.map(one_block, qb)
    return o.transpose(1, 0, 2, 3, 4).reshape(bsz, lq, nh, v.shape[-1])


def mla_mixer(qa, kva, krope, g_q_a, w_q_b, g_kv_a, w_kv_b, cache):
    f32 = jnp.float32
    bsz, length, _ = qa.shape
    q = (rmsnorm(qa, g_q_a) @ w_q_b.astype(f32)).reshape(bsz, length, H_C, QK_NOPE + QK_ROPE)
    ckv = rmsnorm(kva, g_kv_a)
    krope = krope.astype(f32)
    w_kv_b = w_kv_b.astype(f32)
    if cache is None:
        k, v = mla_keys(ckv, krope, w_kv_b)
    else:
        cache_ckv, cache_krope = cache
        cos, sin = axial_rope(length)
        q = jnp.concatenate([q[..., :QK_NOPE], apply_rope(q[..., QK_NOPE:], cos[:, None], sin[:, None])], axis=-1)
        k_lat, v_lat = mla_keys(ckv, apply_rope(krope, cos, sin), w_kv_b)
        k_ctx, v_ctx = mla_keys(cache_ckv.astype(f32), cache_krope.astype(f32), w_kv_b)
        k = jnp.concatenate([k_ctx, k_lat], axis=1)
        v = jnp.concatenate([v_ctx, v_lat], axis=1)
    o = blocked_attention(q, k, v)
    return o.reshape(bsz, length, C_WIDTH), ckv, krope


def token_mixers(h, lp, ctx):
    f32 = jnp.float32
    bsz, length, _ = h.shape
    proj = h @ lp['w_in'].astype(f32)
    a_qkv, a_z, a_beta, a_alpha, b_u, c_qa, c_kva, c_kr, gate_logit = split_columns(proj, IN_SPLITS)
    if ctx is None:
        s0 = jnp.zeros((bsz, 2, H_A, HEAD_DIM_A, HEAD_DIM_A), f32)
        h0 = jnp.zeros((bsz, 2, S5_GROUPS, S5_STATE), jnp.complex64)
        mla_cache = None
    else:
        st_delta, st_re, st_im, c_ckv, c_krope = ctx
        s0 = st_delta.astype(f32)
        h0 = lax.complex(st_re.astype(f32), st_im.astype(f32))
        mla_cache = (c_ckv, c_krope)
    o_a, s_delta = gated_deltanet(a_qkv, a_z, a_beta.reshape(bsz, length, 2, H_A),
                                  a_alpha.reshape(bsz, length, 2, H_A), lp['conv_qkv'], lp['a_log'],
                                  lp['dt_bias'], lp['g_delta_out'], s0)
    o_b, s_s5 = s5_mixer(b_u, lp['s5_lam_re'], lp['s5_lam_im'], lp['s5_log_dt'], lp['s5_b_re'], lp['s5_b_im'],
                         lp['s5_c_re'], lp['s5_c_im'], lp['s5_d'], lp['w_glu'], lp['b_glu'], h0)
    o_c, ckv, krope = mla_mixer(c_qa, c_kva, c_kr, lp['g_q_a'], lp['w_q_b'], lp['g_kv_a'], lp['w_kv_b'], mla_cache)
    branches = jnp.stack([o_a, o_b, o_c], axis=2)
    per_branch = jnp.einsum('blnw,nwd->blnd', branches, lp['w_branch'].astype(f32))
    gates = jax.nn.sigmoid(gate_logit.astype(f32)).reshape(bsz, length, N_BRANCH, D_MODEL)
    out = jnp.sum(gates * per_branch, axis=2) @ lp['w_out'].astype(f32)
    if ctx is None:
        return out, (s_delta, jnp.real(s_s5), jnp.imag(s_s5), ckv, krope)
    return out, None


def conv_mlp(h, w_up, conv_w, conv_b, w_down):
    f32 = jnp.float32
    up = dwconv_centred(h @ w_up.astype(f32), conv_w.astype(f32)) + conv_b.astype(f32)
    gate, val = jnp.split(up, 2, axis=-1)
    return (jax.nn.silu(gate) * val) @ w_down.astype(f32)


def trunk_layer(x, mods, lp, ctx):
    shift_m, scale_m, gate_m, shift_f, scale_f, gate_f = mods
    h = rmsnorm(x, lp['g_norm_mix']) * (1.0 + scale_m) + shift_m
    mix, ctx_tensors = token_mixers(h, lp, ctx)
    x = x + gate_m * mix
    h = rmsnorm(x, lp['g_norm_ffn']) * (1.0 + scale_f) + shift_f
    x = x + gate_f * conv_mlp(h, lp['w_ffn_up'], lp['conv_ffn'], lp['b_conv_ffn'], lp['w_ffn_down'])
    return x, ctx_tensors


def setup_inputs(seed: int = 0) -> dict:
    key = jax.random.key(seed)
    keys = iter(jax.random.split(key, 48))
    f32 = jnp.float32

    def nrm(shape, scale):
        return scale * jax.random.normal(next(keys), shape, f32)

    def unif(shape, lo, hi):
        return jax.random.uniform(next(keys), shape, f32, lo, hi)

    G, P, CG = S5_GROUPS, S5_STATE, S5_GROUP
    dt_a = jnp.exp(unif((DEPTH, 2, H_A), math.log(1e-3), math.log(1e-1)))
    return {
        'x_prompt': nrm((BATCH, SEQ, D_MODEL), 1.0),
        'x_sample': nrm((DEC_BATCH, DEC_SEQ, D_MODEL), 1.0),
        'state_delta': nrm((DEC_BATCH, DEPTH, 2, H_A, HEAD_DIM_A, HEAD_DIM_A), 0.1),
        'state_s5_re': nrm((DEC_BATCH, DEPTH, 2, G, P), 0.05),
        'state_s5_im': nrm((DEC_BATCH, DEPTH, 2, G, P), 0.05),
        'cache_ckv': nrm((DEC_BATCH, DEPTH, PAST_LEN, KV_LORA), 1.0),
        'cache_krope': nrm((DEC_BATCH, DEPTH, PAST_LEN, QK_ROPE), 1.0),
        'c': nrm((DEC_BATCH, D_MODEL), 1.0),
        'c_ctx': nrm((D_MODEL,), 1.0),
        'w_mod': nrm((DEPTH, D_MODEL, 6 * D_MODEL), 0.5 * D_MODEL ** -0.5),
        'b_mod': nrm((DEPTH, 6 * D_MODEL), 0.02),
        'g_norm_mix': 1.0 + nrm((DEPTH, D_MODEL), 0.02),
        'g_norm_ffn': 1.0 + nrm((DEPTH, D_MODEL), 0.02),
        'w_in': nrm((DEPTH, D_MODEL, IN_WIDTH), D_MODEL ** -0.5),
        'conv_qkv': nrm((DEPTH, SHORT_CONV, 3 * A_WIDTH), SHORT_CONV ** -0.5),
        'a_log': jnp.log(unif((DEPTH, 2, H_A), 1.0, 16.0)),
        'dt_bias': dt_a + jnp.log(-jnp.expm1(-dt_a)),
        'g_delta_out': 1.0 + nrm((DEPTH, HEAD_DIM_A), 0.02),
        's5_lam_re': -0.5 + nrm((DEPTH, 2, G, P), 0.01),
        's5_lam_im': math.pi * jnp.arange(P, dtype=f32) + nrm((DEPTH, 2, G, P), 0.01),
        's5_log_dt': unif((DEPTH, 2, G), math.log(1e-3), math.log(1e-1)),
        's5_b_re': nrm((DEPTH, G, P, CG), (2 * CG) ** -0.5),
        's5_b_im': nrm((DEPTH, G, P, CG), (2 * CG) ** -0.5),
        's5_c_re': nrm((DEPTH, G, CG, P), P ** -0.5),
        's5_c_im': nrm((DEPTH, G, CG, P), P ** -0.5),
        's5_d': nrm((DEPTH, B_WIDTH), 1.0),
        'w_glu': nrm((DEPTH, B_WIDTH, B_WIDTH), B_WIDTH ** -0.5),
        'b_glu': nrm((DEPTH, B_WIDTH), 0.02),
        'g_q_a': 1.0 + nrm((DEPTH, Q_LORA), 0.02),
        'w_q_b': nrm((DEPTH, Q_LORA, H_C * (QK_NOPE + QK_ROPE)), Q_LORA ** -0.5),
        'g_kv_a': 1.0 + nrm((DEPTH, KV_LORA), 0.02),
        'w_kv_b': nrm((DEPTH, KV_LORA, H_C * (QK_NOPE + V_HEAD)), KV_LORA ** -0.5),
        'w_branch': nrm((DEPTH, N_BRANCH, BRANCH_WIDTH, D_MODEL), BRANCH_WIDTH ** -0.5),
        'w_out': nrm((DEPTH, D_MODEL, D_MODEL), D_MODEL ** -0.5),
        'w_ffn_up': nrm((DEPTH, D_MODEL, 2 * D_FF), D_MODEL ** -0.5),
        'conv_ffn': nrm((DEPTH, FFN_CONV, 2 * D_FF), FFN_CONV ** -0.5),
        'b_conv_ffn': nrm((DEPTH, 2 * D_FF), 0.02),
        'w_ffn_down': nrm((DEPTH, D_FF, D_MODEL), D_FF ** -0.5),
        'g_final': 1.0 + nrm((D_MODEL,), 0.02),
    }


def reference(x_prompt, x_sample, state_delta, state_s5_re, state_s5_im, cache_ckv, cache_krope, c, c_ctx,
              w_mod, b_mod, g_norm_mix, g_norm_ffn, w_in, conv_qkv, a_log, dt_bias, g_delta_out,
              s5_lam_re, s5_lam_im, s5_log_dt, s5_b_re, s5_b_im, s5_c_re, s5_c_im, s5_d, w_glu, b_glu,
              g_q_a, w_q_b, g_kv_a, w_kv_b, w_branch, w_out, w_ffn_up, conv_ffn, b_conv_ffn, w_ffn_down,
              g_final):
    xp = x_prompt.astype(jnp.float32)
    xs = x_sample.astype(jnp.float32)
    deltas, s5_res, s5_ims, ckvs, kropes = [], [], [], [], []
    for l in range(DEPTH):
        lp = {
            'g_norm_mix': g_norm_mix[l], 'g_norm_ffn': g_norm_ffn[l], 'w_in': w_in[l],
            'conv_qkv': conv_qkv[l], 'a_log': a_log[l], 'dt_bias': dt_bias[l], 'g_delta_out': g_delta_out[l],
            's5_lam_re': s5_lam_re[l], 's5_lam_im': s5_lam_im[l], 's5_log_dt': s5_log_dt[l],
            's5_b_re': s5_b_re[l], 's5_b_im': s5_b_im[l], 's5_c_re': s5_c_re[l], 's5_c_im': s5_c_im[l],
            's5_d': s5_d[l], 'w_glu': w_glu[l], 'b_glu': b_glu[l],
            'g_q_a': g_q_a[l], 'w_q_b': w_q_b[l], 'g_kv_a': g_kv_a[l], 'w_kv_b': w_kv_b[l],
            'w_branch': w_branch[l], 'w_out': w_out[l],
            'w_ffn_up': w_ffn_up[l], 'conv_ffn': conv_ffn[l], 'b_conv_ffn': b_conv_ffn[l],
            'w_ffn_down': w_ffn_down[l],
        }
        mods_p = modulation(c_ctx[None, :], w_mod[l], b_mod[l])
        xp, ctx_out = trunk_layer(xp, mods_p, lp, None)
        deltas.append(ctx_out[0])
        s5_res.append(ctx_out[1])
        s5_ims.append(ctx_out[2])
        ckvs.append(ctx_out[3])
        kropes.append(ctx_out[4])
        mods_s = modulation(c, w_mod[l], b_mod[l])
        cache_l = (state_delta[:, l], state_s5_re[:, l], state_s5_im[:, l], cache_ckv[:, l], cache_krope[:, l])
        xs, _ = trunk_layer(xs, mods_s, lp, cache_l)
    y_prompt = rmsnorm(xp, g_final)
    y_sample = rmsnorm(xs, g_final)
    new_state_delta = jnp.stack(deltas, axis=1)
    new_state_s5_re = jnp.stack(s5_res, axis=1)
    new_state_s5_im = jnp.stack(s5_ims, axis=1)
    new_cache_ckv = jnp.stack(ckvs, axis=1)
    new_cache_krope = jnp.stack(kropes, axis=1)
    return (y_prompt, y_sample, new_state_delta, new_state_s5_re, new_state_s5_im, new_cache_ckv, new_cache_krope)
```

```cpp
#include <hip/hip_runtime.h>
#include <hip/hip_cooperative_groups.h>
#include <cstdio>
namespace cg = cooperative_groups;

#define DI __device__ __forceinline__
typedef __bf16 bf16;
using bf16x8 = __attribute__((ext_vector_type(8))) short;
using f32x4 = __attribute__((ext_vector_type(4))) float;
using f32x16 = __attribute__((ext_vector_type(16))) float;
typedef unsigned short u16;

constexpr int T_ = 24576, TP_ = 8192;
constexpr int NCH = 384;
constexpr long long O_SD = 25165824LL, O_S5RE = 41943040LL, O_S5IM = 42467328LL, O_CKV = 42991616LL, O_KR = 51380224LL;

constexpr size_t W_IN = 0;
constexpr size_t W_G = W_IN + 3328ull * 1024;
constexpr size_t W_QB = W_G + 3072ull * 1024;
constexpr size_t W_KVB = W_QB + 768ull * 384;
constexpr size_t W_GLU = W_KVB + 1024ull * 256;
constexpr size_t W_BR = W_GLU + 512ull * 512;
constexpr size_t W_OUT = W_BR + 1024ull * 1536;
constexpr size_t W_UP = W_OUT + 1024ull * 1024;
constexpr size_t W_DN = W_UP + 5632ull * 1024;
constexpr size_t W_LAYER = W_DN + 1024ull * 2816;

constexpr size_t al(size_t x) { return (x + 255) & ~(size_t)255; }
constexpr size_t B_W = 0;
constexpr size_t B_MODS = al(B_W + 4 * W_LAYER * 2);
constexpr size_t B_ROPE = al(B_MODS + 4ull * 9 * 6144 * 4);
constexpr size_t B_LAMB = al(B_ROPE + 2048ull * 32 * 4);
constexpr size_t B_LAM64 = al(B_LAMB + 4ull * 2 * 32 * 64 * 8);
constexpr size_t B_BBT = al(B_LAM64 + 4ull * 2 * 32 * 64 * 8);
constexpr size_t B_CMT = al(B_BBT + 4ull * 2 * 32 * 128 * 16 * 2);
constexpr size_t B_CKVC = al(B_CMT + 4ull * 32 * 16 * 128 * 2);
constexpr size_t B_H = al(B_CKVC + 4ull * 2048 * 256 * 2);
constexpr size_t B_QKV = al(B_H + (size_t)T_ * 1024 * 2);
constexpr size_t B_Z = al(B_QKV + (size_t)T_ * 1536 * 2);
constexpr size_t B_US5 = al(B_Z + (size_t)T_ * 512 * 2);
constexpr size_t B_QA = al(B_US5 + (size_t)T_ * 512 * 2);
constexpr size_t B_KVA = al(B_QA + (size_t)T_ * 384 * 2);
constexpr size_t B_MISC = al(B_KVA + (size_t)T_ * 256 * 2);
constexpr size_t B_QN = al(B_MISC + (size_t)T_ * 48 * 4);
constexpr size_t B_KN = al(B_QN + (size_t)T_ * 512 * 2);
constexpr size_t B_VV = al(B_KN + (size_t)T_ * 512 * 2);
constexpr size_t B_KT = al(B_VV + (size_t)T_ * 512 * 2);
constexpr size_t B_BG = al(B_KT + (size_t)T_ * 512 * 2);
constexpr size_t B_TM = al(B_BG + (size_t)T_ * 16 * 4);
constexpr size_t B_QKM = al(B_TM + (size_t)T_ * 512 * 2);
constexpr size_t B_GC = al(B_QKM + (size_t)T_ * 512 * 2);
constexpr size_t B_BC = al(B_GC + (size_t)NCH * 4 * 2 * 64 * 4);
constexpr size_t KB_P = 32ull * 8 * 256 * 96, KB_S = 8ull * 8 * 2304 * 96;
constexpr size_t VT_P = 32ull * 8 * 64 * 256, VT_S = 8ull * 8 * 64 * 2304;
constexpr size_t B_KB = al(B_BC + (size_t)NCH * 4 * 2 * 64 * 4);
constexpr size_t B_VT = al(B_KB + (KB_P + KB_S) * 2);
constexpr size_t B_QM = al(B_VT + (VT_P + VT_S) * 2);
constexpr size_t B_HEND = al(B_QM + (size_t)T_ * 768 * 2);
constexpr size_t B_HIN = al(B_HEND + (size_t)NCH * 32 * 2 * 64 * 8);
constexpr size_t B_Y5 = al(B_HIN + (size_t)NCH * 32 * 2 * 64 * 8);
constexpr size_t B_OC = al(B_Y5 + (size_t)T_ * 512 * 2);
constexpr size_t B_END = al(B_OC + (size_t)T_ * 512 * 2);
constexpr size_t B_OF = B_QKV;
constexpr size_t B_OB = B_QKV + (size_t)T_ * 512 * 2;
constexpr size_t B_MG = B_QKV;
constexpr size_t B_OA = B_QN;
constexpr size_t B_OB5 = B_KN;
constexpr size_t B_UP = B_QKV;
constexpr size_t B_ACT = B_KB;
static_assert(B_UP + (size_t)T_ * 5632 * 2 <= B_KB, "UP overlaps ACT");
static_assert(B_ACT + (size_t)T_ * 2816 * 2 <= B_END, "ACT too big");
static_assert(B_END <= 768ull * 1024 * 1024, "workspace too big");

struct Params {
  const float* in[39];
  float* out;
  char* ws;
};

DI int otid() { int t = (int)__builtin_amdgcn_workitem_id_x(); asm volatile("" : "+v"(t)); return t; }
DI unsigned pack2(float a, float b) {
  typedef __attribute__((ext_vector_type(2))) __bf16 bf2;
  bf2 v; v[0] = (__bf16)a; v[1] = (__bf16)b;
  return __builtin_bit_cast(unsigned, v);
}
DI u16 f2bf(float a) { return (u16)(pack2(a, 0.f) & 0xffffu); }
DI float bf2f(u16 u) { return __uint_as_float(((unsigned)u) << 16); }
DI float blo(unsigned u) { return __uint_as_float(u << 16); }
DI float bhi(unsigned u) { return __uint_as_float(u & 0xffff0000u); }
DI float wave_sum(float v) {
#pragma unroll
  for (int o = 32; o > 0; o >>= 1) v += __shfl_xor(v, o);
  return v;
}
DI float sigmoidf_(float x) { return 1.f / (1.f + __expf(-x)); }
DI float siluf_(float x) { return x / (1.f + __expf(-x)); }
DI int tok_v(int t) { return t < TP_ ? 0 : 1 + ((t - TP_) >> 11); }
DI int crow(int r, int h2) { return (r & 3) + 8 * (r >> 2) + 4 * h2; }
DI bf16x8 mk8(unsigned a, unsigned b, unsigned c, unsigned d) {
  uint4 p = make_uint4(a, b, c, d);
  return __builtin_bit_cast(bf16x8, p);
}
DI bf16x8 pack_acc(const f32x16& x, int s) {
  return mk8(pack2(x[8 * s], x[8 * s + 1]), pack2(x[8 * s + 2], x[8 * s + 3]), pack2(x[8 * s + 4], x[8 * s + 5]),
             pack2(x[8 * s + 6], x[8 * s + 7]));
}
DI bf16x8 load_perm(const u16* rowptr, int s, int h2) {
  uint2 a = *(const uint2*)(rowptr + 16 * s + 4 * h2);
  uint2 b = *(const uint2*)(rowptr + 16 * s + 8 + 4 * h2);
  return mk8(a.x, a.y, b.x, b.y);
}
DI unsigned swap16(unsigned u) { return (u >> 16) | (u << 16); }
DI bf16x8 load_perm_rev(const u16* rowptr, int base, int s, int h2) {
  uint2 a = *(const uint2*)(rowptr + 60 - base - 16 * s - 4 * h2);
  uint2 b = *(const uint2*)(rowptr + 52 - base - 16 * s - 4 * h2);
  return mk8(swap16(a.y), swap16(a.x), swap16(b.y), swap16(b.x));
}
#define MFMA16(a, b, c) __builtin_amdgcn_mfma_f32_16x16x32_bf16((a), (b), (c), 0, 0, 0)
#define MFMA32(a, b, c) __builtin_amdgcn_mfma_f32_32x32x16_bf16((a), (b), (c), 0, 0, 0)

template <int NJ>
DI void gemm_core(f32x4 (&acc)[4][NJ], const u16* __restrict__ A, int lda, const u16* __restrict__ B, int ldb, int K,
                  u16* sm) {
  const int tid = otid(), lane = tid & 63, w = tid >> 6, wr = w >> 1, wc = w & 1;
  const int fr = lane & 15, fq = lane >> 4;
  constexpr int BN = NJ * 32;
  constexpr int STG = (128 + BN) * 72;
  const int lrow = tid >> 3, lkc = tid & 7;
  uint4 ra[4], rb[NJ];
  const u16* ap = A + (size_t)lrow * lda + lkc * 8;
  const u16* bp = B + (size_t)lrow * ldb + lkc * 8;
  const int nk = K >> 6;
  __syncthreads();
#pragma unroll
  for (int j = 0; j < 4; ++j) ra[j] = *(const uint4*)(ap + (size_t)(32 * j) * lda);
#pragma unroll
  for (int j = 0; j < NJ; ++j) rb[j] = *(const uint4*)(bp + (size_t)(32 * j) * ldb);
  {
    u16* as = sm; u16* bs = as + 128 * 72;
#pragma unroll
    for (int j = 0; j < 4; ++j) *(uint4*)(as + (lrow + 32 * j) * 72 + lkc * 8) = ra[j];
#pragma unroll
    for (int j = 0; j < NJ; ++j) *(uint4*)(bs + (lrow + 32 * j) * 72 + lkc * 8) = rb[j];
  }
  __syncthreads();
  for (int kt = 0; kt < nk; ++kt) {
    const bool more = (kt + 1 < nk);
    if (more) {
      const int k0 = (kt + 1) * 64;
#pragma unroll
      for (int j = 0; j < 4; ++j) ra[j] = *(const uint4*)(ap + (size_t)(32 * j) * lda + k0);
#pragma unroll
      for (int j = 0; j < NJ; ++j) rb[j] = *(const uint4*)(bp + (size_t)(32 * j) * ldb + k0);
    }
    const u16* as = sm + (kt & 1) * STG;
    const u16* bs = as + 128 * 72;
#pragma unroll
    for (int ks = 0; ks < 2; ++ks) {
      bf16x8 af[4], bfr[NJ];
#pragma unroll
      for (int i = 0; i < 4; ++i) af[i] = *(const bf16x8*)(as + (wr * 64 + i * 16 + fr) * 72 + ks * 32 + fq * 8);
#pragma unroll
      for (int j = 0; j < NJ; ++j) bfr[j] = *(const bf16x8*)(bs + (wc * NJ * 16 + j * 16 + fr) * 72 + ks * 32 + fq * 8);
#pragma unroll
      for (int i = 0; i < 4; ++i)
#pragma unroll
        for (int j = 0; j < NJ; ++j) acc[i][j] = MFMA16(af[i], bfr[j], acc[i][j]);
    }
    if (more) {
      u16* as2 = sm + ((kt + 1) & 1) * STG; u16* bs2 = as2 + 128 * 72;
#pragma unroll
      for (int j = 0; j < 4; ++j) *(uint4*)(as2 + (lrow + 32 * j) * 72 + lkc * 8) = ra[j];
#pragma unroll
      for (int j = 0; j < NJ; ++j) *(uint4*)(bs2 + (lrow + 32 * j) * 72 + lkc * 8) = rb[j];
    }
    __syncthreads();
  }
}
template <int NJ>
DI void zero_acc(f32x4 (&acc)[4][NJ]) {
#pragma unroll
  for (int i = 0; i < 4; ++i)
#pragma unroll
    for (int j = 0; j < NJ; ++j) acc[i][j] = f32x4{0.f, 0.f, 0.f, 0.f};
}
#define EPI_LOOP(NJ_)                                                              \
  const int e_lane = otid() & 63, e_w = otid() >> 6;                     \
  const int e_wr = e_w >> 1, e_wc = e_w & 1, e_fr = e_lane & 15, e_fq = e_lane >> 4; \
  _Pragma("unroll") for (int i = 0; i < 4; ++i)                                    \
  _Pragma("unroll") for (int j = 0; j < NJ_; ++j)                                  \
  _Pragma("unroll") for (int r = 0; r < 4; ++r)
#define EROW (e_wr * 64 + i * 16 + e_fq * 4 + r)
#define ECOL(NJ_) (e_wc * NJ_ * 16 + j * 16 + e_fr)

DI int colmap(int kind, int n) {
  if (kind == 0) {
    if (n < 2048) return n;
    if (n < 2560) return 2064 + (n - 2048);
    if (n < 2944) return 2576 + (n - 2560);
    if (n < 3200) return 2960 + (n - 2944);
    int j = n - 3200;
    if (j < 16) return 2048 + j;
    if (j < 48) return 3216 + (j - 16);
    return -1;
  }
  if (kind == 1) return 3248 + n;
  return n;
}
DI void convT_tile(const float* __restrict__ src, int lds, int K, u16* __restrict__ dst, int kind, int kt, int nt,
                   float* sm) {
  const int tid = otid();
  const int c = tid & 63;
  const int sc = colmap(kind, nt * 64 + c);
  __syncthreads();
#pragma unroll 4
  for (int i = 0; i < 16; ++i) {
    int r = (tid >> 6) + i * 4;
    float v = sc >= 0 ? src[(size_t)(kt * 64 + r) * lds + sc] : 0.f;
    sm[r * 65 + c] = v;
  }
  __syncthreads();
  const int n = tid >> 2, kq = tid & 3;
  unsigned pk[8];
#pragma unroll
  for (int j = 0; j < 8; ++j) pk[j] = pack2(sm[(kq * 16 + 2 * j) * 65 + n], sm[(kq * 16 + 2 * j + 1) * 65 + n]);
  u16* d = dst + (size_t)(nt * 64 + n) * K + kt * 64 + kq * 16;
  *(uint4*)d = make_uint4(pk[0], pk[1], pk[2], pk[3]);
  *(uint4*)(d + 8) = make_uint4(pk[4], pk[5], pk[6], pk[7]);
}
constexpr int CJ0 = 16 * 52, CJ1 = CJ0 + 16 * 48, CJ2 = CJ1 + 6 * 12, CJ3 = CJ2 + 4 * 16, CJ4 = CJ3 + 8 * 8,
              CJ5 = CJ4 + 24 * 16, CJ6 = CJ5 + 16 * 16, CJ7 = CJ6 + 16 * 88, CJ8 = CJ7 + 44 * 16;
DI void conv_job(const Params& p, int l, int j, float* sm) {
  u16* wl = (u16*)(p.ws + B_W) + (size_t)l * W_LAYER;
  if (j < CJ0) { convT_tile(p.in[13] + (size_t)l * 1024 * 6320, 6320, 1024, wl + W_IN, 0, j / 52, j % 52, sm); return; }
  if (j < CJ1) { j -= CJ0; convT_tile(p.in[13] + (size_t)l * 1024 * 6320, 6320, 1024, wl + W_G, 1, j / 48, j % 48, sm); return; }
  if (j < CJ2) { j -= CJ1; convT_tile(p.in[29] + (size_t)l * 384 * 768, 768, 384, wl + W_QB, 2, j / 12, j % 12, sm); return; }
  if (j < CJ3) { j -= CJ2; convT_tile(p.in[31] + (size_t)l * 256 * 1024, 1024, 256, wl + W_KVB, 2, j / 16, j % 16, sm); return; }
  if (j < CJ4) { j -= CJ3; convT_tile(p.in[26] + (size_t)l * 512 * 512, 512, 512, wl + W_GLU, 2, j / 8, j % 8, sm); return; }
  if (j < CJ5) { j -= CJ4; convT_tile(p.in[32] + (size_t)l * 1536 * 1024, 1024, 1536, wl + W_BR, 2, j / 16, j % 16, sm); return; }
  if (j < CJ6) { j -= CJ5; convT_tile(p.in[33] + (size_t)l * 1024 * 1024, 1024, 1024, wl + W_OUT, 2, j / 16, j % 16, sm); return; }
  if (j < CJ7) { j -= CJ6; convT_tile(p.in[34] + (size_t)l * 1024 * 5632, 5632, 1024, wl + W_UP, 2, j / 88, j % 88, sm); return; }
  j -= CJ7; convT_tile(p.in[37] + (size_t)l * 2816 * 1024, 1024, 2816, wl + W_DN, 2, j / 16, j % 16, sm);
}
DI void mods_tile(const Params& p, int l, int jg, float* sm) {
  const int tid = otid();
  __syncthreads();
  for (int i = tid; i < 9 * 1024; i += 256) {
    int v = i >> 10, k = i & 1023;
    float cv = v == 0 ? p.in[8][k] : p.in[7][(v - 1) * 1024 + k];
    sm[i] = cv / (1.f + __expf(-cv));
  }
  __syncthreads();
  const int col = jg * 64 + (tid & 63), kq = tid >> 6;
  float acc[9];
#pragma unroll
  for (int v = 0; v < 9; ++v) acc[v] = 0.f;
  const float* wp = p.in[9] + (size_t)l * 1024 * 6144 + col;
#pragma unroll 4
  for (int k = kq * 256; k < kq * 256 + 256; ++k) {
    float wv = wp[(size_t)k * 6144];
#pragma unroll
    for (int v = 0; v < 9; ++v) acc[v] += sm[v * 1024 + k] * wv;
  }
  float* red = sm + 9 * 1024;
#pragma unroll
  for (int v = 0; v < 9; ++v) red[(kq * 9 + v) * 64 + (tid & 63)] = acc[v];
  __syncthreads();
  if (kq == 0) {
    float* mods = (float*)(p.ws + B_MODS);
    float b = p.in[10][l * 6144 + col];
#pragma unroll
    for (int v = 0; v < 9; ++v) {
      float s = red[(0 * 9 + v) * 64 + tid] + red[(1 * 9 + v) * 64 + tid] + red[(2 * 9 + v) * 64 + tid] + red[(3 * 9 + v) * 64 + tid];
      mods[(size_t)(l * 9 + v) * 6144 + col] = s + b;
    }
  }
}
DI void s5pre_tile(const Params& p, int tile) {
  const int id = tile * 256 + otid();
  const int pp = id & 63, g = (id >> 6) & 31, dir = (id >> 11) & 1, l = id >> 12;
  const float lre = p.in[18][((l * 2 + dir) * 32 + g) * 64 + pp];
  const float lim = p.in[19][((l * 2 + dir) * 32 + g) * 64 + pp];
  const float dt = expf(p.in[20][(l * 2 + dir) * 32 + g]);
  float er = expf(lre * dt), sn, cs;
  sincosf(lim * dt, &sn, &cs);
  const float lbr = er * cs, lbi = er * sn;
  float e64 = expf(64.f * lre * dt), s64, c64;
  sincosf(64.f * lim * dt, &s64, &c64);
  float2* lamb = (float2*)(p.ws + B_LAMB);
  float2* lam64 = (float2*)(p.ws + B_LAM64);
  const int li = ((l * 2 + dir) * 32 + g) * 64 + pp;
  lamb[li] = make_float2(lbr, lbi);
  lam64[li] = make_float2(e64 * c64, e64 * s64);
  const float nr = lbr - 1.f, ni = lbi, den = lre * lre + lim * lim;
  const float cr = (nr * lre + ni * lim) / den, ci = (ni * lre - nr * lim) / den;
  u16* bbt = (u16*)(p.ws + B_BBT) + (size_t)((l * 2 + dir) * 32 + g) * 128 * 16;
  const float* bre = p.in[21] + (size_t)((l * 32 + g) * 64 + pp) * 16;
  const float* bim = p.in[22] + (size_t)((l * 32 + g) * 64 + pp) * 16;
#pragma unroll
  for (int c = 0; c < 16; ++c) {
    float br = bre[c], bi = bim[c];
    bbt[pp * 16 + c] = f2bf(cr * br - ci * bi);
    bbt[(64 + pp) * 16 + c] = f2bf(cr * bi + ci * br);
  }
  if (dir == 0) {
    u16* cmt = (u16*)(p.ws + B_CMT) + (size_t)(l * 32 + g) * 16 * 128;
    const float* cre = p.in[23] + (size_t)(l * 32 + g) * 16 * 64;
    const float* cim = p.in[24] + (size_t)(l * 32 + g) * 16 * 64;
#pragma unroll
    for (int c = 0; c < 16; ++c) {
      cmt[c * 128 + pp] = f2bf(cre[c * 64 + pp]);
      cmt[c * 128 + 64 + pp] = f2bf(-cim[c * 64 + pp]);
    }
  }
}

DI void norm_phase(const Params& p, int l, int shift_idx, int scale_idx, const float* gn) {
  const float* x = p.out;
  u16* H = (u16*)(p.ws + B_H);
  const float* mods = (const float*)(p.ws + B_MODS);
  const int lane = otid() & 63, w = otid() >> 6;
  for (int tile = blockIdx.x; tile < T_ / 4; tile += gridDim.x) {
    const int t = tile * 4 + w;
    const float4* xr = (const float4*)(x + (size_t)t * 1024);
    float4 v[4];
    float ss = 0.f;
#pragma unroll
    for (int j = 0; j < 4; ++j) {
      v[j] = xr[lane + 64 * j];
      ss += v[j].x * v[j].x + v[j].y * v[j].y + v[j].z * v[j].z + v[j].w * v[j].w;
    }
    ss = wave_sum(ss);
    const float rstd = rsqrtf(ss * (1.f / 1024.f) + 1e-6f);
    const float* mb = mods + (size_t)(l * 9 + tok_v(t)) * 6144;
#pragma unroll
    for (int j = 0; j < 4; ++j) {
      const int c = (lane + 64 * j) * 4;
      float4 g = *(const float4*)(gn + c);
      float4 sc = *(const float4*)(mb + scale_idx * 1024 + c);
      float4 sh = *(const float4*)(mb + shift_idx * 1024 + c);
      float y0 = v[j].x * rstd * g.x * (1.f + sc.x) + sh.x;
      float y1 = v[j].y * rstd * g.y * (1.f + sc.y) + sh.y;
      float y2 = v[j].z * rstd * g.z * (1.f + sc.z) + sh.z;
      float y3 = v[j].w * rstd * g.w * (1.f + sc.w) + sh.w;
      *(uint2*)(H + (size_t)t * 1024 + c) = make_uint2(pack2(y0, y1), pack2(y2, y3));
    }
  }
}

DI void gemm_in_phase(const Params& p, int l, u16* sm) {
  const u16* H = (const u16*)(p.ws + B_H);
  const u16* Wt = (const u16*)(p.ws + B_W) + (size_t)l * W_LAYER + W_IN;
  for (int tile = blockIdx.x; tile < 192 * 26; tile += gridDim.x) {
    const int mt = tile / 26, nt = tile % 26;
    f32x4 acc[4][4];
    zero_acc<4>(acc);
    gemm_core<4>(acc, H + (size_t)mt * 128 * 1024, 1024, Wt + (size_t)nt * 128 * 1024, 1024, 1024, sm);
    if (nt < 25) {
      u16* dst; int ld, c0;
      if (nt < 12) { dst = (u16*)(p.ws + B_QKV); ld = 1536; c0 = nt * 128; }
      else if (nt < 16) { dst = (u16*)(p.ws + B_Z); ld = 512; c0 = (nt - 12) * 128; }
      else if (nt < 20) { dst = (u16*)(p.ws + B_US5); ld = 512; c0 = (nt - 16) * 128; }
      else if (nt < 23) { dst = (u16*)(p.ws + B_QA); ld = 384; c0 = (nt - 20) * 128; }
      else { dst = (u16*)(p.ws + B_KVA); ld = 256; c0 = (nt - 23) * 128; }
      EPI_LOOP(4) { dst[(size_t)(mt * 128 + EROW) * ld + c0 + ECOL(4)] = f2bf(acc[i][j][r]); }
    } else {
      float* misc = (float*)(p.ws + B_MISC);
      EPI_LOOP(4) {
        int c = ECOL(4);
        if (c < 48) misc[(size_t)(mt * 128 + EROW) * 48 + c] = acc[i][j][r];
      }
    }
  }
}

DI void delta_prep_tile(const Params& p, int l, int chunk, u16* sm) {
  const int tid = otid(), lane = tid & 63, w = tid >> 6;
  const int tb = chunk * 64;
  int pos0, L;
  if (tb < TP_) { pos0 = tb & 255; L = 256; } else { pos0 = (tb - TP_) & 2047; L = 2048; }
  const u16* qkv = (const u16*)(p.ws + B_QKV);
  const float* cw = p.in[14] + (size_t)l * 5 * 1536;
  u16* ksm = sm + w * (64 * 130);
  __syncthreads();
  for (int gi = w; gi < 12; gi += 4) {
    const int ch = gi * 128 + 2 * lane;
    float w0[5], w1[5];
#pragma unroll
    for (int i = 0; i < 5; ++i) { w0[i] = cw[i * 1536 + ch]; w1[i] = cw[i * 1536 + ch + 1]; }
    float a0[5], a1[5];
#pragma unroll
    for (int i = 0; i < 4; ++i) {
      int ps = pos0 - 2 + i;
      unsigned u = (ps >= 0 && ps < L) ? *(const unsigned*)(qkv + (size_t)(tb - 2 + i) * 1536 + ch) : 0u;
      a0[i + 1] = blo(u); a1[i + 1] = bhi(u);
    }
    u16* dst = (u16*)(p.ws + (gi < 4 ? B_QN : (gi < 8 ? B_KN : B_VV)));
    const int hh = gi & 3;
    for (int tt = 0; tt < 64; ++tt) {
#pragma unroll
      for (int i = 0; i < 4; ++i) { a0[i] = a0[i + 1]; a1[i] = a1[i + 1]; }
      {
        int ps = pos0 + tt + 2;
        unsigned u = (ps < L) ? *(const unsigned*)(qkv + (size_t)(tb + tt + 2) * 1536 + ch) : 0u;
        a0[4] = blo(u); a1[4] = bhi(u);
      }
      float y0 = 0.f, y1 = 0.f;
#pragma unroll
      for (int i = 0; i < 5; ++i) { y0 += w0[i] * a0[i]; y1 += w1[i] * a1[i]; }
      y0 = siluf_(y0); y1 = siluf_(y1);
      if (gi < 8) {
        float ss = wave_sum(y0 * y0 + y1 * y1);
        float sc = rsqrtf(ss + 1e-6f);
        if (gi < 4) sc *= 0.08838834764831845f;
        y0 *= sc; y1 *= sc;
      }
      const unsigned pk = pack2(y0, y1);
      *(unsigned*)(dst + (size_t)(tb + tt) * 512 + hh * 128 + 2 * lane) = pk;
      if (gi >= 4 && gi < 8) *(unsigned*)(ksm + tt * 130 + 2 * lane) = pk;
    }
    if (gi >= 4 && gi < 8) {
      u16* kt = (u16*)(p.ws + B_KT) + (size_t)(chunk * 4 + hh) * 128 * 64;
#pragma unroll
      for (int rr = 0; rr < 2; ++rr) {
        const int dk = lane + 64 * rr;
        unsigned pk[32];
#pragma unroll
        for (int t2 = 0; t2 < 32; ++t2) pk[t2] = (unsigned)ksm[(2 * t2) * 130 + dk] | ((unsigned)ksm[(2 * t2 + 1) * 130 + dk] << 16);
#pragma unroll
        for (int q = 0; q < 8; ++q) *(uint4*)(kt + dk * 64 + q * 8) = make_uint4(pk[4 * q], pk[4 * q + 1], pk[4 * q + 2], pk[4 * q + 3]);
      }
    }
  }
  const float* misc = (const float*)(p.ws + B_MISC);
  float* bg = (float*)(p.ws + B_BG);
  for (int i = tid; i < 512; i += 256) {
    const int tt = i >> 3, dh = i & 7;
    const size_t t = tb + tt;
    float bl = misc[t * 48 + dh], alp = misc[t * 48 + 8 + dh];
    float x = alp + p.in[16][l * 8 + dh];
    float sp = x > 20.f ? x : log1pf(__expf(x));
    bg[t * 16 + dh] = sigmoidf_(bl);
    bg[t * 16 + 8 + dh] = -__expf(p.in[15][l * 8 + dh]) * sp;
  }
}

DI size_t kb_off(int t, int head) {
  if (t < TP_) return ((size_t)((t >> 8) * 8 + head) * 256 + (t & 255)) * 96;
  const int s = (t - TP_) >> 11, pos = (t - TP_) & 2047;
  return KB_P + ((size_t)(s * 8 + head) * 2304 + 256 + pos) * 96;
}
DI void mla_prep_tile(const Params& p, int l, int tile) {
  const int lane = otid() & 63, w = otid() >> 6;
  const int t = tile * 4 + w;
  u16* qa = (u16*)(p.ws + B_QA) + (size_t)t * 384;
  u16* kva = (u16*)(p.ws + B_KVA) + (size_t)t * 256;
  const float* misc = (const float*)(p.ws + B_MISC) + (size_t)t * 48;
  {
    unsigned u[3]; float ss = 0.f;
#pragma unroll
    for (int j = 0; j < 3; ++j) { u[j] = *(const unsigned*)(qa + 2 * lane + 128 * j); float a = blo(u[j]), b = bhi(u[j]); ss += a * a + b * b; }
    ss = wave_sum(ss);
    const float rstd = rsqrtf(ss * (1.f / 384.f) + 1e-6f);
    const float* g = p.in[28] + l * 384;
#pragma unroll
    for (int j = 0; j < 3; ++j) {
      int c = 2 * lane + 128 * j;
      *(unsigned*)(qa + c) = pack2(blo(u[j]) * rstd * g[c], bhi(u[j]) * rstd * g[c + 1]);
    }
  }
  {
    unsigned u[2]; float ss = 0.f;
#pragma unroll
    for (int j = 0; j < 2; ++j) { u[j] = *(const unsigned*)(kva + 2 * lane + 128 * j); float a = blo(u[j]), b = bhi(u[j]); ss += a * a + b * b; }
    ss = wave_sum(ss);
    const float rstd = rsqrtf(ss * (1.f / 256.f) + 1e-6f);
    const float* g = p.in[30] + l * 256;
#pragma unroll
    for (int j = 0; j < 2; ++j) {
      int c = 2 * lane + 128 * j;
      float a = blo(u[j]) * rstd * g[c], b = bhi(u[j]) * rstd * g[c + 1];
      *(unsigned*)(kva + c) = pack2(a, b);
      if (t < TP_) {
        float* o = p.out + O_CKV + ((size_t)((t >> 8) * 4 + l) * 256 + (t & 255)) * 256 + c;
        *(float2*)o = make_float2(a, b);
      }
    }
  }
  {
    const int i = lane & 31;
    float kr = misc[16 + i];
    float val;
    if (t < TP_) {
      val = kr;
      if (lane < 32) p.out[O_KR + ((size_t)((t >> 8) * 4 + l) * 256 + (t & 255)) * 32 + i] = kr;
    } else {
      const int pos = (t - TP_) & 2047;
      const float* rp = (const float*)(p.ws + B_ROPE) + (size_t)pos * 32 + (i & 15) * 2;
      const float cs = rp[0], sn = rp[1];
      float other = __shfl_xor(kr, 16);
      val = (i < 16) ? (kr * cs - other * sn) : (kr * cs + other * sn);
    }
    u16* kb = (u16*)(p.ws + B_KB);
    const u16 bv = f2bf(val);
#pragma unroll
    for (int hh = 0; hh < 4; ++hh) {
      int head = hh * 2 + (lane >> 5);
      kb[kb_off(t, head) + 64 + i] = bv;
    }
  }
}
DI void cache_rope_tile(const Params& p, int l, int tile) {
  const int pr = tile * 8 + (otid() >> 5), i = otid() & 31;
  const int s = pr >> 8, pos = pr & 255;
  const float v = p.in[6][((size_t)(s * 4 + l) * 256 + pos) * 32 + i];
  u16* kb = (u16*)(p.ws + B_KB);
  const u16 bv = f2bf(v);
#pragma unroll
  for (int head = 0; head < 8; ++head) kb[KB_P + ((size_t)(s * 8 + head) * 2304 + pos) * 96 + 64 + i] = bv;
}

DI float gelu_tanh(float x) {
  const float k0 = 0.7978845608028654f, k1 = 0.044715f;
  float u = k0 * (x + k1 * x * x * x);
  float e = __expf(2.f * u);
  float th = 1.f - 2.f / (e + 1.f);
  return 0.5f * x * (1.f + th);
}
DI void s5_chunk_tile(const Params& p, int l, int chunk, int gp, int mode, u16* sm) {
  const int tid = otid(), lane = tid & 63, w = tid >> 6;
  const u16* us5 = (const u16*)(p.ws + B_US5);
  constexpr int RS = 136;
  __syncthreads();
  {
    const int gi = w >> 1, half = w & 1, g = gp * 2 + gi;
    const int n = lane & 31, h2 = lane >> 5;
    bf16x8 af[2];
#pragma unroll
    for (int mi = 0; mi < 2; ++mi) af[mi] = *(const bf16x8*)(us5 + (size_t)(chunk * 64 + mi * 32 + n) * 512 + g * 16 + 8 * h2);
#pragma unroll
    for (int dir = 0; dir < 2; ++dir) {
      const u16* bbt = (const u16*)(p.ws + B_BBT) + (size_t)((l * 2 + dir) * 32 + g) * 128 * 16;
#pragma unroll
      for (int nn = 0; nn < 2; ++nn) {
        const int nt = half * 2 + nn;
        bf16x8 bfr = *(const bf16x8*)(bbt + (nt * 32 + n) * 16 + 8 * h2);
#pragma unroll
        for (int mi = 0; mi < 2; ++mi) {
          f32x16 acc;
#pragma unroll
          for (int r = 0; r < 16; ++r) acc[r] = 0.f;
          acc = MFMA32(af[mi], bfr, acc);
          u16* d = sm + (size_t)((gi * 2 + dir) * 64 + mi * 32) * RS + nt * 32 + n;
#pragma unroll
          for (int r = 0; r < 16; ++r) d[crow(r, h2) * RS] = f2bf(acc[r]);
        }
      }
    }
  }
  __syncthreads();
  {
    const int gi = tid >> 7, dir = (tid >> 6) & 1, pp = tid & 63, g = gp * 2 + gi;
    const float2 lb = ((const float2*)(p.ws + B_LAMB))[((l * 2 + dir) * 32 + g) * 64 + pp];
    const size_t hidx = ((size_t)(chunk * 32 + g) * 2 + dir) * 64 + pp;
    float hr = 0.f, hi = 0.f;
    if (mode) { float2 h0 = ((const float2*)(p.ws + B_HIN))[hidx]; hr = h0.x; hi = h0.y; }
    u16* base = sm + (size_t)((gi * 2 + dir) * 64) * RS;
#pragma unroll 8
    for (int st = 0; st < 64; ++st) {
      const int tk = dir ? 63 - st : st;
      float br = bf2f(base[tk * RS + pp]), bi = bf2f(base[tk * RS + 64 + pp]);
      float nr = lb.x * hr - lb.y * hi + br;
      float ni = lb.x * hi + lb.y * hr + bi;
      hr = nr; hi = ni;
      if (mode) { base[tk * RS + pp] = f2bf(hr); base[tk * RS + 64 + pp] = f2bf(hi); }
    }
    if (!mode) ((float2*)(p.ws + B_HEND))[hidx] = make_float2(hr, hi);
  }
  if (!mode) return;
  __syncthreads();
  {
    const int gi = w >> 1, g = gp * 2 + gi;
    const int fr = lane & 15, fq = lane >> 4;
    const u16* cmt = (const u16*)(p.ws + B_CMT) + (size_t)(l * 32 + g) * 16 * 128;
    f32x4 acc[2];
    acc[0] = f32x4{0.f, 0.f, 0.f, 0.f}; acc[1] = acc[0];
#pragma unroll
    for (int ks = 0; ks < 8; ++ks) {
      const int dir = ks >> 2, kk = (ks & 3) * 32;
      bf16x8 bfr = *(const bf16x8*)(cmt + fr * 128 + kk + fq * 8);
#pragma unroll
      for (int mm = 0; mm < 2; ++mm) {
        const int mi = (w & 1) * 2 + mm;
        bf16x8 af = *(const bf16x8*)(sm + (size_t)((gi * 2 + dir) * 64 + mi * 16 + fr) * RS + kk + fq * 8);
        acc[mm] = MFMA16(af, bfr, acc[mm]);
      }
    }
    const float dsk = p.in[25][l * 512 + g * 16 + fr];
    u16* y5 = (u16*)(p.ws + B_Y5);
#pragma unroll
    for (int mm = 0; mm < 2; ++mm)
#pragma unroll
      for (int r = 0; r < 4; ++r) {
        const size_t t = (size_t)chunk * 64 + ((w & 1) * 2 + mm) * 16 + fq * 4 + r;
        float u = bf2f(us5[t * 512 + g * 16 + fr]);
        float y = acc[mm][r] + dsk * u;
        y5[t * 512 + g * 16 + fr] = f2bf(gelu_tanh(y));
      }
  }
}
DI void s5_carry_tile(const Params& p, int l, int tile) {
  const int seq = tile >> 4, gp = tile & 15;
  const int tid = otid(), gi = tid >> 7, dir = (tid >> 6) & 1, pp = tid & 63, g = gp * 2 + gi;
  int c0, nc;
  if (seq < 32) { c0 = seq * 4; nc = 4; } else { c0 = 128 + (seq - 32) * 32; nc = 32; }
  const float2 l64 = ((const float2*)(p.ws + B_LAM64))[((l * 2 + dir) * 32 + g) * 64 + pp];
  float hr = 0.f, hi = 0.f;
  if (seq >= 32) {
    const size_t si = ((size_t)((seq - 32) * 4 + l) * 2 + dir) * 2048 + g * 64 + pp;
    hr = p.in[3][si]; hi = p.in[4][si];
  }
  const float2* hend = (const float2*)(p.ws + B_HEND);
  float2* hin = (float2*)(p.ws + B_HIN);
  for (int it = 0; it < nc; ++it) {
    const int ck = c0 + (dir ? nc - 1 - it : it);
    const size_t idx = ((size_t)(ck * 32 + g) * 2 + dir) * 64 + pp;
    hin[idx] = make_float2(hr, hi);
    float2 he = hend[idx];
    float nr = l64.x * hr - l64.y * hi + he.x;
    float ni = l64.x * hi + l64.y * hr + he.y;
    hr = nr; hi = ni;
  }
  if (seq < 32) {
    const size_t so = ((size_t)(seq * 4 + l) * 2 + dir) * 2048 + g * 64 + pp;
    p.out[O_S5RE + so] = hr;
    p.out[O_S5IM + so] = hi;
  }
}

DI void delta_local_tile(const Params& p, int tile, float* smf) {
  const int chunk = tile >> 1, dir = tile & 1;
  const int tid = otid(), lane = tid & 63, h = tid >> 6;
  const int m = lane & 31, h2 = lane >> 5;
  const int tb = chunk * 64;
  const float* bg = (const float*)(p.ws + B_BG);
  const u16* kn = (const u16*)(p.ws + B_KN);
  const u16* qn = (const u16*)(p.ws + B_QN);
  float* Aw = smf + h * 4096;
  const size_t cidx = ((size_t)(chunk * 4 + h) * 2 + dir);
  const int tl = tb + (dir ? 63 - lane : lane);
  float gcs = bg[(size_t)tl * 16 + 8 + dir * 4 + h];
  const float beta = bg[(size_t)tl * 16 + dir * 4 + h];
#pragma unroll
  for (int o = 1; o < 64; o <<= 1) {
    float v = __shfl_up(gcs, o);
    if (lane >= o) gcs += v;
  }
  ((float*)(p.ws + B_GC))[cidx * 64 + lane] = gcs;
  ((float*)(p.ws + B_BC))[cidx * 64 + lane] = beta;
  __syncthreads();
  u16* qkm = (u16*)(p.ws + B_QKM) + cidx * 4096;
#pragma unroll 1
  for (int tt = 0; tt < 3; ++tt) {
    const int mi = tt == 0 ? 0 : 1, ni = tt == 2 ? 1 : 0;
    const int cm = 32 * mi + m, cn = 32 * ni + m;
    const u16* krm = kn + (size_t)(tb + (dir ? 63 - cm : cm)) * 512 + h * 128 + h2 * 8;
    const u16* qrm = qn + (size_t)(tb + (dir ? 63 - cm : cm)) * 512 + h * 128 + h2 * 8;
    const u16* krn = kn + (size_t)(tb + (dir ? 63 - cn : cn)) * 512 + h * 128 + h2 * 8;
    f32x16 ak, aq;
#pragma unroll
    for (int r = 0; r < 16; ++r) { ak[r] = 0.f; aq[r] = 0.f; }
#pragma unroll
    for (int ks = 0; ks < 8; ++ks) {
      const bf16x8 fkm = *(const bf16x8*)(krm + ks * 16), fqm = *(const bf16x8*)(qrm + ks * 16), fkn = *(const bf16x8*)(krn + ks * 16);
      ak = MFMA32(fkm, fkn, ak);
      aq = MFMA32(fqm, fkn, aq);
    }
    const int e = 32 * ni + m;
    const float gce = __shfl(gcs, e);
#pragma unroll
    for (int r = 0; r < 16; ++r) {
      const int c = 32 * mi + crow(r, h2);
      const float gcc = __shfl(gcs, c), bc = __shfl(beta, c);
      const float dec = (e <= c) ? __expf(gcc - gce) : 0.f;
      Aw[c * 64 + e] = (e < c) ? ak[r] * bc * dec : 0.f;
      qkm[c * 64 + e] = f2bf(aq[r] * dec);
    }
  }
  __syncthreads();
  u16* tm = (u16*)(p.ws + B_TM) + cidx * 4096;
  float x[64];
#pragma unroll
  for (int i = 0; i < 64; ++i) {
    float a = (i == lane) ? 1.f : 0.f;
#pragma unroll
    for (int j = 0; j < i; ++j) a -= Aw[i * 64 + j] * x[j];
    x[i] = a;
    tm[i * 64 + lane] = f2bf(a);
  }
}

template <int dir>
DI void delta_scan_body(const Params& p, int l, int seq, int h, u16* sm);
DI void delta_scan_tile(const Params& p, int l, int idx, u16* sm) {
  int seq, h, dir;
  if (idx < 64) { seq = 32 + (idx >> 3); h = (idx >> 1) & 3; dir = idx & 1; }
  else { const int i2 = idx - 64; seq = i2 >> 3; h = (i2 >> 1) & 3; dir = i2 & 1; }
  if (dir) delta_scan_body<1>(p, l, seq, h, sm); else delta_scan_body<0>(p, l, seq, h, sm);
}
template <int dir>
DI void delta_scan_body(const Params& p, int l, int seq, int h, u16* sm) {
  int chunk0, nch;
  if (seq < 32) { chunk0 = seq * 4; nch = 4; } else { chunk0 = 128 + (seq - 32) * 32; nch = 32; }
  const int lane = otid() & 63, w = otid() >> 6;
  const int n = lane & 31, h2 = lane >> 5;
  const int dvc = w * 32 + n;
  const u16* kn = (const u16*)(p.ws + B_KN);
  const u16* qn = (const u16*)(p.ws + B_QN);
  const u16* vv = (const u16*)(p.ws + B_VV);
  u16* od = (u16*)(p.ws + (dir ? B_OB : B_OF));
  f32x16 S[4];
  if (seq >= 32) {
    const float* s0 = p.in[2] + ((size_t)(((seq - 32) * 4 + l) * 2 + dir) * 4 + h) * 16384;
#pragma unroll
    for (int t = 0; t < 4; ++t)
#pragma unroll
      for (int r = 0; r < 16; ++r) S[t][r] = s0[(size_t)(32 * t + crow(r, h2)) * 128 + dvc];
  } else {
#pragma unroll
    for (int t = 0; t < 4; ++t)
#pragma unroll
      for (int r = 0; r < 16; ++r) S[t][r] = 0.f;
  }
  for (int it = 0; it < nch; ++it) {
    const int chunk = chunk0 + (dir ? nch - 1 - it : it);
    const int tb = chunk * 64;
    const size_t cidx = ((size_t)(chunk * 4 + h) * 2 + dir);
    const float* gcp = (const float*)(p.ws + B_GC) + cidx * 64;
    const float* bcp = (const float*)(p.ws + B_BC) + cidx * 64;
    const u16* tm = (const u16*)(p.ws + B_TM) + cidx * 4096;
    const u16* qkm = (const u16*)(p.ws + B_QKM) + cidx * 4096;
    const u16* ktp = (const u16*)(p.ws + B_KT) + (size_t)(chunk * 4 + h) * 8192;
    const float glast = gcp[63];
    size_t trow[2];
#pragma unroll
    for (int mi = 0; mi < 2; ++mi) { const int c = 32 * mi + n; trow[mi] = (size_t)(tb + (dir ? 63 - c : c)); }
#define SCHED_FENCE() asm volatile("" ::: "memory")
    u16* vls = sm + w * (64 * 40);
    __syncthreads();
#pragma unroll
    for (int jv = 0; jv < 4; ++jv) {
      const int tau = (lane >> 2) + 16 * jv, cq = lane & 3;
      const uint4 vq = *(const uint4*)(vv + (size_t)(tb + tau) * 512 + h * 128 + w * 32 + cq * 8);
      *(uint4*)(vls + (dir ? 63 - tau : tau) * 40 + cq * 8) = vq;
    }
    __syncthreads();
    f32x16 X[2], QS[2];
    {
      bf16x8 Sb[4][2];
#pragma unroll
      for (int t = 0; t < 4; ++t)
#pragma unroll
        for (int s = 0; s < 2; ++s) Sb[t][s] = pack_acc(S[t], s);
#pragma unroll
      for (int mi = 0; mi < 2; ++mi)
#pragma unroll
        for (int r = 0; r < 16; ++r) { X[mi][r] = 0.f; QS[mi][r] = 0.f; }
#pragma unroll
      for (int t = 0; t < 4; ++t) {
#pragma unroll
        for (int mi = 0; mi < 2; ++mi) {
          const u16* krow_ = kn + trow[mi] * 512 + h * 128;
          const u16* qrow_ = qn + trow[mi] * 512 + h * 128;
#pragma unroll
          for (int s = 0; s < 2; ++s) {
            X[mi] = MFMA32(load_perm(krow_ + 32 * t, s, h2), Sb[t][s], X[mi]);
            QS[mi] = MFMA32(load_perm(qrow_ + 32 * t, s, h2), Sb[t][s], QS[mi]);
          }
        }
        SCHED_FENCE();
      }
    }
    bf16x8 Rb[2][2];
#pragma unroll
    for (int mi = 0; mi < 2; ++mi) {
#pragma unroll
      for (int a = 0; a < 4; ++a) {
        const int c4 = 32 * mi + 8 * a + 4 * h2;
        const float4 g4 = *(const float4*)(gcp + c4);
        const float4 b4 = *(const float4*)(bcp + c4);
        const float gg[4] = {g4.x, g4.y, g4.z, g4.w};
        const float bb[4] = {b4.x, b4.y, b4.z, b4.w};
#pragma unroll
        for (int q = 0; q < 4; ++q) {
          const int c = c4 + q;
          const float v = bf2f(vls[c * 40 + n]);
          const float eg = __expf(gg[q]);
          X[mi][4 * a + q] = bb[q] * (v - eg * X[mi][4 * a + q]);
          QS[mi][4 * a + q] *= eg;
        }
      }
      Rb[mi][0] = pack_acc(X[mi], 0);
      Rb[mi][1] = pack_acc(X[mi], 1);
    }
    SCHED_FENCE();
    f32x16 Vn[2];
#pragma unroll
    for (int mo = 0; mo < 2; ++mo) {
#pragma unroll
      for (int r = 0; r < 16; ++r) Vn[mo][r] = 0.f;
#pragma unroll
      for (int mi = 0; mi <= mo; ++mi)
#pragma unroll
        for (int s = 0; s < 2; ++s) Vn[mo] = MFMA32(load_perm(tm + (32 * mo + n) * 64 + 32 * mi, s, h2), Rb[mi][s], Vn[mo]);
    }
    SCHED_FENCE();
    {
      bf16x8 Vb[2][2];
#pragma unroll
      for (int mi = 0; mi < 2; ++mi) { Vb[mi][0] = pack_acc(Vn[mi], 0); Vb[mi][1] = pack_acc(Vn[mi], 1); }
#pragma unroll
      for (int mo = 0; mo < 2; ++mo) {
#pragma unroll
        for (int mi = 0; mi <= mo; ++mi)
#pragma unroll
          for (int s = 0; s < 2; ++s) QS[mo] = MFMA32(load_perm(qkm + (32 * mo + n) * 64 + 32 * mi, s, h2), Vb[mi][s], QS[mo]);
      }
      __syncthreads();
#pragma unroll
      for (int mo = 0; mo < 2; ++mo)
#pragma unroll
        for (int r = 0; r < 16; ++r) vls[(32 * mo + crow(r, h2)) * 40 + n] = f2bf(QS[mo][r]);
      __syncthreads();
#pragma unroll
      for (int jv = 0; jv < 4; ++jv) {
        const int tau = (lane >> 2) + 16 * jv, cq = lane & 3;
        const uint4 oq = *(const uint4*)(vls + (dir ? 63 - tau : tau) * 40 + cq * 8);
        *(uint4*)(od + (size_t)(tb + tau) * 512 + h * 128 + w * 32 + cq * 8) = oq;
      }
    }
    SCHED_FENCE();
    bf16x8 Vsb[2][2];
#pragma unroll
    for (int mi = 0; mi < 2; ++mi) {
#pragma unroll
      for (int a = 0; a < 4; ++a) {
        const float4 g4 = *(const float4*)(gcp + 32 * mi + 8 * a + 4 * h2);
        Vn[mi][4 * a + 0] *= __expf(glast - g4.x); Vn[mi][4 * a + 1] *= __expf(glast - g4.y);
        Vn[mi][4 * a + 2] *= __expf(glast - g4.z); Vn[mi][4 * a + 3] *= __expf(glast - g4.w);
      }
      Vsb[mi][0] = pack_acc(Vn[mi], 0); Vsb[mi][1] = pack_acc(Vn[mi], 1);
    }
    const float eg = __expf(glast);
#pragma unroll
    for (int t = 0; t < 4; ++t) {
#pragma unroll
      for (int r = 0; r < 16; ++r) S[t][r] *= eg;
      const u16* ktrow = ktp + (32 * t + n) * 64;
#pragma unroll
      for (int mi = 0; mi < 2; ++mi)
#pragma unroll
        for (int s = 0; s < 2; ++s) {
          bf16x8 a = dir ? load_perm_rev(ktrow, 32 * mi, s, h2) : load_perm(ktrow + 32 * mi, s, h2);
          S[t] = MFMA32(a, Vsb[mi][s], S[t]);
        }
      SCHED_FENCE();
    }
  }
  if (seq < 32) {
    float* so = p.out + O_SD + ((size_t)((seq * 4 + l) * 2 + dir) * 4 + h) * 16384;
#pragma unroll
    for (int t = 0; t < 4; ++t)
#pragma unroll
      for (int r = 0; r < 16; ++r) so[(size_t)(32 * t + crow(r, h2)) * 128 + dvc] = S[t][r];
  }
}

DI void attn_tile(const Params& p, int seq, int head, int qb) {
  const int lane = otid() & 63, w = otid() >> 6;
  const int n = lane & 31, h2 = lane >> 5;
  int tq0, nkeys; size_t kbo, vto;
  if (seq < 32) { tq0 = seq * 256 + qb * 128 + w * 32; nkeys = 256; kbo = (size_t)(seq * 8 + head) * 256 * 96; vto = (size_t)(seq * 8 + head) * 64 * 256; }
  else { const int s = seq - 32; tq0 = TP_ + s * 2048 + qb * 128 + w * 32; nkeys = 2304; kbo = KB_P + (size_t)(s * 8 + head) * 2304 * 96; vto = VT_P + (size_t)(s * 8 + head) * 64 * 2304; }
  const u16* kb = (const u16*)(p.ws + B_KB) + kbo;
  const u16* vt = (const u16*)(p.ws + B_VT) + vto;
  const u16* qm = (const u16*)(p.ws + B_QM) + (size_t)(tq0 + n) * 768 + head * 96;
  bf16x8 qf[6];
#pragma unroll
  for (int ks = 0; ks < 6; ++ks) qf[ks] = *(const bf16x8*)(qm + ks * 16 + h2 * 8);
  f32x16 O[2];
#pragma unroll
  for (int r = 0; r < 16; ++r) { O[0][r] = 0.f; O[1][r] = 0.f; }
  float mrun = -1e30f, lsum = 0.f;
  const int nkt = nkeys >> 6;
  for (int kt = 0; kt < nkt; ++kt) {
    f32x16 St[2];
#pragma unroll
    for (int sub = 0; sub < 2; ++sub) {
#pragma unroll
      for (int r = 0; r < 16; ++r) St[sub][r] = 0.f;
      const u16* kr = kb + (size_t)(kt * 64 + sub * 32 + n) * 96 + h2 * 8;
#pragma unroll
      for (int ks = 0; ks < 6; ++ks) St[sub] = MFMA32(*(const bf16x8*)(kr + ks * 16), qf[ks], St[sub]);
    }
    float mx = St[0][0];
#pragma unroll
    for (int r = 0; r < 16; ++r) { mx = fmaxf(mx, St[0][r]); mx = fmaxf(mx, St[1][r]); }
    mx = fmaxf(mx, __shfl_xor(mx, 32));
    const float mnew = fmaxf(mrun, mx);
    const float alpha = exp2f(mrun - mnew);
    mrun = mnew;
    float ps = 0.f;
#pragma unroll
    for (int sub = 0; sub < 2; ++sub)
#pragma unroll
      for (int r = 0; r < 16; ++r) { float e = exp2f(St[sub][r] - mnew); St[sub][r] = e; ps += e; }
    lsum = lsum * alpha + ps;
#pragma unroll
    for (int r = 0; r < 16; ++r) { O[0][r] *= alpha; O[1][r] *= alpha; }
#pragma unroll
    for (int sub = 0; sub < 2; ++sub)
#pragma unroll
      for (int s = 0; s < 2; ++s) {
        const bf16x8 pb = pack_acc(St[sub], s);
#pragma unroll
        for (int dt = 0; dt < 2; ++dt)
          O[dt] = MFMA32(load_perm(vt + (size_t)(dt * 32 + n) * nkeys + kt * 64 + sub * 32, s, h2), pb, O[dt]);
      }
  }
  lsum += __shfl_xor(lsum, 32);
  const float inv = 1.f / lsum;
  u16* oc = (u16*)(p.ws + B_OC) + (size_t)(tq0 + n) * 512 + head * 64;
#pragma unroll
  for (int dt = 0; dt < 2; ++dt)
#pragma unroll
    for (int a = 0; a < 4; ++a) {
      const int dv = dt * 32 + 8 * a + 4 * h2;
      *(uint2*)(oc + dv) = make_uint2(pack2(O[dt][4 * a] * inv, O[dt][4 * a + 1] * inv), pack2(O[dt][4 * a + 2] * inv, O[dt][4 * a + 3] * inv));
    }
}

DI void delta_out_tile(const Params& p, int l, int tile) {
  const int lane = otid() & 63, w = otid() >> 6;
  const u16* of = (const u16*)(p.ws + B_OF);
  const u16* ob = (const u16*)(p.ws + B_OB);
  const u16* z = (const u16*)(p.ws + B_Z);
  u16* oa = (u16*)(p.ws + B_OA);
  const float g0 = p.in[17][l * 128 + 2 * lane], g1 = p.in[17][l * 128 + 2 * lane + 1];
#pragma unroll 1
  for (int q = 0; q < 16; ++q) {
    const size_t t = (size_t)tile * 16 + w * 4 + (q >> 2);
    const int hh = q & 3;
    const size_t off = t * 512 + hh * 128 + 2 * lane;
    unsigned a = *(const unsigned*)(of + off), b = *(const unsigned*)(ob + off), zz = *(const unsigned*)(z + off);
    float o0 = blo(a) + blo(b), o1 = bhi(a) + bhi(b);
    float ss = wave_sum(o0 * o0 + o1 * o1);
    float rstd = rsqrtf(ss * (1.f / 128.f) + 1e-6f);
    float y0 = o0 * rstd * g0 * siluf_(blo(zz)), y1 = o1 * rstd * g1 * siluf_(bhi(zz));
    *(unsigned*)(oa + off) = pack2(y0, y1);
  }
}

#define GSYNC() do { __threadfence(); grid.sync(); __threadfence(); } while (0)
#ifndef ONLY
#define PH(n) 1
#else
#define PH(n) ((n) == ONLY || (n) / 100 == ONLY || (n) == ONLY / 100)
#endif
__global__ void __launch_bounds__(256, 2) mega(Params p) {
  cg::grid_group grid = cg::this_grid();
  __shared__ __attribute__((aligned(16))) char smem_raw[73728];
  u16* sm = (u16*)smem_raw;
  float* smf = (float*)smem_raw;
  const int nb = gridDim.x, bid = blockIdx.x;

  if (PH(0)) {
    const int tid = otid();
    for (int j = bid; j < 4 * CJ8; j += nb) conv_job(p, j / CJ8, j % CJ8, smf);
    for (int j = bid; j < 4 * 96; j += nb) mods_tile(p, j / 96, j % 96, smf);
    for (int j = bid; j < 64; j += nb) s5pre_tile(p, j);
    {
      const float4* xp = (const float4*)p.in[0];
      const float4* xs = (const float4*)p.in[1];
      float4* o = (float4*)p.out;
      const size_t nP = (size_t)TP_ * 256, nT = (size_t)T_ * 256;
      for (size_t i = (size_t)bid * 256 + tid; i < nT; i += (size_t)nb * 256) o[i] = i < nP ? xp[i] : xs[i - nP];
    }
    {
      float* rope = (float*)(p.ws + B_ROPE);
      for (int i = bid * 256 + tid; i < 2048 * 16; i += nb * 256) {
        const int pos = i >> 4, f = i & 15;
        const float invf = 1.f / powf(10000.f, (float)(f & 7) * 0.125f);
        const float ang = (f < 8 ? (float)(pos >> 6) : (float)(pos & 63)) * invf;
        float sn, cs;
        sincosf(ang, &sn, &cs);
        rope[i * 2] = cs; rope[i * 2 + 1] = sn;
      }
    }
    {
      u16* cc = (u16*)(p.ws + B_CKVC);
      for (int i = bid * 256 + tid; i < 8 * 4 * 256 * 256 / 2; i += nb * 256) {
        const int e = i * 2;
        const int c = e & 255, pos = (e >> 8) & 255, l = (e >> 16) & 3, b = e >> 18;
        float2 v = *(const float2*)(p.in[5] + e);
        *(unsigned*)(cc + ((size_t)(l * 2048 + b * 256 + pos)) * 256 + c) = pack2(v.x, v.y);
      }
    }
  }
  GSYNC();

  for (int l = 0; l < 4; ++l) {
    const u16* WL = (const u16*)(p.ws + B_W) + (size_t)l * W_LAYER;
    const float* mods = (const float*)(p.ws + B_MODS);
    if (PH(1)) norm_phase(p, l, 0, 1, p.in[11] + l * 1024);
    GSYNC();
    if (PH(2)) gemm_in_phase(p, l, sm);
    GSYNC();
    if (PH(3)) {
      for (int j = bid; j < NCH; j += nb) delta_prep_tile(p, l, j, sm);
      for (int j = bid; j < T_ / 4; j += nb) mla_prep_tile(p, l, j);
      for (int j = bid; j < 256; j += nb) cache_rope_tile(p, l, j);
      for (int j = bid; j < NCH * 16; j += nb) s5_chunk_tile(p, l, j >> 4, j & 15, 0, sm);
    }
    GSYNC();
    if (PH(4)) {
      const int tid = otid();
      if (PH(400)) for (int j = bid; j < NCH * 2; j += nb) delta_local_tile(p, j, smf);
      if (PH(410)) for (int j = bid; j < 192 * 6; j += nb) {
          const int q = j, mt = q / 6, nt = q % 6;
          f32x4 acc[4][4];
          zero_acc<4>(acc);
          gemm_core<4>(acc, (const u16*)(p.ws + B_QA) + (size_t)mt * 128 * 384, 384, WL + W_QB + (size_t)nt * 128 * 384, 384, 384, sm);
          u16* qm = (u16*)(p.ws + B_QM);
          const float qs = 0.10206207261596575f * 1.4426950408889634f;
          const float* rope = (const float*)(p.ws + B_ROPE);
          const int e_lane = tid & 63, e_w = tid >> 6, e_wr = e_w >> 1, e_wc = e_w & 1, e_fr = e_lane & 15, e_fq = e_lane >> 4;
          const bool is_s = (mt * 128 >= TP_);
#pragma unroll
          for (int i = 0; i < 4; ++i)
#pragma unroll
            for (int r = 0; r < 4; ++r) {
              const int row = mt * 128 + e_wr * 64 + i * 16 + e_fq * 4 + r;
              float vals[4];
#pragma unroll
              for (int jj = 0; jj < 4; ++jj) vals[jj] = acc[i][jj][r];
              if (is_s) {
                const int pos = (row - TP_) & 2047;
                const float cs = rope[(pos * 16 + e_fr) * 2], sn = rope[(pos * 16 + e_fr) * 2 + 1];
#pragma unroll
                for (int jj = 0; jj < 4; jj += 2) {
                  const int gt = (nt * 128 + e_wc * 64) / 16 + jj;
                  if (gt % 6 == 4) {
                    const float x1 = vals[jj], x2 = vals[jj + 1];
                    vals[jj] = x1 * cs - x2 * sn;
                    vals[jj + 1] = x2 * cs + x1 * sn;
                  }
                }
              }
#pragma unroll
              for (int jj = 0; jj < 4; ++jj) qm[(size_t)row * 768 + nt * 128 + e_wc * 64 + jj * 16 + e_fr] = f2bf(vals[jj] * qs);
            }
      }
      if (PH(420)) for (int j = bid; j < 208 * 8; j += nb) {
          const int q = j, mt = q >> 3, head = q & 7;
          f32x4 acc[4][4];
          zero_acc<4>(acc);
          const u16* A = mt < 192 ? (const u16*)(p.ws + B_KVA) + (size_t)mt * 128 * 256
                                  : (const u16*)(p.ws + B_CKVC) + ((size_t)l * 2048 + (size_t)(mt - 192) * 128) * 256;
          gemm_core<4>(acc, A, 256, WL + W_KVB + (size_t)head * 128 * 256, 256, 256, sm);
          int key0, nkeys; size_t kbo, vto;
          if (mt < 64) { const int seq = mt >> 1; key0 = (mt & 1) * 128; nkeys = 256; kbo = (size_t)(seq * 8 + head) * 256 * 96; vto = (size_t)(seq * 8 + head) * 64 * 256; }
          else if (mt < 192) { const int s = (mt - 64) >> 4; key0 = 256 + ((mt - 64) & 15) * 128; nkeys = 2304; kbo = KB_P + (size_t)(s * 8 + head) * 2304 * 96; vto = VT_P + (size_t)(s * 8 + head) * 64 * 2304; }
          else { const int s = (mt - 192) >> 1; key0 = ((mt - 192) & 1) * 128; nkeys = 2304; kbo = KB_P + (size_t)(s * 8 + head) * 2304 * 96; vto = VT_P + (size_t)(s * 8 + head) * 64 * 2304; }
          u16* kb = (u16*)(p.ws + B_KB) + kbo;
          u16* vt = (u16*)(p.ws + B_VT) + vto;
          const int e_lane = tid & 63, e_w = tid >> 6, e_wr = e_w >> 1, e_wc = e_w & 1, e_fr = e_lane & 15, e_fq = e_lane >> 4;
#pragma unroll
          for (int i = 0; i < 4; ++i)
#pragma unroll
            for (int jj = 0; jj < 4; ++jj) {
              const int key = key0 + e_wr * 64 + i * 16 + e_fq * 4;
              const int c = jj * 16 + e_fr;
              if (e_wc == 0) {
#pragma unroll
                for (int r = 0; r < 4; ++r) kb[(size_t)(key + r) * 96 + c] = f2bf(acc[i][jj][r]);
              } else {
                *(uint2*)(vt + (size_t)c * nkeys + key) = make_uint2(pack2(acc[i][jj][0], acc[i][jj][1]), pack2(acc[i][jj][2], acc[i][jj][3]));
              }
            }
      }
      if (PH(430)) for (int j = bid; j < 640; j += nb) s5_carry_tile(p, l, j);
    }
    GSYNC();
    if (PH(5)) {
      if (PH(500)) for (int j = bid; j < 320; j += nb) delta_scan_tile(p, l, j, sm);
      if (PH(510)) for (int j = bid; j < 1536; j += nb) {
        if (j < 1024) attn_tile(p, 32 + (j >> 7), (j >> 4) & 7, j & 15);
        else { const int q = j - 1024; attn_tile(p, q >> 4, (q >> 1) & 7, q & 1); }
      }
      if (PH(530)) for (int j = bid; j < NCH * 8; j += nb) {
        s5_chunk_tile(p, l, j >> 3, (j & 7) * 2, 1, sm);
        s5_chunk_tile(p, l, j >> 3, (j & 7) * 2 + 1, 1, sm);
      }
    }
    GSYNC();
    if (PH(6)) {
      for (int j = bid; j < T_ / 16; j += nb) delta_out_tile(p, l, j);
      for (int j = bid; j < 192 * 4; j += nb) {
        {
          const int q = j, mt = q >> 2, nt = q & 3;
          f32x4 acc[4][4];
          zero_acc<4>(acc);
          const u16* y5 = (const u16*)(p.ws + B_Y5);
          gemm_core<4>(acc, y5 + (size_t)mt * 128 * 512, 512, WL + W_GLU + (size_t)nt * 128 * 512, 512, 512, sm);
          u16* ob5 = (u16*)(p.ws + B_OB5);
          const float* bgl = p.in[27] + l * 512;
          EPI_LOOP(4) {
            const size_t row = mt * 128 + EROW; const int col = nt * 128 + ECOL(4);
            const float y = bf2f(y5[row * 512 + col]);
            ob5[row * 512 + col] = f2bf(y * sigmoidf_(acc[i][j][r] + bgl[col]));
          }
        }
      }
    }
    GSYNC();
    if (PH(7)) {
      const u16* H = (const u16*)(p.ws + B_H);
      u16* mg = (u16*)(p.ws + B_MG);
      for (int j = bid; j < 192 * 16; j += nb) {
        const int mt = j >> 4, nt = j & 15;
        f32x4 mer[4][2];
        zero_acc<2>(mer);
#pragma unroll 1
        for (int n = 0; n < 3; ++n) {
          f32x4 ag[4][2], ab[4][2];
          zero_acc<2>(ag);
          gemm_core<2>(ag, H + (size_t)mt * 128 * 1024, 1024, WL + W_G + (size_t)(n * 1024 + nt * 64) * 1024, 1024, 1024, sm);
          zero_acc<2>(ab);
          const u16* on = (const u16*)(p.ws + (n == 0 ? B_OA : (n == 1 ? B_OB5 : B_OC)));
          gemm_core<2>(ab, on + (size_t)mt * 128 * 512, 512, WL + W_BR + (size_t)(nt * 64) * 1536 + n * 512, 1536, 512, sm);
#pragma unroll
          for (int i = 0; i < 4; ++i)
#pragma unroll
            for (int jj = 0; jj < 2; ++jj)
#pragma unroll
              for (int r = 0; r < 4; ++r) mer[i][jj][r] += sigmoidf_(ag[i][jj][r]) * ab[i][jj][r];
        }
        EPI_LOOP(2) { mg[(size_t)(mt * 128 + EROW) * 1024 + nt * 64 + ECOL(2)] = f2bf(mer[i][j][r]); }
      }
    }
    GSYNC();
    if (PH(8)) {
      const u16* mg = (const u16*)(p.ws + B_MG);
      for (int j = bid; j < 192 * 8; j += nb) {
        const int mt = j >> 3, nt = j & 7;
        f32x4 acc[4][4];
        zero_acc<4>(acc);
        gemm_core<4>(acc, mg + (size_t)mt * 128 * 1024, 1024, WL + W_OUT + (size_t)nt * 128 * 1024, 1024, 1024, sm);
        const float* gm = mods + (size_t)(l * 9 + tok_v(mt * 128)) * 6144 + 2 * 1024;
        EPI_LOOP(4) {
          const size_t row = mt * 128 + EROW; const int col = nt * 128 + ECOL(4);
          p.out[row * 1024 + col] += gm[col] * acc[i][j][r];
        }
      }
    }
    GSYNC();
    if (PH(9)) norm_phase(p, l, 3, 4, p.in[12] + l * 1024);
    GSYNC();
    if (PH(10)) {
      const u16* H = (const u16*)(p.ws + B_H);
      u16* up = (u16*)(p.ws + B_UP);
      for (int j = bid; j < 192 * 44; j += nb) {
        const int mt = j / 44, nt = j % 44;
        f32x4 acc[4][4];
        zero_acc<4>(acc);
        gemm_core<4>(acc, H + (size_t)mt * 128 * 1024, 1024, WL + W_UP + (size_t)nt * 128 * 1024, 1024, 1024, sm);
        EPI_LOOP(4) { up[(size_t)(mt * 128 + EROW) * 5632 + nt * 128 + ECOL(4)] = f2bf(acc[i][j][r]); }
      }
    }
    GSYNC();
    if (PH(11)) {
      const int tid = otid();
      const u16* up = (const u16*)(p.ws + B_UP);
      u16* act = (u16*)(p.ws + B_ACT);
      const float* cw = p.in[35] + (size_t)l * 3 * 5632;
      const float* cb = p.in[36] + (size_t)l * 5632;
      for (size_t it = (size_t)bid * 256 + tid; it < (size_t)T_ * 352; it += (size_t)nb * 256) {
        const int t = (int)(it / 352), c8 = (int)(it % 352) * 8;
        int pos, L;
        if (t < TP_) { pos = t & 255; L = 256; } else { pos = (t - TP_) & 2047; L = 2048; }
        float res[8];
        float gv[8], vv2[8];
#pragma unroll
        for (int e = 0; e < 8; ++e) { gv[e] = cb[c8 + e]; vv2[e] = cb[2816 + c8 + e]; }
#pragma unroll
        for (int d = 0; d < 3; ++d) {
          const int ps = pos + d - 1;
          if (ps < 0 || ps >= L) continue;
          const u16* rowp = up + (size_t)(t + d - 1) * 5632;
          uint4 ug = *(const uint4*)(rowp + c8);
          uint4 uv = *(const uint4*)(rowp + 2816 + c8);
          const unsigned ugs[4] = {ug.x, ug.y, ug.z, ug.w}, uvs[4] = {uv.x, uv.y, uv.z, uv.w};
#pragma unroll
          for (int e = 0; e < 4; ++e) {
            gv[2 * e] += cw[d * 5632 + c8 + 2 * e] * blo(ugs[e]);
            gv[2 * e + 1] += cw[d * 5632 + c8 + 2 * e + 1] * bhi(ugs[e]);
            vv2[2 * e] += cw[d * 5632 + 2816 + c8 + 2 * e] * blo(uvs[e]);
            vv2[2 * e + 1] += cw[d * 5632 + 2816 + c8 + 2 * e + 1] * bhi(uvs[e]);
          }
        }
#pragma unroll
        for (int e = 0; e < 8; ++e) res[e] = siluf_(gv[e]) * vv2[e];
        *(uint4*)(act + (size_t)t * 2816 + c8) = make_uint4(pack2(res[0], res[1]), pack2(res[2], res[3]), pack2(res[4], res[5]), pack2(res[6], res[7]));
      }
    }
    GSYNC();
    if (PH(12)) {
      const u16* act = (const u16*)(p.ws + B_ACT);
      for (int j = bid; j < 192 * 8; j += nb) {
        const int mt = j >> 3, nt = j & 7;
        f32x4 acc[4][4];
        zero_acc<4>(acc);
        gemm_core<4>(acc, act + (size_t)mt * 128 * 2816, 2816, WL + W_DN + (size_t)nt * 128 * 2816, 2816, 2816, sm);
        const float* gf = mods + (size_t)(l * 9 + tok_v(mt * 128)) * 6144 + 5 * 1024;
        EPI_LOOP(4) {
          const size_t row = mt * 128 + EROW; const int col = nt * 128 + ECOL(4);
          p.out[row * 1024 + col] += gf[col] * acc[i][j][r];
        }
      }
    }
    GSYNC();
  }
  if (PH(13)) {
    const int tid = otid();
    const int lane = tid & 63, w = tid >> 6;
    const float* gfin = p.in[38];
    for (int tile = bid; tile < T_ / 4; tile += nb) {
      const int t = tile * 4 + w;
      float4* xr = (float4*)(p.out + (size_t)t * 1024);
      float4 v[4];
      float ss = 0.f;
#pragma unroll
      for (int j = 0; j < 4; ++j) { v[j] = xr[lane + 64 * j]; ss += v[j].x * v[j].x + v[j].y * v[j].y + v[j].z * v[j].z + v[j].w * v[j].w; }
      ss = wave_sum(ss);
      const float rstd = rsqrtf(ss * (1.f / 1024.f) + 1e-6f);
#pragma unroll
      for (int j = 0; j < 4; ++j) {
        float4 g = *(const float4*)(gfin + (lane + 64 * j) * 4);
        xr[lane + 64 * j] = make_float4(v[j].x * rstd * g.x, v[j].y * rstd * g.y, v[j].z * rstd * g.z, v[j].w * rstd * g.w);
      }
    }
  }
}

extern "C" void kernel_launch(void* const* d_in, const int* in_sizes, int n_in, void* d_out, int out_size,
                              void* d_ws, size_t ws_size, hipStream_t stream) {
  static int grid_blocks = 0;
  if (!grid_blocks) {
    int dev = 0, cus = 0, per_cu = 0;
    (void)hipGetDevice(&dev);
    (void)hipDeviceGetAttribute(&cus, hipDeviceAttributeMultiprocessorCount, dev);
    (void)hipOccupancyMaxActiveBlocksPerMultiprocessor(&per_cu, mega, 256, 0);
    if (per_cu > 2) per_cu = 2;
    if (per_cu < 1) per_cu = 1;
    grid_blocks = cus * per_cu;
  }
  if (ws_size < B_END || n_in < 39) {
    fprintf(stderr, "workspace too small: %zu < %zu\n", ws_size, (size_t)B_END);
    return;
  }
  Params p{};
  for (int i = 0; i < 39; ++i) p.in[i] = (const float*)d_in[i];
  p.out = (float*)d_out;
  p.ws = (char*)d_ws;
  void* args[] = {&p};
  hipError_t e = hipLaunchCooperativeKernel((void*)mega, dim3(grid_blocks), dim3(256), args, 0, stream);
  if (e != hipSuccess) fprintf(stderr, "cooperative launch failed: %s (grid %d)\n", hipGetErrorString(e), grid_blocks);
}
```

```cpp
#include <hip/hip_runtime.h>
#include <hip/hip_cooperative_groups.h>
#include <cstdio>
namespace cg = cooperative_groups;

#define DI __device__ __forceinline__
typedef __bf16 bf16;
using bf16x8 = __attribute__((ext_vector_type(8))) short;
using f32x4 = __attribute__((ext_vector_type(4))) float;
using f32x16 = __attribute__((ext_vector_type(16))) float;
typedef unsigned short u16;

constexpr int T_ = 24576, TP_ = 8192;
constexpr int NCH = 384;
constexpr long long O_SD = 25165824LL, O_S5RE = 41943040LL, O_S5IM = 42467328LL, O_CKV = 42991616LL, O_KR = 51380224LL;

constexpr size_t W_IN = 0;
constexpr size_t W_G = W_IN + 3328ull * 1024;
constexpr size_t W_QB = W_G + 3072ull * 1024;
constexpr size_t W_KVB = W_QB + 768ull * 384;
constexpr size_t W_GLU = W_KVB + 1024ull * 256;
constexpr size_t W_BR = W_GLU + 512ull * 512;
constexpr size_t W_OUT = W_BR + 1024ull * 1536;
constexpr size_t W_UP = W_OUT + 1024ull * 1024;
constexpr size_t W_DN = W_UP + 5632ull * 1024;
constexpr size_t W_LAYER = W_DN + 1024ull * 2816;

constexpr size_t al(size_t x) { return (x + 255) & ~(size_t)255; }
constexpr size_t B_W = 0;
constexpr size_t B_MODS = al(B_W + 4 * W_LAYER * 2);
constexpr size_t B_ROPE = al(B_MODS + 4ull * 9 * 6144 * 4);
constexpr size_t B_LAMB = al(B_ROPE + 2048ull * 32 * 4);
constexpr size_t B_LAM64 = al(B_LAMB + 4ull * 2 * 32 * 64 * 8);
constexpr size_t B_BBT = al(B_LAM64 + 4ull * 2 * 32 * 64 * 8);
constexpr size_t B_CMT = al(B_BBT + 4ull * 2 * 32 * 128 * 16 * 2);
constexpr size_t B_CKVC = al(B_CMT + 4ull * 32 * 16 * 128 * 2);
constexpr size_t B_H = al(B_CKVC + 4ull * 2048 * 256 * 2);
constexpr size_t B_QKV = al(B_H + (size_t)T_ * 1024 * 2);
constexpr size_t B_Z = al(B_QKV + (size_t)T_ * 1536 * 2);
constexpr size_t B_US5 = al(B_Z + (size_t)T_ * 512 * 2);
constexpr size_t B_QA = al(B_US5 + (size_t)T_ * 512 * 2);
constexpr size_t B_KVA = al(B_QA + (size_t)T_ * 384 * 2);
constexpr size_t B_MISC = al(B_KVA + (size_t)T_ * 256 * 2);
constexpr size_t B_QN = al(B_MISC + (size_t)T_ * 48 * 4);
constexpr size_t B_KN = al(B_QN + (size_t)T_ * 512 * 2);
constexpr size_t B_VV = al(B_KN + (size_t)T_ * 512 * 2);
constexpr size_t B_KT = al(B_VV + (size_t)T_ * 512 * 2);
constexpr size_t B_BG = al(B_KT + (size_t)T_ * 512 * 2);
constexpr size_t B_TM = al(B_BG + (size_t)T_ * 16 * 4);
constexpr size_t B_QKM = al(B_TM + (size_t)T_ * 512 * 2);
constexpr size_t B_GC = al(B_QKM + (size_t)T_ * 512 * 2);
constexpr size_t B_BC = al(B_GC + (size_t)NCH * 4 * 2 * 64 * 4);
constexpr size_t KB_P = 32ull * 8 * 256 * 96, KB_S = 8ull * 8 * 2304 * 96;
constexpr size_t VT_P = 32ull * 8 * 64 * 256, VT_S = 8ull * 8 * 64 * 2304;
constexpr size_t B_KB = al(B_BC + (size_t)NCH * 4 * 2 * 64 * 4);
constexpr size_t B_VT = al(B_KB + (KB_P + KB_S) * 2);
constexpr size_t B_QM = al(B_VT + (VT_P + VT_S) * 2);
constexpr size_t B_HEND = al(B_QM + (size_t)T_ * 768 * 2);
constexpr size_t B_HIN = al(B_HEND + (size_t)NCH * 32 * 2 * 64 * 8);
constexpr size_t B_Y5 = al(B_HIN + (size_t)NCH * 32 * 2 * 64 * 8);
constexpr size_t B_OC = al(B_Y5 + (size_t)T_ * 512 * 2);
constexpr size_t B_END = al(B_OC + (size_t)T_ * 512 * 2);
constexpr size_t B_OF = B_QKV;
constexpr size_t B_OB = B_QKV + (size_t)T_ * 512 * 2;
constexpr size_t B_MG = B_QKV;
constexpr size_t B_OA = B_QN;
constexpr size_t B_OB5 = B_KN;
constexpr size_t B_UP = B_QKV;
constexpr size_t B_ACT = B_KB;
static_assert(B_UP + (size_t)T_ * 5632 * 2 <= B_KB, "UP overlaps ACT");
static_assert(B_ACT + (size_t)T_ * 2816 * 2 <= B_END, "ACT too big");
constexpr size_t B_BAR = B_END;
constexpr size_t B_TOTAL = B_BAR + 256;
static_assert(B_TOTAL <= 768ull * 1024 * 1024, "workspace too big");

struct Params {
  const float* in[39];
  float* out;
  char* ws;
  unsigned* bar;
};

DI int otid() { int t = (int)__builtin_amdgcn_workitem_id_x(); asm volatile("" : "+v"(t)); return t; }
DI unsigned pack2(float a, float b) {
  typedef __attribute__((ext_vector_type(2))) __bf16 bf2;
  bf2 v; v[0] = (__bf16)a; v[1] = (__bf16)b;
  return __builtin_bit_cast(unsigned, v);
}
DI u16 f2bf(float a) { return (u16)(pack2(a, 0.f) & 0xffffu); }
DI float bf2f(u16 u) { return __uint_as_float(((unsigned)u) << 16); }
DI float blo(unsigned u) { return __uint_as_float(u << 16); }
DI float bhi(unsigned u) { return __uint_as_float(u & 0xffff0000u); }
DI float wave_sum(float v) {
#pragma unroll
  for (int o = 32; o > 0; o >>= 1) v += __shfl_xor(v, o);
  return v;
}
DI float sigmoidf_(float x) { return 1.f / (1.f + __expf(-x)); }
DI float siluf_(float x) { return x / (1.f + __expf(-x)); }
DI int tok_v(int t) { return t < TP_ ? 0 : 1 + ((t - TP_) >> 11); }
DI int crow(int r, int h2) { return (r & 3) + 8 * (r >> 2) + 4 * h2; }
DI bf16x8 mk8(unsigned a, unsigned b, unsigned c, unsigned d) {
  uint4 p = make_uint4(a, b, c, d);
  return __builtin_bit_cast(bf16x8, p);
}
DI bf16x8 pack_acc(const f32x16& x, int s) {
  return mk8(pack2(x[8 * s], x[8 * s + 1]), pack2(x[8 * s + 2], x[8 * s + 3]), pack2(x[8 * s + 4], x[8 * s + 5]),
             pack2(x[8 * s + 6], x[8 * s + 7]));
}
DI bf16x8 load_perm(const u16* rowptr, int s, int h2) {
  uint2 a = *(const uint2*)(rowptr + 16 * s + 4 * h2);
  uint2 b = *(const uint2*)(rowptr + 16 * s + 8 + 4 * h2);
  return mk8(a.x, a.y, b.x, b.y);
}
DI unsigned swap16(unsigned u) { return (u >> 16) | (u << 16); }
DI bf16x8 load_perm_rev(const u16* rowptr, int base, int s, int h2) {
  uint2 a = *(const uint2*)(rowptr + 60 - base - 16 * s - 4 * h2);
  uint2 b = *(const uint2*)(rowptr + 52 - base - 16 * s - 4 * h2);
  return mk8(swap16(a.y), swap16(a.x), swap16(b.y), swap16(b.x));
}
#define MFMA16(a, b, c) __builtin_amdgcn_mfma_f32_16x16x32_bf16((a), (b), (c), 0, 0, 0)
#define MFMA32(a, b, c) __builtin_amdgcn_mfma_f32_32x32x16_bf16((a), (b), (c), 0, 0, 0)

template <int NJ>
DI void gemm_core(f32x4 (&acc)[4][NJ], const u16* __restrict__ A, int lda, const u16* __restrict__ B, int ldb, int K,
                  u16* sm) {
  const int tid = otid(), lane = tid & 63, w = tid >> 6, wr = w >> 1, wc = w & 1;
  const int fr = lane & 15, fq = lane >> 4;
  constexpr int BN = NJ * 32;
  constexpr int STG = (128 + BN) * 72;
  const int lrow = tid >> 3, lkc = tid & 7;
  uint4 ra[4], rb[NJ];
  const u16* ap = A + (size_t)lrow * lda + lkc * 8;
  const u16* bp = B + (size_t)lrow * ldb + lkc * 8;
  const int nk = K >> 6;
  __syncthreads();
#pragma unroll
  for (int j = 0; j < 4; ++j) ra[j] = *(const uint4*)(ap + (size_t)(32 * j) * lda);
#pragma unroll
  for (int j = 0; j < NJ; ++j) rb[j] = *(const uint4*)(bp + (size_t)(32 * j) * ldb);
  {
    u16* as = sm; u16* bs = as + 128 * 72;
#pragma unroll
    for (int j = 0; j < 4; ++j) *(uint4*)(as + (lrow + 32 * j) * 72 + lkc * 8) = ra[j];
#pragma unroll
    for (int j = 0; j < NJ; ++j) *(uint4*)(bs + (lrow + 32 * j) * 72 + lkc * 8) = rb[j];
  }
  __syncthreads();
  for (int kt = 0; kt < nk; ++kt) {
    const bool more = (kt + 1 < nk);
    if (more) {
      const int k0 = (kt + 1) * 64;
#pragma unroll
      for (int j = 0; j < 4; ++j) ra[j] = *(const uint4*)(ap + (size_t)(32 * j) * lda + k0);
#pragma unroll
      for (int j = 0; j < NJ; ++j) rb[j] = *(const uint4*)(bp + (size_t)(32 * j) * ldb + k0);
    }
    const u16* as = sm + (kt & 1) * STG;
    const u16* bs = as + 128 * 72;
#pragma unroll
    for (int ks = 0; ks < 2; ++ks) {
      bf16x8 af[4], bfr[NJ];
#pragma unroll
      for (int i = 0; i < 4; ++i) af[i] = *(const bf16x8*)(as + (wr * 64 + i * 16 + fr) * 72 + ks * 32 + fq * 8);
#pragma unroll
      for (int j = 0; j < NJ; ++j) bfr[j] = *(const bf16x8*)(bs + (wc * NJ * 16 + j * 16 + fr) * 72 + ks * 32 + fq * 8);
#pragma unroll
      for (int i = 0; i < 4; ++i)
#pragma unroll
        for (int j = 0; j < NJ; ++j) acc[i][j] = MFMA16(af[i], bfr[j], acc[i][j]);
    }
    if (more) {
      u16* as2 = sm + ((kt + 1) & 1) * STG; u16* bs2 = as2 + 128 * 72;
#pragma unroll
      for (int j = 0; j < 4; ++j) *(uint4*)(as2 + (lrow + 32 * j) * 72 + lkc * 8) = ra[j];
#pragma unroll
      for (int j = 0; j < NJ; ++j) *(uint4*)(bs2 + (lrow + 32 * j) * 72 + lkc * 8) = rb[j];
    }
    __syncthreads();
  }
}
template <int NJ>
DI void zero_acc(f32x4 (&acc)[4][NJ]) {
#pragma unroll
  for (int i = 0; i < 4; ++i)
#pragma unroll
    for (int j = 0; j < NJ; ++j) acc[i][j] = f32x4{0.f, 0.f, 0.f, 0.f};
}
#define EPI_LOOP(NJ_)                                                              \
  const int e_lane = otid() & 63, e_w = otid() >> 6;                     \
  const int e_wr = e_w >> 1, e_wc = e_w & 1, e_fr = e_lane & 15, e_fq = e_lane >> 4; \
  _Pragma("unroll") for (int i = 0; i < 4; ++i)                                    \
  _Pragma("unroll") for (int j = 0; j < NJ_; ++j)                                  \
  _Pragma("unroll") for (int r = 0; r < 4; ++r)
#define EROW (e_wr * 64 + i * 16 + e_fq * 4 + r)
#define ECOL(NJ_) (e_wc * NJ_ * 16 + j * 16 + e_fr)

DI int colmap(int kind, int n) {
  if (kind == 0) {
    if (n < 2048) return n;
    if (n < 2560) return 2064 + (n - 2048);
    if (n < 2944) return 2576 + (n - 2560);
    if (n < 3200) return 2960 + (n - 2944);
    int j = n - 3200;
    if (j < 16) return 2048 + j;
    if (j < 48) return 3216 + (j - 16);
    return -1;
  }
  if (kind == 1) return 3248 + n;
  return n;
}
DI void convT_tile(const float* __restrict__ src, int lds, int K, u16* __restrict__ dst, int kind, int kt, int nt,
                   float* sm) {
  const int tid = otid();
  const int c = tid & 63;
  const int sc = colmap(kind, nt * 64 + c);
  __syncthreads();
#pragma unroll 4
  for (int i = 0; i < 16; ++i) {
    int r = (tid >> 6) + i * 4;
    float v = sc >= 0 ? src[(size_t)(kt * 64 + r) * lds + sc] : 0.f;
    sm[r * 65 + c] = v;
  }
  __syncthreads();
  const int n = tid >> 2, kq = tid & 3;
  unsigned pk[8];
#pragma unroll
  for (int j = 0; j < 8; ++j) pk[j] = pack2(sm[(kq * 16 + 2 * j) * 65 + n], sm[(kq * 16 + 2 * j + 1) * 65 + n]);
  u16* d = dst + (size_t)(nt * 64 + n) * K + kt * 64 + kq * 16;
  *(uint4*)d = make_uint4(pk[0], pk[1], pk[2], pk[3]);
  *(uint4*)(d + 8) = make_uint4(pk[4], pk[5], pk[6], pk[7]);
}
constexpr int CJ0 = 16 * 52, CJ1 = CJ0 + 16 * 48, CJ2 = CJ1 + 6 * 12, CJ3 = CJ2 + 4 * 16, CJ4 = CJ3 + 8 * 8,
              CJ5 = CJ4 + 24 * 16, CJ6 = CJ5 + 16 * 16, CJ7 = CJ6 + 16 * 88, CJ8 = CJ7 + 44 * 16;
DI void conv_job(const Params& p, int l, int j, float* sm) {
  u16* wl = (u16*)(p.ws + B_W) + (size_t)l * W_LAYER;
  if (j < CJ0) { convT_tile(p.in[13] + (size_t)l * 1024 * 6320, 6320, 1024, wl + W_IN, 0, j / 52, j % 52, sm); return; }
  if (j < CJ1) { j -= CJ0; convT_tile(p.in[13] + (size_t)l * 1024 * 6320, 6320, 1024, wl + W_G, 1, j / 48, j % 48, sm); return; }
  if (j < CJ2) { j -= CJ1; convT_tile(p.in[29] + (size_t)l * 384 * 768, 768, 384, wl + W_QB, 2, j / 12, j % 12, sm); return; }
  if (j < CJ3) { j -= CJ2; convT_tile(p.in[31] + (size_t)l * 256 * 1024, 1024, 256, wl + W_KVB, 2, j / 16, j % 16, sm); return; }
  if (j < CJ4) { j -= CJ3; convT_tile(p.in[26] + (size_t)l * 512 * 512, 512, 512, wl + W_GLU, 2, j / 8, j % 8, sm); return; }
  if (j < CJ5) { j -= CJ4; convT_tile(p.in[32] + (size_t)l * 1536 * 1024, 1024, 1536, wl + W_BR, 2, j / 16, j % 16, sm); return; }
  if (j < CJ6) { j -= CJ5; convT_tile(p.in[33] + (size_t)l * 1024 * 1024, 1024, 1024, wl + W_OUT, 2, j / 16, j % 16, sm); return; }
  if (j < CJ7) { j -= CJ6; convT_tile(p.in[34] + (size_t)l * 1024 * 5632, 5632, 1024, wl + W_UP, 2, j / 88, j % 88, sm); return; }
  j -= CJ7; convT_tile(p.in[37] + (size_t)l * 2816 * 1024, 1024, 2816, wl + W_DN, 2, j / 16, j % 16, sm);
}
DI void mods_tile(const Params& p, int l, int jg, float* sm) {
  const int tid = otid();
  __syncthreads();
  for (int i = tid; i < 9 * 1024; i += 256) {
    int v = i >> 10, k = i & 1023;
    float cv = v == 0 ? p.in[8][k] : p.in[7][(v - 1) * 1024 + k];
    sm[i] = cv / (1.f + __expf(-cv));
  }
  __syncthreads();
  const int col = jg * 64 + (tid & 63), kq = tid >> 6;
  float acc[9];
#pragma unroll
  for (int v = 0; v < 9; ++v) acc[v] = 0.f;
  const float* wp = p.in[9] + (size_t)l * 1024 * 6144 + col;
#pragma unroll 4
  for (int k = kq * 256; k < kq * 256 + 256; ++k) {
    float wv = wp[(size_t)k * 6144];
#pragma unroll
    for (int v = 0; v < 9; ++v) acc[v] += sm[v * 1024 + k] * wv;
  }
  float* red = sm + 9 * 1024;
#pragma unroll
  for (int v = 0; v < 9; ++v) red[(kq * 9 + v) * 64 + (tid & 63)] = acc[v];
  __syncthreads();
  if (kq == 0) {
    float* mods = (float*)(p.ws + B_MODS);
    float b = p.in[10][l * 6144 + col];
#pragma unroll
    for (int v = 0; v < 9; ++v) {
      float s = red[(0 * 9 + v) * 64 + tid] + red[(1 * 9 + v) * 64 + tid] + red[(2 * 9 + v) * 64 + tid] + red[(3 * 9 + v) * 64 + tid];
      mods[(size_t)(l * 9 + v) * 6144 + col] = s + b;
    }
  }
}
DI void s5pre_tile(const Params& p, int tile) {
  const int id = tile * 256 + otid();
  const int pp = id & 63, g = (id >> 6) & 31, dir = (id >> 11) & 1, l = id >> 12;
  const float lre = p.in[18][((l * 2 + dir) * 32 + g) * 64 + pp];
  const float lim = p.in[19][((l * 2 + dir) * 32 + g) * 64 + pp];
  const float dt = expf(p.in[20][(l * 2 + dir) * 32 + g]);
  float er = expf(lre * dt), sn, cs;
  sincosf(lim * dt, &sn, &cs);
  const float lbr = er * cs, lbi = er * sn;
  float e64 = expf(64.f * lre * dt), s64, c64;
  sincosf(64.f * lim * dt, &s64, &c64);
  float2* lamb = (float2*)(p.ws + B_LAMB);
  float2* lam64 = (float2*)(p.ws + B_LAM64);
  const int li = ((l * 2 + dir) * 32 + g) * 64 + pp;
  lamb[li] = make_float2(lbr, lbi);
  lam64[li] = make_float2(e64 * c64, e64 * s64);
  const float nr = lbr - 1.f, ni = lbi, den = lre * lre + lim * lim;
  const float cr = (nr * lre + ni * lim) / den, ci = (ni * lre - nr * lim) / den;
  u16* bbt = (u16*)(p.ws + B_BBT) + (size_t)((l * 2 + dir) * 32 + g) * 128 * 16;
  const float* bre = p.in[21] + (size_t)((l * 32 + g) * 64 + pp) * 16;
  const float* bim = p.in[22] + (size_t)((l * 32 + g) * 64 + pp) * 16;
#pragma unroll
  for (int c = 0; c < 16; ++c) {
    float br = bre[c], bi = bim[c];
    bbt[pp * 16 + c] = f2bf(cr * br - ci * bi);
    bbt[(64 + pp) * 16 + c] = f2bf(cr * bi + ci * br);
  }
  if (dir == 0) {
    u16* cmt = (u16*)(p.ws + B_CMT) + (size_t)(l * 32 + g) * 16 * 128;
    const float* cre = p.in[23] + (size_t)(l * 32 + g) * 16 * 64;
    const float* cim = p.in[24] + (size_t)(l * 32 + g) * 16 * 64;
#pragma unroll
    for (int c = 0; c < 16; ++c) {
      cmt[c * 128 + pp] = f2bf(cre[c * 64 + pp]);
      cmt[c * 128 + 64 + pp] = f2bf(-cim[c * 64 + pp]);
    }
  }
}

DI void norm_phase(const Params& p, int l, int shift_idx, int scale_idx, const float* gn) {
  const float* x = p.out;
  u16* H = (u16*)(p.ws + B_H);
  const float* mods = (const float*)(p.ws + B_MODS);
  const int lane = otid() & 63, w = otid() >> 6;
  for (int tile = blockIdx.x; tile < T_ / 4; tile += gridDim.x) {
    const int t = tile * 4 + w;
    const float4* xr = (const float4*)(x + (size_t)t * 1024);
    float4 v[4];
    float ss = 0.f;
#pragma unroll
    for (int j = 0; j < 4; ++j) {
      v[j] = xr[lane + 64 * j];
      ss += v[j].x * v[j].x + v[j].y * v[j].y + v[j].z * v[j].z + v[j].w * v[j].w;
    }
    ss = wave_sum(ss);
    const float rstd = rsqrtf(ss * (1.f / 1024.f) + 1e-6f);
    const float* mb = mods + (size_t)(l * 9 + tok_v(t)) * 6144;
#pragma unroll
    for (int j = 0; j < 4; ++j) {
      const int c = (lane + 64 * j) * 4;
      float4 g = *(const float4*)(gn + c);
      float4 sc = *(const float4*)(mb + scale_idx * 1024 + c);
      float4 sh = *(const float4*)(mb + shift_idx * 1024 + c);
      float y0 = v[j].x * rstd * g.x * (1.f + sc.x) + sh.x;
      float y1 = v[j].y * rstd * g.y * (1.f + sc.y) + sh.y;
      float y2 = v[j].z * rstd * g.z * (1.f + sc.z) + sh.z;
      float y3 = v[j].w * rstd * g.w * (1.f + sc.w) + sh.w;
      *(uint2*)(H + (size_t)t * 1024 + c) = make_uint2(pack2(y0, y1), pack2(y2, y3));
    }
  }
}

DI void gemm_in_phase(const Params& p, int l, u16* sm) {
  const u16* H = (const u16*)(p.ws + B_H);
  const u16* Wt = (const u16*)(p.ws + B_W) + (size_t)l * W_LAYER + W_IN;
  for (int tile = blockIdx.x; tile < 192 * 26; tile += gridDim.x) {
    const int mt = tile / 26, nt = tile % 26;
    f32x4 acc[4][4];
    zero_acc<4>(acc);
    gemm_core<4>(acc, H + (size_t)mt * 128 * 1024, 1024, Wt + (size_t)nt * 128 * 1024, 1024, 1024, sm);
    if (nt < 25) {
      u16* dst; int ld, c0;
      if (nt < 12) { dst = (u16*)(p.ws + B_QKV); ld = 1536; c0 = nt * 128; }
      else if (nt < 16) { dst = (u16*)(p.ws + B_Z); ld = 512; c0 = (nt - 12) * 128; }
      else if (nt < 20) { dst = (u16*)(p.ws + B_US5); ld = 512; c0 = (nt - 16) * 128; }
      else if (nt < 23) { dst = (u16*)(p.ws + B_QA); ld = 384; c0 = (nt - 20) * 128; }
      else { dst = (u16*)(p.ws + B_KVA); ld = 256; c0 = (nt - 23) * 128; }
      EPI_LOOP(4) { dst[(size_t)(mt * 128 + EROW) * ld + c0 + ECOL(4)] = f2bf(acc[i][j][r]); }
    } else {
      float* misc = (float*)(p.ws + B_MISC);
      EPI_LOOP(4) {
        int c = ECOL(4);
        if (c < 48) misc[(size_t)(mt * 128 + EROW) * 48 + c] = acc[i][j][r];
      }
    }
  }
}

DI void delta_prep_tile(const Params& p, int l, int chunk, u16* sm) {
  const int tid = otid(), lane = tid & 63, w = tid >> 6;
  const int tb = chunk * 64;
  int pos0, L;
  if (tb < TP_) { pos0 = tb & 255; L = 256; } else { pos0 = (tb - TP_) & 2047; L = 2048; }
  const u16* qkv = (const u16*)(p.ws + B_QKV);
  const float* cw = p.in[14] + (size_t)l * 5 * 1536;
  u16* ksm = sm + w * (64 * 130);
  __syncthreads();
  for (int gi = w; gi < 12; gi += 4) {
    const int ch = gi * 128 + 2 * lane;
    float w0[5], w1[5];
#pragma unroll
    for (int i = 0; i < 5; ++i) { w0[i] = cw[i * 1536 + ch]; w1[i] = cw[i * 1536 + ch + 1]; }
    float a0[5], a1[5];
#pragma unroll
    for (int i = 0; i < 4; ++i) {
      int ps = pos0 - 2 + i;
      unsigned u = (ps >= 0 && ps < L) ? *(const unsigned*)(qkv + (size_t)(tb - 2 + i) * 1536 + ch) : 0u;
      a0[i + 1] = blo(u); a1[i + 1] = bhi(u);
    }
    u16* dst = (u16*)(p.ws + (gi < 4 ? B_QN : (gi < 8 ? B_KN : B_VV)));
    const int hh = gi & 3;
    for (int tt = 0; tt < 64; ++tt) {
#pragma unroll
      for (int i = 0; i < 4; ++i) { a0[i] = a0[i + 1]; a1[i] = a1[i + 1]; }
      {
        int ps = pos0 + tt + 2;
        unsigned u = (ps < L) ? *(const unsigned*)(qkv + (size_t)(tb + tt + 2) * 1536 + ch) : 0u;
        a0[4] = blo(u); a1[4] = bhi(u);
      }
      float y0 = 0.f, y1 = 0.f;
#pragma unroll
      for (int i = 0; i < 5; ++i) { y0 += w0[i] * a0[i]; y1 += w1[i] * a1[i]; }
      y0 = siluf_(y0); y1 = siluf_(y1);
      if (gi < 8) {
        float ss = wave_sum(y0 * y0 + y1 * y1);
        float sc = rsqrtf(ss + 1e-6f);
        if (gi < 4) sc *= 0.08838834764831845f;
        y0 *= sc; y1 *= sc;
      }
      const unsigned pk = pack2(y0, y1);
      *(unsigned*)(dst + (size_t)(tb + tt) * 512 + hh * 128 + 2 * lane) = pk;
      if (gi >= 4 && gi < 8) *(unsigned*)(ksm + tt * 130 + 2 * lane) = pk;
    }
    if (gi >= 4 && gi < 8) {
      u16* kt = (u16*)(p.ws + B_KT) + (size_t)(chunk * 4 + hh) * 128 * 64;
#pragma unroll
      for (int rr = 0; rr < 2; ++rr) {
        const int dk = lane + 64 * rr;
        unsigned pk[32];
#pragma unroll
        for (int t2 = 0; t2 < 32; ++t2) pk[t2] = (unsigned)ksm[(2 * t2) * 130 + dk] | ((unsigned)ksm[(2 * t2 + 1) * 130 + dk] << 16);
#pragma unroll
        for (int q = 0; q < 8; ++q) *(uint4*)(kt + dk * 64 + q * 8) = make_uint4(pk[4 * q], pk[4 * q + 1], pk[4 * q + 2], pk[4 * q + 3]);
      }
    }
  }
  const float* misc = (const float*)(p.ws + B_MISC);
  float* bg = (float*)(p.ws + B_BG);
  for (int i = tid; i < 512; i += 256) {
    const int tt = i >> 3, dh = i & 7;
    const size_t t = tb + tt;
    float bl = misc[t * 48 + dh], alp = misc[t * 48 + 8 + dh];
    float x = alp + p.in[16][l * 8 + dh];
    float sp = x > 20.f ? x : log1pf(__expf(x));
    bg[t * 16 + dh] = sigmoidf_(bl);
    bg[t * 16 + 8 + dh] = -__expf(p.in[15][l * 8 + dh]) * sp;
  }
}

DI size_t kb_off(int t, int head) {
  if (t < TP_) return ((size_t)((t >> 8) * 8 + head) * 256 + (t & 255)) * 96;
  const int s = (t - TP_) >> 11, pos = (t - TP_) & 2047;
  return KB_P + ((size_t)(s * 8 + head) * 2304 + 256 + pos) * 96;
}
DI void mla_prep_tile(const Params& p, int l, int tile) {
  const int lane = otid() & 63, w = otid() >> 6;
  const int t = tile * 4 + w;
  u16* qa = (u16*)(p.ws + B_QA) + (size_t)t * 384;
  u16* kva = (u16*)(p.ws + B_KVA) + (size_t)t * 256;
  const float* misc = (const float*)(p.ws + B_MISC) + (size_t)t * 48;
  {
    unsigned u[3]; float ss = 0.f;
#pragma unroll
    for (int j = 0; j < 3; ++j) { u[j] = *(const unsigned*)(qa + 2 * lane + 128 * j); float a = blo(u[j]), b = bhi(u[j]); ss += a * a + b * b; }
    ss = wave_sum(ss);
    const float rstd = rsqrtf(ss * (1.f / 384.f) + 1e-6f);
    const float* g = p.in[28] + l * 384;
#pragma unroll
    for (int j = 0; j < 3; ++j) {
      int c = 2 * lane + 128 * j;
      *(unsigned*)(qa + c) = pack2(blo(u[j]) * rstd * g[c], bhi(u[j]) * rstd * g[c + 1]);
    }
  }
  {
    unsigned u[2]; float ss = 0.f;
#pragma unroll
    for (int j = 0; j < 2; ++j) { u[j] = *(const unsigned*)(kva + 2 * lane + 128 * j); float a = blo(u[j]), b = bhi(u[j]); ss += a * a + b * b; }
    ss = wave_sum(ss);
    const float rstd = rsqrtf(ss * (1.f / 256.f) + 1e-6f);
    const float* g = p.in[30] + l * 256;
#pragma unroll
    for (int j = 0; j < 2; ++j) {
      int c = 2 * lane + 128 * j;
      float a = blo(u[j]) * rstd * g[c], b = bhi(u[j]) * rstd * g[c + 1];
      *(unsigned*)(kva + c) = pack2(a, b);
      if (t < TP_) {
        float* o = p.out + O_CKV + ((size_t)((t >> 8) * 4 + l) * 256 + (t & 255)) * 256 + c;
        *(float2*)o = make_float2(a, b);
      }
    }
  }
  {
    const int i = lane & 31;
    float kr = misc[16 + i];
    float val;
    if (t < TP_) {
      val = kr;
      if (lane < 32) p.out[O_KR + ((size_t)((t >> 8) * 4 + l) * 256 + (t & 255)) * 32 + i] = kr;
    } else {
      const int pos = (t - TP_) & 2047;
      const float* rp = (const float*)(p.ws + B_ROPE) + (size_t)pos * 32 + (i & 15) * 2;
      const float cs = rp[0], sn = rp[1];
      float other = __shfl_xor(kr, 16);
      val = (i < 16) ? (kr * cs - other * sn) : (kr * cs + other * sn);
    }
    u16* kb = (u16*)(p.ws + B_KB);
    const u16 bv = f2bf(val);
#pragma unroll
    for (int hh = 0; hh < 4; ++hh) {
      int head = hh * 2 + (lane >> 5);
      kb[kb_off(t, head) + 64 + i] = bv;
    }
  }
}
DI void cache_rope_tile(const Params& p, int l, int tile) {
  const int pr = tile * 8 + (otid() >> 5), i = otid() & 31;
  const int s = pr >> 8, pos = pr & 255;
  const float v = p.in[6][((size_t)(s * 4 + l) * 256 + pos) * 32 + i];
  u16* kb = (u16*)(p.ws + B_KB);
  const u16 bv = f2bf(v);
#pragma unroll
  for (int head = 0; head < 8; ++head) kb[KB_P + ((size_t)(s * 8 + head) * 2304 + pos) * 96 + 64 + i] = bv;
}

DI float gelu_tanh(float x) {
  const float k0 = 0.7978845608028654f, k1 = 0.044715f;
  float u = k0 * (x + k1 * x * x * x);
  float e = __expf(2.f * u);
  float th = 1.f - 2.f / (e + 1.f);
  return 0.5f * x * (1.f + th);
}
DI void s5_chunk_tile(const Params& p, int l, int chunk, int gp, int mode, u16* sm) {
  const int tid = otid(), lane = tid & 63, w = tid >> 6;
  const u16* us5 = (const u16*)(p.ws + B_US5);
  constexpr int RS = 136;
  __syncthreads();
  {
    const int gi = w >> 1, half = w & 1, g = gp * 2 + gi;
    const int n = lane & 31, h2 = lane >> 5;
    bf16x8 af[2];
#pragma unroll
    for (int mi = 0; mi < 2; ++mi) af[mi] = *(const bf16x8*)(us5 + (size_t)(chunk * 64 + mi * 32 + n) * 512 + g * 16 + 8 * h2);
#pragma unroll
    for (int dir = 0; dir < 2; ++dir) {
      const u16* bbt = (const u16*)(p.ws + B_BBT) + (size_t)((l * 2 + dir) * 32 + g) * 128 * 16;
#pragma unroll
      for (int nn = 0; nn < 2; ++nn) {
        const int nt = half * 2 + nn;
        bf16x8 bfr = *(const bf16x8*)(bbt + (nt * 32 + n) * 16 + 8 * h2);
#pragma unroll
        for (int mi = 0; mi < 2; ++mi) {
          f32x16 acc;
#pragma unroll
          for (int r = 0; r < 16; ++r) acc[r] = 0.f;
          acc = MFMA32(af[mi], bfr, acc);
          u16* d = sm + (size_t)((gi * 2 + dir) * 64 + mi * 32) * RS + nt * 32 + n;
#pragma unroll
          for (int r = 0; r < 16; ++r) d[crow(r, h2) * RS] = f2bf(acc[r]);
        }
      }
    }
  }
  __syncthreads();
  {
    const int gi = tid >> 7, dir = (tid >> 6) & 1, pp = tid & 63, g = gp * 2 + gi;
    const float2 lb = ((const float2*)(p.ws + B_LAMB))[((l * 2 + dir) * 32 + g) * 64 + pp];
    const size_t hidx = ((size_t)(chunk * 32 + g) * 2 + dir) * 64 + pp;
    float hr = 0.f, hi = 0.f;
    if (mode) { float2 h0 = ((const float2*)(p.ws + B_HIN))[hidx]; hr = h0.x; hi = h0.y; }
    u16* base = sm + (size_t)((gi * 2 + dir) * 64) * RS;
#pragma unroll 8
    for (int st = 0; st < 64; ++st) {
      const int tk = dir ? 63 - st : st;
      float br = bf2f(base[tk * RS + pp]), bi = bf2f(base[tk * RS + 64 + pp]);
      float nr = lb.x * hr - lb.y * hi + br;
      float ni = lb.x * hi + lb.y * hr + bi;
      hr = nr; hi = ni;
      if (mode) { base[tk * RS + pp] = f2bf(hr); base[tk * RS + 64 + pp] = f2bf(hi); }
    }
    if (!mode) ((float2*)(p.ws + B_HEND))[hidx] = make_float2(hr, hi);
  }
  if (!mode) return;
  __syncthreads();
  {
    const int gi = w >> 1, g = gp * 2 + gi;
    const int fr = lane & 15, fq = lane >> 4;
    const u16* cmt = (const u16*)(p.ws + B_CMT) + (size_t)(l * 32 + g) * 16 * 128;
    f32x4 acc[2];
    acc[0] = f32x4{0.f, 0.f, 0.f, 0.f}; acc[1] = acc[0];
#pragma unroll
    for (int ks = 0; ks < 8; ++ks) {
      const int dir = ks >> 2, kk = (ks & 3) * 32;
      bf16x8 bfr = *(const bf16x8*)(cmt + fr * 128 + kk + fq * 8);
#pragma unroll
      for (int mm = 0; mm < 2; ++mm) {
        const int mi = (w & 1) * 2 + mm;
        bf16x8 af = *(const bf16x8*)(sm + (size_t)((gi * 2 + dir) * 64 + mi * 16 + fr) * RS + kk + fq * 8);
        acc[mm] = MFMA16(af, bfr, acc[mm]);
      }
    }
    const float dsk = p.in[25][l * 512 + g * 16 + fr];
    u16* y5 = (u16*)(p.ws + B_Y5);
#pragma unroll
    for (int mm = 0; mm < 2; ++mm)
#pragma unroll
      for (int r = 0; r < 4; ++r) {
        const size_t t = (size_t)chunk * 64 + ((w & 1) * 2 + mm) * 16 + fq * 4 + r;
        float u = bf2f(us5[t * 512 + g * 16 + fr]);
        float y = acc[mm][r] + dsk * u;
        y5[t * 512 + g * 16 + fr] = f2bf(gelu_tanh(y));
      }
  }
}
DI void s5_carry_tile(const Params& p, int l, int tile) {
  const int seq = tile >> 4, gp = tile & 15;
  const int tid = otid(), gi = tid >> 7, dir = (tid >> 6) & 1, pp = tid & 63, g = gp * 2 + gi;
  int c0, nc;
  if (seq < 32) { c0 = seq * 4; nc = 4; } else { c0 = 128 + (seq - 32) * 32; nc = 32; }
  const float2 l64 = ((const float2*)(p.ws + B_LAM64))[((l * 2 + dir) * 32 + g) * 64 + pp];
  float hr = 0.f, hi = 0.f;
  if (seq >= 32) {
    const size_t si = ((size_t)((seq - 32) * 4 + l) * 2 + dir) * 2048 + g * 64 + pp;
    hr = p.in[3][si]; hi = p.in[4][si];
  }
  const float2* hend = (const float2*)(p.ws + B_HEND);
  float2* hin = (float2*)(p.ws + B_HIN);
  for (int it = 0; it < nc; ++it) {
    const int ck = c0 + (dir ? nc - 1 - it : it);
    const size_t idx = ((size_t)(ck * 32 + g) * 2 + dir) * 64 + pp;
    hin[idx] = make_float2(hr, hi);
    float2 he = hend[idx];
    float nr = l64.x * hr - l64.y * hi + he.x;
    float ni = l64.x * hi + l64.y * hr + he.y;
    hr = nr; hi = ni;
  }
  if (seq < 32) {
    const size_t so = ((size_t)(seq * 4 + l) * 2 + dir) * 2048 + g * 64 + pp;
    p.out[O_S5RE + so] = hr;
    p.out[O_S5IM + so] = hi;
  }
}

DI void delta_local_tile(const Params& p, int tile, float* smf) {
  const int chunk = tile >> 1, dir = tile & 1;
  const int tid = otid(), lane = tid & 63, h = tid >> 6;
  const int m = lane & 31, h2 = lane >> 5;
  const int tb = chunk * 64;
  const float* bg = (const float*)(p.ws + B_BG);
  const u16* kn = (const u16*)(p.ws + B_KN);
  const u16* qn = (const u16*)(p.ws + B_QN);
  float* Aw = smf + h * 4096;
  const size_t cidx = ((size_t)(chunk * 4 + h) * 2 + dir);
  const int tl = tb + (dir ? 63 - lane : lane);
  float gcs = bg[(size_t)tl * 16 + 8 + dir * 4 + h];
  const float beta = bg[(size_t)tl * 16 + dir * 4 + h];
#pragma unroll
  for (int o = 1; o < 64; o <<= 1) {
    float v = __shfl_up(gcs, o);
    if (lane >= o) gcs += v;
  }
  ((float*)(p.ws + B_GC))[cidx * 64 + lane] = gcs;
  ((float*)(p.ws + B_BC))[cidx * 64 + lane] = beta;
  __syncthreads();
  u16* qkm = (u16*)(p.ws + B_QKM) + cidx * 4096;
#pragma unroll 1
  for (int tt = 0; tt < 3; ++tt) {
    const int mi = tt == 0 ? 0 : 1, ni = tt == 2 ? 1 : 0;
    const int cm = 32 * mi + m, cn = 32 * ni + m;
    const u16* krm = kn + (size_t)(tb + (dir ? 63 - cm : cm)) * 512 + h * 128 + h2 * 8;
    const u16* qrm = qn + (size_t)(tb + (dir ? 63 - cm : cm)) * 512 + h * 128 + h2 * 8;
    const u16* krn = kn + (size_t)(tb + (dir ? 63 - cn : cn)) * 512 + h * 128 + h2 * 8;
    f32x16 ak, aq;
#pragma unroll
    for (int r = 0; r < 16; ++r) { ak[r] = 0.f; aq[r] = 0.f; }
#pragma unroll
    for (int ks = 0; ks < 8; ++ks) {
      const bf16x8 fkm = *(const bf16x8*)(krm + ks * 16), fqm = *(const bf16x8*)(qrm + ks * 16), fkn = *(const bf16x8*)(krn + ks * 16);
      ak = MFMA32(fkm, fkn, ak);
      aq = MFMA32(fqm, fkn, aq);
    }
    const int e = 32 * ni + m;
    const float gce = __shfl(gcs, e);
#pragma unroll
    for (int r = 0; r < 16; ++r) {
      const int c = 32 * mi + crow(r, h2);
      const float gcc = __shfl(gcs, c), bc = __shfl(beta, c);
      const float dec = (e <= c) ? __expf(gcc - gce) : 0.f;
      Aw[c * 64 + e] = (e < c) ? ak[r] * bc * dec : 0.f;
      qkm[c * 64 + e] = f2bf(aq[r] * dec);
    }
  }
  __syncthreads();
  u16* tm = (u16*)(p.ws + B_TM) + cidx * 4096;
  float x[64];
#pragma unroll
  for (int i = 0; i < 64; ++i) {
    float a = (i == lane) ? 1.f : 0.f;
#pragma unroll
    for (int j = 0; j < i; ++j) a -= Aw[i * 64 + j] * x[j];
    x[i] = a;
    tm[i * 64 + lane] = f2bf(a);
  }
}

template <int dir>
DI void delta_scan_body(const Params& p, int l, int seq, int h, u16* sm);
DI void delta_scan_tile(const Params& p, int l, int idx, u16* sm) {
  int seq, h, dir;
  if (idx < 64) { seq = 32 + (idx >> 3); h = (idx >> 1) & 3; dir = idx & 1; }
  else { const int i2 = idx - 64; seq = i2 >> 3; h = (i2 >> 1) & 3; dir = i2 & 1; }
  if (dir) delta_scan_body<1>(p, l, seq, h, sm); else delta_scan_body<0>(p, l, seq, h, sm);
}
template <int dir>
DI void delta_scan_body(const Params& p, int l, int seq, int h, u16* sm) {
  int chunk0, nch;
  if (seq < 32) { chunk0 = seq * 4; nch = 4; } else { chunk0 = 128 + (seq - 32) * 32; nch = 32; }
  const int lane = otid() & 63, w = otid() >> 6;
  const int n = lane & 31, h2 = lane >> 5;
  const int dvc = w * 32 + n;
  const u16* kn = (const u16*)(p.ws + B_KN);
  const u16* qn = (const u16*)(p.ws + B_QN);
  const u16* vv = (const u16*)(p.ws + B_VV);
  u16* od = (u16*)(p.ws + (dir ? B_OB : B_OF));
  f32x16 S[4];
  if (seq >= 32) {
    const float* s0 = p.in[2] + ((size_t)(((seq - 32) * 4 + l) * 2 + dir) * 4 + h) * 16384;
#pragma unroll
    for (int t = 0; t < 4; ++t)
#pragma unroll
      for (int r = 0; r < 16; ++r) S[t][r] = s0[(size_t)(32 * t + crow(r, h2)) * 128 + dvc];
  } else {
#pragma unroll
    for (int t = 0; t < 4; ++t)
#pragma unroll
      for (int r = 0; r < 16; ++r) S[t][r] = 0.f;
  }
  for (int it = 0; it < nch; ++it) {
    const int chunk = chunk0 + (dir ? nch - 1 - it : it);
    const int tb = chunk * 64;
    const size_t cidx = ((size_t)(chunk * 4 + h) * 2 + dir);
    const float* gcp = (const float*)(p.ws + B_GC) + cidx * 64;
    const float* bcp = (const float*)(p.ws + B_BC) + cidx * 64;
    const u16* tm = (const u16*)(p.ws + B_TM) + cidx * 4096;
    const u16* qkm = (const u16*)(p.ws + B_QKM) + cidx * 4096;
    const u16* ktp = (const u16*)(p.ws + B_KT) + (size_t)(chunk * 4 + h) * 8192;
    const float glast = gcp[63];
    size_t trow[2];
#pragma unroll
    for (int mi = 0; mi < 2; ++mi) { const int c = 32 * mi + n; trow[mi] = (size_t)(tb + (dir ? 63 - c : c)); }
#define SCHED_FENCE() asm volatile("" ::: "memory")
    u16* vls = sm + w * (64 * 40);
    __syncthreads();
#pragma unroll
    for (int jv = 0; jv < 4; ++jv) {
      const int tau = (lane >> 2) + 16 * jv, cq = lane & 3;
      const uint4 vq = *(const uint4*)(vv + (size_t)(tb + tau) * 512 + h * 128 + w * 32 + cq * 8);
      *(uint4*)(vls + (dir ? 63 - tau : tau) * 40 + cq * 8) = vq;
    }
    __syncthreads();
    f32x16 X[2], QS[2];
    {
      bf16x8 Sb[4][2];
#pragma unroll
      for (int t = 0; t < 4; ++t)
#pragma unroll
        for (int s = 0; s < 2; ++s) Sb[t][s] = pack_acc(S[t], s);
#pragma unroll
      for (int mi = 0; mi < 2; ++mi)
#pragma unroll
        for (int r = 0; r < 16; ++r) { X[mi][r] = 0.f; QS[mi][r] = 0.f; }
#pragma unroll
      for (int t = 0; t < 4; ++t) {
#pragma unroll
        for (int mi = 0; mi < 2; ++mi) {
          const u16* krow_ = kn + trow[mi] * 512 + h * 128;
          const u16* qrow_ = qn + trow[mi] * 512 + h * 128;
#pragma unroll
          for (int s = 0; s < 2; ++s) {
            X[mi] = MFMA32(load_perm(krow_ + 32 * t, s, h2), Sb[t][s], X[mi]);
            QS[mi] = MFMA32(load_perm(qrow_ + 32 * t, s, h2), Sb[t][s], QS[mi]);
          }
        }
        SCHED_FENCE();
      }
    }
    bf16x8 Rb[2][2];
#pragma unroll
    for (int mi = 0; mi < 2; ++mi) {
#pragma unroll
      for (int a = 0; a < 4; ++a) {
        const int c4 = 32 * mi + 8 * a + 4 * h2;
        const float4 g4 = *(const float4*)(gcp + c4);
        const float4 b4 = *(const float4*)(bcp + c4);
        const float gg[4] = {g4.x, g4.y, g4.z, g4.w};
        const float bb[4] = {b4.x, b4.y, b4.z, b4.w};
#pragma unroll
        for (int q = 0; q < 4; ++q) {
          const int c = c4 + q;
          const float v = bf2f(vls[c * 40 + n]);
          const float eg = __expf(gg[q]);
          X[mi][4 * a + q] = bb[q] * (v - eg * X[mi][4 * a + q]);
          QS[mi][4 * a + q] *= eg;
        }
      }
      Rb[mi][0] = pack_acc(X[mi], 0);
      Rb[mi][1] = pack_acc(X[mi], 1);
    }
    SCHED_FENCE();
    f32x16 Vn[2];
#pragma unroll
    for (int mo = 0; mo < 2; ++mo) {
#pragma unroll
      for (int r = 0; r < 16; ++r) Vn[mo][r] = 0.f;
#pragma unroll
      for (int mi = 0; mi <= mo; ++mi)
#pragma unroll
        for (int s = 0; s < 2; ++s) Vn[mo] = MFMA32(load_perm(tm + (32 * mo + n) * 64 + 32 * mi, s, h2), Rb[mi][s], Vn[mo]);
    }
    SCHED_FENCE();
    {
      bf16x8 Vb[2][2];
#pragma unroll
      for (int mi = 0; mi < 2; ++mi) { Vb[mi][0] = pack_acc(Vn[mi], 0); Vb[mi][1] = pack_acc(Vn[mi], 1); }
#pragma unroll
      for (int mo = 0; mo < 2; ++mo) {
#pragma unroll
        for (int mi = 0; mi <= mo; ++mi)
#pragma unroll
          for (int s = 0; s < 2; ++s) QS[mo] = MFMA32(load_perm(qkm + (32 * mo + n) * 64 + 32 * mi, s, h2), Vb[mi][s], QS[mo]);
      }
      __syncthreads();
#pragma unroll
      for (int mo = 0; mo < 2; ++mo)
#pragma unroll
        for (int r = 0; r < 16; ++r) vls[(32 * mo + crow(r, h2)) * 40 + n] = f2bf(QS[mo][r]);
      __syncthreads();
#pragma unroll
      for (int jv = 0; jv < 4; ++jv) {
        const int tau = (lane >> 2) + 16 * jv, cq = lane & 3;
        const uint4 oq = *(const uint4*)(vls + (dir ? 63 - tau : tau) * 40 + cq * 8);
        *(uint4*)(od + (size_t)(tb + tau) * 512 + h * 128 + w * 32 + cq * 8) = oq;
      }
    }
    SCHED_FENCE();
    bf16x8 Vsb[2][2];
#pragma unroll
    for (int mi = 0; mi < 2; ++mi) {
#pragma unroll
      for (int a = 0; a < 4; ++a) {
        const float4 g4 = *(const float4*)(gcp + 32 * mi + 8 * a + 4 * h2);
        Vn[mi][4 * a + 0] *= __expf(glast - g4.x); Vn[mi][4 * a + 1] *= __expf(glast - g4.y);
        Vn[mi][4 * a + 2] *= __expf(glast - g4.z); Vn[mi][4 * a + 3] *= __expf(glast - g4.w);
      }
      Vsb[mi][0] = pack_acc(Vn[mi], 0); Vsb[mi][1] = pack_acc(Vn[mi], 1);
    }
    const float eg = __expf(glast);
#pragma unroll
    for (int t = 0; t < 4; ++t) {
#pragma unroll
      for (int r = 0; r < 16; ++r) S[t][r] *= eg;
      const u16* ktrow = ktp + (32 * t + n) * 64;
#pragma unroll
      for (int mi = 0; mi < 2; ++mi)
#pragma unroll
        for (int s = 0; s < 2; ++s) {
          bf16x8 a = dir ? load_perm_rev(ktrow, 32 * mi, s, h2) : load_perm(ktrow + 32 * mi, s, h2);
          S[t] = MFMA32(a, Vsb[mi][s], S[t]);
        }
      SCHED_FENCE();
    }
  }
  if (seq < 32) {
    float* so = p.out + O_SD + ((size_t)((seq * 4 + l) * 2 + dir) * 4 + h) * 16384;
#pragma unroll
    for (int t = 0; t < 4; ++t)
#pragma unroll
      for (int r = 0; r < 16; ++r) so[(size_t)(32 * t + crow(r, h2)) * 128 + dvc] = S[t][r];
  }
}

DI void attn_tile(const Params& p, int seq, int head, int qb) {
  const int lane = otid() & 63, w = otid() >> 6;
  const int n = lane & 31, h2 = lane >> 5;
  int tq0, nkeys; size_t kbo, vto;
  if (seq < 32) { tq0 = seq * 256 + qb * 128 + w * 32; nkeys = 256; kbo = (size_t)(seq * 8 + head) * 256 * 96; vto = (size_t)(seq * 8 + head) * 64 * 256; }
  else { const int s = seq - 32; tq0 = TP_ + s * 2048 + qb * 128 + w * 32; nkeys = 2304; kbo = KB_P + (size_t)(s * 8 + head) * 2304 * 96; vto = VT_P + (size_t)(s * 8 + head) * 64 * 2304; }
  const u16* kb = (const u16*)(p.ws + B_KB) + kbo;
  const u16* vt = (const u16*)(p.ws + B_VT) + vto;
  const u16* qm = (const u16*)(p.ws + B_QM) + (size_t)(tq0 + n) * 768 + head * 96;
  bf16x8 qf[6];
#pragma unroll
  for (int ks = 0; ks < 6; ++ks) qf[ks] = *(const bf16x8*)(qm + ks * 16 + h2 * 8);
  f32x16 O[2];
#pragma unroll
  for (int r = 0; r < 16; ++r) { O[0][r] = 0.f; O[1][r] = 0.f; }
  float mrun = -1e30f, lsum = 0.f;
  const int nkt = nkeys >> 6;
  for (int kt = 0; kt < nkt; ++kt) {
    f32x16 St[2];
#pragma unroll
    for (int sub = 0; sub < 2; ++sub) {
#pragma unroll
      for (int r = 0; r < 16; ++r) St[sub][r] = 0.f;
      const u16* kr = kb + (size_t)(kt * 64 + sub * 32 + n) * 96 + h2 * 8;
#pragma unroll
      for (int ks = 0; ks < 6; ++ks) St[sub] = MFMA32(*(const bf16x8*)(kr + ks * 16), qf[ks], St[sub]);
    }
    float mx = St[0][0];
#pragma unroll
    for (int r = 0; r < 16; ++r) { mx = fmaxf(mx, St[0][r]); mx = fmaxf(mx, St[1][r]); }
    mx = fmaxf(mx, __shfl_xor(mx, 32));
    const float mnew = fmaxf(mrun, mx);
    const float alpha = exp2f(mrun - mnew);
    mrun = mnew;
    float ps = 0.f;
#pragma unroll
    for (int sub = 0; sub < 2; ++sub)
#pragma unroll
      for (int r = 0; r < 16; ++r) { float e = exp2f(St[sub][r] - mnew); St[sub][r] = e; ps += e; }
    lsum = lsum * alpha + ps;
#pragma unroll
    for (int r = 0; r < 16; ++r) { O[0][r] *= alpha; O[1][r] *= alpha; }
#pragma unroll
    for (int sub = 0; sub < 2; ++sub)
#pragma unroll
      for (int s = 0; s < 2; ++s) {
        const bf16x8 pb = pack_acc(St[sub], s);
#pragma unroll
        for (int dt = 0; dt < 2; ++dt)
          O[dt] = MFMA32(load_perm(vt + (size_t)(dt * 32 + n) * nkeys + kt * 64 + sub * 32, s, h2), pb, O[dt]);
      }
  }
  lsum += __shfl_xor(lsum, 32);
  const float inv = 1.f / lsum;
  u16* oc = (u16*)(p.ws + B_OC) + (size_t)(tq0 + n) * 512 + head * 64;
#pragma unroll
  for (int dt = 0; dt < 2; ++dt)
#pragma unroll
    for (int a = 0; a < 4; ++a) {
      const int dv = dt * 32 + 8 * a + 4 * h2;
      *(uint2*)(oc + dv) = make_uint2(pack2(O[dt][4 * a] * inv, O[dt][4 * a + 1] * inv), pack2(O[dt][4 * a + 2] * inv, O[dt][4 * a + 3] * inv));
    }
}

DI void delta_out_tile(const Params& p, int l, int tile) {
  const int lane = otid() & 63, w = otid() >> 6;
  const u16* of = (const u16*)(p.ws + B_OF);
  const u16* ob = (const u16*)(p.ws + B_OB);
  const u16* z = (const u16*)(p.ws + B_Z);
  u16* oa = (u16*)(p.ws + B_OA);
  const float g0 = p.in[17][l * 128 + 2 * lane], g1 = p.in[17][l * 128 + 2 * lane + 1];
#pragma unroll 1
  for (int q = 0; q < 16; ++q) {
    const size_t t = (size_t)tile * 16 + w * 4 + (q >> 2);
    const int hh = q & 3;
    const size_t off = t * 512 + hh * 128 + 2 * lane;
    unsigned a = *(const unsigned*)(of + off), b = *(const unsigned*)(ob + off), zz = *(const unsigned*)(z + off);
    float o0 = blo(a) + blo(b), o1 = bhi(a) + bhi(b);
    float ss = wave_sum(o0 * o0 + o1 * o1);
    float rstd = rsqrtf(ss * (1.f / 128.f) + 1e-6f);
    float y0 = o0 * rstd * g0 * siluf_(blo(zz)), y1 = o1 * rstd * g1 * siluf_(bhi(zz));
    *(unsigned*)(oa + off) = pack2(y0, y1);
  }
}

DI void grid_barrier(unsigned* bar, unsigned target) {
  __threadfence();
  asm volatile("s_waitcnt vmcnt(0) lgkmcnt(0)" ::: "memory");
  __syncthreads();
  if (otid() == 0) {
    __hip_atomic_fetch_add(bar, 1u, __ATOMIC_RELEASE, __HIP_MEMORY_SCOPE_AGENT);
    while (__hip_atomic_load(bar, __ATOMIC_RELAXED, __HIP_MEMORY_SCOPE_AGENT) < target) __builtin_amdgcn_s_sleep(2);
    __builtin_amdgcn_fence(__ATOMIC_ACQUIRE, "agent");
    asm volatile("s_waitcnt vmcnt(0)" ::: "memory");
  }
  __syncthreads();
  __threadfence();
  asm volatile("s_waitcnt vmcnt(0)" ::: "memory");
}
#define GSYNC() do { bar_target += gridDim.x; grid_barrier(p.bar, bar_target); } while (0)
#ifndef ONLY
#define PH(n) 1
#else
#define PH(n) ((n) == ONLY || (n) / 100 == ONLY || (n) == ONLY / 100)
#endif
__global__ void __launch_bounds__(256, 2) mega(Params p) {
  cg::grid_group grid = cg::this_grid();
  __shared__ __attribute__((aligned(16))) char smem_raw[73728];
  u16* sm = (u16*)smem_raw;
  float* smf = (float*)smem_raw;
  const int nb = gridDim.x, bid = blockIdx.x;
  unsigned bar_target = 0;
  grid.sync();

  if (PH(0)) {
    const int tid = otid();
    for (int j = bid; j < 4 * CJ8; j += nb) conv_job(p, j / CJ8, j % CJ8, smf);
    for (int j = bid; j < 4 * 96; j += nb) mods_tile(p, j / 96, j % 96, smf);
    for (int j = bid; j < 64; j += nb) s5pre_tile(p, j);
    {
      const float4* xp = (const float4*)p.in[0];
      const float4* xs = (const float4*)p.in[1];
      float4* o = (float4*)p.out;
      const size_t nP = (size_t)TP_ * 256, nT = (size_t)T_ * 256;
      for (size_t i = (size_t)bid * 256 + tid; i < nT; i += (size_t)nb * 256) o[i] = i < nP ? xp[i] : xs[i - nP];
    }
    {
      float* rope = (float*)(p.ws + B_ROPE);
      for (int i = bid * 256 + tid; i < 2048 * 16; i += nb * 256) {
        const int pos = i >> 4, f = i & 15;
        const float invf = 1.f / powf(10000.f, (float)(f & 7) * 0.125f);
        const float ang = (f < 8 ? (float)(pos >> 6) : (float)(pos & 63)) * invf;
        float sn, cs;
        sincosf(ang, &sn, &cs);
        rope[i * 2] = cs; rope[i * 2 + 1] = sn;
      }
    }
    {
      u16* cc = (u16*)(p.ws + B_CKVC);
      for (int i = bid * 256 + tid; i < 8 * 4 * 256 * 256 / 2; i += nb * 256) {
        const int e = i * 2;
        const int c = e & 255, pos = (e >> 8) & 255, l = (e >> 16) & 3, b = e >> 18;
        float2 v = *(const float2*)(p.in[5] + e);
        *(unsigned*)(cc + ((size_t)(l * 2048 + b * 256 + pos)) * 256 + c) = pack2(v.x, v.y);
      }
    }
  }
  GSYNC();

  for (int l = 0; l < 4; ++l) {
    const u16* WL = (const u16*)(p.ws + B_W) + (size_t)l * W_LAYER;
    const float* mods = (const float*)(p.ws + B_MODS);
    if (PH(1)) norm_phase(p, l, 0, 1, p.in[11] + l * 1024);
    GSYNC();
    if (PH(2)) gemm_in_phase(p, l, sm);
    GSYNC();
    if (PH(3)) {
      for (int j = bid; j < NCH; j += nb) delta_prep_tile(p, l, j, sm);
      for (int j = bid; j < T_ / 4; j += nb) mla_prep_tile(p, l, j);
      for (int j = bid; j < 256; j += nb) cache_rope_tile(p, l, j);
      for (int j = bid; j < NCH * 16; j += nb) s5_chunk_tile(p, l, j >> 4, j & 15, 0, sm);
    }
    GSYNC();
    if (PH(4)) {
      const int tid = otid();
      if (PH(400)) for (int j = bid; j < NCH * 2; j += nb) delta_local_tile(p, j, smf);
      if (PH(410)) for (int j = bid; j < 192 * 6; j += nb) {
          const int q = j, mt = q / 6, nt = q % 6;
          f32x4 acc[4][4];
          zero_acc<4>(acc);
          gemm_core<4>(acc, (const u16*)(p.ws + B_QA) + (size_t)mt * 128 * 384, 384, WL + W_QB + (size_t)nt * 128 * 384, 384, 384, sm);
          u16* qm = (u16*)(p.ws + B_QM);
          const float qs = 0.10206207261596575f * 1.4426950408889634f;
          const float* rope = (const float*)(p.ws + B_ROPE);
          const int e_lane = tid & 63, e_w = tid >> 6, e_wr = e_w >> 1, e_wc = e_w & 1, e_fr = e_lane & 15, e_fq = e_lane >> 4;
          const bool is_s = (mt * 128 >= TP_);
#pragma unroll
          for (int i = 0; i < 4; ++i)
#pragma unroll
            for (int r = 0; r < 4; ++r) {
              const int row = mt * 128 + e_wr * 64 + i * 16 + e_fq * 4 + r;
              float vals[4];
#pragma unroll
              for (int jj = 0; jj < 4; ++jj) vals[jj] = acc[i][jj][r];
              if (is_s) {
                const int pos = (row - TP_) & 2047;
                const float cs = rope[(pos * 16 + e_fr) * 2], sn = rope[(pos * 16 + e_fr) * 2 + 1];
#pragma unroll
                for (int jj = 0; jj < 4; jj += 2) {
                  const int gt = (nt * 128 + e_wc * 64) / 16 + jj;
                  if (gt % 6 == 4) {
                    const float x1 = vals[jj], x2 = vals[jj + 1];
                    vals[jj] = x1 * cs - x2 * sn;
                    vals[jj + 1] = x2 * cs + x1 * sn;
                  }
                }
              }
#pragma unroll
              for (int jj = 0; jj < 4; ++jj) qm[(size_t)row * 768 + nt * 128 + e_wc * 64 + jj * 16 + e_fr] = f2bf(vals[jj] * qs);
            }
      }
      if (PH(420)) for (int j = bid; j < 208 * 8; j += nb) {
          const int q = j, mt = q >> 3, head = q & 7;
          f32x4 acc[4][4];
          zero_acc<4>(acc);
          const u16* A = mt < 192 ? (const u16*)(p.ws + B_KVA) + (size_t)mt * 128 * 256
                                  : (const u16*)(p.ws + B_CKVC) + ((size_t)l * 2048 + (size_t)(mt - 192) * 128) * 256;
          gemm_core<4>(acc, A, 256, WL + W_KVB + (size_t)head * 128 * 256, 256, 256, sm);
          int key0, nkeys; size_t kbo, vto;
          if (mt < 64) { const int seq = mt >> 1; key0 = (mt & 1) * 128; nkeys = 256; kbo = (size_t)(seq * 8 + head) * 256 * 96; vto = (size_t)(seq * 8 + head) * 64 * 256; }
          else if (mt < 192) { const int s = (mt - 64) >> 4; key0 = 256 + ((mt - 64) & 15) * 128; nkeys = 2304; kbo = KB_P + (size_t)(s * 8 + head) * 2304 * 96; vto = VT_P + (size_t)(s * 8 + head) * 64 * 2304; }
          else { const int s = (mt - 192) >> 1; key0 = ((mt - 192) & 1) * 128; nkeys = 2304; kbo = KB_P + (size_t)(s * 8 + head) * 2304 * 96; vto = VT_P + (size_t)(s * 8 + head) * 64 * 2304; }
          u16* kb = (u16*)(p.ws + B_KB) + kbo;
          u16* vt = (u16*)(p.ws + B_VT) + vto;
          const int e_lane = tid & 63, e_w = tid >> 6, e_wr = e_w >> 1, e_wc = e_w & 1, e_fr = e_lane & 15, e_fq = e_lane >> 4;
#pragma unroll
          for (int i = 0; i < 4; ++i)
#pragma unroll
            for (int jj = 0; jj < 4; ++jj) {
              const int key = key0 + e_wr * 64 + i * 16 + e_fq * 4;
              const int c = jj * 16 + e_fr;
              if (e_wc == 0) {
#pragma unroll
                for (int r = 0; r < 4; ++r) kb[(size_t)(key + r) * 96 + c] = f2bf(acc[i][jj][r]);
              } else {
                *(uint2*)(vt + (size_t)c * nkeys + key) = make_uint2(pack2(acc[i][jj][0], acc[i][jj][1]), pack2(acc[i][jj][2], acc[i][jj][3]));
              }
            }
      }
      if (PH(430)) for (int j = bid; j < 640; j += nb) s5_carry_tile(p, l, j);
    }
    GSYNC();
    if (PH(5)) {
      if (PH(500)) for (int j = bid; j < 320; j += nb) delta_scan_tile(p, l, j, sm);
      if (PH(510)) for (int j = bid; j < 1536; j += nb) {
        if (j < 1024) attn_tile(p, 32 + (j >> 7), (j >> 4) & 7, j & 15);
        else { const int q = j - 1024; attn_tile(p, q >> 4, (q >> 1) & 7, q & 1); }
      }
      if (PH(530)) for (int j = bid; j < NCH * 8; j += nb) {
        s5_chunk_tile(p, l, j >> 3, (j & 7) * 2, 1, sm);
        s5_chunk_tile(p, l, j >> 3, (j & 7) * 2 + 1, 1, sm);
      }
    }
    GSYNC();
    if (PH(6)) {
      for (int j = bid; j < T_ / 16; j += nb) delta_out_tile(p, l, j);
      for (int j = bid; j < 192 * 4; j += nb) {
        {
          const int q = j, mt = q >> 2, nt = q & 3;
          f32x4 acc[4][4];
          zero_acc<4>(acc);
          const u16* y5 = (const u16*)(p.ws + B_Y5);
          gemm_core<4>(acc, y5 + (size_t)mt * 128 * 512, 512, WL + W_GLU + (size_t)nt * 128 * 512, 512, 512, sm);
          u16* ob5 = (u16*)(p.ws + B_OB5);
          const float* bgl = p.in[27] + l * 512;
          EPI_LOOP(4) {
            const size_t row = mt * 128 + EROW; const int col = nt * 128 + ECOL(4);
            const float y = bf2f(y5[row * 512 + col]);
            ob5[row * 512 + col] = f2bf(y * sigmoidf_(acc[i][j][r] + bgl[col]));
          }
        }
      }
    }
    GSYNC();
    if (PH(7)) {
      const u16* H = (const u16*)(p.ws + B_H);
      u16* mg = (u16*)(p.ws + B_MG);
      for (int j = bid; j < 192 * 16; j += nb) {
        const int mt = j >> 4, nt = j & 15;
        f32x4 mer[4][2];
        zero_acc<2>(mer);
#pragma unroll 1
        for (int n = 0; n < 3; ++n) {
          f32x4 ag[4][2], ab[4][2];
          zero_acc<2>(ag);
          gemm_core<2>(ag, H + (size_t)mt * 128 * 1024, 1024, WL + W_G + (size_t)(n * 1024 + nt * 64) * 1024, 1024, 1024, sm);
          zero_acc<2>(ab);
          const u16* on = (const u16*)(p.ws + (n == 0 ? B_OA : (n == 1 ? B_OB5 : B_OC)));
          gemm_core<2>(ab, on + (size_t)mt * 128 * 512, 512, WL + W_BR + (size_t)(nt * 64) * 1536 + n * 512, 1536, 512, sm);
#pragma unroll
          for (int i = 0; i < 4; ++i)
#pragma unroll
            for (int jj = 0; jj < 2; ++jj)
#pragma unroll
              for (int r = 0; r < 4; ++r) mer[i][jj][r] += sigmoidf_(ag[i][jj][r]) * ab[i][jj][r];
        }
        EPI_LOOP(2) { mg[(size_t)(mt * 128 + EROW) * 1024 + nt * 64 + ECOL(2)] = f2bf(mer[i][j][r]); }
      }
    }
    GSYNC();
    if (PH(8)) {
      const u16* mg = (const u16*)(p.ws + B_MG);
      for (int j = bid; j < 192 * 8; j += nb) {
        const int mt = j >> 3, nt = j & 7;
        f32x4 acc[4][4];
        zero_acc<4>(acc);
        gemm_core<4>(acc, mg + (size_t)mt * 128 * 1024, 1024, WL + W_OUT + (size_t)nt * 128 * 1024, 1024, 1024, sm);
        const float* gm = mods + (size_t)(l * 9 + tok_v(mt * 128)) * 6144 + 2 * 1024;
        EPI_LOOP(4) {
          const size_t row = mt * 128 + EROW; const int col = nt * 128 + ECOL(4);
          p.out[row * 1024 + col] += gm[col] * acc[i][j][r];
        }
      }
    }
    GSYNC();
    if (PH(9)) norm_phase(p, l, 3, 4, p.in[12] + l * 1024);
    GSYNC();
    if (PH(10)) {
      const u16* H = (const u16*)(p.ws + B_H);
      u16* up = (u16*)(p.ws + B_UP);
      for (int j = bid; j < 192 * 44; j += nb) {
        const int mt = j / 44, nt = j % 44;
        f32x4 acc[4][4];
        zero_acc<4>(acc);
        gemm_core<4>(acc, H + (size_t)mt * 128 * 1024, 1024, WL + W_UP + (size_t)nt * 128 * 1024, 1024, 1024, sm);
        EPI_LOOP(4) { up[(size_t)(mt * 128 + EROW) * 5632 + nt * 128 + ECOL(4)] = f2bf(acc[i][j][r]); }
      }
    }
    GSYNC();
    if (PH(11)) {
      const int tid = otid();
      const u16* up = (const u16*)(p.ws + B_UP);
      u16* act = (u16*)(p.ws + B_ACT);
      const float* cw = p.in[35] + (size_t)l * 3 * 5632;
      const float* cb = p.in[36] + (size_t)l * 5632;
      for (size_t it = (size_t)bid * 256 + tid; it < (size_t)T_ * 352; it += (size_t)nb * 256) {
        const int t = (int)(it / 352), c8 = (int)(it % 352) * 8;
        int pos, L;
        if (t < TP_) { pos = t & 255; L = 256; } else { pos = (t - TP_) & 2047; L = 2048; }
        float res[8];
        float gv[8], vv2[8];
#pragma unroll
        for (int e = 0; e < 8; ++e) { gv[e] = cb[c8 + e]; vv2[e] = cb[2816 + c8 + e]; }
#pragma unroll
        for (int d = 0; d < 3; ++d) {
          const int ps = pos + d - 1;
          if (ps < 0 || ps >= L) continue;
          const u16* rowp = up + (size_t)(t + d - 1) * 5632;
          uint4 ug = *(const uint4*)(rowp + c8);
          uint4 uv = *(const uint4*)(rowp + 2816 + c8);
          const unsigned ugs[4] = {ug.x, ug.y, ug.z, ug.w}, uvs[4] = {uv.x, uv.y, uv.z, uv.w};
#pragma unroll
          for (int e = 0; e < 4; ++e) {
            gv[2 * e] += cw[d * 5632 + c8 + 2 * e] * blo(ugs[e]);
            gv[2 * e + 1] += cw[d * 5632 + c8 + 2 * e + 1] * bhi(ugs[e]);
            vv2[2 * e] += cw[d * 5632 + 2816 + c8 + 2 * e] * blo(uvs[e]);
            vv2[2 * e + 1] += cw[d * 5632 + 2816 + c8 + 2 * e + 1] * bhi(uvs[e]);
          }
        }
#pragma unroll
        for (int e = 0; e < 8; ++e) res[e] = siluf_(gv[e]) * vv2[e];
        *(uint4*)(act + (size_t)t * 2816 + c8) = make_uint4(pack2(res[0], res[1]), pack2(res[2], res[3]), pack2(res[4], res[5]), pack2(res[6], res[7]));
      }
    }
    GSYNC();
    if (PH(12)) {
      const u16* act = (const u16*)(p.ws + B_ACT);
      for (int j = bid; j < 192 * 8; j += nb) {
        const int mt = j >> 3, nt = j & 7;
        f32x4 acc[4][4];
        zero_acc<4>(acc);
        gemm_core<4>(acc, act + (size_t)mt * 128 * 2816, 2816, WL + W_DN + (size_t)nt * 128 * 2816, 2816, 2816, sm);
        const float* gf = mods + (size_t)(l * 9 + tok_v(mt * 128)) * 6144 + 5 * 1024;
        EPI_LOOP(4) {
          const size_t row = mt * 128 + EROW; const int col = nt * 128 + ECOL(4);
          p.out[row * 1024 + col] += gf[col] * acc[i][j][r];
        }
      }
    }
    GSYNC();
  }
  if (PH(13)) {
    const int tid = otid();
    const int lane = tid & 63, w = tid >> 6;
    const float* gfin = p.in[38];
    for (int tile = bid; tile < T_ / 4; tile += nb) {
      const int t = tile * 4 + w;
      float4* xr = (float4*)(p.out + (size_t)t * 1024);
      float4 v[4];
      float ss = 0.f;
#pragma unroll
      for (int j = 0; j < 4; ++j) { v[j] = xr[lane + 64 * j]; ss += v[j].x * v[j].x + v[j].y * v[j].y + v[j].z * v[j].z + v[j].w * v[j].w; }
      ss = wave_sum(ss);
      const float rstd = rsqrtf(ss * (1.f / 1024.f) + 1e-6f);
#pragma unroll
      for (int j = 0; j < 4; ++j) {
        float4 g = *(const float4*)(gfin + (lane + 64 * j) * 4);
        xr[lane + 64 * j] = make_float4(v[j].x * rstd * g.x, v[j].y * rstd * g.y, v[j].z * rstd * g.z, v[j].w * rstd * g.w);
      }
    }
  }
}

extern "C" void kernel_launch(void* const* d_in, const int* in_sizes, int n_in, void* d_out, int out_size,
                              void* d_ws, size_t ws_size, hipStream_t stream) {
  static int grid_blocks = 0;
  if (!grid_blocks) {
    int dev = 0, cus = 0, per_cu = 0;
    (void)hipGetDevice(&dev);
    (void)hipDeviceGetAttribute(&cus, hipDeviceAttributeMultiprocessorCount, dev);
    (void)hipOccupancyMaxActiveBlocksPerMultiprocessor(&per_cu, mega, 256, 0);
    if (per_cu > 2) per_cu = 2;
    if (per_cu < 1) per_cu = 1;
    grid_blocks = cus * per_cu;
  }
  if (ws_size < B_TOTAL || n_in < 39) {
    fprintf(stderr, "workspace too small: %zu < %zu\n", ws_size, (size_t)B_END);
    return;
  }
  Params p{};
  for (int i = 0; i < 39; ++i) p.in[i] = (const float*)d_in[i];
  p.out = (float*)d_out;
  p.ws = (char*)d_ws;
  p.bar = (unsigned*)((char*)d_ws + B_BAR);
  (void)hipMemsetAsync(p.bar, 0, 256, stream);
  void* args[] = {&p};
  hipError_t e = hipLaunchCooperativeKernel((void*)mega, dim3(grid_blocks), dim3(256), args, 0, stream);
  if (e != hipSuccess) fprintf(stderr, "cooperative launch failed: %s (grid %d)\n", hipGetErrorString(e), grid_blocks);
}
```

```cpp
#include <hip/hip_runtime.h>
#include <hip/hip_cooperative_groups.h>
#include <cstdio>
namespace cg = cooperative_groups;

#define DI __device__ __forceinline__
typedef __bf16 bf16;
using bf16x8 = __attribute__((ext_vector_type(8))) short;
using f32x4 = __attribute__((ext_vector_type(4))) float;
using f32x16 = __attribute__((ext_vector_type(16))) float;
typedef unsigned short u16;

constexpr int T_ = 24576, TP_ = 8192;
constexpr int NCH = 384;
constexpr long long O_SD = 25165824LL, O_S5RE = 41943040LL, O_S5IM = 42467328LL, O_CKV = 42991616LL, O_KR = 51380224LL;

constexpr size_t W_IN = 0;
constexpr size_t W_G = W_IN + 3328ull * 1024;
constexpr size_t W_QB = W_G + 3072ull * 1024;
constexpr size_t W_KVB = W_QB + 768ull * 384;
constexpr size_t W_GLU = W_KVB + 1024ull * 256;
constexpr size_t W_BR = W_GLU + 512ull * 512;
constexpr size_t W_OUT = W_BR + 1024ull * 1536;
constexpr size_t W_UP = W_OUT + 1024ull * 1024;
constexpr size_t W_DN = W_UP + 5632ull * 1024;
constexpr size_t W_LAYER = W_DN + 1024ull * 2816;

constexpr size_t al(size_t x) { return (x + 255) & ~(size_t)255; }
constexpr size_t B_W = 0;
constexpr size_t B_MODS = al(B_W + 4 * W_LAYER * 2);
constexpr size_t B_ROPE = al(B_MODS + 4ull * 9 * 6144 * 4);
constexpr size_t B_LAMB = al(B_ROPE + 2048ull * 32 * 4);
constexpr size_t B_LAM64 = al(B_LAMB + 4ull * 2 * 32 * 64 * 8);
constexpr size_t B_BBT = al(B_LAM64 + 4ull * 2 * 32 * 64 * 8);
constexpr size_t B_CMT = al(B_BBT + 4ull * 2 * 32 * 128 * 16 * 2);
constexpr size_t B_CKVC = al(B_CMT + 4ull * 32 * 16 * 128 * 2);
constexpr size_t B_H = al(B_CKVC + 4ull * 2048 * 256 * 2);
constexpr size_t B_QKV = al(B_H + (size_t)T_ * 1024 * 2);
constexpr size_t B_Z = al(B_QKV + (size_t)T_ * 1536 * 2);
constexpr size_t B_US5 = al(B_Z + (size_t)T_ * 512 * 2);
constexpr size_t B_QA = al(B_US5 + (size_t)T_ * 512 * 2);
constexpr size_t B_KVA = al(B_QA + (size_t)T_ * 384 * 2);
constexpr size_t B_MISC = al(B_KVA + (size_t)T_ * 256 * 2);
constexpr size_t B_QN = al(B_MISC + (size_t)T_ * 48 * 4);
constexpr size_t B_KN = al(B_QN + (size_t)T_ * 512 * 2);
constexpr size_t B_VV = al(B_KN + (size_t)T_ * 512 * 2);
constexpr size_t B_KT = al(B_VV + (size_t)T_ * 512 * 2);
constexpr size_t B_BG = al(B_KT + (size_t)T_ * 512 * 2);
constexpr size_t B_TM = al(B_BG + (size_t)T_ * 16 * 4);
constexpr size_t B_QKM = al(B_TM + (size_t)T_ * 512 * 2);
constexpr size_t B_GC = al(B_QKM + (size_t)T_ * 512 * 2);
constexpr size_t B_BC = al(B_GC + (size_t)NCH * 4 * 2 * 64 * 4);
constexpr size_t KB_P = 32ull * 8 * 256 * 96, KB_S = 8ull * 8 * 2304 * 96;
constexpr size_t VT_P = 32ull * 8 * 64 * 256, VT_S = 8ull * 8 * 64 * 2304;
constexpr size_t B_KB = al(B_BC + (size_t)NCH * 4 * 2 * 64 * 4);
constexpr size_t B_VT = al(B_KB + (KB_P + KB_S) * 2);
constexpr size_t B_QM = al(B_VT + (VT_P + VT_S) * 2);
constexpr size_t B_HEND = al(B_QM + (size_t)T_ * 768 * 2);
constexpr size_t B_HIN = al(B_HEND + (size_t)NCH * 32 * 2 * 64 * 8);
constexpr size_t B_Y5 = al(B_HIN + (size_t)NCH * 32 * 2 * 64 * 8);
constexpr size_t B_OC = al(B_Y5 + (size_t)T_ * 512 * 2);
constexpr size_t B_END = al(B_OC + (size_t)T_ * 512 * 2);
constexpr size_t B_OF = B_QKV;
constexpr size_t B_OB = B_QKV + (size_t)T_ * 512 * 2;
constexpr size_t B_MG = B_QKV;
constexpr size_t B_OA = B_QN;
constexpr size_t B_OB5 = B_KN;
constexpr size_t B_UP = B_QKV;
constexpr size_t B_ACT = B_KB;
static_assert(B_UP + (size_t)T_ * 5632 * 2 <= B_KB, "UP overlaps ACT");
static_assert(B_ACT + (size_t)T_ * 2816 * 2 <= B_END, "ACT too big");
constexpr size_t B_BAR = B_END;
constexpr size_t B_TOTAL = B_BAR + 256;
static_assert(B_TOTAL <= 768ull * 1024 * 1024, "workspace too big");

struct Params {
  const float* in[39];
  float* out;
  char* ws;
  unsigned* bar;
};

DI int otid() { int t = (int)__builtin_amdgcn_workitem_id_x(); asm volatile("" : "+v"(t)); return t; }
DI unsigned pack2(float a, float b) {
  typedef __attribute__((ext_vector_type(2))) __bf16 bf2;
  bf2 v; v[0] = (__bf16)a; v[1] = (__bf16)b;
  return __builtin_bit_cast(unsigned, v);
}
DI u16 f2bf(float a) { return (u16)(pack2(a, 0.f) & 0xffffu); }
DI float bf2f(u16 u) { return __uint_as_float(((unsigned)u) << 16); }
DI float blo(unsigned u) { return __uint_as_float(u << 16); }
DI float bhi(unsigned u) { return __uint_as_float(u & 0xffff0000u); }
DI float wave_sum(float v) {
#pragma unroll
  for (int o = 32; o > 0; o >>= 1) v += __shfl_xor(v, o);
  return v;
}
DI float sigmoidf_(float x) { return 1.f / (1.f + __expf(-x)); }
DI float siluf_(float x) { return x / (1.f + __expf(-x)); }
DI int tok_v(int t) { return t < TP_ ? 0 : 1 + ((t - TP_) >> 11); }
DI int crow(int r, int h2) { return (r & 3) + 8 * (r >> 2) + 4 * h2; }
DI bf16x8 mk8(unsigned a, unsigned b, unsigned c, unsigned d) {
  uint4 p = make_uint4(a, b, c, d);
  return __builtin_bit_cast(bf16x8, p);
}
DI bf16x8 pack_acc(const f32x16& x, int s) {
  return mk8(pack2(x[8 * s], x[8 * s + 1]), pack2(x[8 * s + 2], x[8 * s + 3]), pack2(x[8 * s + 4], x[8 * s + 5]),
             pack2(x[8 * s + 6], x[8 * s + 7]));
}
DI bf16x8 load_perm(const u16* rowptr, int s, int h2) {
  uint2 a = *(const uint2*)(rowptr + 16 * s + 4 * h2);
  uint2 b = *(const uint2*)(rowptr + 16 * s + 8 + 4 * h2);
  return mk8(a.x, a.y, b.x, b.y);
}
DI unsigned swap16(unsigned u) { return (u >> 16) | (u << 16); }
DI bf16x8 load_perm_rev(const u16* rowptr, int base, int s, int h2) {
  uint2 a = *(const uint2*)(rowptr + 60 - base - 16 * s - 4 * h2);
  uint2 b = *(const uint2*)(rowptr + 52 - base - 16 * s - 4 * h2);
  return mk8(swap16(a.y), swap16(a.x), swap16(b.y), swap16(b.x));
}
#define MFMA16(a, b, c) __builtin_amdgcn_mfma_f32_16x16x32_bf16((a), (b), (c), 0, 0, 0)
#define MFMA32(a, b, c) __builtin_amdgcn_mfma_f32_32x32x16_bf16((a), (b), (c), 0, 0, 0)

template <int NJ>
DI void gemm_core(f32x4 (&acc)[4][NJ], const u16* __restrict__ A, int lda, const u16* __restrict__ B, int ldb, int K,
                  u16* sm) {
  const int tid = otid(), lane = tid & 63, w = tid >> 6, wr = w >> 1, wc = w & 1;
  const int fr = lane & 15, fq = lane >> 4;
  constexpr int BN = NJ * 32;
  constexpr int STG = (128 + BN) * 72;
  const int lrow = tid >> 3, lkc = tid & 7;
  uint4 ra[4], rb[NJ];
  const u16* ap = A + (size_t)lrow * lda + lkc * 8;
  const u16* bp = B + (size_t)lrow * ldb + lkc * 8;
  const int nk = K >> 6;
  __syncthreads();
#pragma unroll
  for (int j = 0; j < 4; ++j) ra[j] = *(const uint4*)(ap + (size_t)(32 * j) * lda);
#pragma unroll
  for (int j = 0; j < NJ; ++j) rb[j] = *(const uint4*)(bp + (size_t)(32 * j) * ldb);
  {
    u16* as = sm; u16* bs = as + 128 * 72;
#pragma unroll
    for (int j = 0; j < 4; ++j) *(uint4*)(as + (lrow + 32 * j) * 72 + lkc * 8) = ra[j];
#pragma unroll
    for (int j = 0; j < NJ; ++j) *(uint4*)(bs + (lrow + 32 * j) * 72 + lkc * 8) = rb[j];
  }
  __syncthreads();
  for (int kt = 0; kt < nk; ++kt) {
    const bool more = (kt + 1 < nk);
    if (more) {
      const int k0 = (kt + 1) * 64;
#pragma unroll
      for (int j = 0; j < 4; ++j) ra[j] = *(const uint4*)(ap + (size_t)(32 * j) * lda + k0);
#pragma unroll
      for (int j = 0; j < NJ; ++j) rb[j] = *(const uint4*)(bp + (size_t)(32 * j) * ldb + k0);
    }
    const u16* as = sm + (kt & 1) * STG;
    const u16* bs = as + 128 * 72;
#pragma unroll
    for (int ks = 0; ks < 2; ++ks) {
      bf16x8 af[4], bfr[NJ];
#pragma unroll
      for (int i = 0; i < 4; ++i) af[i] = *(const bf16x8*)(as + (wr * 64 + i * 16 + fr) * 72 + ks * 32 + fq * 8);
#pragma unroll
      for (int j = 0; j < NJ; ++j) bfr[j] = *(const bf16x8*)(bs + (wc * NJ * 16 + j * 16 + fr) * 72 + ks * 32 + fq * 8);
#pragma unroll
      for (int i = 0; i < 4; ++i)
#pragma unroll
        for (int j = 0; j < NJ; ++j) acc[i][j] = MFMA16(af[i], bfr[j], acc[i][j]);
    }
    if (more) {
      u16* as2 = sm + ((kt + 1) & 1) * STG; u16* bs2 = as2 + 128 * 72;
#pragma unroll
      for (int j = 0; j < 4; ++j) *(uint4*)(as2 + (lrow + 32 * j) * 72 + lkc * 8) = ra[j];
#pragma unroll
      for (int j = 0; j < NJ; ++j) *(uint4*)(bs2 + (lrow + 32 * j) * 72 + lkc * 8) = rb[j];
    }
    __syncthreads();
  }
}
template <int NJ>
DI void zero_acc(f32x4 (&acc)[4][NJ]) {
#pragma unroll
  for (int i = 0; i < 4; ++i)
#pragma unroll
    for (int j = 0; j < NJ; ++j) acc[i][j] = f32x4{0.f, 0.f, 0.f, 0.f};
}
#define EPI_LOOP(NJ_)                                                              \
  const int e_lane = otid() & 63, e_w = otid() >> 6;                     \
  const int e_wr = e_w >> 1, e_wc = e_w & 1, e_fr = e_lane & 15, e_fq = e_lane >> 4; \
  _Pragma("unroll") for (int i = 0; i < 4; ++i)                                    \
  _Pragma("unroll") for (int j = 0; j < NJ_; ++j)                                  \
  _Pragma("unroll") for (int r = 0; r < 4; ++r)
#define EROW (e_wr * 64 + i * 16 + e_fq * 4 + r)
#define ECOL(NJ_) (e_wc * NJ_ * 16 + j * 16 + e_fr)

DI int colmap(int kind, int n) {
  if (kind == 0) {
    if (n < 2048) return n;
    if (n < 2560) return 2064 + (n - 2048);
    if (n < 2944) return 2576 + (n - 2560);
    if (n < 3200) return 2960 + (n - 2944);
    int j = n - 3200;
    if (j < 16) return 2048 + j;
    if (j < 48) return 3216 + (j - 16);
    return -1;
  }
  if (kind == 1) return 3248 + n;
  return n;
}
DI void convT_tile(const float* __restrict__ src, int lds, int K, u16* __restrict__ dst, int kind, int kt, int nt,
                   float* sm) {
  const int tid = otid();
  const int c = tid & 63;
  const int sc = colmap(kind, nt * 64 + c);
  __syncthreads();
#pragma unroll 4
  for (int i = 0; i < 16; ++i) {
    int r = (tid >> 6) + i * 4;
    float v = sc >= 0 ? src[(size_t)(kt * 64 + r) * lds + sc] : 0.f;
    sm[r * 65 + c] = v;
  }
  __syncthreads();
  const int n = tid >> 2, kq = tid & 3;
  unsigned pk[8];
#pragma unroll
  for (int j = 0; j < 8; ++j) pk[j] = pack2(sm[(kq * 16 + 2 * j) * 65 + n], sm[(kq * 16 + 2 * j + 1) * 65 + n]);
  u16* d = dst + (size_t)(nt * 64 + n) * K + kt * 64 + kq * 16;
  *(uint4*)d = make_uint4(pk[0], pk[1], pk[2], pk[3]);
  *(uint4*)(d + 8) = make_uint4(pk[4], pk[5], pk[6], pk[7]);
}
constexpr int CJ0 = 16 * 52, CJ1 = CJ0 + 16 * 48, CJ2 = CJ1 + 6 * 12, CJ3 = CJ2 + 4 * 16, CJ4 = CJ3 + 8 * 8,
              CJ5 = CJ4 + 24 * 16, CJ6 = CJ5 + 16 * 16, CJ7 = CJ6 + 16 * 88, CJ8 = CJ7 + 44 * 16;
DI void conv_job(const Params& p, int l, int j, float* sm) {
  u16* wl = (u16*)(p.ws + B_W) + (size_t)l * W_LAYER;
  if (j < CJ0) { convT_tile(p.in[13] + (size_t)l * 1024 * 6320, 6320, 1024, wl + W_IN, 0, j / 52, j % 52, sm); return; }
  if (j < CJ1) { j -= CJ0; convT_tile(p.in[13] + (size_t)l * 1024 * 6320, 6320, 1024, wl + W_G, 1, j / 48, j % 48, sm); return; }
  if (j < CJ2) { j -= CJ1; convT_tile(p.in[29] + (size_t)l * 384 * 768, 768, 384, wl + W_QB, 2, j / 12, j % 12, sm); return; }
  if (j < CJ3) { j -= CJ2; convT_tile(p.in[31] + (size_t)l * 256 * 1024, 1024, 256, wl + W_KVB, 2, j / 16, j % 16, sm); return; }
  if (j < CJ4) { j -= CJ3; convT_tile(p.in[26] + (size_t)l * 512 * 512, 512, 512, wl + W_GLU, 2, j / 8, j % 8, sm); return; }
  if (j < CJ5) { j -= CJ4; convT_tile(p.in[32] + (size_t)l * 1536 * 1024, 1024, 1536, wl + W_BR, 2, j / 16, j % 16, sm); return; }
  if (j < CJ6) { j -= CJ5; convT_tile(p.in[33] + (size_t)l * 1024 * 1024, 1024, 1024, wl + W_OUT, 2, j / 16, j % 16, sm); return; }
  if (j < CJ7) { j -= CJ6; convT_tile(p.in[34] + (size_t)l * 1024 * 5632, 5632, 1024, wl + W_UP, 2, j / 88, j % 88, sm); return; }
  j -= CJ7; convT_tile(p.in[37] + (size_t)l * 2816 * 1024, 1024, 2816, wl + W_DN, 2, j / 16, j % 16, sm);
}
DI void mods_tile(const Params& p, int l, int jg, float* sm) {
  const int tid = otid();
  __syncthreads();
  for (int i = tid; i < 9 * 1024; i += 256) {
    int v = i >> 10, k = i & 1023;
    float cv = v == 0 ? p.in[8][k] : p.in[7][(v - 1) * 1024 + k];
    sm[i] = cv / (1.f + __expf(-cv));
  }
  __syncthreads();
  const int col = jg * 64 + (tid & 63), kq = tid >> 6;
  float acc[9];
#pragma unroll
  for (int v = 0; v < 9; ++v) acc[v] = 0.f;
  const float* wp = p.in[9] + (size_t)l * 1024 * 6144 + col;
#pragma unroll 4
  for (int k = kq * 256; k < kq * 256 + 256; ++k) {
    float wv = wp[(size_t)k * 6144];
#pragma unroll
    for (int v = 0; v < 9; ++v) acc[v] += sm[v * 1024 + k] * wv;
  }
  float* red = sm + 9 * 1024;
#pragma unroll
  for (int v = 0; v < 9; ++v) red[(kq * 9 + v) * 64 + (tid & 63)] = acc[v];
  __syncthreads();
  if (kq == 0) {
    float* mods = (float*)(p.ws + B_MODS);
    float b = p.in[10][l * 6144 + col];
#pragma unroll
    for (int v = 0; v < 9; ++v) {
      float s = red[(0 * 9 + v) * 64 + tid] + red[(1 * 9 + v) * 64 + tid] + red[(2 * 9 + v) * 64 + tid] + red[(3 * 9 + v) * 64 + tid];
      mods[(size_t)(l * 9 + v) * 6144 + col] = s + b;
    }
  }
}
DI void s5pre_tile(const Params& p, int tile) {
  const int id = tile * 256 + otid();
  const int pp = id & 63, g = (id >> 6) & 31, dir = (id >> 11) & 1, l = id >> 12;
  const float lre = p.in[18][((l * 2 + dir) * 32 + g) * 64 + pp];
  const float lim = p.in[19][((l * 2 + dir) * 32 + g) * 64 + pp];
  const float dt = expf(p.in[20][(l * 2 + dir) * 32 + g]);
  float er = expf(lre * dt), sn, cs;
  sincosf(lim * dt, &sn, &cs);
  const float lbr = er * cs, lbi = er * sn;
  float e64 = expf(64.f * lre * dt), s64, c64;
  sincosf(64.f * lim * dt, &s64, &c64);
  float2* lamb = (float2*)(p.ws + B_LAMB);
  float2* lam64 = (float2*)(p.ws + B_LAM64);
  const int li = ((l * 2 + dir) * 32 + g) * 64 + pp;
  lamb[li] = make_float2(lbr, lbi);
  lam64[li] = make_float2(e64 * c64, e64 * s64);
  const float nr = lbr - 1.f, ni = lbi, den = lre * lre + lim * lim;
  const float cr = (nr * lre + ni * lim) / den, ci = (ni * lre - nr * lim) / den;
  u16* bbt = (u16*)(p.ws + B_BBT) + (size_t)((l * 2 + dir) * 32 + g) * 128 * 16;
  const float* bre = p.in[21] + (size_t)((l * 32 + g) * 64 + pp) * 16;
  const float* bim = p.in[22] + (size_t)((l * 32 + g) * 64 + pp) * 16;
#pragma unroll
  for (int c = 0; c < 16; ++c) {
    float br = bre[c], bi = bim[c];
    bbt[pp * 16 + c] = f2bf(cr * br - ci * bi);
    bbt[(64 + pp) * 16 + c] = f2bf(cr * bi + ci * br);
  }
  if (dir == 0) {
    u16* cmt = (u16*)(p.ws + B_CMT) + (size_t)(l * 32 + g) * 16 * 128;
    const float* cre = p.in[23] + (size_t)(l * 32 + g) * 16 * 64;
    const float* cim = p.in[24] + (size_t)(l * 32 + g) * 16 * 64;
#pragma unroll
    for (int c = 0; c < 16; ++c) {
      cmt[c * 128 + pp] = f2bf(cre[c * 64 + pp]);
      cmt[c * 128 + 64 + pp] = f2bf(-cim[c * 64 + pp]);
    }
  }
}

DI void norm_phase(const Params& p, int l, int shift_idx, int scale_idx, const float* gn) {
  const float* x = p.out;
  u16* H = (u16*)(p.ws + B_H);
  const float* mods = (const float*)(p.ws + B_MODS);
  const int lane = otid() & 63, w = otid() >> 6;
  for (int tile = blockIdx.x; tile < T_ / 4; tile += gridDim.x) {
    const int t = tile * 4 + w;
    const float4* xr = (const float4*)(x + (size_t)t * 1024);
    float4 v[4];
    float ss = 0.f;
#pragma unroll
    for (int j = 0; j < 4; ++j) {
      v[j] = xr[lane + 64 * j];
      ss += v[j].x * v[j].x + v[j].y * v[j].y + v[j].z * v[j].z + v[j].w * v[j].w;
    }
    ss = wave_sum(ss);
    const float rstd = rsqrtf(ss * (1.f / 1024.f) + 1e-6f);
    const float* mb = mods + (size_t)(l * 9 + tok_v(t)) * 6144;
#pragma unroll
    for (int j = 0; j < 4; ++j) {
      const int c = (lane + 64 * j) * 4;
      float4 g = *(const float4*)(gn + c);
      float4 sc = *(const float4*)(mb + scale_idx * 1024 + c);
      float4 sh = *(const float4*)(mb + shift_idx * 1024 + c);
      float y0 = v[j].x * rstd * g.x * (1.f + sc.x) + sh.x;
      float y1 = v[j].y * rstd * g.y * (1.f + sc.y) + sh.y;
      float y2 = v[j].z * rstd * g.z * (1.f + sc.z) + sh.z;
      float y3 = v[j].w * rstd * g.w * (1.f + sc.w) + sh.w;
      *(uint2*)(H + (size_t)t * 1024 + c) = make_uint2(pack2(y0, y1), pack2(y2, y3));
    }
  }
}

DI void gemm_in_phase(const Params& p, int l, u16* sm) {
  const u16* H = (const u16*)(p.ws + B_H);
  const u16* Wt = (const u16*)(p.ws + B_W) + (size_t)l * W_LAYER + W_IN;
  for (int tile = blockIdx.x; tile < 192 * 26; tile += gridDim.x) {
    const int mt = tile / 26, nt = tile % 26;
    f32x4 acc[4][4];
    zero_acc<4>(acc);
    gemm_core<4>(acc, H + (size_t)mt * 128 * 1024, 1024, Wt + (size_t)nt * 128 * 1024, 1024, 1024, sm);
    if (nt < 25) {
      u16* dst; int ld, c0;
      if (nt < 12) { dst = (u16*)(p.ws + B_QKV); ld = 1536; c0 = nt * 128; }
      else if (nt < 16) { dst = (u16*)(p.ws + B_Z); ld = 512; c0 = (nt - 12) * 128; }
      else if (nt < 20) { dst = (u16*)(p.ws + B_US5); ld = 512; c0 = (nt - 16) * 128; }
      else if (nt < 23) { dst = (u16*)(p.ws + B_QA); ld = 384; c0 = (nt - 20) * 128; }
      else { dst = (u16*)(p.ws + B_KVA); ld = 256; c0 = (nt - 23) * 128; }
      EPI_LOOP(4) { dst[(size_t)(mt * 128 + EROW) * ld + c0 + ECOL(4)] = f2bf(acc[i][j][r]); }
    } else {
      float* misc = (float*)(p.ws + B_MISC);
      EPI_LOOP(4) {
        int c = ECOL(4);
        if (c < 48) misc[(size_t)(mt * 128 + EROW) * 48 + c] = acc[i][j][r];
      }
    }
  }
}

DI void delta_prep_tile(const Params& p, int l, int chunk, u16* sm) {
  const int tid = otid(), lane = tid & 63, w = tid >> 6;
  const int tb = chunk * 64;
  int pos0, L;
  if (tb < TP_) { pos0 = tb & 255; L = 256; } else { pos0 = (tb - TP_) & 2047; L = 2048; }
  const u16* qkv = (const u16*)(p.ws + B_QKV);
  const float* cw = p.in[14] + (size_t)l * 5 * 1536;
  u16* ksm = sm + w * (64 * 130);
  __syncthreads();
  for (int gi = w; gi < 12; gi += 4) {
    const int ch = gi * 128 + 2 * lane;
    float w0[5], w1[5];
#pragma unroll
    for (int i = 0; i < 5; ++i) { w0[i] = cw[i * 1536 + ch]; w1[i] = cw[i * 1536 + ch + 1]; }
    float a0[5], a1[5];
#pragma unroll
    for (int i = 0; i < 4; ++i) {
      int ps = pos0 - 2 + i;
      unsigned u = (ps >= 0 && ps < L) ? *(const unsigned*)(qkv + (size_t)(tb - 2 + i) * 1536 + ch) : 0u;
      a0[i + 1] = blo(u); a1[i + 1] = bhi(u);
    }
    u16* dst = (u16*)(p.ws + (gi < 4 ? B_QN : (gi < 8 ? B_KN : B_VV)));
    const int hh = gi & 3;
    for (int tt = 0; tt < 64; ++tt) {
#pragma unroll
      for (int i = 0; i < 4; ++i) { a0[i] = a0[i + 1]; a1[i] = a1[i + 1]; }
      {
        int ps = pos0 + tt + 2;
        unsigned u = (ps < L) ? *(const unsigned*)(qkv + (size_t)(tb + tt + 2) * 1536 + ch) : 0u;
        a0[4] = blo(u); a1[4] = bhi(u);
      }
      float y0 = 0.f, y1 = 0.f;
#pragma unroll
      for (int i = 0; i < 5; ++i) { y0 += w0[i] * a0[i]; y1 += w1[i] * a1[i]; }
      y0 = siluf_(y0); y1 = siluf_(y1);
      if (gi < 8) {
        float ss = wave_sum(y0 * y0 + y1 * y1);
        float sc = rsqrtf(ss + 1e-6f);
        if (gi < 4) sc *= 0.08838834764831845f;
        y0 *= sc; y1 *= sc;
      }
      const unsigned pk = pack2(y0, y1);
      *(unsigned*)(dst + (size_t)(tb + tt) * 512 + hh * 128 + 2 * lane) = pk;
      if (gi >= 4 && gi < 8) *(unsigned*)(ksm + tt * 130 + 2 * lane) = pk;
    }
    if (gi >= 4 && gi < 8) {
      u16* kt = (u16*)(p.ws + B_KT) + (size_t)(chunk * 4 + hh) * 128 * 64;
#pragma unroll
      for (int rr = 0; rr < 2; ++rr) {
        const int dk = lane + 64 * rr;
        unsigned pk[32];
#pragma unroll
        for (int t2 = 0; t2 < 32; ++t2) pk[t2] = (unsigned)ksm[(2 * t2) * 130 + dk] | ((unsigned)ksm[(2 * t2 + 1) * 130 + dk] << 16);
#pragma unroll
        for (int q = 0; q < 8; ++q) *(uint4*)(kt + dk * 64 + q * 8) = make_uint4(pk[4 * q], pk[4 * q + 1], pk[4 * q + 2], pk[4 * q + 3]);
      }
    }
  }
  const float* misc = (const float*)(p.ws + B_MISC);
  float* bg = (float*)(p.ws + B_BG);
  for (int i = tid; i < 512; i += 256) {
    const int tt = i >> 3, dh = i & 7;
    const size_t t = tb + tt;
    float bl = misc[t * 48 + dh], alp = misc[t * 48 + 8 + dh];
    float x = alp + p.in[16][l * 8 + dh];
    float sp = x > 20.f ? x : log1pf(__expf(x));
    bg[t * 16 + dh] = sigmoidf_(bl);
    bg[t * 16 + 8 + dh] = -__expf(p.in[15][l * 8 + dh]) * sp;
  }
}

DI size_t kb_off(int t, int head) {
  if (t < TP_) return ((size_t)((t >> 8) * 8 + head) * 256 + (t & 255)) * 96;
  const int s = (t - TP_) >> 11, pos = (t - TP_) & 2047;
  return KB_P + ((size_t)(s * 8 + head) * 2304 + 256 + pos) * 96;
}
DI void mla_prep_tile(const Params& p, int l, int tile) {
  const int lane = otid() & 63, w = otid() >> 6;
  const int t = tile * 4 + w;
  u16* qa = (u16*)(p.ws + B_QA) + (size_t)t * 384;
  u16* kva = (u16*)(p.ws + B_KVA) + (size_t)t * 256;
  const float* misc = (const float*)(p.ws + B_MISC) + (size_t)t * 48;
  {
    unsigned u[3]; float ss = 0.f;
#pragma unroll
    for (int j = 0; j < 3; ++j) { u[j] = *(const unsigned*)(qa + 2 * lane + 128 * j); float a = blo(u[j]), b = bhi(u[j]); ss += a * a + b * b; }
    ss = wave_sum(ss);
    const float rstd = rsqrtf(ss * (1.f / 384.f) + 1e-6f);
    const float* g = p.in[28] + l * 384;
#pragma unroll
    for (int j = 0; j < 3; ++j) {
      int c = 2 * lane + 128 * j;
      *(unsigned*)(qa + c) = pack2(blo(u[j]) * rstd * g[c], bhi(u[j]) * rstd * g[c + 1]);
    }
  }
  {
    unsigned u[2]; float ss = 0.f;
#pragma unroll
    for (int j = 0; j < 2; ++j) { u[j] = *(const unsigned*)(kva + 2 * lane + 128 * j); float a = blo(u[j]), b = bhi(u[j]); ss += a * a + b * b; }
    ss = wave_sum(ss);
    const float rstd = rsqrtf(ss * (1.f / 256.f) + 1e-6f);
    const float* g = p.in[30] + l * 256;
#pragma unroll
    for (int j = 0; j < 2; ++j) {
      int c = 2 * lane + 128 * j;
      float a = blo(u[j]) * rstd * g[c], b = bhi(u[j]) * rstd * g[c + 1];
      *(unsigned*)(kva + c) = pack2(a, b);
      if (t < TP_) {
        float* o = p.out + O_CKV + ((size_t)((t >> 8) * 4 + l) * 256 + (t & 255)) * 256 + c;
        *(float2*)o = make_float2(a, b);
      }
    }
  }
  {
    const int i = lane & 31;
    float kr = misc[16 + i];
    float val;
    if (t < TP_) {
      val = kr;
      if (lane < 32) p.out[O_KR + ((size_t)((t >> 8) * 4 + l) * 256 + (t & 255)) * 32 + i] = kr;
    } else {
      const int pos = (t - TP_) & 2047;
      const float* rp = (const float*)(p.ws + B_ROPE) + (size_t)pos * 32 + (i & 15) * 2;
      const float cs = rp[0], sn = rp[1];
      float other = __shfl_xor(kr, 16);
      val = (i < 16) ? (kr * cs - other * sn) : (kr * cs + other * sn);
    }
    u16* kb = (u16*)(p.ws + B_KB);
    const u16 bv = f2bf(val);
#pragma unroll
    for (int hh = 0; hh < 4; ++hh) {
      int head = hh * 2 + (lane >> 5);
      kb[kb_off(t, head) + 64 + i] = bv;
    }
  }
}
DI void cache_rope_tile(const Params& p, int l, int tile) {
  const int pr = tile * 8 + (otid() >> 5), i = otid() & 31;
  const int s = pr >> 8, pos = pr & 255;
  const float v = p.in[6][((size_t)(s * 4 + l) * 256 + pos) * 32 + i];
  u16* kb = (u16*)(p.ws + B_KB);
  const u16 bv = f2bf(v);
#pragma unroll
  for (int head = 0; head < 8; ++head) kb[KB_P + ((size_t)(s * 8 + head) * 2304 + pos) * 96 + 64 + i] = bv;
}

DI float gelu_tanh(float x) {
  const float k0 = 0.7978845608028654f, k1 = 0.044715f;
  float u = k0 * (x + k1 * x * x * x);
  float e = __expf(2.f * u);
  float th = 1.f - 2.f / (e + 1.f);
  return 0.5f * x * (1.f + th);
}
DI void s5_chunk_tile(const Params& p, int l, int chunk, int gp, int mode, u16* sm) {
  const int tid = otid(), lane = tid & 63, w = tid >> 6;
  const u16* us5 = (const u16*)(p.ws + B_US5);
  constexpr int RS = 136;
  __syncthreads();
  {
    const int gi = w >> 1, half = w & 1, g = gp * 2 + gi;
    const int n = lane & 31, h2 = lane >> 5;
    bf16x8 af[2];
#pragma unroll
    for (int mi = 0; mi < 2; ++mi) af[mi] = *(const bf16x8*)(us5 + (size_t)(chunk * 64 + mi * 32 + n) * 512 + g * 16 + 8 * h2);
#pragma unroll
    for (int dir = 0; dir < 2; ++dir) {
      const u16* bbt = (const u16*)(p.ws + B_BBT) + (size_t)((l * 2 + dir) * 32 + g) * 128 * 16;
#pragma unroll
      for (int nn = 0; nn < 2; ++nn) {
        const int nt = half * 2 + nn;
        bf16x8 bfr = *(const bf16x8*)(bbt + (nt * 32 + n) * 16 + 8 * h2);
#pragma unroll
        for (int mi = 0; mi < 2; ++mi) {
          f32x16 acc;
#pragma unroll
          for (int r = 0; r < 16; ++r) acc[r] = 0.f;
          acc = MFMA32(af[mi], bfr, acc);
          u16* d = sm + (size_t)((gi * 2 + dir) * 64 + mi * 32) * RS + nt * 32 + n;
#pragma unroll
          for (int r = 0; r < 16; ++r) d[crow(r, h2) * RS] = f2bf(acc[r]);
        }
      }
    }
  }
  __syncthreads();
  {
    const int gi = tid >> 7, dir = (tid >> 6) & 1, pp = tid & 63, g = gp * 2 + gi;
    const float2 lb = ((const float2*)(p.ws + B_LAMB))[((l * 2 + dir) * 32 + g) * 64 + pp];
    const size_t hidx = ((size_t)(chunk * 32 + g) * 2 + dir) * 64 + pp;
    float hr = 0.f, hi = 0.f;
    if (mode) { float2 h0 = ((const float2*)(p.ws + B_HIN))[hidx]; hr = h0.x; hi = h0.y; }
    u16* base = sm + (size_t)((gi * 2 + dir) * 64) * RS;
#pragma unroll 8
    for (int st = 0; st < 64; ++st) {
      const int tk = dir ? 63 - st : st;
      float br = bf2f(base[tk * RS + pp]), bi = bf2f(base[tk * RS + 64 + pp]);
      float nr = __builtin_fmaf(lb.x, hr, __builtin_fmaf(-lb.y, hi, br));
      float ni = __builtin_fmaf(lb.x, hi, __builtin_fmaf(lb.y, hr, bi));
      asm volatile("" : "+v"(nr));
      asm volatile("" : "+v"(ni));
      hr = nr; hi = ni;
      if (mode) { base[tk * RS + pp] = f2bf(hr); base[tk * RS + 64 + pp] = f2bf(hi); }
    }
    if (!mode) ((float2*)(p.ws + B_HEND))[hidx] = make_float2(hr, hi);
  }
  if (!mode) return;
  __syncthreads();
  {
    const int gi = w >> 1, g = gp * 2 + gi;
    const int fr = lane & 15, fq = lane >> 4;
    const u16* cmt = (const u16*)(p.ws + B_CMT) + (size_t)(l * 32 + g) * 16 * 128;
    f32x4 acc[2];
    acc[0] = f32x4{0.f, 0.f, 0.f, 0.f}; acc[1] = acc[0];
#pragma unroll
    for (int ks = 0; ks < 8; ++ks) {
      const int dir = ks >> 2, kk = (ks & 3) * 32;
      bf16x8 bfr = *(const bf16x8*)(cmt + fr * 128 + kk + fq * 8);
#pragma unroll
      for (int mm = 0; mm < 2; ++mm) {
        const int mi = (w & 1) * 2 + mm;
        bf16x8 af = *(const bf16x8*)(sm + (size_t)((gi * 2 + dir) * 64 + mi * 16 + fr) * RS + kk + fq * 8);
        acc[mm] = MFMA16(af, bfr, acc[mm]);
      }
    }
    const float dsk = p.in[25][l * 512 + g * 16 + fr];
    u16* y5 = (u16*)(p.ws + B_Y5);
#pragma unroll
    for (int mm = 0; mm < 2; ++mm)
#pragma unroll
      for (int r = 0; r < 4; ++r) {
        const size_t t = (size_t)chunk * 64 + ((w & 1) * 2 + mm) * 16 + fq * 4 + r;
        float u = bf2f(us5[t * 512 + g * 16 + fr]);
        float y = acc[mm][r] + dsk * u;
        y5[t * 512 + g * 16 + fr] = f2bf(gelu_tanh(y));
      }
  }
}
DI void s5_carry_tile(const Params& p, int l, int tile) {
  const int seq = tile >> 4, gp = tile & 15;
  const int tid = otid(), gi = tid >> 7, dir = (tid >> 6) & 1, pp = tid & 63, g = gp * 2 + gi;
  int c0, nc;
  if (seq < 32) { c0 = seq * 4; nc = 4; } else { c0 = 128 + (seq - 32) * 32; nc = 32; }
  const float2 l64 = ((const float2*)(p.ws + B_LAM64))[((l * 2 + dir) * 32 + g) * 64 + pp];
  float hr = 0.f, hi = 0.f;
  if (seq >= 32) {
    const size_t si = ((size_t)((seq - 32) * 4 + l) * 2 + dir) * 2048 + g * 64 + pp;
    hr = p.in[3][si]; hi = p.in[4][si];
  }
  const float2* hend = (const float2*)(p.ws + B_HEND);
  float2* hin = (float2*)(p.ws + B_HIN);
  for (int it = 0; it < nc; ++it) {
    const int ck = c0 + (dir ? nc - 1 - it : it);
    const size_t idx = ((size_t)(ck * 32 + g) * 2 + dir) * 64 + pp;
    hin[idx] = make_float2(hr, hi);
    float2 he = hend[idx];
    float nr = __builtin_fmaf(l64.x, hr, __builtin_fmaf(-l64.y, hi, he.x));
    float ni = __builtin_fmaf(l64.x, hi, __builtin_fmaf(l64.y, hr, he.y));
    asm volatile("" : "+v"(nr));
    asm volatile("" : "+v"(ni));
    hr = nr; hi = ni;
  }
  if (seq < 32) {
    const size_t so = ((size_t)(seq * 4 + l) * 2 + dir) * 2048 + g * 64 + pp;
    p.out[O_S5RE + so] = hr;
    p.out[O_S5IM + so] = hi;
  }
}

DI void delta_local_tile(const Params& p, int tile, float* smf) {
  const int chunk = tile >> 1, dir = tile & 1;
  const int tid = otid(), lane = tid & 63, h = tid >> 6;
  const int m = lane & 31, h2 = lane >> 5;
  const int tb = chunk * 64;
  const float* bg = (const float*)(p.ws + B_BG);
  const u16* kn = (const u16*)(p.ws + B_KN);
  const u16* qn = (const u16*)(p.ws + B_QN);
  float* Aw = smf + h * 4096;
  const size_t cidx = ((size_t)(chunk * 4 + h) * 2 + dir);
  const int tl = tb + (dir ? 63 - lane : lane);
  float gcs = bg[(size_t)tl * 16 + 8 + dir * 4 + h];
  const float beta = bg[(size_t)tl * 16 + dir * 4 + h];
#pragma unroll
  for (int o = 1; o < 64; o <<= 1) {
    float v = __shfl_up(gcs, o);
    if (lane >= o) gcs += v;
  }
  ((float*)(p.ws + B_GC))[cidx * 64 + lane] = gcs;
  ((float*)(p.ws + B_BC))[cidx * 64 + lane] = beta;
  __syncthreads();
  u16* qkm = (u16*)(p.ws + B_QKM) + cidx * 4096;
#pragma unroll 1
  for (int tt = 0; tt < 3; ++tt) {
    const int mi = tt == 0 ? 0 : 1, ni = tt == 2 ? 1 : 0;
    const int cm = 32 * mi + m, cn = 32 * ni + m;
    const u16* krm = kn + (size_t)(tb + (dir ? 63 - cm : cm)) * 512 + h * 128 + h2 * 8;
    const u16* qrm = qn + (size_t)(tb + (dir ? 63 - cm : cm)) * 512 + h * 128 + h2 * 8;
    const u16* krn = kn + (size_t)(tb + (dir ? 63 - cn : cn)) * 512 + h * 128 + h2 * 8;
    f32x16 ak, aq;
#pragma unroll
    for (int r = 0; r < 16; ++r) { ak[r] = 0.f; aq[r] = 0.f; }
#pragma unroll
    for (int ks = 0; ks < 8; ++ks) {
      const bf16x8 fkm = *(const bf16x8*)(krm + ks * 16), fqm = *(const bf16x8*)(qrm + ks * 16), fkn = *(const bf16x8*)(krn + ks * 16);
      ak = MFMA32(fkm, fkn, ak);
      aq = MFMA32(fqm, fkn, aq);
    }
    const int e = 32 * ni + m;
    const float gce = __shfl(gcs, e);
#pragma unroll
    for (int r = 0; r < 16; ++r) {
      const int c = 32 * mi + crow(r, h2);
      const float gcc = __shfl(gcs, c), bc = __shfl(beta, c);
      const float dec = (e <= c) ? __expf(gcc - gce) : 0.f;
      Aw[c * 64 + e] = (e < c) ? ak[r] * bc * dec : 0.f;
      qkm[c * 64 + e] = f2bf(aq[r] * dec);
    }
  }
  __syncthreads();
  u16* tm = (u16*)(p.ws + B_TM) + cidx * 4096;
  float x[64];
#pragma unroll
  for (int i = 0; i < 64; ++i) {
    float a = (i == lane) ? 1.f : 0.f;
#pragma unroll
    for (int j = 0; j < i; ++j) a -= Aw[i * 64 + j] * x[j];
    x[i] = a;
    tm[i * 64 + lane] = f2bf(a);
  }
}

template <int dir>
DI void delta_scan_body(const Params& p, int l, int seq, int h, u16* sm);
DI void delta_scan_tile(const Params& p, int l, int idx, u16* sm) {
  int seq, h, dir;
  if (idx < 64) { seq = 32 + (idx >> 3); h = (idx >> 1) & 3; dir = idx & 1; }
  else { const int i2 = idx - 64; seq = i2 >> 3; h = (i2 >> 1) & 3; dir = i2 & 1; }
  if (dir) delta_scan_body<1>(p, l, seq, h, sm); else delta_scan_body<0>(p, l, seq, h, sm);
}
template <int dir>
DI void delta_scan_body(const Params& p, int l, int seq, int h, u16* sm) {
  int chunk0, nch;
  if (seq < 32) { chunk0 = seq * 4; nch = 4; } else { chunk0 = 128 + (seq - 32) * 32; nch = 32; }
  const int lane = otid() & 63, w = otid() >> 6;
  const int n = lane & 31, h2 = lane >> 5;
  const int dvc = w * 32 + n;
  const u16* kn = (const u16*)(p.ws + B_KN);
  const u16* qn = (const u16*)(p.ws + B_QN);
  const u16* vv = (const u16*)(p.ws + B_VV);
  u16* od = (u16*)(p.ws + (dir ? B_OB : B_OF));
  f32x16 S[4];
  if (seq >= 32) {
    const float* s0 = p.in[2] + ((size_t)(((seq - 32) * 4 + l) * 2 + dir) * 4 + h) * 16384;
#pragma unroll
    for (int t = 0; t < 4; ++t)
#pragma unroll
      for (int r = 0; r < 16; ++r) S[t][r] = s0[(size_t)(32 * t + crow(r, h2)) * 128 + dvc];
  } else {
#pragma unroll
    for (int t = 0; t < 4; ++t)
#pragma unroll
      for (int r = 0; r < 16; ++r) S[t][r] = 0.f;
  }
  for (int it = 0; it < nch; ++it) {
    const int chunk = chunk0 + (dir ? nch - 1 - it : it);
    const int tb = chunk * 64;
    const size_t cidx = ((size_t)(chunk * 4 + h) * 2 + dir);
    const float* gcp = (const float*)(p.ws + B_GC) + cidx * 64;
    const float* bcp = (const float*)(p.ws + B_BC) + cidx * 64;
    const u16* tm = (const u16*)(p.ws + B_TM) + cidx * 4096;
    const u16* qkm = (const u16*)(p.ws + B_QKM) + cidx * 4096;
    const u16* ktp = (const u16*)(p.ws + B_KT) + (size_t)(chunk * 4 + h) * 8192;
    const float glast = gcp[63];
    size_t trow[2];
#pragma unroll
    for (int mi = 0; mi < 2; ++mi) { const int c = 32 * mi + n; trow[mi] = (size_t)(tb + (dir ? 63 - c : c)); }
#define SCHED_FENCE() asm volatile("" ::: "memory")
    u16* vls = sm + w * (64 * 40);
    __syncthreads();
#pragma unroll
    for (int jv = 0; jv < 4; ++jv) {
      const int tau = (lane >> 2) + 16 * jv, cq = lane & 3;
      const uint4 vq = *(const uint4*)(vv + (size_t)(tb + tau) * 512 + h * 128 + w * 32 + cq * 8);
      *(uint4*)(vls + (dir ? 63 - tau : tau) * 40 + cq * 8) = vq;
    }
    __syncthreads();
    f32x16 X[2], QS[2];
    {
      bf16x8 Sb[4][2];
#pragma unroll
      for (int t = 0; t < 4; ++t)
#pragma unroll
        for (int s = 0; s < 2; ++s) Sb[t][s] = pack_acc(S[t], s);
#pragma unroll
      for (int mi = 0; mi < 2; ++mi)
#pragma unroll
        for (int r = 0; r < 16; ++r) { X[mi][r] = 0.f; QS[mi][r] = 0.f; }
#pragma unroll
      for (int t = 0; t < 4; ++t) {
#pragma unroll
        for (int mi = 0; mi < 2; ++mi) {
          const u16* krow_ = kn + trow[mi] * 512 + h * 128;
          const u16* qrow_ = qn + trow[mi] * 512 + h * 128;
#pragma unroll
          for (int s = 0; s < 2; ++s) {
            X[mi] = MFMA32(load_perm(krow_ + 32 * t, s, h2), Sb[t][s], X[mi]);
            QS[mi] = MFMA32(load_perm(qrow_ + 32 * t, s, h2), Sb[t][s], QS[mi]);
          }
        }
        SCHED_FENCE();
      }
    }
    bf16x8 Rb[2][2];
#pragma unroll
    for (int mi = 0; mi < 2; ++mi) {
#pragma unroll
      for (int a = 0; a < 4; ++a) {
        const int c4 = 32 * mi + 8 * a + 4 * h2;
        const float4 g4 = *(const float4*)(gcp + c4);
        const float4 b4 = *(const float4*)(bcp + c4);
        const float gg[4] = {g4.x, g4.y, g4.z, g4.w};
        const float bb[4] = {b4.x, b4.y, b4.z, b4.w};
#pragma unroll
        for (int q = 0; q < 4; ++q) {
          const int c = c4 + q;
          const float v = bf2f(vls[c * 40 + n]);
          const float eg = __expf(gg[q]);
          X[mi][4 * a + q] = bb[q] * (v - eg * X[mi][4 * a + q]);
          QS[mi][4 * a + q] *= eg;
        }
      }
      Rb[mi][0] = pack_acc(X[mi], 0);
      Rb[mi][1] = pack_acc(X[mi], 1);
    }
    SCHED_FENCE();
    f32x16 Vn[2];
#pragma unroll
    for (int mo = 0; mo < 2; ++mo) {
#pragma unroll
      for (int r = 0; r < 16; ++r) Vn[mo][r] = 0.f;
#pragma unroll
      for (int mi = 0; mi <= mo; ++mi)
#pragma unroll
        for (int s = 0; s < 2; ++s) Vn[mo] = MFMA32(load_perm(tm + (32 * mo + n) * 64 + 32 * mi, s, h2), Rb[mi][s], Vn[mo]);
    }
    SCHED_FENCE();
    {
      bf16x8 Vb[2][2];
#pragma unroll
      for (int mi = 0; mi < 2; ++mi) { Vb[mi][0] = pack_acc(Vn[mi], 0); Vb[mi][1] = pack_acc(Vn[mi], 1); }
#pragma unroll
      for (int mo = 0; mo < 2; ++mo) {
#pragma unroll
        for (int mi = 0; mi <= mo; ++mi)
#pragma unroll
          for (int s = 0; s < 2; ++s) QS[mo] = MFMA32(load_perm(qkm + (32 * mo + n) * 64 + 32 * mi, s, h2), Vb[mi][s], QS[mo]);
      }
      __syncthreads();
#pragma unroll
      for (int mo = 0; mo < 2; ++mo)
#pragma unroll
        for (int r = 0; r < 16; ++r) vls[(32 * mo + crow(r, h2)) * 40 + n] = f2bf(QS[mo][r]);
      __syncthreads();
#pragma unroll
      for (int jv = 0; jv < 4; ++jv) {
        const int tau = (lane >> 2) + 16 * jv, cq = lane & 3;
        const uint4 oq = *(const uint4*)(vls + (dir ? 63 - tau : tau) * 40 + cq * 8);
        *(uint4*)(od + (size_t)(tb + tau) * 512 + h * 128 + w * 32 + cq * 8) = oq;
      }
    }
    SCHED_FENCE();
    bf16x8 Vsb[2][2];
#pragma unroll
    for (int mi = 0; mi < 2; ++mi) {
#pragma unroll
      for (int a = 0; a < 4; ++a) {
        const float4 g4 = *(const float4*)(gcp + 32 * mi + 8 * a + 4 * h2);
        Vn[mi][4 * a + 0] *= __expf(glast - g4.x); Vn[mi][4 * a + 1] *= __expf(glast - g4.y);
        Vn[mi][4 * a + 2] *= __expf(glast - g4.z); Vn[mi][4 * a + 3] *= __expf(glast - g4.w);
      }
      Vsb[mi][0] = pack_acc(Vn[mi], 0); Vsb[mi][1] = pack_acc(Vn[mi], 1);
    }
    const float eg = __expf(glast);
#pragma unroll
    for (int t = 0; t < 4; ++t) {
#pragma unroll
      for (int r = 0; r < 16; ++r) S[t][r] *= eg;
      const u16* ktrow = ktp + (32 * t + n) * 64;
#pragma unroll
      for (int mi = 0; mi < 2; ++mi)
#pragma unroll
        for (int s = 0; s < 2; ++s) {
          bf16x8 a = dir ? load_perm_rev(ktrow, 32 * mi, s, h2) : load_perm(ktrow + 32 * mi, s, h2);
          S[t] = MFMA32(a, Vsb[mi][s], S[t]);
        }
      SCHED_FENCE();
    }
  }
  if (seq < 32) {
    float* so = p.out + O_SD + ((size_t)((seq * 4 + l) * 2 + dir) * 4 + h) * 16384;
#pragma unroll
    for (int t = 0; t < 4; ++t)
#pragma unroll
      for (int r = 0; r < 16; ++r) so[(size_t)(32 * t + crow(r, h2)) * 128 + dvc] = S[t][r];
  }
}

DI void attn_tile(const Params& p, int seq, int head, int qb) {
  const int lane = otid() & 63, w = otid() >> 6;
  const int n = lane & 31, h2 = lane >> 5;
  int tq0, nkeys; size_t kbo, vto;
  if (seq < 32) { tq0 = seq * 256 + qb * 128 + w * 32; nkeys = 256; kbo = (size_t)(seq * 8 + head) * 256 * 96; vto = (size_t)(seq * 8 + head) * 64 * 256; }
  else { const int s = seq - 32; tq0 = TP_ + s * 2048 + qb * 128 + w * 32; nkeys = 2304; kbo = KB_P + (size_t)(s * 8 + head) * 2304 * 96; vto = VT_P + (size_t)(s * 8 + head) * 64 * 2304; }
  const u16* kb = (const u16*)(p.ws + B_KB) + kbo;
  const u16* vt = (const u16*)(p.ws + B_VT) + vto;
  const u16* qm = (const u16*)(p.ws + B_QM) + (size_t)(tq0 + n) * 768 + head * 96;
  bf16x8 qf[6];
#pragma unroll
  for (int ks = 0; ks < 6; ++ks) qf[ks] = *(const bf16x8*)(qm + ks * 16 + h2 * 8);
  f32x16 O[2];
#pragma unroll
  for (int r = 0; r < 16; ++r) { O[0][r] = 0.f; O[1][r] = 0.f; }
  float mrun = -1e30f, lsum = 0.f;
  const int nkt = nkeys >> 6;
  for (int kt = 0; kt < nkt; ++kt) {
    f32x16 St[2];
#pragma unroll
    for (int sub = 0; sub < 2; ++sub) {
#pragma unroll
      for (int r = 0; r < 16; ++r) St[sub][r] = 0.f;
      const u16* kr = kb + (size_t)(kt * 64 + sub * 32 + n) * 96 + h2 * 8;
#pragma unroll
      for (int ks = 0; ks < 6; ++ks) St[sub] = MFMA32(*(const bf16x8*)(kr + ks * 16), qf[ks], St[sub]);
    }
    float mx = St[0][0];
#pragma unroll
    for (int r = 0; r < 16; ++r) { mx = fmaxf(mx, St[0][r]); mx = fmaxf(mx, St[1][r]); }
    mx = fmaxf(mx, __shfl_xor(mx, 32));
    const float mnew = fmaxf(mrun, mx);
    const float alpha = exp2f(mrun - mnew);
    mrun = mnew;
    float ps = 0.f;
#pragma unroll
    for (int sub = 0; sub < 2; ++sub)
#pragma unroll
      for (int r = 0; r < 16; ++r) { float e = exp2f(St[sub][r] - mnew); St[sub][r] = e; ps += e; }
    lsum = lsum * alpha + ps;
#pragma unroll
    for (int r = 0; r < 16; ++r) { O[0][r] *= alpha; O[1][r] *= alpha; }
#pragma unroll
    for (int sub = 0; sub < 2; ++sub)
#pragma unroll
      for (int s = 0; s < 2; ++s) {
        const bf16x8 pb = pack_acc(St[sub], s);
#pragma unroll
        for (int dt = 0; dt < 2; ++dt)
          O[dt] = MFMA32(load_perm(vt + (size_t)(dt * 32 + n) * nkeys + kt * 64 + sub * 32, s, h2), pb, O[dt]);
      }
  }
  lsum += __shfl_xor(lsum, 32);
  const float inv = 1.f / lsum;
  u16* oc = (u16*)(p.ws + B_OC) + (size_t)(tq0 + n) * 512 + head * 64;
#pragma unroll
  for (int dt = 0; dt < 2; ++dt)
#pragma unroll
    for (int a = 0; a < 4; ++a) {
      const int dv = dt * 32 + 8 * a + 4 * h2;
      *(uint2*)(oc + dv) = make_uint2(pack2(O[dt][4 * a] * inv, O[dt][4 * a + 1] * inv), pack2(O[dt][4 * a + 2] * inv, O[dt][4 * a + 3] * inv));
    }
}

DI void delta_out_tile(const Params& p, int l, int tile) {
  const int lane = otid() & 63, w = otid() >> 6;
  const u16* of = (const u16*)(p.ws + B_OF);
  const u16* ob = (const u16*)(p.ws + B_OB);
  const u16* z = (const u16*)(p.ws + B_Z);
  u16* oa = (u16*)(p.ws + B_OA);
  const float g0 = p.in[17][l * 128 + 2 * lane], g1 = p.in[17][l * 128 + 2 * lane + 1];
#pragma unroll 1
  for (int q = 0; q < 16; ++q) {
    const size_t t = (size_t)tile * 16 + w * 4 + (q >> 2);
    const int hh = q & 3;
    const size_t off = t * 512 + hh * 128 + 2 * lane;
    unsigned a = *(const unsigned*)(of + off), b = *(const unsigned*)(ob + off), zz = *(const unsigned*)(z + off);
    float o0 = blo(a) + blo(b), o1 = bhi(a) + bhi(b);
    float ss = wave_sum(o0 * o0 + o1 * o1);
    float rstd = rsqrtf(ss * (1.f / 128.f) + 1e-6f);
    float y0 = o0 * rstd * g0 * siluf_(blo(zz)), y1 = o1 * rstd * g1 * siluf_(bhi(zz));
    *(unsigned*)(oa + off) = pack2(y0, y1);
  }
}

DI void grid_barrier(unsigned* bar, unsigned target) {
  __threadfence();
  asm volatile("s_waitcnt vmcnt(0) lgkmcnt(0)" ::: "memory");
  __syncthreads();
  if (otid() == 0) {
    __hip_atomic_fetch_add(bar, 1u, __ATOMIC_RELEASE, __HIP_MEMORY_SCOPE_AGENT);
    while (__hip_atomic_load(bar, __ATOMIC_RELAXED, __HIP_MEMORY_SCOPE_AGENT) < target) __builtin_amdgcn_s_sleep(2);
    __builtin_amdgcn_fence(__ATOMIC_ACQUIRE, "agent");
    asm volatile("s_waitcnt vmcnt(0)" ::: "memory");
  }
  __syncthreads();
  __threadfence();
  asm volatile("s_waitcnt vmcnt(0)" ::: "memory");
}
#define GSYNC() do { bar_target += gridDim.x; grid_barrier(p.bar, bar_target); } while (0)
#ifndef ONLY
#define PH(n) 1
#else
#define PH(n) ((n) == ONLY || (n) / 100 == ONLY || (n) == ONLY / 100)
#endif
__global__ void __launch_bounds__(256, 2) mega(Params p) {
  cg::grid_group grid = cg::this_grid();
  __shared__ __attribute__((aligned(16))) char smem_raw[73728];
  u16* sm = (u16*)smem_raw;
  float* smf = (float*)smem_raw;
  const int nb = gridDim.x, bid = blockIdx.x;
  unsigned bar_target = 0;
  grid.sync();

  if (PH(0)) {
    const int tid = otid();
    for (int j = bid; j < 4 * CJ8; j += nb) conv_job(p, j / CJ8, j % CJ8, smf);
    for (int j = bid; j < 4 * 96; j += nb) mods_tile(p, j / 96, j % 96, smf);
    for (int j = bid; j < 64; j += nb) s5pre_tile(p, j);
    {
      const float4* xp = (const float4*)p.in[0];
      const float4* xs = (const float4*)p.in[1];
      float4* o = (float4*)p.out;
      const size_t nP = (size_t)TP_ * 256, nT = (size_t)T_ * 256;
      for (size_t i = (size_t)bid * 256 + tid; i < nT; i += (size_t)nb * 256) o[i] = i < nP ? xp[i] : xs[i - nP];
    }
    {
      float* rope = (float*)(p.ws + B_ROPE);
      for (int i = bid * 256 + tid; i < 2048 * 16; i += nb * 256) {
        const int pos = i >> 4, f = i & 15;
        const float invf = 1.f / powf(10000.f, (float)(f & 7) * 0.125f);
        const float ang = (f < 8 ? (float)(pos >> 6) : (float)(pos & 63)) * invf;
        float sn, cs;
        sincosf(ang, &sn, &cs);
        rope[i * 2] = cs; rope[i * 2 + 1] = sn;
      }
    }
    {
      u16* cc = (u16*)(p.ws + B_CKVC);
      for (int i = bid * 256 + tid; i < 8 * 4 * 256 * 256 / 2; i += nb * 256) {
        const int e = i * 2;
        const int c = e & 255, pos = (e >> 8) & 255, l = (e >> 16) & 3, b = e >> 18;
        float2 v = *(const float2*)(p.in[5] + e);
        *(unsigned*)(cc + ((size_t)(l * 2048 + b * 256 + pos)) * 256 + c) = pack2(v.x, v.y);
      }
    }
  }
  GSYNC();

  for (int l = 0; l < 4; ++l) {
    const u16* WL = (const u16*)(p.ws + B_W) + (size_t)l * W_LAYER;
    const float* mods = (const float*)(p.ws + B_MODS);
    if (PH(1)) norm_phase(p, l, 0, 1, p.in[11] + l * 1024);
    GSYNC();
    if (PH(2)) gemm_in_phase(p, l, sm);
    GSYNC();
    if (PH(3)) {
      for (int j = bid; j < NCH; j += nb) delta_prep_tile(p, l, j, sm);
      for (int j = bid; j < T_ / 4; j += nb) mla_prep_tile(p, l, j);
      for (int j = bid; j < 256; j += nb) cache_rope_tile(p, l, j);
      for (int j = bid; j < NCH * 16; j += nb) s5_chunk_tile(p, l, j >> 4, j & 15, 0, sm);
    }
    GSYNC();
    if (PH(4)) {
      const int tid = otid();
      if (PH(400)) for (int j = bid; j < NCH * 2; j += nb) delta_local_tile(p, j, smf);
      if (PH(410)) for (int j = bid; j < 192 * 6; j += nb) {
          const int q = j, mt = q / 6, nt = q % 6;
          f32x4 acc[4][4];
          zero_acc<4>(acc);
          gemm_core<4>(acc, (const u16*)(p.ws + B_QA) + (size_t)mt * 128 * 384, 384, WL + W_QB + (size_t)nt * 128 * 384, 384, 384, sm);
          u16* qm = (u16*)(p.ws + B_QM);
          const float qs = 0.10206207261596575f * 1.4426950408889634f;
          const float* rope = (const float*)(p.ws + B_ROPE);
          const int e_lane = tid & 63, e_w = tid >> 6, e_wr = e_w >> 1, e_wc = e_w & 1, e_fr = e_lane & 15, e_fq = e_lane >> 4;
          const bool is_s = (mt * 128 >= TP_);
#pragma unroll
          for (int i = 0; i < 4; ++i)
#pragma unroll
            for (int r = 0; r < 4; ++r) {
              const int row = mt * 128 + e_wr * 64 + i * 16 + e_fq * 4 + r;
              float vals[4];
#pragma unroll
              for (int jj = 0; jj < 4; ++jj) vals[jj] = acc[i][jj][r];
              if (is_s) {
                const int pos = (row - TP_) & 2047;
                const float cs = rope[(pos * 16 + e_fr) * 2], sn = rope[(pos * 16 + e_fr) * 2 + 1];
#pragma unroll
                for (int jj = 0; jj < 4; jj += 2) {
                  const int gt = (nt * 128 + e_wc * 64) / 16 + jj;
                  if (gt % 6 == 4) {
                    const float x1 = vals[jj], x2 = vals[jj + 1];
                    vals[jj] = x1 * cs - x2 * sn;
                    vals[jj + 1] = x2 * cs + x1 * sn;
                  }
                }
              }
#pragma unroll
              for (int jj = 0; jj < 4; ++jj) qm[(size_t)row * 768 + nt * 128 + e_wc * 64 + jj * 16 + e_fr] = f2bf(vals[jj] * qs);
            }
      }
      if (PH(420)) for (int j = bid; j < 208 * 8; j += nb) {
          const int q = j, mt = q >> 3, head = q & 7;
          f32x4 acc[4][4];
          zero_acc<4>(acc);
          const u16* A = mt < 192 ? (const u16*)(p.ws + B_KVA) + (size_t)mt * 128 * 256
                                  : (const u16*)(p.ws + B_CKVC) + ((size_t)l * 2048 + (size_t)(mt - 192) * 128) * 256;
          gemm_core<4>(acc, A, 256, WL + W_KVB + (size_t)head * 128 * 256, 256, 256, sm);
          int key0, nkeys; size_t kbo, vto;
          if (mt < 64) { const int seq = mt >> 1; key0 = (mt & 1) * 128; nkeys = 256; kbo = (size_t)(seq * 8 + head) * 256 * 96; vto = (size_t)(seq * 8 + head) * 64 * 256; }
          else if (mt < 192) { const int s = (mt - 64) >> 4; key0 = 256 + ((mt - 64) & 15) * 128; nkeys = 2304; kbo = KB_P + (size_t)(s * 8 + head) * 2304 * 96; vto = VT_P + (size_t)(s * 8 + head) * 64 * 2304; }
          else { const int s = (mt - 192) >> 1; key0 = ((mt - 192) & 1) * 128; nkeys = 2304; kbo = KB_P + (size_t)(s * 8 + head) * 2304 * 96; vto = VT_P + (size_t)(s * 8 + head) * 64 * 2304; }
          u16* kb = (u16*)(p.ws + B_KB) + kbo;
          u16* vt = (u16*)(p.ws + B_VT) + vto;
          const int e_lane = tid & 63, e_w = tid >> 6, e_wr = e_w >> 1, e_wc = e_w & 1, e_fr = e_lane & 15, e_fq = e_lane >> 4;
#pragma unroll
          for (int i = 0; i < 4; ++i)
#pragma unroll
            for (int jj = 0; jj < 4; ++jj) {
              const int key = key0 + e_wr * 64 + i * 16 + e_fq * 4;
              const int c = jj * 16 + e_fr;
              if (e_wc == 0) {
#pragma unroll
                for (int r = 0; r < 4; ++r) kb[(size_t)(key + r) * 96 + c] = f2bf(acc[i][jj][r]);
              } else {
                *(uint2*)(vt + (size_t)c * nkeys + key) = make_uint2(pack2(acc[i][jj][0], acc[i][jj][1]), pack2(acc[i][jj][2], acc[i][jj][3]));
              }
            }
      }
      if (PH(430)) for (int j = bid; j < 640; j += nb) s5_carry_tile(p, l, j);
    }
    GSYNC();
    if (PH(5)) {
      if (PH(500)) for (int j = bid; j < 320; j += nb) delta_scan_tile(p, l, j, sm);
      if (PH(510)) for (int j = bid; j < 1536; j += nb) {
        if (j < 1024) attn_tile(p, 32 + (j >> 7), (j >> 4) & 7, j & 15);
        else { const int q = j - 1024; attn_tile(p, q >> 4, (q >> 1) & 7, q & 1); }
      }
      if (PH(530)) for (int j = bid; j < NCH * 8; j += nb) {
        s5_chunk_tile(p, l, j >> 3, (j & 7) * 2, 1, sm);
        s5_chunk_tile(p, l, j >> 3, (j & 7) * 2 + 1, 1, sm);
      }
    }
    GSYNC();
    if (PH(6)) {
      for (int j = bid; j < T_ / 16; j += nb) delta_out_tile(p, l, j);
      for (int j = bid; j < 192 * 4; j += nb) {
        {
          const int q = j, mt = q >> 2, nt = q & 3;
          f32x4 acc[4][4];
          zero_acc<4>(acc);
          const u16* y5 = (const u16*)(p.ws + B_Y5);
          gemm_core<4>(acc, y5 + (size_t)mt * 128 * 512, 512, WL + W_GLU + (size_t)nt * 128 * 512, 512, 512, sm);
          u16* ob5 = (u16*)(p.ws + B_OB5);
          const float* bgl = p.in[27] + l * 512;
          EPI_LOOP(4) {
            const size_t row = mt * 128 + EROW; const int col = nt * 128 + ECOL(4);
            const float y = bf2f(y5[row * 512 + col]);
            ob5[row * 512 + col] = f2bf(y * sigmoidf_(acc[i][j][r] + bgl[col]));
          }
        }
      }
    }
    GSYNC();
    if (PH(7)) {
      const u16* H = (const u16*)(p.ws + B_H);
      u16* mg = (u16*)(p.ws + B_MG);
      for (int j = bid; j < 192 * 16; j += nb) {
        const int mt = j >> 4, nt = j & 15;
        f32x4 mer[4][2];
        zero_acc<2>(mer);
#pragma unroll 1
        for (int n = 0; n < 3; ++n) {
          f32x4 ag[4][2], ab[4][2];
          zero_acc<2>(ag);
          gemm_core<2>(ag, H + (size_t)mt * 128 * 1024, 1024, WL + W_G + (size_t)(n * 1024 + nt * 64) * 1024, 1024, 1024, sm);
          zero_acc<2>(ab);
          const u16* on = (const u16*)(p.ws + (n == 0 ? B_OA : (n == 1 ? B_OB5 : B_OC)));
          gemm_core<2>(ab, on + (size_t)mt * 128 * 512, 512, WL + W_BR + (size_t)(nt * 64) * 1536 + n * 512, 1536, 512, sm);
#pragma unroll
          for (int i = 0; i < 4; ++i)
#pragma unroll
            for (int jj = 0; jj < 2; ++jj)
#pragma unroll
              for (int r = 0; r < 4; ++r) mer[i][jj][r] += sigmoidf_(ag[i][jj][r]) * ab[i][jj][r];
        }
        EPI_LOOP(2) { mg[(size_t)(mt * 128 + EROW) * 1024 + nt * 64 + ECOL(2)] = f2bf(mer[i][j][r]); }
      }
    }
    GSYNC();
    if (PH(8)) {
      const u16* mg = (const u16*)(p.ws + B_MG);
      for (int j = bid; j < 192 * 8; j += nb) {
        const int mt = j >> 3, nt = j & 7;
        f32x4 acc[4][4];
        zero_acc<4>(acc);
        gemm_core<4>(acc, mg + (size_t)mt * 128 * 1024, 1024, WL + W_OUT + (size_t)nt * 128 * 1024, 1024, 1024, sm);
        const float* gm = mods + (size_t)(l * 9 + tok_v(mt * 128)) * 6144 + 2 * 1024;
        EPI_LOOP(4) {
          const size_t row = mt * 128 + EROW; const int col = nt * 128 + ECOL(4);
          p.out[row * 1024 + col] += gm[col] * acc[i][j][r];
        }
      }
    }
    GSYNC();
    if (PH(9)) norm_phase(p, l, 3, 4, p.in[12] + l * 1024);
    GSYNC();
    if (PH(10)) {
      const u16* H = (const u16*)(p.ws + B_H);
      u16* up = (u16*)(p.ws + B_UP);
      for (int j = bid; j < 192 * 44; j += nb) {
        const int mt = j / 44, nt = j % 44;
        f32x4 acc[4][4];
        zero_acc<4>(acc);
        gemm_core<4>(acc, H + (size_t)mt * 128 * 1024, 1024, WL + W_UP + (size_t)nt * 128 * 1024, 1024, 1024, sm);
        EPI_LOOP(4) { up[(size_t)(mt * 128 + EROW) * 5632 + nt * 128 + ECOL(4)] = f2bf(acc[i][j][r]); }
      }
    }
    GSYNC();
    if (PH(11)) {
      const int tid = otid();
      const u16* up = (const u16*)(p.ws + B_UP);
      u16* act = (u16*)(p.ws + B_ACT);
      const float* cw = p.in[35] + (size_t)l * 3 * 5632;
      const float* cb = p.in[36] + (size_t)l * 5632;
      for (size_t it = (size_t)bid * 256 + tid; it < (size_t)T_ * 352; it += (size_t)nb * 256) {
        const int t = (int)(it / 352), c8 = (int)(it % 352) * 8;
        int pos, L;
        if (t < TP_) { pos = t & 255; L = 256; } else { pos = (t - TP_) & 2047; L = 2048; }
        float res[8];
        float gv[8], vv2[8];
#pragma unroll
        for (int e = 0; e < 8; ++e) { gv[e] = cb[c8 + e]; vv2[e] = cb[2816 + c8 + e]; }
#pragma unroll
        for (int d = 0; d < 3; ++d) {
          const int ps = pos + d - 1;
          if (ps < 0 || ps >= L) continue;
          const u16* rowp = up + (size_t)(t + d - 1) * 5632;
          uint4 ug = *(const uint4*)(rowp + c8);
          uint4 uv = *(const uint4*)(rowp + 2816 + c8);
          const unsigned ugs[4] = {ug.x, ug.y, ug.z, ug.w}, uvs[4] = {uv.x, uv.y, uv.z, uv.w};
#pragma unroll
          for (int e = 0; e < 4; ++e) {
            gv[2 * e] += cw[d * 5632 + c8 + 2 * e] * blo(ugs[e]);
            gv[2 * e + 1] += cw[d * 5632 + c8 + 2 * e + 1] * bhi(ugs[e]);
            vv2[2 * e] += cw[d * 5632 + 2816 + c8 + 2 * e] * blo(uvs[e]);
            vv2[2 * e + 1] += cw[d * 5632 + 2816 + c8 + 2 * e + 1] * bhi(uvs[e]);
          }
        }
#pragma unroll
        for (int e = 0; e < 8; ++e) res[e] = siluf_(gv[e]) * vv2[e];
        *(uint4*)(act + (size_t)t * 2816 + c8) = make_uint4(pack2(res[0], res[1]), pack2(res[2], res[3]), pack2(res[4], res[5]), pack2(res[6], res[7]));
      }
    }
    GSYNC();
    if (PH(12)) {
      const u16* act = (const u16*)(p.ws + B_ACT);
      for (int j = bid; j < 192 * 8; j += nb) {
        const int mt = j >> 3, nt = j & 7;
        f32x4 acc[4][4];
        zero_acc<4>(acc);
        gemm_core<4>(acc, act + (size_t)mt * 128 * 2816, 2816, WL + W_DN + (size_t)nt * 128 * 2816, 2816, 2816, sm);
        const float* gf = mods + (size_t)(l * 9 + tok_v(mt * 128)) * 6144 + 5 * 1024;
        EPI_LOOP(4) {
          const size_t row = mt * 128 + EROW; const int col = nt * 128 + ECOL(4);
          p.out[row * 1024 + col] += gf[col] * acc[i][j][r];
        }
      }
    }
    GSYNC();
  }
  if (PH(13)) {
    const int tid = otid();
    const int lane = tid & 63, w = tid >> 6;
    const float* gfin = p.in[38];
    for (int tile = bid; tile < T_ / 4; tile += nb) {
      const int t = tile * 4 + w;
      float4* xr = (float4*)(p.out + (size_t)t * 1024);
      float4 v[4];
      float ss = 0.f;
#pragma unroll
      for (int j = 0; j < 4; ++j) { v[j] = xr[lane + 64 * j]; ss += v[j].x * v[j].x + v[j].y * v[j].y + v[j].z * v[j].z + v[j].w * v[j].w; }
      ss = wave_sum(ss);
      const float rstd = rsqrtf(ss * (1.f / 1024.f) + 1e-6f);
#pragma unroll
      for (int j = 0; j < 4; ++j) {
        float4 g = *(const float4*)(gfin + (lane + 64 * j) * 4);
        xr[lane + 64 * j] = make_float4(v[j].x * rstd * g.x, v[j].y * rstd * g.y, v[j].z * rstd * g.z, v[j].w * rstd * g.w);
      }
    }
  }
}

extern "C" void kernel_launch(void* const* d_in, const int* in_sizes, int n_in, void* d_out, int out_size,
                              void* d_ws, size_t ws_size, hipStream_t stream) {
  static int grid_blocks = 0;
  if (!grid_blocks) {
    int dev = 0, cus = 0, per_cu = 0;
    (void)hipGetDevice(&dev);
    (void)hipDeviceGetAttribute(&cus, hipDeviceAttributeMultiprocessorCount, dev);
    (void)hipOccupancyMaxActiveBlocksPerMultiprocessor(&per_cu, mega, 256, 0);
    if (per_cu > 2) per_cu = 2;
    if (per_cu < 1) per_cu = 1;
    grid_blocks = cus * per_cu;
  }
  if (ws_size < B_TOTAL || n_in < 39) {
    fprintf(stderr, "workspace too small: %zu < %zu\n", ws_size, (size_t)B_END);
    return;
  }
  Params p{};
  for (int i = 0; i < 39; ++i) p.in[i] = (const float*)d_in[i];
  p.out = (float*)d_out;
  p.ws = (char*)d_ws;
  p.bar = (unsigned*)((char*)d_ws + B_BAR);
  (void)hipMemsetAsync(p.bar, 0, 256, stream);
  void* args[] = {&p};
  hipError_t e = hipLaunchCooperativeKernel((void*)mega, dim3(grid_blocks), dim3(256), args, 0, stream);
  if (e != hipSuccess) fprintf(stderr, "cooperative launch failed: %s (grid %d)\n", hipGetErrorString(e), grid_blocks);
}
```

```cpp
#include <hip/hip_runtime.h>
#include <hip/hip_cooperative_groups.h>
#include <cstdio>
namespace cg = cooperative_groups;

#define DI __device__ __forceinline__
typedef __bf16 bf16;
using bf16x8 = __attribute__((ext_vector_type(8))) short;
using f32x4 = __attribute__((ext_vector_type(4))) float;
using f32x16 = __attribute__((ext_vector_type(16))) float;
typedef unsigned short u16;

constexpr int T_ = 24576, TP_ = 8192;
constexpr int NCH = 384;
constexpr long long O_SD = 25165824LL, O_S5RE = 41943040LL, O_S5IM = 42467328LL, O_CKV = 42991616LL, O_KR = 51380224LL;

constexpr size_t W_IN = 0;
constexpr size_t W_G = W_IN + 3328ull * 1024;
constexpr size_t W_QB = W_G + 3072ull * 1024;
constexpr size_t W_KVB = W_QB + 768ull * 384;
constexpr size_t W_GLU = W_KVB + 1024ull * 256;
constexpr size_t W_BR = W_GLU + 512ull * 512;
constexpr size_t W_OUT = W_BR + 1024ull * 1536;
constexpr size_t W_UP = W_OUT + 1024ull * 1024;
constexpr size_t W_DN = W_UP + 5632ull * 1024;
constexpr size_t W_LAYER = W_DN + 1024ull * 2816;

constexpr size_t al(size_t x) { return (x + 255) & ~(size_t)255; }
constexpr size_t B_W = 0;
constexpr size_t B_MODS = al(B_W + 4 * W_LAYER * 2);
constexpr size_t B_ROPE = al(B_MODS + 4ull * 9 * 6144 * 4);
constexpr size_t B_LAMB = al(B_ROPE + 2048ull * 32 * 4);
constexpr size_t B_LAM64 = al(B_LAMB + 4ull * 2 * 32 * 64 * 8);
constexpr size_t B_BBT = al(B_LAM64 + 4ull * 2 * 32 * 64 * 8);
constexpr size_t B_CMT = al(B_BBT + 4ull * 2 * 32 * 128 * 16 * 2);
constexpr size_t B_CKVC = al(B_CMT + 4ull * 32 * 16 * 128 * 2);
constexpr size_t B_H = al(B_CKVC + 4ull * 2048 * 256 * 2);
constexpr size_t B_QKV = al(B_H + (size_t)T_ * 1024 * 2);
constexpr size_t B_Z = al(B_QKV + (size_t)T_ * 1536 * 2);
constexpr size_t B_US5 = al(B_Z + (size_t)T_ * 512 * 2);
constexpr size_t B_QA = al(B_US5 + (size_t)T_ * 512 * 2);
constexpr size_t B_KVA = al(B_QA + (size_t)T_ * 384 * 2);
constexpr size_t B_MISC = al(B_KVA + (size_t)T_ * 256 * 2);
constexpr size_t B_QN = al(B_MISC + (size_t)T_ * 48 * 4);
constexpr size_t B_KN = al(B_QN + (size_t)T_ * 512 * 2);
constexpr size_t B_VV = al(B_KN + (size_t)T_ * 512 * 2);
constexpr size_t B_KT = al(B_VV + (size_t)T_ * 512 * 2);
constexpr size_t B_BG = al(B_KT + (size_t)T_ * 512 * 2);
constexpr size_t B_TM = al(B_BG + (size_t)T_ * 16 * 4);
constexpr size_t B_QKM = al(B_TM + (size_t)T_ * 512 * 2);
constexpr size_t B_GC = al(B_QKM + (size_t)T_ * 512 * 2);
constexpr size_t B_BC = al(B_GC + (size_t)NCH * 4 * 2 * 64 * 4);
constexpr size_t KB_P = 32ull * 8 * 256 * 96, KB_S = 8ull * 8 * 2304 * 96;
constexpr size_t VT_P = 32ull * 8 * 64 * 256, VT_S = 8ull * 8 * 64 * 2304;
constexpr size_t B_KB = al(B_BC + (size_t)NCH * 4 * 2 * 64 * 4);
constexpr size_t B_VT = al(B_KB + (KB_P + KB_S) * 2);
constexpr size_t B_QM = al(B_VT + (VT_P + VT_S) * 2);
constexpr size_t B_HEND = al(B_QM + (size_t)T_ * 768 * 2);
constexpr size_t B_HIN = al(B_HEND + (size_t)NCH * 32 * 2 * 64 * 8);
constexpr size_t B_Y5 = al(B_HIN + (size_t)NCH * 32 * 2 * 64 * 8);
constexpr size_t B_OC = al(B_Y5 + (size_t)T_ * 512 * 2);
constexpr size_t B_END = al(B_OC + (size_t)T_ * 512 * 2);
constexpr size_t B_OF = B_QKV;
constexpr size_t B_OB = B_QKV + (size_t)T_ * 512 * 2;
constexpr size_t B_MG = B_QKV;
constexpr size_t B_OA = B_QN;
constexpr size_t B_OB5 = B_KN;
constexpr size_t B_UP = B_QKV;
constexpr size_t B_ACT = B_KB;
static_assert(B_UP + (size_t)T_ * 5632 * 2 <= B_KB, "UP overlaps ACT");
static_assert(B_ACT + (size_t)T_ * 2816 * 2 <= B_END, "ACT too big");
constexpr size_t B_BAR = B_END;
constexpr size_t B_TOTAL = B_BAR + 256;
static_assert(B_TOTAL <= 768ull * 1024 * 1024, "workspace too big");

struct Params {
  const float* in[39];
  float* out;
  char* ws;
  unsigned* bar;
};

DI int otid() { int t = (int)__builtin_amdgcn_workitem_id_x(); asm volatile("" : "+v"(t)); return t; }
DI unsigned pack2(float a, float b) {
  typedef __attribute__((ext_vector_type(2))) __bf16 bf2;
  bf2 v; v[0] = (__bf16)a; v[1] = (__bf16)b;
  return __builtin_bit_cast(unsigned, v);
}
DI u16 f2bf(float a) { return (u16)(pack2(a, 0.f) & 0xffffu); }
DI float bf2f(u16 u) { return __uint_as_float(((unsigned)u) << 16); }
DI float blo(unsigned u) { return __uint_as_float(u << 16); }
DI float bhi(unsigned u) { return __uint_as_float(u & 0xffff0000u); }
DI float wave_sum(float v) {
#pragma unroll
  for (int o = 32; o > 0; o >>= 1) v += __shfl_xor(v, o);
  return v;
}
DI float sigmoidf_(float x) { return 1.f / (1.f + __expf(-x)); }
DI float siluf_(float x) { return x / (1.f + __expf(-x)); }
DI int tok_v(int t) { return t < TP_ ? 0 : 1 + ((t - TP_) >> 11); }
DI int crow(int r, int h2) { return (r & 3) + 8 * (r >> 2) + 4 * h2; }
DI bf16x8 mk8(unsigned a, unsigned b, unsigned c, unsigned d) {
  uint4 p = make_uint4(a, b, c, d);
  return __builtin_bit_cast(bf16x8, p);
}
DI bf16x8 pack_acc(const f32x16& x, int s) {
  return mk8(pack2(x[8 * s], x[8 * s + 1]), pack2(x[8 * s + 2], x[8 * s + 3]), pack2(x[8 * s + 4], x[8 * s + 5]),
             pack2(x[8 * s + 6], x[8 * s + 7]));
}
DI bf16x8 load_perm(const u16* rowptr, int s, int h2) {
  uint2 a = *(const uint2*)(rowptr + 16 * s + 4 * h2);
  uint2 b = *(const uint2*)(rowptr + 16 * s + 8 + 4 * h2);
  return mk8(a.x, a.y, b.x, b.y);
}
DI unsigned swap16(unsigned u) { return (u >> 16) | (u << 16); }
DI bf16x8 load_perm_rev(const u16* rowptr, int base, int s, int h2) {
  uint2 a = *(const uint2*)(rowptr + 60 - base - 16 * s - 4 * h2);
  uint2 b = *(const uint2*)(rowptr + 52 - base - 16 * s - 4 * h2);
  return mk8(swap16(a.y), swap16(a.x), swap16(b.y), swap16(b.x));
}
#define MFMA16(a, b, c) __builtin_amdgcn_mfma_f32_16x16x32_bf16((a), (b), (c), 0, 0, 0)
#define MFMA32(a, b, c) __builtin_amdgcn_mfma_f32_32x32x16_bf16((a), (b), (c), 0, 0, 0)

template <int NJ>
DI void gemm_core(f32x4 (&acc)[4][NJ], const u16* __restrict__ A, int lda, const u16* __restrict__ B, int ldb, int K,
                  u16* sm) {
  const int tid = otid(), lane = tid & 63, w = tid >> 6, wr = w >> 1, wc = w & 1;
  const int fr = lane & 15, fq = lane >> 4;
  constexpr int RS = 136;
  const int lrow = tid >> 4, lkc = tid & 15;
  uint4 a0, a1, a2, a3, a4, a5, a6, a7, b0, b1, b2, b3, b4, b5, b6, b7;
  b4 = b5 = b6 = b7 = make_uint4(0, 0, 0, 0);
  const u16* ap = A + (size_t)lrow * lda + lkc * 8;
  const u16* bp = B + (size_t)lrow * ldb + lkc * 8;
  const int nk = K >> 7;
  u16* as = sm;
  u16* bs = sm + 128 * RS;
  {
    const int k0 = 0;
    a0 = *(const uint4*)(ap + (size_t)(0 * 16) * lda + k0);
    a1 = *(const uint4*)(ap + (size_t)(1 * 16) * lda + k0);
    a2 = *(const uint4*)(ap + (size_t)(2 * 16) * lda + k0);
    a3 = *(const uint4*)(ap + (size_t)(3 * 16) * lda + k0);
    a4 = *(const uint4*)(ap + (size_t)(4 * 16) * lda + k0);
    a5 = *(const uint4*)(ap + (size_t)(5 * 16) * lda + k0);
    a6 = *(const uint4*)(ap + (size_t)(6 * 16) * lda + k0);
    a7 = *(const uint4*)(ap + (size_t)(7 * 16) * lda + k0);
    b0 = *(const uint4*)(bp + (size_t)(0 * 16) * ldb + k0);
    b1 = *(const uint4*)(bp + (size_t)(1 * 16) * ldb + k0);
    b2 = *(const uint4*)(bp + (size_t)(2 * 16) * ldb + k0);
    b3 = *(const uint4*)(bp + (size_t)(3 * 16) * ldb + k0);
    if (NJ == 4) b4 = *(const uint4*)(bp + (size_t)(4 * 16) * ldb + k0);
    if (NJ == 4) b5 = *(const uint4*)(bp + (size_t)(5 * 16) * ldb + k0);
    if (NJ == 4) b6 = *(const uint4*)(bp + (size_t)(6 * 16) * ldb + k0);
    if (NJ == 4) b7 = *(const uint4*)(bp + (size_t)(7 * 16) * ldb + k0);
  }
  for (int kt = 0; kt < nk; ++kt) {
    __syncthreads();
    *(uint4*)(as + (lrow + 0 * 16) * RS + lkc * 8) = a0;
    *(uint4*)(as + (lrow + 1 * 16) * RS + lkc * 8) = a1;
    *(uint4*)(as + (lrow + 2 * 16) * RS + lkc * 8) = a2;
    *(uint4*)(as + (lrow + 3 * 16) * RS + lkc * 8) = a3;
    *(uint4*)(as + (lrow + 4 * 16) * RS + lkc * 8) = a4;
    *(uint4*)(as + (lrow + 5 * 16) * RS + lkc * 8) = a5;
    *(uint4*)(as + (lrow + 6 * 16) * RS + lkc * 8) = a6;
    *(uint4*)(as + (lrow + 7 * 16) * RS + lkc * 8) = a7;
    *(uint4*)(bs + (lrow + 0 * 16) * RS + lkc * 8) = b0;
    *(uint4*)(bs + (lrow + 1 * 16) * RS + lkc * 8) = b1;
    *(uint4*)(bs + (lrow + 2 * 16) * RS + lkc * 8) = b2;
    *(uint4*)(bs + (lrow + 3 * 16) * RS + lkc * 8) = b3;
    if (NJ == 4) *(uint4*)(bs + (lrow + 4 * 16) * RS + lkc * 8) = b4;
    if (NJ == 4) *(uint4*)(bs + (lrow + 5 * 16) * RS + lkc * 8) = b5;
    if (NJ == 4) *(uint4*)(bs + (lrow + 6 * 16) * RS + lkc * 8) = b6;
    if (NJ == 4) *(uint4*)(bs + (lrow + 7 * 16) * RS + lkc * 8) = b7;
    __syncthreads();
    {
      const int k0 = (kt + 1 < nk ? kt + 1 : kt) * 128;
    a0 = *(const uint4*)(ap + (size_t)(0 * 16) * lda + k0);
    a1 = *(const uint4*)(ap + (size_t)(1 * 16) * lda + k0);
    a2 = *(const uint4*)(ap + (size_t)(2 * 16) * lda + k0);
    a3 = *(const uint4*)(ap + (size_t)(3 * 16) * lda + k0);
    a4 = *(const uint4*)(ap + (size_t)(4 * 16) * lda + k0);
    a5 = *(const uint4*)(ap + (size_t)(5 * 16) * lda + k0);
    a6 = *(const uint4*)(ap + (size_t)(6 * 16) * lda + k0);
    a7 = *(const uint4*)(ap + (size_t)(7 * 16) * lda + k0);
    b0 = *(const uint4*)(bp + (size_t)(0 * 16) * ldb + k0);
    b1 = *(const uint4*)(bp + (size_t)(1 * 16) * ldb + k0);
    b2 = *(const uint4*)(bp + (size_t)(2 * 16) * ldb + k0);
    b3 = *(const uint4*)(bp + (size_t)(3 * 16) * ldb + k0);
    if (NJ == 4) b4 = *(const uint4*)(bp + (size_t)(4 * 16) * ldb + k0);
    if (NJ == 4) b5 = *(const uint4*)(bp + (size_t)(5 * 16) * ldb + k0);
    if (NJ == 4) b6 = *(const uint4*)(bp + (size_t)(6 * 16) * ldb + k0);
    if (NJ == 4) b7 = *(const uint4*)(bp + (size_t)(7 * 16) * ldb + k0);
    }
#pragma unroll
    for (int ks = 0; ks < 4; ++ks) {
      bf16x8 af[4], bfr[NJ];
#pragma unroll
      for (int i = 0; i < 4; ++i) af[i] = *(const bf16x8*)(as + (wr * 64 + i * 16 + fr) * RS + ks * 32 + fq * 8);
#pragma unroll
      for (int j = 0; j < NJ; ++j) bfr[j] = *(const bf16x8*)(bs + (wc * NJ * 16 + j * 16 + fr) * RS + ks * 32 + fq * 8);
#pragma unroll
      for (int i = 0; i < 4; ++i)
#pragma unroll
        for (int j = 0; j < NJ; ++j) acc[i][j] = MFMA16(af[i], bfr[j], acc[i][j]);
    }
  }
}
template <int NJ>
DI void zero_acc(f32x4 (&acc)[4][NJ]) {
#pragma unroll
  for (int i = 0; i < 4; ++i)
#pragma unroll
    for (int j = 0; j < NJ; ++j) acc[i][j] = f32x4{0.f, 0.f, 0.f, 0.f};
}
#define EPI_LOOP(NJ_)                                                              \
  const int e_lane = otid() & 63, e_w = otid() >> 6;                     \
  const int e_wr = e_w >> 1, e_wc = e_w & 1, e_fr = e_lane & 15, e_fq = e_lane >> 4; \
  _Pragma("unroll") for (int i = 0; i < 4; ++i)                                    \
  _Pragma("unroll") for (int j = 0; j < NJ_; ++j)                                  \
  _Pragma("unroll") for (int r = 0; r < 4; ++r)
#define EROW (e_wr * 64 + i * 16 + e_fq * 4 + r)
#define ECOL(NJ_) (e_wc * NJ_ * 16 + j * 16 + e_fr)

DI int colmap(int kind, int n) {
  if (kind == 0) {
    if (n < 2048) return n;
    if (n < 2560) return 2064 + (n - 2048);
    if (n < 2944) return 2576 + (n - 2560);
    if (n < 3200) return 2960 + (n - 2944);
    int j = n - 3200;
    if (j < 16) return 2048 + j;
    if (j < 48) return 3216 + (j - 16);
    return -1;
  }
  if (kind == 1) return 3248 + n;
  return n;
}
DI void convT_tile(const float* __restrict__ src, int lds, int K, u16* __restrict__ dst, int kind, int kt, int nt,
                   float* sm) {
  const int tid = otid();
  const int c = tid & 63;
  const int sc = colmap(kind, nt * 64 + c);
  __syncthreads();
#pragma unroll 4
  for (int i = 0; i < 16; ++i) {
    int r = (tid >> 6) + i * 4;
    float v = sc >= 0 ? src[(size_t)(kt * 64 + r) * lds + sc] : 0.f;
    sm[r * 65 + c] = v;
  }
  __syncthreads();
  const int n = tid >> 2, kq = tid & 3;
  unsigned pk[8];
#pragma unroll
  for (int j = 0; j < 8; ++j) pk[j] = pack2(sm[(kq * 16 + 2 * j) * 65 + n], sm[(kq * 16 + 2 * j + 1) * 65 + n]);
  u16* d = dst + (size_t)(nt * 64 + n) * K + kt * 64 + kq * 16;
  *(uint4*)d = make_uint4(pk[0], pk[1], pk[2], pk[3]);
  *(uint4*)(d + 8) = make_uint4(pk[4], pk[5], pk[6], pk[7]);
}
constexpr int CJ0 = 16 * 52, CJ1 = CJ0 + 16 * 48, CJ2 = CJ1 + 6 * 12, CJ3 = CJ2 + 4 * 16, CJ4 = CJ3 + 8 * 8,
              CJ5 = CJ4 + 24 * 16, CJ6 = CJ5 + 16 * 16, CJ7 = CJ6 + 16 * 88, CJ8 = CJ7 + 44 * 16;
DI void conv_job(const Params& p, int l, int j, float* sm) {
  u16* wl = (u16*)(p.ws + B_W) + (size_t)l * W_LAYER;
  if (j < CJ0) { convT_tile(p.in[13] + (size_t)l * 1024 * 6320, 6320, 1024, wl + W_IN, 0, j / 52, j % 52, sm); return; }
  if (j < CJ1) { j -= CJ0; convT_tile(p.in[13] + (size_t)l * 1024 * 6320, 6320, 1024, wl + W_G, 1, j / 48, j % 48, sm); return; }
  if (j < CJ2) { j -= CJ1; convT_tile(p.in[29] + (size_t)l * 384 * 768, 768, 384, wl + W_QB, 2, j / 12, j % 12, sm); return; }
  if (j < CJ3) { j -= CJ2; convT_tile(p.in[31] + (size_t)l * 256 * 1024, 1024, 256, wl + W_KVB, 2, j / 16, j % 16, sm); return; }
  if (j < CJ4) { j -= CJ3; convT_tile(p.in[26] + (size_t)l * 512 * 512, 512, 512, wl + W_GLU, 2, j / 8, j % 8, sm); return; }
  if (j < CJ5) { j -= CJ4; convT_tile(p.in[32] + (size_t)l * 1536 * 1024, 1024, 1536, wl + W_BR, 2, j / 16, j % 16, sm); return; }
  if (j < CJ6) { j -= CJ5; convT_tile(p.in[33] + (size_t)l * 1024 * 1024, 1024, 1024, wl + W_OUT, 2, j / 16, j % 16, sm); return; }
  if (j < CJ7) { j -= CJ6; convT_tile(p.in[34] + (size_t)l * 1024 * 5632, 5632, 1024, wl + W_UP, 2, j / 88, j % 88, sm); return; }
  j -= CJ7; convT_tile(p.in[37] + (size_t)l * 2816 * 1024, 1024, 2816, wl + W_DN, 2, j / 16, j % 16, sm);
}
DI void mods_tile(const Params& p, int l, int jg, float* sm) {
  const int tid = otid();
  __syncthreads();
  for (int i = tid; i < 9 * 1024; i += 256) {
    int v = i >> 10, k = i & 1023;
    float cv = v == 0 ? p.in[8][k] : p.in[7][(v - 1) * 1024 + k];
    sm[i] = cv / (1.f + __expf(-cv));
  }
  __syncthreads();
  const int col = jg * 64 + (tid & 63), kq = tid >> 6;
  float acc[9];
#pragma unroll
  for (int v = 0; v < 9; ++v) acc[v] = 0.f;
  const float* wp = p.in[9] + (size_t)l * 1024 * 6144 + col;
#pragma unroll 4
  for (int k = kq * 256; k < kq * 256 + 256; ++k) {
    float wv = wp[(size_t)k * 6144];
#pragma unroll
    for (int v = 0; v < 9; ++v) acc[v] += sm[v * 1024 + k] * wv;
  }
  float* red = sm + 9 * 1024;
#pragma unroll
  for (int v = 0; v < 9; ++v) red[(kq * 9 + v) * 64 + (tid & 63)] = acc[v];
  __syncthreads();
  if (kq == 0) {
    float* mods = (float*)(p.ws + B_MODS);
    float b = p.in[10][l * 6144 + col];
#pragma unroll
    for (int v = 0; v < 9; ++v) {
      float s = red[(0 * 9 + v) * 64 + tid] + red[(1 * 9 + v) * 64 + tid] + red[(2 * 9 + v) * 64 + tid] + red[(3 * 9 + v) * 64 + tid];
      mods[(size_t)(l * 9 + v) * 6144 + col] = s + b;
    }
  }
}
DI void s5pre_tile(const Params& p, int tile) {
  const int id = tile * 256 + otid();
  const int pp = id & 63, g = (id >> 6) & 31, dir = (id >> 11) & 1, l = id >> 12;
  const float lre = p.in[18][((l * 2 + dir) * 32 + g) * 64 + pp];
  const float lim = p.in[19][((l * 2 + dir) * 32 + g) * 64 + pp];
  const float dt = expf(p.in[20][(l * 2 + dir) * 32 + g]);
  float er = expf(lre * dt), sn, cs;
  sincosf(lim * dt, &sn, &cs);
  const float lbr = er * cs, lbi = er * sn;
  float e64 = expf(64.f * lre * dt), s64, c64;
  sincosf(64.f * lim * dt, &s64, &c64);
  float2* lamb = (float2*)(p.ws + B_LAMB);
  float2* lam64 = (float2*)(p.ws + B_LAM64);
  const int li = ((l * 2 + dir) * 32 + g) * 64 + pp;
  lamb[li] = make_float2(lbr, lbi);
  lam64[li] = make_float2(e64 * c64, e64 * s64);
  const float nr = lbr - 1.f, ni = lbi, den = lre * lre + lim * lim;
  const float cr = (nr * lre + ni * lim) / den, ci = (ni * lre - nr * lim) / den;
  u16* bbt = (u16*)(p.ws + B_BBT) + (size_t)((l * 2 + dir) * 32 + g) * 128 * 16;
  const float* bre = p.in[21] + (size_t)((l * 32 + g) * 64 + pp) * 16;
  const float* bim = p.in[22] + (size_t)((l * 32 + g) * 64 + pp) * 16;
#pragma unroll
  for (int c = 0; c < 16; ++c) {
    float br = bre[c], bi = bim[c];
    bbt[pp * 16 + c] = f2bf(cr * br - ci * bi);
    bbt[(64 + pp) * 16 + c] = f2bf(cr * bi + ci * br);
  }
  if (dir == 0) {
    u16* cmt = (u16*)(p.ws + B_CMT) + (size_t)(l * 32 + g) * 16 * 128;
    const float* cre = p.in[23] + (size_t)(l * 32 + g) * 16 * 64;
    const float* cim = p.in[24] + (size_t)(l * 32 + g) * 16 * 64;
#pragma unroll
    for (int c = 0; c < 16; ++c) {
      cmt[c * 128 + pp] = f2bf(cre[c * 64 + pp]);
      cmt[c * 128 + 64 + pp] = f2bf(-cim[c * 64 + pp]);
    }
  }
}

DI void norm_phase(const Params& p, int l, int shift_idx, int scale_idx, const float* gn) {
  const float* x = p.out;
  u16* H = (u16*)(p.ws + B_H);
  const float* mods = (const float*)(p.ws + B_MODS);
  const int lane = otid() & 63, w = otid() >> 6;
  for (int tile = blockIdx.x; tile < T_ / 4; tile += gridDim.x) {
    const int t = tile * 4 + w;
    const float4* xr = (const float4*)(x + (size_t)t * 1024);
    float4 v[4];
    float ss = 0.f;
#pragma unroll
    for (int j = 0; j < 4; ++j) {
      v[j] = xr[lane + 64 * j];
      ss += v[j].x * v[j].x + v[j].y * v[j].y + v[j].z * v[j].z + v[j].w * v[j].w;
    }
    ss = wave_sum(ss);
    const float rstd = rsqrtf(ss * (1.f / 1024.f) + 1e-6f);
    const float* mb = mods + (size_t)(l * 9 + tok_v(t)) * 6144;
#pragma unroll
    for (int j = 0; j < 4; ++j) {
      const int c = (lane + 64 * j) * 4;
      float4 g = *(const float4*)(gn + c);
      float4 sc = *(const float4*)(mb + scale_idx * 1024 + c);
      float4 sh = *(const float4*)(mb + shift_idx * 1024 + c);
      float y0 = v[j].x * rstd * g.x * (1.f + sc.x) + sh.x;
      float y1 = v[j].y * rstd * g.y * (1.f + sc.y) + sh.y;
      float y2 = v[j].z * rstd * g.z * (1.f + sc.z) + sh.z;
      float y3 = v[j].w * rstd * g.w * (1.f + sc.w) + sh.w;
      *(uint2*)(H + (size_t)t * 1024 + c) = make_uint2(pack2(y0, y1), pack2(y2, y3));
    }
  }
}

DI void gemm_in_phase(const Params& p, int l, u16* sm) {
  const u16* H = (const u16*)(p.ws + B_H);
  const u16* Wt = (const u16*)(p.ws + B_W) + (size_t)l * W_LAYER + W_IN;
  for (int tile = blockIdx.x; tile < 192 * 26; tile += gridDim.x) {
    const int mt = tile / 26, nt = tile % 26;
    f32x4 acc[4][4];
    zero_acc<4>(acc);
    gemm_core<4>(acc, H + (size_t)mt * 128 * 1024, 1024, Wt + (size_t)nt * 128 * 1024, 1024, 1024, sm);
    if (nt < 25) {
      u16* dst; int ld, c0;
      if (nt < 12) { dst = (u16*)(p.ws + B_QKV); ld = 1536; c0 = nt * 128; }
      else if (nt < 16) { dst = (u16*)(p.ws + B_Z); ld = 512; c0 = (nt - 12) * 128; }
      else if (nt < 20) { dst = (u16*)(p.ws + B_US5); ld = 512; c0 = (nt - 16) * 128; }
      else if (nt < 23) { dst = (u16*)(p.ws + B_QA); ld = 384; c0 = (nt - 20) * 128; }
      else { dst = (u16*)(p.ws + B_KVA); ld = 256; c0 = (nt - 23) * 128; }
      EPI_LOOP(4) { dst[(size_t)(mt * 128 + EROW) * ld + c0 + ECOL(4)] = f2bf(acc[i][j][r]); }
    } else {
      float* misc = (float*)(p.ws + B_MISC);
      EPI_LOOP(4) {
        int c = ECOL(4);
        if (c < 48) misc[(size_t)(mt * 128 + EROW) * 48 + c] = acc[i][j][r];
      }
    }
  }
}

DI void delta_prep_tile(const Params& p, int l, int chunk, u16* sm) {
  const int tid = otid(), lane = tid & 63, w = tid >> 6;
  const int tb = chunk * 64;
  int pos0, L;
  if (tb < TP_) { pos0 = tb & 255; L = 256; } else { pos0 = (tb - TP_) & 2047; L = 2048; }
  const u16* qkv = (const u16*)(p.ws + B_QKV);
  const float* cw = p.in[14] + (size_t)l * 5 * 1536;
  u16* ksm = sm + w * (64 * 130);
  __syncthreads();
  for (int gi = w; gi < 12; gi += 4) {
    const int ch = gi * 128 + 2 * lane;
    float w0[5], w1[5];
#pragma unroll
    for (int i = 0; i < 5; ++i) { w0[i] = cw[i * 1536 + ch]; w1[i] = cw[i * 1536 + ch + 1]; }
    float a0[5], a1[5];
#pragma unroll
    for (int i = 0; i < 4; ++i) {
      int ps = pos0 - 2 + i;
      unsigned u = (ps >= 0 && ps < L) ? *(const unsigned*)(qkv + (size_t)(tb - 2 + i) * 1536 + ch) : 0u;
      a0[i + 1] = blo(u); a1[i + 1] = bhi(u);
    }
    u16* dst = (u16*)(p.ws + (gi < 4 ? B_QN : (gi < 8 ? B_KN : B_VV)));
    const int hh = gi & 3;
    for (int tt = 0; tt < 64; ++tt) {
#pragma unroll
      for (int i = 0; i < 4; ++i) { a0[i] = a0[i + 1]; a1[i] = a1[i + 1]; }
      {
        int ps = pos0 + tt + 2;
        unsigned u = (ps < L) ? *(const unsigned*)(qkv + (size_t)(tb + tt + 2) * 1536 + ch) : 0u;
        a0[4] = blo(u); a1[4] = bhi(u);
      }
      float y0 = 0.f, y1 = 0.f;
#pragma unroll
      for (int i = 0; i < 5; ++i) { y0 += w0[i] * a0[i]; y1 += w1[i] * a1[i]; }
      y0 = siluf_(y0); y1 = siluf_(y1);
      if (gi < 8) {
        float ss = wave_sum(y0 * y0 + y1 * y1);
        float sc = rsqrtf(ss + 1e-6f);
        if (gi < 4) sc *= 0.08838834764831845f;
        y0 *= sc; y1 *= sc;
      }
      const unsigned pk = pack2(y0, y1);
      *(unsigned*)(dst + (size_t)(tb + tt) * 512 + hh * 128 + 2 * lane) = pk;
      if (gi >= 4 && gi < 8) *(unsigned*)(ksm + tt * 130 + 2 * lane) = pk;
    }
    if (gi >= 4 && gi < 8) {
      u16* kt = (u16*)(p.ws + B_KT) + (size_t)(chunk * 4 + hh) * 128 * 64;
#pragma unroll
      for (int rr = 0; rr < 2; ++rr) {
        const int dk = lane + 64 * rr;
        unsigned pk[32];
#pragma unroll
        for (int t2 = 0; t2 < 32; ++t2) pk[t2] = (unsigned)ksm[(2 * t2) * 130 + dk] | ((unsigned)ksm[(2 * t2 + 1) * 130 + dk] << 16);
#pragma unroll
        for (int q = 0; q < 8; ++q) *(uint4*)(kt + dk * 64 + q * 8) = make_uint4(pk[4 * q], pk[4 * q + 1], pk[4 * q + 2], pk[4 * q + 3]);
      }
    }
  }
  const float* misc = (const float*)(p.ws + B_MISC);
  float* bg = (float*)(p.ws + B_BG);
  for (int i = tid; i < 512; i += 256) {
    const int tt = i >> 3, dh = i & 7;
    const size_t t = tb + tt;
    float bl = misc[t * 48 + dh], alp = misc[t * 48 + 8 + dh];
    float x = alp + p.in[16][l * 8 + dh];
    float sp = x > 20.f ? x : log1pf(__expf(x));
    bg[t * 16 + dh] = sigmoidf_(bl);
    bg[t * 16 + 8 + dh] = -__expf(p.in[15][l * 8 + dh]) * sp;
  }
}

DI size_t kb_off(int t, int head) {
  if (t < TP_) return ((size_t)((t >> 8) * 8 + head) * 256 + (t & 255)) * 96;
  const int s = (t - TP_) >> 11, pos = (t - TP_) & 2047;
  return KB_P + ((size_t)(s * 8 + head) * 2304 + 256 + pos) * 96;
}
DI void mla_prep_tile(const Params& p, int l, int tile) {
  const int lane = otid() & 63, w = otid() >> 6;
  const int t = tile * 4 + w;
  u16* qa = (u16*)(p.ws + B_QA) + (size_t)t * 384;
  u16* kva = (u16*)(p.ws + B_KVA) + (size_t)t * 256;
  const float* misc = (const float*)(p.ws + B_MISC) + (size_t)t * 48;
  {
    unsigned u[3]; float ss = 0.f;
#pragma unroll
    for (int j = 0; j < 3; ++j) { u[j] = *(const unsigned*)(qa + 2 * lane + 128 * j); float a = blo(u[j]), b = bhi(u[j]); ss += a * a + b * b; }
    ss = wave_sum(ss);
    const float rstd = rsqrtf(ss * (1.f / 384.f) + 1e-6f);
    const float* g = p.in[28] + l * 384;
#pragma unroll
    for (int j = 0; j < 3; ++j) {
      int c = 2 * lane + 128 * j;
      *(unsigned*)(qa + c) = pack2(blo(u[j]) * rstd * g[c], bhi(u[j]) * rstd * g[c + 1]);
    }
  }
  {
    unsigned u[2]; float ss = 0.f;
#pragma unroll
    for (int j = 0; j < 2; ++j) { u[j] = *(const unsigned*)(kva + 2 * lane + 128 * j); float a = blo(u[j]), b = bhi(u[j]); ss += a * a + b * b; }
    ss = wave_sum(ss);
    const float rstd = rsqrtf(ss * (1.f / 256.f) + 1e-6f);
    const float* g = p.in[30] + l * 256;
#pragma unroll
    for (int j = 0; j < 2; ++j) {
      int c = 2 * lane + 128 * j;
      float a = blo(u[j]) * rstd * g[c], b = bhi(u[j]) * rstd * g[c + 1];
      *(unsigned*)(kva + c) = pack2(a, b);
      if (t < TP_) {
        float* o = p.out + O_CKV + ((size_t)((t >> 8) * 4 + l) * 256 + (t & 255)) * 256 + c;
        *(float2*)o = make_float2(a, b);
      }
    }
  }
  {
    const int i = lane & 31;
    float kr = misc[16 + i];
    float val;
    if (t < TP_) {
      val = kr;
      if (lane < 32) p.out[O_KR + ((size_t)((t >> 8) * 4 + l) * 256 + (t & 255)) * 32 + i] = kr;
    } else {
      const int pos = (t - TP_) & 2047;
      const float* rp = (const float*)(p.ws + B_ROPE) + (size_t)pos * 32 + (i & 15) * 2;
      const float cs = rp[0], sn = rp[1];
      float other = __shfl_xor(kr, 16);
      val = (i < 16) ? (kr * cs - other * sn) : (kr * cs + other * sn);
    }
    u16* kb = (u16*)(p.ws + B_KB);
    const u16 bv = f2bf(val);
#pragma unroll
    for (int hh = 0; hh < 4; ++hh) {
      int head = hh * 2 + (lane >> 5);
      kb[kb_off(t, head) + 64 + i] = bv;
    }
  }
}
DI void cache_rope_tile(const Params& p, int l, int tile) {
  const int pr = tile * 8 + (otid() >> 5), i = otid() & 31;
  const int s = pr >> 8, pos = pr & 255;
  const float v = p.in[6][((size_t)(s * 4 + l) * 256 + pos) * 32 + i];
  u16* kb = (u16*)(p.ws + B_KB);
  const u16 bv = f2bf(v);
#pragma unroll
  for (int head = 0; head < 8; ++head) kb[KB_P + ((size_t)(s * 8 + head) * 2304 + pos) * 96 + 64 + i] = bv;
}

DI float gelu_tanh(float x) {
  const float k0 = 0.7978845608028654f, k1 = 0.044715f;
  float u = k0 * (x + k1 * x * x * x);
  float e = __expf(2.f * u);
  float th = 1.f - 2.f / (e + 1.f);
  return 0.5f * x * (1.f + th);
}
DI void s5_chunk_tile(const Params& p, int l, int chunk, int gp, int mode, u16* sm) {
  const int tid = otid(), lane = tid & 63, w = tid >> 6;
  const u16* us5 = (const u16*)(p.ws + B_US5);
  constexpr int RS = 136;
  __syncthreads();
  {
    const int gi = w >> 1, half = w & 1, g = gp * 2 + gi;
    const int n = lane & 31, h2 = lane >> 5;
    bf16x8 af[2];
#pragma unroll
    for (int mi = 0; mi < 2; ++mi) af[mi] = *(const bf16x8*)(us5 + (size_t)(chunk * 64 + mi * 32 + n) * 512 + g * 16 + 8 * h2);
#pragma unroll
    for (int dir = 0; dir < 2; ++dir) {
      const u16* bbt = (const u16*)(p.ws + B_BBT) + (size_t)((l * 2 + dir) * 32 + g) * 128 * 16;
#pragma unroll
      for (int nn = 0; nn < 2; ++nn) {
        const int nt = half * 2 + nn;
        bf16x8 bfr = *(const bf16x8*)(bbt + (nt * 32 + n) * 16 + 8 * h2);
#pragma unroll
        for (int mi = 0; mi < 2; ++mi) {
          f32x16 acc;
#pragma unroll
          for (int r = 0; r < 16; ++r) acc[r] = 0.f;
          acc = MFMA32(af[mi], bfr, acc);
          u16* d = sm + (size_t)((gi * 2 + dir) * 64 + mi * 32) * RS + nt * 32 + n;
#pragma unroll
          for (int r = 0; r < 16; ++r) d[crow(r, h2) * RS] = f2bf(acc[r]);
        }
      }
    }
  }
  __syncthreads();
  {
    const int gi = tid >> 7, dir = (tid >> 6) & 1, pp = tid & 63, g = gp * 2 + gi;
    const float2 lb = ((const float2*)(p.ws + B_LAMB))[((l * 2 + dir) * 32 + g) * 64 + pp];
    const size_t hidx = ((size_t)(chunk * 32 + g) * 2 + dir) * 64 + pp;
    float hr = 0.f, hi = 0.f;
    if (mode) { float2 h0 = ((const float2*)(p.ws + B_HIN))[hidx]; hr = h0.x; hi = h0.y; }
    u16* base = sm + (size_t)((gi * 2 + dir) * 64) * RS;
#pragma unroll 8
    for (int st = 0; st < 64; ++st) {
      const int tk = dir ? 63 - st : st;
      float br = bf2f(base[tk * RS + pp]), bi = bf2f(base[tk * RS + 64 + pp]);
      float nr = __builtin_fmaf(lb.x, hr, __builtin_fmaf(-lb.y, hi, br));
      float ni = __builtin_fmaf(lb.x, hi, __builtin_fmaf(lb.y, hr, bi));
      asm volatile("" : "+v"(nr));
      asm volatile("" : "+v"(ni));
      hr = nr; hi = ni;
      if (mode) { base[tk * RS + pp] = f2bf(hr); base[tk * RS + 64 + pp] = f2bf(hi); }
    }
    if (!mode) ((float2*)(p.ws + B_HEND))[hidx] = make_float2(hr, hi);
  }
  if (!mode) return;
  __syncthreads();
  {
    const int gi = w >> 1, g = gp * 2 + gi;
    const int fr = lane & 15, fq = lane >> 4;
    const u16* cmt = (const u16*)(p.ws + B_CMT) + (size_t)(l * 32 + g) * 16 * 128;
    f32x4 acc[2];
    acc[0] = f32x4{0.f, 0.f, 0.f, 0.f}; acc[1] = acc[0];
#pragma unroll
    for (int ks = 0; ks < 8; ++ks) {
      const int dir = ks >> 2, kk = (ks & 3) * 32;
      bf16x8 bfr = *(const bf16x8*)(cmt + fr * 128 + kk + fq * 8);
#pragma unroll
      for (int mm = 0; mm < 2; ++mm) {
        const int mi = (w & 1) * 2 + mm;
        bf16x8 af = *(const bf16x8*)(sm + (size_t)((gi * 2 + dir) * 64 + mi * 16 + fr) * RS + kk + fq * 8);
        acc[mm] = MFMA16(af, bfr, acc[mm]);
      }
    }
    const float dsk = p.in[25][l * 512 + g * 16 + fr];
    u16* y5 = (u16*)(p.ws + B_Y5);
#pragma unroll
    for (int mm = 0; mm < 2; ++mm)
#pragma unroll
      for (int r = 0; r < 4; ++r) {
        const size_t t = (size_t)chunk * 64 + ((w & 1) * 2 + mm) * 16 + fq * 4 + r;
        float u = bf2f(us5[t * 512 + g * 16 + fr]);
        float y = acc[mm][r] + dsk * u;
        y5[t * 512 + g * 16 + fr] = f2bf(gelu_tanh(y));
      }
  }
}
DI void s5_carry_tile(const Params& p, int l, int tile) {
  const int seq = tile >> 4, gp = tile & 15;
  const int tid = otid(), gi = tid >> 7, dir = (tid >> 6) & 1, pp = tid & 63, g = gp * 2 + gi;
  int c0, nc;
  if (seq < 32) { c0 = seq * 4; nc = 4; } else { c0 = 128 + (seq - 32) * 32; nc = 32; }
  const float2 l64 = ((const float2*)(p.ws + B_LAM64))[((l * 2 + dir) * 32 + g) * 64 + pp];
  float hr = 0.f, hi = 0.f;
  if (seq >= 32) {
    const size_t si = ((size_t)((seq - 32) * 4 + l) * 2 + dir) * 2048 + g * 64 + pp;
    hr = p.in[3][si]; hi = p.in[4][si];
  }
  const float2* hend = (const float2*)(p.ws + B_HEND);
  float2* hin = (float2*)(p.ws + B_HIN);
  for (int it = 0; it < nc; ++it) {
    const int ck = c0 + (dir ? nc - 1 - it : it);
    const size_t idx = ((size_t)(ck * 32 + g) * 2 + dir) * 64 + pp;
    hin[idx] = make_float2(hr, hi);
    float2 he = hend[idx];
    float nr = __builtin_fmaf(l64.x, hr, __builtin_fmaf(-l64.y, hi, he.x));
    float ni = __builtin_fmaf(l64.x, hi, __builtin_fmaf(l64.y, hr, he.y));
    asm volatile("" : "+v"(nr));
    asm volatile("" : "+v"(ni));
    hr = nr; hi = ni;
  }
  if (seq < 32) {
    const size_t so = ((size_t)(seq * 4 + l) * 2 + dir) * 2048 + g * 64 + pp;
    p.out[O_S5RE + so] = hr;
    p.out[O_S5IM + so] = hi;
  }
}

DI void delta_local_tile(const Params& p, int tile, float* smf) {
  const int chunk = tile >> 1, dir = tile & 1;
  const int tid = otid(), lane = tid & 63, h = tid >> 6;
  const int m = lane & 31, h2 = lane >> 5;
  const int tb = chunk * 64;
  const float* bg = (const float*)(p.ws + B_BG);
  const u16* kn = (const u16*)(p.ws + B_KN);
  const u16* qn = (const u16*)(p.ws + B_QN);
  float* Aw = smf + h * 4096;
  const size_t cidx = ((size_t)(chunk * 4 + h) * 2 + dir);
  const int tl = tb + (dir ? 63 - lane : lane);
  float gcs = bg[(size_t)tl * 16 + 8 + dir * 4 + h];
  const float beta = bg[(size_t)tl * 16 + dir * 4 + h];
#pragma unroll
  for (int o = 1; o < 64; o <<= 1) {
    float v = __shfl_up(gcs, o);
    if (lane >= o) gcs += v;
  }
  ((float*)(p.ws + B_GC))[cidx * 64 + lane] = gcs;
  ((float*)(p.ws + B_BC))[cidx * 64 + lane] = beta;
  __syncthreads();
  u16* qkm = (u16*)(p.ws + B_QKM) + cidx * 4096;
#pragma unroll 1
  for (int tt = 0; tt < 3; ++tt) {
    const int mi = tt == 0 ? 0 : 1, ni = tt == 2 ? 1 : 0;
    const int cm = 32 * mi + m, cn = 32 * ni + m;
    const u16* krm = kn + (size_t)(tb + (dir ? 63 - cm : cm)) * 512 + h * 128 + h2 * 8;
    const u16* qrm = qn + (size_t)(tb + (dir ? 63 - cm : cm)) * 512 + h * 128 + h2 * 8;
    const u16* krn = kn + (size_t)(tb + (dir ? 63 - cn : cn)) * 512 + h * 128 + h2 * 8;
    f32x16 ak, aq;
#pragma unroll
    for (int r = 0; r < 16; ++r) { ak[r] = 0.f; aq[r] = 0.f; }
#pragma unroll
    for (int ks = 0; ks < 8; ++ks) {
      const bf16x8 fkm = *(const bf16x8*)(krm + ks * 16), fqm = *(const bf16x8*)(qrm + ks * 16), fkn = *(const bf16x8*)(krn + ks * 16);
      ak = MFMA32(fkm, fkn, ak);
      aq = MFMA32(fqm, fkn, aq);
    }
    const int e = 32 * ni + m;
    const float gce = __shfl(gcs, e);
#pragma unroll
    for (int r = 0; r < 16; ++r) {
      const int c = 32 * mi + crow(r, h2);
      const float gcc = __shfl(gcs, c), bc = __shfl(beta, c);
      const float dec = (e <= c) ? __expf(gcc - gce) : 0.f;
      Aw[c * 64 + e] = (e < c) ? ak[r] * bc * dec : 0.f;
      qkm[c * 64 + e] = f2bf(aq[r] * dec);
    }
  }
  __syncthreads();
  u16* tm = (u16*)(p.ws + B_TM) + cidx * 4096;
  float x[64];
#pragma unroll
  for (int i = 0; i < 64; ++i) {
    float a = (i == lane) ? 1.f : 0.f;
#pragma unroll
    for (int j = 0; j < i; ++j) a -= Aw[i * 64 + j] * x[j];
    x[i] = a;
    tm[i * 64 + lane] = f2bf(a);
  }
}

template <int dir>
DI void delta_scan_body(const Params& p, int l, int seq, int h, u16* sm);
DI void delta_scan_tile(const Params& p, int l, int idx, u16* sm) {
  int seq, h, dir;
  if (idx < 64) { seq = 32 + (idx >> 3); h = (idx >> 1) & 3; dir = idx & 1; }
  else { const int i2 = idx - 64; seq = i2 >> 3; h = (i2 >> 1) & 3; dir = i2 & 1; }
  if (dir) delta_scan_body<1>(p, l, seq, h, sm); else delta_scan_body<0>(p, l, seq, h, sm);
}
template <int dir>
DI void delta_scan_body(const Params& p, int l, int seq, int h, u16* sm) {
  int chunk0, nch;
  if (seq < 32) { chunk0 = seq * 4; nch = 4; } else { chunk0 = 128 + (seq - 32) * 32; nch = 32; }
  const int lane = otid() & 63, w = otid() >> 6;
  const int n = lane & 31, h2 = lane >> 5;
  const int dvc = w * 32 + n;
  const u16* kn = (const u16*)(p.ws + B_KN);
  const u16* qn = (const u16*)(p.ws + B_QN);
  const u16* vv = (const u16*)(p.ws + B_VV);
  u16* od = (u16*)(p.ws + (dir ? B_OB : B_OF));
  f32x16 S[4];
  if (seq >= 32) {
    const float* s0 = p.in[2] + ((size_t)(((seq - 32) * 4 + l) * 2 + dir) * 4 + h) * 16384;
#pragma unroll
    for (int t = 0; t < 4; ++t)
#pragma unroll
      for (int r = 0; r < 16; ++r) S[t][r] = s0[(size_t)(32 * t + crow(r, h2)) * 128 + dvc];
  } else {
#pragma unroll
    for (int t = 0; t < 4; ++t)
#pragma unroll
      for (int r = 0; r < 16; ++r) S[t][r] = 0.f;
  }
  for (int it = 0; it < nch; ++it) {
    const int chunk = chunk0 + (dir ? nch - 1 - it : it);
    const int tb = chunk * 64;
    const size_t cidx = ((size_t)(chunk * 4 + h) * 2 + dir);
    const float* gcp = (const float*)(p.ws + B_GC) + cidx * 64;
    const float* bcp = (const float*)(p.ws + B_BC) + cidx * 64;
    const u16* tm = (const u16*)(p.ws + B_TM) + cidx * 4096;
    const u16* qkm = (const u16*)(p.ws + B_QKM) + cidx * 4096;
    const u16* ktp = (const u16*)(p.ws + B_KT) + (size_t)(chunk * 4 + h) * 8192;
    const float glast = gcp[63];
    size_t trow[2];
#pragma unroll
    for (int mi = 0; mi < 2; ++mi) { const int c = 32 * mi + n; trow[mi] = (size_t)(tb + (dir ? 63 - c : c)); }
#define SCHED_FENCE() asm volatile("" ::: "memory")
    u16* vls = sm + w * (64 * 40);
    __syncthreads();
#pragma unroll
    for (int jv = 0; jv < 4; ++jv) {
      const int tau = (lane >> 2) + 16 * jv, cq = lane & 3;
      const uint4 vq = *(const uint4*)(vv + (size_t)(tb + tau) * 512 + h * 128 + w * 32 + cq * 8);
      *(uint4*)(vls + (dir ? 63 - tau : tau) * 40 + cq * 8) = vq;
    }
    __syncthreads();
    f32x16 X[2], QS[2];
    {
      bf16x8 Sb[4][2];
#pragma unroll
      for (int t = 0; t < 4; ++t)
#pragma unroll
        for (int s = 0; s < 2; ++s) Sb[t][s] = pack_acc(S[t], s);
#pragma unroll
      for (int mi = 0; mi < 2; ++mi)
#pragma unroll
        for (int r = 0; r < 16; ++r) { X[mi][r] = 0.f; QS[mi][r] = 0.f; }
#pragma unroll
      for (int t = 0; t < 4; ++t) {
#pragma unroll
        for (int mi = 0; mi < 2; ++mi) {
          const u16* krow_ = kn + trow[mi] * 512 + h * 128;
          const u16* qrow_ = qn + trow[mi] * 512 + h * 128;
#pragma unroll
          for (int s = 0; s < 2; ++s) {
            X[mi] = MFMA32(load_perm(krow_ + 32 * t, s, h2), Sb[t][s], X[mi]);
            QS[mi] = MFMA32(load_perm(qrow_ + 32 * t, s, h2), Sb[t][s], QS[mi]);
          }
        }
        SCHED_FENCE();
      }
    }
    bf16x8 Rb[2][2];
#pragma unroll
    for (int mi = 0; mi < 2; ++mi) {
#pragma unroll
      for (int a = 0; a < 4; ++a) {
        const int c4 = 32 * mi + 8 * a + 4 * h2;
        const float4 g4 = *(const float4*)(gcp + c4);
        const float4 b4 = *(const float4*)(bcp + c4);
        const float gg[4] = {g4.x, g4.y, g4.z, g4.w};
        const float bb[4] = {b4.x, b4.y, b4.z, b4.w};
#pragma unroll
        for (int q = 0; q < 4; ++q) {
          const int c = c4 + q;
          const float v = bf2f(vls[c * 40 + n]);
          const float eg = __expf(gg[q]);
          X[mi][4 * a + q] = bb[q] * (v - eg * X[mi][4 * a + q]);
          QS[mi][4 * a + q] *= eg;
        }
      }
      Rb[mi][0] = pack_acc(X[mi], 0);
      Rb[mi][1] = pack_acc(X[mi], 1);
    }
    SCHED_FENCE();
    f32x16 Vn[2];
#pragma unroll
    for (int mo = 0; mo < 2; ++mo) {
#pragma unroll
      for (int r = 0; r < 16; ++r) Vn[mo][r] = 0.f;
#pragma unroll
      for (int mi = 0; mi <= mo; ++mi)
#pragma unroll
        for (int s = 0; s < 2; ++s) Vn[mo] = MFMA32(load_perm(tm + (32 * mo + n) * 64 + 32 * mi, s, h2), Rb[mi][s], Vn[mo]);
    }
    SCHED_FENCE();
    {
      bf16x8 Vb[2][2];
#pragma unroll
      for (int mi = 0; mi < 2; ++mi) { Vb[mi][0] = pack_acc(Vn[mi], 0); Vb[mi][1] = pack_acc(Vn[mi], 1); }
#pragma unroll
      for (int mo = 0; mo < 2; ++mo) {
#pragma unroll
        for (int mi = 0; mi <= mo; ++mi)
#pragma unroll
          for (int s = 0; s < 2; ++s) QS[mo] = MFMA32(load_perm(qkm + (32 * mo + n) * 64 + 32 * mi, s, h2), Vb[mi][s], QS[mo]);
      }
      __syncthreads();
#pragma unroll
      for (int mo = 0; mo < 2; ++mo)
#pragma unroll
        for (int r = 0; r < 16; ++r) vls[(32 * mo + crow(r, h2)) * 40 + n] = f2bf(QS[mo][r]);
      __syncthreads();
#pragma unroll
      for (int jv = 0; jv < 4; ++jv) {
        const int tau = (lane >> 2) + 16 * jv, cq = lane & 3;
        const uint4 oq = *(const uint4*)(vls + (dir ? 63 - tau : tau) * 40 + cq * 8);
        *(uint4*)(od + (size_t)(tb + tau) * 512 + h * 128 + w * 32 + cq * 8) = oq;
      }
    }
    SCHED_FENCE();
    bf16x8 Vsb[2][2];
#pragma unroll
    for (int mi = 0; mi < 2; ++mi) {
#pragma unroll
      for (int a = 0; a < 4; ++a) {
        const float4 g4 = *(const float4*)(gcp + 32 * mi + 8 * a + 4 * h2);
        Vn[mi][4 * a + 0] *= __expf(glast - g4.x); Vn[mi][4 * a + 1] *= __expf(glast - g4.y);
        Vn[mi][4 * a + 2] *= __expf(glast - g4.z); Vn[mi][4 * a + 3] *= __expf(glast - g4.w);
      }
      Vsb[mi][0] = pack_acc(Vn[mi], 0); Vsb[mi][1] = pack_acc(Vn[mi], 1);
    }
    const float eg = __expf(glast);
#pragma unroll
    for (int t = 0; t < 4; ++t) {
#pragma unroll
      for (int r = 0; r < 16; ++r) S[t][r] *= eg;
      const u16* ktrow = ktp + (32 * t + n) * 64;
#pragma unroll
      for (int mi = 0; mi < 2; ++mi)
#pragma unroll
        for (int s = 0; s < 2; ++s) {
          bf16x8 a = dir ? load_perm_rev(ktrow, 32 * mi, s, h2) : load_perm(ktrow + 32 * mi, s, h2);
          S[t] = MFMA32(a, Vsb[mi][s], S[t]);
        }
      SCHED_FENCE();
    }
  }
  if (seq < 32) {
    float* so = p.out + O_SD + ((size_t)((seq * 4 + l) * 2 + dir) * 4 + h) * 16384;
#pragma unroll
    for (int t = 0; t < 4; ++t)
#pragma unroll
      for (int r = 0; r < 16; ++r) so[(size_t)(32 * t + crow(r, h2)) * 128 + dvc] = S[t][r];
  }
}

DI void attn_tile(const Params& p, int seq, int head, int qb) {
  const int lane = otid() & 63, w = otid() >> 6;
  const int n = lane & 31, h2 = lane >> 5;
  int tq0, nkeys; size_t kbo, vto;
  if (seq < 32) { tq0 = seq * 256 + qb * 128 + w * 32; nkeys = 256; kbo = (size_t)(seq * 8 + head) * 256 * 96; vto = (size_t)(seq * 8 + head) * 64 * 256; }
  else { const int s = seq - 32; tq0 = TP_ + s * 2048 + qb * 128 + w * 32; nkeys = 2304; kbo = KB_P + (size_t)(s * 8 + head) * 2304 * 96; vto = VT_P + (size_t)(s * 8 + head) * 64 * 2304; }
  const u16* kb = (const u16*)(p.ws + B_KB) + kbo;
  const u16* vt = (const u16*)(p.ws + B_VT) + vto;
  const u16* qm = (const u16*)(p.ws + B_QM) + (size_t)(tq0 + n) * 768 + head * 96;
  bf16x8 qf[6];
#pragma unroll
  for (int ks = 0; ks < 6; ++ks) qf[ks] = *(const bf16x8*)(qm + ks * 16 + h2 * 8);
  f32x16 O[2];
#pragma unroll
  for (int r = 0; r < 16; ++r) { O[0][r] = 0.f; O[1][r] = 0.f; }
  float mrun = -1e30f, lsum = 0.f;
  const int nkt = nkeys >> 6;
  for (int kt = 0; kt < nkt; ++kt) {
    f32x16 St[2];
#pragma unroll
    for (int sub = 0; sub < 2; ++sub) {
#pragma unroll
      for (int r = 0; r < 16; ++r) St[sub][r] = 0.f;
      const u16* kr = kb + (size_t)(kt * 64 + sub * 32 + n) * 96 + h2 * 8;
#pragma unroll
      for (int ks = 0; ks < 6; ++ks) St[sub] = MFMA32(*(const bf16x8*)(kr + ks * 16), qf[ks], St[sub]);
    }
    float mx = St[0][0];
#pragma unroll
    for (int r = 0; r < 16; ++r) { mx = fmaxf(mx, St[0][r]); mx = fmaxf(mx, St[1][r]); }
    mx = fmaxf(mx, __shfl_xor(mx, 32));
    const float mnew = fmaxf(mrun, mx);
    const float alpha = exp2f(mrun - mnew);
    mrun = mnew;
    float ps = 0.f;
#pragma unroll
    for (int sub = 0; sub < 2; ++sub)
#pragma unroll
      for (int r = 0; r < 16; ++r) { float e = exp2f(St[sub][r] - mnew); St[sub][r] = e; ps += e; }
    lsum = lsum * alpha + ps;
#pragma unroll
    for (int r = 0; r < 16; ++r) { O[0][r] *= alpha; O[1][r] *= alpha; }
#pragma unroll
    for (int sub = 0; sub < 2; ++sub)
#pragma unroll
      for (int s = 0; s < 2; ++s) {
        const bf16x8 pb = pack_acc(St[sub], s);
#pragma unroll
        for (int dt = 0; dt < 2; ++dt)
          O[dt] = MFMA32(load_perm(vt + (size_t)(dt * 32 + n) * nkeys + kt * 64 + sub * 32, s, h2), pb, O[dt]);
      }
  }
  lsum += __shfl_xor(lsum, 32);
  const float inv = 1.f / lsum;
  u16* oc = (u16*)(p.ws + B_OC) + (size_t)(tq0 + n) * 512 + head * 64;
#pragma unroll
  for (int dt = 0; dt < 2; ++dt)
#pragma unroll
    for (int a = 0; a < 4; ++a) {
      const int dv = dt * 32 + 8 * a + 4 * h2;
      *(uint2*)(oc + dv) = make_uint2(pack2(O[dt][4 * a] * inv, O[dt][4 * a + 1] * inv), pack2(O[dt][4 * a + 2] * inv, O[dt][4 * a + 3] * inv));
    }
}

DI void delta_out_tile(const Params& p, int l, int tile) {
  const int lane = otid() & 63, w = otid() >> 6;
  const u16* of = (const u16*)(p.ws + B_OF);
  const u16* ob = (const u16*)(p.ws + B_OB);
  const u16* z = (const u16*)(p.ws + B_Z);
  u16* oa = (u16*)(p.ws + B_OA);
  const float g0 = p.in[17][l * 128 + 2 * lane], g1 = p.in[17][l * 128 + 2 * lane + 1];
#pragma unroll 1
  for (int q = 0; q < 16; ++q) {
    const size_t t = (size_t)tile * 16 + w * 4 + (q >> 2);
    const int hh = q & 3;
    const size_t off = t * 512 + hh * 128 + 2 * lane;
    unsigned a = *(const unsigned*)(of + off), b = *(const unsigned*)(ob + off), zz = *(const unsigned*)(z + off);
    float o0 = blo(a) + blo(b), o1 = bhi(a) + bhi(b);
    float ss = wave_sum(o0 * o0 + o1 * o1);
    float rstd = rsqrtf(ss * (1.f / 128.f) + 1e-6f);
    float y0 = o0 * rstd * g0 * siluf_(blo(zz)), y1 = o1 * rstd * g1 * siluf_(bhi(zz));
    *(unsigned*)(oa + off) = pack2(y0, y1);
  }
}

DI void grid_barrier(unsigned* bar, unsigned target) {
  __threadfence();
  asm volatile("s_waitcnt vmcnt(0) lgkmcnt(0)" ::: "memory");
  __syncthreads();
  if (otid() == 0) {
    __hip_atomic_fetch_add(bar, 1u, __ATOMIC_RELEASE, __HIP_MEMORY_SCOPE_AGENT);
    while (__hip_atomic_load(bar, __ATOMIC_RELAXED, __HIP_MEMORY_SCOPE_AGENT) < target) __builtin_amdgcn_s_sleep(2);
    __builtin_amdgcn_fence(__ATOMIC_ACQUIRE, "agent");
    asm volatile("s_waitcnt vmcnt(0)" ::: "memory");
  }
  __syncthreads();
  __threadfence();
  asm volatile("s_waitcnt vmcnt(0)" ::: "memory");
}
#define GSYNC() do { bar_target += gridDim.x; grid_barrier(p.bar, bar_target); } while (0)
#ifndef ONLY
#define PH(n) 1
#else
#define PH(n) ((n) == ONLY || (n) / 100 == ONLY || (n) == ONLY / 100)
#endif
__global__ void __launch_bounds__(256, 2) mega(Params p) {
  cg::grid_group grid = cg::this_grid();
  __shared__ __attribute__((aligned(16))) char smem_raw[73728];
  u16* sm = (u16*)smem_raw;
  float* smf = (float*)smem_raw;
  const int nb = gridDim.x, bid = blockIdx.x;
  unsigned bar_target = 0;
  grid.sync();

  if (PH(0)) {
    const int tid = otid();
    for (int j = bid; j < 4 * CJ8; j += nb) conv_job(p, j / CJ8, j % CJ8, smf);
    for (int j = bid; j < 4 * 96; j += nb) mods_tile(p, j / 96, j % 96, smf);
    for (int j = bid; j < 64; j += nb) s5pre_tile(p, j);
    {
      const float4* xp = (const float4*)p.in[0];
      const float4* xs = (const float4*)p.in[1];
      float4* o = (float4*)p.out;
      const size_t nP = (size_t)TP_ * 256, nT = (size_t)T_ * 256;
      for (size_t i = (size_t)bid * 256 + tid; i < nT; i += (size_t)nb * 256) o[i] = i < nP ? xp[i] : xs[i - nP];
    }
    {
      float* rope = (float*)(p.ws + B_ROPE);
      for (int i = bid * 256 + tid; i < 2048 * 16; i += nb * 256) {
        const int pos = i >> 4, f = i & 15;
        const float invf = 1.f / powf(10000.f, (float)(f & 7) * 0.125f);
        const float ang = (f < 8 ? (float)(pos >> 6) : (float)(pos & 63)) * invf;
        float sn, cs;
        sincosf(ang, &sn, &cs);
        rope[i * 2] = cs; rope[i * 2 + 1] = sn;
      }
    }
    {
      u16* cc = (u16*)(p.ws + B_CKVC);
      for (int i = bid * 256 + tid; i < 8 * 4 * 256 * 256 / 2; i += nb * 256) {
        const int e = i * 2;
        const int c = e & 255, pos = (e >> 8) & 255, l = (e >> 16) & 3, b = e >> 18;
        float2 v = *(const float2*)(p.in[5] + e);
        *(unsigned*)(cc + ((size_t)(l * 2048 + b * 256 + pos)) * 256 + c) = pack2(v.x, v.y);
      }
    }
  }
  GSYNC();

  for (int l = 0; l < 4; ++l) {
    const u16* WL = (const u16*)(p.ws + B_W) + (size_t)l * W_LAYER;
    const float* mods = (const float*)(p.ws + B_MODS);
    if (PH(1)) norm_phase(p, l, 0, 1, p.in[11] + l * 1024);
    GSYNC();
    if (PH(2)) gemm_in_phase(p, l, sm);
    GSYNC();
    if (PH(3)) {
      for (int j = bid; j < NCH; j += nb) delta_prep_tile(p, l, j, sm);
      for (int j = bid; j < T_ / 4; j += nb) mla_prep_tile(p, l, j);
      for (int j = bid; j < 256; j += nb) cache_rope_tile(p, l, j);
      for (int j = bid; j < NCH * 16; j += nb) s5_chunk_tile(p, l, j >> 4, j & 15, 0, sm);
    }
    GSYNC();
    if (PH(4)) {
      const int tid = otid();
      if (PH(400)) for (int j = bid; j < NCH * 2; j += nb) delta_local_tile(p, j, smf);
      if (PH(410)) for (int j = bid; j < 192 * 6; j += nb) {
          const int q = j, mt = q / 6, nt = q % 6;
          f32x4 acc[4][4];
          zero_acc<4>(acc);
          gemm_core<4>(acc, (const u16*)(p.ws + B_QA) + (size_t)mt * 128 * 384, 384, WL + W_QB + (size_t)nt * 128 * 384, 384, 384, sm);
          u16* qm = (u16*)(p.ws + B_QM);
          const float qs = 0.10206207261596575f * 1.4426950408889634f;
          const float* rope = (const float*)(p.ws + B_ROPE);
          const int e_lane = tid & 63, e_w = tid >> 6, e_wr = e_w >> 1, e_wc = e_w & 1, e_fr = e_lane & 15, e_fq = e_lane >> 4;
          const bool is_s = (mt * 128 >= TP_);
#pragma unroll
          for (int i = 0; i < 4; ++i)
#pragma unroll
            for (int r = 0; r < 4; ++r) {
              const int row = mt * 128 + e_wr * 64 + i * 16 + e_fq * 4 + r;
              float vals[4];
#pragma unroll
              for (int jj = 0; jj < 4; ++jj) vals[jj] = acc[i][jj][r];
              if (is_s) {
                const int pos = (row - TP_) & 2047;
                const float cs = rope[(pos * 16 + e_fr) * 2], sn = rope[(pos * 16 + e_fr) * 2 + 1];
#pragma unroll
                for (int jj = 0; jj < 4; jj += 2) {
                  const int gt = (nt * 128 + e_wc * 64) / 16 + jj;
                  if (gt % 6 == 4) {
                    const float x1 = vals[jj], x2 = vals[jj + 1];
                    vals[jj] = x1 * cs - x2 * sn;
                    vals[jj + 1] = x2 * cs + x1 * sn;
                  }
                }
              }
#pragma unroll
              for (int jj = 0; jj < 4; ++jj) qm[(size_t)row * 768 + nt * 128 + e_wc * 64 + jj * 16 + e_fr] = f2bf(vals[jj] * qs);
            }
      }
      if (PH(420)) for (int j = bid; j < 208 * 8; j += nb) {
          const int q = j, mt = q >> 3, head = q & 7;
          f32x4 acc[4][4];
          zero_acc<4>(acc);
          const u16* A = mt < 192 ? (const u16*)(p.ws + B_KVA) + (size_t)mt * 128 * 256
                                  : (const u16*)(p.ws + B_CKVC) + ((size_t)l * 2048 + (size_t)(mt - 192) * 128) * 256;
          gemm_core<4>(acc, A, 256, WL + W_KVB + (size_t)head * 128 * 256, 256, 256, sm);
          int key0, nkeys; size_t kbo, vto;
          if (mt < 64) { const int seq = mt >> 1; key0 = (mt & 1) * 128; nkeys = 256; kbo = (size_t)(seq * 8 + head) * 256 * 96; vto = (size_t)(seq * 8 + head) * 64 * 256; }
          else if (mt < 192) { const int s = (mt - 64) >> 4; key0 = 256 + ((mt - 64) & 15) * 128; nkeys = 2304; kbo = KB_P + (size_t)(s * 8 + head) * 2304 * 96; vto = VT_P + (size_t)(s * 8 + head) * 64 * 2304; }
          else { const int s = (mt - 192) >> 1; key0 = ((mt - 192) & 1) * 128; nkeys = 2304; kbo = KB_P + (size_t)(s * 8 + head) * 2304 * 96; vto = VT_P + (size_t)(s * 8 + head) * 64 * 2304; }
          u16* kb = (u16*)(p.ws + B_KB) + kbo;
          u16* vt = (u16*)(p.ws + B_VT) + vto;
          const int e_lane = tid & 63, e_w = tid >> 6, e_wr = e_w >> 1, e_wc = e_w & 1, e_fr = e_lane & 15, e_fq = e_lane >> 4;
#pragma unroll
          for (int i = 0; i < 4; ++i)
#pragma unroll
            for (int jj = 0; jj < 4; ++jj) {
              const int key = key0 + e_wr * 64 + i * 16 + e_fq * 4;
              const int c = jj * 16 + e_fr;
              if (e_wc == 0) {
#pragma unroll
                for (int r = 0; r < 4; ++r) kb[(size_t)(key + r) * 96 + c] = f2bf(acc[i][jj][r]);
              } else {
                *(uint2*)(vt + (size_t)c * nkeys + key) = make_uint2(pack2(acc[i][jj][0], acc[i][jj][1]), pack2(acc[i][jj][2], acc[i][jj][3]));
              }
            }
      }
      if (PH(430)) for (int j = bid; j < 640; j += nb) s5_carry_tile(p, l, j);
    }
    GSYNC();
    if (PH(5)) {
      if (PH(500)) for (int j = bid; j < 320; j += nb) delta_scan_tile(p, l, j, sm);
      if (PH(510)) for (int j = bid; j < 1536; j += nb) {
        if (j < 1024) attn_tile(p, 32 + (j >> 7), (j >> 4) & 7, j & 15);
        else { const int q = j - 1024; attn_tile(p, q >> 4, (q >> 1) & 7, q & 1); }
      }
      if (PH(530)) for (int j = bid; j < NCH * 8; j += nb) {
        s5_chunk_tile(p, l, j >> 3, (j & 7) * 2, 1, sm);
        s5_chunk_tile(p, l, j >> 3, (j & 7) * 2 + 1, 1, sm);
      }
    }
    GSYNC();
    if (PH(6)) {
      for (int j = bid; j < T_ / 16; j += nb) delta_out_tile(p, l, j);
      for (int j = bid; j < 192 * 4; j += nb) {
        {
          const int q = j, mt = q >> 2, nt = q & 3;
          f32x4 acc[4][4];
          zero_acc<4>(acc);
          const u16* y5 = (const u16*)(p.ws + B_Y5);
          gemm_core<4>(acc, y5 + (size_t)mt * 128 * 512, 512, WL + W_GLU + (size_t)nt * 128 * 512, 512, 512, sm);
          u16* ob5 = (u16*)(p.ws + B_OB5);
          const float* bgl = p.in[27] + l * 512;
          EPI_LOOP(4) {
            const size_t row = mt * 128 + EROW; const int col = nt * 128 + ECOL(4);
            const float y = bf2f(y5[row * 512 + col]);
            ob5[row * 512 + col] = f2bf(y * sigmoidf_(acc[i][j][r] + bgl[col]));
          }
        }
      }
    }
    GSYNC();
    if (PH(7)) {
      const u16* H = (const u16*)(p.ws + B_H);
      u16* mg = (u16*)(p.ws + B_MG);
      for (int j = bid; j < 192 * 16; j += nb) {
        const int mt = j >> 4, nt = j & 15;
        f32x4 mer[4][2];
        zero_acc<2>(mer);
#pragma unroll 1
        for (int n = 0; n < 3; ++n) {
          f32x4 ag[4][2], ab[4][2];
          zero_acc<2>(ag);
          gemm_core<2>(ag, H + (size_t)mt * 128 * 1024, 1024, WL + W_G + (size_t)(n * 1024 + nt * 64) * 1024, 1024, 1024, sm);
          zero_acc<2>(ab);
          const u16* on = (const u16*)(p.ws + (n == 0 ? B_OA : (n == 1 ? B_OB5 : B_OC)));
          gemm_core<2>(ab, on + (size_t)mt * 128 * 512, 512, WL + W_BR + (size_t)(nt * 64) * 1536 + n * 512, 1536, 512, sm);
#pragma unroll
          for (int i = 0; i < 4; ++i)
#pragma unroll
            for (int jj = 0; jj < 2; ++jj)
#pragma unroll
              for (int r = 0; r < 4; ++r) mer[i][jj][r] += sigmoidf_(ag[i][jj][r]) * ab[i][jj][r];
        }
        EPI_LOOP(2) { mg[(size_t)(mt * 128 + EROW) * 1024 + nt * 64 + ECOL(2)] = f2bf(mer[i][j][r]); }
      }
    }
    GSYNC();
    if (PH(8)) {
      const u16* mg = (const u16*)(p.ws + B_MG);
      for (int j = bid; j < 192 * 8; j += nb) {
        const int mt = j >> 3, nt = j & 7;
        f32x4 acc[4][4];
        zero_acc<4>(acc);
        gemm_core<4>(acc, mg + (size_t)mt * 128 * 1024, 1024, WL + W_OUT + (size_t)nt * 128 * 1024, 1024, 1024, sm);
        const float* gm = mods + (size_t)(l * 9 + tok_v(mt * 128)) * 6144 + 2 * 1024;
        EPI_LOOP(4) {
          const size_t row = mt * 128 + EROW; const int col = nt * 128 + ECOL(4);
          p.out[row * 1024 + col] += gm[col] * acc[i][j][r];
        }
      }
    }
    GSYNC();
    if (PH(9)) norm_phase(p, l, 3, 4, p.in[12] + l * 1024);
    GSYNC();
    if (PH(10)) {
      const u16* H = (const u16*)(p.ws + B_H);
      u16* up = (u16*)(p.ws + B_UP);
      for (int j = bid; j < 192 * 44; j += nb) {
        const int mt = j / 44, nt = j % 44;
        f32x4 acc[4][4];
        zero_acc<4>(acc);
        gemm_core<4>(acc, H + (size_t)mt * 128 * 1024, 1024, WL + W_UP + (size_t)nt * 128 * 1024, 1024, 1024, sm);
        EPI_LOOP(4) { up[(size_t)(mt * 128 + EROW) * 5632 + nt * 128 + ECOL(4)] = f2bf(acc[i][j][r]); }
      }
    }
    GSYNC();
    if (PH(11)) {
      const int tid = otid();
      const u16* up = (const u16*)(p.ws + B_UP);
      u16* act = (u16*)(p.ws + B_ACT);
      const float* cw = p.in[35] + (size_t)l * 3 * 5632;
      const float* cb = p.in[36] + (size_t)l * 5632;
      for (size_t it = (size_t)bid * 256 + tid; it < (size_t)T_ * 352; it += (size_t)nb * 256) {
        const int t = (int)(it / 352), c8 = (int)(it % 352) * 8;
        int pos, L;
        if (t < TP_) { pos = t & 255; L = 256; } else { pos = (t - TP_) & 2047; L = 2048; }
        float res[8];
        float gv[8], vv2[8];
#pragma unroll
        for (int e = 0; e < 8; ++e) { gv[e] = cb[c8 + e]; vv2[e] = cb[2816 + c8 + e]; }
#pragma unroll
        for (int d = 0; d < 3; ++d) {
          const int ps = pos + d - 1;
          if (ps < 0 || ps >= L) continue;
          const u16* rowp = up + (size_t)(t + d - 1) * 5632;
          uint4 ug = *(const uint4*)(rowp + c8);
          uint4 uv = *(const uint4*)(rowp + 2816 + c8);
          const unsigned ugs[4] = {ug.x, ug.y, ug.z, ug.w}, uvs[4] = {uv.x, uv.y, uv.z, uv.w};
#pragma unroll
          for (int e = 0; e < 4; ++e) {
            gv[2 * e] += cw[d * 5632 + c8 + 2 * e] * blo(ugs[e]);
            gv[2 * e + 1] += cw[d * 5632 + c8 + 2 * e + 1] * bhi(ugs[e]);
            vv2[2 * e] += cw[d * 5632 + 2816 + c8 + 2 * e] * blo(uvs[e]);
            vv2[2 * e + 1] += cw[d * 5632 + 2816 + c8 + 2 * e + 1] * bhi(uvs[e]);
          }
        }
#pragma unroll
        for (int e = 0; e < 8; ++e) res[e] = siluf_(gv[e]) * vv2[e];
        *(uint4*)(act + (size_t)t * 2816 + c8) = make_uint4(pack2(res[0], res[1]), pack2(res[2], res[3]), pack2(res[4], res[5]), pack2(res[6], res[7]));
      }
    }
    GSYNC();
    if (PH(12)) {
      const u16* act = (const u16*)(p.ws + B_ACT);
      for (int j = bid; j < 192 * 8; j += nb) {
        const int mt = j >> 3, nt = j & 7;
        f32x4 acc[4][4];
        zero_acc<4>(acc);
        gemm_core<4>(acc, act + (size_t)mt * 128 * 2816, 2816, WL + W_DN + (size_t)nt * 128 * 2816, 2816, 2816, sm);
        const float* gf = mods + (size_t)(l * 9 + tok_v(mt * 128)) * 6144 + 5 * 1024;
        EPI_LOOP(4) {
          const size_t row = mt * 128 + EROW; const int col = nt * 128 + ECOL(4);
          p.out[row * 1024 + col] += gf[col] * acc[i][j][r];
        }
      }
    }
    GSYNC();
  }
  if (PH(13)) {
    const int tid = otid();
    const int lane = tid & 63, w = tid >> 6;
    const float* gfin = p.in[38];
    for (int tile = bid; tile < T_ / 4; tile += nb) {
      const int t = tile * 4 + w;
      float4* xr = (float4*)(p.out + (size_t)t * 1024);
      float4 v[4];
      float ss = 0.f;
#pragma unroll
      for (int j = 0; j < 4; ++j) { v[j] = xr[lane + 64 * j]; ss += v[j].x * v[j].x + v[j].y * v[j].y + v[j].z * v[j].z + v[j].w * v[j].w; }
      ss = wave_sum(ss);
      const float rstd = rsqrtf(ss * (1.f / 1024.f) + 1e-6f);
#pragma unroll
      for (int j = 0; j < 4; ++j) {
        float4 g = *(const float4*)(gfin + (lane + 64 * j) * 4);
        xr[lane + 64 * j] = make_float4(v[j].x * rstd * g.x, v[j].y * rstd * g.y, v[j].z * rstd * g.z, v[j].w * rstd * g.w);
      }
    }
  }
}

extern "C" void kernel_launch(void* const* d_in, const int* in_sizes, int n_in, void* d_out, int out_size,
                              void* d_ws, size_t ws_size, hipStream_t stream) {
  static int grid_blocks = 0;
  if (!grid_blocks) {
    int dev = 0, cus = 0, per_cu = 0;
    (void)hipGetDevice(&dev);
    (void)hipDeviceGetAttribute(&cus, hipDeviceAttributeMultiprocessorCount, dev);
    (void)hipOccupancyMaxActiveBlocksPerMultiprocessor(&per_cu, mega, 256, 0);
    if (per_cu > 2) per_cu = 2;
    if (per_cu < 1) per_cu = 1;
    grid_blocks = cus * per_cu;
  }
  if (ws_size < B_TOTAL || n_in < 39) {
    fprintf(stderr, "workspace too small: %zu < %zu\n", ws_size, (size_t)B_END);
    return;
  }
  Params p{};
  for (int i = 0; i < 39; ++i) p.in[i] = (const float*)d_in[i];
  p.out = (float*)d_out;
  p.ws = (char*)d_ws;
  p.bar = (unsigned*)((char*)d_ws + B_BAR);
  (void)hipMemsetAsync(p.bar, 0, 256, stream);
  void* args[] = {&p};
  hipError_t e = hipLaunchCooperativeKernel((void*)mega, dim3(grid_blocks), dim3(256), args, 0, stream);
  if (e != hipSuccess) fprintf(stderr, "cooperative launch failed: %s (grid %d)\n", hipGetErrorString(e), grid_blocks);
}
```

```cpp
#include <hip/hip_runtime.h>
#include <hip/hip_cooperative_groups.h>
#include <cstdio>
namespace cg = cooperative_groups;

#define DI __device__ __forceinline__
typedef __bf16 bf16;
using bf16x8 = __attribute__((ext_vector_type(8))) short;
using f32x4 = __attribute__((ext_vector_type(4))) float;
using f32x16 = __attribute__((ext_vector_type(16))) float;
typedef unsigned short u16;

constexpr int T_ = 24576, TP_ = 8192;
constexpr int NCH = 384;
constexpr long long O_SD = 25165824LL, O_S5RE = 41943040LL, O_S5IM = 42467328LL, O_CKV = 42991616LL, O_KR = 51380224LL;

constexpr size_t W_IN = 0;
constexpr size_t W_G = W_IN + 3328ull * 1024;
constexpr size_t W_QB = W_G + 3072ull * 1024;
constexpr size_t W_KVB = W_QB + 768ull * 384;
constexpr size_t W_GLU = W_KVB + 1024ull * 256;
constexpr size_t W_BR = W_GLU + 512ull * 512;
constexpr size_t W_OUT = W_BR + 1024ull * 1536;
constexpr size_t W_UP = W_OUT + 1024ull * 1024;
constexpr size_t W_DN = W_UP + 5632ull * 1024;
constexpr size_t W_LAYER = W_DN + 1024ull * 2816;

constexpr size_t al(size_t x) { return (x + 255) & ~(size_t)255; }
constexpr size_t B_W = 0;
constexpr size_t B_MODS = al(B_W + 4 * W_LAYER * 2);
constexpr size_t B_ROPE = al(B_MODS + 4ull * 9 * 6144 * 4);
constexpr size_t B_LAMB = al(B_ROPE + 2048ull * 32 * 4);
constexpr size_t B_LAM64 = al(B_LAMB + 4ull * 2 * 32 * 64 * 8);
constexpr size_t B_BBT = al(B_LAM64 + 4ull * 2 * 32 * 64 * 8);
constexpr size_t B_CMT = al(B_BBT + 4ull * 2 * 32 * 128 * 16 * 2);
constexpr size_t B_CKVC = al(B_CMT + 4ull * 32 * 16 * 128 * 2);
constexpr size_t B_H = al(B_CKVC + 4ull * 2048 * 256 * 2);
constexpr size_t B_QKV = al(B_H + (size_t)T_ * 1024 * 2);
constexpr size_t B_Z = al(B_QKV + (size_t)T_ * 1536 * 2);
constexpr size_t B_US5 = al(B_Z + (size_t)T_ * 512 * 2);
constexpr size_t B_QA = al(B_US5 + (size_t)T_ * 512 * 2);
constexpr size_t B_KVA = al(B_QA + (size_t)T_ * 384 * 2);
constexpr size_t B_MISC = al(B_KVA + (size_t)T_ * 256 * 2);
constexpr size_t B_QN = al(B_MISC + (size_t)T_ * 48 * 4);
constexpr size_t B_KN = al(B_QN + (size_t)T_ * 512 * 2);
constexpr size_t B_VV = al(B_KN + (size_t)T_ * 512 * 2);
constexpr size_t B_KT = al(B_VV + (size_t)T_ * 512 * 2);
constexpr size_t B_BG = al(B_KT + (size_t)T_ * 512 * 2);
constexpr size_t B_TM = al(B_BG + (size_t)T_ * 16 * 4);
constexpr size_t B_QKM = al(B_TM + (size_t)T_ * 512 * 2);
constexpr size_t B_GC = al(B_QKM + (size_t)T_ * 512 * 2);
constexpr size_t B_BC = al(B_GC + (size_t)NCH * 4 * 2 * 64 * 4);
constexpr size_t KB_P = 32ull * 8 * 256 * 96, KB_S = 8ull * 8 * 2304 * 96;
constexpr size_t VT_P = 32ull * 8 * 64 * 256, VT_S = 8ull * 8 * 64 * 2304;
constexpr size_t B_KB = al(B_BC + (size_t)NCH * 4 * 2 * 64 * 4);
constexpr size_t B_VT = al(B_KB + (KB_P + KB_S) * 2);
constexpr size_t B_QM = al(B_VT + (VT_P + VT_S) * 2);
constexpr size_t B_HEND = al(B_QM + (size_t)T_ * 768 * 2);
constexpr size_t B_HIN = al(B_HEND + (size_t)NCH * 32 * 2 * 64 * 8);
constexpr size_t B_Y5 = al(B_HIN + (size_t)NCH * 32 * 2 * 64 * 8);
constexpr size_t B_OC = al(B_Y5 + (size_t)T_ * 512 * 2);
constexpr size_t B_END = al(B_OC + (size_t)T_ * 512 * 2);
constexpr size_t B_OF = B_QKV;
constexpr size_t B_OB = B_QKV + (size_t)T_ * 512 * 2;
constexpr size_t B_MG = B_QKV;
constexpr size_t B_OA = B_QN;
constexpr size_t B_OB5 = B_KN;
constexpr size_t B_UP = B_QKV;
constexpr size_t B_ACT = B_KB;
static_assert(B_UP + (size_t)T_ * 5632 * 2 <= B_KB, "UP overlaps ACT");
static_assert(B_ACT + (size_t)T_ * 2816 * 2 <= B_END, "ACT too big");
constexpr size_t B_BAR = B_END;
constexpr size_t B_TOTAL = B_BAR + 256;
static_assert(B_TOTAL <= 768ull * 1024 * 1024, "workspace too big");

struct Params {
  const float* in[39];
  float* out;
  char* ws;
  unsigned* bar;
};

DI int otid() { int t = (int)__builtin_amdgcn_workitem_id_x(); asm volatile("" : "+v"(t)); return t; }
DI unsigned pack2(float a, float b) {
  typedef __attribute__((ext_vector_type(2))) __bf16 bf2;
  bf2 v; v[0] = (__bf16)a; v[1] = (__bf16)b;
  return __builtin_bit_cast(unsigned, v);
}
DI u16 f2bf(float a) { return (u16)(pack2(a, 0.f) & 0xffffu); }
DI float bf2f(u16 u) { return __uint_as_float(((unsigned)u) << 16); }
DI float blo(unsigned u) { return __uint_as_float(u << 16); }
DI float bhi(unsigned u) { return __uint_as_float(u & 0xffff0000u); }
DI float wave_sum(float v) {
#pragma unroll
  for (int o = 32; o > 0; o >>= 1) v += __shfl_xor(v, o);
  return v;
}
DI float sigmoidf_(float x) { return 1.f / (1.f + __expf(-x)); }
DI float siluf_(float x) { return x / (1.f + __expf(-x)); }
DI int tok_v(int t) { return t < TP_ ? 0 : 1 + ((t - TP_) >> 11); }
DI int crow(int r, int h2) { return (r & 3) + 8 * (r >> 2) + 4 * h2; }
DI bf16x8 mk8(unsigned a, unsigned b, unsigned c, unsigned d) {
  uint4 p = make_uint4(a, b, c, d);
  return __builtin_bit_cast(bf16x8, p);
}
DI bf16x8 pack_acc(const f32x16& x, int s) {
  return mk8(pack2(x[8 * s], x[8 * s + 1]), pack2(x[8 * s + 2], x[8 * s + 3]), pack2(x[8 * s + 4], x[8 * s + 5]),
             pack2(x[8 * s + 6], x[8 * s + 7]));
}
DI bf16x8 load_perm(const u16* rowptr, int s, int h2) {
  uint2 a = *(const uint2*)(rowptr + 16 * s + 4 * h2);
  uint2 b = *(const uint2*)(rowptr + 16 * s + 8 + 4 * h2);
  return mk8(a.x, a.y, b.x, b.y);
}
DI unsigned swap16(unsigned u) { return (u >> 16) | (u << 16); }
DI bf16x8 load_perm_rev(const u16* rowptr, int base, int s, int h2) {
  uint2 a = *(const uint2*)(rowptr + 60 - base - 16 * s - 4 * h2);
  uint2 b = *(const uint2*)(rowptr + 52 - base - 16 * s - 4 * h2);
  return mk8(swap16(a.y), swap16(a.x), swap16(b.y), swap16(b.x));
}
#define MFMA16(a, b, c) __builtin_amdgcn_mfma_f32_16x16x32_bf16((a), (b), (c), 0, 0, 0)
#define MFMA32(a, b, c) __builtin_amdgcn_mfma_f32_32x32x16_bf16((a), (b), (c), 0, 0, 0)

template <int NJ>
DI void gemm_core(f32x4 (&acc)[4][NJ], const u16* __restrict__ A, int lda, const u16* __restrict__ B, int ldb, int K,
                  u16* sm) {
  const int tid = otid(), lane = tid & 63, w = tid >> 6, wr = w >> 1, wc = w & 1;
  const int fr = lane & 15, fq = lane >> 4;
  constexpr int RS = 136;
  const int lrow = tid >> 4, lkc = tid & 15;
  uint4 a0, a1, a2, a3, a4, a5, a6, a7, b0, b1, b2, b3, b4, b5, b6, b7;
  b4 = b5 = b6 = b7 = make_uint4(0, 0, 0, 0);
  const u16* ap = A + (size_t)lrow * lda + lkc * 8;
  const u16* bp = B + (size_t)lrow * ldb + lkc * 8;
  const int nk = K >> 7;
  u16* as = sm;
  u16* bs = sm + 128 * RS;
  {
    const int k0 = 0;
    a0 = *(const uint4*)(ap + (size_t)(0 * 16) * lda + k0);
    a1 = *(const uint4*)(ap + (size_t)(1 * 16) * lda + k0);
    a2 = *(const uint4*)(ap + (size_t)(2 * 16) * lda + k0);
    a3 = *(const uint4*)(ap + (size_t)(3 * 16) * lda + k0);
    a4 = *(const uint4*)(ap + (size_t)(4 * 16) * lda + k0);
    a5 = *(const uint4*)(ap + (size_t)(5 * 16) * lda + k0);
    a6 = *(const uint4*)(ap + (size_t)(6 * 16) * lda + k0);
    a7 = *(const uint4*)(ap + (size_t)(7 * 16) * lda + k0);
    b0 = *(const uint4*)(bp + (size_t)(0 * 16) * ldb + k0);
    b1 = *(const uint4*)(bp + (size_t)(1 * 16) * ldb + k0);
    b2 = *(const uint4*)(bp + (size_t)(2 * 16) * ldb + k0);
    b3 = *(const uint4*)(bp + (size_t)(3 * 16) * ldb + k0);
    if (NJ == 4) b4 = *(const uint4*)(bp + (size_t)(4 * 16) * ldb + k0);
    if (NJ == 4) b5 = *(const uint4*)(bp + (size_t)(5 * 16) * ldb + k0);
    if (NJ == 4) b6 = *(const uint4*)(bp + (size_t)(6 * 16) * ldb + k0);
    if (NJ == 4) b7 = *(const uint4*)(bp + (size_t)(7 * 16) * ldb + k0);
  }
  for (int kt = 0; kt < nk; ++kt) {
    __syncthreads();
    *(uint4*)(as + (lrow + 0 * 16) * RS + lkc * 8) = a0;
    *(uint4*)(as + (lrow + 1 * 16) * RS + lkc * 8) = a1;
    *(uint4*)(as + (lrow + 2 * 16) * RS + lkc * 8) = a2;
    *(uint4*)(as + (lrow + 3 * 16) * RS + lkc * 8) = a3;
    *(uint4*)(as + (lrow + 4 * 16) * RS + lkc * 8) = a4;
    *(uint4*)(as + (lrow + 5 * 16) * RS + lkc * 8) = a5;
    *(uint4*)(as + (lrow + 6 * 16) * RS + lkc * 8) = a6;
    *(uint4*)(as + (lrow + 7 * 16) * RS + lkc * 8) = a7;
    *(uint4*)(bs + (lrow + 0 * 16) * RS + lkc * 8) = b0;
    *(uint4*)(bs + (lrow + 1 * 16) * RS + lkc * 8) = b1;
    *(uint4*)(bs + (lrow + 2 * 16) * RS + lkc * 8) = b2;
    *(uint4*)(bs + (lrow + 3 * 16) * RS + lkc * 8) = b3;
    if (NJ == 4) *(uint4*)(bs + (lrow + 4 * 16) * RS + lkc * 8) = b4;
    if (NJ == 4) *(uint4*)(bs + (lrow + 5 * 16) * RS + lkc * 8) = b5;
    if (NJ == 4) *(uint4*)(bs + (lrow + 6 * 16) * RS + lkc * 8) = b6;
    if (NJ == 4) *(uint4*)(bs + (lrow + 7 * 16) * RS + lkc * 8) = b7;
    __syncthreads();
    {
      const int k0 = (kt + 1 < nk ? kt + 1 : kt) * 128;
    a0 = *(const uint4*)(ap + (size_t)(0 * 16) * lda + k0);
    a1 = *(const uint4*)(ap + (size_t)(1 * 16) * lda + k0);
    a2 = *(const uint4*)(ap + (size_t)(2 * 16) * lda + k0);
    a3 = *(const uint4*)(ap + (size_t)(3 * 16) * lda + k0);
    a4 = *(const uint4*)(ap + (size_t)(4 * 16) * lda + k0);
    a5 = *(const uint4*)(ap + (size_t)(5 * 16) * lda + k0);
    a6 = *(const uint4*)(ap + (size_t)(6 * 16) * lda + k0);
    a7 = *(const uint4*)(ap + (size_t)(7 * 16) * lda + k0);
    b0 = *(const uint4*)(bp + (size_t)(0 * 16) * ldb + k0);
    b1 = *(const uint4*)(bp + (size_t)(1 * 16) * ldb + k0);
    b2 = *(const uint4*)(bp + (size_t)(2 * 16) * ldb + k0);
    b3 = *(const uint4*)(bp + (size_t)(3 * 16) * ldb + k0);
    if (NJ == 4) b4 = *(const uint4*)(bp + (size_t)(4 * 16) * ldb + k0);
    if (NJ == 4) b5 = *(const uint4*)(bp + (size_t)(5 * 16) * ldb + k0);
    if (NJ == 4) b6 = *(const uint4*)(bp + (size_t)(6 * 16) * ldb + k0);
    if (NJ == 4) b7 = *(const uint4*)(bp + (size_t)(7 * 16) * ldb + k0);
    }
#pragma unroll
    for (int ks = 0; ks < 4; ++ks) {
      bf16x8 af[4], bfr[NJ];
#pragma unroll
      for (int i = 0; i < 4; ++i) af[i] = *(const bf16x8*)(as + (wr * 64 + i * 16 + fr) * RS + ks * 32 + fq * 8);
#pragma unroll
      for (int j = 0; j < NJ; ++j) bfr[j] = *(const bf16x8*)(bs + (wc * NJ * 16 + j * 16 + fr) * RS + ks * 32 + fq * 8);
#pragma unroll
      for (int i = 0; i < 4; ++i)
#pragma unroll
        for (int j = 0; j < NJ; ++j) acc[i][j] = MFMA16(af[i], bfr[j], acc[i][j]);
    }
  }
}
template <int NJ>
DI void zero_acc(f32x4 (&acc)[4][NJ]) {
#pragma unroll
  for (int i = 0; i < 4; ++i)
#pragma unroll
    for (int j = 0; j < NJ; ++j) acc[i][j] = f32x4{0.f, 0.f, 0.f, 0.f};
}
#define EPI_LOOP(NJ_)                                                              \
  const int e_lane = otid() & 63, e_w = otid() >> 6;                     \
  const int e_wr = e_w >> 1, e_wc = e_w & 1, e_fr = e_lane & 15, e_fq = e_lane >> 4; \
  _Pragma("unroll") for (int i = 0; i < 4; ++i)                                    \
  _Pragma("unroll") for (int j = 0; j < NJ_; ++j)                                  \
  _Pragma("unroll") for (int r = 0; r < 4; ++r)
#define EROW (e_wr * 64 + i * 16 + e_fq * 4 + r)
#define ECOL(NJ_) (e_wc * NJ_ * 16 + j * 16 + e_fr)

DI int colmap(int kind, int n) {
  if (kind == 0) {
    if (n < 2048) return n;
    if (n < 2560) return 2064 + (n - 2048);
    if (n < 2944) return 2576 + (n - 2560);
    if (n < 3200) return 2960 + (n - 2944);
    int j = n - 3200;
    if (j < 16) return 2048 + j;
    if (j < 48) return 3216 + (j - 16);
    return -1;
  }
  if (kind == 1) return 3248 + n;
  return n;
}
DI void convT_tile(const float* __restrict__ src, int lds, int K, u16* __restrict__ dst, int kind, int kt, int nt,
                   float* sm) {
  const int tid = otid();
  const int c = tid & 63;
  const int sc = colmap(kind, nt * 64 + c);
  __syncthreads();
#pragma unroll 4
  for (int i = 0; i < 16; ++i) {
    int r = (tid >> 6) + i * 4;
    float v = sc >= 0 ? src[(size_t)(kt * 64 + r) * lds + sc] : 0.f;
    sm[r * 65 + c] = v;
  }
  __syncthreads();
  const int n = tid >> 2, kq = tid & 3;
  unsigned pk[8];
#pragma unroll
  for (int j = 0; j < 8; ++j) pk[j] = pack2(sm[(kq * 16 + 2 * j) * 65 + n], sm[(kq * 16 + 2 * j + 1) * 65 + n]);
  u16* d = dst + (size_t)(nt * 64 + n) * K + kt * 64 + kq * 16;
  *(uint4*)d = make_uint4(pk[0], pk[1], pk[2], pk[3]);
  *(uint4*)(d + 8) = make_uint4(pk[4], pk[5], pk[6], pk[7]);
}
constexpr int CJ0 = 16 * 52, CJ1 = CJ0 + 16 * 48, CJ2 = CJ1 + 6 * 12, CJ3 = CJ2 + 4 * 16, CJ4 = CJ3 + 8 * 8,
              CJ5 = CJ4 + 24 * 16, CJ6 = CJ5 + 16 * 16, CJ7 = CJ6 + 16 * 88, CJ8 = CJ7 + 44 * 16;
DI void conv_job(const Params& p, int l, int j, float* sm) {
  u16* wl = (u16*)(p.ws + B_W) + (size_t)l * W_LAYER;
  if (j < CJ0) { convT_tile(p.in[13] + (size_t)l * 1024 * 6320, 6320, 1024, wl + W_IN, 0, j / 52, j % 52, sm); return; }
  if (j < CJ1) { j -= CJ0; convT_tile(p.in[13] + (size_t)l * 1024 * 6320, 6320, 1024, wl + W_G, 1, j / 48, j % 48, sm); return; }
  if (j < CJ2) { j -= CJ1; convT_tile(p.in[29] + (size_t)l * 384 * 768, 768, 384, wl + W_QB, 2, j / 12, j % 12, sm); return; }
  if (j < CJ3) { j -= CJ2; convT_tile(p.in[31] + (size_t)l * 256 * 1024, 1024, 256, wl + W_KVB, 2, j / 16, j % 16, sm); return; }
  if (j < CJ4) { j -= CJ3; convT_tile(p.in[26] + (size_t)l * 512 * 512, 512, 512, wl + W_GLU, 2, j / 8, j % 8, sm); return; }
  if (j < CJ5) { j -= CJ4; convT_tile(p.in[32] + (size_t)l * 1536 * 1024, 1024, 1536, wl + W_BR, 2, j / 16, j % 16, sm); return; }
  if (j < CJ6) { j -= CJ5; convT_tile(p.in[33] + (size_t)l * 1024 * 1024, 1024, 1024, wl + W_OUT, 2, j / 16, j % 16, sm); return; }
  if (j < CJ7) { j -= CJ6; convT_tile(p.in[34] + (size_t)l * 1024 * 5632, 5632, 1024, wl + W_UP, 2, j / 88, j % 88, sm); return; }
  j -= CJ7; convT_tile(p.in[37] + (size_t)l * 2816 * 1024, 1024, 2816, wl + W_DN, 2, j / 16, j % 16, sm);
}
DI void mods_tile(const Params& p, int l, int jg, float* sm) {
  const int tid = otid();
  __syncthreads();
  for (int i = tid; i < 9 * 1024; i += 256) {
    int v = i >> 10, k = i & 1023;
    float cv = v == 0 ? p.in[8][k] : p.in[7][(v - 1) * 1024 + k];
    sm[i] = cv / (1.f + __expf(-cv));
  }
  __syncthreads();
  const int col = jg * 64 + (tid & 63), kq = tid >> 6;
  float acc[9];
#pragma unroll
  for (int v = 0; v < 9; ++v) acc[v] = 0.f;
  const float* wp = p.in[9] + (size_t)l * 1024 * 6144 + col;
#pragma unroll 4
  for (int k = kq * 256; k < kq * 256 + 256; ++k) {
    float wv = wp[(size_t)k * 6144];
#pragma unroll
    for (int v = 0; v < 9; ++v) acc[v] += sm[v * 1024 + k] * wv;
  }
  float* red = sm + 9 * 1024;
#pragma unroll
  for (int v = 0; v < 9; ++v) red[(kq * 9 + v) * 64 + (tid & 63)] = acc[v];
  __syncthreads();
  if (kq == 0) {
    float* mods = (float*)(p.ws + B_MODS);
    float b = p.in[10][l * 6144 + col];
#pragma unroll
    for (int v = 0; v < 9; ++v) {
      float s = red[(0 * 9 + v) * 64 + tid] + red[(1 * 9 + v) * 64 + tid] + red[(2 * 9 + v) * 64 + tid] + red[(3 * 9 + v) * 64 + tid];
      mods[(size_t)(l * 9 + v) * 6144 + col] = s + b;
    }
  }
}
DI void s5pre_tile(const Params& p, int tile) {
  const int id = tile * 256 + otid();
  const int pp = id & 63, g = (id >> 6) & 31, dir = (id >> 11) & 1, l = id >> 12;
  const float lre = p.in[18][((l * 2 + dir) * 32 + g) * 64 + pp];
  const float lim = p.in[19][((l * 2 + dir) * 32 + g) * 64 + pp];
  const float dt = expf(p.in[20][(l * 2 + dir) * 32 + g]);
  float er = expf(lre * dt), sn, cs;
  sincosf(lim * dt, &sn, &cs);
  const float lbr = er * cs, lbi = er * sn;
  float e64 = expf(64.f * lre * dt), s64, c64;
  sincosf(64.f * lim * dt, &s64, &c64);
  float2* lamb = (float2*)(p.ws + B_LAMB);
  float2* lam64 = (float2*)(p.ws + B_LAM64);
  const int li = ((l * 2 + dir) * 32 + g) * 64 + pp;
  lamb[li] = make_float2(lbr, lbi);
  lam64[li] = make_float2(e64 * c64, e64 * s64);
  const float nr = lbr - 1.f, ni = lbi, den = lre * lre + lim * lim;
  const float cr = (nr * lre + ni * lim) / den, ci = (ni * lre - nr * lim) / den;
  u16* bbt = (u16*)(p.ws + B_BBT) + (size_t)((l * 2 + dir) * 32 + g) * 128 * 16;
  const float* bre = p.in[21] + (size_t)((l * 32 + g) * 64 + pp) * 16;
  const float* bim = p.in[22] + (size_t)((l * 32 + g) * 64 + pp) * 16;
#pragma unroll
  for (int c = 0; c < 16; ++c) {
    float br = bre[c], bi = bim[c];
    bbt[pp * 16 + c] = f2bf(cr * br - ci * bi);
    bbt[(64 + pp) * 16 + c] = f2bf(cr * bi + ci * br);
  }
  if (dir == 0) {
    u16* cmt = (u16*)(p.ws + B_CMT) + (size_t)(l * 32 + g) * 16 * 128;
    const float* cre = p.in[23] + (size_t)(l * 32 + g) * 16 * 64;
    const float* cim = p.in[24] + (size_t)(l * 32 + g) * 16 * 64;
#pragma unroll
    for (int c = 0; c < 16; ++c) {
      cmt[c * 128 + pp] = f2bf(cre[c * 64 + pp]);
      cmt[c * 128 + 64 + pp] = f2bf(-cim[c * 64 + pp]);
    }
  }
}

DI void norm_phase(const Params& p, int l, int shift_idx, int scale_idx, const float* gn) {
  const float* x = p.out;
  u16* H = (u16*)(p.ws + B_H);
  const float* mods = (const float*)(p.ws + B_MODS);
  const int lane = otid() & 63, w = otid() >> 6;
  for (int tile = blockIdx.x; tile < T_ / 4; tile += gridDim.x) {
    const int t = tile * 4 + w;
    const float4* xr = (const float4*)(x + (size_t)t * 1024);
    float4 v[4];
    float ss = 0.f;
#pragma unroll
    for (int j = 0; j < 4; ++j) {
      v[j] = xr[lane + 64 * j];
      ss += v[j].x * v[j].x + v[j].y * v[j].y + v[j].z * v[j].z + v[j].w * v[j].w;
    }
    ss = wave_sum(ss);
    const float rstd = rsqrtf(ss * (1.f / 1024.f) + 1e-6f);
    const float* mb = mods + (size_t)(l * 9 + tok_v(t)) * 6144;
#pragma unroll
    for (int j = 0; j < 4; ++j) {
      const int c = (lane + 64 * j) * 4;
      float4 g = *(const float4*)(gn + c);
      float4 sc = *(const float4*)(mb + scale_idx * 1024 + c);
      float4 sh = *(const float4*)(mb + shift_idx * 1024 + c);
      float y0 = v[j].x * rstd * g.x * (1.f + sc.x) + sh.x;
      float y1 = v[j].y * rstd * g.y * (1.f + sc.y) + sh.y;
      float y2 = v[j].z * rstd * g.z * (1.f + sc.z) + sh.z;
      float y3 = v[j].w * rstd * g.w * (1.f + sc.w) + sh.w;
      *(uint2*)(H + (size_t)t * 1024 + c) = make_uint2(pack2(y0, y1), pack2(y2, y3));
    }
  }
}

DI void gemm_in_phase(const Params& p, int l, u16* sm) {
  const u16* H = (const u16*)(p.ws + B_H);
  const u16* Wt = (const u16*)(p.ws + B_W) + (size_t)l * W_LAYER + W_IN;
  for (int tile = blockIdx.x; tile < 192 * 26; tile += gridDim.x) {
    const int mt = tile / 26, nt = tile % 26;
    f32x4 acc[4][4];
    zero_acc<4>(acc);
    gemm_core<4>(acc, H + (size_t)mt * 128 * 1024, 1024, Wt + (size_t)nt * 128 * 1024, 1024, 1024, sm);
    if (nt < 25) {
      u16* dst; int ld, c0;
      if (nt < 12) { dst = (u16*)(p.ws + B_QKV); ld = 1536; c0 = nt * 128; }
      else if (nt < 16) { dst = (u16*)(p.ws + B_Z); ld = 512; c0 = (nt - 12) * 128; }
      else if (nt < 20) { dst = (u16*)(p.ws + B_US5); ld = 512; c0 = (nt - 16) * 128; }
      else if (nt < 23) { dst = (u16*)(p.ws + B_QA); ld = 384; c0 = (nt - 20) * 128; }
      else { dst = (u16*)(p.ws + B_KVA); ld = 256; c0 = (nt - 23) * 128; }
      EPI_LOOP(4) { dst[(size_t)(mt * 128 + EROW) * ld + c0 + ECOL(4)] = f2bf(acc[i][j][r]); }
    } else {
      float* misc = (float*)(p.ws + B_MISC);
      EPI_LOOP(4) {
        int c = ECOL(4);
        if (c < 48) misc[(size_t)(mt * 128 + EROW) * 48 + c] = acc[i][j][r];
      }
    }
  }
}

DI void delta_prep_tile(const Params& p, int l, int chunk, u16* sm) {
  const int tid = otid(), lane = tid & 63, w = tid >> 6;
  const int tb = chunk * 64;
  int pos0, L;
  if (tb < TP_) { pos0 = tb & 255; L = 256; } else { pos0 = (tb - TP_) & 2047; L = 2048; }
  const u16* qkv = (const u16*)(p.ws + B_QKV);
  const float* cw = p.in[14] + (size_t)l * 5 * 1536;
  u16* ksm = sm + w * (64 * 130);
  __syncthreads();
  for (int gi = w; gi < 12; gi += 4) {
    const int ch = gi * 128 + 2 * lane;
    float w0[5], w1[5];
#pragma unroll
    for (int i = 0; i < 5; ++i) { w0[i] = cw[i * 1536 + ch]; w1[i] = cw[i * 1536 + ch + 1]; }
    float a0[5], a1[5];
#pragma unroll
    for (int i = 0; i < 4; ++i) {
      int ps = pos0 - 2 + i;
      unsigned u = (ps >= 0 && ps < L) ? *(const unsigned*)(qkv + (size_t)(tb - 2 + i) * 1536 + ch) : 0u;
      a0[i + 1] = blo(u); a1[i + 1] = bhi(u);
    }
    u16* dst = (u16*)(p.ws + (gi < 4 ? B_QN : (gi < 8 ? B_KN : B_VV)));
    const int hh = gi & 3;
    for (int tt = 0; tt < 64; ++tt) {
#pragma unroll
      for (int i = 0; i < 4; ++i) { a0[i] = a0[i + 1]; a1[i] = a1[i + 1]; }
      {
        int ps = pos0 + tt + 2;
        unsigned u = (ps < L) ? *(const unsigned*)(qkv + (size_t)(tb + tt + 2) * 1536 + ch) : 0u;
        a0[4] = blo(u); a1[4] = bhi(u);
      }
      float y0 = 0.f, y1 = 0.f;
#pragma unroll
      for (int i = 0; i < 5; ++i) { y0 += w0[i] * a0[i]; y1 += w1[i] * a1[i]; }
      y0 = siluf_(y0); y1 = siluf_(y1);
      if (gi < 8) {
        float ss = wave_sum(y0 * y0 + y1 * y1);
        float sc = rsqrtf(ss + 1e-6f);
        if (gi < 4) sc *= 0.08838834764831845f;
        y0 *= sc; y1 *= sc;
      }
      const unsigned pk = pack2(y0, y1);
      *(unsigned*)(dst + (size_t)(tb + tt) * 512 + hh * 128 + 2 * lane) = pk;
      if (gi >= 4 && gi < 8) *(unsigned*)(ksm + tt * 130 + 2 * lane) = pk;
    }
    if (gi >= 4 && gi < 8) {
      u16* kt = (u16*)(p.ws + B_KT) + (size_t)(chunk * 4 + hh) * 128 * 64;
#pragma unroll
      for (int rr = 0; rr < 2; ++rr) {
        const int dk = lane + 64 * rr;
        unsigned pk[32];
#pragma unroll
        for (int t2 = 0; t2 < 32; ++t2) pk[t2] = (unsigned)ksm[(2 * t2) * 130 + dk] | ((unsigned)ksm[(2 * t2 + 1) * 130 + dk] << 16);
#pragma unroll
        for (int q = 0; q < 8; ++q) *(uint4*)(kt + dk * 64 + q * 8) = make_uint4(pk[4 * q], pk[4 * q + 1], pk[4 * q + 2], pk[4 * q + 3]);
      }
    }
  }
  const float* misc = (const float*)(p.ws + B_MISC);
  float* bg = (float*)(p.ws + B_BG);
  for (int i = tid; i < 512; i += 256) {
    const int tt = i >> 3, dh = i & 7;
    const size_t t = tb + tt;
    float bl = misc[t * 48 + dh], alp = misc[t * 48 + 8 + dh];
    float x = alp + p.in[16][l * 8 + dh];
    float sp = x > 20.f ? x : log1pf(__expf(x));
    bg[t * 16 + dh] = sigmoidf_(bl);
    bg[t * 16 + 8 + dh] = -__expf(p.in[15][l * 8 + dh]) * sp;
  }
}

DI size_t kb_off(int t, int head) {
  if (t < TP_) return ((size_t)((t >> 8) * 8 + head) * 256 + (t & 255)) * 96;
  const int s = (t - TP_) >> 11, pos = (t - TP_) & 2047;
  return KB_P + ((size_t)(s * 8 + head) * 2304 + 256 + pos) * 96;
}
DI void mla_prep_tile(const Params& p, int l, int tile) {
  const int lane = otid() & 63, w = otid() >> 6;
  const int t = tile * 4 + w;
  u16* qa = (u16*)(p.ws + B_QA) + (size_t)t * 384;
  u16* kva = (u16*)(p.ws + B_KVA) + (size_t)t * 256;
  const float* misc = (const float*)(p.ws + B_MISC) + (size_t)t * 48;
  {
    unsigned u[3]; float ss = 0.f;
#pragma unroll
    for (int j = 0; j < 3; ++j) { u[j] = *(const unsigned*)(qa + 2 * lane + 128 * j); float a = blo(u[j]), b = bhi(u[j]); ss += a * a + b * b; }
    ss = wave_sum(ss);
    const float rstd = rsqrtf(ss * (1.f / 384.f) + 1e-6f);
    const float* g = p.in[28] + l * 384;
#pragma unroll
    for (int j = 0; j < 3; ++j) {
      int c = 2 * lane + 128 * j;
      *(unsigned*)(qa + c) = pack2(blo(u[j]) * rstd * g[c], bhi(u[j]) * rstd * g[c + 1]);
    }
  }
  {
    unsigned u[2]; float ss = 0.f;
#pragma unroll
    for (int j = 0; j < 2; ++j) { u[j] = *(const unsigned*)(kva + 2 * lane + 128 * j); float a = blo(u[j]), b = bhi(u[j]); ss += a * a + b * b; }
    ss = wave_sum(ss);
    const float rstd = rsqrtf(ss * (1.f / 256.f) + 1e-6f);
    const float* g = p.in[30] + l * 256;
#pragma unroll
    for (int j = 0; j < 2; ++j) {
      int c = 2 * lane + 128 * j;
      float a = blo(u[j]) * rstd * g[c], b = bhi(u[j]) * rstd * g[c + 1];
      *(unsigned*)(kva + c) = pack2(a, b);
      if (t < TP_) {
        float* o = p.out + O_CKV + ((size_t)((t >> 8) * 4 + l) * 256 + (t & 255)) * 256 + c;
        *(float2*)o = make_float2(a, b);
      }
    }
  }
  {
    const int i = lane & 31;
    float kr = misc[16 + i];
    float val;
    if (t < TP_) {
      val = kr;
      if (lane < 32) p.out[O_KR + ((size_t)((t >> 8) * 4 + l) * 256 + (t & 255)) * 32 + i] = kr;
    } else {
      const int pos = (t - TP_) & 2047;
      const float* rp = (const float*)(p.ws + B_ROPE) + (size_t)pos * 32 + (i & 15) * 2;
      const float cs = rp[0], sn = rp[1];
      float other = __shfl_xor(kr, 16);
      val = (i < 16) ? (kr * cs - other * sn) : (kr * cs + other * sn);
    }
    u16* kb = (u16*)(p.ws + B_KB);
    const u16 bv = f2bf(val);
#pragma unroll
    for (int hh = 0; hh < 4; ++hh) {
      int head = hh * 2 + (lane >> 5);
      kb[kb_off(t, head) + 64 + i] = bv;
    }
  }
}
DI void cache_rope_tile(const Params& p, int l, int tile) {
  const int pr = tile * 8 + (otid() >> 5), i = otid() & 31;
  const int s = pr >> 8, pos = pr & 255;
  const float v = p.in[6][((size_t)(s * 4 + l) * 256 + pos) * 32 + i];
  u16* kb = (u16*)(p.ws + B_KB);
  const u16 bv = f2bf(v);
#pragma unroll
  for (int head = 0; head < 8; ++head) kb[KB_P + ((size_t)(s * 8 + head) * 2304 + pos) * 96 + 64 + i] = bv;
}

DI float gelu_tanh(float x) {
  const float k0 = 0.7978845608028654f, k1 = 0.044715f;
  float u = k0 * (x + k1 * x * x * x);
  float e = __expf(2.f * u);
  float th = 1.f - 2.f / (e + 1.f);
  return 0.5f * x * (1.f + th);
}
DI void s5_chunk_tile(const Params& p, int l, int chunk, int gp, int mode, u16* sm) {
  const int tid = otid(), lane = tid & 63, w = tid >> 6;
  const u16* us5 = (const u16*)(p.ws + B_US5);
  constexpr int RS = 136;
  __syncthreads();
  {
    const int gi = w >> 1, half = w & 1, g = gp * 2 + gi;
    const int n = lane & 31, h2 = lane >> 5;
    bf16x8 af[2];
#pragma unroll
    for (int mi = 0; mi < 2; ++mi) af[mi] = *(const bf16x8*)(us5 + (size_t)(chunk * 64 + mi * 32 + n) * 512 + g * 16 + 8 * h2);
#pragma unroll
    for (int dir = 0; dir < 2; ++dir) {
      const u16* bbt = (const u16*)(p.ws + B_BBT) + (size_t)((l * 2 + dir) * 32 + g) * 128 * 16;
#pragma unroll
      for (int nn = 0; nn < 2; ++nn) {
        const int nt = half * 2 + nn;
        bf16x8 bfr = *(const bf16x8*)(bbt + (nt * 32 + n) * 16 + 8 * h2);
#pragma unroll
        for (int mi = 0; mi < 2; ++mi) {
          f32x16 acc;
#pragma unroll
          for (int r = 0; r < 16; ++r) acc[r] = 0.f;
          acc = MFMA32(af[mi], bfr, acc);
          u16* d = sm + (size_t)((gi * 2 + dir) * 64 + mi * 32) * RS + nt * 32 + n;
#pragma unroll
          for (int r = 0; r < 16; ++r) d[crow(r, h2) * RS] = f2bf(acc[r]);
        }
      }
    }
  }
  __syncthreads();
  {
    const int gi = tid >> 7, dir = (tid >> 6) & 1, pp = tid & 63, g = gp * 2 + gi;
    const float2 lb = ((const float2*)(p.ws + B_LAMB))[((l * 2 + dir) * 32 + g) * 64 + pp];
    const size_t hidx = ((size_t)(chunk * 32 + g) * 2 + dir) * 64 + pp;
    float hr = 0.f, hi = 0.f;
    if (mode) { float2 h0 = ((const float2*)(p.ws + B_HIN))[hidx]; hr = h0.x; hi = h0.y; }
    u16* base = sm + (size_t)((gi * 2 + dir) * 64) * RS;
#pragma unroll 8
    for (int st = 0; st < 64; ++st) {
      const int tk = dir ? 63 - st : st;
      float br = bf2f(base[tk * RS + pp]), bi = bf2f(base[tk * RS + 64 + pp]);
      float nr = __builtin_fmaf(lb.x, hr, __builtin_fmaf(-lb.y, hi, br));
      float ni = __builtin_fmaf(lb.x, hi, __builtin_fmaf(lb.y, hr, bi));
      asm volatile("" : "+v"(nr));
      asm volatile("" : "+v"(ni));
      hr = nr; hi = ni;
      if (mode) { base[tk * RS + pp] = f2bf(hr); base[tk * RS + 64 + pp] = f2bf(hi); }
    }
    if (!mode) ((float2*)(p.ws + B_HEND))[hidx] = make_float2(hr, hi);
  }
  if (!mode) return;
  __syncthreads();
  {
    const int gi = w >> 1, g = gp * 2 + gi;
    const int fr = lane & 15, fq = lane >> 4;
    const u16* cmt = (const u16*)(p.ws + B_CMT) + (size_t)(l * 32 + g) * 16 * 128;
    f32x4 acc[2];
    acc[0] = f32x4{0.f, 0.f, 0.f, 0.f}; acc[1] = acc[0];
#pragma unroll
    for (int ks = 0; ks < 8; ++ks) {
      const int dir = ks >> 2, kk = (ks & 3) * 32;
      bf16x8 bfr = *(const bf16x8*)(cmt + fr * 128 + kk + fq * 8);
#pragma unroll
      for (int mm = 0; mm < 2; ++mm) {
        const int mi = (w & 1) * 2 + mm;
        bf16x8 af = *(const bf16x8*)(sm + (size_t)((gi * 2 + dir) * 64 + mi * 16 + fr) * RS + kk + fq * 8);
        acc[mm] = MFMA16(af, bfr, acc[mm]);
      }
    }
    const float dsk = p.in[25][l * 512 + g * 16 + fr];
    u16* y5 = (u16*)(p.ws + B_Y5);
#pragma unroll
    for (int mm = 0; mm < 2; ++mm)
#pragma unroll
      for (int r = 0; r < 4; ++r) {
        const size_t t = (size_t)chunk * 64 + ((w & 1) * 2 + mm) * 16 + fq * 4 + r;
        float u = bf2f(us5[t * 512 + g * 16 + fr]);
        float y = acc[mm][r] + dsk * u;
        y5[t * 512 + g * 16 + fr] = f2bf(gelu_tanh(y));
      }
  }
}
DI void s5_carry_tile(const Params& p, int l, int tile) {
  const int seq = tile >> 4, gp = tile & 15;
  const int tid = otid(), gi = tid >> 7, dir = (tid >> 6) & 1, pp = tid & 63, g = gp * 2 + gi;
  int c0, nc;
  if (seq < 32) { c0 = seq * 4; nc = 4; } else { c0 = 128 + (seq - 32) * 32; nc = 32; }
  const float2 l64 = ((const float2*)(p.ws + B_LAM64))[((l * 2 + dir) * 32 + g) * 64 + pp];
  float hr = 0.f, hi = 0.f;
  if (seq >= 32) {
    const size_t si = ((size_t)((seq - 32) * 4 + l) * 2 + dir) * 2048 + g * 64 + pp;
    hr = p.in[3][si]; hi = p.in[4][si];
  }
  const float2* hend = (const float2*)(p.ws + B_HEND);
  float2* hin = (float2*)(p.ws + B_HIN);
  for (int it = 0; it < nc; ++it) {
    const int ck = c0 + (dir ? nc - 1 - it : it);
    const size_t idx = ((size_t)(ck * 32 + g) * 2 + dir) * 64 + pp;
    hin[idx] = make_float2(hr, hi);
    float2 he = hend[idx];
    float nr = __builtin_fmaf(l64.x, hr, __builtin_fmaf(-l64.y, hi, he.x));
    float ni = __builtin_fmaf(l64.x, hi, __builtin_fmaf(l64.y, hr, he.y));
    asm volatile("" : "+v"(nr));
    asm volatile("" : "+v"(ni));
    hr = nr; hi = ni;
  }
  if (seq < 32) {
    const size_t so = ((size_t)(seq * 4 + l) * 2 + dir) * 2048 + g * 64 + pp;
    p.out[O_S5RE + so] = hr;
    p.out[O_S5IM + so] = hi;
  }
}

DI void delta_local_tile(const Params& p, int tile, float* smf) {
  const int chunk = tile >> 1, dir = tile & 1;
  const int tid = otid(), lane = tid & 63, h = tid >> 6;
  const int m = lane & 31, h2 = lane >> 5;
  const int tb = chunk * 64;
  const float* bg = (const float*)(p.ws + B_BG);
  const u16* kn = (const u16*)(p.ws + B_KN);
  const u16* qn = (const u16*)(p.ws + B_QN);
  float* Aw = smf + h * 4096;
  const size_t cidx = ((size_t)(chunk * 4 + h) * 2 + dir);
  const int tl = tb + (dir ? 63 - lane : lane);
  float gcs = bg[(size_t)tl * 16 + 8 + dir * 4 + h];
  const float beta = bg[(size_t)tl * 16 + dir * 4 + h];
#pragma unroll
  for (int o = 1; o < 64; o <<= 1) {
    float v = __shfl_up(gcs, o);
    if (lane >= o) gcs += v;
  }
  ((float*)(p.ws + B_GC))[cidx * 64 + lane] = gcs;
  ((float*)(p.ws + B_BC))[cidx * 64 + lane] = beta;
  __syncthreads();
  u16* qkm = (u16*)(p.ws + B_QKM) + cidx * 4096;
#pragma unroll 1
  for (int tt = 0; tt < 3; ++tt) {
    const int mi = tt == 0 ? 0 : 1, ni = tt == 2 ? 1 : 0;
    const int cm = 32 * mi + m, cn = 32 * ni + m;
    const u16* krm = kn + (size_t)(tb + (dir ? 63 - cm : cm)) * 512 + h * 128 + h2 * 8;
    const u16* qrm = qn + (size_t)(tb + (dir ? 63 - cm : cm)) * 512 + h * 128 + h2 * 8;
    const u16* krn = kn + (size_t)(tb + (dir ? 63 - cn : cn)) * 512 + h * 128 + h2 * 8;
    f32x16 ak, aq;
#pragma unroll
    for (int r = 0; r < 16; ++r) { ak[r] = 0.f; aq[r] = 0.f; }
#pragma unroll
    for (int ks = 0; ks < 8; ++ks) {
      const bf16x8 fkm = *(const bf16x8*)(krm + ks * 16), fqm = *(const bf16x8*)(qrm + ks * 16), fkn = *(const bf16x8*)(krn + ks * 16);
      ak = MFMA32(fkm, fkn, ak);
      aq = MFMA32(fqm, fkn, aq);
    }
    const int e = 32 * ni + m;
    const float gce = __shfl(gcs, e);
#pragma unroll
    for (int r = 0; r < 16; ++r) {
      const int c = 32 * mi + crow(r, h2);
      const float gcc = __shfl(gcs, c), bc = __shfl(beta, c);
      const float dec = (e <= c) ? __expf(gcc - gce) : 0.f;
      Aw[c * 64 + e] = (e < c) ? ak[r] * bc * dec : 0.f;
      qkm[c * 64 + e] = f2bf(aq[r] * dec);
    }
  }
  __syncthreads();
  u16* tm = (u16*)(p.ws + B_TM) + cidx * 4096;
  float x[64];
#pragma unroll
  for (int i = 0; i < 64; ++i) {
    float a = (i == lane) ? 1.f : 0.f;
#pragma unroll
    for (int j = 0; j < i; ++j) a -= Aw[i * 64 + j] * x[j];
    x[i] = a;
    tm[i * 64 + lane] = f2bf(a);
  }
}

template <int dir>
DI void delta_scan_body(const Params& p, int l, int seq, int h, u16* sm);
DI void delta_scan_tile(const Params& p, int l, int idx, u16* sm) {
  int seq, h, dir;
  if (idx < 64) { seq = 32 + (idx >> 3); h = (idx >> 1) & 3; dir = idx & 1; }
  else { const int i2 = idx - 64; seq = i2 >> 3; h = (i2 >> 1) & 3; dir = i2 & 1; }
  if (dir) delta_scan_body<1>(p, l, seq, h, sm); else delta_scan_body<0>(p, l, seq, h, sm);
}
template <int dir>
DI void delta_scan_body(const Params& p, int l, int seq, int h, u16* sm) {
  int chunk0, nch;
  if (seq < 32) { chunk0 = seq * 4; nch = 4; } else { chunk0 = 128 + (seq - 32) * 32; nch = 32; }
  const int lane = otid() & 63, w = otid() >> 6;
  const int n = lane & 31, h2 = lane >> 5;
  const int dvc = w * 32 + n;
  const u16* kn = (const u16*)(p.ws + B_KN);
  const u16* qn = (const u16*)(p.ws + B_QN);
  const u16* vv = (const u16*)(p.ws + B_VV);
  u16* od = (u16*)(p.ws + (dir ? B_OB : B_OF));
  f32x16 S[4];
  if (seq >= 32) {
    const float* s0 = p.in[2] + ((size_t)(((seq - 32) * 4 + l) * 2 + dir) * 4 + h) * 16384;
#pragma unroll
    for (int t = 0; t < 4; ++t)
#pragma unroll
      for (int r = 0; r < 16; ++r) S[t][r] = s0[(size_t)(32 * t + crow(r, h2)) * 128 + dvc];
  } else {
#pragma unroll
    for (int t = 0; t < 4; ++t)
#pragma unroll
      for (int r = 0; r < 16; ++r) S[t][r] = 0.f;
  }
  for (int it = 0; it < nch; ++it) {
    const int chunk = chunk0 + (dir ? nch - 1 - it : it);
    const int tb = chunk * 64;
    const size_t cidx = ((size_t)(chunk * 4 + h) * 2 + dir);
    const float* gcp = (const float*)(p.ws + B_GC) + cidx * 64;
    const float* bcp = (const float*)(p.ws + B_BC) + cidx * 64;
    const u16* tm = (const u16*)(p.ws + B_TM) + cidx * 4096;
    const u16* qkm = (const u16*)(p.ws + B_QKM) + cidx * 4096;
    const u16* ktp = (const u16*)(p.ws + B_KT) + (size_t)(chunk * 4 + h) * 8192;
    const float glast = gcp[63];
    size_t trow[2];
#pragma unroll
    for (int mi = 0; mi < 2; ++mi) { const int c = 32 * mi + n; trow[mi] = (size_t)(tb + (dir ? 63 - c : c)); }
#define SCHED_FENCE() asm volatile("" ::: "memory")
    u16* Ks = sm; u16* Qs = sm + 8704; u16* Vs = sm + 17408; u16* KTs = sm + 26112;
    u16* vls = Vs + w * 32;
    __syncthreads();
    {
      const int tid_ = otid();
      const int r0 = tid_ >> 4, ck = tid_ & 15;
      uint4 tk[4], tq[4], tv[4], tt[4];
#pragma unroll
      for (int j = 0; j < 4; ++j) {
        const size_t go = (size_t)(tb + r0 + 16 * j) * 512 + h * 128 + ck * 8;
        tk[j] = *(const uint4*)(kn + go); tq[j] = *(const uint4*)(qn + go); tv[j] = *(const uint4*)(vv + go);
        tt[j] = *(const uint4*)(ktp + ((tid_ >> 3) + 32 * j) * 64 + (tid_ & 7) * 8);
      }
#pragma unroll
      for (int j = 0; j < 4; ++j) {
        const int tau = r0 + 16 * j, c = dir ? 63 - tau : tau;
        *(uint4*)(Ks + c * 136 + ck * 8) = tk[j]; *(uint4*)(Qs + c * 136 + ck * 8) = tq[j]; *(uint4*)(Vs + c * 136 + ck * 8) = tv[j];
        *(uint4*)(KTs + ((tid_ >> 3) + 32 * j) * 72 + (tid_ & 7) * 8) = tt[j];
      }
    }
    __syncthreads();
    f32x16 X[2], QS[2];
    {
      bf16x8 Sb[4][2];
#pragma unroll
      for (int t = 0; t < 4; ++t)
#pragma unroll
        for (int s = 0; s < 2; ++s) Sb[t][s] = pack_acc(S[t], s);
#pragma unroll
      for (int mi = 0; mi < 2; ++mi)
#pragma unroll
        for (int r = 0; r < 16; ++r) { X[mi][r] = 0.f; QS[mi][r] = 0.f; }
#pragma unroll
      for (int t = 0; t < 4; ++t) {
#pragma unroll
        for (int mi = 0; mi < 2; ++mi) {
          const u16* krow_ = Ks + (32 * mi + n) * 136;
          const u16* qrow_ = Qs + (32 * mi + n) * 136;
#pragma unroll
          for (int s = 0; s < 2; ++s) {
            X[mi] = MFMA32(load_perm(krow_ + 32 * t, s, h2), Sb[t][s], X[mi]);
            QS[mi] = MFMA32(load_perm(qrow_ + 32 * t, s, h2), Sb[t][s], QS[mi]);
          }
        }
        SCHED_FENCE();
      }
    }
    bf16x8 Rb[2][2];
#pragma unroll
    for (int mi = 0; mi < 2; ++mi) {
#pragma unroll
      for (int a = 0; a < 4; ++a) {
        const int c4 = 32 * mi + 8 * a + 4 * h2;
        const float4 g4 = *(const float4*)(gcp + c4);
        const float4 b4 = *(const float4*)(bcp + c4);
        const float gg[4] = {g4.x, g4.y, g4.z, g4.w};
        const float bb[4] = {b4.x, b4.y, b4.z, b4.w};
#pragma unroll
        for (int q = 0; q < 4; ++q) {
          const int c = c4 + q;
          const float v = bf2f(vls[c * 136 + n]);
          const float eg = __expf(gg[q]);
          X[mi][4 * a + q] = bb[q] * (v - eg * X[mi][4 * a + q]);
          QS[mi][4 * a + q] *= eg;
        }
      }
      Rb[mi][0] = pack_acc(X[mi], 0);
      Rb[mi][1] = pack_acc(X[mi], 1);
    }
    SCHED_FENCE();
    f32x16 Vn[2];
#pragma unroll
    for (int mo = 0; mo < 2; ++mo) {
#pragma unroll
      for (int r = 0; r < 16; ++r) Vn[mo][r] = 0.f;
#pragma unroll
      for (int mi = 0; mi <= mo; ++mi)
#pragma unroll
        for (int s = 0; s < 2; ++s) Vn[mo] = MFMA32(load_perm(tm + (32 * mo + n) * 64 + 32 * mi, s, h2), Rb[mi][s], Vn[mo]);
    }
    SCHED_FENCE();
    {
      bf16x8 Vb[2][2];
#pragma unroll
      for (int mi = 0; mi < 2; ++mi) { Vb[mi][0] = pack_acc(Vn[mi], 0); Vb[mi][1] = pack_acc(Vn[mi], 1); }
#pragma unroll
      for (int mo = 0; mo < 2; ++mo) {
#pragma unroll
        for (int mi = 0; mi <= mo; ++mi)
#pragma unroll
          for (int s = 0; s < 2; ++s) QS[mo] = MFMA32(load_perm(qkm + (32 * mo + n) * 64 + 32 * mi, s, h2), Vb[mi][s], QS[mo]);
      }
      __syncthreads();
#pragma unroll
      for (int mo = 0; mo < 2; ++mo)
#pragma unroll
        for (int r = 0; r < 16; ++r) vls[(32 * mo + crow(r, h2)) * 136 + n] = f2bf(QS[mo][r]);
      __syncthreads();
#pragma unroll
      for (int jv = 0; jv < 4; ++jv) {
        const int tau = (lane >> 2) + 16 * jv, cq = lane & 3;
        const uint4 oq = *(const uint4*)(vls + (dir ? 63 - tau : tau) * 136 + cq * 8);
        *(uint4*)(od + (size_t)(tb + tau) * 512 + h * 128 + w * 32 + cq * 8) = oq;
      }
    }
    SCHED_FENCE();
    bf16x8 Vsb[2][2];
#pragma unroll
    for (int mi = 0; mi < 2; ++mi) {
#pragma unroll
      for (int a = 0; a < 4; ++a) {
        const float4 g4 = *(const float4*)(gcp + 32 * mi + 8 * a + 4 * h2);
        Vn[mi][4 * a + 0] *= __expf(glast - g4.x); Vn[mi][4 * a + 1] *= __expf(glast - g4.y);
        Vn[mi][4 * a + 2] *= __expf(glast - g4.z); Vn[mi][4 * a + 3] *= __expf(glast - g4.w);
      }
      Vsb[mi][0] = pack_acc(Vn[mi], 0); Vsb[mi][1] = pack_acc(Vn[mi], 1);
    }
    const float eg = __expf(glast);
#pragma unroll
    for (int t = 0; t < 4; ++t) {
#pragma unroll
      for (int r = 0; r < 16; ++r) S[t][r] *= eg;
      const u16* ktrow = KTs + (32 * t + n) * 72;
#pragma unroll
      for (int mi = 0; mi < 2; ++mi)
#pragma unroll
        for (int s = 0; s < 2; ++s) {
          bf16x8 a = dir ? load_perm_rev(ktrow, 32 * mi, s, h2) : load_perm(ktrow + 32 * mi, s, h2);
          S[t] = MFMA32(a, Vsb[mi][s], S[t]);
        }
      SCHED_FENCE();
    }
  }
  if (seq < 32) {
    float* so = p.out + O_SD + ((size_t)((seq * 4 + l) * 2 + dir) * 4 + h) * 16384;
#pragma unroll
    for (int t = 0; t < 4; ++t)
#pragma unroll
      for (int r = 0; r < 16; ++r) so[(size_t)(32 * t + crow(r, h2)) * 128 + dvc] = S[t][r];
  }
}

DI void attn_tile(const Params& p, int seq, int head, int qb, u16* sm) {
  const int lane = otid() & 63, w = otid() >> 6;
  const int n = lane & 31, h2 = lane >> 5;
  int tq0, nkeys; size_t kbo, vto;
  if (seq < 32) { tq0 = seq * 256 + qb * 128 + w * 32; nkeys = 256; kbo = (size_t)(seq * 8 + head) * 256 * 96; vto = (size_t)(seq * 8 + head) * 64 * 256; }
  else { const int s = seq - 32; tq0 = TP_ + s * 2048 + qb * 128 + w * 32; nkeys = 2304; kbo = KB_P + (size_t)(s * 8 + head) * 2304 * 96; vto = VT_P + (size_t)(s * 8 + head) * 64 * 2304; }
  const u16* kb = (const u16*)(p.ws + B_KB) + kbo;
  const u16* vt = (const u16*)(p.ws + B_VT) + vto;
  const u16* qm = (const u16*)(p.ws + B_QM) + (size_t)(tq0 + n) * 768 + head * 96;
  bf16x8 qf[6];
#pragma unroll
  for (int ks = 0; ks < 6; ++ks) qf[ks] = *(const bf16x8*)(qm + ks * 16 + h2 * 8);
  f32x16 O[2];
#pragma unroll
  for (int r = 0; r < 16; ++r) { O[0][r] = 0.f; O[1][r] = 0.f; }
  float mrun = -1e30f, lsum = 0.f;
  const int nkt = nkeys >> 6;
  constexpr int KST = 104, VST = 72, STG = 64 * KST + 64 * VST;
  const int tid_ = otid();
  uint4 rk0, rk1, rk2, rv0, rv1;
  const int kc0 = tid_, kc1 = tid_ + 256, kc2 = tid_ + 512;
  const u16* kg0 = kb + (size_t)(kc0 / 12) * 96 + (kc0 % 12) * 8;
  const u16* kg1 = kb + (size_t)(kc1 / 12) * 96 + (kc1 % 12) * 8;
  const u16* kg2 = kb + (size_t)(kc2 / 12) * 96 + (kc2 % 12) * 8;
  const u16* vg0 = vt + (size_t)(tid_ >> 3) * nkeys + (tid_ & 7) * 8;
  const u16* vg1 = vt + (size_t)((tid_ + 256) >> 3) * nkeys + (tid_ & 7) * 8;
  const int kl0 = (kc0 / 12) * KST + (kc0 % 12) * 8, kl1 = (kc1 / 12) * KST + (kc1 % 12) * 8, kl2 = (kc2 / 12) * KST + (kc2 % 12) * 8;
  const int vl0 = (tid_ >> 3) * VST + (tid_ & 7) * 8, vl1 = ((tid_ + 256) >> 3) * VST + (tid_ & 7) * 8;
#define AT_GLOAD(kt_) do { rk0 = *(const uint4*)(kg0 + (size_t)(kt_) * 6144); rk1 = *(const uint4*)(kg1 + (size_t)(kt_) * 6144); \
    rk2 = *(const uint4*)(kg2 + (size_t)(kt_) * 6144); rv0 = *(const uint4*)(vg0 + (kt_) * 64); rv1 = *(const uint4*)(vg1 + (kt_) * 64); } while (0)
#define AT_SSTORE(st_) do { u16* ks2_ = sm + (st_) * STG; u16* vs2_ = ks2_ + 64 * KST; \
    *(uint4*)(ks2_ + kl0) = rk0; *(uint4*)(ks2_ + kl1) = rk1; *(uint4*)(ks2_ + kl2) = rk2; *(uint4*)(vs2_ + vl0) = rv0; *(uint4*)(vs2_ + vl1) = rv1; } while (0)
  __syncthreads();
  AT_GLOAD(0); AT_SSTORE(0);
  __syncthreads();
  for (int kt = 0; kt < nkt; ++kt) {
    const bool more = kt + 1 < nkt;
    if (more) AT_GLOAD(kt + 1);
    const u16* ks_ = sm + (kt & 1) * STG;
    const u16* vs_ = ks_ + 64 * KST;
    f32x16 St[2];
#pragma unroll
    for (int sub = 0; sub < 2; ++sub) {
#pragma unroll
      for (int r = 0; r < 16; ++r) St[sub][r] = 0.f;
      const u16* kr = ks_ + (sub * 32 + n) * KST + h2 * 8;
#pragma unroll
      for (int ks = 0; ks < 6; ++ks) St[sub] = MFMA32(*(const bf16x8*)(kr + ks * 16), qf[ks], St[sub]);
    }
    float mx = St[0][0];
#pragma unroll
    for (int r = 0; r < 16; ++r) { mx = fmaxf(mx, St[0][r]); mx = fmaxf(mx, St[1][r]); }
    mx = fmaxf(mx, __shfl_xor(mx, 32));
    const float mnew = fmaxf(mrun, mx);
    const float alpha = exp2f(mrun - mnew);
    mrun = mnew;
    float ps = 0.f;
#pragma unroll
    for (int sub = 0; sub < 2; ++sub)
#pragma unroll
      for (int r = 0; r < 16; ++r) { float e = exp2f(St[sub][r] - mnew); St[sub][r] = e; ps += e; }
    lsum = lsum * alpha + ps;
#pragma unroll
    for (int r = 0; r < 16; ++r) { O[0][r] *= alpha; O[1][r] *= alpha; }
#pragma unroll
    for (int sub = 0; sub < 2; ++sub)
#pragma unroll
      for (int s = 0; s < 2; ++s) {
        const bf16x8 pb = pack_acc(St[sub], s);
#pragma unroll
        for (int dt = 0; dt < 2; ++dt)
          O[dt] = MFMA32(load_perm(vs_ + (dt * 32 + n) * VST + sub * 32, s, h2), pb, O[dt]);
      }
    if (more) AT_SSTORE((kt + 1) & 1);
    __syncthreads();
  }
  lsum += __shfl_xor(lsum, 32);
  const float inv = 1.f / lsum;
  u16* oc = (u16*)(p.ws + B_OC) + (size_t)(tq0 + n) * 512 + head * 64;
#pragma unroll
  for (int dt = 0; dt < 2; ++dt)
#pragma unroll
    for (int a = 0; a < 4; ++a) {
      const int dv = dt * 32 + 8 * a + 4 * h2;
      *(uint2*)(oc + dv) = make_uint2(pack2(O[dt][4 * a] * inv, O[dt][4 * a + 1] * inv), pack2(O[dt][4 * a + 2] * inv, O[dt][4 * a + 3] * inv));
    }
}

DI void delta_out_tile(const Params& p, int l, int tile) {
  const int lane = otid() & 63, w = otid() >> 6;
  const u16* of = (const u16*)(p.ws + B_OF);
  const u16* ob = (const u16*)(p.ws + B_OB);
  const u16* z = (const u16*)(p.ws + B_Z);
  u16* oa = (u16*)(p.ws + B_OA);
  const float g0 = p.in[17][l * 128 + 2 * lane], g1 = p.in[17][l * 128 + 2 * lane + 1];
#pragma unroll 1
  for (int q = 0; q < 16; ++q) {
    const size_t t = (size_t)tile * 16 + w * 4 + (q >> 2);
    const int hh = q & 3;
    const size_t off = t * 512 + hh * 128 + 2 * lane;
    unsigned a = *(const unsigned*)(of + off), b = *(const unsigned*)(ob + off), zz = *(const unsigned*)(z + off);
    float o0 = blo(a) + blo(b), o1 = bhi(a) + bhi(b);
    float ss = wave_sum(o0 * o0 + o1 * o1);
    float rstd = rsqrtf(ss * (1.f / 128.f) + 1e-6f);
    float y0 = o0 * rstd * g0 * siluf_(blo(zz)), y1 = o1 * rstd * g1 * siluf_(bhi(zz));
    *(unsigned*)(oa + off) = pack2(y0, y1);
  }
}

DI void grid_barrier(unsigned* bar, unsigned target) {
  __threadfence();
  asm volatile("s_waitcnt vmcnt(0) lgkmcnt(0)" ::: "memory");
  __syncthreads();
  if (otid() == 0) {
    __hip_atomic_fetch_add(bar, 1u, __ATOMIC_RELEASE, __HIP_MEMORY_SCOPE_AGENT);
    while (__hip_atomic_load(bar, __ATOMIC_RELAXED, __HIP_MEMORY_SCOPE_AGENT) < target) __builtin_amdgcn_s_sleep(2);
    __builtin_amdgcn_fence(__ATOMIC_ACQUIRE, "agent");
    asm volatile("s_waitcnt vmcnt(0)" ::: "memory");
  }
  __syncthreads();
  __threadfence();
  asm volatile("s_waitcnt vmcnt(0)" ::: "memory");
}
#define GSYNC() do { bar_target += gridDim.x; grid_barrier(p.bar, bar_target); } while (0)
#ifndef ONLY
#define PH(n) 1
#else
#define PH(n) ((n) == ONLY || (n) / 100 == ONLY || (n) == ONLY / 100)
#endif
__global__ void __launch_bounds__(256, 2) mega(Params p) {
  cg::grid_group grid = cg::this_grid();
  __shared__ __attribute__((aligned(16))) char smem_raw[73728];
  u16* sm = (u16*)smem_raw;
  float* smf = (float*)smem_raw;
  const int nb = gridDim.x, bid = blockIdx.x;
  unsigned bar_target = 0;
  grid.sync();

  if (PH(0)) {
    const int tid = otid();
    for (int j = bid; j < 4 * CJ8; j += nb) conv_job(p, j / CJ8, j % CJ8, smf);
    for (int j = bid; j < 4 * 96; j += nb) mods_tile(p, j / 96, j % 96, smf);
    for (int j = bid; j < 64; j += nb) s5pre_tile(p, j);
    {
      const float4* xp = (const float4*)p.in[0];
      const float4* xs = (const float4*)p.in[1];
      float4* o = (float4*)p.out;
      const size_t nP = (size_t)TP_ * 256, nT = (size_t)T_ * 256;
      for (size_t i = (size_t)bid * 256 + tid; i < nT; i += (size_t)nb * 256) o[i] = i < nP ? xp[i] : xs[i - nP];
    }
    {
      float* rope = (float*)(p.ws + B_ROPE);
      for (int i = bid * 256 + tid; i < 2048 * 16; i += nb * 256) {
        const int pos = i >> 4, f = i & 15;
        const float invf = 1.f / powf(10000.f, (float)(f & 7) * 0.125f);
        const float ang = (f < 8 ? (float)(pos >> 6) : (float)(pos & 63)) * invf;
        float sn, cs;
        sincosf(ang, &sn, &cs);
        rope[i * 2] = cs; rope[i * 2 + 1] = sn;
      }
    }
    {
      u16* cc = (u16*)(p.ws + B_CKVC);
      for (int i = bid * 256 + tid; i < 8 * 4 * 256 * 256 / 2; i += nb * 256) {
        const int e = i * 2;
        const int c = e & 255, pos = (e >> 8) & 255, l = (e >> 16) & 3, b = e >> 18;
        float2 v = *(const float2*)(p.in[5] + e);
        *(unsigned*)(cc + ((size_t)(l * 2048 + b * 256 + pos)) * 256 + c) = pack2(v.x, v.y);
      }
    }
  }
  GSYNC();

  for (int l = 0; l < 4; ++l) {
    const u16* WL = (const u16*)(p.ws + B_W) + (size_t)l * W_LAYER;
    const float* mods = (const float*)(p.ws + B_MODS);
    if (PH(1)) norm_phase(p, l, 0, 1, p.in[11] + l * 1024);
    GSYNC();
    if (PH(2)) gemm_in_phase(p, l, sm);
    GSYNC();
    if (PH(3)) {
      for (int j = bid; j < NCH; j += nb) delta_prep_tile(p, l, j, sm);
      for (int j = bid; j < T_ / 4; j += nb) mla_prep_tile(p, l, j);
      for (int j = bid; j < 256; j += nb) cache_rope_tile(p, l, j);
      for (int j = bid; j < NCH * 16; j += nb) s5_chunk_tile(p, l, j >> 4, j & 15, 0, sm);
    }
    GSYNC();
    if (PH(4)) {
      const int tid = otid();
      if (PH(400)) for (int j = bid; j < NCH * 2; j += nb) delta_local_tile(p, j, smf);
      if (PH(410)) for (int j = bid; j < 192 * 6; j += nb) {
          const int q = j, mt = q / 6, nt = q % 6;
          f32x4 acc[4][4];
          zero_acc<4>(acc);
          gemm_core<4>(acc, (const u16*)(p.ws + B_QA) + (size_t)mt * 128 * 384, 384, WL + W_QB + (size_t)nt * 128 * 384, 384, 384, sm);
          u16* qm = (u16*)(p.ws + B_QM);
          const float qs = 0.10206207261596575f * 1.4426950408889634f;
          const float* rope = (const float*)(p.ws + B_ROPE);
          const int e_lane = tid & 63, e_w = tid >> 6, e_wr = e_w >> 1, e_wc = e_w & 1, e_fr = e_lane & 15, e_fq = e_lane >> 4;
          const bool is_s = (mt * 128 >= TP_);
#pragma unroll
          for (int i = 0; i < 4; ++i)
#pragma unroll
            for (int r = 0; r < 4; ++r) {
              const int row = mt * 128 + e_wr * 64 + i * 16 + e_fq * 4 + r;
              float vals[4];
#pragma unroll
              for (int jj = 0; jj < 4; ++jj) vals[jj] = acc[i][jj][r];
              if (is_s) {
                const int pos = (row - TP_) & 2047;
                const float cs = rope[(pos * 16 + e_fr) * 2], sn = rope[(pos * 16 + e_fr) * 2 + 1];
#pragma unroll
                for (int jj = 0; jj < 4; jj += 2) {
                  const int gt = (nt * 128 + e_wc * 64) / 16 + jj;
                  if (gt % 6 == 4) {
                    const float x1 = vals[jj], x2 = vals[jj + 1];
                    vals[jj] = x1 * cs - x2 * sn;
                    vals[jj + 1] = x2 * cs + x1 * sn;
                  }
                }
              }
#pragma unroll
              for (int jj = 0; jj < 4; ++jj) qm[(size_t)row * 768 + nt * 128 + e_wc * 64 + jj * 16 + e_fr] = f2bf(vals[jj] * qs);
            }
      }
      if (PH(420)) for (int j = bid; j < 208 * 8; j += nb) {
          const int q = j, mt = q >> 3, head = q & 7;
          f32x4 acc[4][4];
          zero_acc<4>(acc);
          const u16* A = mt < 192 ? (const u16*)(p.ws + B_KVA) + (size_t)mt * 128 * 256
                                  : (const u16*)(p.ws + B_CKVC) + ((size_t)l * 2048 + (size_t)(mt - 192) * 128) * 256;
          gemm_core<4>(acc, A, 256, WL + W_KVB + (size_t)head * 128 * 256, 256, 256, sm);
          int key0, nkeys; size_t kbo, vto;
          if (mt < 64) { const int seq = mt >> 1; key0 = (mt & 1) * 128; nkeys = 256; kbo = (size_t)(seq * 8 + head) * 256 * 96; vto = (size_t)(seq * 8 + head) * 64 * 256; }
          else if (mt < 192) { const int s = (mt - 64) >> 4; key0 = 256 + ((mt - 64) & 15) * 128; nkeys = 2304; kbo = KB_P + (size_t)(s * 8 + head) * 2304 * 96; vto = VT_P + (size_t)(s * 8 + head) * 64 * 2304; }
          else { const int s = (mt - 192) >> 1; key0 = ((mt - 192) & 1) * 128; nkeys = 2304; kbo = KB_P + (size_t)(s * 8 + head) * 2304 * 96; vto = VT_P + (size_t)(s * 8 + head) * 64 * 2304; }
          u16* kb = (u16*)(p.ws + B_KB) + kbo;
          u16* vt = (u16*)(p.ws + B_VT) + vto;
          const int e_lane = tid & 63, e_w = tid >> 6, e_wr = e_w >> 1, e_wc = e_w & 1, e_fr = e_lane & 15, e_fq = e_lane >> 4;
#pragma unroll
          for (int i = 0; i < 4; ++i)
#pragma unroll
            for (int jj = 0; jj < 4; ++jj) {
              const int key = key0 + e_wr * 64 + i * 16 + e_fq * 4;
              const int c = jj * 16 + e_fr;
              if (e_wc == 0) {
#pragma unroll
                for (int r = 0; r < 4; ++r) kb[(size_t)(key + r) * 96 + c] = f2bf(acc[i][jj][r]);
              } else {
                *(uint2*)(vt + (size_t)c * nkeys + key) = make_uint2(pack2(acc[i][jj][0], acc[i][jj][1]), pack2(acc[i][jj][2], acc[i][jj][3]));
              }
            }
      }
      if (PH(430)) for (int j = bid; j < 640; j += nb) s5_carry_tile(p, l, j);
    }
    GSYNC();
    if (PH(5)) {
      if (PH(500)) for (int j = bid; j < 320; j += nb) delta_scan_tile(p, l, j, sm);
      if (PH(510)) for (int j = bid; j < 1536; j += nb) {
        if (j < 1024) attn_tile(p, 32 + (j >> 7), (j >> 4) & 7, j & 15, sm);
        else { const int q = j - 1024; attn_tile(p, q >> 4, (q >> 1) & 7, q & 1, sm); }
      }
      if (PH(530)) for (int j = bid; j < NCH * 8; j += nb) {
        s5_chunk_tile(p, l, j >> 3, (j & 7) * 2, 1, sm);
        s5_chunk_tile(p, l, j >> 3, (j & 7) * 2 + 1, 1, sm);
      }
    }
    GSYNC();
    if (PH(6)) {
      for (int j = bid; j < T_ / 16; j += nb) delta_out_tile(p, l, j);
      for (int j = bid; j < 192 * 4; j += nb) {
        {
          const int q = j, mt = q >> 2, nt = q & 3;
          f32x4 acc[4][4];
          zero_acc<4>(acc);
          const u16* y5 = (const u16*)(p.ws + B_Y5);
          gemm_core<4>(acc, y5 + (size_t)mt * 128 * 512, 512, WL + W_GLU + (size_t)nt * 128 * 512, 512, 512, sm);
          u16* ob5 = (u16*)(p.ws + B_OB5);
          const float* bgl = p.in[27] + l * 512;
          EPI_LOOP(4) {
            const size_t row = mt * 128 + EROW; const int col = nt * 128 + ECOL(4);
            const float y = bf2f(y5[row * 512 + col]);
            ob5[row * 512 + col] = f2bf(y * sigmoidf_(acc[i][j][r] + bgl[col]));
          }
        }
      }
    }
    GSYNC();
    if (PH(7)) {
      const u16* H = (const u16*)(p.ws + B_H);
      u16* mg = (u16*)(p.ws + B_MG);
      for (int j = bid; j < 192 * 16; j += nb) {
        const int mt = j >> 4, nt = j & 15;
        f32x4 mer[4][2];
        zero_acc<2>(mer);
#pragma unroll 1
        for (int n = 0; n < 3; ++n) {
          f32x4 ag[4][2], ab[4][2];
          zero_acc<2>(ag);
          gemm_core<2>(ag, H + (size_t)mt * 128 * 1024, 1024, WL + W_G + (size_t)(n * 1024 + nt * 64) * 1024, 1024, 1024, sm);
          zero_acc<2>(ab);
          const u16* on = (const u16*)(p.ws + (n == 0 ? B_OA : (n == 1 ? B_OB5 : B_OC)));
          gemm_core<2>(ab, on + (size_t)mt * 128 * 512, 512, WL + W_BR + (size_t)(nt * 64) * 1536 + n * 512, 1536, 512, sm);
#pragma unroll
          for (int i = 0; i < 4; ++i)
#pragma unroll
            for (int jj = 0; jj < 2; ++jj)
#pragma unroll
              for (int r = 0; r < 4; ++r) mer[i][jj][r] += sigmoidf_(ag[i][jj][r]) * ab[i][jj][r];
        }
        EPI_LOOP(2) { mg[(size_t)(mt * 128 + EROW) * 1024 + nt * 64 + ECOL(2)] = f2bf(mer[i][j][r]); }
      }
    }
    GSYNC();
    if (PH(8)) {
      const u16* mg = (const u16*)(p.ws + B_MG);
      for (int j = bid; j < 192 * 8; j += nb) {
        const int mt = j >> 3, nt = j & 7;
        f32x4 acc[4][4];
        zero_acc<4>(acc);
        gemm_core<4>(acc, mg + (size_t)mt * 128 * 1024, 1024, WL + W_OUT + (size_t)nt * 128 * 1024, 1024, 1024, sm);
        const float* gm = mods + (size_t)(l * 9 + tok_v(mt * 128)) * 6144 + 2 * 1024;
        EPI_LOOP(4) {
          const size_t row = mt * 128 + EROW; const int col = nt * 128 + ECOL(4);
          p.out[row * 1024 + col] += gm[col] * acc[i][j][r];
        }
      }
    }
    GSYNC();
    if (PH(9)) norm_phase(p, l, 3, 4, p.in[12] + l * 1024);
    GSYNC();
    if (PH(10)) {
      const u16* H = (const u16*)(p.ws + B_H);
      u16* up = (u16*)(p.ws + B_UP);
      for (int j = bid; j < 192 * 44; j += nb) {
        const int mt = j / 44, nt = j % 44;
        f32x4 acc[4][4];
        zero_acc<4>(acc);
        gemm_core<4>(acc, H + (size_t)mt * 128 * 1024, 1024, WL + W_UP + (size_t)nt * 128 * 1024, 1024, 1024, sm);
        EPI_LOOP(4) { up[(size_t)(mt * 128 + EROW) * 5632 + nt * 128 + ECOL(4)] = f2bf(acc[i][j][r]); }
      }
    }
    GSYNC();
    if (PH(11)) {
      const int tid = otid();
      const u16* up = (const u16*)(p.ws + B_UP);
      u16* act = (u16*)(p.ws + B_ACT);
      const float* cw = p.in[35] + (size_t)l * 3 * 5632;
      const float* cb = p.in[36] + (size_t)l * 5632;
      for (size_t it = (size_t)bid * 256 + tid; it < (size_t)T_ * 352; it += (size_t)nb * 256) {
        const int t = (int)(it / 352), c8 = (int)(it % 352) * 8;
        int pos, L;
        if (t < TP_) { pos = t & 255; L = 256; } else { pos = (t - TP_) & 2047; L = 2048; }
        float res[8];
        float gv[8], vv2[8];
#pragma unroll
        for (int e = 0; e < 8; ++e) { gv[e] = cb[c8 + e]; vv2[e] = cb[2816 + c8 + e]; }
#pragma unroll
        for (int d = 0; d < 3; ++d) {
          const int ps = pos + d - 1;
          if (ps < 0 || ps >= L) continue;
          const u16* rowp = up + (size_t)(t + d - 1) * 5632;
          uint4 ug = *(const uint4*)(rowp + c8);
          uint4 uv = *(const uint4*)(rowp + 2816 + c8);
          const unsigned ugs[4] = {ug.x, ug.y, ug.z, ug.w}, uvs[4] = {uv.x, uv.y, uv.z, uv.w};
#pragma unroll
          for (int e = 0; e < 4; ++e) {
            gv[2 * e] += cw[d * 5632 + c8 + 2 * e] * blo(ugs[e]);
            gv[2 * e + 1] += cw[d * 5632 + c8 + 2 * e + 1] * bhi(ugs[e]);
            vv2[2 * e] += cw[d * 5632 + 2816 + c8 + 2 * e] * blo(uvs[e]);
            vv2[2 * e + 1] += cw[d * 5632 + 2816 + c8 + 2 * e + 1] * bhi(uvs[e]);
          }
        }
#pragma unroll
        for (int e = 0; e < 8; ++e) res[e] = siluf_(gv[e]) * vv2[e];
        *(uint4*)(act + (size_t)t * 2816 + c8) = make_uint4(pack2(res[0], res[1]), pack2(res[2], res[3]), pack2(res[4], res[5]), pack2(res[6], res[7]));
      }
    }
    GSYNC();
    if (PH(12)) {
      const u16* act = (const u16*)(p.ws + B_ACT);
      for (int j = bid; j < 192 * 8; j += nb) {
        const int mt = j >> 3, nt = j & 7;
        f32x4 acc[4][4];
        zero_acc<4>(acc);
        gemm_core<4>(acc, act + (size_t)mt * 128 * 2816, 2816, WL + W_DN + (size_t)nt * 128 * 2816, 2816, 2816, sm);
        const float* gf = mods + (size_t)(l * 9 + tok_v(mt * 128)) * 6144 + 5 * 1024;
        EPI_LOOP(4) {
          const size_t row = mt * 128 + EROW; const int col = nt * 128 + ECOL(4);
          p.out[row * 1024 + col] += gf[col] * acc[i][j][r];
        }
      }
    }
    GSYNC();
  }
  if (PH(13)) {
    const int tid = otid();
    const int lane = tid & 63, w = tid >> 6;
    const float* gfin = p.in[38];
    for (int tile = bid; tile < T_ / 4; tile += nb) {
      const int t = tile * 4 + w;
      float4* xr = (float4*)(p.out + (size_t)t * 1024);
      float4 v[4];
      float ss = 0.f;
#pragma unroll
      for (int j = 0; j < 4; ++j) { v[j] = xr[lane + 64 * j]; ss += v[j].x * v[j].x + v[j].y * v[j].y + v[j].z * v[j].z + v[j].w * v[j].w; }
      ss = wave_sum(ss);
      const float rstd = rsqrtf(ss * (1.f / 1024.f) + 1e-6f);
#pragma unroll
      for (int j = 0; j < 4; ++j) {
        float4 g = *(const float4*)(gfin + (lane + 64 * j) * 4);
        xr[lane + 64 * j] = make_float4(v[j].x * rstd * g.x, v[j].y * rstd * g.y, v[j].z * rstd * g.z, v[j].w * rstd * g.w);
      }
    }
  }
}

extern "C" void kernel_launch(void* const* d_in, const int* in_sizes, int n_in, void* d_out, int out_size,
                              void* d_ws, size_t ws_size, hipStream_t stream) {
  static int grid_blocks = 0;
  if (!grid_blocks) {
    int dev = 0, cus = 0, per_cu = 0;
    (void)hipGetDevice(&dev);
    (void)hipDeviceGetAttribute(&cus, hipDeviceAttributeMultiprocessorCount, dev);
    (void)hipOccupancyMaxActiveBlocksPerMultiprocessor(&per_cu, mega, 256, 0);
    if (per_cu > 2) per_cu = 2;
    if (per_cu < 1) per_cu = 1;
    grid_blocks = cus * per_cu;
  }
  if (ws_size < B_TOTAL || n_in < 39) {
    fprintf(stderr, "workspace too small: %zu < %zu\n", ws_size, (size_t)B_END);
    return;
  }
  Params p{};
  for (int i = 0; i < 39; ++i) p.in[i] = (const float*)d_in[i];
  p.out = (float*)d_out;
  p.ws = (char*)d_ws;
  p.bar = (unsigned*)((char*)d_ws + B_BAR);
  (void)hipMemsetAsync(p.bar, 0, 256, stream);
  void* args[] = {&p};
  hipError_t e = hipLaunchCooperativeKernel((void*)mega, dim3(grid_blocks), dim3(256), args, 0, stream);
  if (e != hipSuccess) fprintf(stderr, "cooperative launch failed: %s (grid %d)\n", hipGetErrorString(e), grid_blocks);
}
```

```cpp
#include <hip/hip_runtime.h>
#include <hip/hip_cooperative_groups.h>
#include <cstdio>
namespace cg = cooperative_groups;

#define DI __device__ __forceinline__
typedef __bf16 bf16;
using bf16x8 = __attribute__((ext_vector_type(8))) short;
using f32x4 = __attribute__((ext_vector_type(4))) float;
using f32x16 = __attribute__((ext_vector_type(16))) float;
typedef unsigned short u16;

constexpr int T_ = 24576, TP_ = 8192;
constexpr int NCH = 384;
constexpr long long O_SD = 25165824LL, O_S5RE = 41943040LL, O_S5IM = 42467328LL, O_CKV = 42991616LL, O_KR = 51380224LL;

constexpr size_t W_IN = 0;
constexpr size_t W_G = W_IN + 3328ull * 1024;
constexpr size_t W_QB = W_G + 3072ull * 1024;
constexpr size_t W_KVB = W_QB + 768ull * 384;
constexpr size_t W_GLU = W_KVB + 1024ull * 256;
constexpr size_t W_BR = W_GLU + 512ull * 512;
constexpr size_t W_OUT = W_BR + 1024ull * 1536;
constexpr size_t W_UP = W_OUT + 1024ull * 1024;
constexpr size_t W_DN = W_UP + 5632ull * 1024;
constexpr size_t W_LAYER = W_DN + 1024ull * 2816;

constexpr size_t al(size_t x) { return (x + 255) & ~(size_t)255; }
constexpr size_t B_W = 0;
constexpr size_t B_MODS = al(B_W + 4 * W_LAYER * 2);
constexpr size_t B_ROPE = al(B_MODS + 4ull * 9 * 6144 * 4);
constexpr size_t B_LAMB = al(B_ROPE + 2048ull * 32 * 4);
constexpr size_t B_LAM64 = al(B_LAMB + 4ull * 2 * 32 * 64 * 8);
constexpr size_t B_BBT = al(B_LAM64 + 4ull * 2 * 32 * 64 * 8);
constexpr size_t B_CMT = al(B_BBT + 4ull * 2 * 32 * 128 * 16 * 2);
constexpr size_t B_CKVC = al(B_CMT + 4ull * 32 * 16 * 128 * 2);
constexpr size_t B_H = al(B_CKVC + 4ull * 2048 * 256 * 2);
constexpr size_t B_QKV = al(B_H + (size_t)T_ * 1024 * 2);
constexpr size_t B_Z = al(B_QKV + (size_t)T_ * 1536 * 2);
constexpr size_t B_US5 = al(B_Z + (size_t)T_ * 512 * 2);
constexpr size_t B_QA = al(B_US5 + (size_t)T_ * 512 * 2);
constexpr size_t B_KVA = al(B_QA + (size_t)T_ * 384 * 2);
constexpr size_t B_MISC = al(B_KVA + (size_t)T_ * 256 * 2);
constexpr size_t B_QN = al(B_MISC + (size_t)T_ * 48 * 4);
constexpr size_t B_KN = al(B_QN + (size_t)T_ * 512 * 2);
constexpr size_t B_VV = al(B_KN + (size_t)T_ * 512 * 2);
constexpr size_t B_KT = al(B_VV + (size_t)T_ * 512 * 2);
constexpr size_t B_BG = al(B_KT + (size_t)T_ * 512 * 2);
constexpr size_t B_TM = al(B_BG + (size_t)T_ * 16 * 4);
constexpr size_t B_QKM = al(B_TM + (size_t)T_ * 512 * 2);
constexpr size_t B_GC = al(B_QKM + (size_t)T_ * 512 * 2);
constexpr size_t B_BC = al(B_GC + (size_t)NCH * 4 * 2 * 64 * 4);
constexpr size_t KB_P = 32ull * 8 * 256 * 96, KB_S = 8ull * 8 * 2304 * 96;
constexpr size_t VT_P = 32ull * 8 * 64 * 256, VT_S = 8ull * 8 * 64 * 2304;
constexpr size_t B_KB = al(B_BC + (size_t)NCH * 4 * 2 * 64 * 4);
constexpr size_t B_VT = al(B_KB + (KB_P + KB_S) * 2);
constexpr size_t B_QM = al(B_VT + (VT_P + VT_S) * 2);
constexpr size_t B_HEND = al(B_QM + (size_t)T_ * 768 * 2);
constexpr size_t B_HIN = al(B_HEND + (size_t)NCH * 32 * 2 * 64 * 8);
constexpr size_t B_Y5 = al(B_HIN + (size_t)NCH * 32 * 2 * 64 * 8);
constexpr size_t B_OC = al(B_Y5 + (size_t)T_ * 512 * 2);
constexpr size_t B_END = al(B_OC + (size_t)T_ * 512 * 2);
constexpr size_t B_OF = B_QKV;
constexpr size_t B_OB = B_QKV + (size_t)T_ * 512 * 2;
constexpr size_t B_MG = B_QKV;
constexpr size_t B_OA = B_QN;
constexpr size_t B_OB5 = B_KN;
constexpr size_t B_UP = B_QKV;
constexpr size_t B_ACT = B_KB;
static_assert(B_UP + (size_t)T_ * 5632 * 2 <= B_KB, "UP overlaps ACT");
static_assert(B_ACT + (size_t)T_ * 2816 * 2 <= B_END, "ACT too big");
constexpr size_t B_BAR = B_END;
constexpr size_t B_TOTAL = B_BAR + 256;
static_assert(B_TOTAL <= 768ull * 1024 * 1024, "workspace too big");

struct Params {
  const float* in[39];
  float* out;
  char* ws;
  unsigned* bar;
};

DI int otid() { int t = (int)__builtin_amdgcn_workitem_id_x(); asm volatile("" : "+v"(t)); return t; }
DI unsigned pack2(float a, float b) {
  typedef __attribute__((ext_vector_type(2))) __bf16 bf2;
  bf2 v; v[0] = (__bf16)a; v[1] = (__bf16)b;
  return __builtin_bit_cast(unsigned, v);
}
DI u16 f2bf(float a) { return (u16)(pack2(a, 0.f) & 0xffffu); }
DI float bf2f(u16 u) { return __uint_as_float(((unsigned)u) << 16); }
DI float blo(unsigned u) { return __uint_as_float(u << 16); }
DI float bhi(unsigned u) { return __uint_as_float(u & 0xffff0000u); }
DI float wave_sum(float v) {
#pragma unroll
  for (int o = 32; o > 0; o >>= 1) v += __shfl_xor(v, o);
  return v;
}
DI float sigmoidf_(float x) { return 1.f / (1.f + __expf(-x)); }
DI float siluf_(float x) { return x / (1.f + __expf(-x)); }
DI int tok_v(int t) { return t < TP_ ? 0 : 1 + ((t - TP_) >> 11); }
DI int crow(int r, int h2) { return (r & 3) + 8 * (r >> 2) + 4 * h2; }
DI bf16x8 mk8(unsigned a, unsigned b, unsigned c, unsigned d) {
  uint4 p = make_uint4(a, b, c, d);
  return __builtin_bit_cast(bf16x8, p);
}
DI bf16x8 pack_acc(const f32x16& x, int s) {
  return mk8(pack2(x[8 * s], x[8 * s + 1]), pack2(x[8 * s + 2], x[8 * s + 3]), pack2(x[8 * s + 4], x[8 * s + 5]),
             pack2(x[8 * s + 6], x[8 * s + 7]));
}
DI bf16x8 load_perm(const u16* rowptr, int s, int h2) {
  uint2 a = *(const uint2*)(rowptr + 16 * s + 4 * h2);
  uint2 b = *(const uint2*)(rowptr + 16 * s + 8 + 4 * h2);
  return mk8(a.x, a.y, b.x, b.y);
}
DI unsigned swap16(unsigned u) { return (u >> 16) | (u << 16); }
DI bf16x8 load_perm_rev(const u16* rowptr, int base, int s, int h2) {
  uint2 a = *(const uint2*)(rowptr + 60 - base - 16 * s - 4 * h2);
  uint2 b = *(const uint2*)(rowptr + 52 - base - 16 * s - 4 * h2);
  return mk8(swap16(a.y), swap16(a.x), swap16(b.y), swap16(b.x));
}
#define MFMA16(a, b, c) __builtin_amdgcn_mfma_f32_16x16x32_bf16((a), (b), (c), 0, 0, 0)
#define MFMA32(a, b, c) __builtin_amdgcn_mfma_f32_32x32x16_bf16((a), (b), (c), 0, 0, 0)

template <int NJ>
DI void gemm_core(f32x4 (&acc)[4][NJ], const u16* __restrict__ A, int lda, const u16* __restrict__ B, int ldb, int K,
                  u16* sm) {
  const int tid = otid(), lane = tid & 63, w = tid >> 6, wr = w >> 1, wc = w & 1;
  const int fr = lane & 15, fq = lane >> 4;
  constexpr int RS = 136;
  const int lrow = tid >> 4, lkc = tid & 15;
  uint4 a0, a1, a2, a3, a4, a5, a6, a7, b0, b1, b2, b3, b4, b5, b6, b7;
  b4 = b5 = b6 = b7 = make_uint4(0, 0, 0, 0);
  const u16* ap = A + (size_t)lrow * lda + lkc * 8;
  const u16* bp = B + (size_t)lrow * ldb + lkc * 8;
  const int nk = K >> 7;
  u16* as = sm;
  u16* bs = sm + 128 * RS;
  {
    const int k0 = 0;
    a0 = *(const uint4*)(ap + (size_t)(0 * 16) * lda + k0);
    a1 = *(const uint4*)(ap + (size_t)(1 * 16) * lda + k0);
    a2 = *(const uint4*)(ap + (size_t)(2 * 16) * lda + k0);
    a3 = *(const uint4*)(ap + (size_t)(3 * 16) * lda + k0);
    a4 = *(const uint4*)(ap + (size_t)(4 * 16) * lda + k0);
    a5 = *(const uint4*)(ap + (size_t)(5 * 16) * lda + k0);
    a6 = *(const uint4*)(ap + (size_t)(6 * 16) * lda + k0);
    a7 = *(const uint4*)(ap + (size_t)(7 * 16) * lda + k0);
    b0 = *(const uint4*)(bp + (size_t)(0 * 16) * ldb + k0);
    b1 = *(const uint4*)(bp + (size_t)(1 * 16) * ldb + k0);
    b2 = *(const uint4*)(bp + (size_t)(2 * 16) * ldb + k0);
    b3 = *(const uint4*)(bp + (size_t)(3 * 16) * ldb + k0);
    if (NJ == 4) b4 = *(const uint4*)(bp + (size_t)(4 * 16) * ldb + k0);
    if (NJ == 4) b5 = *(const uint4*)(bp + (size_t)(5 * 16) * ldb + k0);
    if (NJ == 4) b6 = *(const uint4*)(bp + (size_t)(6 * 16) * ldb + k0);
    if (NJ == 4) b7 = *(const uint4*)(bp + (size_t)(7 * 16) * ldb + k0);
  }
  for (int kt = 0; kt < nk; ++kt) {
    __syncthreads();
    *(uint4*)(as + (lrow + 0 * 16) * RS + lkc * 8) = a0;
    *(uint4*)(as + (lrow + 1 * 16) * RS + lkc * 8) = a1;
    *(uint4*)(as + (lrow + 2 * 16) * RS + lkc * 8) = a2;
    *(uint4*)(as + (lrow + 3 * 16) * RS + lkc * 8) = a3;
    *(uint4*)(as + (lrow + 4 * 16) * RS + lkc * 8) = a4;
    *(uint4*)(as + (lrow + 5 * 16) * RS + lkc * 8) = a5;
    *(uint4*)(as + (lrow + 6 * 16) * RS + lkc * 8) = a6;
    *(uint4*)(as + (lrow + 7 * 16) * RS + lkc * 8) = a7;
    *(uint4*)(bs + (lrow + 0 * 16) * RS + lkc * 8) = b0;
    *(uint4*)(bs + (lrow + 1 * 16) * RS + lkc * 8) = b1;
    *(uint4*)(bs + (lrow + 2 * 16) * RS + lkc * 8) = b2;
    *(uint4*)(bs + (lrow + 3 * 16) * RS + lkc * 8) = b3;
    if (NJ == 4) *(uint4*)(bs + (lrow + 4 * 16) * RS + lkc * 8) = b4;
    if (NJ == 4) *(uint4*)(bs + (lrow + 5 * 16) * RS + lkc * 8) = b5;
    if (NJ == 4) *(uint4*)(bs + (lrow + 6 * 16) * RS + lkc * 8) = b6;
    if (NJ == 4) *(uint4*)(bs + (lrow + 7 * 16) * RS + lkc * 8) = b7;
    __syncthreads();
    {
      const int k0 = (kt + 1 < nk ? kt + 1 : kt) * 128;
    a0 = *(const uint4*)(ap + (size_t)(0 * 16) * lda + k0);
    a1 = *(const uint4*)(ap + (size_t)(1 * 16) * lda + k0);
    a2 = *(const uint4*)(ap + (size_t)(2 * 16) * lda + k0);
    a3 = *(const uint4*)(ap + (size_t)(3 * 16) * lda + k0);
    a4 = *(const uint4*)(ap + (size_t)(4 * 16) * lda + k0);
    a5 = *(const uint4*)(ap + (size_t)(5 * 16) * lda + k0);
    a6 = *(const uint4*)(ap + (size_t)(6 * 16) * lda + k0);
    a7 = *(const uint4*)(ap + (size_t)(7 * 16) * lda + k0);
    b0 = *(const uint4*)(bp + (size_t)(0 * 16) * ldb + k0);
    b1 = *(const uint4*)(bp + (size_t)(1 * 16) * ldb + k0);
    b2 = *(const uint4*)(bp + (size_t)(2 * 16) * ldb + k0);
    b3 = *(const uint4*)(bp + (size_t)(3 * 16) * ldb + k0);
    if (NJ == 4) b4 = *(const uint4*)(bp + (size_t)(4 * 16) * ldb + k0);
    if (NJ == 4) b5 = *(const uint4*)(bp + (size_t)(5 * 16) * ldb + k0);
    if (NJ == 4) b6 = *(const uint4*)(bp + (size_t)(6 * 16) * ldb + k0);
    if (NJ == 4) b7 = *(const uint4*)(bp + (size_t)(7 * 16) * ldb + k0);
    }
#pragma unroll
    for (int ks = 0; ks < 4; ++ks) {
      bf16x8 af[4], bfr[NJ];
#pragma unroll
      for (int i = 0; i < 4; ++i) af[i] = *(const bf16x8*)(as + (wr * 64 + i * 16 + fr) * RS + ks * 32 + fq * 8);
#pragma unroll
      for (int j = 0; j < NJ; ++j) bfr[j] = *(const bf16x8*)(bs + (wc * NJ * 16 + j * 16 + fr) * RS + ks * 32 + fq * 8);
#pragma unroll
      for (int i = 0; i < 4; ++i)
#pragma unroll
        for (int j = 0; j < NJ; ++j) acc[i][j] = MFMA16(af[i], bfr[j], acc[i][j]);
    }
  }
}
template <int NJ>
DI void zero_acc(f32x4 (&acc)[4][NJ]) {
#pragma unroll
  for (int i = 0; i < 4; ++i)
#pragma unroll
    for (int j = 0; j < NJ; ++j) acc[i][j] = f32x4{0.f, 0.f, 0.f, 0.f};
}
#define EPI_LOOP(NJ_)                                                              \
  const int e_lane = otid() & 63, e_w = otid() >> 6;                     \
  const int e_wr = e_w >> 1, e_wc = e_w & 1, e_fr = e_lane & 15, e_fq = e_lane >> 4; \
  _Pragma("unroll") for (int i = 0; i < 4; ++i)                                    \
  _Pragma("unroll") for (int j = 0; j < NJ_; ++j)                                  \
  _Pragma("unroll") for (int r = 0; r < 4; ++r)
#define EROW (e_wr * 64 + i * 16 + e_fq * 4 + r)
#define ECOL(NJ_) (e_wc * NJ_ * 16 + j * 16 + e_fr)

DI int colmap(int kind, int n) {
  if (kind == 0) {
    if (n < 2048) return n;
    if (n < 2560) return 2064 + (n - 2048);
    if (n < 2944) return 2576 + (n - 2560);
    if (n < 3200) return 2960 + (n - 2944);
    int j = n - 3200;
    if (j < 16) return 2048 + j;
    if (j < 48) return 3216 + (j - 16);
    return -1;
  }
  if (kind == 1) return 3248 + n;
  return n;
}
DI void convT_tile(const float* __restrict__ src, int lds, int K, u16* __restrict__ dst, int kind, int kt, int nt,
                   float* sm) {
  const int tid = otid();
  const int c = tid & 63;
  const int sc = colmap(kind, nt * 64 + c);
  __syncthreads();
#pragma unroll 4
  for (int i = 0; i < 16; ++i) {
    int r = (tid >> 6) + i * 4;
    float v = sc >= 0 ? src[(size_t)(kt * 64 + r) * lds + sc] : 0.f;
    sm[r * 65 + c] = v;
  }
  __syncthreads();
  const int n = tid >> 2, kq = tid & 3;
  unsigned pk[8];
#pragma unroll
  for (int j = 0; j < 8; ++j) pk[j] = pack2(sm[(kq * 16 + 2 * j) * 65 + n], sm[(kq * 16 + 2 * j + 1) * 65 + n]);
  u16* d = dst + (size_t)(nt * 64 + n) * K + kt * 64 + kq * 16;
  *(uint4*)d = make_uint4(pk[0], pk[1], pk[2], pk[3]);
  *(uint4*)(d + 8) = make_uint4(pk[4], pk[5], pk[6], pk[7]);
}
constexpr int CJ0 = 16 * 52, CJ1 = CJ0 + 16 * 48, CJ2 = CJ1 + 6 * 12, CJ3 = CJ2 + 4 * 16, CJ4 = CJ3 + 8 * 8,
              CJ5 = CJ4 + 24 * 16, CJ6 = CJ5 + 16 * 16, CJ7 = CJ6 + 16 * 88, CJ8 = CJ7 + 44 * 16;
DI void conv_job(const Params& p, int l, int j, float* sm) {
  u16* wl = (u16*)(p.ws + B_W) + (size_t)l * W_LAYER;
  if (j < CJ0) { convT_tile(p.in[13] + (size_t)l * 1024 * 6320, 6320, 1024, wl + W_IN, 0, j / 52, j % 52, sm); return; }
  if (j < CJ1) { j -= CJ0; convT_tile(p.in[13] + (size_t)l * 1024 * 6320, 6320, 1024, wl + W_G, 1, j / 48, j % 48, sm); return; }
  if (j < CJ2) { j -= CJ1; convT_tile(p.in[29] + (size_t)l * 384 * 768, 768, 384, wl + W_QB, 2, j / 12, j % 12, sm); return; }
  if (j < CJ3) { j -= CJ2; convT_tile(p.in[31] + (size_t)l * 256 * 1024, 1024, 256, wl + W_KVB, 2, j / 16, j % 16, sm); return; }
  if (j < CJ4) { j -= CJ3; convT_tile(p.in[26] + (size_t)l * 512 * 512, 512, 512, wl + W_GLU, 2, j / 8, j % 8, sm); return; }
  if (j < CJ5) { j -= CJ4; convT_tile(p.in[32] + (size_t)l * 1536 * 1024, 1024, 1536, wl + W_BR, 2, j / 16, j % 16, sm); return; }
  if (j < CJ6) { j -= CJ5; convT_tile(p.in[33] + (size_t)l * 1024 * 1024, 1024, 1024, wl + W_OUT, 2, j / 16, j % 16, sm); return; }
  if (j < CJ7) { j -= CJ6; convT_tile(p.in[34] + (size_t)l * 1024 * 5632, 5632, 1024, wl + W_UP, 2, j / 88, j % 88, sm); return; }
  j -= CJ7; convT_tile(p.in[37] + (size_t)l * 2816 * 1024, 1024, 2816, wl + W_DN, 2, j / 16, j % 16, sm);
}
DI void mods_tile(const Params& p, int l, int jg, float* sm) {
  const int tid = otid();
  __syncthreads();
  for (int i = tid; i < 9 * 1024; i += 256) {
    int v = i >> 10, k = i & 1023;
    float cv = v == 0 ? p.in[8][k] : p.in[7][(v - 1) * 1024 + k];
    sm[i] = cv / (1.f + __expf(-cv));
  }
  __syncthreads();
  const int col = jg * 64 + (tid & 63), kq = tid >> 6;
  float acc[9];
#pragma unroll
  for (int v = 0; v < 9; ++v) acc[v] = 0.f;
  const float* wp = p.in[9] + (size_t)l * 1024 * 6144 + col;
#pragma unroll 4
  for (int k = kq * 256; k < kq * 256 + 256; ++k) {
    float wv = wp[(size_t)k * 6144];
#pragma unroll
    for (int v = 0; v < 9; ++v) acc[v] += sm[v * 1024 + k] * wv;
  }
  float* red = sm + 9 * 1024;
#pragma unroll
  for (int v = 0; v < 9; ++v) red[(kq * 9 + v) * 64 + (tid & 63)] = acc[v];
  __syncthreads();
  if (kq == 0) {
    float* mods = (float*)(p.ws + B_MODS);
    float b = p.in[10][l * 6144 + col];
#pragma unroll
    for (int v = 0; v < 9; ++v) {
      float s = red[(0 * 9 + v) * 64 + tid] + red[(1 * 9 + v) * 64 + tid] + red[(2 * 9 + v) * 64 + tid] + red[(3 * 9 + v) * 64 + tid];
      mods[(size_t)(l * 9 + v) * 6144 + col] = s + b;
    }
  }
}
DI void s5pre_tile(const Params& p, int tile) {
  const int id = tile * 256 + otid();
  const int pp = id & 63, g = (id >> 6) & 31, dir = (id >> 11) & 1, l = id >> 12;
  const float lre = p.in[18][((l * 2 + dir) * 32 + g) * 64 + pp];
  const float lim = p.in[19][((l * 2 + dir) * 32 + g) * 64 + pp];
  const float dt = expf(p.in[20][(l * 2 + dir) * 32 + g]);
  float er = expf(lre * dt), sn, cs;
  sincosf(lim * dt, &sn, &cs);
  const float lbr = er * cs, lbi = er * sn;
  float e64 = expf(64.f * lre * dt), s64, c64;
  sincosf(64.f * lim * dt, &s64, &c64);
  float2* lamb = (float2*)(p.ws + B_LAMB);
  float2* lam64 = (float2*)(p.ws + B_LAM64);
  const int li = ((l * 2 + dir) * 32 + g) * 64 + pp;
  lamb[li] = make_float2(lbr, lbi);
  lam64[li] = make_float2(e64 * c64, e64 * s64);
  const float nr = lbr - 1.f, ni = lbi, den = lre * lre + lim * lim;
  const float cr = (nr * lre + ni * lim) / den, ci = (ni * lre - nr * lim) / den;
  u16* bbt = (u16*)(p.ws + B_BBT) + (size_t)((l * 2 + dir) * 32 + g) * 128 * 16;
  const float* bre = p.in[21] + (size_t)((l * 32 + g) * 64 + pp) * 16;
  const float* bim = p.in[22] + (size_t)((l * 32 + g) * 64 + pp) * 16;
#pragma unroll
  for (int c = 0; c < 16; ++c) {
    float br = bre[c], bi = bim[c];
    bbt[pp * 16 + c] = f2bf(cr * br - ci * bi);
    bbt[(64 + pp) * 16 + c] = f2bf(cr * bi + ci * br);
  }
  if (dir == 0) {
    u16* cmt = (u16*)(p.ws + B_CMT) + (size_t)(l * 32 + g) * 16 * 128;
    const float* cre = p.in[23] + (size_t)(l * 32 + g) * 16 * 64;
    const float* cim = p.in[24] + (size_t)(l * 32 + g) * 16 * 64;
#pragma unroll
    for (int c = 0; c < 16; ++c) {
      cmt[c * 128 + pp] = f2bf(cre[c * 64 + pp]);
      cmt[c * 128 + 64 + pp] = f2bf(-cim[c * 64 + pp]);
    }
  }
}

DI void norm_phase(const Params& p, int l, int shift_idx, int scale_idx, const float* gn) {
  const float* x = p.out;
  u16* H = (u16*)(p.ws + B_H);
  const float* mods = (const float*)(p.ws + B_MODS);
  const int lane = otid() & 63, w = otid() >> 6;
  for (int tile = blockIdx.x; tile < T_ / 4; tile += gridDim.x) {
    const int t = tile * 4 + w;
    const float4* xr = (const float4*)(x + (size_t)t * 1024);
    float4 v[4];
    float ss = 0.f;
#pragma unroll
    for (int j = 0; j < 4; ++j) {
      v[j] = xr[lane + 64 * j];
      ss += v[j].x * v[j].x + v[j].y * v[j].y + v[j].z * v[j].z + v[j].w * v[j].w;
    }
    ss = wave_sum(ss);
    const float rstd = rsqrtf(ss * (1.f / 1024.f) + 1e-6f);
    const float* mb = mods + (size_t)(l * 9 + tok_v(t)) * 6144;
#pragma unroll
    for (int j = 0; j < 4; ++j) {
      const int c = (lane + 64 * j) * 4;
      float4 g = *(const float4*)(gn + c);
      float4 sc = *(const float4*)(mb + scale_idx * 1024 + c);
      float4 sh = *(const float4*)(mb + shift_idx * 1024 + c);
      float y0 = v[j].x * rstd * g.x * (1.f + sc.x) + sh.x;
      float y1 = v[j].y * rstd * g.y * (1.f + sc.y) + sh.y;
      float y2 = v[j].z * rstd * g.z * (1.f + sc.z) + sh.z;
      float y3 = v[j].w * rstd * g.w * (1.f + sc.w) + sh.w;
      *(uint2*)(H + (size_t)t * 1024 + c) = make_uint2(pack2(y0, y1), pack2(y2, y3));
    }
  }
}

DI void gemm_in_phase(const Params& p, int l, u16* sm) {
  const u16* H = (const u16*)(p.ws + B_H);
  const u16* Wt = (const u16*)(p.ws + B_W) + (size_t)l * W_LAYER + W_IN;
  for (int tile = blockIdx.x; tile < 192 * 26; tile += gridDim.x) {
    const int mt = tile / 26, nt = tile % 26;
    f32x4 acc[4][4];
    zero_acc<4>(acc);
    gemm_core<4>(acc, H + (size_t)mt * 128 * 1024, 1024, Wt + (size_t)nt * 128 * 1024, 1024, 1024, sm);
    if (nt < 25) {
      u16* dst; int ld, c0;
      if (nt < 12) { dst = (u16*)(p.ws + B_QKV); ld = 1536; c0 = nt * 128; }
      else if (nt < 16) { dst = (u16*)(p.ws + B_Z); ld = 512; c0 = (nt - 12) * 128; }
      else if (nt < 20) { dst = (u16*)(p.ws + B_US5); ld = 512; c0 = (nt - 16) * 128; }
      else if (nt < 23) { dst = (u16*)(p.ws + B_QA); ld = 384; c0 = (nt - 20) * 128; }
      else { dst = (u16*)(p.ws + B_KVA); ld = 256; c0 = (nt - 23) * 128; }
      EPI_LOOP(4) { dst[(size_t)(mt * 128 + EROW) * ld + c0 + ECOL(4)] = f2bf(acc[i][j][r]); }
    } else {
      float* misc = (float*)(p.ws + B_MISC);
      EPI_LOOP(4) {
        int c = ECOL(4);
        if (c < 48) misc[(size_t)(mt * 128 + EROW) * 48 + c] = acc[i][j][r];
      }
    }
  }
}

DI void delta_prep_tile(const Params& p, int l, int chunk, u16* sm) {
  const int tid = otid(), lane = tid & 63, w = tid >> 6;
  const int tb = chunk * 64;
  int pos0, L;
  if (tb < TP_) { pos0 = tb & 255; L = 256; } else { pos0 = (tb - TP_) & 2047; L = 2048; }
  const u16* qkv = (const u16*)(p.ws + B_QKV);
  const float* cw = p.in[14] + (size_t)l * 5 * 1536;
  u16* ksm = sm + w * (64 * 130);
  __syncthreads();
  for (int gi = w; gi < 12; gi += 4) {
    const int ch = gi * 128 + 2 * lane;
    float w0[5], w1[5];
#pragma unroll
    for (int i = 0; i < 5; ++i) { w0[i] = cw[i * 1536 + ch]; w1[i] = cw[i * 1536 + ch + 1]; }
    float a0[5], a1[5];
#pragma unroll
    for (int i = 0; i < 4; ++i) {
      int ps = pos0 - 2 + i;
      unsigned u = (ps >= 0 && ps < L) ? *(const unsigned*)(qkv + (size_t)(tb - 2 + i) * 1536 + ch) : 0u;
      a0[i + 1] = blo(u); a1[i + 1] = bhi(u);
    }
    u16* dst = (u16*)(p.ws + (gi < 4 ? B_QN : (gi < 8 ? B_KN : B_VV)));
    const int hh = gi & 3;
    for (int tt = 0; tt < 64; ++tt) {
#pragma unroll
      for (int i = 0; i < 4; ++i) { a0[i] = a0[i + 1]; a1[i] = a1[i + 1]; }
      {
        int ps = pos0 + tt + 2;
        unsigned u = (ps < L) ? *(const unsigned*)(qkv + (size_t)(tb + tt + 2) * 1536 + ch) : 0u;
        a0[4] = blo(u); a1[4] = bhi(u);
      }
      float y0 = 0.f, y1 = 0.f;
#pragma unroll
      for (int i = 0; i < 5; ++i) { y0 += w0[i] * a0[i]; y1 += w1[i] * a1[i]; }
      y0 = siluf_(y0); y1 = siluf_(y1);
      if (gi < 8) {
        float ss = wave_sum(y0 * y0 + y1 * y1);
        float sc = rsqrtf(ss + 1e-6f);
        if (gi < 4) sc *= 0.08838834764831845f;
        y0 *= sc; y1 *= sc;
      }
      const unsigned pk = pack2(y0, y1);
      *(unsigned*)(dst + (size_t)(tb + tt) * 512 + hh * 128 + 2 * lane) = pk;
      if (gi >= 4 && gi < 8) *(unsigned*)(ksm + tt * 130 + 2 * lane) = pk;
    }
    if (gi >= 4 && gi < 8) {
      u16* kt = (u16*)(p.ws + B_KT) + (size_t)(chunk * 4 + hh) * 128 * 64;
#pragma unroll
      for (int rr = 0; rr < 2; ++rr) {
        const int dk = lane + 64 * rr;
        unsigned pk[32];
#pragma unroll
        for (int t2 = 0; t2 < 32; ++t2) pk[t2] = (unsigned)ksm[(2 * t2) * 130 + dk] | ((unsigned)ksm[(2 * t2 + 1) * 130 + dk] << 16);
#pragma unroll
        for (int q = 0; q < 8; ++q) *(uint4*)(kt + dk * 64 + q * 8) = make_uint4(pk[4 * q], pk[4 * q + 1], pk[4 * q + 2], pk[4 * q + 3]);
      }
    }
  }
  const float* misc = (const float*)(p.ws + B_MISC);
  float* bg = (float*)(p.ws + B_BG);
  for (int i = tid; i < 512; i += 256) {
    const int tt = i >> 3, dh = i & 7;
    const size_t t = tb + tt;
    float bl = misc[t * 48 + dh], alp = misc[t * 48 + 8 + dh];
    float x = alp + p.in[16][l * 8 + dh];
    float sp = x > 20.f ? x : log1pf(__expf(x));
    bg[t * 16 + dh] = sigmoidf_(bl);
    bg[t * 16 + 8 + dh] = -__expf(p.in[15][l * 8 + dh]) * sp;
  }
}

DI size_t kb_off(int t, int head) {
  if (t < TP_) return ((size_t)((t >> 8) * 8 + head) * 256 + (t & 255)) * 96;
  const int s = (t - TP_) >> 11, pos = (t - TP_) & 2047;
  return KB_P + ((size_t)(s * 8 + head) * 2304 + 256 + pos) * 96;
}
DI void mla_prep_tile(const Params& p, int l, int tile) {
  const int lane = otid() & 63, w = otid() >> 6;
  const int t = tile * 4 + w;
  u16* qa = (u16*)(p.ws + B_QA) + (size_t)t * 384;
  u16* kva = (u16*)(p.ws + B_KVA) + (size_t)t * 256;
  const float* misc = (const float*)(p.ws + B_MISC) + (size_t)t * 48;
  {
    unsigned u[3]; float ss = 0.f;
#pragma unroll
    for (int j = 0; j < 3; ++j) { u[j] = *(const unsigned*)(qa + 2 * lane + 128 * j); float a = blo(u[j]), b = bhi(u[j]); ss += a * a + b * b; }
    ss = wave_sum(ss);
    const float rstd = rsqrtf(ss * (1.f / 384.f) + 1e-6f);
    const float* g = p.in[28] + l * 384;
#pragma unroll
    for (int j = 0; j < 3; ++j) {
      int c = 2 * lane + 128 * j;
      *(unsigned*)(qa + c) = pack2(blo(u[j]) * rstd * g[c], bhi(u[j]) * rstd * g[c + 1]);
    }
  }
  {
    unsigned u[2]; float ss = 0.f;
#pragma unroll
    for (int j = 0; j < 2; ++j) { u[j] = *(const unsigned*)(kva + 2 * lane + 128 * j); float a = blo(u[j]), b = bhi(u[j]); ss += a * a + b * b; }
    ss = wave_sum(ss);
    const float rstd = rsqrtf(ss * (1.f / 256.f) + 1e-6f);
    const float* g = p.in[30] + l * 256;
#pragma unroll
    for (int j = 0; j < 2; ++j) {
      int c = 2 * lane + 128 * j;
      float a = blo(u[j]) * rstd * g[c], b = bhi(u[j]) * rstd * g[c + 1];
      *(unsigned*)(kva + c) = pack2(a, b);
      if (t < TP_) {
        float* o = p.out + O_CKV + ((size_t)((t >> 8) * 4 + l) * 256 + (t & 255)) * 256 + c;
        *(float2*)o = make_float2(a, b);
      }
    }
  }
  {
    const int i = lane & 31;
    float kr = misc[16 + i];
    float val;
    if (t < TP_) {
      val = kr;
      if (lane < 32) p.out[O_KR + ((size_t)((t >> 8) * 4 + l) * 256 + (t & 255)) * 32 + i] = kr;
    } else {
      const int pos = (t - TP_) & 2047;
      const float* rp = (const float*)(p.ws + B_ROPE) + (size_t)pos * 32 + (i & 15) * 2;
      const float cs = rp[0], sn = rp[1];
      float other = __shfl_xor(kr, 16);
      val = (i < 16) ? (kr * cs - other * sn) : (kr * cs + other * sn);
    }
    u16* kb = (u16*)(p.ws + B_KB);
    const u16 bv = f2bf(val);
#pragma unroll
    for (int hh = 0; hh < 4; ++hh) {
      int head = hh * 2 + (lane >> 5);
      kb[kb_off(t, head) + 64 + i] = bv;
    }
  }
}
DI void cache_rope_tile(const Params& p, int l, int tile) {
  const int pr = tile * 8 + (otid() >> 5), i = otid() & 31;
  const int s = pr >> 8, pos = pr & 255;
  const float v = p.in[6][((size_t)(s * 4 + l) * 256 + pos) * 32 + i];
  u16* kb = (u16*)(p.ws + B_KB);
  const u16 bv = f2bf(v);
#pragma unroll
  for (int head = 0; head < 8; ++head) kb[KB_P + ((size_t)(s * 8 + head) * 2304 + pos) * 96 + 64 + i] = bv;
}

DI float gelu_tanh(float x) {
  const float k0 = 0.7978845608028654f, k1 = 0.044715f;
  float u = k0 * (x + k1 * x * x * x);
  float e = __expf(2.f * u);
  float th = 1.f - 2.f / (e + 1.f);
  return 0.5f * x * (1.f + th);
}
DI void s5_chunk_tile(const Params& p, int l, int chunk, int gp, int mode, u16* sm) {
  const int tid = otid(), lane = tid & 63, w = tid >> 6;
  const u16* us5 = (const u16*)(p.ws + B_US5);
  constexpr int RS = 136;
  __syncthreads();
  {
    const int gi = w >> 1, half = w & 1, g = gp * 2 + gi;
    const int n = lane & 31, h2 = lane >> 5;
    bf16x8 af[2];
#pragma unroll
    for (int mi = 0; mi < 2; ++mi) af[mi] = *(const bf16x8*)(us5 + (size_t)(chunk * 64 + mi * 32 + n) * 512 + g * 16 + 8 * h2);
#pragma unroll
    for (int dir = 0; dir < 2; ++dir) {
      const u16* bbt = (const u16*)(p.ws + B_BBT) + (size_t)((l * 2 + dir) * 32 + g) * 128 * 16;
#pragma unroll
      for (int nn = 0; nn < 2; ++nn) {
        const int nt = half * 2 + nn;
        bf16x8 bfr = *(const bf16x8*)(bbt + (nt * 32 + n) * 16 + 8 * h2);
#pragma unroll
        for (int mi = 0; mi < 2; ++mi) {
          f32x16 acc;
#pragma unroll
          for (int r = 0; r < 16; ++r) acc[r] = 0.f;
          acc = MFMA32(af[mi], bfr, acc);
          u16* d = sm + (size_t)((gi * 2 + dir) * 64 + mi * 32) * RS + nt * 32 + n;
#pragma unroll
          for (int r = 0; r < 16; ++r) d[crow(r, h2) * RS] = f2bf(acc[r]);
        }
      }
    }
  }
  __syncthreads();
  {
    const int gi = tid >> 7, dir = (tid >> 6) & 1, pp = tid & 63, g = gp * 2 + gi;
    const float2 lb = ((const float2*)(p.ws + B_LAMB))[((l * 2 + dir) * 32 + g) * 64 + pp];
    const size_t hidx = ((size_t)(chunk * 32 + g) * 2 + dir) * 64 + pp;
    float hr = 0.f, hi = 0.f;
    if (mode) { float2 h0 = ((const float2*)(p.ws + B_HIN))[hidx]; hr = h0.x; hi = h0.y; }
    u16* base = sm + (size_t)((gi * 2 + dir) * 64) * RS;
#pragma unroll 8
    for (int st = 0; st < 64; ++st) {
      const int tk = dir ? 63 - st : st;
      float br = bf2f(base[tk * RS + pp]), bi = bf2f(base[tk * RS + 64 + pp]);
      float nr = __builtin_fmaf(lb.x, hr, __builtin_fmaf(-lb.y, hi, br));
      float ni = __builtin_fmaf(lb.x, hi, __builtin_fmaf(lb.y, hr, bi));
      asm volatile("" : "+v"(nr));
      asm volatile("" : "+v"(ni));
      hr = nr; hi = ni;
      if (mode) { base[tk * RS + pp] = f2bf(hr); base[tk * RS + 64 + pp] = f2bf(hi); }
    }
    if (!mode) ((float2*)(p.ws + B_HEND))[hidx] = make_float2(hr, hi);
  }
  if (!mode) return;
  __syncthreads();
  {
    const int gi = w >> 1, g = gp * 2 + gi;
    const int fr = lane & 15, fq = lane >> 4;
    const u16* cmt = (const u16*)(p.ws + B_CMT) + (size_t)(l * 32 + g) * 16 * 128;
    f32x4 acc[2];
    acc[0] = f32x4{0.f, 0.f, 0.f, 0.f}; acc[1] = acc[0];
#pragma unroll
    for (int ks = 0; ks < 8; ++ks) {
      const int dir = ks >> 2, kk = (ks & 3) * 32;
      bf16x8 bfr = *(const bf16x8*)(cmt + fr * 128 + kk + fq * 8);
#pragma unroll
      for (int mm = 0; mm < 2; ++mm) {
        const int mi = (w & 1) * 2 + mm;
        bf16x8 af = *(const bf16x8*)(sm + (size_t)((gi * 2 + dir) * 64 + mi * 16 + fr) * RS + kk + fq * 8);
        acc[mm] = MFMA16(af, bfr, acc[mm]);
      }
    }
    const float dsk = p.in[25][l * 512 + g * 16 + fr];
    u16* y5 = (u16*)(p.ws + B_Y5);
#pragma unroll
    for (int mm = 0; mm < 2; ++mm)
#pragma unroll
      for (int r = 0; r < 4; ++r) {
        const size_t t = (size_t)chunk * 64 + ((w & 1) * 2 + mm) * 16 + fq * 4 + r;
        float u = bf2f(us5[t * 512 + g * 16 + fr]);
        float y = acc[mm][r] + dsk * u;
        y5[t * 512 + g * 16 + fr] = f2bf(gelu_tanh(y));
      }
  }
}
DI void s5_carry_tile(const Params& p, int l, int tile) {
  const int seq = tile >> 4, gp = tile & 15;
  const int tid = otid(), gi = tid >> 7, dir = (tid >> 6) & 1, pp = tid & 63, g = gp * 2 + gi;
  int c0, nc;
  if (seq < 32) { c0 = seq * 4; nc = 4; } else { c0 = 128 + (seq - 32) * 32; nc = 32; }
  const float2 l64 = ((const float2*)(p.ws + B_LAM64))[((l * 2 + dir) * 32 + g) * 64 + pp];
  float hr = 0.f, hi = 0.f;
  if (seq >= 32) {
    const size_t si = ((size_t)((seq - 32) * 4 + l) * 2 + dir) * 2048 + g * 64 + pp;
    hr = p.in[3][si]; hi = p.in[4][si];
  }
  const float2* hend = (const float2*)(p.ws + B_HEND);
  float2* hin = (float2*)(p.ws + B_HIN);
  for (int it = 0; it < nc; ++it) {
    const int ck = c0 + (dir ? nc - 1 - it : it);
    const size_t idx = ((size_t)(ck * 32 + g) * 2 + dir) * 64 + pp;
    hin[idx] = make_float2(hr, hi);
    float2 he = hend[idx];
    float nr = __builtin_fmaf(l64.x, hr, __builtin_fmaf(-l64.y, hi, he.x));
    float ni = __builtin_fmaf(l64.x, hi, __builtin_fmaf(l64.y, hr, he.y));
    asm volatile("" : "+v"(nr));
    asm volatile("" : "+v"(ni));
    hr = nr; hi = ni;
  }
  if (seq < 32) {
    const size_t so = ((size_t)(seq * 4 + l) * 2 + dir) * 2048 + g * 64 + pp;
    p.out[O_S5RE + so] = hr;
    p.out[O_S5IM + so] = hi;
  }
}

DI void delta_local_tile(const Params& p, int tile, float* smf) {
  const int chunk = tile >> 1, dir = tile & 1;
  const int tid = otid(), lane = tid & 63, h = tid >> 6;
  const int m = lane & 31, h2 = lane >> 5;
  const int tb = chunk * 64;
  const float* bg = (const float*)(p.ws + B_BG);
  const u16* kn = (const u16*)(p.ws + B_KN);
  const u16* qn = (const u16*)(p.ws + B_QN);
  float* Aw = smf + h * 4096;
  const size_t cidx = ((size_t)(chunk * 4 + h) * 2 + dir);
  const int tl = tb + (dir ? 63 - lane : lane);
  float gcs = bg[(size_t)tl * 16 + 8 + dir * 4 + h];
  const float beta = bg[(size_t)tl * 16 + dir * 4 + h];
#pragma unroll
  for (int o = 1; o < 64; o <<= 1) {
    float v = __shfl_up(gcs, o);
    if (lane >= o) gcs += v;
  }
  ((float*)(p.ws + B_GC))[cidx * 64 + lane] = gcs;
  ((float*)(p.ws + B_BC))[cidx * 64 + lane] = beta;
  __syncthreads();
  u16* qkm = (u16*)(p.ws + B_QKM) + cidx * 4096;
#pragma unroll 1
  for (int tt = 0; tt < 3; ++tt) {
    const int mi = tt == 0 ? 0 : 1, ni = tt == 2 ? 1 : 0;
    const int cm = 32 * mi + m, cn = 32 * ni + m;
    const u16* krm = kn + (size_t)(tb + (dir ? 63 - cm : cm)) * 512 + h * 128 + h2 * 8;
    const u16* qrm = qn + (size_t)(tb + (dir ? 63 - cm : cm)) * 512 + h * 128 + h2 * 8;
    const u16* krn = kn + (size_t)(tb + (dir ? 63 - cn : cn)) * 512 + h * 128 + h2 * 8;
    f32x16 ak, aq;
#pragma unroll
    for (int r = 0; r < 16; ++r) { ak[r] = 0.f; aq[r] = 0.f; }
#pragma unroll
    for (int ks = 0; ks < 8; ++ks) {
      const bf16x8 fkm = *(const bf16x8*)(krm + ks * 16), fqm = *(const bf16x8*)(qrm + ks * 16), fkn = *(const bf16x8*)(krn + ks * 16);
      ak = MFMA32(fkm, fkn, ak);
      aq = MFMA32(fqm, fkn, aq);
    }
    const int e = 32 * ni + m;
    const float gce = __shfl(gcs, e);
#pragma unroll
    for (int r = 0; r < 16; ++r) {
      const int c = 32 * mi + crow(r, h2);
      const float gcc = __shfl(gcs, c), bc = __shfl(beta, c);
      const float dec = (e <= c) ? __expf(gcc - gce) : 0.f;
      Aw[c * 64 + e] = (e < c) ? ak[r] * bc * dec : 0.f;
      qkm[c * 64 + e] = f2bf(aq[r] * dec);
    }
  }
  __syncthreads();
  u16* tm = (u16*)(p.ws + B_TM) + cidx * 4096;
  float x[64];
#pragma unroll
  for (int i = 0; i < 64; ++i) {
    float a = (i == lane) ? 1.f : 0.f;
#pragma unroll
    for (int j = 0; j < i; ++j) a -= Aw[i * 64 + j] * x[j];
    x[i] = a;
    tm[i * 64 + lane] = f2bf(a);
  }
}

template <int dir>
DI void delta_scan_body(const Params& p, int l, int seq, int h, u16* sm);
DI void delta_scan_tile(const Params& p, int l, int idx, u16* sm) {
  int seq, h, dir;
  if (idx < 64) { seq = 32 + (idx >> 3); h = (idx >> 1) & 3; dir = idx & 1; }
  else { const int i2 = idx - 64; seq = i2 >> 3; h = (i2 >> 1) & 3; dir = i2 & 1; }
  if (dir) delta_scan_body<1>(p, l, seq, h, sm); else delta_scan_body<0>(p, l, seq, h, sm);
}
template <int dir>
DI void delta_scan_body(const Params& p, int l, int seq, int h, u16* sm) {
  int chunk0, nch;
  if (seq < 32) { chunk0 = seq * 4; nch = 4; } else { chunk0 = 128 + (seq - 32) * 32; nch = 32; }
  const int lane = otid() & 63, w = otid() >> 6;
  const int n = lane & 31, h2 = lane >> 5;
  const int dvc = w * 32 + n;
  const u16* kn = (const u16*)(p.ws + B_KN);
  const u16* qn = (const u16*)(p.ws + B_QN);
  const u16* vv = (const u16*)(p.ws + B_VV);
  u16* od = (u16*)(p.ws + (dir ? B_OB : B_OF));
  f32x16 S[4];
  if (seq >= 32) {
    const float* s0 = p.in[2] + ((size_t)(((seq - 32) * 4 + l) * 2 + dir) * 4 + h) * 16384;
#pragma unroll
    for (int t = 0; t < 4; ++t)
#pragma unroll
      for (int r = 0; r < 16; ++r) S[t][r] = s0[(size_t)(32 * t + crow(r, h2)) * 128 + dvc];
  } else {
#pragma unroll
    for (int t = 0; t < 4; ++t)
#pragma unroll
      for (int r = 0; r < 16; ++r) S[t][r] = 0.f;
  }
  for (int it = 0; it < nch; ++it) {
    const int chunk = chunk0 + (dir ? nch - 1 - it : it);
    const int tb = chunk * 64;
    const size_t cidx = ((size_t)(chunk * 4 + h) * 2 + dir);
    const float* gcp = (const float*)(p.ws + B_GC) + cidx * 64;
    const float* bcp = (const float*)(p.ws + B_BC) + cidx * 64;
    const u16* tm = (const u16*)(p.ws + B_TM) + cidx * 4096;
    const u16* qkm = (const u16*)(p.ws + B_QKM) + cidx * 4096;
    const u16* ktp = (const u16*)(p.ws + B_KT) + (size_t)(chunk * 4 + h) * 8192;
    const float glast = gcp[63];
    size_t trow[2];
#pragma unroll
    for (int mi = 0; mi < 2; ++mi) { const int c = 32 * mi + n; trow[mi] = (size_t)(tb + (dir ? 63 - c : c)); }
#define SCHED_FENCE() asm volatile("" ::: "memory")
    u16* Ks = sm; u16* Qs = sm + 8704; u16* Vs = sm + 17408; u16* KTs = sm + 26112;
    u16* vls = Vs + w * 32;
    __syncthreads();
    {
      const int tid_ = otid();
      const int r0 = tid_ >> 4, ck = tid_ & 15;
      uint4 tk[4], tq[4], tv[4], tt[4];
#pragma unroll
      for (int j = 0; j < 4; ++j) {
        const size_t go = (size_t)(tb + r0 + 16 * j) * 512 + h * 128 + ck * 8;
        tk[j] = *(const uint4*)(kn + go); tq[j] = *(const uint4*)(qn + go); tv[j] = *(const uint4*)(vv + go);
        tt[j] = *(const uint4*)(ktp + ((tid_ >> 3) + 32 * j) * 64 + (tid_ & 7) * 8);
      }
#pragma unroll
      for (int j = 0; j < 4; ++j) {
        const int tau = r0 + 16 * j, c = dir ? 63 - tau : tau;
        *(uint4*)(Ks + c * 136 + ck * 8) = tk[j]; *(uint4*)(Qs + c * 136 + ck * 8) = tq[j]; *(uint4*)(Vs + c * 136 + ck * 8) = tv[j];
        *(uint4*)(KTs + ((tid_ >> 3) + 32 * j) * 72 + (tid_ & 7) * 8) = tt[j];
      }
    }
    __syncthreads();
    f32x16 X[2], QS[2];
    {
      bf16x8 Sb[4][2];
#pragma unroll
      for (int t = 0; t < 4; ++t)
#pragma unroll
        for (int s = 0; s < 2; ++s) Sb[t][s] = pack_acc(S[t], s);
#pragma unroll
      for (int mi = 0; mi < 2; ++mi)
#pragma unroll
        for (int r = 0; r < 16; ++r) { X[mi][r] = 0.f; QS[mi][r] = 0.f; }
#pragma unroll
      for (int t = 0; t < 4; ++t) {
#pragma unroll
        for (int mi = 0; mi < 2; ++mi) {
          const u16* krow_ = Ks + (32 * mi + n) * 136;
          const u16* qrow_ = Qs + (32 * mi + n) * 136;
#pragma unroll
          for (int s = 0; s < 2; ++s) {
            X[mi] = MFMA32(load_perm(krow_ + 32 * t, s, h2), Sb[t][s], X[mi]);
            QS[mi] = MFMA32(load_perm(qrow_ + 32 * t, s, h2), Sb[t][s], QS[mi]);
          }
        }
        SCHED_FENCE();
      }
    }
    bf16x8 Rb[2][2];
#pragma unroll
    for (int mi = 0; mi < 2; ++mi) {
#pragma unroll
      for (int a = 0; a < 4; ++a) {
        const int c4 = 32 * mi + 8 * a + 4 * h2;
        const float4 g4 = *(const float4*)(gcp + c4);
        const float4 b4 = *(const float4*)(bcp + c4);
        const float gg[4] = {g4.x, g4.y, g4.z, g4.w};
        const float bb[4] = {b4.x, b4.y, b4.z, b4.w};
#pragma unroll
        for (int q = 0; q < 4; ++q) {
          const int c = c4 + q;
          const float v = bf2f(vls[c * 136 + n]);
          const float eg = __expf(gg[q]);
          X[mi][4 * a + q] = bb[q] * (v - eg * X[mi][4 * a + q]);
          QS[mi][4 * a + q] *= eg;
        }
      }
      Rb[mi][0] = pack_acc(X[mi], 0);
      Rb[mi][1] = pack_acc(X[mi], 1);
    }
    SCHED_FENCE();
    f32x16 Vn[2];
#pragma unroll
    for (int mo = 0; mo < 2; ++mo) {
#pragma unroll
      for (int r = 0; r < 16; ++r) Vn[mo][r] = 0.f;
#pragma unroll
      for (int mi = 0; mi <= mo; ++mi)
#pragma unroll
        for (int s = 0; s < 2; ++s) Vn[mo] = MFMA32(load_perm(tm + (32 * mo + n) * 64 + 32 * mi, s, h2), Rb[mi][s], Vn[mo]);
    }
    SCHED_FENCE();
    {
      bf16x8 Vb[2][2];
#pragma unroll
      for (int mi = 0; mi < 2; ++mi) { Vb[mi][0] = pack_acc(Vn[mi], 0); Vb[mi][1] = pack_acc(Vn[mi], 1); }
#pragma unroll
      for (int mo = 0; mo < 2; ++mo) {
#pragma unroll
        for (int mi = 0; mi <= mo; ++mi)
#pragma unroll
          for (int s = 0; s < 2; ++s) QS[mo] = MFMA32(load_perm(qkm + (32 * mo + n) * 64 + 32 * mi, s, h2), Vb[mi][s], QS[mo]);
      }
      __syncthreads();
#pragma unroll
      for (int mo = 0; mo < 2; ++mo)
#pragma unroll
        for (int r = 0; r < 16; ++r) vls[(32 * mo + crow(r, h2)) * 136 + n] = f2bf(QS[mo][r]);
      __syncthreads();
#pragma unroll
      for (int jv = 0; jv < 4; ++jv) {
        const int tau = (lane >> 2) + 16 * jv, cq = lane & 3;
        const uint4 oq = *(const uint4*)(vls + (dir ? 63 - tau : tau) * 136 + cq * 8);
        *(uint4*)(od + (size_t)(tb + tau) * 512 + h * 128 + w * 32 + cq * 8) = oq;
      }
    }
    SCHED_FENCE();
    bf16x8 Vsb[2][2];
#pragma unroll
    for (int mi = 0; mi < 2; ++mi) {
#pragma unroll
      for (int a = 0; a < 4; ++a) {
        const float4 g4 = *(const float4*)(gcp + 32 * mi + 8 * a + 4 * h2);
        Vn[mi][4 * a + 0] *= __expf(glast - g4.x); Vn[mi][4 * a + 1] *= __expf(glast - g4.y);
        Vn[mi][4 * a + 2] *= __expf(glast - g4.z); Vn[mi][4 * a + 3] *= __expf(glast - g4.w);
      }
      Vsb[mi][0] = pack_acc(Vn[mi], 0); Vsb[mi][1] = pack_acc(Vn[mi], 1);
    }
    const float eg = __expf(glast);
#pragma unroll
    for (int t = 0; t < 4; ++t) {
#pragma unroll
      for (int r = 0; r < 16; ++r) S[t][r] *= eg;
      const u16* ktrow = KTs + (32 * t + n) * 72;
#pragma unroll
      for (int mi = 0; mi < 2; ++mi)
#pragma unroll
        for (int s = 0; s < 2; ++s) {
          bf16x8 a = dir ? load_perm_rev(ktrow, 32 * mi, s, h2) : load_perm(ktrow + 32 * mi, s, h2);
          S[t] = MFMA32(a, Vsb[mi][s], S[t]);
        }
      SCHED_FENCE();
    }
  }
  if (seq < 32) {
    float* so = p.out + O_SD + ((size_t)((seq * 4 + l) * 2 + dir) * 4 + h) * 16384;
#pragma unroll
    for (int t = 0; t < 4; ++t)
#pragma unroll
      for (int r = 0; r < 16; ++r) so[(size_t)(32 * t + crow(r, h2)) * 128 + dvc] = S[t][r];
  }
}

DI void attn_tile(const Params& p, int seq, int head, int qb, u16* sm) {
  const int lane = otid() & 63, w = otid() >> 6;
  const int n = lane & 31, h2 = lane >> 5;
  int tq0, nkeys; size_t kbo, vto;
  if (seq < 32) { tq0 = seq * 256 + qb * 128 + w * 32; nkeys = 256; kbo = (size_t)(seq * 8 + head) * 256 * 96; vto = (size_t)(seq * 8 + head) * 64 * 256; }
  else { const int s = seq - 32; tq0 = TP_ + s * 2048 + qb * 128 + w * 32; nkeys = 2304; kbo = KB_P + (size_t)(s * 8 + head) * 2304 * 96; vto = VT_P + (size_t)(s * 8 + head) * 64 * 2304; }
  const u16* kb = (const u16*)(p.ws + B_KB) + kbo;
  const u16* vt = (const u16*)(p.ws + B_VT) + vto;
  const u16* qm = (const u16*)(p.ws + B_QM) + (size_t)(tq0 + n) * 768 + head * 96;
  bf16x8 qf[6];
#pragma unroll
  for (int ks = 0; ks < 6; ++ks) qf[ks] = *(const bf16x8*)(qm + ks * 16 + h2 * 8);
  f32x16 O[2];
#pragma unroll
  for (int r = 0; r < 16; ++r) { O[0][r] = 0.f; O[1][r] = 0.f; }
  float mrun = -1e30f, lsum = 0.f;
  const int nkt = nkeys >> 6;
  constexpr int KST = 104, VST = 72, STG = 64 * KST + 64 * VST;
  const int tid_ = otid();
  uint4 rk0, rk1, rk2, rv0, rv1;
  const int kc0 = tid_, kc1 = tid_ + 256, kc2 = tid_ + 512;
  const u16* kg0 = kb + (size_t)(kc0 / 12) * 96 + (kc0 % 12) * 8;
  const u16* kg1 = kb + (size_t)(kc1 / 12) * 96 + (kc1 % 12) * 8;
  const u16* kg2 = kb + (size_t)(kc2 / 12) * 96 + (kc2 % 12) * 8;
  const u16* vg0 = vt + (size_t)(tid_ >> 3) * nkeys + (tid_ & 7) * 8;
  const u16* vg1 = vt + (size_t)((tid_ + 256) >> 3) * nkeys + (tid_ & 7) * 8;
  const int kl0 = (kc0 / 12) * KST + (kc0 % 12) * 8, kl1 = (kc1 / 12) * KST + (kc1 % 12) * 8, kl2 = (kc2 / 12) * KST + (kc2 % 12) * 8;
  const int vl0 = (tid_ >> 3) * VST + (tid_ & 7) * 8, vl1 = ((tid_ + 256) >> 3) * VST + (tid_ & 7) * 8;
#define AT_GLOAD(kt_) do { rk0 = *(const uint4*)(kg0 + (size_t)(kt_) * 6144); rk1 = *(const uint4*)(kg1 + (size_t)(kt_) * 6144); \
    rk2 = *(const uint4*)(kg2 + (size_t)(kt_) * 6144); rv0 = *(const uint4*)(vg0 + (kt_) * 64); rv1 = *(const uint4*)(vg1 + (kt_) * 64); } while (0)
#define AT_SSTORE(st_) do { u16* ks2_ = sm + (st_) * STG; u16* vs2_ = ks2_ + 64 * KST; \
    *(uint4*)(ks2_ + kl0) = rk0; *(uint4*)(ks2_ + kl1) = rk1; *(uint4*)(ks2_ + kl2) = rk2; *(uint4*)(vs2_ + vl0) = rv0; *(uint4*)(vs2_ + vl1) = rv1; } while (0)
  __syncthreads();
  AT_GLOAD(0); AT_SSTORE(0);
  __syncthreads();
  for (int kt = 0; kt < nkt; ++kt) {
    const bool more = kt + 1 < nkt;
    if (more) AT_GLOAD(kt + 1);
    const u16* ks_ = sm + (kt & 1) * STG;
    const u16* vs_ = ks_ + 64 * KST;
    f32x16 St[2];
#pragma unroll
    for (int sub = 0; sub < 2; ++sub) {
#pragma unroll
      for (int r = 0; r < 16; ++r) St[sub][r] = 0.f;
      const u16* kr = ks_ + (sub * 32 + n) * KST + h2 * 8;
#pragma unroll
      for (int ks = 0; ks < 6; ++ks) St[sub] = MFMA32(*(const bf16x8*)(kr + ks * 16), qf[ks], St[sub]);
    }
    float mx = St[0][0];
#pragma unroll
    for (int r = 0; r < 16; ++r) { mx = fmaxf(mx, St[0][r]); mx = fmaxf(mx, St[1][r]); }
    mx = fmaxf(mx, __shfl_xor(mx, 32));
    const float mnew = fmaxf(mrun, mx);
    const float alpha = exp2f(mrun - mnew);
    mrun = mnew;
    float ps = 0.f;
#pragma unroll
    for (int sub = 0; sub < 2; ++sub)
#pragma unroll
      for (int r = 0; r < 16; ++r) { float e = exp2f(St[sub][r] - mnew); St[sub][r] = e; ps += e; }
    lsum = lsum * alpha + ps;
#pragma unroll
    for (int r = 0; r < 16; ++r) { O[0][r] *= alpha; O[1][r] *= alpha; }
#pragma unroll
    for (int sub = 0; sub < 2; ++sub)
#pragma unroll
      for (int s = 0; s < 2; ++s) {
        const bf16x8 pb = pack_acc(St[sub], s);
#pragma unroll
        for (int dt = 0; dt < 2; ++dt)
          O[dt] = MFMA32(load_perm(vs_ + (dt * 32 + n) * VST + sub * 32, s, h2), pb, O[dt]);
      }
    if (more) AT_SSTORE((kt + 1) & 1);
    __syncthreads();
  }
  lsum += __shfl_xor(lsum, 32);
  const float inv = 1.f / lsum;
  u16* oc = (u16*)(p.ws + B_OC) + (size_t)(tq0 + n) * 512 + head * 64;
#pragma unroll
  for (int dt = 0; dt < 2; ++dt)
#pragma unroll
    for (int a = 0; a < 4; ++a) {
      const int dv = dt * 32 + 8 * a + 4 * h2;
      *(uint2*)(oc + dv) = make_uint2(pack2(O[dt][4 * a] * inv, O[dt][4 * a + 1] * inv), pack2(O[dt][4 * a + 2] * inv, O[dt][4 * a + 3] * inv));
    }
}

DI void delta_out_tile(const Params& p, int l, int tile) {
  const int lane = otid() & 63, w = otid() >> 6;
  const u16* of = (const u16*)(p.ws + B_OF);
  const u16* ob = (const u16*)(p.ws + B_OB);
  const u16* z = (const u16*)(p.ws + B_Z);
  u16* oa = (u16*)(p.ws + B_OA);
  const float g0 = p.in[17][l * 128 + 2 * lane], g1 = p.in[17][l * 128 + 2 * lane + 1];
#pragma unroll 1
  for (int q = 0; q < 16; ++q) {
    const size_t t = (size_t)tile * 16 + w * 4 + (q >> 2);
    const int hh = q & 3;
    const size_t off = t * 512 + hh * 128 + 2 * lane;
    unsigned a = *(const unsigned*)(of + off), b = *(const unsigned*)(ob + off), zz = *(const unsigned*)(z + off);
    float o0 = blo(a) + blo(b), o1 = bhi(a) + bhi(b);
    float ss = wave_sum(o0 * o0 + o1 * o1);
    float rstd = rsqrtf(ss * (1.f / 128.f) + 1e-6f);
    float y0 = o0 * rstd * g0 * siluf_(blo(zz)), y1 = o1 * rstd * g1 * siluf_(bhi(zz));
    *(unsigned*)(oa + off) = pack2(y0, y1);
  }
}

DI void grid_barrier(unsigned* bar, unsigned target) {
  asm volatile("s_waitcnt vmcnt(0) lgkmcnt(0)" ::: "memory");
  __syncthreads();
  if (otid() == 0) {
    __builtin_amdgcn_fence(__ATOMIC_RELEASE, "agent");
    asm volatile("s_waitcnt vmcnt(0)" ::: "memory");
    __hip_atomic_fetch_add(bar, 1u, __ATOMIC_RELAXED, __HIP_MEMORY_SCOPE_AGENT);
    while (__hip_atomic_load(bar, __ATOMIC_RELAXED, __HIP_MEMORY_SCOPE_AGENT) < target) __builtin_amdgcn_s_sleep(1);
    __builtin_amdgcn_fence(__ATOMIC_ACQUIRE, "agent");
    asm volatile("s_waitcnt vmcnt(0)" ::: "memory");
  }
  __syncthreads();
}
#define GSYNC() do { bar_target += gridDim.x; grid_barrier(p.bar, bar_target); } while (0)
#ifndef ONLY
#define PH(n) 1
#else
#define PH(n) ((n) == ONLY || (n) / 100 == ONLY || (n) == ONLY / 100)
#endif
__global__ void __launch_bounds__(256, 2) mega(Params p) {
  cg::grid_group grid = cg::this_grid();
  __shared__ __attribute__((aligned(16))) char smem_raw[73728];
  u16* sm = (u16*)smem_raw;
  float* smf = (float*)smem_raw;
  const int nb = gridDim.x, bid = blockIdx.x;
  unsigned bar_target = 0;
  grid.sync();

  if (PH(0)) {
    const int tid = otid();
    for (int j = bid; j < 4 * CJ8; j += nb) conv_job(p, j / CJ8, j % CJ8, smf);
    for (int j = bid; j < 4 * 96; j += nb) mods_tile(p, j / 96, j % 96, smf);
    for (int j = bid; j < 64; j += nb) s5pre_tile(p, j);
    {
      const float4* xp = (const float4*)p.in[0];
      const float4* xs = (const float4*)p.in[1];
      float4* o = (float4*)p.out;
      const size_t nP = (size_t)TP_ * 256, nT = (size_t)T_ * 256;
      for (size_t i = (size_t)bid * 256 + tid; i < nT; i += (size_t)nb * 256) o[i] = i < nP ? xp[i] : xs[i - nP];
    }
    {
      float* rope = (float*)(p.ws + B_ROPE);
      for (int i = bid * 256 + tid; i < 2048 * 16; i += nb * 256) {
        const int pos = i >> 4, f = i & 15;
        const float invf = 1.f / powf(10000.f, (float)(f & 7) * 0.125f);
        const float ang = (f < 8 ? (float)(pos >> 6) : (float)(pos & 63)) * invf;
        float sn, cs;
        sincosf(ang, &sn, &cs);
        rope[i * 2] = cs; rope[i * 2 + 1] = sn;
      }
    }
    {
      u16* cc = (u16*)(p.ws + B_CKVC);
      for (int i = bid * 256 + tid; i < 8 * 4 * 256 * 256 / 2; i += nb * 256) {
        const int e = i * 2;
        const int c = e & 255, pos = (e >> 8) & 255, l = (e >> 16) & 3, b = e >> 18;
        float2 v = *(const float2*)(p.in[5] + e);
        *(unsigned*)(cc + ((size_t)(l * 2048 + b * 256 + pos)) * 256 + c) = pack2(v.x, v.y);
      }
    }
  }
  GSYNC();

  for (int l = 0; l < 4; ++l) {
    const u16* WL = (const u16*)(p.ws + B_W) + (size_t)l * W_LAYER;
    const float* mods = (const float*)(p.ws + B_MODS);
    if (PH(1)) norm_phase(p, l, 0, 1, p.in[11] + l * 1024);
    GSYNC();
    if (PH(2)) gemm_in_phase(p, l, sm);
    GSYNC();
    if (PH(3)) {
      for (int j = bid; j < NCH; j += nb) delta_prep_tile(p, l, j, sm);
      for (int j = bid; j < T_ / 4; j += nb) mla_prep_tile(p, l, j);
      for (int j = bid; j < 256; j += nb) cache_rope_tile(p, l, j);
      for (int j = bid; j < NCH * 16; j += nb) s5_chunk_tile(p, l, j >> 4, j & 15, 0, sm);
    }
    GSYNC();
    if (PH(4)) {
      const int tid = otid();
      if (PH(400)) for (int j = bid; j < NCH * 2; j += nb) delta_local_tile(p, j, smf);
      if (PH(410)) for (int j = bid; j < 192 * 6; j += nb) {
          const int q = j, mt = q / 6, nt = q % 6;
          f32x4 acc[4][4];
          zero_acc<4>(acc);
          gemm_core<4>(acc, (const u16*)(p.ws + B_QA) + (size_t)mt * 128 * 384, 384, WL + W_QB + (size_t)nt * 128 * 384, 384, 384, sm);
          u16* qm = (u16*)(p.ws + B_QM);
          const float qs = 0.10206207261596575f * 1.4426950408889634f;
          const float* rope = (const float*)(p.ws + B_ROPE);
          const int e_lane = tid & 63, e_w = tid >> 6, e_wr = e_w >> 1, e_wc = e_w & 1, e_fr = e_lane & 15, e_fq = e_lane >> 4;
          const bool is_s = (mt * 128 >= TP_);
#pragma unroll
          for (int i = 0; i < 4; ++i)
#pragma unroll
            for (int r = 0; r < 4; ++r) {
              const int row = mt * 128 + e_wr * 64 + i * 16 + e_fq * 4 + r;
              float vals[4];
#pragma unroll
              for (int jj = 0; jj < 4; ++jj) vals[jj] = acc[i][jj][r];
              if (is_s) {
                const int pos = (row - TP_) & 2047;
                const float cs = rope[(pos * 16 + e_fr) * 2], sn = rope[(pos * 16 + e_fr) * 2 + 1];
#pragma unroll
                for (int jj = 0; jj < 4; jj += 2) {
                  const int gt = (nt * 128 + e_wc * 64) / 16 + jj;
                  if (gt % 6 == 4) {
                    const float x1 = vals[jj], x2 = vals[jj + 1];
                    vals[jj] = x1 * cs - x2 * sn;
                    vals[jj + 1] = x2 * cs + x1 * sn;
                  }
                }
              }
#pragma unroll
              for (int jj = 0; jj < 4; ++jj) qm[(size_t)row * 768 + nt * 128 + e_wc * 64 + jj * 16 + e_fr] = f2bf(vals[jj] * qs);
            }
      }
      if (PH(420)) for (int j = bid; j < 208 * 8; j += nb) {
          const int q = j, mt = q >> 3, head = q & 7;
          f32x4 acc[4][4];
          zero_acc<4>(acc);
          const u16* A = mt < 192 ? (const u16*)(p.ws + B_KVA) + (size_t)mt * 128 * 256
                                  : (const u16*)(p.ws + B_CKVC) + ((size_t)l * 2048 + (size_t)(mt - 192) * 128) * 256;
          gemm_core<4>(acc, A, 256, WL + W_KVB + (size_t)head * 128 * 256, 256, 256, sm);
          int key0, nkeys; size_t kbo, vto;
          if (mt < 64) { const int seq = mt >> 1; key0 = (mt & 1) * 128; nkeys = 256; kbo = (size_t)(seq * 8 + head) * 256 * 96; vto = (size_t)(seq * 8 + head) * 64 * 256; }
          else if (mt < 192) { const int s = (mt - 64) >> 4; key0 = 256 + ((mt - 64) & 15) * 128; nkeys = 2304; kbo = KB_P + (size_t)(s * 8 + head) * 2304 * 96; vto = VT_P + (size_t)(s * 8 + head) * 64 * 2304; }
          else { const int s = (mt - 192) >> 1; key0 = ((mt - 192) & 1) * 128; nkeys = 2304; kbo = KB_P + (size_t)(s * 8 + head) * 2304 * 96; vto = VT_P + (size_t)(s * 8 + head) * 64 * 2304; }
          u16* kb = (u16*)(p.ws + B_KB) + kbo;
          u16* vt = (u16*)(p.ws + B_VT) + vto;
          const int e_lane = tid & 63, e_w = tid >> 6, e_wr = e_w >> 1, e_wc = e_w & 1, e_fr = e_lane & 15, e_fq = e_lane >> 4;
#pragma unroll
          for (int i = 0; i < 4; ++i)
#pragma unroll
            for (int jj = 0; jj < 4; ++jj) {
              const int key = key0 + e_wr * 64 + i * 16 + e_fq * 4;
              const int c = jj * 16 + e_fr;
              if (e_wc == 0) {
#pragma unroll
                for (int r = 0; r < 4; ++r) kb[(size_t)(key + r) * 96 + c] = f2bf(acc[i][jj][r]);
              } else {
                *(uint2*)(vt + (size_t)c * nkeys + key) = make_uint2(pack2(acc[i][jj][0], acc[i][jj][1]), pack2(acc[i][jj][2], acc[i][jj][3]));
              }
            }
      }
      if (PH(430)) for (int j = bid; j < 640; j += nb) s5_carry_tile(p, l, j);
    }
    GSYNC();
    if (PH(5)) {
      if (PH(500)) for (int j = bid; j < 320; j += nb) delta_scan_tile(p, l, j, sm);
      if (PH(510)) for (int j = bid; j < 1536; j += nb) {
        if (j < 1024) attn_tile(p, 32 + (j >> 7), (j >> 4) & 7, j & 15, sm);
        else { const int q = j - 1024; attn_tile(p, q >> 4, (q >> 1) & 7, q & 1, sm); }
      }
      if (PH(530)) for (int j = bid; j < NCH * 8; j += nb) {
        s5_chunk_tile(p, l, j >> 3, (j & 7) * 2, 1, sm);
        s5_chunk_tile(p, l, j >> 3, (j & 7) * 2 + 1, 1, sm);
      }
    }
    GSYNC();
    if (PH(6)) {
      for (int j = bid; j < T_ / 16; j += nb) delta_out_tile(p, l, j);
      for (int j = bid; j < 192 * 4; j += nb) {
        {
          const int q = j, mt = q >> 2, nt = q & 3;
          f32x4 acc[4][4];
          zero_acc<4>(acc);
          const u16* y5 = (const u16*)(p.ws + B_Y5);
          gemm_core<4>(acc, y5 + (size_t)mt * 128 * 512, 512, WL + W_GLU + (size_t)nt * 128 * 512, 512, 512, sm);
          u16* ob5 = (u16*)(p.ws + B_OB5);
          const float* bgl = p.in[27] + l * 512;
          EPI_LOOP(4) {
            const size_t row = mt * 128 + EROW; const int col = nt * 128 + ECOL(4);
            const float y = bf2f(y5[row * 512 + col]);
            ob5[row * 512 + col] = f2bf(y * sigmoidf_(acc[i][j][r] + bgl[col]));
          }
        }
      }
    }
    GSYNC();
    if (PH(7)) {
      const u16* H = (const u16*)(p.ws + B_H);
      u16* mg = (u16*)(p.ws + B_MG);
      for (int j = bid; j < 192 * 16; j += nb) {
        const int mt = j >> 4, nt = j & 15;
        f32x4 mer[4][2];
        zero_acc<2>(mer);
#pragma unroll 1
        for (int n = 0; n < 3; ++n) {
          f32x4 ag[4][2], ab[4][2];
          zero_acc<2>(ag);
          gemm_core<2>(ag, H + (size_t)mt * 128 * 1024, 1024, WL + W_G + (size_t)(n * 1024 + nt * 64) * 1024, 1024, 1024, sm);
          zero_acc<2>(ab);
          const u16* on = (const u16*)(p.ws + (n == 0 ? B_OA : (n == 1 ? B_OB5 : B_OC)));
          gemm_core<2>(ab, on + (size_t)mt * 128 * 512, 512, WL + W_BR + (size_t)(nt * 64) * 1536 + n * 512, 1536, 512, sm);
#pragma unroll
          for (int i = 0; i < 4; ++i)
#pragma unroll
            for (int jj = 0; jj < 2; ++jj)
#pragma unroll
              for (int r = 0; r < 4; ++r) mer[i][jj][r] += sigmoidf_(ag[i][jj][r]) * ab[i][jj][r];
        }
        EPI_LOOP(2) { mg[(size_t)(mt * 128 + EROW) * 1024 + nt * 64 + ECOL(2)] = f2bf(mer[i][j][r]); }
      }
    }
    GSYNC();
    if (PH(8)) {
      const u16* mg = (const u16*)(p.ws + B_MG);
      for (int j = bid; j < 192 * 8; j += nb) {
        const int mt = j >> 3, nt = j & 7;
        f32x4 acc[4][4];
        zero_acc<4>(acc);
        gemm_core<4>(acc, mg + (size_t)mt * 128 * 1024, 1024, WL + W_OUT + (size_t)nt * 128 * 1024, 1024, 1024, sm);
        const float* gm = mods + (size_t)(l * 9 + tok_v(mt * 128)) * 6144 + 2 * 1024;
        EPI_LOOP(4) {
          const size_t row = mt * 128 + EROW; const int col = nt * 128 + ECOL(4);
          p.out[row * 1024 + col] += gm[col] * acc[i][j][r];
        }
      }
    }
    GSYNC();
    if (PH(9)) norm_phase(p, l, 3, 4, p.in[12] + l * 1024);
    GSYNC();
    if (PH(10)) {
      const u16* H = (const u16*)(p.ws + B_H);
      u16* up = (u16*)(p.ws + B_UP);
      for (int j = bid; j < 192 * 44; j += nb) {
        const int mt = j / 44, nt = j % 44;
        f32x4 acc[4][4];
        zero_acc<4>(acc);
        gemm_core<4>(acc, H + (size_t)mt * 128 * 1024, 1024, WL + W_UP + (size_t)nt * 128 * 1024, 1024, 1024, sm);
        EPI_LOOP(4) { up[(size_t)(mt * 128 + EROW) * 5632 + nt * 128 + ECOL(4)] = f2bf(acc[i][j][r]); }
      }
    }
    GSYNC();
    if (PH(11)) {
      const int tid = otid();
      const u16* up = (const u16*)(p.ws + B_UP);
      u16* act = (u16*)(p.ws + B_ACT);
      const float* cw = p.in[35] + (size_t)l * 3 * 5632;
      const float* cb = p.in[36] + (size_t)l * 5632;
      for (size_t it = (size_t)bid * 256 + tid; it < (size_t)T_ * 352; it += (size_t)nb * 256) {
        const int t = (int)(it / 352), c8 = (int)(it % 352) * 8;
        int pos, L;
        if (t < TP_) { pos = t & 255; L = 256; } else { pos = (t - TP_) & 2047; L = 2048; }
        float res[8];
        float gv[8], vv2[8];
#pragma unroll
        for (int e = 0; e < 8; ++e) { gv[e] = cb[c8 + e]; vv2[e] = cb[2816 + c8 + e]; }
#pragma unroll
        for (int d = 0; d < 3; ++d) {
          const int ps = pos + d - 1;
          if (ps < 0 || ps >= L) continue;
          const u16* rowp = up + (size_t)(t + d - 1) * 5632;
          uint4 ug = *(const uint4*)(rowp + c8);
          uint4 uv = *(const uint4*)(rowp + 2816 + c8);
          const unsigned ugs[4] = {ug.x, ug.y, ug.z, ug.w}, uvs[4] = {uv.x, uv.y, uv.z, uv.w};
#pragma unroll
          for (int e = 0; e < 4; ++e) {
            gv[2 * e] += cw[d * 5632 + c8 + 2 * e] * blo(ugs[e]);
            gv[2 * e + 1] += cw[d * 5632 + c8 + 2 * e + 1] * bhi(ugs[e]);
            vv2[2 * e] += cw[d * 5632 + 2816 + c8 + 2 * e] * blo(uvs[e]);
            vv2[2 * e + 1] += cw[d * 5632 + 2816 + c8 + 2 * e + 1] * bhi(uvs[e]);
          }
        }
#pragma unroll
        for (int e = 0; e < 8; ++e) res[e] = siluf_(gv[e]) * vv2[e];
        *(uint4*)(act + (size_t)t * 2816 + c8) = make_uint4(pack2(res[0], res[1]), pack2(res[2], res[3]), pack2(res[4], res[5]), pack2(res[6], res[7]));
      }
    }
    GSYNC();
    if (PH(12)) {
      const u16* act = (const u16*)(p.ws + B_ACT);
      for (int j = bid; j < 192 * 8; j += nb) {
        const int mt = j >> 3, nt = j & 7;
        f32x4 acc[4][4];
        zero_acc<4>(acc);
        gemm_core<4>(acc, act + (size_t)mt * 128 * 2816, 2816, WL + W_DN + (size_t)nt * 128 * 2816, 2816, 2816, sm);
        const float* gf = mods + (size_t)(l * 9 + tok_v(mt * 128)) * 6144 + 5 * 1024;
        EPI_LOOP(4) {
          const size_t row = mt * 128 + EROW; const int col = nt * 128 + ECOL(4);
          p.out[row * 1024 + col] += gf[col] * acc[i][j][r];
        }
      }
    }
    GSYNC();
  }
  if (PH(13)) {
    const int tid = otid();
    const int lane = tid & 63, w = tid >> 6;
    const float* gfin = p.in[38];
    for (int tile = bid; tile < T_ / 4; tile += nb) {
      const int t = tile * 4 + w;
      float4* xr = (float4*)(p.out + (size_t)t * 1024);
      float4 v[4];
      float ss = 0.f;
#pragma unroll
      for (int j = 0; j < 4; ++j) { v[j] = xr[lane + 64 * j]; ss += v[j].x * v[j].x + v[j].y * v[j].y + v[j].z * v[j].z + v[j].w * v[j].w; }
      ss = wave_sum(ss);
      const float rstd = rsqrtf(ss * (1.f / 1024.f) + 1e-6f);
#pragma unroll
      for (int j = 0; j < 4; ++j) {
        float4 g = *(const float4*)(gfin + (lane + 64 * j) * 4);
        xr[lane + 64 * j] = make_float4(v[j].x * rstd * g.x, v[j].y * rstd * g.y, v[j].z * rstd * g.z, v[j].w * rstd * g.w);
      }
    }
  }
}

extern "C" void kernel_launch(void* const* d_in, const int* in_sizes, int n_in, void* d_out, int out_size,
                              void* d_ws, size_t ws_size, hipStream_t stream) {
  static int grid_blocks = 0;
  if (!grid_blocks) {
    int dev = 0, cus = 0, per_cu = 0;
    (void)hipGetDevice(&dev);
    (void)hipDeviceGetAttribute(&cus, hipDeviceAttributeMultiprocessorCount, dev);
    (void)hipOccupancyMaxActiveBlocksPerMultiprocessor(&per_cu, mega, 256, 0);
    if (per_cu > 2) per_cu = 2;
    if (per_cu < 1) per_cu = 1;
    grid_blocks = cus * per_cu;
  }
  if (ws_size < B_TOTAL || n_in < 39) {
    fprintf(stderr, "workspace too small: %zu < %zu\n", ws_size, (size_t)B_END);
    return;
  }
  Params p{};
  for (int i = 0; i < 39; ++i) p.in[i] = (const float*)d_in[i];
  p.out = (float*)d_out;
  p.ws = (char*)d_ws;
  p.bar = (unsigned*)((char*)d_ws + B_BAR);
  (void)hipMemsetAsync(p.bar, 0, 256, stream);
  void* args[] = {&p};
  hipError_t e = hipLaunchCooperativeKernel((void*)mega, dim3(grid_blocks), dim3(256), args, 0, stream);
  if (e != hipSuccess) fprintf(stderr, "cooperative launch failed: %s (grid %d)\n", hipGetErrorString(e), grid_blocks);
}
```

```cpp
#include <hip/hip_runtime.h>
#include <hip/hip_cooperative_groups.h>
#include <cstdio>
namespace cg = cooperative_groups;

#define DI __device__ __forceinline__
typedef __bf16 bf16;
using bf16x8 = __attribute__((ext_vector_type(8))) short;
using f32x4 = __attribute__((ext_vector_type(4))) float;
using f32x16 = __attribute__((ext_vector_type(16))) float;
typedef unsigned short u16;

constexpr int T_ = 24576, TP_ = 8192;
constexpr int NCH = 384;
constexpr long long O_SD = 25165824LL, O_S5RE = 41943040LL, O_S5IM = 42467328LL, O_CKV = 42991616LL, O_KR = 51380224LL;

constexpr size_t W_IN = 0;
constexpr size_t W_G = W_IN + 3328ull * 1024;
constexpr size_t W_QB = W_G + 3072ull * 1024;
constexpr size_t W_KVB = W_QB + 768ull * 384;
constexpr size_t W_GLU = W_KVB + 1024ull * 256;
constexpr size_t W_BR = W_GLU + 512ull * 512;
constexpr size_t W_OUT = W_BR + 1024ull * 1536;
constexpr size_t W_UP = W_OUT + 1024ull * 1024;
constexpr size_t W_DN = W_UP + 5632ull * 1024;
constexpr size_t W_LAYER = W_DN + 1024ull * 2816;

constexpr size_t al(size_t x) { return (x + 255) & ~(size_t)255; }
constexpr size_t B_W = 0;
constexpr size_t B_MODS = al(B_W + 4 * W_LAYER * 2);
constexpr size_t B_ROPE = al(B_MODS + 4ull * 9 * 6144 * 4);
constexpr size_t B_LAMB = al(B_ROPE + 2048ull * 32 * 4);
constexpr size_t B_LAM64 = al(B_LAMB + 4ull * 2 * 32 * 64 * 8);
constexpr size_t B_BBT = al(B_LAM64 + 4ull * 2 * 32 * 64 * 8);
constexpr size_t B_CMT = al(B_BBT + 4ull * 2 * 32 * 128 * 16 * 2);
constexpr size_t B_CKVC = al(B_CMT + 4ull * 32 * 16 * 128 * 2);
constexpr size_t B_H = al(B_CKVC + 4ull * 2048 * 256 * 2);
constexpr size_t B_QKV = al(B_H + (size_t)T_ * 1024 * 2);
constexpr size_t B_Z = al(B_QKV + (size_t)T_ * 1536 * 2);
constexpr size_t B_US5 = al(B_Z + (size_t)T_ * 512 * 2);
constexpr size_t B_QA = al(B_US5 + (size_t)T_ * 512 * 2);
constexpr size_t B_KVA = al(B_QA + (size_t)T_ * 384 * 2);
constexpr size_t B_MISC = al(B_KVA + (size_t)T_ * 256 * 2);
constexpr size_t B_QN = al(B_MISC + (size_t)T_ * 48 * 4);
constexpr size_t B_KN = al(B_QN + (size_t)T_ * 512 * 2);
constexpr size_t B_VV = al(B_KN + (size_t)T_ * 512 * 2);
constexpr size_t B_KT = al(B_VV + (size_t)T_ * 512 * 2);
constexpr size_t B_BG = al(B_KT + (size_t)T_ * 512 * 2);
constexpr size_t B_TM = al(B_BG + (size_t)T_ * 16 * 4);
constexpr size_t B_QKM = al(B_TM + (size_t)T_ * 512 * 2);
constexpr size_t B_GC = al(B_QKM + (size_t)T_ * 512 * 2);
constexpr size_t B_BC = al(B_GC + (size_t)NCH * 4 * 2 * 64 * 4);
constexpr size_t KB_P = 32ull * 8 * 256 * 96, KB_S = 8ull * 8 * 2304 * 96;
constexpr size_t VT_P = 32ull * 8 * 64 * 256, VT_S = 8ull * 8 * 64 * 2304;
constexpr size_t B_KB = al(B_BC + (size_t)NCH * 4 * 2 * 64 * 4);
constexpr size_t B_VT = al(B_KB + (KB_P + KB_S) * 2);
constexpr size_t B_QM = al(B_VT + (VT_P + VT_S) * 2);
constexpr size_t B_HEND = al(B_QM + (size_t)T_ * 768 * 2);
constexpr size_t B_HIN = al(B_HEND + (size_t)NCH * 32 * 2 * 64 * 8);
constexpr size_t B_Y5 = al(B_HIN + (size_t)NCH * 32 * 2 * 64 * 8);
constexpr size_t B_OC = al(B_Y5 + (size_t)T_ * 512 * 2);
constexpr size_t B_END = al(B_OC + (size_t)T_ * 512 * 2);
constexpr size_t B_OF = B_QKV;
constexpr size_t B_OB = B_QKV + (size_t)T_ * 512 * 2;
constexpr size_t B_MG = B_QKV;
constexpr size_t B_OA = B_QN;
constexpr size_t B_OB5 = B_KN;
constexpr size_t B_UP = B_QKV;
constexpr size_t B_ACT = B_KB;
static_assert(B_UP + (size_t)T_ * 5632 * 2 <= B_KB, "UP overlaps ACT");
static_assert(B_ACT + (size_t)T_ * 2816 * 2 <= B_END, "ACT too big");
constexpr size_t B_BAR = B_END;
constexpr size_t B_TOTAL = B_BAR + 256;
static_assert(B_TOTAL <= 768ull * 1024 * 1024, "workspace too big");

struct Params {
  const float* in[39];
  float* out;
  char* ws;
  unsigned* bar;
};

DI int otid() { int t = (int)__builtin_amdgcn_workitem_id_x(); asm volatile("" : "+v"(t)); return t; }
DI unsigned pack2(float a, float b) {
  typedef __attribute__((ext_vector_type(2))) __bf16 bf2;
  bf2 v; v[0] = (__bf16)a; v[1] = (__bf16)b;
  return __builtin_bit_cast(unsigned, v);
}
DI u16 f2bf(float a) { return (u16)(pack2(a, 0.f) & 0xffffu); }
DI float bf2f(u16 u) { return __uint_as_float(((unsigned)u) << 16); }
DI float blo(unsigned u) { return __uint_as_float(u << 16); }
DI float bhi(unsigned u) { return __uint_as_float(u & 0xffff0000u); }
DI float wave_sum(float v) {
#pragma unroll
  for (int o = 32; o > 0; o >>= 1) v += __shfl_xor(v, o);
  return v;
}
DI float sigmoidf_(float x) { return 1.f / (1.f + __expf(-x)); }
DI float siluf_(float x) { return x / (1.f + __expf(-x)); }
DI int tok_v(int t) { return t < TP_ ? 0 : 1 + ((t - TP_) >> 11); }
DI int crow(int r, int h2) { return (r & 3) + 8 * (r >> 2) + 4 * h2; }
DI bf16x8 mk8(unsigned a, unsigned b, unsigned c, unsigned d) {
  uint4 p = make_uint4(a, b, c, d);
  return __builtin_bit_cast(bf16x8, p);
}
DI bf16x8 pack_acc(const f32x16& x, int s) {
  return mk8(pack2(x[8 * s], x[8 * s + 1]), pack2(x[8 * s + 2], x[8 * s + 3]), pack2(x[8 * s + 4], x[8 * s + 5]),
             pack2(x[8 * s + 6], x[8 * s + 7]));
}
DI bf16x8 load_perm(const u16* rowptr, int s, int h2) {
  uint2 a = *(const uint2*)(rowptr + 16 * s + 4 * h2);
  uint2 b = *(const uint2*)(rowptr + 16 * s + 8 + 4 * h2);
  return mk8(a.x, a.y, b.x, b.y);
}
DI unsigned swap16(unsigned u) { return (u >> 16) | (u << 16); }
DI bf16x8 load_perm_rev(const u16* rowptr, int base, int s, int h2) {
  uint2 a = *(const uint2*)(rowptr + 60 - base - 16 * s - 4 * h2);
  uint2 b = *(const uint2*)(rowptr + 52 - base - 16 * s - 4 * h2);
  return mk8(swap16(a.y), swap16(a.x), swap16(b.y), swap16(b.x));
}
#define MFMA16(a, b, c) __builtin_amdgcn_mfma_f32_16x16x32_bf16((a), (b), (c), 0, 0, 0)
#define MFMA32(a, b, c) __builtin_amdgcn_mfma_f32_32x32x16_bf16((a), (b), (c), 0, 0, 0)

template <int NJ>
DI void gemm_core(f32x4 (&acc)[4][NJ], const u16* __restrict__ A, int lda, const u16* __restrict__ B, int ldb, int K,
                  u16* sm) {
  const int tid = otid(), lane = tid & 63, w = tid >> 6, wr = w >> 1, wc = w & 1;
  const int fr = lane & 15, fq = lane >> 4;
  constexpr int RS = 136;
  const int lrow = tid >> 4, lkc = tid & 15;
  uint4 a0, a1, a2, a3, a4, a5, a6, a7, b0, b1, b2, b3, b4, b5, b6, b7;
  b4 = b5 = b6 = b7 = make_uint4(0, 0, 0, 0);
  const u16* ap = A + (size_t)lrow * lda + lkc * 8;
  const u16* bp = B + (size_t)lrow * ldb + lkc * 8;
  const int nk = K >> 7;
  u16* as = sm;
  u16* bs = sm + 128 * RS;
  {
    const int k0 = 0;
    a0 = *(const uint4*)(ap + (size_t)(0 * 16) * lda + k0);
    a1 = *(const uint4*)(ap + (size_t)(1 * 16) * lda + k0);
    a2 = *(const uint4*)(ap + (size_t)(2 * 16) * lda + k0);
    a3 = *(const uint4*)(ap + (size_t)(3 * 16) * lda + k0);
    a4 = *(const uint4*)(ap + (size_t)(4 * 16) * lda + k0);
    a5 = *(const uint4*)(ap + (size_t)(5 * 16) * lda + k0);
    a6 = *(const uint4*)(ap + (size_t)(6 * 16) * lda + k0);
    a7 = *(const uint4*)(ap + (size_t)(7 * 16) * lda + k0);
    b0 = *(const uint4*)(bp + (size_t)(0 * 16) * ldb + k0);
    b1 = *(const uint4*)(bp + (size_t)(1 * 16) * ldb + k0);
    b2 = *(const uint4*)(bp + (size_t)(2 * 16) * ldb + k0);
    b3 = *(const uint4*)(bp + (size_t)(3 * 16) * ldb + k0);
    if (NJ == 4) b4 = *(const uint4*)(bp + (size_t)(4 * 16) * ldb + k0);
    if (NJ == 4) b5 = *(const uint4*)(bp + (size_t)(5 * 16) * ldb + k0);
    if (NJ == 4) b6 = *(const uint4*)(bp + (size_t)(6 * 16) * ldb + k0);
    if (NJ == 4) b7 = *(const uint4*)(bp + (size_t)(7 * 16) * ldb + k0);
  }
  for (int kt = 0; kt < nk; ++kt) {
    __syncthreads();
    *(uint4*)(as + (lrow + 0 * 16) * RS + lkc * 8) = a0;
    *(uint4*)(as + (lrow + 1 * 16) * RS + lkc * 8) = a1;
    *(uint4*)(as + (lrow + 2 * 16) * RS + lkc * 8) = a2;
    *(uint4*)(as + (lrow + 3 * 16) * RS + lkc * 8) = a3;
    *(uint4*)(as + (lrow + 4 * 16) * RS + lkc * 8) = a4;
    *(uint4*)(as + (lrow + 5 * 16) * RS + lkc * 8) = a5;
    *(uint4*)(as + (lrow + 6 * 16) * RS + lkc * 8) = a6;
    *(uint4*)(as + (lrow + 7 * 16) * RS + lkc * 8) = a7;
    *(uint4*)(bs + (lrow + 0 * 16) * RS + lkc * 8) = b0;
    *(uint4*)(bs + (lrow + 1 * 16) * RS + lkc * 8) = b1;
    *(uint4*)(bs + (lrow + 2 * 16) * RS + lkc * 8) = b2;
    *(uint4*)(bs + (lrow + 3 * 16) * RS + lkc * 8) = b3;
    if (NJ == 4) *(uint4*)(bs + (lrow + 4 * 16) * RS + lkc * 8) = b4;
    if (NJ == 4) *(uint4*)(bs + (lrow + 5 * 16) * RS + lkc * 8) = b5;
    if (NJ == 4) *(uint4*)(bs + (lrow + 6 * 16) * RS + lkc * 8) = b6;
    if (NJ == 4) *(uint4*)(bs + (lrow + 7 * 16) * RS + lkc * 8) = b7;
    __syncthreads();
    {
      const int k0 = (kt + 1 < nk ? kt + 1 : kt) * 128;
    a0 = *(const uint4*)(ap + (size_t)(0 * 16) * lda + k0);
    a1 = *(const uint4*)(ap + (size_t)(1 * 16) * lda + k0);
    a2 = *(const uint4*)(ap + (size_t)(2 * 16) * lda + k0);
    a3 = *(const uint4*)(ap + (size_t)(3 * 16) * lda + k0);
    a4 = *(const uint4*)(ap + (size_t)(4 * 16) * lda + k0);
    a5 = *(const uint4*)(ap + (size_t)(5 * 16) * lda + k0);
    a6 = *(const uint4*)(ap + (size_t)(6 * 16) * lda + k0);
    a7 = *(const uint4*)(ap + (size_t)(7 * 16) * lda + k0);
    b0 = *(const uint4*)(bp + (size_t)(0 * 16) * ldb + k0);
    b1 = *(const uint4*)(bp + (size_t)(1 * 16) * ldb + k0);
    b2 = *(const uint4*)(bp + (size_t)(2 * 16) * ldb + k0);
    b3 = *(const uint4*)(bp + (size_t)(3 * 16) * ldb + k0);
    if (NJ == 4) b4 = *(const uint4*)(bp + (size_t)(4 * 16) * ldb + k0);
    if (NJ == 4) b5 = *(const uint4*)(bp + (size_t)(5 * 16) * ldb + k0);
    if (NJ == 4) b6 = *(const uint4*)(bp + (size_t)(6 * 16) * ldb + k0);
    if (NJ == 4) b7 = *(const uint4*)(bp + (size_t)(7 * 16) * ldb + k0);
    }
#pragma unroll
    for (int ks = 0; ks < 4; ++ks) {
      bf16x8 af[4], bfr[NJ];
#pragma unroll
      for (int i = 0; i < 4; ++i) af[i] = *(const bf16x8*)(as + (wr * 64 + i * 16 + fr) * RS + ks * 32 + fq * 8);
#pragma unroll
      for (int j = 0; j < NJ; ++j) bfr[j] = *(const bf16x8*)(bs + (wc * NJ * 16 + j * 16 + fr) * RS + ks * 32 + fq * 8);
#pragma unroll
      for (int i = 0; i < 4; ++i)
#pragma unroll
        for (int j = 0; j < NJ; ++j) acc[i][j] = MFMA16(af[i], bfr[j], acc[i][j]);
    }
  }
}
template <int NJ>
DI void zero_acc(f32x4 (&acc)[4][NJ]) {
#pragma unroll
  for (int i = 0; i < 4; ++i)
#pragma unroll
    for (int j = 0; j < NJ; ++j) acc[i][j] = f32x4{0.f, 0.f, 0.f, 0.f};
}
#define EPI_LOOP(NJ_)                                                              \
  const int e_lane = otid() & 63, e_w = otid() >> 6;                     \
  const int e_wr = e_w >> 1, e_wc = e_w & 1, e_fr = e_lane & 15, e_fq = e_lane >> 4; \
  _Pragma("unroll") for (int i = 0; i < 4; ++i)                                    \
  _Pragma("unroll") for (int j = 0; j < NJ_; ++j)                                  \
  _Pragma("unroll") for (int r = 0; r < 4; ++r)
#define EROW (e_wr * 64 + i * 16 + e_fq * 4 + r)
#define ECOL(NJ_) (e_wc * NJ_ * 16 + j * 16 + e_fr)

DI int colmap(int kind, int n) {
  if (kind == 0) {
    if (n < 2048) return n;
    if (n < 2560) return 2064 + (n - 2048);
    if (n < 2944) return 2576 + (n - 2560);
    if (n < 3200) return 2960 + (n - 2944);
    int j = n - 3200;
    if (j < 16) return 2048 + j;
    if (j < 48) return 3216 + (j - 16);
    return -1;
  }
  if (kind == 1) return 3248 + n;
  return n;
}
DI void convT_tile(const float* __restrict__ src, int lds, int K, u16* __restrict__ dst, int kind, int kt, int nt,
                   float* sm) {
  const int tid = otid();
  const int c = tid & 63;
  const int sc = colmap(kind, nt * 64 + c);
  __syncthreads();
#pragma unroll 4
  for (int i = 0; i < 16; ++i) {
    int r = (tid >> 6) + i * 4;
    float v = sc >= 0 ? src[(size_t)(kt * 64 + r) * lds + sc] : 0.f;
    sm[r * 65 + c] = v;
  }
  __syncthreads();
  const int n = tid >> 2, kq = tid & 3;
  unsigned pk[8];
#pragma unroll
  for (int j = 0; j < 8; ++j) pk[j] = pack2(sm[(kq * 16 + 2 * j) * 65 + n], sm[(kq * 16 + 2 * j + 1) * 65 + n]);
  u16* d = dst + (size_t)(nt * 64 + n) * K + kt * 64 + kq * 16;
  *(uint4*)d = make_uint4(pk[0], pk[1], pk[2], pk[3]);
  *(uint4*)(d + 8) = make_uint4(pk[4], pk[5], pk[6], pk[7]);
}
constexpr int CJ0 = 16 * 52, CJ1 = CJ0 + 16 * 48, CJ2 = CJ1 + 6 * 12, CJ3 = CJ2 + 4 * 16, CJ4 = CJ3 + 8 * 8,
              CJ5 = CJ4 + 24 * 16, CJ6 = CJ5 + 16 * 16, CJ7 = CJ6 + 16 * 88, CJ8 = CJ7 + 44 * 16;
DI void conv_job(const Params& p, int l, int j, float* sm) {
  u16* wl = (u16*)(p.ws + B_W) + (size_t)l * W_LAYER;
  if (j < CJ0) { convT_tile(p.in[13] + (size_t)l * 1024 * 6320, 6320, 1024, wl + W_IN, 0, j / 52, j % 52, sm); return; }
  if (j < CJ1) { j -= CJ0; convT_tile(p.in[13] + (size_t)l * 1024 * 6320, 6320, 1024, wl + W_G, 1, j / 48, j % 48, sm); return; }
  if (j < CJ2) { j -= CJ1; convT_tile(p.in[29] + (size_t)l * 384 * 768, 768, 384, wl + W_QB, 2, j / 12, j % 12, sm); return; }
  if (j < CJ3) { j -= CJ2; convT_tile(p.in[31] + (size_t)l * 256 * 1024, 1024, 256, wl + W_KVB, 2, j / 16, j % 16, sm); return; }
  if (j < CJ4) { j -= CJ3; convT_tile(p.in[26] + (size_t)l * 512 * 512, 512, 512, wl + W_GLU, 2, j / 8, j % 8, sm); return; }
  if (j < CJ5) { j -= CJ4; convT_tile(p.in[32] + (size_t)l * 1536 * 1024, 1024, 1536, wl + W_BR, 2, j / 16, j % 16, sm); return; }
  if (j < CJ6) { j -= CJ5; convT_tile(p.in[33] + (size_t)l * 1024 * 1024, 1024, 1024, wl + W_OUT, 2, j / 16, j % 16, sm); return; }
  if (j < CJ7) { j -= CJ6; convT_tile(p.in[34] + (size_t)l * 1024 * 5632, 5632, 1024, wl + W_UP, 2, j / 88, j % 88, sm); return; }
  j -= CJ7; convT_tile(p.in[37] + (size_t)l * 2816 * 1024, 1024, 2816, wl + W_DN, 2, j / 16, j % 16, sm);
}
DI void mods_tile(const Params& p, int l, int jg, float* sm) {
  const int tid = otid();
  __syncthreads();
  for (int i = tid; i < 9 * 1024; i += 256) {
    int v = i >> 10, k = i & 1023;
    float cv = v == 0 ? p.in[8][k] : p.in[7][(v - 1) * 1024 + k];
    sm[i] = cv / (1.f + __expf(-cv));
  }
  __syncthreads();
  const int col = jg * 64 + (tid & 63), kq = tid >> 6;
  float acc[9];
#pragma unroll
  for (int v = 0; v < 9; ++v) acc[v] = 0.f;
  const float* wp = p.in[9] + (size_t)l * 1024 * 6144 + col;
#pragma unroll 4
  for (int k = kq * 256; k < kq * 256 + 256; ++k) {
    float wv = wp[(size_t)k * 6144];
#pragma unroll
    for (int v = 0; v < 9; ++v) acc[v] += sm[v * 1024 + k] * wv;
  }
  float* red = sm + 9 * 1024;
#pragma unroll
  for (int v = 0; v < 9; ++v) red[(kq * 9 + v) * 64 + (tid & 63)] = acc[v];
  __syncthreads();
  if (kq == 0) {
    float* mods = (float*)(p.ws + B_MODS);
    float b = p.in[10][l * 6144 + col];
#pragma unroll
    for (int v = 0; v < 9; ++v) {
      float s = red[(0 * 9 + v) * 64 + tid] + red[(1 * 9 + v) * 64 + tid] + red[(2 * 9 + v) * 64 + tid] + red[(3 * 9 + v) * 64 + tid];
      mods[(size_t)(l * 9 + v) * 6144 + col] = s + b;
    }
  }
}
DI void s5pre_tile(const Params& p, int tile) {
  const int id = tile * 256 + otid();
  const int pp = id & 63, g = (id >> 6) & 31, dir = (id >> 11) & 1, l = id >> 12;
  const float lre = p.in[18][((l * 2 + dir) * 32 + g) * 64 + pp];
  const float lim = p.in[19][((l * 2 + dir) * 32 + g) * 64 + pp];
  const float dt = expf(p.in[20][(l * 2 + dir) * 32 + g]);
  float er = expf(lre * dt), sn, cs;
  sincosf(lim * dt, &sn, &cs);
  const float lbr = er * cs, lbi = er * sn;
  float e64 = expf(64.f * lre * dt), s64, c64;
  sincosf(64.f * lim * dt, &s64, &c64);
  float2* lamb = (float2*)(p.ws + B_LAMB);
  float2* lam64 = (float2*)(p.ws + B_LAM64);
  const int li = ((l * 2 + dir) * 32 + g) * 64 + pp;
  lamb[li] = make_float2(lbr, lbi);
  lam64[li] = make_float2(e64 * c64, e64 * s64);
  const float nr = lbr - 1.f, ni = lbi, den = lre * lre + lim * lim;
  const float cr = (nr * lre + ni * lim) / den, ci = (ni * lre - nr * lim) / den;
  u16* bbt = (u16*)(p.ws + B_BBT) + (size_t)((l * 2 + dir) * 32 + g) * 128 * 16;
  const float* bre = p.in[21] + (size_t)((l * 32 + g) * 64 + pp) * 16;
  const float* bim = p.in[22] + (size_t)((l * 32 + g) * 64 + pp) * 16;
#pragma unroll
  for (int c = 0; c < 16; ++c) {
    float br = bre[c], bi = bim[c];
    bbt[pp * 16 + c] = f2bf(cr * br - ci * bi);
    bbt[(64 + pp) * 16 + c] = f2bf(cr * bi + ci * br);
  }
  if (dir == 0) {
    u16* cmt = (u16*)(p.ws + B_CMT) + (size_t)(l * 32 + g) * 16 * 128;
    const float* cre = p.in[23] + (size_t)(l * 32 + g) * 16 * 64;
    const float* cim = p.in[24] + (size_t)(l * 32 + g) * 16 * 64;
#pragma unroll
    for (int c = 0; c < 16; ++c) {
      cmt[c * 128 + pp] = f2bf(cre[c * 64 + pp]);
      cmt[c * 128 + 64 + pp] = f2bf(-cim[c * 64 + pp]);
    }
  }
}

DI void norm_phase(const Params& p, int l, int shift_idx, int scale_idx, const float* gn) {
  const float* x = p.out;
  u16* H = (u16*)(p.ws + B_H);
  const float* mods = (const float*)(p.ws + B_MODS);
  const int lane = otid() & 63, w = otid() >> 6;
  for (int tile = blockIdx.x; tile < T_ / 4; tile += gridDim.x) {
    const int t = tile * 4 + w;
    const float4* xr = (const float4*)(x + (size_t)t * 1024);
    float4 v[4];
    float ss = 0.f;
#pragma unroll
    for (int j = 0; j < 4; ++j) {
      v[j] = xr[lane + 64 * j];
      ss += v[j].x * v[j].x + v[j].y * v[j].y + v[j].z * v[j].z + v[j].w * v[j].w;
    }
    ss = wave_sum(ss);
    const float rstd = rsqrtf(ss * (1.f / 1024.f) + 1e-6f);
    const float* mb = mods + (size_t)(l * 9 + tok_v(t)) * 6144;
#pragma unroll
    for (int j = 0; j < 4; ++j) {
      const int c = (lane + 64 * j) * 4;
      float4 g = *(const float4*)(gn + c);
      float4 sc = *(const float4*)(mb + scale_idx * 1024 + c);
      float4 sh = *(const float4*)(mb + shift_idx * 1024 + c);
      float y0 = v[j].x * rstd * g.x * (1.f + sc.x) + sh.x;
      float y1 = v[j].y * rstd * g.y * (1.f + sc.y) + sh.y;
      float y2 = v[j].z * rstd * g.z * (1.f + sc.z) + sh.z;
      float y3 = v[j].w * rstd * g.w * (1.f + sc.w) + sh.w;
      *(uint2*)(H + (size_t)t * 1024 + c) = make_uint2(pack2(y0, y1), pack2(y2, y3));
    }
  }
}

DI void gemm_in_phase(const Params& p, int l, u16* sm) {
  const u16* H = (const u16*)(p.ws + B_H);
  const u16* Wt = (const u16*)(p.ws + B_W) + (size_t)l * W_LAYER + W_IN;
  for (int tile = blockIdx.x; tile < 192 * 26; tile += gridDim.x) {
    const int mt = tile / 26, nt = tile % 26;
    f32x4 acc[4][4];
    zero_acc<4>(acc);
    gemm_core<4>(acc, H + (size_t)mt * 128 * 1024, 1024, Wt + (size_t)nt * 128 * 1024, 1024, 1024, sm);
    if (nt < 25) {
      u16* dst; int ld, c0;
      if (nt < 12) { dst = (u16*)(p.ws + B_QKV); ld = 1536; c0 = nt * 128; }
      else if (nt < 16) { dst = (u16*)(p.ws + B_Z); ld = 512; c0 = (nt - 12) * 128; }
      else if (nt < 20) { dst = (u16*)(p.ws + B_US5); ld = 512; c0 = (nt - 16) * 128; }
      else if (nt < 23) { dst = (u16*)(p.ws + B_QA); ld = 384; c0 = (nt - 20) * 128; }
      else { dst = (u16*)(p.ws + B_KVA); ld = 256; c0 = (nt - 23) * 128; }
      EPI_LOOP(4) { dst[(size_t)(mt * 128 + EROW) * ld + c0 + ECOL(4)] = f2bf(acc[i][j][r]); }
    } else {
      float* misc = (float*)(p.ws + B_MISC);
      EPI_LOOP(4) {
        int c = ECOL(4);
        if (c < 48) misc[(size_t)(mt * 128 + EROW) * 48 + c] = acc[i][j][r];
      }
    }
  }
}

DI void delta_prep_tile(const Params& p, int l, int chunk, u16* sm) {
  const int tid = otid(), lane = tid & 63, w = tid >> 6;
  const int tb = chunk * 64;
  int pos0, L;
  if (tb < TP_) { pos0 = tb & 255; L = 256; } else { pos0 = (tb - TP_) & 2047; L = 2048; }
  const u16* qkv = (const u16*)(p.ws + B_QKV);
  const float* cw = p.in[14] + (size_t)l * 5 * 1536;
  u16* ksm = sm + w * (64 * 130);
  __syncthreads();
  for (int gi = w; gi < 12; gi += 4) {
    const int ch = gi * 128 + 2 * lane;
    float w0[5], w1[5];
#pragma unroll
    for (int i = 0; i < 5; ++i) { w0[i] = cw[i * 1536 + ch]; w1[i] = cw[i * 1536 + ch + 1]; }
    float a0[5], a1[5];
#pragma unroll
    for (int i = 0; i < 4; ++i) {
      int ps = pos0 - 2 + i;
      unsigned u = (ps >= 0 && ps < L) ? *(const unsigned*)(qkv + (size_t)(tb - 2 + i) * 1536 + ch) : 0u;
      a0[i + 1] = blo(u); a1[i + 1] = bhi(u);
    }
    u16* dst = (u16*)(p.ws + (gi < 4 ? B_QN : (gi < 8 ? B_KN : B_VV)));
    const int hh = gi & 3;
    for (int tt = 0; tt < 64; ++tt) {
#pragma unroll
      for (int i = 0; i < 4; ++i) { a0[i] = a0[i + 1]; a1[i] = a1[i + 1]; }
      {
        int ps = pos0 + tt + 2;
        unsigned u = (ps < L) ? *(const unsigned*)(qkv + (size_t)(tb + tt + 2) * 1536 + ch) : 0u;
        a0[4] = blo(u); a1[4] = bhi(u);
      }
      float y0 = 0.f, y1 = 0.f;
#pragma unroll
      for (int i = 0; i < 5; ++i) { y0 += w0[i] * a0[i]; y1 += w1[i] * a1[i]; }
      y0 = siluf_(y0); y1 = siluf_(y1);
      if (gi < 8) {
        float ss = wave_sum(y0 * y0 + y1 * y1);
        float sc = rsqrtf(ss + 1e-6f);
        if (gi < 4) sc *= 0.08838834764831845f;
        y0 *= sc; y1 *= sc;
      }
      const unsigned pk = pack2(y0, y1);
      *(unsigned*)(dst + (size_t)(tb + tt) * 512 + hh * 128 + 2 * lane) = pk;
      if (gi >= 4 && gi < 8) *(unsigned*)(ksm + tt * 130 + 2 * lane) = pk;
    }
    if (gi >= 4 && gi < 8) {
      u16* kt = (u16*)(p.ws + B_KT) + (size_t)(chunk * 4 + hh) * 128 * 64;
#pragma unroll
      for (int rr = 0; rr < 2; ++rr) {
        const int dk = lane + 64 * rr;
        unsigned pk[32];
#pragma unroll
        for (int t2 = 0; t2 < 32; ++t2) pk[t2] = (unsigned)ksm[(2 * t2) * 130 + dk] | ((unsigned)ksm[(2 * t2 + 1) * 130 + dk] << 16);
#pragma unroll
        for (int q = 0; q < 8; ++q) *(uint4*)(kt + dk * 64 + q * 8) = make_uint4(pk[4 * q], pk[4 * q + 1], pk[4 * q + 2], pk[4 * q + 3]);
      }
    }
  }
  const float* misc = (const float*)(p.ws + B_MISC);
  float* bg = (float*)(p.ws + B_BG);
  for (int i = tid; i < 512; i += 256) {
    const int tt = i >> 3, dh = i & 7;
    const size_t t = tb + tt;
    float bl = misc[t * 48 + dh], alp = misc[t * 48 + 8 + dh];
    float x = alp + p.in[16][l * 8 + dh];
    float sp = x > 20.f ? x : log1pf(__expf(x));
    bg[t * 16 + dh] = sigmoidf_(bl);
    bg[t * 16 + 8 + dh] = -__expf(p.in[15][l * 8 + dh]) * sp;
  }
}

DI size_t kb_off(int t, int head) {
  if (t < TP_) return ((size_t)((t >> 8) * 8 + head) * 256 + (t & 255)) * 96;
  const int s = (t - TP_) >> 11, pos = (t - TP_) & 2047;
  return KB_P + ((size_t)(s * 8 + head) * 2304 + 256 + pos) * 96;
}
DI void mla_prep_tile(const Params& p, int l, int tile) {
  const int lane = otid() & 63, w = otid() >> 6;
  const int t = tile * 4 + w;
  u16* qa = (u16*)(p.ws + B_QA) + (size_t)t * 384;
  u16* kva = (u16*)(p.ws + B_KVA) + (size_t)t * 256;
  const float* misc = (const float*)(p.ws + B_MISC) + (size_t)t * 48;
  {
    unsigned u[3]; float ss = 0.f;
#pragma unroll
    for (int j = 0; j < 3; ++j) { u[j] = *(const unsigned*)(qa + 2 * lane + 128 * j); float a = blo(u[j]), b = bhi(u[j]); ss += a * a + b * b; }
    ss = wave_sum(ss);
    const float rstd = rsqrtf(ss * (1.f / 384.f) + 1e-6f);
    const float* g = p.in[28] + l * 384;
#pragma unroll
    for (int j = 0; j < 3; ++j) {
      int c = 2 * lane + 128 * j;
      *(unsigned*)(qa + c) = pack2(blo(u[j]) * rstd * g[c], bhi(u[j]) * rstd * g[c + 1]);
    }
  }
  {
    unsigned u[2]; float ss = 0.f;
#pragma unroll
    for (int j = 0; j < 2; ++j) { u[j] = *(const unsigned*)(kva + 2 * lane + 128 * j); float a = blo(u[j]), b = bhi(u[j]); ss += a * a + b * b; }
    ss = wave_sum(ss);
    const float rstd = rsqrtf(ss * (1.f / 256.f) + 1e-6f);
    const float* g = p.in[30] + l * 256;
#pragma unroll
    for (int j = 0; j < 2; ++j) {
      int c = 2 * lane + 128 * j;
      float a = blo(u[j]) * rstd * g[c], b = bhi(u[j]) * rstd * g[c + 1];
      *(unsigned*)(kva + c) = pack2(a, b);
      if (t < TP_) {
        float* o = p.out + O_CKV + ((size_t)((t >> 8) * 4 + l) * 256 + (t & 255)) * 256 + c;
        *(float2*)o = make_float2(a, b);
      }
    }
  }
  {
    const int i = lane & 31;
    float kr = misc[16 + i];
    float val;
    if (t < TP_) {
      val = kr;
      if (lane < 32) p.out[O_KR + ((size_t)((t >> 8) * 4 + l) * 256 + (t & 255)) * 32 + i] = kr;
    } else {
      const int pos = (t - TP_) & 2047;
      const float* rp = (const float*)(p.ws + B_ROPE) + (size_t)pos * 32 + (i & 15) * 2;
      const float cs = rp[0], sn = rp[1];
      float other = __shfl_xor(kr, 16);
      val = (i < 16) ? (kr * cs - other * sn) : (kr * cs + other * sn);
    }
    u16* kb = (u16*)(p.ws + B_KB);
    const u16 bv = f2bf(val);
#pragma unroll
    for (int hh = 0; hh < 4; ++hh) {
      int head = hh * 2 + (lane >> 5);
      kb[kb_off(t, head) + 64 + i] = bv;
    }
  }
}
DI void cache_rope_tile(const Params& p, int l, int tile) {
  const int pr = tile * 8 + (otid() >> 5), i = otid() & 31;
  const int s = pr >> 8, pos = pr & 255;
  const float v = p.in[6][((size_t)(s * 4 + l) * 256 + pos) * 32 + i];
  u16* kb = (u16*)(p.ws + B_KB);
  const u16 bv = f2bf(v);
#pragma unroll
  for (int head = 0; head < 8; ++head) kb[KB_P + ((size_t)(s * 8 + head) * 2304 + pos) * 96 + 64 + i] = bv;
}

DI float gelu_tanh(float x) {
  const float k0 = 0.7978845608028654f, k1 = 0.044715f;
  float u = k0 * (x + k1 * x * x * x);
  float e = __expf(2.f * u);
  float th = 1.f - 2.f / (e + 1.f);
  return 0.5f * x * (1.f + th);
}
DI void s5_chunk_tile(const Params& p, int l, int chunk, int gp, int mode, u16* sm) {
  const int tid = otid(), lane = tid & 63, w = tid >> 6;
  const u16* us5 = (const u16*)(p.ws + B_US5);
  constexpr int RS = 136;
  __syncthreads();
  {
    const int gi = w >> 1, half = w & 1, g = gp * 2 + gi;
    const int n = lane & 31, h2 = lane >> 5;
    bf16x8 af[2];
#pragma unroll
    for (int mi = 0; mi < 2; ++mi) af[mi] = *(const bf16x8*)(us5 + (size_t)(chunk * 64 + mi * 32 + n) * 512 + g * 16 + 8 * h2);
#pragma unroll
    for (int dir = 0; dir < 2; ++dir) {
      const u16* bbt = (const u16*)(p.ws + B_BBT) + (size_t)((l * 2 + dir) * 32 + g) * 128 * 16;
#pragma unroll
      for (int nn = 0; nn < 2; ++nn) {
        const int nt = half * 2 + nn;
        bf16x8 bfr = *(const bf16x8*)(bbt + (nt * 32 + n) * 16 + 8 * h2);
#pragma unroll
        for (int mi = 0; mi < 2; ++mi) {
          f32x16 acc;
#pragma unroll
          for (int r = 0; r < 16; ++r) acc[r] = 0.f;
          acc = MFMA32(af[mi], bfr, acc);
          u16* d = sm + (size_t)((gi * 2 + dir) * 64 + mi * 32) * RS + nt * 32 + n;
#pragma unroll
          for (int r = 0; r < 16; ++r) d[crow(r, h2) * RS] = f2bf(acc[r]);
        }
      }
    }
  }
  __syncthreads();
  {
    const int gi = tid >> 7, dir = (tid >> 6) & 1, pp = tid & 63, g = gp * 2 + gi;
    const float2 lb = ((const float2*)(p.ws + B_LAMB))[((l * 2 + dir) * 32 + g) * 64 + pp];
    const size_t hidx = ((size_t)(chunk * 32 + g) * 2 + dir) * 64 + pp;
    float hr = 0.f, hi = 0.f;
    if (mode) { float2 h0 = ((const float2*)(p.ws + B_HIN))[hidx]; hr = h0.x; hi = h0.y; }
    u16* base = sm + (size_t)((gi * 2 + dir) * 64) * RS;
#pragma unroll 8
    for (int st = 0; st < 64; ++st) {
      const int tk = dir ? 63 - st : st;
      float br = bf2f(base[tk * RS + pp]), bi = bf2f(base[tk * RS + 64 + pp]);
      float nr = __builtin_fmaf(lb.x, hr, __builtin_fmaf(-lb.y, hi, br));
      float ni = __builtin_fmaf(lb.x, hi, __builtin_fmaf(lb.y, hr, bi));
      asm volatile("" : "+v"(nr));
      asm volatile("" : "+v"(ni));
      hr = nr; hi = ni;
      if (mode) { base[tk * RS + pp] = f2bf(hr); base[tk * RS + 64 + pp] = f2bf(hi); }
    }
    if (!mode) ((float2*)(p.ws + B_HEND))[hidx] = make_float2(hr, hi);
  }
  if (!mode) return;
  __syncthreads();
  {
    const int gi = w >> 1, g = gp * 2 + gi;
    const int fr = lane & 15, fq = lane >> 4;
    const u16* cmt = (const u16*)(p.ws + B_CMT) + (size_t)(l * 32 + g) * 16 * 128;
    f32x4 acc[2];
    acc[0] = f32x4{0.f, 0.f, 0.f, 0.f}; acc[1] = acc[0];
#pragma unroll
    for (int ks = 0; ks < 8; ++ks) {
      const int dir = ks >> 2, kk = (ks & 3) * 32;
      bf16x8 bfr = *(const bf16x8*)(cmt + fr * 128 + kk + fq * 8);
#pragma unroll
      for (int mm = 0; mm < 2; ++mm) {
        const int mi = (w & 1) * 2 + mm;
        bf16x8 af = *(const bf16x8*)(sm + (size_t)((gi * 2 + dir) * 64 + mi * 16 + fr) * RS + kk + fq * 8);
        acc[mm] = MFMA16(af, bfr, acc[mm]);
      }
    }
    const float dsk = p.in[25][l * 512 + g * 16 + fr];
    u16* y5 = (u16*)(p.ws + B_Y5);
#pragma unroll
    for (int mm = 0; mm < 2; ++mm)
#pragma unroll
      for (int r = 0; r < 4; ++r) {
        const size_t t = (size_t)chunk * 64 + ((w & 1) * 2 + mm) * 16 + fq * 4 + r;
        float u = bf2f(us5[t * 512 + g * 16 + fr]);
        float y = acc[mm][r] + dsk * u;
        y5[t * 512 + g * 16 + fr] = f2bf(gelu_tanh(y));
      }
  }
}
DI void s5_carry_tile(const Params& p, int l, int tile) {
  const int seq = tile >> 4, gp = tile & 15;
  const int tid = otid(), gi = tid >> 7, dir = (tid >> 6) & 1, pp = tid & 63, g = gp * 2 + gi;
  int c0, nc;
  if (seq < 32) { c0 = seq * 4; nc = 4; } else { c0 = 128 + (seq - 32) * 32; nc = 32; }
  const float2 l64 = ((const float2*)(p.ws + B_LAM64))[((l * 2 + dir) * 32 + g) * 64 + pp];
  float hr = 0.f, hi = 0.f;
  if (seq >= 32) {
    const size_t si = ((size_t)((seq - 32) * 4 + l) * 2 + dir) * 2048 + g * 64 + pp;
    hr = p.in[3][si]; hi = p.in[4][si];
  }
  const float2* hend = (const float2*)(p.ws + B_HEND);
  float2* hin = (float2*)(p.ws + B_HIN);
  for (int it = 0; it < nc; ++it) {
    const int ck = c0 + (dir ? nc - 1 - it : it);
    const size_t idx = ((size_t)(ck * 32 + g) * 2 + dir) * 64 + pp;
    hin[idx] = make_float2(hr, hi);
    float2 he = hend[idx];
    float nr = __builtin_fmaf(l64.x, hr, __builtin_fmaf(-l64.y, hi, he.x));
    float ni = __builtin_fmaf(l64.x, hi, __builtin_fmaf(l64.y, hr, he.y));
    asm volatile("" : "+v"(nr));
    asm volatile("" : "+v"(ni));
    hr = nr; hi = ni;
  }
  if (seq < 32) {
    const size_t so = ((size_t)(seq * 4 + l) * 2 + dir) * 2048 + g * 64 + pp;
    p.out[O_S5RE + so] = hr;
    p.out[O_S5IM + so] = hi;
  }
}

DI void delta_local_tile(const Params& p, int tile, float* smf) {
  const int chunk = tile >> 1, dir = tile & 1;
  const int tid = otid(), lane = tid & 63, h = tid >> 6;
  const int m = lane & 31, h2 = lane >> 5;
  const int tb = chunk * 64;
  const float* bg = (const float*)(p.ws + B_BG);
  const u16* kn = (const u16*)(p.ws + B_KN);
  const u16* qn = (const u16*)(p.ws + B_QN);
  float* Aw = smf + h * 4096;
  const size_t cidx = ((size_t)(chunk * 4 + h) * 2 + dir);
  const int tl = tb + (dir ? 63 - lane : lane);
  float gcs = bg[(size_t)tl * 16 + 8 + dir * 4 + h];
  const float beta = bg[(size_t)tl * 16 + dir * 4 + h];
#pragma unroll
  for (int o = 1; o < 64; o <<= 1) {
    float v = __shfl_up(gcs, o);
    if (lane >= o) gcs += v;
  }
  ((float*)(p.ws + B_GC))[cidx * 64 + lane] = gcs;
  ((float*)(p.ws + B_BC))[cidx * 64 + lane] = beta;
  __syncthreads();
  u16* qkm = (u16*)(p.ws + B_QKM) + cidx * 4096;
#pragma unroll 1
  for (int tt = 0; tt < 3; ++tt) {
    const int mi = tt == 0 ? 0 : 1, ni = tt == 2 ? 1 : 0;
    const int cm = 32 * mi + m, cn = 32 * ni + m;
    const u16* krm = kn + (size_t)(tb + (dir ? 63 - cm : cm)) * 512 + h * 128 + h2 * 8;
    const u16* qrm = qn + (size_t)(tb + (dir ? 63 - cm : cm)) * 512 + h * 128 + h2 * 8;
    const u16* krn = kn + (size_t)(tb + (dir ? 63 - cn : cn)) * 512 + h * 128 + h2 * 8;
    f32x16 ak, aq;
#pragma unroll
    for (int r = 0; r < 16; ++r) { ak[r] = 0.f; aq[r] = 0.f; }
#pragma unroll
    for (int ks = 0; ks < 8; ++ks) {
      const bf16x8 fkm = *(const bf16x8*)(krm + ks * 16), fqm = *(const bf16x8*)(qrm + ks * 16), fkn = *(const bf16x8*)(krn + ks * 16);
      ak = MFMA32(fkm, fkn, ak);
      aq = MFMA32(fqm, fkn, aq);
    }
    const int e = 32 * ni + m;
    const float gce = __shfl(gcs, e);
#pragma unroll
    for (int r = 0; r < 16; ++r) {
      const int c = 32 * mi + crow(r, h2);
      const float gcc = __shfl(gcs, c), bc = __shfl(beta, c);
      const float dec = (e <= c) ? __expf(gcc - gce) : 0.f;
      Aw[c * 64 + e] = (e < c) ? ak[r] * bc * dec : 0.f;
      qkm[c * 64 + e] = f2bf(aq[r] * dec);
    }
  }
  __syncthreads();
  u16* tm = (u16*)(p.ws + B_TM) + cidx * 4096;
  float x[64];
#pragma unroll
  for (int i = 0; i < 64; ++i) {
    float a = (i == lane) ? 1.f : 0.f;
#pragma unroll
    for (int j = 0; j < i; ++j) a -= Aw[i * 64 + j] * x[j];
    x[i] = a;
    tm[i * 64 + lane] = f2bf(a);
  }
}

template <int dir>
DI void delta_scan_body(const Params& p, int l, int seq, int h, u16* sm);
DI void delta_scan_tile(const Params& p, int l, int idx, u16* sm) {
  int seq, h, dir;
  if (idx < 64) { seq = 32 + (idx >> 3); h = (idx >> 1) & 3; dir = idx & 1; }
  else { const int i2 = idx - 64; seq = i2 >> 3; h = (i2 >> 1) & 3; dir = i2 & 1; }
  if (dir) delta_scan_body<1>(p, l, seq, h, sm); else delta_scan_body<0>(p, l, seq, h, sm);
}
template <int dir>
DI void delta_scan_body(const Params& p, int l, int seq, int h, u16* sm) {
  int chunk0, nch;
  if (seq < 32) { chunk0 = seq * 4; nch = 4; } else { chunk0 = 128 + (seq - 32) * 32; nch = 32; }
  const int lane = otid() & 63, w = otid() >> 6;
  const int n = lane & 31, h2 = lane >> 5;
  const int dvc = w * 32 + n;
  const u16* kn = (const u16*)(p.ws + B_KN);
  const u16* qn = (const u16*)(p.ws + B_QN);
  const u16* vv = (const u16*)(p.ws + B_VV);
  u16* od = (u16*)(p.ws + (dir ? B_OB : B_OF));
  f32x16 S[4];
  if (seq >= 32) {
    const float* s0 = p.in[2] + ((size_t)(((seq - 32) * 4 + l) * 2 + dir) * 4 + h) * 16384;
#pragma unroll
    for (int t = 0; t < 4; ++t)
#pragma unroll
      for (int r = 0; r < 16; ++r) S[t][r] = s0[(size_t)(32 * t + crow(r, h2)) * 128 + dvc];
  } else {
#pragma unroll
    for (int t = 0; t < 4; ++t)
#pragma unroll
      for (int r = 0; r < 16; ++r) S[t][r] = 0.f;
  }
  for (int it = 0; it < nch; ++it) {
    const int chunk = chunk0 + (dir ? nch - 1 - it : it);
    const int tb = chunk * 64;
    const size_t cidx = ((size_t)(chunk * 4 + h) * 2 + dir);
    const float* gcp = (const float*)(p.ws + B_GC) + cidx * 64;
    const float* bcp = (const float*)(p.ws + B_BC) + cidx * 64;
    const u16* tm = (const u16*)(p.ws + B_TM) + cidx * 4096;
    const u16* qkm = (const u16*)(p.ws + B_QKM) + cidx * 4096;
    const u16* ktp = (const u16*)(p.ws + B_KT) + (size_t)(chunk * 4 + h) * 8192;
    const float glast = gcp[63];
    size_t trow[2];
#pragma unroll
    for (int mi = 0; mi < 2; ++mi) { const int c = 32 * mi + n; trow[mi] = (size_t)(tb + (dir ? 63 - c : c)); }
#define SCHED_FENCE() asm volatile("" ::: "memory")
    u16* Ks = sm; u16* Qs = sm + 8704; u16* Vs = sm + 17408; u16* KTs = sm + 26112;
    u16* vls = Vs + w * 32;
    __syncthreads();
    {
      const int tid_ = otid();
      const int r0 = tid_ >> 4, ck = tid_ & 15;
      uint4 tk[4], tq[4], tv[4], tt[4];
#pragma unroll
      for (int j = 0; j < 4; ++j) {
        const size_t go = (size_t)(tb + r0 + 16 * j) * 512 + h * 128 + ck * 8;
        tk[j] = *(const uint4*)(kn + go); tq[j] = *(const uint4*)(qn + go); tv[j] = *(const uint4*)(vv + go);
        tt[j] = *(const uint4*)(ktp + ((tid_ >> 3) + 32 * j) * 64 + (tid_ & 7) * 8);
      }
#pragma unroll
      for (int j = 0; j < 4; ++j) {
        const int tau = r0 + 16 * j, c = dir ? 63 - tau : tau;
        *(uint4*)(Ks + c * 136 + ck * 8) = tk[j]; *(uint4*)(Qs + c * 136 + ck * 8) = tq[j]; *(uint4*)(Vs + c * 136 + ck * 8) = tv[j];
        *(uint4*)(KTs + ((tid_ >> 3) + 32 * j) * 72 + (tid_ & 7) * 8) = tt[j];
      }
    }
    __syncthreads();
    f32x16 X[2], QS[2];
    {
      bf16x8 Sb[4][2];
#pragma unroll
      for (int t = 0; t < 4; ++t)
#pragma unroll
        for (int s = 0; s < 2; ++s) Sb[t][s] = pack_acc(S[t], s);
#pragma unroll
      for (int mi = 0; mi < 2; ++mi)
#pragma unroll
        for (int r = 0; r < 16; ++r) { X[mi][r] = 0.f; QS[mi][r] = 0.f; }
#pragma unroll
      for (int t = 0; t < 4; ++t) {
#pragma unroll
        for (int mi = 0; mi < 2; ++mi) {
          const u16* krow_ = Ks + (32 * mi + n) * 136;
          const u16* qrow_ = Qs + (32 * mi + n) * 136;
#pragma unroll
          for (int s = 0; s < 2; ++s) {
            X[mi] = MFMA32(load_perm(krow_ + 32 * t, s, h2), Sb[t][s], X[mi]);
            QS[mi] = MFMA32(load_perm(qrow_ + 32 * t, s, h2), Sb[t][s], QS[mi]);
          }
        }
        SCHED_FENCE();
      }
    }
    bf16x8 Rb[2][2];
#pragma unroll
    for (int mi = 0; mi < 2; ++mi) {
#pragma unroll
      for (int a = 0; a < 4; ++a) {
        const int c4 = 32 * mi + 8 * a + 4 * h2;
        const float4 g4 = *(const float4*)(gcp + c4);
        const float4 b4 = *(const float4*)(bcp + c4);
        const float gg[4] = {g4.x, g4.y, g4.z, g4.w};
        const float bb[4] = {b4.x, b4.y, b4.z, b4.w};
#pragma unroll
        for (int q = 0; q < 4; ++q) {
          const int c = c4 + q;
          const float v = bf2f(vls[c * 136 + n]);
          const float eg = __expf(gg[q]);
          X[mi][4 * a + q] = bb[q] * (v - eg * X[mi][4 * a + q]);
          QS[mi][4 * a + q] *= eg;
        }
      }
      Rb[mi][0] = pack_acc(X[mi], 0);
      Rb[mi][1] = pack_acc(X[mi], 1);
    }
    SCHED_FENCE();
    f32x16 Vn[2];
#pragma unroll
    for (int mo = 0; mo < 2; ++mo) {
#pragma unroll
      for (int r = 0; r < 16; ++r) Vn[mo][r] = 0.f;
#pragma unroll
      for (int mi = 0; mi <= mo; ++mi)
#pragma unroll
        for (int s = 0; s < 2; ++s) Vn[mo] = MFMA32(load_perm(tm + (32 * mo + n) * 64 + 32 * mi, s, h2), Rb[mi][s], Vn[mo]);
    }
    SCHED_FENCE();
    {
      bf16x8 Vb[2][2];
#pragma unroll
      for (int mi = 0; mi < 2; ++mi) { Vb[mi][0] = pack_acc(Vn[mi], 0); Vb[mi][1] = pack_acc(Vn[mi], 1); }
#pragma unroll
      for (int mo = 0; mo < 2; ++mo) {
#pragma unroll
        for (int mi = 0; mi <= mo; ++mi)
#pragma unroll
          for (int s = 0; s < 2; ++s) QS[mo] = MFMA32(load_perm(qkm + (32 * mo + n) * 64 + 32 * mi, s, h2), Vb[mi][s], QS[mo]);
      }
      __syncthreads();
#pragma unroll
      for (int mo = 0; mo < 2; ++mo)
#pragma unroll
        for (int r = 0; r < 16; ++r) vls[(32 * mo + crow(r, h2)) * 136 + n] = f2bf(QS[mo][r]);
      __syncthreads();
#pragma unroll
      for (int jv = 0; jv < 4; ++jv) {
        const int tau = (lane >> 2) + 16 * jv, cq = lane & 3;
        const uint4 oq = *(const uint4*)(vls + (dir ? 63 - tau : tau) * 136 + cq * 8);
        *(uint4*)(od + (size_t)(tb + tau) * 512 + h * 128 + w * 32 + cq * 8) = oq;
      }
    }
    SCHED_FENCE();
    bf16x8 Vsb[2][2];
#pragma unroll
    for (int mi = 0; mi < 2; ++mi) {
#pragma unroll
      for (int a = 0; a < 4; ++a) {
        const float4 g4 = *(const float4*)(gcp + 32 * mi + 8 * a + 4 * h2);
        Vn[mi][4 * a + 0] *= __expf(glast - g4.x); Vn[mi][4 * a + 1] *= __expf(glast - g4.y);
        Vn[mi][4 * a + 2] *= __expf(glast - g4.z); Vn[mi][4 * a + 3] *= __expf(glast - g4.w);
      }
      Vsb[mi][0] = pack_acc(Vn[mi], 0); Vsb[mi][1] = pack_acc(Vn[mi], 1);
    }
    const float eg = __expf(glast);
#pragma unroll
    for (int t = 0; t < 4; ++t) {
#pragma unroll
      for (int r = 0; r < 16; ++r) S[t][r] *= eg;
      const u16* ktrow = KTs + (32 * t + n) * 72;
#pragma unroll
      for (int mi = 0; mi < 2; ++mi)
#pragma unroll
        for (int s = 0; s < 2; ++s) {
          bf16x8 a = dir ? load_perm_rev(ktrow, 32 * mi, s, h2) : load_perm(ktrow + 32 * mi, s, h2);
          S[t] = MFMA32(a, Vsb[mi][s], S[t]);
        }
      SCHED_FENCE();
    }
  }
  if (seq < 32) {
    float* so = p.out + O_SD + ((size_t)((seq * 4 + l) * 2 + dir) * 4 + h) * 16384;
#pragma unroll
    for (int t = 0; t < 4; ++t)
#pragma unroll
      for (int r = 0; r < 16; ++r) so[(size_t)(32 * t + crow(r, h2)) * 128 + dvc] = S[t][r];
  }
}

DI void attn_tile(const Params& p, int seq, int head, int qb, u16* sm) {
  const int lane = otid() & 63, w = otid() >> 6;
  const int n = lane & 31, h2 = lane >> 5;
  int tq0, nkeys; size_t kbo, vto;
  if (seq < 32) { tq0 = seq * 256 + qb * 128 + w * 32; nkeys = 256; kbo = (size_t)(seq * 8 + head) * 256 * 96; vto = (size_t)(seq * 8 + head) * 64 * 256; }
  else { const int s = seq - 32; tq0 = TP_ + s * 2048 + qb * 128 + w * 32; nkeys = 2304; kbo = KB_P + (size_t)(s * 8 + head) * 2304 * 96; vto = VT_P + (size_t)(s * 8 + head) * 64 * 2304; }
  const u16* kb = (const u16*)(p.ws + B_KB) + kbo;
  const u16* vt = (const u16*)(p.ws + B_VT) + vto;
  const u16* qm = (const u16*)(p.ws + B_QM) + (size_t)(tq0 + n) * 768 + head * 96;
  bf16x8 qf[6];
#pragma unroll
  for (int ks = 0; ks < 6; ++ks) qf[ks] = *(const bf16x8*)(qm + ks * 16 + h2 * 8);
  f32x16 O[2];
#pragma unroll
  for (int r = 0; r < 16; ++r) { O[0][r] = 0.f; O[1][r] = 0.f; }
  float mrun = -1e30f, lsum = 0.f;
  const int nkt = nkeys >> 6;
  constexpr int KST = 104, VST = 72, STG = 64 * KST + 64 * VST;
  const int tid_ = otid();
  uint4 rk0, rk1, rk2, rv0, rv1;
  const int kc0 = tid_, kc1 = tid_ + 256, kc2 = tid_ + 512;
  const u16* kg0 = kb + (size_t)(kc0 / 12) * 96 + (kc0 % 12) * 8;
  const u16* kg1 = kb + (size_t)(kc1 / 12) * 96 + (kc1 % 12) * 8;
  const u16* kg2 = kb + (size_t)(kc2 / 12) * 96 + (kc2 % 12) * 8;
  const u16* vg0 = vt + (size_t)(tid_ >> 3) * nkeys + (tid_ & 7) * 8;
  const u16* vg1 = vt + (size_t)((tid_ + 256) >> 3) * nkeys + (tid_ & 7) * 8;
  const int kl0 = (kc0 / 12) * KST + (kc0 % 12) * 8, kl1 = (kc1 / 12) * KST + (kc1 % 12) * 8, kl2 = (kc2 / 12) * KST + (kc2 % 12) * 8;
  const int vl0 = (tid_ >> 3) * VST + (tid_ & 7) * 8, vl1 = ((tid_ + 256) >> 3) * VST + (tid_ & 7) * 8;
#define AT_GLOAD(kt_) do { rk0 = *(const uint4*)(kg0 + (size_t)(kt_) * 6144); rk1 = *(const uint4*)(kg1 + (size_t)(kt_) * 6144); \
    rk2 = *(const uint4*)(kg2 + (size_t)(kt_) * 6144); rv0 = *(const uint4*)(vg0 + (kt_) * 64); rv1 = *(const uint4*)(vg1 + (kt_) * 64); } while (0)
#define AT_SSTORE(st_) do { u16* ks2_ = sm + (st_) * STG; u16* vs2_ = ks2_ + 64 * KST; \
    *(uint4*)(ks2_ + kl0) = rk0; *(uint4*)(ks2_ + kl1) = rk1; *(uint4*)(ks2_ + kl2) = rk2; *(uint4*)(vs2_ + vl0) = rv0; *(uint4*)(vs2_ + vl1) = rv1; } while (0)
  __syncthreads();
  AT_GLOAD(0); AT_SSTORE(0);
  __syncthreads();
  for (int kt = 0; kt < nkt; ++kt) {
    const bool more = kt + 1 < nkt;
    if (more) AT_GLOAD(kt + 1);
    const u16* ks_ = sm + (kt & 1) * STG;
    const u16* vs_ = ks_ + 64 * KST;
    f32x16 St[2];
#pragma unroll
    for (int sub = 0; sub < 2; ++sub) {
#pragma unroll
      for (int r = 0; r < 16; ++r) St[sub][r] = 0.f;
      const u16* kr = ks_ + (sub * 32 + n) * KST + h2 * 8;
#pragma unroll
      for (int ks = 0; ks < 6; ++ks) St[sub] = MFMA32(*(const bf16x8*)(kr + ks * 16), qf[ks], St[sub]);
    }
    float mx = St[0][0];
#pragma unroll
    for (int r = 0; r < 16; ++r) { mx = fmaxf(mx, St[0][r]); mx = fmaxf(mx, St[1][r]); }
    mx = fmaxf(mx, __shfl_xor(mx, 32));
    const float mnew = fmaxf(mrun, mx);
    const float alpha = exp2f(mrun - mnew);
    mrun = mnew;
    float ps = 0.f;
#pragma unroll
    for (int sub = 0; sub < 2; ++sub)
#pragma unroll
      for (int r = 0; r < 16; ++r) { float e = exp2f(St[sub][r] - mnew); St[sub][r] = e; ps += e; }
    lsum = lsum * alpha + ps;
#pragma unroll
    for (int r = 0; r < 16; ++r) { O[0][r] *= alpha; O[1][r] *= alpha; }
#pragma unroll
    for (int sub = 0; sub < 2; ++sub)
#pragma unroll
      for (int s = 0; s < 2; ++s) {
        const bf16x8 pb = pack_acc(St[sub], s);
#pragma unroll
        for (int dt = 0; dt < 2; ++dt)
          O[dt] = MFMA32(load_perm(vs_ + (dt * 32 + n) * VST + sub * 32, s, h2), pb, O[dt]);
      }
    if (more) AT_SSTORE((kt + 1) & 1);
    __syncthreads();
  }
  lsum += __shfl_xor(lsum, 32);
  const float inv = 1.f / lsum;
  u16* oc = (u16*)(p.ws + B_OC) + (size_t)(tq0 + n) * 512 + head * 64;
#pragma unroll
  for (int dt = 0; dt < 2; ++dt)
#pragma unroll
    for (int a = 0; a < 4; ++a) {
      const int dv = dt * 32 + 8 * a + 4 * h2;
      *(uint2*)(oc + dv) = make_uint2(pack2(O[dt][4 * a] * inv, O[dt][4 * a + 1] * inv), pack2(O[dt][4 * a + 2] * inv, O[dt][4 * a + 3] * inv));
    }
}

DI void delta_out_tile(const Params& p, int l, int tile) {
  const int lane = otid() & 63, w = otid() >> 6;
  const u16* of = (const u16*)(p.ws + B_OF);
  const u16* ob = (const u16*)(p.ws + B_OB);
  const u16* z = (const u16*)(p.ws + B_Z);
  u16* oa = (u16*)(p.ws + B_OA);
  const float g0 = p.in[17][l * 128 + 2 * lane], g1 = p.in[17][l * 128 + 2 * lane + 1];
#pragma unroll 1
  for (int q = 0; q < 16; ++q) {
    const size_t t = (size_t)tile * 16 + w * 4 + (q >> 2);
    const int hh = q & 3;
    const size_t off = t * 512 + hh * 128 + 2 * lane;
    unsigned a = *(const unsigned*)(of + off), b = *(const unsigned*)(ob + off), zz = *(const unsigned*)(z + off);
    float o0 = blo(a) + blo(b), o1 = bhi(a) + bhi(b);
    float ss = wave_sum(o0 * o0 + o1 * o1);
    float rstd = rsqrtf(ss * (1.f / 128.f) + 1e-6f);
    float y0 = o0 * rstd * g0 * siluf_(blo(zz)), y1 = o1 * rstd * g1 * siluf_(bhi(zz));
    *(unsigned*)(oa + off) = pack2(y0, y1);
  }
}

DI void grid_barrier(unsigned* bar, unsigned target) {
  asm volatile("s_waitcnt vmcnt(0) lgkmcnt(0)" ::: "memory");
  __syncthreads();
  if (otid() == 0) {
    __builtin_amdgcn_fence(__ATOMIC_RELEASE, "agent");
    asm volatile("s_waitcnt vmcnt(0)" ::: "memory");
    __hip_atomic_fetch_add(bar, 1u, __ATOMIC_RELAXED, __HIP_MEMORY_SCOPE_AGENT);
    while (__hip_atomic_load(bar, __ATOMIC_RELAXED, __HIP_MEMORY_SCOPE_AGENT) < target) __builtin_amdgcn_s_sleep(1);
    __builtin_amdgcn_fence(__ATOMIC_ACQUIRE, "agent");
    asm volatile("s_waitcnt vmcnt(0)" ::: "memory");
  }
  __syncthreads();
}
#define GSYNC() do { bar_target += gridDim.x; grid_barrier(p.bar, bar_target); } while (0)
#ifndef ONLY
#define PH(n) 1
#else
#define PH(n) ((n) == ONLY || (n) / 100 == ONLY || (n) == ONLY / 100)
#endif
__global__ void __launch_bounds__(256, 2) mega(Params p) {
  cg::grid_group grid = cg::this_grid();
  __shared__ __attribute__((aligned(16))) char smem_raw[73728];
  u16* sm = (u16*)smem_raw;
  float* smf = (float*)smem_raw;
  const int nb = gridDim.x, bid = blockIdx.x;
  unsigned bar_target = 0;
  grid.sync();

  if (PH(0)) {
    const int tid = otid();
    for (int j = bid; j < 4 * CJ8; j += nb) conv_job(p, j / CJ8, j % CJ8, smf);
    for (int j = bid; j < 4 * 96; j += nb) mods_tile(p, j / 96, j % 96, smf);
    for (int j = bid; j < 64; j += nb) s5pre_tile(p, j);
    {
      const float4* xp = (const float4*)p.in[0];
      const float4* xs = (const float4*)p.in[1];
      float4* o = (float4*)p.out;
      const size_t nP = (size_t)TP_ * 256, nT = (size_t)T_ * 256;
      for (size_t i = (size_t)bid * 256 + tid; i < nT; i += (size_t)nb * 256) o[i] = i < nP ? xp[i] : xs[i - nP];
    }
    {
      float* rope = (float*)(p.ws + B_ROPE);
      for (int i = bid * 256 + tid; i < 2048 * 16; i += nb * 256) {
        const int pos = i >> 4, f = i & 15;
        const float invf = 1.f / powf(10000.f, (float)(f & 7) * 0.125f);
        const float ang = (f < 8 ? (float)(pos >> 6) : (float)(pos & 63)) * invf;
        float sn, cs;
        sincosf(ang, &sn, &cs);
        rope[i * 2] = cs; rope[i * 2 + 1] = sn;
      }
    }
    {
      u16* cc = (u16*)(p.ws + B_CKVC);
      for (int i = bid * 256 + tid; i < 8 * 4 * 256 * 256 / 2; i += nb * 256) {
        const int e = i * 2;
        const int c = e & 255, pos = (e >> 8) & 255, l = (e >> 16) & 3, b = e >> 18;
        float2 v = *(const float2*)(p.in[5] + e);
        *(unsigned*)(cc + ((size_t)(l * 2048 + b * 256 + pos)) * 256 + c) = pack2(v.x, v.y);
      }
    }
  }
  GSYNC();

  for (int l = 0; l < 4; ++l) {
    const u16* WL = (const u16*)(p.ws + B_W) + (size_t)l * W_LAYER;
    const float* mods = (const float*)(p.ws + B_MODS);
    if (PH(1)) norm_phase(p, l, 0, 1, p.in[11] + l * 1024);
    GSYNC();
    if (PH(2)) gemm_in_phase(p, l, sm);
    GSYNC();
    if (PH(3)) {
      for (int j = bid; j < NCH; j += nb) delta_prep_tile(p, l, j, sm);
      for (int j = bid; j < T_ / 4; j += nb) mla_prep_tile(p, l, j);
      for (int j = bid; j < 256; j += nb) cache_rope_tile(p, l, j);
      for (int j = bid; j < NCH * 16; j += nb) s5_chunk_tile(p, l, j >> 4, j & 15, 0, sm);
    }
    GSYNC();
    if (PH(4)) {
      const int tid = otid();
      if (PH(400)) for (int j = bid; j < NCH * 2; j += nb) delta_local_tile(p, j, smf);
      if (PH(410)) for (int j = bid; j < 192 * 6; j += nb) {
          const int q = j, mt = q / 6, nt = q % 6;
          f32x4 acc[4][4];
          zero_acc<4>(acc);
          gemm_core<4>(acc, (const u16*)(p.ws + B_QA) + (size_t)mt * 128 * 384, 384, WL + W_QB + (size_t)nt * 128 * 384, 384, 384, sm);
          u16* qm = (u16*)(p.ws + B_QM);
          const float qs = 0.10206207261596575f * 1.4426950408889634f;
          const float* rope = (const float*)(p.ws + B_ROPE);
          const int e_lane = tid & 63, e_w = tid >> 6, e_wr = e_w >> 1, e_wc = e_w & 1, e_fr = e_lane & 15, e_fq = e_lane >> 4;
          const bool is_s = (mt * 128 >= TP_);
#pragma unroll
          for (int i = 0; i < 4; ++i)
#pragma unroll
            for (int r = 0; r < 4; ++r) {
              const int row = mt * 128 + e_wr * 64 + i * 16 + e_fq * 4 + r;
              float vals[4];
#pragma unroll
              for (int jj = 0; jj < 4; ++jj) vals[jj] = acc[i][jj][r];
              if (is_s) {
                const int pos = (row - TP_) & 2047;
                const float cs = rope[(pos * 16 + e_fr) * 2], sn = rope[(pos * 16 + e_fr) * 2 + 1];
#pragma unroll
                for (int jj = 0; jj < 4; jj += 2) {
                  const int gt = (nt * 128 + e_wc * 64) / 16 + jj;
                  if (gt % 6 == 4) {
                    const float x1 = vals[jj], x2 = vals[jj + 1];
                    vals[jj] = x1 * cs - x2 * sn;
                    vals[jj + 1] = x2 * cs + x1 * sn;
                  }
                }
              }
#pragma unroll
              for (int jj = 0; jj < 4; ++jj) qm[(size_t)row * 768 + nt * 128 + e_wc * 64 + jj * 16 + e_fr] = f2bf(vals[jj] * qs);
            }
      }
      if (PH(420)) for (int j = bid; j < 208 * 8; j += nb) {
          const int q = j, mt = q >> 3, head = q & 7;
          f32x4 acc[4][4];
          zero_acc<4>(acc);
          const u16* A = mt < 192 ? (const u16*)(p.ws + B_KVA) + (size_t)mt * 128 * 256
                                  : (const u16*)(p.ws + B_CKVC) + ((size_t)l * 2048 + (size_t)(mt - 192) * 128) * 256;
          gemm_core<4>(acc, A, 256, WL + W_KVB + (size_t)head * 128 * 256, 256, 256, sm);
          int key0, nkeys; size_t kbo, vto;
          if (mt < 64) { const int seq = mt >> 1; key0 = (mt & 1) * 128; nkeys = 256; kbo = (size_t)(seq * 8 + head) * 256 * 96; vto = (size_t)(seq * 8 + head) * 64 * 256; }
          else if (mt < 192) { const int s = (mt - 64) >> 4; key0 = 256 + ((mt - 64) & 15) * 128; nkeys = 2304; kbo = KB_P + (size_t)(s * 8 + head) * 2304 * 96; vto = VT_P + (size_t)(s * 8 + head) * 64 * 2304; }
          else { const int s = (mt - 192) >> 1; key0 = ((mt - 192) & 1) * 128; nkeys = 2304; kbo = KB_P + (size_t)(s * 8 + head) * 2304 * 96; vto = VT_P + (size_t)(s * 8 + head) * 64 * 2304; }
          u16* kb = (u16*)(p.ws + B_KB) + kbo;
          u16* vt = (u16*)(p.ws + B_VT) + vto;
          const int e_lane = tid & 63, e_w = tid >> 6, e_wr = e_w >> 1, e_wc = e_w & 1, e_fr = e_lane & 15, e_fq = e_lane >> 4;
#pragma unroll
          for (int i = 0; i < 4; ++i)
#pragma unroll
            for (int jj = 0; jj < 4; ++jj) {
              const int key = key0 + e_wr * 64 + i * 16 + e_fq * 4;
              const int c = jj * 16 + e_fr;
              if (e_wc == 0) {
#pragma unroll
                for (int r = 0; r < 4; ++r) kb[(size_t)(key + r) * 96 + c] = f2bf(acc[i][jj][r]);
              } else {
                *(uint2*)(vt + (size_t)c * nkeys + key) = make_uint2(pack2(acc[i][jj][0], acc[i][jj][1]), pack2(acc[i][jj][2], acc[i][jj][3]));
              }
            }
      }
      if (PH(430)) for (int j = bid; j < 640; j += nb) s5_carry_tile(p, l, j);
    }
    GSYNC();
    if (PH(5)) {
      if (PH(500)) for (int j = bid; j < 320; j += nb) delta_scan_tile(p, l, j, sm);
      if (PH(510)) for (int j = bid; j < 1536; j += nb) {
        if (j < 1024) attn_tile(p, 32 + (j >> 7), (j >> 4) & 7, j & 15, sm);
        else { const int q = j - 1024; attn_tile(p, q >> 4, (q >> 1) & 7, q & 1, sm); }
      }
      if (PH(530)) for (int j = bid; j < NCH * 8; j += nb) {
        s5_chunk_tile(p, l, j >> 3, (j & 7) * 2, 1, sm);
        s5_chunk_tile(p, l, j >> 3, (j & 7) * 2 + 1, 1, sm);
      }
    }
    GSYNC();
    if (PH(6)) {
      for (int j = bid; j < T_ / 16; j += nb) delta_out_tile(p, l, j);
      for (int j = bid; j < 192 * 4; j += nb) {
        {
          const int q = j, mt = q >> 2, nt = q & 3;
          f32x4 acc[4][4];
          zero_acc<4>(acc);
          const u16* y5 = (const u16*)(p.ws + B_Y5);
          gemm_core<4>(acc, y5 + (size_t)mt * 128 * 512, 512, WL + W_GLU + (size_t)nt * 128 * 512, 512, 512, sm);
          u16* ob5 = (u16*)(p.ws + B_OB5);
          const float* bgl = p.in[27] + l * 512;
          EPI_LOOP(4) {
            const size_t row = mt * 128 + EROW; const int col = nt * 128 + ECOL(4);
            const float y = bf2f(y5[row * 512 + col]);
            ob5[row * 512 + col] = f2bf(y * sigmoidf_(acc[i][j][r] + bgl[col]));
          }
        }
      }
    }
    GSYNC();
    if (PH(7)) {
      const u16* H = (const u16*)(p.ws + B_H);
      u16* mg = (u16*)(p.ws + B_MG);
      for (int j = bid; j < 192 * 16; j += nb) {
        const int mt = j >> 4, nt = j & 15;
        f32x4 mer[4][2];
        zero_acc<2>(mer);
#pragma unroll 1
        for (int n = 0; n < 3; ++n) {
          f32x4 ag[4][2], ab[4][2];
          zero_acc<2>(ag);
          gemm_core<2>(ag, H + (size_t)mt * 128 * 1024, 1024, WL + W_G + (size_t)(n * 1024 + nt * 64) * 1024, 1024, 1024, sm);
          zero_acc<2>(ab);
          const u16* on = (const u16*)(p.ws + (n == 0 ? B_OA : (n == 1 ? B_OB5 : B_OC)));
          gemm_core<2>(ab, on + (size_t)mt * 128 * 512, 512, WL + W_BR + (size_t)(nt * 64) * 1536 + n * 512, 1536, 512, sm);
#pragma unroll
          for (int i = 0; i < 4; ++i)
#pragma unroll
            for (int jj = 0; jj < 2; ++jj)
#pragma unroll
              for (int r = 0; r < 4; ++r) mer[i][jj][r] += sigmoidf_(ag[i][jj][r]) * ab[i][jj][r];
        }
        EPI_LOOP(2) { mg[(size_t)(mt * 128 + EROW) * 1024 + nt * 64 + ECOL(2)] = f2bf(mer[i][j][r]); }
      }
    }
    GSYNC();
    if (PH(8)) {
      const u16* mg = (const u16*)(p.ws + B_MG);
      for (int j = bid; j < 192 * 8; j += nb) {
        const int mt = j >> 3, nt = j & 7;
        f32x4 acc[4][4];
        zero_acc<4>(acc);
        gemm_core<4>(acc, mg + (size_t)mt * 128 * 1024, 1024, WL + W_OUT + (size_t)nt * 128 * 1024, 1024, 1024, sm);
        const float* gm = mods + (size_t)(l * 9 + tok_v(mt * 128)) * 6144 + 2 * 1024;
        EPI_LOOP(4) {
          const size_t row = mt * 128 + EROW; const int col = nt * 128 + ECOL(4);
          p.out[row * 1024 + col] += gm[col] * acc[i][j][r];
        }
      }
    }
    GSYNC();
    if (PH(9)) norm_phase(p, l, 3, 4, p.in[12] + l * 1024);
    GSYNC();
    if (PH(10)) {
      const u16* H = (const u16*)(p.ws + B_H);
      u16* up = (u16*)(p.ws + B_UP);
      for (int j = bid; j < 192 * 44; j += nb) {
        const int mt = j / 44, nt = j % 44;
        f32x4 acc[4][4];
        zero_acc<4>(acc);
        gemm_core<4>(acc, H + (size_t)mt * 128 * 1024, 1024, WL + W_UP + (size_t)nt * 128 * 1024, 1024, 1024, sm);
        EPI_LOOP(4) { up[(size_t)(mt * 128 + EROW) * 5632 + nt * 128 + ECOL(4)] = f2bf(acc[i][j][r]); }
      }
    }
    GSYNC();
    if (PH(11)) {
      const int tid = otid();
      const u16* up = (const u16*)(p.ws + B_UP);
      u16* act = (u16*)(p.ws + B_ACT);
      const float* cw = p.in[35] + (size_t)l * 3 * 5632;
      const float* cb = p.in[36] + (size_t)l * 5632;
      for (int it = bid * 256 + tid; it < (T_ / 2) * 352; it += nb * 256) {
        const int t = (it / 352) * 2, c8 = (it % 352) * 8;
        int pos, L;
        if (t < TP_) { pos = t & 255; L = 256; } else { pos = (t - TP_) & 2047; L = 2048; }
        float wg[3][8], wv[3][8], bgv[8], bvv[8];
#pragma unroll
        for (int d = 0; d < 3; ++d) {
          const float4 g0 = *(const float4*)(cw + d * 5632 + c8), g1 = *(const float4*)(cw + d * 5632 + c8 + 4);
          const float4 v0 = *(const float4*)(cw + d * 5632 + 2816 + c8), v1 = *(const float4*)(cw + d * 5632 + 2816 + c8 + 4);
          wg[d][0] = g0.x; wg[d][1] = g0.y; wg[d][2] = g0.z; wg[d][3] = g0.w; wg[d][4] = g1.x; wg[d][5] = g1.y; wg[d][6] = g1.z; wg[d][7] = g1.w;
          wv[d][0] = v0.x; wv[d][1] = v0.y; wv[d][2] = v0.z; wv[d][3] = v0.w; wv[d][4] = v1.x; wv[d][5] = v1.y; wv[d][6] = v1.z; wv[d][7] = v1.w;
        }
        {
          const float4 g0 = *(const float4*)(cb + c8), g1 = *(const float4*)(cb + c8 + 4);
          const float4 v0 = *(const float4*)(cb + 2816 + c8), v1 = *(const float4*)(cb + 2816 + c8 + 4);
          bgv[0] = g0.x; bgv[1] = g0.y; bgv[2] = g0.z; bgv[3] = g0.w; bgv[4] = g1.x; bgv[5] = g1.y; bgv[6] = g1.z; bgv[7] = g1.w;
          bvv[0] = v0.x; bvv[1] = v0.y; bvv[2] = v0.z; bvv[3] = v0.w; bvv[4] = v1.x; bvv[5] = v1.y; bvv[6] = v1.z; bvv[7] = v1.w;
        }
        float rg[4][8], rv[4][8];
#pragma unroll
        for (int q = 0; q < 4; ++q) {
          const int ps = pos + q - 1;
          uint4 ug = make_uint4(0, 0, 0, 0), uv = ug;
          if (ps >= 0 && ps < L) {
            const u16* rowp = up + (size_t)(t + q - 1) * 5632;
            ug = *(const uint4*)(rowp + c8); uv = *(const uint4*)(rowp + 2816 + c8);
          }
          rg[q][0] = blo(ug.x); rg[q][1] = bhi(ug.x); rg[q][2] = blo(ug.y); rg[q][3] = bhi(ug.y); rg[q][4] = blo(ug.z); rg[q][5] = bhi(ug.z); rg[q][6] = blo(ug.w); rg[q][7] = bhi(ug.w);
          rv[q][0] = blo(uv.x); rv[q][1] = bhi(uv.x); rv[q][2] = blo(uv.y); rv[q][3] = bhi(uv.y); rv[q][4] = blo(uv.z); rv[q][5] = bhi(uv.z); rv[q][6] = blo(uv.w); rv[q][7] = bhi(uv.w);
        }
#pragma unroll
        for (int o = 0; o < 2; ++o) {
          float res[8];
#pragma unroll
          for (int e = 0; e < 8; ++e) {
            float g = bgv[e], v = bvv[e];
#pragma unroll
            for (int d = 0; d < 3; ++d) { g += wg[d][e] * rg[o + d][e]; v += wv[d][e] * rv[o + d][e]; }
            res[e] = siluf_(g) * v;
          }
          *(uint4*)(act + (size_t)(t + o) * 2816 + c8) = make_uint4(pack2(res[0], res[1]), pack2(res[2], res[3]), pack2(res[4], res[5]), pack2(res[6], res[7]));
        }
      }
    }
    GSYNC();
    if (PH(12)) {
      const u16* act = (const u16*)(p.ws + B_ACT);
      for (int j = bid; j < 192 * 8; j += nb) {
        const int mt = j >> 3, nt = j & 7;
        f32x4 acc[4][4];
        zero_acc<4>(acc);
        gemm_core<4>(acc, act + (size_t)mt * 128 * 2816, 2816, WL + W_DN + (size_t)nt * 128 * 2816, 2816, 2816, sm);
        const float* gf = mods + (size_t)(l * 9 + tok_v(mt * 128)) * 6144 + 5 * 1024;
        EPI_LOOP(4) {
          const size_t row = mt * 128 + EROW; const int col = nt * 128 + ECOL(4);
          p.out[row * 1024 + col] += gf[col] * acc[i][j][r];
        }
      }
    }
    GSYNC();
  }
  if (PH(13)) {
    const int tid = otid();
    const int lane = tid & 63, w = tid >> 6;
    const float* gfin = p.in[38];
    for (int tile = bid; tile < T_ / 4; tile += nb) {
      const int t = tile * 4 + w;
      float4* xr = (float4*)(p.out + (size_t)t * 1024);
      float4 v[4];
      float ss = 0.f;
#pragma unroll
      for (int j = 0; j < 4; ++j) { v[j] = xr[lane + 64 * j]; ss += v[j].x * v[j].x + v[j].y * v[j].y + v[j].z * v[j].z + v[j].w * v[j].w; }
      ss = wave_sum(ss);
      const float rstd = rsqrtf(ss * (1.f / 1024.f) + 1e-6f);
#pragma unroll
      for (int j = 0; j < 4; ++j) {
        float4 g = *(const float4*)(gfin + (lane + 64 * j) * 4);
        xr[lane + 64 * j] = make_float4(v[j].x * rstd * g.x, v[j].y * rstd * g.y, v[j].z * rstd * g.z, v[j].w * rstd * g.w);
      }
    }
  }
}

extern "C" void kernel_launch(void* const* d_in, const int* in_sizes, int n_in, void* d_out, int out_size,
                              void* d_ws, size_t ws_size, hipStream_t stream) {
  static int grid_blocks = 0;
  if (!grid_blocks) {
    int dev = 0, cus = 0, per_cu = 0;
    (void)hipGetDevice(&dev);
    (void)hipDeviceGetAttribute(&cus, hipDeviceAttributeMultiprocessorCount, dev);
    (void)hipOccupancyMaxActiveBlocksPerMultiprocessor(&per_cu, mega, 256, 0);
    if (per_cu > 2) per_cu = 2;
    if (per_cu < 1) per_cu = 1;
    grid_blocks = cus * per_cu;
  }
  if (ws_size < B_TOTAL || n_in < 39) {
    fprintf(stderr, "workspace too small: %zu < %zu\n", ws_size, (size_t)B_END);
    return;
  }
  Params p{};
  for (int i = 0; i < 39; ++i) p.in[i] = (const float*)d_in[i];
  p.out = (float*)d_out;
  p.ws = (char*)d_ws;
  p.bar = (unsigned*)((char*)d_ws + B_BAR);
  (void)hipMemsetAsync(p.bar, 0, 256, stream);
  void* args[] = {&p};
  hipError_t e = hipLaunchCooperativeKernel((void*)mega, dim3(grid_blocks), dim3(256), args, 0, stream);
  if (e != hipSuccess) fprintf(stderr, "cooperative launch failed: %s (grid %d)\n", hipGetErrorString(e), grid_blocks);
}
```

```cpp
#include <hip/hip_runtime.h>
#include <hip/hip_cooperative_groups.h>
#include <cstdio>
namespace cg = cooperative_groups;

#define DI __device__ __forceinline__
typedef __bf16 bf16;
using bf16x8 = __attribute__((ext_vector_type(8))) short;
using f32x4 = __attribute__((ext_vector_type(4))) float;
using f32x16 = __attribute__((ext_vector_type(16))) float;
typedef unsigned short u16;

constexpr int T_ = 24576, TP_ = 8192;
constexpr int NCH = 384;
constexpr long long O_SD = 25165824LL, O_S5RE = 41943040LL, O_S5IM = 42467328LL, O_CKV = 42991616LL, O_KR = 51380224LL;

constexpr size_t W_IN = 0;
constexpr size_t W_G = W_IN + 3328ull * 1024;
constexpr size_t W_QB = W_G + 3072ull * 1024;
constexpr size_t W_KVB = W_QB + 768ull * 384;
constexpr size_t W_GLU = W_KVB + 1024ull * 256;
constexpr size_t W_BR = W_GLU + 512ull * 512;
constexpr size_t W_OUT = W_BR + 1024ull * 1536;
constexpr size_t W_UP = W_OUT + 1024ull * 1024;
constexpr size_t W_DN = W_UP + 5632ull * 1024;
constexpr size_t W_LAYER = W_DN + 1024ull * 2816;

constexpr size_t al(size_t x) { return (x + 255) & ~(size_t)255; }
constexpr size_t B_W = 0;
constexpr size_t B_MODS = al(B_W + 4 * W_LAYER * 2);
constexpr size_t B_ROPE = al(B_MODS + 4ull * 9 * 6144 * 4);
constexpr size_t B_LAMB = al(B_ROPE + 2048ull * 32 * 4);
constexpr size_t B_LAM64 = al(B_LAMB + 4ull * 2 * 32 * 64 * 8);
constexpr size_t B_BBT = al(B_LAM64 + 4ull * 2 * 32 * 64 * 8);
constexpr size_t B_CMT = al(B_BBT + 4ull * 2 * 32 * 128 * 16 * 2);
constexpr size_t B_CKVC = al(B_CMT + 4ull * 32 * 16 * 128 * 2);
constexpr size_t B_H = al(B_CKVC + 4ull * 2048 * 256 * 2);
constexpr size_t B_QKV = al(B_H + (size_t)T_ * 1024 * 2);
constexpr size_t B_Z = al(B_QKV + (size_t)T_ * 1536 * 2);
constexpr size_t B_US5 = al(B_Z + (size_t)T_ * 512 * 2);
constexpr size_t B_QA = al(B_US5 + (size_t)T_ * 512 * 2);
constexpr size_t B_KVA = al(B_QA + (size_t)T_ * 384 * 2);
constexpr size_t B_MISC = al(B_KVA + (size_t)T_ * 256 * 2);
constexpr size_t B_QN = al(B_MISC + (size_t)T_ * 48 * 4);
constexpr size_t B_KN = al(B_QN + (size_t)T_ * 512 * 2);
constexpr size_t B_VV = al(B_KN + (size_t)T_ * 512 * 2);
constexpr size_t B_KT = al(B_VV + (size_t)T_ * 512 * 2);
constexpr size_t B_BG = al(B_KT + (size_t)T_ * 512 * 2);
constexpr size_t B_TM = al(B_BG + (size_t)T_ * 16 * 4);
constexpr size_t B_QKM = al(B_TM + (size_t)T_ * 512 * 2);
constexpr size_t B_GC = al(B_QKM + (size_t)T_ * 512 * 2);
constexpr size_t B_BC = al(B_GC + (size_t)NCH * 4 * 2 * 64 * 4);
constexpr size_t KB_P = 32ull * 8 * 256 * 96, KB_S = 8ull * 8 * 2304 * 96;
constexpr size_t VT_P = 32ull * 8 * 64 * 256, VT_S = 8ull * 8 * 64 * 2304;
constexpr size_t B_KB = al(B_BC + (size_t)NCH * 4 * 2 * 64 * 4);
constexpr size_t B_VT = al(B_KB + (KB_P + KB_S) * 2);
constexpr size_t B_QM = al(B_VT + (VT_P + VT_S) * 2);
constexpr size_t B_HEND = al(B_QM + (size_t)T_ * 768 * 2);
constexpr size_t B_HIN = al(B_HEND + (size_t)NCH * 32 * 2 * 64 * 8);
constexpr size_t B_Y5 = al(B_HIN + (size_t)NCH * 32 * 2 * 64 * 8);
constexpr size_t B_OC = al(B_Y5 + (size_t)T_ * 512 * 2);
constexpr size_t B_END = al(B_OC + (size_t)T_ * 512 * 2);
constexpr size_t B_OF = B_QKV;
constexpr size_t B_OB = B_QKV + (size_t)T_ * 512 * 2;
constexpr size_t B_MG = B_QKV;
constexpr size_t B_OA = B_QN;
constexpr size_t B_OB5 = B_KN;
constexpr size_t B_UP = B_QKV;
constexpr size_t B_ACT = B_KB;
static_assert(B_UP + (size_t)T_ * 5632 * 2 <= B_KB, "UP overlaps ACT");
static_assert(B_ACT + (size_t)T_ * 2816 * 2 <= B_END, "ACT too big");
constexpr size_t B_BAR = B_END;
constexpr size_t B_TOTAL = B_BAR + 256;
static_assert(B_TOTAL <= 768ull * 1024 * 1024, "workspace too big");

struct Params {
  const float* in[39];
  float* out;
  char* ws;
  unsigned* bar;
};

DI int otid() { int t = (int)__builtin_amdgcn_workitem_id_x(); asm volatile("" : "+v"(t)); return t; }
DI unsigned pack2(float a, float b) {
  typedef __attribute__((ext_vector_type(2))) __bf16 bf2;
  bf2 v; v[0] = (__bf16)a; v[1] = (__bf16)b;
  return __builtin_bit_cast(unsigned, v);
}
DI u16 f2bf(float a) { return (u16)(pack2(a, 0.f) & 0xffffu); }
DI float bf2f(u16 u) { return __uint_as_float(((unsigned)u) << 16); }
DI float blo(unsigned u) { return __uint_as_float(u << 16); }
DI float bhi(unsigned u) { return __uint_as_float(u & 0xffff0000u); }
DI float wave_sum(float v) {
#pragma unroll
  for (int o = 32; o > 0; o >>= 1) v += __shfl_xor(v, o);
  return v;
}
DI float sigmoidf_(float x) { return 1.f / (1.f + __expf(-x)); }
DI float siluf_(float x) { return x / (1.f + __expf(-x)); }
DI int tok_v(int t) { return t < TP_ ? 0 : 1 + ((t - TP_) >> 11); }
DI int crow(int r, int h2) { return (r & 3) + 8 * (r >> 2) + 4 * h2; }
DI bf16x8 mk8(unsigned a, unsigned b, unsigned c, unsigned d) {
  uint4 p = make_uint4(a, b, c, d);
  return __builtin_bit_cast(bf16x8, p);
}
DI bf16x8 pack_acc(const f32x16& x, int s) {
  return mk8(pack2(x[8 * s], x[8 * s + 1]), pack2(x[8 * s + 2], x[8 * s + 3]), pack2(x[8 * s + 4], x[8 * s + 5]),
             pack2(x[8 * s + 6], x[8 * s + 7]));
}
DI bf16x8 load_perm(const u16* rowptr, int s, int h2) {
  uint2 a = *(const uint2*)(rowptr + 16 * s + 4 * h2);
  uint2 b = *(const uint2*)(rowptr + 16 * s + 8 + 4 * h2);
  return mk8(a.x, a.y, b.x, b.y);
}
DI unsigned swap16(unsigned u) { return (u >> 16) | (u << 16); }
DI bf16x8 load_perm_rev(const u16* rowptr, int base, int s, int h2) {
  uint2 a = *(const uint2*)(rowptr + 60 - base - 16 * s - 4 * h2);
  uint2 b = *(const uint2*)(rowptr + 52 - base - 16 * s - 4 * h2);
  return mk8(swap16(a.y), swap16(a.x), swap16(b.y), swap16(b.x));
}
#define MFMA16(a, b, c) __builtin_amdgcn_mfma_f32_16x16x32_bf16((a), (b), (c), 0, 0, 0)
#define MFMA32(a, b, c) __builtin_amdgcn_mfma_f32_32x32x16_bf16((a), (b), (c), 0, 0, 0)

template <int NJ, bool SWAP = true>
DI void gemm_core(f32x4 (&acc)[4][NJ], const u16* __restrict__ A, int lda, const u16* __restrict__ B, int ldb, int K,
                  u16* sm) {
  const int tid = otid(), lane = tid & 63, w = tid >> 6, wr = w >> 1, wc = w & 1;
  const int fr = lane & 15, fq = lane >> 4;
  constexpr int RS = 136;
  const int lrow = tid >> 4, lkc = tid & 15;
  uint4 a0, a1, a2, a3, a4, a5, a6, a7, b0, b1, b2, b3, b4, b5, b6, b7;
  b4 = b5 = b6 = b7 = make_uint4(0, 0, 0, 0);
  const u16* ap = A + (size_t)lrow * lda + lkc * 8;
  const u16* bp = B + (size_t)lrow * ldb + lkc * 8;
  const int nk = K >> 7;
  u16* as = sm;
  u16* bs = sm + 128 * RS;
  {
    const int k0 = 0;
    a0 = *(const uint4*)(ap + (size_t)(0 * 16) * lda + k0);
    a1 = *(const uint4*)(ap + (size_t)(1 * 16) * lda + k0);
    a2 = *(const uint4*)(ap + (size_t)(2 * 16) * lda + k0);
    a3 = *(const uint4*)(ap + (size_t)(3 * 16) * lda + k0);
    a4 = *(const uint4*)(ap + (size_t)(4 * 16) * lda + k0);
    a5 = *(const uint4*)(ap + (size_t)(5 * 16) * lda + k0);
    a6 = *(const uint4*)(ap + (size_t)(6 * 16) * lda + k0);
    a7 = *(const uint4*)(ap + (size_t)(7 * 16) * lda + k0);
    b0 = *(const uint4*)(bp + (size_t)(0 * 16) * ldb + k0);
    b1 = *(const uint4*)(bp + (size_t)(1 * 16) * ldb + k0);
    b2 = *(const uint4*)(bp + (size_t)(2 * 16) * ldb + k0);
    b3 = *(const uint4*)(bp + (size_t)(3 * 16) * ldb + k0);
    if (NJ == 4) b4 = *(const uint4*)(bp + (size_t)(4 * 16) * ldb + k0);
    if (NJ == 4) b5 = *(const uint4*)(bp + (size_t)(5 * 16) * ldb + k0);
    if (NJ == 4) b6 = *(const uint4*)(bp + (size_t)(6 * 16) * ldb + k0);
    if (NJ == 4) b7 = *(const uint4*)(bp + (size_t)(7 * 16) * ldb + k0);
  }
  for (int kt = 0; kt < nk; ++kt) {
    __syncthreads();
    *(uint4*)(as + (lrow + 0 * 16) * RS + lkc * 8) = a0;
    *(uint4*)(as + (lrow + 1 * 16) * RS + lkc * 8) = a1;
    *(uint4*)(as + (lrow + 2 * 16) * RS + lkc * 8) = a2;
    *(uint4*)(as + (lrow + 3 * 16) * RS + lkc * 8) = a3;
    *(uint4*)(as + (lrow + 4 * 16) * RS + lkc * 8) = a4;
    *(uint4*)(as + (lrow + 5 * 16) * RS + lkc * 8) = a5;
    *(uint4*)(as + (lrow + 6 * 16) * RS + lkc * 8) = a6;
    *(uint4*)(as + (lrow + 7 * 16) * RS + lkc * 8) = a7;
    *(uint4*)(bs + (lrow + 0 * 16) * RS + lkc * 8) = b0;
    *(uint4*)(bs + (lrow + 1 * 16) * RS + lkc * 8) = b1;
    *(uint4*)(bs + (lrow + 2 * 16) * RS + lkc * 8) = b2;
    *(uint4*)(bs + (lrow + 3 * 16) * RS + lkc * 8) = b3;
    if (NJ == 4) *(uint4*)(bs + (lrow + 4 * 16) * RS + lkc * 8) = b4;
    if (NJ == 4) *(uint4*)(bs + (lrow + 5 * 16) * RS + lkc * 8) = b5;
    if (NJ == 4) *(uint4*)(bs + (lrow + 6 * 16) * RS + lkc * 8) = b6;
    if (NJ == 4) *(uint4*)(bs + (lrow + 7 * 16) * RS + lkc * 8) = b7;
    __syncthreads();
    {
      const int k0 = (kt + 1 < nk ? kt + 1 : kt) * 128;
    a0 = *(const uint4*)(ap + (size_t)(0 * 16) * lda + k0);
    a1 = *(const uint4*)(ap + (size_t)(1 * 16) * lda + k0);
    a2 = *(const uint4*)(ap + (size_t)(2 * 16) * lda + k0);
    a3 = *(const uint4*)(ap + (size_t)(3 * 16) * lda + k0);
    a4 = *(const uint4*)(ap + (size_t)(4 * 16) * lda + k0);
    a5 = *(const uint4*)(ap + (size_t)(5 * 16) * lda + k0);
    a6 = *(const uint4*)(ap + (size_t)(6 * 16) * lda + k0);
    a7 = *(const uint4*)(ap + (size_t)(7 * 16) * lda + k0);
    b0 = *(const uint4*)(bp + (size_t)(0 * 16) * ldb + k0);
    b1 = *(const uint4*)(bp + (size_t)(1 * 16) * ldb + k0);
    b2 = *(const uint4*)(bp + (size_t)(2 * 16) * ldb + k0);
    b3 = *(const uint4*)(bp + (size_t)(3 * 16) * ldb + k0);
    if (NJ == 4) b4 = *(const uint4*)(bp + (size_t)(4 * 16) * ldb + k0);
    if (NJ == 4) b5 = *(const uint4*)(bp + (size_t)(5 * 16) * ldb + k0);
    if (NJ == 4) b6 = *(const uint4*)(bp + (size_t)(6 * 16) * ldb + k0);
    if (NJ == 4) b7 = *(const uint4*)(bp + (size_t)(7 * 16) * ldb + k0);
    }
#pragma unroll
    for (int ks = 0; ks < 4; ++ks) {
      bf16x8 af[4], bfr[NJ];
#pragma unroll
      for (int i = 0; i < 4; ++i) af[i] = *(const bf16x8*)(as + (wr * 64 + i * 16 + fr) * RS + ks * 32 + fq * 8);
#pragma unroll
      for (int j = 0; j < NJ; ++j) bfr[j] = *(const bf16x8*)(bs + (wc * NJ * 16 + j * 16 + fr) * RS + ks * 32 + fq * 8);
#pragma unroll
      for (int i = 0; i < 4; ++i)
#pragma unroll
        for (int j = 0; j < NJ; ++j) acc[i][j] = SWAP ? MFMA16(bfr[j], af[i], acc[i][j]) : MFMA16(af[i], bfr[j], acc[i][j]);
    }
  }
}
template <int NJ>
DI void zero_acc(f32x4 (&acc)[4][NJ]) {
#pragma unroll
  for (int i = 0; i < 4; ++i)
#pragma unroll
    for (int j = 0; j < NJ; ++j) acc[i][j] = f32x4{0.f, 0.f, 0.f, 0.f};
}
#define EPI_LOOP(NJ_)                                                              \
  const int e_lane = otid() & 63, e_w = otid() >> 6;                               \
  const int e_wr = e_w >> 1, e_wc = e_w & 1, e_fr = e_lane & 15, e_fq = e_lane >> 4; \
  _Pragma("unroll") for (int i = 0; i < 4; ++i)                                    \
  _Pragma("unroll") for (int j = 0; j < NJ_; ++j)
#define EROW (e_wr * 64 + i * 16 + e_fr)
#define ECOL4(NJ_) (e_wc * NJ_ * 16 + j * 16 + e_fq * 4)
DI uint2 pack4(const f32x4& v) { return make_uint2(pack2(v[0], v[1]), pack2(v[2], v[3])); }

DI int colmap(int kind, int n) {
  if (kind == 0) {
    if (n < 2048) return n;
    if (n < 2560) return 2064 + (n - 2048);
    if (n < 2944) return 2576 + (n - 2560);
    if (n < 3200) return 2960 + (n - 2944);
    int j = n - 3200;
    if (j < 16) return 2048 + j;
    if (j < 48) return 3216 + (j - 16);
    return -1;
  }
  if (kind == 1) return 3248 + n;
  return n;
}
DI void convT_tile(const float* __restrict__ src, int lds, int K, u16* __restrict__ dst, int kind, int kt, int nt,
                   float* sm) {
  const int tid = otid();
  const int c = tid & 63;
  const int sc = colmap(kind, nt * 64 + c);
  __syncthreads();
#pragma unroll 4
  for (int i = 0; i < 16; ++i) {
    int r = (tid >> 6) + i * 4;
    float v = sc >= 0 ? src[(size_t)(kt * 64 + r) * lds + sc] : 0.f;
    sm[r * 65 + c] = v;
  }
  __syncthreads();
  const int n = tid >> 2, kq = tid & 3;
  unsigned pk[8];
#pragma unroll
  for (int j = 0; j < 8; ++j) pk[j] = pack2(sm[(kq * 16 + 2 * j) * 65 + n], sm[(kq * 16 + 2 * j + 1) * 65 + n]);
  u16* d = dst + (size_t)(nt * 64 + n) * K + kt * 64 + kq * 16;
  *(uint4*)d = make_uint4(pk[0], pk[1], pk[2], pk[3]);
  *(uint4*)(d + 8) = make_uint4(pk[4], pk[5], pk[6], pk[7]);
}
constexpr int CJ0 = 16 * 52, CJ1 = CJ0 + 16 * 48, CJ2 = CJ1 + 6 * 12, CJ3 = CJ2 + 4 * 16, CJ4 = CJ3 + 8 * 8,
              CJ5 = CJ4 + 24 * 16, CJ6 = CJ5 + 16 * 16, CJ7 = CJ6 + 16 * 88, CJ8 = CJ7 + 44 * 16;
DI void conv_job(const Params& p, int l, int j, float* sm) {
  u16* wl = (u16*)(p.ws + B_W) + (size_t)l * W_LAYER;
  if (j < CJ0) { convT_tile(p.in[13] + (size_t)l * 1024 * 6320, 6320, 1024, wl + W_IN, 0, j / 52, j % 52, sm); return; }
  if (j < CJ1) { j -= CJ0; convT_tile(p.in[13] + (size_t)l * 1024 * 6320, 6320, 1024, wl + W_G, 1, j / 48, j % 48, sm); return; }
  if (j < CJ2) { j -= CJ1; convT_tile(p.in[29] + (size_t)l * 384 * 768, 768, 384, wl + W_QB, 2, j / 12, j % 12, sm); return; }
  if (j < CJ3) { j -= CJ2; convT_tile(p.in[31] + (size_t)l * 256 * 1024, 1024, 256, wl + W_KVB, 2, j / 16, j % 16, sm); return; }
  if (j < CJ4) { j -= CJ3; convT_tile(p.in[26] + (size_t)l * 512 * 512, 512, 512, wl + W_GLU, 2, j / 8, j % 8, sm); return; }
  if (j < CJ5) { j -= CJ4; convT_tile(p.in[32] + (size_t)l * 1536 * 1024, 1024, 1536, wl + W_BR, 2, j / 16, j % 16, sm); return; }
  if (j < CJ6) { j -= CJ5; convT_tile(p.in[33] + (size_t)l * 1024 * 1024, 1024, 1024, wl + W_OUT, 2, j / 16, j % 16, sm); return; }
  if (j < CJ7) { j -= CJ6; convT_tile(p.in[34] + (size_t)l * 1024 * 5632, 5632, 1024, wl + W_UP, 2, j / 88, j % 88, sm); return; }
  j -= CJ7; convT_tile(p.in[37] + (size_t)l * 2816 * 1024, 1024, 2816, wl + W_DN, 2, j / 16, j % 16, sm);
}
DI void mods_tile(const Params& p, int l, int jg, float* sm) {
  const int tid = otid();
  __syncthreads();
  for (int i = tid; i < 9 * 1024; i += 256) {
    int v = i >> 10, k = i & 1023;
    float cv = v == 0 ? p.in[8][k] : p.in[7][(v - 1) * 1024 + k];
    sm[i] = cv / (1.f + __expf(-cv));
  }
  __syncthreads();
  const int col = jg * 64 + (tid & 63), kq = tid >> 6;
  float acc[9];
#pragma unroll
  for (int v = 0; v < 9; ++v) acc[v] = 0.f;
  const float* wp = p.in[9] + (size_t)l * 1024 * 6144 + col;
#pragma unroll 4
  for (int k = kq * 256; k < kq * 256 + 256; ++k) {
    float wv = wp[(size_t)k * 6144];
#pragma unroll
    for (int v = 0; v < 9; ++v) acc[v] += sm[v * 1024 + k] * wv;
  }
  float* red = sm + 9 * 1024;
#pragma unroll
  for (int v = 0; v < 9; ++v) red[(kq * 9 + v) * 64 + (tid & 63)] = acc[v];
  __syncthreads();
  if (kq == 0) {
    float* mods = (float*)(p.ws + B_MODS);
    float b = p.in[10][l * 6144 + col];
#pragma unroll
    for (int v = 0; v < 9; ++v) {
      float s = red[(0 * 9 + v) * 64 + tid] + red[(1 * 9 + v) * 64 + tid] + red[(2 * 9 + v) * 64 + tid] + red[(3 * 9 + v) * 64 + tid];
      mods[(size_t)(l * 9 + v) * 6144 + col] = s + b;
    }
  }
}
DI void s5pre_tile(const Params& p, int tile) {
  const int id = tile * 256 + otid();
  const int pp = id & 63, g = (id >> 6) & 31, dir = (id >> 11) & 1, l = id >> 12;
  const float lre = p.in[18][((l * 2 + dir) * 32 + g) * 64 + pp];
  const float lim = p.in[19][((l * 2 + dir) * 32 + g) * 64 + pp];
  const float dt = expf(p.in[20][(l * 2 + dir) * 32 + g]);
  float er = expf(lre * dt), sn, cs;
  sincosf(lim * dt, &sn, &cs);
  const float lbr = er * cs, lbi = er * sn;
  float e64 = expf(64.f * lre * dt), s64, c64;
  sincosf(64.f * lim * dt, &s64, &c64);
  float2* lamb = (float2*)(p.ws + B_LAMB);
  float2* lam64 = (float2*)(p.ws + B_LAM64);
  const int li = ((l * 2 + dir) * 32 + g) * 64 + pp;
  lamb[li] = make_float2(lbr, lbi);
  lam64[li] = make_float2(e64 * c64, e64 * s64);
  const float nr = lbr - 1.f, ni = lbi, den = lre * lre + lim * lim;
  const float cr = (nr * lre + ni * lim) / den, ci = (ni * lre - nr * lim) / den;
  u16* bbt = (u16*)(p.ws + B_BBT) + (size_t)((l * 2 + dir) * 32 + g) * 128 * 16;
  const float* bre = p.in[21] + (size_t)((l * 32 + g) * 64 + pp) * 16;
  const float* bim = p.in[22] + (size_t)((l * 32 + g) * 64 + pp) * 16;
#pragma unroll
  for (int c = 0; c < 16; ++c) {
    float br = bre[c], bi = bim[c];
    bbt[pp * 16 + c] = f2bf(cr * br - ci * bi);
    bbt[(64 + pp) * 16 + c] = f2bf(cr * bi + ci * br);
  }
  if (dir == 0) {
    u16* cmt = (u16*)(p.ws + B_CMT) + (size_t)(l * 32 + g) * 16 * 128;
    const float* cre = p.in[23] + (size_t)(l * 32 + g) * 16 * 64;
    const float* cim = p.in[24] + (size_t)(l * 32 + g) * 16 * 64;
#pragma unroll
    for (int c = 0; c < 16; ++c) {
      cmt[c * 128 + pp] = f2bf(cre[c * 64 + pp]);
      cmt[c * 128 + 64 + pp] = f2bf(-cim[c * 64 + pp]);
    }
  }
}

DI void norm_phase(const Params& p, int l, int shift_idx, int scale_idx, const float* gn) {
  const float* x = p.out;
  u16* H = (u16*)(p.ws + B_H);
  const float* mods = (const float*)(p.ws + B_MODS);
  const int lane = otid() & 63, w = otid() >> 6;
  for (int tile = blockIdx.x; tile < T_ / 4; tile += gridDim.x) {
    const int t = tile * 4 + w;
    const float4* xr = (const float4*)(x + (size_t)t * 1024);
    float4 v[4];
    float ss = 0.f;
#pragma unroll
    for (int j = 0; j < 4; ++j) {
      v[j] = xr[lane + 64 * j];
      ss += v[j].x * v[j].x + v[j].y * v[j].y + v[j].z * v[j].z + v[j].w * v[j].w;
    }
    ss = wave_sum(ss);
    const float rstd = rsqrtf(ss * (1.f / 1024.f) + 1e-6f);
    const float* mb = mods + (size_t)(l * 9 + tok_v(t)) * 6144;
#pragma unroll
    for (int j = 0; j < 4; ++j) {
      const int c = (lane + 64 * j) * 4;
      float4 g = *(const float4*)(gn + c);
      float4 sc = *(const float4*)(mb + scale_idx * 1024 + c);
      float4 sh = *(const float4*)(mb + shift_idx * 1024 + c);
      float y0 = v[j].x * rstd * g.x * (1.f + sc.x) + sh.x;
      float y1 = v[j].y * rstd * g.y * (1.f + sc.y) + sh.y;
      float y2 = v[j].z * rstd * g.z * (1.f + sc.z) + sh.z;
      float y3 = v[j].w * rstd * g.w * (1.f + sc.w) + sh.w;
      *(uint2*)(H + (size_t)t * 1024 + c) = make_uint2(pack2(y0, y1), pack2(y2, y3));
    }
  }
}

DI void gemm_in_phase(const Params& p, int l, u16* sm) {
  const u16* H = (const u16*)(p.ws + B_H);
  const u16* Wt = (const u16*)(p.ws + B_W) + (size_t)l * W_LAYER + W_IN;
  for (int tile = blockIdx.x; tile < 192 * 26; tile += gridDim.x) {
    const int mt = tile / 26, nt = tile % 26;
    f32x4 acc[4][4];
    zero_acc<4>(acc);
    gemm_core<4>(acc, H + (size_t)mt * 128 * 1024, 1024, Wt + (size_t)nt * 128 * 1024, 1024, 1024, sm);
    if (nt < 25) {
      u16* dst; int ld, c0;
      if (nt < 12) { dst = (u16*)(p.ws + B_QKV); ld = 1536; c0 = nt * 128; }
      else if (nt < 16) { dst = (u16*)(p.ws + B_Z); ld = 512; c0 = (nt - 12) * 128; }
      else if (nt < 20) { dst = (u16*)(p.ws + B_US5); ld = 512; c0 = (nt - 16) * 128; }
      else if (nt < 23) { dst = (u16*)(p.ws + B_QA); ld = 384; c0 = (nt - 20) * 128; }
      else { dst = (u16*)(p.ws + B_KVA); ld = 256; c0 = (nt - 23) * 128; }
      EPI_LOOP(4) { *(uint2*)(dst + (size_t)(mt * 128 + EROW) * ld + c0 + ECOL4(4)) = pack4(acc[i][j]); }
    } else {
      float* misc = (float*)(p.ws + B_MISC);
      EPI_LOOP(4) {
        const int c = ECOL4(4);
        if (c < 48) *(float4*)(misc + (size_t)(mt * 128 + EROW) * 48 + c) = make_float4(acc[i][j][0], acc[i][j][1], acc[i][j][2], acc[i][j][3]);
      }
    }
  }
}

DI void delta_prep_tile(const Params& p, int l, int chunk, u16* sm) {
  const int tid = otid(), lane = tid & 63, w = tid >> 6;
  const int tb = chunk * 64;
  int pos0, L;
  if (tb < TP_) { pos0 = tb & 255; L = 256; } else { pos0 = (tb - TP_) & 2047; L = 2048; }
  const u16* qkv = (const u16*)(p.ws + B_QKV);
  const float* cw = p.in[14] + (size_t)l * 5 * 1536;
  u16* ksm = sm + w * (64 * 130);
  __syncthreads();
  for (int gi = w; gi < 12; gi += 4) {
    const int ch = gi * 128 + 2 * lane;
    float w0[5], w1[5];
#pragma unroll
    for (int i = 0; i < 5; ++i) { w0[i] = cw[i * 1536 + ch]; w1[i] = cw[i * 1536 + ch + 1]; }
    float a0[5], a1[5];
#pragma unroll
    for (int i = 0; i < 4; ++i) {
      int ps = pos0 - 2 + i;
      unsigned u = (ps >= 0 && ps < L) ? *(const unsigned*)(qkv + (size_t)(tb - 2 + i) * 1536 + ch) : 0u;
      a0[i + 1] = blo(u); a1[i + 1] = bhi(u);
    }
    u16* dst = (u16*)(p.ws + (gi < 4 ? B_QN : (gi < 8 ? B_KN : B_VV)));
    const int hh = gi & 3;
    for (int tt = 0; tt < 64; ++tt) {
#pragma unroll
      for (int i = 0; i < 4; ++i) { a0[i] = a0[i + 1]; a1[i] = a1[i + 1]; }
      {
        int ps = pos0 + tt + 2;
        unsigned u = (ps < L) ? *(const unsigned*)(qkv + (size_t)(tb + tt + 2) * 1536 + ch) : 0u;
        a0[4] = blo(u); a1[4] = bhi(u);
      }
      float y0 = 0.f, y1 = 0.f;
#pragma unroll
      for (int i = 0; i < 5; ++i) { y0 += w0[i] * a0[i]; y1 += w1[i] * a1[i]; }
      y0 = siluf_(y0); y1 = siluf_(y1);
      if (gi < 8) {
        float ss = wave_sum(y0 * y0 + y1 * y1);
        float sc = rsqrtf(ss + 1e-6f);
        if (gi < 4) sc *= 0.08838834764831845f;
        y0 *= sc; y1 *= sc;
      }
      const unsigned pk = pack2(y0, y1);
      *(unsigned*)(dst + (size_t)(tb + tt) * 512 + hh * 128 + 2 * lane) = pk;
      if (gi >= 4 && gi < 8) *(unsigned*)(ksm + tt * 130 + 2 * lane) = pk;
    }
    if (gi >= 4 && gi < 8) {
      u16* kt = (u16*)(p.ws + B_KT) + (size_t)(chunk * 4 + hh) * 128 * 64;
#pragma unroll
      for (int rr = 0; rr < 2; ++rr) {
        const int dk = lane + 64 * rr;
        unsigned pk[32];
#pragma unroll
        for (int t2 = 0; t2 < 32; ++t2) pk[t2] = (unsigned)ksm[(2 * t2) * 130 + dk] | ((unsigned)ksm[(2 * t2 + 1) * 130 + dk] << 16);
#pragma unroll
        for (int q = 0; q < 8; ++q) *(uint4*)(kt + dk * 64 + q * 8) = make_uint4(pk[4 * q], pk[4 * q + 1], pk[4 * q + 2], pk[4 * q + 3]);
      }
    }
  }
  const float* misc = (const float*)(p.ws + B_MISC);
  float* bg = (float*)(p.ws + B_BG);
  for (int i = tid; i < 512; i += 256) {
    const int tt = i >> 3, dh = i & 7;
    const size_t t = tb + tt;
    float bl = misc[t * 48 + dh], alp = misc[t * 48 + 8 + dh];
    float x = alp + p.in[16][l * 8 + dh];
    float sp = x > 20.f ? x : log1pf(__expf(x));
    bg[t * 16 + dh] = sigmoidf_(bl);
    bg[t * 16 + 8 + dh] = -__expf(p.in[15][l * 8 + dh]) * sp;
  }
}

DI size_t kb_off(int t, int head) {
  if (t < TP_) return ((size_t)((t >> 8) * 8 + head) * 256 + (t & 255)) * 96;
  const int s = (t - TP_) >> 11, pos = (t - TP_) & 2047;
  return KB_P + ((size_t)(s * 8 + head) * 2304 + 256 + pos) * 96;
}
DI void mla_prep_tile(const Params& p, int l, int tile) {
  const int lane = otid() & 63, w = otid() >> 6;
  const int t = tile * 4 + w;
  u16* qa = (u16*)(p.ws + B_QA) + (size_t)t * 384;
  u16* kva = (u16*)(p.ws + B_KVA) + (size_t)t * 256;
  const float* misc = (const float*)(p.ws + B_MISC) + (size_t)t * 48;
  {
    unsigned u[3]; float ss = 0.f;
#pragma unroll
    for (int j = 0; j < 3; ++j) { u[j] = *(const unsigned*)(qa + 2 * lane + 128 * j); float a = blo(u[j]), b = bhi(u[j]); ss += a * a + b * b; }
    ss = wave_sum(ss);
    const float rstd = rsqrtf(ss * (1.f / 384.f) + 1e-6f);
    const float* g = p.in[28] + l * 384;
#pragma unroll
    for (int j = 0; j < 3; ++j) {
      int c = 2 * lane + 128 * j;
      *(unsigned*)(qa + c) = pack2(blo(u[j]) * rstd * g[c], bhi(u[j]) * rstd * g[c + 1]);
    }
  }
  {
    unsigned u[2]; float ss = 0.f;
#pragma unroll
    for (int j = 0; j < 2; ++j) { u[j] = *(const unsigned*)(kva + 2 * lane + 128 * j); float a = blo(u[j]), b = bhi(u[j]); ss += a * a + b * b; }
    ss = wave_sum(ss);
    const float rstd = rsqrtf(ss * (1.f / 256.f) + 1e-6f);
    const float* g = p.in[30] + l * 256;
#pragma unroll
    for (int j = 0; j < 2; ++j) {
      int c = 2 * lane + 128 * j;
      float a = blo(u[j]) * rstd * g[c], b = bhi(u[j]) * rstd * g[c + 1];
      *(unsigned*)(kva + c) = pack2(a, b);
      if (t < TP_) {
        float* o = p.out + O_CKV + ((size_t)((t >> 8) * 4 + l) * 256 + (t & 255)) * 256 + c;
        *(float2*)o = make_float2(a, b);
      }
    }
  }
  {
    const int i = lane & 31;
    float kr = misc[16 + i];
    float val;
    if (t < TP_) {
      val = kr;
      if (lane < 32) p.out[O_KR + ((size_t)((t >> 8) * 4 + l) * 256 + (t & 255)) * 32 + i] = kr;
    } else {
      const int pos = (t - TP_) & 2047;
      const float* rp = (const float*)(p.ws + B_ROPE) + (size_t)pos * 32 + (i & 15) * 2;
      const float cs = rp[0], sn = rp[1];
      float other = __shfl_xor(kr, 16);
      val = (i < 16) ? (kr * cs - other * sn) : (kr * cs + other * sn);
    }
    u16* kb = (u16*)(p.ws + B_KB);
    const u16 bv = f2bf(val);
#pragma unroll
    for (int hh = 0; hh < 4; ++hh) {
      int head = hh * 2 + (lane >> 5);
      kb[kb_off(t, head) + 64 + i] = bv;
    }
  }
}
DI void cache_rope_tile(const Params& p, int l, int tile) {
  const int pr = tile * 8 + (otid() >> 5), i = otid() & 31;
  const int s = pr >> 8, pos = pr & 255;
  const float v = p.in[6][((size_t)(s * 4 + l) * 256 + pos) * 32 + i];
  u16* kb = (u16*)(p.ws + B_KB);
  const u16 bv = f2bf(v);
#pragma unroll
  for (int head = 0; head < 8; ++head) kb[KB_P + ((size_t)(s * 8 + head) * 2304 + pos) * 96 + 64 + i] = bv;
}

DI float gelu_tanh(float x) {
  const float k0 = 0.7978845608028654f, k1 = 0.044715f;
  float u = k0 * (x + k1 * x * x * x);
  float e = __expf(2.f * u);
  float th = 1.f - 2.f / (e + 1.f);
  return 0.5f * x * (1.f + th);
}
DI void s5_chunk_tile(const Params& p, int l, int chunk, int gp, int mode, u16* sm) {
  const int tid = otid(), lane = tid & 63, w = tid >> 6;
  const u16* us5 = (const u16*)(p.ws + B_US5);
  constexpr int RS = 136;
  __syncthreads();
  {
    const int gi = w >> 1, half = w & 1, g = gp * 2 + gi;
    const int n = lane & 31, h2 = lane >> 5;
    bf16x8 af[2];
#pragma unroll
    for (int mi = 0; mi < 2; ++mi) af[mi] = *(const bf16x8*)(us5 + (size_t)(chunk * 64 + mi * 32 + n) * 512 + g * 16 + 8 * h2);
#pragma unroll
    for (int dir = 0; dir < 2; ++dir) {
      const u16* bbt = (const u16*)(p.ws + B_BBT) + (size_t)((l * 2 + dir) * 32 + g) * 128 * 16;
#pragma unroll
      for (int nn = 0; nn < 2; ++nn) {
        const int nt = half * 2 + nn;
        bf16x8 bfr = *(const bf16x8*)(bbt + (nt * 32 + n) * 16 + 8 * h2);
#pragma unroll
        for (int mi = 0; mi < 2; ++mi) {
          f32x16 acc;
#pragma unroll
          for (int r = 0; r < 16; ++r) acc[r] = 0.f;
          acc = MFMA32(af[mi], bfr, acc);
          u16* d = sm + (size_t)((gi * 2 + dir) * 64 + mi * 32) * RS + nt * 32 + n;
#pragma unroll
          for (int r = 0; r < 16; ++r) d[crow(r, h2) * RS] = f2bf(acc[r]);
        }
      }
    }
  }
  __syncthreads();
  {
    const int gi = tid >> 7, dir = (tid >> 6) & 1, pp = tid & 63, g = gp * 2 + gi;
    const float2 lb = ((const float2*)(p.ws + B_LAMB))[((l * 2 + dir) * 32 + g) * 64 + pp];
    const size_t hidx = ((size_t)(chunk * 32 + g) * 2 + dir) * 64 + pp;
    float hr = 0.f, hi = 0.f;
    if (mode) { float2 h0 = ((const float2*)(p.ws + B_HIN))[hidx]; hr = h0.x; hi = h0.y; }
    u16* base = sm + (size_t)((gi * 2 + dir) * 64) * RS;
#pragma unroll 8
    for (int st = 0; st < 64; ++st) {
      const int tk = dir ? 63 - st : st;
      float br = bf2f(base[tk * RS + pp]), bi = bf2f(base[tk * RS + 64 + pp]);
      float nr = __builtin_fmaf(lb.x, hr, __builtin_fmaf(-lb.y, hi, br));
      float ni = __builtin_fmaf(lb.x, hi, __builtin_fmaf(lb.y, hr, bi));
      asm volatile("" : "+v"(nr));
      asm volatile("" : "+v"(ni));
      hr = nr; hi = ni;
      if (mode) { base[tk * RS + pp] = f2bf(hr); base[tk * RS + 64 + pp] = f2bf(hi); }
    }
    if (!mode) ((float2*)(p.ws + B_HEND))[hidx] = make_float2(hr, hi);
  }
  if (!mode) return;
  __syncthreads();
  {
    const int gi = w >> 1, g = gp * 2 + gi;
    const int fr = lane & 15, fq = lane >> 4;
    const u16* cmt = (const u16*)(p.ws + B_CMT) + (size_t)(l * 32 + g) * 16 * 128;
    f32x4 acc[2];
    acc[0] = f32x4{0.f, 0.f, 0.f, 0.f}; acc[1] = acc[0];
#pragma unroll
    for (int ks = 0; ks < 8; ++ks) {
      const int dir = ks >> 2, kk = (ks & 3) * 32;
      bf16x8 bfr = *(const bf16x8*)(cmt + fr * 128 + kk + fq * 8);
#pragma unroll
      for (int mm = 0; mm < 2; ++mm) {
        const int mi = (w & 1) * 2 + mm;
        bf16x8 af = *(const bf16x8*)(sm + (size_t)((gi * 2 + dir) * 64 + mi * 16 + fr) * RS + kk + fq * 8);
        acc[mm] = MFMA16(af, bfr, acc[mm]);
      }
    }
    const float dsk = p.in[25][l * 512 + g * 16 + fr];
    u16* y5 = (u16*)(p.ws + B_Y5);
#pragma unroll
    for (int mm = 0; mm < 2; ++mm)
#pragma unroll
      for (int r = 0; r < 4; ++r) {
        const size_t t = (size_t)chunk * 64 + ((w & 1) * 2 + mm) * 16 + fq * 4 + r;
        float u = bf2f(us5[t * 512 + g * 16 + fr]);
        float y = acc[mm][r] + dsk * u;
        y5[t * 512 + g * 16 + fr] = f2bf(gelu_tanh(y));
      }
  }
}
DI void s5_carry_tile(const Params& p, int l, int tile) {
  const int seq = tile >> 4, gp = tile & 15;
  const int tid = otid(), gi = tid >> 7, dir = (tid >> 6) & 1, pp = tid & 63, g = gp * 2 + gi;
  int c0, nc;
  if (seq < 32) { c0 = seq * 4; nc = 4; } else { c0 = 128 + (seq - 32) * 32; nc = 32; }
  const float2 l64 = ((const float2*)(p.ws + B_LAM64))[((l * 2 + dir) * 32 + g) * 64 + pp];
  float hr = 0.f, hi = 0.f;
  if (seq >= 32) {
    const size_t si = ((size_t)((seq - 32) * 4 + l) * 2 + dir) * 2048 + g * 64 + pp;
    hr = p.in[3][si]; hi = p.in[4][si];
  }
  const float2* hend = (const float2*)(p.ws + B_HEND);
  float2* hin = (float2*)(p.ws + B_HIN);
  for (int it = 0; it < nc; ++it) {
    const int ck = c0 + (dir ? nc - 1 - it : it);
    const size_t idx = ((size_t)(ck * 32 + g) * 2 + dir) * 64 + pp;
    hin[idx] = make_float2(hr, hi);
    float2 he = hend[idx];
    float nr = __builtin_fmaf(l64.x, hr, __builtin_fmaf(-l64.y, hi, he.x));
    float ni = __builtin_fmaf(l64.x, hi, __builtin_fmaf(l64.y, hr, he.y));
    asm volatile("" : "+v"(nr));
    asm volatile("" : "+v"(ni));
    hr = nr; hi = ni;
  }
  if (seq < 32) {
    const size_t so = ((size_t)(seq * 4 + l) * 2 + dir) * 2048 + g * 64 + pp;
    p.out[O_S5RE + so] = hr;
    p.out[O_S5IM + so] = hi;
  }
}

DI void delta_local_tile(const Params& p, int tile, float* smf) {
  const int chunk = tile >> 1, dir = tile & 1;
  const int tid = otid(), lane = tid & 63, h = tid >> 6;
  const int m = lane & 31, h2 = lane >> 5;
  const int tb = chunk * 64;
  const float* bg = (const float*)(p.ws + B_BG);
  const u16* kn = (const u16*)(p.ws + B_KN);
  const u16* qn = (const u16*)(p.ws + B_QN);
  float* Aw = smf + h * 4096;
  const size_t cidx = ((size_t)(chunk * 4 + h) * 2 + dir);
  const int tl = tb + (dir ? 63 - lane : lane);
  float gcs = bg[(size_t)tl * 16 + 8 + dir * 4 + h];
  const float beta = bg[(size_t)tl * 16 + dir * 4 + h];
#pragma unroll
  for (int o = 1; o < 64; o <<= 1) {
    float v = __shfl_up(gcs, o);
    if (lane >= o) gcs += v;
  }
  ((float*)(p.ws + B_GC))[cidx * 64 + lane] = gcs;
  ((float*)(p.ws + B_BC))[cidx * 64 + lane] = beta;
  __syncthreads();
  u16* qkm = (u16*)(p.ws + B_QKM) + cidx * 4096;
#pragma unroll 1
  for (int tt = 0; tt < 3; ++tt) {
    const int mi = tt == 0 ? 0 : 1, ni = tt == 2 ? 1 : 0;
    const int cm = 32 * mi + m, cn = 32 * ni + m;
    const u16* krm = kn + (size_t)(tb + (dir ? 63 - cm : cm)) * 512 + h * 128 + h2 * 8;
    const u16* qrm = qn + (size_t)(tb + (dir ? 63 - cm : cm)) * 512 + h * 128 + h2 * 8;
    const u16* krn = kn + (size_t)(tb + (dir ? 63 - cn : cn)) * 512 + h * 128 + h2 * 8;
    f32x16 ak, aq;
#pragma unroll
    for (int r = 0; r < 16; ++r) { ak[r] = 0.f; aq[r] = 0.f; }
#pragma unroll
    for (int ks = 0; ks < 8; ++ks) {
      const bf16x8 fkm = *(const bf16x8*)(krm + ks * 16), fqm = *(const bf16x8*)(qrm + ks * 16), fkn = *(const bf16x8*)(krn + ks * 16);
      ak = MFMA32(fkm, fkn, ak);
      aq = MFMA32(fqm, fkn, aq);
    }
    const int e = 32 * ni + m;
    const float gce = __shfl(gcs, e);
#pragma unroll
    for (int r = 0; r < 16; ++r) {
      const int c = 32 * mi + crow(r, h2);
      const float gcc = __shfl(gcs, c), bc = __shfl(beta, c);
      const float dec = (e <= c) ? __expf(gcc - gce) : 0.f;
      Aw[c * 64 + e] = (e < c) ? ak[r] * bc * dec : 0.f;
      qkm[c * 64 + e] = f2bf(aq[r] * dec);
    }
  }
  __syncthreads();
  u16* tm = (u16*)(p.ws + B_TM) + cidx * 4096;
  float x[64];
#pragma unroll
  for (int i = 0; i < 64; ++i) {
    float a = (i == lane) ? 1.f : 0.f;
#pragma unroll
    for (int j = 0; j < i; ++j) a -= Aw[i * 64 + j] * x[j];
    x[i] = a;
    tm[i * 64 + lane] = f2bf(a);
  }
}

template <int dir>
DI void delta_scan_body(const Params& p, int l, int seq, int h, u16* sm);
DI void delta_scan_tile(const Params& p, int l, int idx, u16* sm) {
  int seq, h, dir;
  if (idx < 64) { seq = 32 + (idx >> 3); h = (idx >> 1) & 3; dir = idx & 1; }
  else { const int i2 = idx - 64; seq = i2 >> 3; h = (i2 >> 1) & 3; dir = i2 & 1; }
  if (dir) delta_scan_body<1>(p, l, seq, h, sm); else delta_scan_body<0>(p, l, seq, h, sm);
}
template <int dir>
DI void delta_scan_body(const Params& p, int l, int seq, int h, u16* sm) {
  int chunk0, nch;
  if (seq < 32) { chunk0 = seq * 4; nch = 4; } else { chunk0 = 128 + (seq - 32) * 32; nch = 32; }
  const int lane = otid() & 63, w = otid() >> 6;
  const int n = lane & 31, h2 = lane >> 5;
  const int dvc = w * 32 + n;
  const u16* kn = (const u16*)(p.ws + B_KN);
  const u16* qn = (const u16*)(p.ws + B_QN);
  const u16* vv = (const u16*)(p.ws + B_VV);
  u16* od = (u16*)(p.ws + (dir ? B_OB : B_OF));
  f32x16 S[4];
  if (seq >= 32) {
    const float* s0 = p.in[2] + ((size_t)(((seq - 32) * 4 + l) * 2 + dir) * 4 + h) * 16384;
#pragma unroll
    for (int t = 0; t < 4; ++t)
#pragma unroll
      for (int r = 0; r < 16; ++r) S[t][r] = s0[(size_t)(32 * t + crow(r, h2)) * 128 + dvc];
  } else {
#pragma unroll
    for (int t = 0; t < 4; ++t)
#pragma unroll
      for (int r = 0; r < 16; ++r) S[t][r] = 0.f;
  }
  for (int it = 0; it < nch; ++it) {
    const int chunk = chunk0 + (dir ? nch - 1 - it : it);
    const int tb = chunk * 64;
    const size_t cidx = ((size_t)(chunk * 4 + h) * 2 + dir);
    const float* gcp = (const float*)(p.ws + B_GC) + cidx * 64;
    const float* bcp = (const float*)(p.ws + B_BC) + cidx * 64;
    const u16* tm = (const u16*)(p.ws + B_TM) + cidx * 4096;
    const u16* qkm = (const u16*)(p.ws + B_QKM) + cidx * 4096;
    const u16* ktp = (const u16*)(p.ws + B_KT) + (size_t)(chunk * 4 + h) * 8192;
    const float glast = gcp[63];
    size_t trow[2];
#pragma unroll
    for (int mi = 0; mi < 2; ++mi) { const int c = 32 * mi + n; trow[mi] = (size_t)(tb + (dir ? 63 - c : c)); }
#define SCHED_FENCE() asm volatile("" ::: "memory")
    u16* Ks = sm; u16* Qs = sm + 8704; u16* Vs = sm + 17408; u16* KTs = sm + 26112;
    float* GCs = (float*)(sm + 35328);
    const float* gcl = GCs; const float* bcl = GCs + 64;
    uint4 xm0, xm1, xq0, xq1;
    u16* vls = Vs + w * 32;
    __syncthreads();
    {
      const int tid_ = otid();
      const int r0 = tid_ >> 4, ck = tid_ & 15;
      uint4 tk[4], tq[4], tv[4], tt[4];
      xm0 = *(const uint4*)(tm + tid_ * 8); xm1 = *(const uint4*)(tm + 2048 + tid_ * 8);
      xq0 = *(const uint4*)(qkm + tid_ * 8); xq1 = *(const uint4*)(qkm + 2048 + tid_ * 8);
      float4 gcv = make_float4(0.f, 0.f, 0.f, 0.f);
      if (tid_ < 16) gcv = *(const float4*)(gcp + tid_ * 4); else if (tid_ < 32) gcv = *(const float4*)(bcp + (tid_ - 16) * 4);
#pragma unroll
      for (int j = 0; j < 4; ++j) {
        const size_t go = (size_t)(tb + r0 + 16 * j) * 512 + h * 128 + ck * 8;
        tk[j] = *(const uint4*)(kn + go); tq[j] = *(const uint4*)(qn + go); tv[j] = *(const uint4*)(vv + go);
        tt[j] = *(const uint4*)(ktp + ((tid_ >> 3) + 32 * j) * 64 + (tid_ & 7) * 8);
      }
#pragma unroll
      for (int j = 0; j < 4; ++j) {
        const int tau = r0 + 16 * j, c = dir ? 63 - tau : tau;
        *(uint4*)(Ks + c * 136 + ck * 8) = tk[j]; *(uint4*)(Qs + c * 136 + ck * 8) = tq[j]; *(uint4*)(Vs + c * 136 + ck * 8) = tv[j];
        *(uint4*)(KTs + ((tid_ >> 3) + 32 * j) * 72 + (tid_ & 7) * 8) = tt[j];
      }
      if (tid_ < 32) *(float4*)(GCs + tid_ * 4) = gcv;
    }
    __syncthreads();
    f32x16 X[2], QS[2];
    {
      bf16x8 Sb[4][2];
#pragma unroll
      for (int t = 0; t < 4; ++t)
#pragma unroll
        for (int s = 0; s < 2; ++s) Sb[t][s] = pack_acc(S[t], s);
#pragma unroll
      for (int mi = 0; mi < 2; ++mi)
#pragma unroll
        for (int r = 0; r < 16; ++r) { X[mi][r] = 0.f; QS[mi][r] = 0.f; }
#pragma unroll
      for (int t = 0; t < 4; ++t) {
#pragma unroll
        for (int mi = 0; mi < 2; ++mi) {
          const u16* krow_ = Ks + (32 * mi + n) * 136;
          const u16* qrow_ = Qs + (32 * mi + n) * 136;
#pragma unroll
          for (int s = 0; s < 2; ++s) {
            X[mi] = MFMA32(load_perm(krow_ + 32 * t, s, h2), Sb[t][s], X[mi]);
            QS[mi] = MFMA32(load_perm(qrow_ + 32 * t, s, h2), Sb[t][s], QS[mi]);
          }
        }
        SCHED_FENCE();
      }
    }
    __syncthreads();
    {
      const int tid_ = otid();
      const int r_ = tid_ >> 3, c_ = (tid_ & 7) * 8;
      *(uint4*)(Ks + r_ * 72 + c_) = xm0; *(uint4*)(Ks + (r_ + 32) * 72 + c_) = xm1;
      *(uint4*)(Qs + r_ * 72 + c_) = xq0; *(uint4*)(Qs + (r_ + 32) * 72 + c_) = xq1;
    }
    __syncthreads();
    bf16x8 Rb[2][2];
#pragma unroll
    for (int mi = 0; mi < 2; ++mi) {
#pragma unroll
      for (int a = 0; a < 4; ++a) {
        const int c4 = 32 * mi + 8 * a + 4 * h2;
        const float4 g4 = *(const float4*)(gcl + c4);
        const float4 b4 = *(const float4*)(bcl + c4);
        const float gg[4] = {g4.x, g4.y, g4.z, g4.w};
        const float bb[4] = {b4.x, b4.y, b4.z, b4.w};
#pragma unroll
        for (int q = 0; q < 4; ++q) {
          const int c = c4 + q;
          const float v = bf2f(vls[c * 136 + n]);
          const float eg = __expf(gg[q]);
          X[mi][4 * a + q] = bb[q] * (v - eg * X[mi][4 * a + q]);
          QS[mi][4 * a + q] *= eg;
        }
      }
      Rb[mi][0] = pack_acc(X[mi], 0);
      Rb[mi][1] = pack_acc(X[mi], 1);
    }
    SCHED_FENCE();
    f32x16 Vn[2];
#pragma unroll
    for (int mo = 0; mo < 2; ++mo) {
#pragma unroll
      for (int r = 0; r < 16; ++r) Vn[mo][r] = 0.f;
#pragma unroll
      for (int mi = 0; mi <= mo; ++mi)
#pragma unroll
        for (int s = 0; s < 2; ++s) Vn[mo] = MFMA32(load_perm(Ks + (32 * mo + n) * 72 + 32 * mi, s, h2), Rb[mi][s], Vn[mo]);
    }
    SCHED_FENCE();
    {
      bf16x8 Vb[2][2];
#pragma unroll
      for (int mi = 0; mi < 2; ++mi) { Vb[mi][0] = pack_acc(Vn[mi], 0); Vb[mi][1] = pack_acc(Vn[mi], 1); }
#pragma unroll
      for (int mo = 0; mo < 2; ++mo) {
#pragma unroll
        for (int mi = 0; mi <= mo; ++mi)
#pragma unroll
          for (int s = 0; s < 2; ++s) QS[mo] = MFMA32(load_perm(Qs + (32 * mo + n) * 72 + 32 * mi, s, h2), Vb[mi][s], QS[mo]);
      }
      __syncthreads();
#pragma unroll
      for (int mo = 0; mo < 2; ++mo)
#pragma unroll
        for (int r = 0; r < 16; ++r) vls[(32 * mo + crow(r, h2)) * 136 + n] = f2bf(QS[mo][r]);
      __syncthreads();
#pragma unroll
      for (int jv = 0; jv < 4; ++jv) {
        const int tau = (lane >> 2) + 16 * jv, cq = lane & 3;
        const uint4 oq = *(const uint4*)(vls + (dir ? 63 - tau : tau) * 136 + cq * 8);
        *(uint4*)(od + (size_t)(tb + tau) * 512 + h * 128 + w * 32 + cq * 8) = oq;
      }
    }
    SCHED_FENCE();
    bf16x8 Vsb[2][2];
#pragma unroll
    for (int mi = 0; mi < 2; ++mi) {
#pragma unroll
      for (int a = 0; a < 4; ++a) {
        const float4 g4 = *(const float4*)(gcl + 32 * mi + 8 * a + 4 * h2);
        Vn[mi][4 * a + 0] *= __expf(glast - g4.x); Vn[mi][4 * a + 1] *= __expf(glast - g4.y);
        Vn[mi][4 * a + 2] *= __expf(glast - g4.z); Vn[mi][4 * a + 3] *= __expf(glast - g4.w);
      }
      Vsb[mi][0] = pack_acc(Vn[mi], 0); Vsb[mi][1] = pack_acc(Vn[mi], 1);
    }
    const float eg = __expf(glast);
#pragma unroll
    for (int t = 0; t < 4; ++t) {
#pragma unroll
      for (int r = 0; r < 16; ++r) S[t][r] *= eg;
      const u16* ktrow = KTs + (32 * t + n) * 72;
#pragma unroll
      for (int mi = 0; mi < 2; ++mi)
#pragma unroll
        for (int s = 0; s < 2; ++s) {
          bf16x8 a = dir ? load_perm_rev(ktrow, 32 * mi, s, h2) : load_perm(ktrow + 32 * mi, s, h2);
          S[t] = MFMA32(a, Vsb[mi][s], S[t]);
        }
      SCHED_FENCE();
    }
  }
  if (seq < 32) {
    float* so = p.out + O_SD + ((size_t)((seq * 4 + l) * 2 + dir) * 4 + h) * 16384;
#pragma unroll
    for (int t = 0; t < 4; ++t)
#pragma unroll
      for (int r = 0; r < 16; ++r) so[(size_t)(32 * t + crow(r, h2)) * 128 + dvc] = S[t][r];
  }
}

DI void attn_tile(const Params& p, int seq, int head, int qb, u16* sm) {
  const int lane = otid() & 63, w = otid() >> 6;
  const int n = lane & 31, h2 = lane >> 5;
  int tq0, nkeys; size_t kbo, vto;
  if (seq < 32) { tq0 = seq * 256 + qb * 128 + w * 32; nkeys = 256; kbo = (size_t)(seq * 8 + head) * 256 * 96; vto = (size_t)(seq * 8 + head) * 64 * 256; }
  else { const int s = seq - 32; tq0 = TP_ + s * 2048 + qb * 128 + w * 32; nkeys = 2304; kbo = KB_P + (size_t)(s * 8 + head) * 2304 * 96; vto = VT_P + (size_t)(s * 8 + head) * 64 * 2304; }
  const u16* kb = (const u16*)(p.ws + B_KB) + kbo;
  const u16* vt = (const u16*)(p.ws + B_VT) + vto;
  const u16* qm = (const u16*)(p.ws + B_QM) + (size_t)(tq0 + n) * 768 + head * 96;
  bf16x8 qf[6];
#pragma unroll
  for (int ks = 0; ks < 6; ++ks) qf[ks] = *(const bf16x8*)(qm + ks * 16 + h2 * 8);
  f32x16 O[2];
#pragma unroll
  for (int r = 0; r < 16; ++r) { O[0][r] = 0.f; O[1][r] = 0.f; }
  float mrun = -1e30f, lsum = 0.f;
  const int nkt = nkeys >> 6;
  constexpr int KST = 104, VST = 72, STG = 64 * KST + 64 * VST;
  const int tid_ = otid();
  uint4 rk0, rk1, rk2, rv0, rv1;
  const int kc0 = tid_, kc1 = tid_ + 256, kc2 = tid_ + 512;
  const u16* kg0 = kb + (size_t)(kc0 / 12) * 96 + (kc0 % 12) * 8;
  const u16* kg1 = kb + (size_t)(kc1 / 12) * 96 + (kc1 % 12) * 8;
  const u16* kg2 = kb + (size_t)(kc2 / 12) * 96 + (kc2 % 12) * 8;
  const u16* vg0 = vt + (size_t)(tid_ >> 3) * nkeys + (tid_ & 7) * 8;
  const u16* vg1 = vt + (size_t)((tid_ + 256) >> 3) * nkeys + (tid_ & 7) * 8;
  const int kl0 = (kc0 / 12) * KST + (kc0 % 12) * 8, kl1 = (kc1 / 12) * KST + (kc1 % 12) * 8, kl2 = (kc2 / 12) * KST + (kc2 % 12) * 8;
  const int vl0 = (tid_ >> 3) * VST + (tid_ & 7) * 8, vl1 = ((tid_ + 256) >> 3) * VST + (tid_ & 7) * 8;
#define AT_GLOAD(kt_) do { rk0 = *(const uint4*)(kg0 + (size_t)(kt_) * 6144); rk1 = *(const uint4*)(kg1 + (size_t)(kt_) * 6144); \
    rk2 = *(const uint4*)(kg2 + (size_t)(kt_) * 6144); rv0 = *(const uint4*)(vg0 + (kt_) * 64); rv1 = *(const uint4*)(vg1 + (kt_) * 64); } while (0)
#define AT_SSTORE(st_) do { u16* ks2_ = sm + (st_) * STG; u16* vs2_ = ks2_ + 64 * KST; \
    *(uint4*)(ks2_ + kl0) = rk0; *(uint4*)(ks2_ + kl1) = rk1; *(uint4*)(ks2_ + kl2) = rk2; *(uint4*)(vs2_ + vl0) = rv0; *(uint4*)(vs2_ + vl1) = rv1; } while (0)
  __syncthreads();
  AT_GLOAD(0); AT_SSTORE(0);
  __syncthreads();
  for (int kt = 0; kt < nkt; ++kt) {
    const bool more = kt + 1 < nkt;
    if (more) AT_GLOAD(kt + 1);
    const u16* ks_ = sm + (kt & 1) * STG;
    const u16* vs_ = ks_ + 64 * KST;
    f32x16 St[2];
#pragma unroll
    for (int sub = 0; sub < 2; ++sub) {
#pragma unroll
      for (int r = 0; r < 16; ++r) St[sub][r] = 0.f;
      const u16* kr = ks_ + (sub * 32 + n) * KST + h2 * 8;
#pragma unroll
      for (int ks = 0; ks < 6; ++ks) St[sub] = MFMA32(*(const bf16x8*)(kr + ks * 16), qf[ks], St[sub]);
    }
    float mx = St[0][0];
#pragma unroll
    for (int r = 0; r < 16; ++r) { mx = fmaxf(mx, St[0][r]); mx = fmaxf(mx, St[1][r]); }
    mx = fmaxf(mx, __shfl_xor(mx, 32));
    const float mnew = fmaxf(mrun, mx);
    const float alpha = exp2f(mrun - mnew);
    mrun = mnew;
    float ps = 0.f;
#pragma unroll
    for (int sub = 0; sub < 2; ++sub)
#pragma unroll
      for (int r = 0; r < 16; ++r) { float e = exp2f(St[sub][r] - mnew); St[sub][r] = e; ps += e; }
    lsum = lsum * alpha + ps;
#pragma unroll
    for (int r = 0; r < 16; ++r) { O[0][r] *= alpha; O[1][r] *= alpha; }
#pragma unroll
    for (int sub = 0; sub < 2; ++sub)
#pragma unroll
      for (int s = 0; s < 2; ++s) {
        const bf16x8 pb = pack_acc(St[sub], s);
#pragma unroll
        for (int dt = 0; dt < 2; ++dt)
          O[dt] = MFMA32(load_perm(vs_ + (dt * 32 + n) * VST + sub * 32, s, h2), pb, O[dt]);
      }
    if (more) AT_SSTORE((kt + 1) & 1);
    __syncthreads();
  }
  lsum += __shfl_xor(lsum, 32);
  const float inv = 1.f / lsum;
  u16* oc = (u16*)(p.ws + B_OC) + (size_t)(tq0 + n) * 512 + head * 64;
#pragma unroll
  for (int dt = 0; dt < 2; ++dt)
#pragma unroll
    for (int a = 0; a < 4; ++a) {
      const int dv = dt * 32 + 8 * a + 4 * h2;
      *(uint2*)(oc + dv) = make_uint2(pack2(O[dt][4 * a] * inv, O[dt][4 * a + 1] * inv), pack2(O[dt][4 * a + 2] * inv, O[dt][4 * a + 3] * inv));
    }
}

DI void delta_out_tile(const Params& p, int l, int tile) {
  const int lane = otid() & 63, w = otid() >> 6;
  const u16* of = (const u16*)(p.ws + B_OF);
  const u16* ob = (const u16*)(p.ws + B_OB);
  const u16* z = (const u16*)(p.ws + B_Z);
  u16* oa = (u16*)(p.ws + B_OA);
  const float g0 = p.in[17][l * 128 + 2 * lane], g1 = p.in[17][l * 128 + 2 * lane + 1];
#pragma unroll 1
  for (int q = 0; q < 16; ++q) {
    const size_t t = (size_t)tile * 16 + w * 4 + (q >> 2);
    const int hh = q & 3;
    const size_t off = t * 512 + hh * 128 + 2 * lane;
    unsigned a = *(const unsigned*)(of + off), b = *(const unsigned*)(ob + off), zz = *(const unsigned*)(z + off);
    float o0 = blo(a) + blo(b), o1 = bhi(a) + bhi(b);
    float ss = wave_sum(o0 * o0 + o1 * o1);
    float rstd = rsqrtf(ss * (1.f / 128.f) + 1e-6f);
    float y0 = o0 * rstd * g0 * siluf_(blo(zz)), y1 = o1 * rstd * g1 * siluf_(bhi(zz));
    *(unsigned*)(oa + off) = pack2(y0, y1);
  }
}

DI void grid_barrier(unsigned* bar, unsigned target) {
  asm volatile("s_waitcnt vmcnt(0) lgkmcnt(0)" ::: "memory");
  __syncthreads();
  if (otid() == 0) {
    __builtin_amdgcn_fence(__ATOMIC_RELEASE, "agent");
    asm volatile("s_waitcnt vmcnt(0)" ::: "memory");
    __hip_atomic_fetch_add(bar, 1u, __ATOMIC_RELAXED, __HIP_MEMORY_SCOPE_AGENT);
    while (__hip_atomic_load(bar, __ATOMIC_RELAXED, __HIP_MEMORY_SCOPE_AGENT) < target) __builtin_amdgcn_s_sleep(1);
    __builtin_amdgcn_fence(__ATOMIC_ACQUIRE, "agent");
    asm volatile("s_waitcnt vmcnt(0)" ::: "memory");
  }
  __syncthreads();
}
#define GSYNC() do { bar_target += gridDim.x; grid_barrier(p.bar, bar_target); } while (0)
#ifndef ONLY
#define PH(n) 1
#else
#define PH(n) ((n) == ONLY || (n) / 100 == ONLY || (n) == ONLY / 100)
#endif
__global__ void __launch_bounds__(256, 2) mega(Params p) {
  cg::grid_group grid = cg::this_grid();
  __shared__ __attribute__((aligned(16))) char smem_raw[73728];
  u16* sm = (u16*)smem_raw;
  float* smf = (float*)smem_raw;
  const int nb = gridDim.x, bid = blockIdx.x;
  unsigned bar_target = 0;
  grid.sync();

  if (PH(0)) {
    const int tid = otid();
    for (int j = bid; j < 4 * CJ8; j += nb) conv_job(p, j / CJ8, j % CJ8, smf);
    for (int j = bid; j < 4 * 96; j += nb) mods_tile(p, j / 96, j % 96, smf);
    for (int j = bid; j < 64; j += nb) s5pre_tile(p, j);
    {
      const float4* xp = (const float4*)p.in[0];
      const float4* xs = (const float4*)p.in[1];
      float4* o = (float4*)p.out;
      const size_t nP = (size_t)TP_ * 256, nT = (size_t)T_ * 256;
      for (size_t i = (size_t)bid * 256 + tid; i < nT; i += (size_t)nb * 256) o[i] = i < nP ? xp[i] : xs[i - nP];
    }
    {
      float* rope = (float*)(p.ws + B_ROPE);
      for (int i = bid * 256 + tid; i < 2048 * 16; i += nb * 256) {
        const int pos = i >> 4, f = i & 15;
        const float invf = 1.f / powf(10000.f, (float)(f & 7) * 0.125f);
        const float ang = (f < 8 ? (float)(pos >> 6) : (float)(pos & 63)) * invf;
        float sn, cs;
        sincosf(ang, &sn, &cs);
        rope[i * 2] = cs; rope[i * 2 + 1] = sn;
      }
    }
    {
      u16* cc = (u16*)(p.ws + B_CKVC);
      for (int i = bid * 256 + tid; i < 8 * 4 * 256 * 256 / 2; i += nb * 256) {
        const int e = i * 2;
        const int c = e & 255, pos = (e >> 8) & 255, l = (e >> 16) & 3, b = e >> 18;
        float2 v = *(const float2*)(p.in[5] + e);
        *(unsigned*)(cc + ((size_t)(l * 2048 + b * 256 + pos)) * 256 + c) = pack2(v.x, v.y);
      }
    }
  }
  GSYNC();

  for (int l = 0; l < 4; ++l) {
    const u16* WL = (const u16*)(p.ws + B_W) + (size_t)l * W_LAYER;
    const float* mods = (const float*)(p.ws + B_MODS);
    if (PH(1)) norm_phase(p, l, 0, 1, p.in[11] + l * 1024);
    GSYNC();
    if (PH(2)) gemm_in_phase(p, l, sm);
    GSYNC();
    if (PH(3)) {
      for (int j = bid; j < NCH; j += nb) delta_prep_tile(p, l, j, sm);
      for (int j = bid; j < T_ / 4; j += nb) mla_prep_tile(p, l, j);
      for (int j = bid; j < 256; j += nb) cache_rope_tile(p, l, j);
      for (int j = bid; j < NCH * 16; j += nb) s5_chunk_tile(p, l, j >> 4, j & 15, 0, sm);
    }
    GSYNC();
    if (PH(4)) {
      const int tid = otid();
      if (PH(400)) for (int j = bid; j < NCH * 2; j += nb) delta_local_tile(p, j, smf);
      if (PH(410)) for (int j = bid; j < 192 * 6; j += nb) {
          const int q = j, mt = q / 6, nt = q % 6;
          f32x4 acc[4][4];
          zero_acc<4>(acc);
          gemm_core<4>(acc, (const u16*)(p.ws + B_QA) + (size_t)mt * 128 * 384, 384, WL + W_QB + (size_t)nt * 128 * 384, 384, 384, sm);
          u16* qm = (u16*)(p.ws + B_QM);
          const float qs = 0.10206207261596575f * 1.4426950408889634f;
          const float* rope = (const float*)(p.ws + B_ROPE);
          const int e_lane = tid & 63, e_w = tid >> 6, e_wr = e_w >> 1, e_wc = e_w & 1, e_fr = e_lane & 15, e_fq = e_lane >> 4;
          const bool is_s = (mt * 128 >= TP_);
#pragma unroll
          for (int i = 0; i < 4; ++i) {
            const int row = mt * 128 + e_wr * 64 + i * 16 + e_fr;
            f32x4 vals[4];
#pragma unroll
            for (int jj = 0; jj < 4; ++jj) vals[jj] = acc[i][jj];
            if (is_s) {
              const int pos = (row - TP_) & 2047;
              const float4 cs0 = *(const float4*)(rope + (size_t)(pos * 16 + e_fq * 4) * 2);
              const float4 cs1 = *(const float4*)(rope + (size_t)(pos * 16 + e_fq * 4) * 2 + 4);
              const float cs[4] = {cs0.x, cs0.z, cs1.x, cs1.z}, sn[4] = {cs0.y, cs0.w, cs1.y, cs1.w};
#pragma unroll
              for (int jj = 0; jj < 4; jj += 2) {
                const int gt = (nt * 128 + e_wc * 64) / 16 + jj;
                if (gt % 6 == 4) {
#pragma unroll
                  for (int r = 0; r < 4; ++r) {
                    const float x1 = vals[jj][r], x2 = vals[jj + 1][r];
                    vals[jj][r] = x1 * cs[r] - x2 * sn[r];
                    vals[jj + 1][r] = x2 * cs[r] + x1 * sn[r];
                  }
                }
              }
            }
#pragma unroll
            for (int jj = 0; jj < 4; ++jj) {
              f32x4 o; o[0] = vals[jj][0] * qs; o[1] = vals[jj][1] * qs; o[2] = vals[jj][2] * qs; o[3] = vals[jj][3] * qs;
              *(uint2*)(qm + (size_t)row * 768 + nt * 128 + e_wc * 64 + jj * 16 + e_fq * 4) = pack4(o);
            }
          }
      }
      if (PH(420)) for (int j = bid; j < 208 * 8; j += nb) {
          const int q = j, mt = q >> 3, head = q & 7;
          f32x4 acc[4][4];
          zero_acc<4>(acc);
          const u16* A = mt < 192 ? (const u16*)(p.ws + B_KVA) + (size_t)mt * 128 * 256
                                  : (const u16*)(p.ws + B_CKVC) + ((size_t)l * 2048 + (size_t)(mt - 192) * 128) * 256;
          gemm_core<4, false>(acc, A, 256, WL + W_KVB + (size_t)head * 128 * 256, 256, 256, sm);
          int key0, nkeys; size_t kbo, vto;
          if (mt < 64) { const int seq = mt >> 1; key0 = (mt & 1) * 128; nkeys = 256; kbo = (size_t)(seq * 8 + head) * 256 * 96; vto = (size_t)(seq * 8 + head) * 64 * 256; }
          else if (mt < 192) { const int s = (mt - 64) >> 4; key0 = 256 + ((mt - 64) & 15) * 128; nkeys = 2304; kbo = KB_P + (size_t)(s * 8 + head) * 2304 * 96; vto = VT_P + (size_t)(s * 8 + head) * 64 * 2304; }
          else { const int s = (mt - 192) >> 1; key0 = ((mt - 192) & 1) * 128; nkeys = 2304; kbo = KB_P + (size_t)(s * 8 + head) * 2304 * 96; vto = VT_P + (size_t)(s * 8 + head) * 64 * 2304; }
          u16* kb = (u16*)(p.ws + B_KB) + kbo;
          u16* vt = (u16*)(p.ws + B_VT) + vto;
          const int e_lane = tid & 63, e_w = tid >> 6, e_wr = e_w >> 1, e_wc = e_w & 1, e_fr = e_lane & 15, e_fq = e_lane >> 4;
#pragma unroll
          for (int i = 0; i < 4; ++i)
#pragma unroll
            for (int jj = 0; jj < 4; ++jj) {
              const int key = key0 + e_wr * 64 + i * 16 + e_fq * 4;
              const int c = jj * 16 + e_fr;
              if (e_wc == 0) {
#pragma unroll
                for (int r = 0; r < 4; ++r) kb[(size_t)(key + r) * 96 + c] = f2bf(acc[i][jj][r]);
              } else {
                *(uint2*)(vt + (size_t)c * nkeys + key) = make_uint2(pack2(acc[i][jj][0], acc[i][jj][1]), pack2(acc[i][jj][2], acc[i][jj][3]));
              }
            }
      }
      if (PH(430)) for (int j = bid; j < 640; j += nb) s5_carry_tile(p, l, j);
    }
    GSYNC();
    if (PH(5)) {
      if (PH(500)) for (int j = bid; j < 320; j += nb) delta_scan_tile(p, l, j, sm);
      if (PH(510)) for (int j = bid; j < 1536; j += nb) {
        if (j < 1024) attn_tile(p, 32 + (j >> 7), (j >> 4) & 7, j & 15, sm);
        else { const int q = j - 1024; attn_tile(p, q >> 4, (q >> 1) & 7, q & 1, sm); }
      }
      if (PH(530)) for (int j = bid; j < NCH * 8; j += nb) {
        s5_chunk_tile(p, l, j >> 3, (j & 7) * 2, 1, sm);
        s5_chunk_tile(p, l, j >> 3, (j & 7) * 2 + 1, 1, sm);
      }
    }
    GSYNC();
    if (PH(6)) {
      for (int j = bid; j < T_ / 16; j += nb) delta_out_tile(p, l, j);
      for (int j = bid; j < 192 * 4; j += nb) {
        {
          const int q = j, mt = q >> 2, nt = q & 3;
          f32x4 acc[4][4];
          zero_acc<4>(acc);
          const u16* y5 = (const u16*)(p.ws + B_Y5);
          gemm_core<4>(acc, y5 + (size_t)mt * 128 * 512, 512, WL + W_GLU + (size_t)nt * 128 * 512, 512, 512, sm);
          u16* ob5 = (u16*)(p.ws + B_OB5);
          const float* bgl = p.in[27] + l * 512;
          EPI_LOOP(4) {
            const size_t row = mt * 128 + EROW; const int col = nt * 128 + ECOL4(4);
            const uint2 yy = *(const uint2*)(y5 + row * 512 + col);
            const float4 bb = *(const float4*)(bgl + col);
            f32x4 o;
            o[0] = blo(yy.x) * sigmoidf_(acc[i][j][0] + bb.x); o[1] = bhi(yy.x) * sigmoidf_(acc[i][j][1] + bb.y);
            o[2] = blo(yy.y) * sigmoidf_(acc[i][j][2] + bb.z); o[3] = bhi(yy.y) * sigmoidf_(acc[i][j][3] + bb.w);
            *(uint2*)(ob5 + row * 512 + col) = pack4(o);
          }
        }
      }
    }
    GSYNC();
    if (PH(7)) {
      const u16* H = (const u16*)(p.ws + B_H);
      u16* mg = (u16*)(p.ws + B_MG);
      for (int j = bid; j < 192 * 16; j += nb) {
        const int mt = j >> 4, nt = j & 15;
        f32x4 mer[4][2];
        zero_acc<2>(mer);
#pragma unroll 1
        for (int n = 0; n < 3; ++n) {
          f32x4 ag[4][2], ab[4][2];
          zero_acc<2>(ag);
          gemm_core<2>(ag, H + (size_t)mt * 128 * 1024, 1024, WL + W_G + (size_t)(n * 1024 + nt * 64) * 1024, 1024, 1024, sm);
          zero_acc<2>(ab);
          const u16* on = (const u16*)(p.ws + (n == 0 ? B_OA : (n == 1 ? B_OB5 : B_OC)));
          gemm_core<2>(ab, on + (size_t)mt * 128 * 512, 512, WL + W_BR + (size_t)(nt * 64) * 1536 + n * 512, 1536, 512, sm);
#pragma unroll
          for (int i = 0; i < 4; ++i)
#pragma unroll
            for (int jj = 0; jj < 2; ++jj)
#pragma unroll
              for (int r = 0; r < 4; ++r) mer[i][jj][r] += sigmoidf_(ag[i][jj][r]) * ab[i][jj][r];
        }
        EPI_LOOP(2) { *(uint2*)(mg + (size_t)(mt * 128 + EROW) * 1024 + nt * 64 + ECOL4(2)) = pack4(mer[i][j]); }
      }
    }
    GSYNC();
    if (PH(8)) {
      const u16* mg = (const u16*)(p.ws + B_MG);
      for (int j = bid; j < 192 * 8; j += nb) {
        const int mt = j >> 3, nt = j & 7;
        f32x4 acc[4][4];
        zero_acc<4>(acc);
        gemm_core<4>(acc, mg + (size_t)mt * 128 * 1024, 1024, WL + W_OUT + (size_t)nt * 128 * 1024, 1024, 1024, sm);
        const float* gm = mods + (size_t)(l * 9 + tok_v(mt * 128)) * 6144 + 2 * 1024;
        EPI_LOOP(4) {
          const size_t row = mt * 128 + EROW; const int col = nt * 128 + ECOL4(4);
          float4* xp_ = (float4*)(p.out + row * 1024 + col);
          float4 xv = *xp_; const float4 gg = *(const float4*)(gm + col);
          xv.x += gg.x * acc[i][j][0]; xv.y += gg.y * acc[i][j][1]; xv.z += gg.z * acc[i][j][2]; xv.w += gg.w * acc[i][j][3];
          *xp_ = xv;
        }
      }
    }
    GSYNC();
    if (PH(9)) norm_phase(p, l, 3, 4, p.in[12] + l * 1024);
    GSYNC();
    if (PH(10)) {
      const u16* H = (const u16*)(p.ws + B_H);
      u16* up = (u16*)(p.ws + B_UP);
      for (int j = bid; j < 192 * 44; j += nb) {
        const int mt = j / 44, nt = j % 44;
        f32x4 acc[4][4];
        zero_acc<4>(acc);
        gemm_core<4>(acc, H + (size_t)mt * 128 * 1024, 1024, WL + W_UP + (size_t)nt * 128 * 1024, 1024, 1024, sm);
        EPI_LOOP(4) { *(uint2*)(up + (size_t)(mt * 128 + EROW) * 5632 + nt * 128 + ECOL4(4)) = pack4(acc[i][j]); }
      }
    }
    GSYNC();
    if (PH(11)) {
      const int tid = otid();
      const u16* up = (const u16*)(p.ws + B_UP);
      u16* act = (u16*)(p.ws + B_ACT);
      const float* cw = p.in[35] + (size_t)l * 3 * 5632;
      const float* cb = p.in[36] + (size_t)l * 5632;
      for (int it = bid * 256 + tid; it < (T_ / 2) * 352; it += nb * 256) {
        const int t = (it / 352) * 2, c8 = (it % 352) * 8;
        int pos, L;
        if (t < TP_) { pos = t & 255; L = 256; } else { pos = (t - TP_) & 2047; L = 2048; }
        float wg[3][8], wv[3][8], bgv[8], bvv[8];
#pragma unroll
        for (int d = 0; d < 3; ++d) {
          const float4 g0 = *(const float4*)(cw + d * 5632 + c8), g1 = *(const float4*)(cw + d * 5632 + c8 + 4);
          const float4 v0 = *(const float4*)(cw + d * 5632 + 2816 + c8), v1 = *(const float4*)(cw + d * 5632 + 2816 + c8 + 4);
          wg[d][0] = g0.x; wg[d][1] = g0.y; wg[d][2] = g0.z; wg[d][3] = g0.w; wg[d][4] = g1.x; wg[d][5] = g1.y; wg[d][6] = g1.z; wg[d][7] = g1.w;
          wv[d][0] = v0.x; wv[d][1] = v0.y; wv[d][2] = v0.z; wv[d][3] = v0.w; wv[d][4] = v1.x; wv[d][5] = v1.y; wv[d][6] = v1.z; wv[d][7] = v1.w;
        }
        {
          const float4 g0 = *(const float4*)(cb + c8), g1 = *(const float4*)(cb + c8 + 4);
          const float4 v0 = *(const float4*)(cb + 2816 + c8), v1 = *(const float4*)(cb + 2816 + c8 + 4);
          bgv[0] = g0.x; bgv[1] = g0.y; bgv[2] = g0.z; bgv[3] = g0.w; bgv[4] = g1.x; bgv[5] = g1.y; bgv[6] = g1.z; bgv[7] = g1.w;
          bvv[0] = v0.x; bvv[1] = v0.y; bvv[2] = v0.z; bvv[3] = v0.w; bvv[4] = v1.x; bvv[5] = v1.y; bvv[6] = v1.z; bvv[7] = v1.w;
        }
        float rg[4][8], rv[4][8];
#pragma unroll
        for (int q = 0; q < 4; ++q) {
          const int ps = pos + q - 1;
          uint4 ug = make_uint4(0, 0, 0, 0), uv = ug;
          if (ps >= 0 && ps < L) {
            const u16* rowp = up + (size_t)(t + q - 1) * 5632;
            ug = *(const uint4*)(rowp + c8); uv = *(const uint4*)(rowp + 2816 + c8);
          }
          rg[q][0] = blo(ug.x); rg[q][1] = bhi(ug.x); rg[q][2] = blo(ug.y); rg[q][3] = bhi(ug.y); rg[q][4] = blo(ug.z); rg[q][5] = bhi(ug.z); rg[q][6] = blo(ug.w); rg[q][7] = bhi(ug.w);
          rv[q][0] = blo(uv.x); rv[q][1] = bhi(uv.x); rv[q][2] = blo(uv.y); rv[q][3] = bhi(uv.y); rv[q][4] = blo(uv.z); rv[q][5] = bhi(uv.z); rv[q][6] = blo(uv.w); rv[q][7] = bhi(uv.w);
        }
#pragma unroll
        for (int o = 0; o < 2; ++o) {
          float res[8];
#pragma unroll
          for (int e = 0; e < 8; ++e) {
            float g = bgv[e], v = bvv[e];
#pragma unroll
            for (int d = 0; d < 3; ++d) { g += wg[d][e] * rg[o + d][e]; v += wv[d][e] * rv[o + d][e]; }
            res[e] = siluf_(g) * v;
          }
          *(uint4*)(act + (size_t)(t + o) * 2816 + c8) = make_uint4(pack2(res[0], res[1]), pack2(res[2], res[3]), pack2(res[4], res[5]), pack2(res[6], res[7]));
        }
      }
    }
    GSYNC();
    if (PH(12)) {
      const u16* act = (const u16*)(p.ws + B_ACT);
      for (int j = bid; j < 192 * 8; j += nb) {
        const int mt = j >> 3, nt = j & 7;
        f32x4 acc[4][4];
        zero_acc<4>(acc);
        gemm_core<4>(acc, act + (size_t)mt * 128 * 2816, 2816, WL + W_DN + (size_t)nt * 128 * 2816, 2816, 2816, sm);
        const float* gf = mods + (size_t)(l * 9 + tok_v(mt * 128)) * 6144 + 5 * 1024;
        EPI_LOOP(4) {
          const size_t row = mt * 128 + EROW; const int col = nt * 128 + ECOL4(4);
          float4* xp_ = (float4*)(p.out + row * 1024 + col);
          float4 xv = *xp_; const float4 gg = *(const float4*)(gf + col);
          xv.x += gg.x * acc[i][j][0]; xv.y += gg.y * acc[i][j][1]; xv.z += gg.z * acc[i][j][2]; xv.w += gg.w * acc[i][j][3];
          *xp_ = xv;
        }
      }
    }
    GSYNC();
  }
  if (PH(13)) {
    const int tid = otid();
    const int lane = tid & 63, w = tid >> 6;
    const float* gfin = p.in[38];
    for (int tile = bid; tile < T_ / 4; tile += nb) {
      const int t = tile * 4 + w;
      float4* xr = (float4*)(p.out + (size_t)t * 1024);
      float4 v[4];
      float ss = 0.f;
#pragma unroll
      for (int j = 0; j < 4; ++j) { v[j] = xr[lane + 64 * j]; ss += v[j].x * v[j].x + v[j].y * v[j].y + v[j].z * v[j].z + v[j].w * v[j].w; }
      ss = wave_sum(ss);
      const float rstd = rsqrtf(ss * (1.f / 1024.f) + 1e-6f);
#pragma unroll
      for (int j = 0; j < 4; ++j) {
        float4 g = *(const float4*)(gfin + (lane + 64 * j) * 4);
        xr[lane + 64 * j] = make_float4(v[j].x * rstd * g.x, v[j].y * rstd * g.y, v[j].z * rstd * g.z, v[j].w * rstd * g.w);
      }
    }
  }
}

extern "C" void kernel_launch(void* const* d_in, const int* in_sizes, int n_in, void* d_out, int out_size,
                              void* d_ws, size_t ws_size, hipStream_t stream) {
  static int grid_blocks = 0;
  if (!grid_blocks) {
    int dev = 0, cus = 0, per_cu = 0;
    (void)hipGetDevice(&dev);
    (void)hipDeviceGetAttribute(&cus, hipDeviceAttributeMultiprocessorCount, dev);
    (void)hipOccupancyMaxActiveBlocksPerMultiprocessor(&per_cu, mega, 256, 0);
    if (per_cu > 2) per_cu = 2;
    if (per_cu < 1) per_cu = 1;
    grid_blocks = cus * per_cu;
  }
  if (ws_size < B_TOTAL || n_in < 39) {
    fprintf(stderr, "workspace too small: %zu < %zu\n", ws_size, (size_t)B_END);
    return;
  }
  Params p{};
  for (int i = 0; i < 39; ++i) p.in[i] = (const float*)d_in[i];
  p.out = (float*)d_out;
  p.ws = (char*)d_ws;
  p.bar = (unsigned*)((char*)d_ws + B_BAR);
  (void)hipMemsetAsync(p.bar, 0, 256, stream);
  void* args[] = {&p};
  hipError_t e = hipLaunchCooperativeKernel((void*)mega, dim3(grid_blocks), dim3(256), args, 0, stream);
  if (e != hipSuccess) fprintf(stderr, "cooperative launch failed: %s (grid %d)\n", hipGetErrorString(e), grid_blocks);
}
```

```cpp
#include <hip/hip_runtime.h>
#include <hip/hip_cooperative_groups.h>
#include <cstdio>
namespace cg = cooperative_groups;

#define DI __device__ __forceinline__
typedef __bf16 bf16;
using bf16x8 = __attribute__((ext_vector_type(8))) short;
using f32x4 = __attribute__((ext_vector_type(4))) float;
using f32x16 = __attribute__((ext_vector_type(16))) float;
typedef unsigned short u16;

constexpr int T_ = 24576, TP_ = 8192;
constexpr int NCH = 384;
constexpr long long O_SD = 25165824LL, O_S5RE = 41943040LL, O_S5IM = 42467328LL, O_CKV = 42991616LL, O_KR = 51380224LL;

constexpr size_t W_IN = 0;
constexpr size_t W_G = W_IN + 3328ull * 1024;
constexpr size_t W_QB = W_G + 3072ull * 1024;
constexpr size_t W_KVB = W_QB + 768ull * 384;
constexpr size_t W_GLU = W_KVB + 1024ull * 256;
constexpr size_t W_BR = W_GLU + 512ull * 512;
constexpr size_t W_OUT = W_BR + 1024ull * 1536;
constexpr size_t W_UP = W_OUT + 1024ull * 1024;
constexpr size_t W_DN = W_UP + 5632ull * 1024;
constexpr size_t W_LAYER = W_DN + 1024ull * 2816;

constexpr size_t al(size_t x) { return (x + 255) & ~(size_t)255; }
constexpr size_t B_W = 0;
constexpr size_t B_MODS = al(B_W + 4 * W_LAYER * 2);
constexpr size_t B_ROPE = al(B_MODS + 4ull * 9 * 6144 * 4);
constexpr size_t B_LAMB = al(B_ROPE + 2048ull * 32 * 4);
constexpr size_t B_LAM64 = al(B_LAMB + 4ull * 2 * 32 * 64 * 8);
constexpr size_t B_BBT = al(B_LAM64 + 4ull * 2 * 32 * 64 * 8);
constexpr size_t B_CMT = al(B_BBT + 4ull * 2 * 32 * 128 * 16 * 2);
constexpr size_t B_CKVC = al(B_CMT + 4ull * 32 * 16 * 128 * 2);
constexpr size_t B_H = al(B_CKVC + 4ull * 2048 * 256 * 2);
constexpr size_t B_QKV = al(B_H + (size_t)T_ * 1024 * 2);
constexpr size_t B_Z = al(B_QKV + (size_t)T_ * 1536 * 2);
constexpr size_t B_US5 = al(B_Z + (size_t)T_ * 512 * 2);
constexpr size_t B_QA = al(B_US5 + (size_t)T_ * 512 * 2);
constexpr size_t B_KVA = al(B_QA + (size_t)T_ * 384 * 2);
constexpr size_t B_MISC = al(B_KVA + (size_t)T_ * 256 * 2);
constexpr size_t B_QN = al(B_MISC + (size_t)T_ * 48 * 4);
constexpr size_t B_KN = al(B_QN + (size_t)T_ * 512 * 2);
constexpr size_t B_VV = al(B_KN + (size_t)T_ * 512 * 2);
constexpr size_t B_KT = al(B_VV + (size_t)T_ * 512 * 2);
constexpr size_t B_BG = al(B_KT + (size_t)T_ * 512 * 2);
constexpr size_t B_TM = al(B_BG + (size_t)T_ * 16 * 4);
constexpr size_t B_QKM = al(B_TM + (size_t)T_ * 512 * 2);
constexpr size_t B_GC = al(B_QKM + (size_t)T_ * 512 * 2);
constexpr size_t B_BC = al(B_GC + (size_t)NCH * 4 * 2 * 64 * 4);
constexpr size_t KB_P = 32ull * 8 * 256 * 96, KB_S = 8ull * 8 * 2304 * 96;
constexpr size_t VT_P = 32ull * 8 * 64 * 256, VT_S = 8ull * 8 * 64 * 2304;
constexpr size_t B_KB = al(B_BC + (size_t)NCH * 4 * 2 * 64 * 4);
constexpr size_t B_VT = al(B_KB + (KB_P + KB_S) * 2);
constexpr size_t B_QM = al(B_VT + (VT_P + VT_S) * 2);
constexpr size_t B_HEND = al(B_QM + (size_t)T_ * 768 * 2);
constexpr size_t B_HIN = al(B_HEND + (size_t)NCH * 32 * 2 * 64 * 8);
constexpr size_t B_Y5 = al(B_HIN + (size_t)NCH * 32 * 2 * 64 * 8);
constexpr size_t B_OC = al(B_Y5 + (size_t)T_ * 512 * 2);
constexpr size_t B_END = al(B_OC + (size_t)T_ * 512 * 2);
constexpr size_t B_OF = B_QKV;
constexpr size_t B_OB = B_QKV + (size_t)T_ * 512 * 2;
constexpr size_t B_MG = B_QKV;
constexpr size_t B_OA = B_QN;
constexpr size_t B_OB5 = B_KN;
constexpr size_t B_UP = B_QKV;
constexpr size_t B_ACT = B_KB;
static_assert(B_UP + (size_t)T_ * 5632 * 2 <= B_KB, "UP overlaps ACT");
static_assert(B_ACT + (size_t)T_ * 2816 * 2 <= B_END, "ACT too big");
constexpr size_t B_BAR = B_END;
constexpr size_t B_TOTAL = B_BAR + 256;
static_assert(B_TOTAL <= 768ull * 1024 * 1024, "workspace too big");

struct Params {
  const float* in[39];
  float* out;
  char* ws;
  unsigned* bar;
};

DI int otid() { int t = (int)__builtin_amdgcn_workitem_id_x(); asm volatile("" : "+v"(t)); return t; }
DI unsigned pack2(float a, float b) {
  typedef __attribute__((ext_vector_type(2))) __bf16 bf2;
  bf2 v; v[0] = (__bf16)a; v[1] = (__bf16)b;
  return __builtin_bit_cast(unsigned, v);
}
DI u16 f2bf(float a) { return (u16)(pack2(a, 0.f) & 0xffffu); }
DI float bf2f(u16 u) { return __uint_as_float(((unsigned)u) << 16); }
DI float blo(unsigned u) { return __uint_as_float(u << 16); }
DI float bhi(unsigned u) { return __uint_as_float(u & 0xffff0000u); }
DI float wave_sum(float v) {
#pragma unroll
  for (int o = 32; o > 0; o >>= 1) v += __shfl_xor(v, o);
  return v;
}
DI float sigmoidf_(float x) { return 1.f / (1.f + __expf(-x)); }
DI float siluf_(float x) { return x / (1.f + __expf(-x)); }
DI int tok_v(int t) { return t < TP_ ? 0 : 1 + ((t - TP_) >> 11); }
DI int crow(int r, int h2) { return (r & 3) + 8 * (r >> 2) + 4 * h2; }
DI bf16x8 mk8(unsigned a, unsigned b, unsigned c, unsigned d) {
  uint4 p = make_uint4(a, b, c, d);
  return __builtin_bit_cast(bf16x8, p);
}
DI bf16x8 pack_acc(const f32x16& x, int s) {
  return mk8(pack2(x[8 * s], x[8 * s + 1]), pack2(x[8 * s + 2], x[8 * s + 3]), pack2(x[8 * s + 4], x[8 * s + 5]),
             pack2(x[8 * s + 6], x[8 * s + 7]));
}
DI bf16x8 load_perm(const u16* rowptr, int s, int h2) {
  uint2 a = *(const uint2*)(rowptr + 16 * s + 4 * h2);
  uint2 b = *(const uint2*)(rowptr + 16 * s + 8 + 4 * h2);
  return mk8(a.x, a.y, b.x, b.y);
}
DI unsigned swap16(unsigned u) { return (u >> 16) | (u << 16); }
DI bf16x8 load_perm_rev(const u16* rowptr, int base, int s, int h2) {
  uint2 a = *(const uint2*)(rowptr + 60 - base - 16 * s - 4 * h2);
  uint2 b = *(const uint2*)(rowptr + 52 - base - 16 * s - 4 * h2);
  return mk8(swap16(a.y), swap16(a.x), swap16(b.y), swap16(b.x));
}
#define MFMA16(a, b, c) __builtin_amdgcn_mfma_f32_16x16x32_bf16((a), (b), (c), 0, 0, 0)
#define MFMA32(a, b, c) __builtin_amdgcn_mfma_f32_32x32x16_bf16((a), (b), (c), 0, 0, 0)

template <int NJ, bool SWAP = true>
DI void gemm_core(f32x4 (&acc)[4][NJ], const u16* __restrict__ A, int lda, const u16* __restrict__ B, int ldb, int K,
                  u16* sm) {
  const int tid = otid(), lane = tid & 63, w = tid >> 6, wr = w >> 1, wc = w & 1;
  const int fr = lane & 15, fq = lane >> 4;
  constexpr int RS = 136;
  const int lrow = tid >> 4, lkc = tid & 15;
  uint4 a0, a1, a2, a3, a4, a5, a6, a7, b0, b1, b2, b3, b4, b5, b6, b7;
  b4 = b5 = b6 = b7 = make_uint4(0, 0, 0, 0);
  const u16* ap = A + (size_t)lrow * lda + lkc * 8;
  const u16* bp = B + (size_t)lrow * ldb + lkc * 8;
  const int nk = K >> 7;
  u16* as = sm;
  u16* bs = sm + 128 * RS;
  {
    const int k0 = 0;
    a0 = *(const uint4*)(ap + (size_t)(0 * 16) * lda + k0);
    a1 = *(const uint4*)(ap + (size_t)(1 * 16) * lda + k0);
    a2 = *(const uint4*)(ap + (size_t)(2 * 16) * lda + k0);
    a3 = *(const uint4*)(ap + (size_t)(3 * 16) * lda + k0);
    a4 = *(const uint4*)(ap + (size_t)(4 * 16) * lda + k0);
    a5 = *(const uint4*)(ap + (size_t)(5 * 16) * lda + k0);
    a6 = *(const uint4*)(ap + (size_t)(6 * 16) * lda + k0);
    a7 = *(const uint4*)(ap + (size_t)(7 * 16) * lda + k0);
    b0 = *(const uint4*)(bp + (size_t)(0 * 16) * ldb + k0);
    b1 = *(const uint4*)(bp + (size_t)(1 * 16) * ldb + k0);
    b2 = *(const uint4*)(bp + (size_t)(2 * 16) * ldb + k0);
    b3 = *(const uint4*)(bp + (size_t)(3 * 16) * ldb + k0);
    if (NJ == 4) b4 = *(const uint4*)(bp + (size_t)(4 * 16) * ldb + k0);
    if (NJ == 4) b5 = *(const uint4*)(bp + (size_t)(5 * 16) * ldb + k0);
    if (NJ == 4) b6 = *(const uint4*)(bp + (size_t)(6 * 16) * ldb + k0);
    if (NJ == 4) b7 = *(const uint4*)(bp + (size_t)(7 * 16) * ldb + k0);
  }
  for (int kt = 0; kt < nk; ++kt) {
    __syncthreads();
    *(uint4*)(as + (lrow + 0 * 16) * RS + lkc * 8) = a0;
    *(uint4*)(as + (lrow + 1 * 16) * RS + lkc * 8) = a1;
    *(uint4*)(as + (lrow + 2 * 16) * RS + lkc * 8) = a2;
    *(uint4*)(as + (lrow + 3 * 16) * RS + lkc * 8) = a3;
    *(uint4*)(as + (lrow + 4 * 16) * RS + lkc * 8) = a4;
    *(uint4*)(as + (lrow + 5 * 16) * RS + lkc * 8) = a5;
    *(uint4*)(as + (lrow + 6 * 16) * RS + lkc * 8) = a6;
    *(uint4*)(as + (lrow + 7 * 16) * RS + lkc * 8) = a7;
    *(uint4*)(bs + (lrow + 0 * 16) * RS + lkc * 8) = b0;
    *(uint4*)(bs + (lrow + 1 * 16) * RS + lkc * 8) = b1;
    *(uint4*)(bs + (lrow + 2 * 16) * RS + lkc * 8) = b2;
    *(uint4*)(bs + (lrow + 3 * 16) * RS + lkc * 8) = b3;
    if (NJ == 4) *(uint4*)(bs + (lrow + 4 * 16) * RS + lkc * 8) = b4;
    if (NJ == 4) *(uint4*)(bs + (lrow + 5 * 16) * RS + lkc * 8) = b5;
    if (NJ == 4) *(uint4*)(bs + (lrow + 6 * 16) * RS + lkc * 8) = b6;
    if (NJ == 4) *(uint4*)(bs + (lrow + 7 * 16) * RS + lkc * 8) = b7;
    __syncthreads();
    {
      const int k0 = (kt + 1 < nk ? kt + 1 : kt) * 128;
    a0 = *(const uint4*)(ap + (size_t)(0 * 16) * lda + k0);
    a1 = *(const uint4*)(ap + (size_t)(1 * 16) * lda + k0);
    a2 = *(const uint4*)(ap + (size_t)(2 * 16) * lda + k0);
    a3 = *(const uint4*)(ap + (size_t)(3 * 16) * lda + k0);
    a4 = *(const uint4*)(ap + (size_t)(4 * 16) * lda + k0);
    a5 = *(const uint4*)(ap + (size_t)(5 * 16) * lda + k0);
    a6 = *(const uint4*)(ap + (size_t)(6 * 16) * lda + k0);
    a7 = *(const uint4*)(ap + (size_t)(7 * 16) * lda + k0);
    b0 = *(const uint4*)(bp + (size_t)(0 * 16) * ldb + k0);
    b1 = *(const uint4*)(bp + (size_t)(1 * 16) * ldb + k0);
    b2 = *(const uint4*)(bp + (size_t)(2 * 16) * ldb + k0);
    b3 = *(const uint4*)(bp + (size_t)(3 * 16) * ldb + k0);
    if (NJ == 4) b4 = *(const uint4*)(bp + (size_t)(4 * 16) * ldb + k0);
    if (NJ == 4) b5 = *(const uint4*)(bp + (size_t)(5 * 16) * ldb + k0);
    if (NJ == 4) b6 = *(const uint4*)(bp + (size_t)(6 * 16) * ldb + k0);
    if (NJ == 4) b7 = *(const uint4*)(bp + (size_t)(7 * 16) * ldb + k0);
    }
    __builtin_amdgcn_s_setprio(1);
#pragma unroll
    for (int ks = 0; ks < 4; ++ks) {
      bf16x8 af[4], bfr[NJ];
#pragma unroll
      for (int i = 0; i < 4; ++i) af[i] = *(const bf16x8*)(as + (wr * 64 + i * 16 + fr) * RS + ks * 32 + fq * 8);
#pragma unroll
      for (int j = 0; j < NJ; ++j) bfr[j] = *(const bf16x8*)(bs + (wc * NJ * 16 + j * 16 + fr) * RS + ks * 32 + fq * 8);
#pragma unroll
      for (int i = 0; i < 4; ++i)
#pragma unroll
        for (int j = 0; j < NJ; ++j) acc[i][j] = SWAP ? MFMA16(bfr[j], af[i], acc[i][j]) : MFMA16(af[i], bfr[j], acc[i][j]);
    }
    __builtin_amdgcn_s_setprio(0);
  }
}
template <int NJ>
DI void zero_acc(f32x4 (&acc)[4][NJ]) {
#pragma unroll
  for (int i = 0; i < 4; ++i)
#pragma unroll
    for (int j = 0; j < NJ; ++j) acc[i][j] = f32x4{0.f, 0.f, 0.f, 0.f};
}
#define EPI_LOOP(NJ_)                                                              \
  const int e_lane = otid() & 63, e_w = otid() >> 6;                               \
  const int e_wr = e_w >> 1, e_wc = e_w & 1, e_fr = e_lane & 15, e_fq = e_lane >> 4; \
  _Pragma("unroll") for (int i = 0; i < 4; ++i)                                    \
  _Pragma("unroll") for (int j = 0; j < NJ_; ++j)
#define EROW (e_wr * 64 + i * 16 + e_fr)
#define ECOL4(NJ_) (e_wc * NJ_ * 16 + j * 16 + e_fq * 4)
DI uint2 pack4(const f32x4& v) { return make_uint2(pack2(v[0], v[1]), pack2(v[2], v[3])); }

DI int colmap(int kind, int n) {
  if (kind == 0) {
    if (n < 2048) return n;
    if (n < 2560) return 2064 + (n - 2048);
    if (n < 2944) return 2576 + (n - 2560);
    if (n < 3200) return 2960 + (n - 2944);
    int j = n - 3200;
    if (j < 16) return 2048 + j;
    if (j < 48) return 3216 + (j - 16);
    return -1;
  }
  if (kind == 1) return 3248 + n;
  return n;
}
DI void convT_tile(const float* __restrict__ src, int lds, int K, u16* __restrict__ dst, int kind, int kt, int nt,
                   float* sm) {
  const int tid = otid();
  const int c = tid & 63;
  const int sc = colmap(kind, nt * 64 + c);
  __syncthreads();
#pragma unroll 4
  for (int i = 0; i < 16; ++i) {
    int r = (tid >> 6) + i * 4;
    float v = sc >= 0 ? src[(size_t)(kt * 64 + r) * lds + sc] : 0.f;
    sm[r * 65 + c] = v;
  }
  __syncthreads();
  const int n = tid >> 2, kq = tid & 3;
  unsigned pk[8];
#pragma unroll
  for (int j = 0; j < 8; ++j) pk[j] = pack2(sm[(kq * 16 + 2 * j) * 65 + n], sm[(kq * 16 + 2 * j + 1) * 65 + n]);
  u16* d = dst + (size_t)(nt * 64 + n) * K + kt * 64 + kq * 16;
  *(uint4*)d = make_uint4(pk[0], pk[1], pk[2], pk[3]);
  *(uint4*)(d + 8) = make_uint4(pk[4], pk[5], pk[6], pk[7]);
}
constexpr int CJ0 = 16 * 52, CJ1 = CJ0 + 16 * 48, CJ2 = CJ1 + 6 * 12, CJ3 = CJ2 + 4 * 16, CJ4 = CJ3 + 8 * 8,
              CJ5 = CJ4 + 24 * 16, CJ6 = CJ5 + 16 * 16, CJ7 = CJ6 + 16 * 88, CJ8 = CJ7 + 44 * 16;
DI void conv_job(const Params& p, int l, int j, float* sm) {
  u16* wl = (u16*)(p.ws + B_W) + (size_t)l * W_LAYER;
  if (j < CJ0) { convT_tile(p.in[13] + (size_t)l * 1024 * 6320, 6320, 1024, wl + W_IN, 0, j / 52, j % 52, sm); return; }
  if (j < CJ1) { j -= CJ0; convT_tile(p.in[13] + (size_t)l * 1024 * 6320, 6320, 1024, wl + W_G, 1, j / 48, j % 48, sm); return; }
  if (j < CJ2) { j -= CJ1; convT_tile(p.in[29] + (size_t)l * 384 * 768, 768, 384, wl + W_QB, 2, j / 12, j % 12, sm); return; }
  if (j < CJ3) { j -= CJ2; convT_tile(p.in[31] + (size_t)l * 256 * 1024, 1024, 256, wl + W_KVB, 2, j / 16, j % 16, sm); return; }
  if (j < CJ4) { j -= CJ3; convT_tile(p.in[26] + (size_t)l * 512 * 512, 512, 512, wl + W_GLU, 2, j / 8, j % 8, sm); return; }
  if (j < CJ5) { j -= CJ4; convT_tile(p.in[32] + (size_t)l * 1536 * 1024, 1024, 1536, wl + W_BR, 2, j / 16, j % 16, sm); return; }
  if (j < CJ6) { j -= CJ5; convT_tile(p.in[33] + (size_t)l * 1024 * 1024, 1024, 1024, wl + W_OUT, 2, j / 16, j % 16, sm); return; }
  if (j < CJ7) { j -= CJ6; convT_tile(p.in[34] + (size_t)l * 1024 * 5632, 5632, 1024, wl + W_UP, 2, j / 88, j % 88, sm); return; }
  j -= CJ7; convT_tile(p.in[37] + (size_t)l * 2816 * 1024, 1024, 2816, wl + W_DN, 2, j / 16, j % 16, sm);
}
DI void mods_tile(const Params& p, int l, int jg, float* sm) {
  const int tid = otid();
  __syncthreads();
  for (int i = tid; i < 9 * 1024; i += 256) {
    int v = i >> 10, k = i & 1023;
    float cv = v == 0 ? p.in[8][k] : p.in[7][(v - 1) * 1024 + k];
    sm[i] = cv / (1.f + __expf(-cv));
  }
  __syncthreads();
  const int col = jg * 64 + (tid & 63), kq = tid >> 6;
  float acc[9];
#pragma unroll
  for (int v = 0; v < 9; ++v) acc[v] = 0.f;
  const float* wp = p.in[9] + (size_t)l * 1024 * 6144 + col;
#pragma unroll 4
  for (int k = kq * 256; k < kq * 256 + 256; ++k) {
    float wv = wp[(size_t)k * 6144];
#pragma unroll
    for (int v = 0; v < 9; ++v) acc[v] += sm[v * 1024 + k] * wv;
  }
  float* red = sm + 9 * 1024;
#pragma unroll
  for (int v = 0; v < 9; ++v) red[(kq * 9 + v) * 64 + (tid & 63)] = acc[v];
  __syncthreads();
  if (kq == 0) {
    float* mods = (float*)(p.ws + B_MODS);
    float b = p.in[10][l * 6144 + col];
#pragma unroll
    for (int v = 0; v < 9; ++v) {
      float s = red[(0 * 9 + v) * 64 + tid] + red[(1 * 9 + v) * 64 + tid] + red[(2 * 9 + v) * 64 + tid] + red[(3 * 9 + v) * 64 + tid];
      mods[(size_t)(l * 9 + v) * 6144 + col] = s + b;
    }
  }
}
DI void s5pre_tile(const Params& p, int tile) {
  const int id = tile * 256 + otid();
  const int pp = id & 63, g = (id >> 6) & 31, dir = (id >> 11) & 1, l = id >> 12;
  const float lre = p.in[18][((l * 2 + dir) * 32 + g) * 64 + pp];
  const float lim = p.in[19][((l * 2 + dir) * 32 + g) * 64 + pp];
  const float dt = expf(p.in[20][(l * 2 + dir) * 32 + g]);
  float er = expf(lre * dt), sn, cs;
  sincosf(lim * dt, &sn, &cs);
  const float lbr = er * cs, lbi = er * sn;
  float e64 = expf(64.f * lre * dt), s64, c64;
  sincosf(64.f * lim * dt, &s64, &c64);
  float2* lamb = (float2*)(p.ws + B_LAMB);
  float2* lam64 = (float2*)(p.ws + B_LAM64);
  const int li = ((l * 2 + dir) * 32 + g) * 64 + pp;
  lamb[li] = make_float2(lbr, lbi);
  lam64[li] = make_float2(e64 * c64, e64 * s64);
  const float nr = lbr - 1.f, ni = lbi, den = lre * lre + lim * lim;
  const float cr = (nr * lre + ni * lim) / den, ci = (ni * lre - nr * lim) / den;
  u16* bbt = (u16*)(p.ws + B_BBT) + (size_t)((l * 2 + dir) * 32 + g) * 128 * 16;
  const float* bre = p.in[21] + (size_t)((l * 32 + g) * 64 + pp) * 16;
  const float* bim = p.in[22] + (size_t)((l * 32 + g) * 64 + pp) * 16;
#pragma unroll
  for (int c = 0; c < 16; ++c) {
    float br = bre[c], bi = bim[c];
    bbt[pp * 16 + c] = f2bf(cr * br - ci * bi);
    bbt[(64 + pp) * 16 + c] = f2bf(cr * bi + ci * br);
  }
  if (dir == 0) {
    u16* cmt = (u16*)(p.ws + B_CMT) + (size_t)(l * 32 + g) * 16 * 128;
    const float* cre = p.in[23] + (size_t)(l * 32 + g) * 16 * 64;
    const float* cim = p.in[24] + (size_t)(l * 32 + g) * 16 * 64;
#pragma unroll
    for (int c = 0; c < 16; ++c) {
      cmt[c * 128 + pp] = f2bf(cre[c * 64 + pp]);
      cmt[c * 128 + 64 + pp] = f2bf(-cim[c * 64 + pp]);
    }
  }
}

DI void norm_phase(const Params& p, int l, int shift_idx, int scale_idx, const float* gn) {
  const float* x = p.out;
  u16* H = (u16*)(p.ws + B_H);
  const float* mods = (const float*)(p.ws + B_MODS);
  const int lane = otid() & 63, w = otid() >> 6;
  for (int tile = blockIdx.x; tile < T_ / 4; tile += gridDim.x) {
    const int t = tile * 4 + w;
    const float4* xr = (const float4*)(x + (size_t)t * 1024);
    float4 v[4];
    float ss = 0.f;
#pragma unroll
    for (int j = 0; j < 4; ++j) {
      v[j] = xr[lane + 64 * j];
      ss += v[j].x * v[j].x + v[j].y * v[j].y + v[j].z * v[j].z + v[j].w * v[j].w;
    }
    ss = wave_sum(ss);
    const float rstd = rsqrtf(ss * (1.f / 1024.f) + 1e-6f);
    const float* mb = mods + (size_t)(l * 9 + tok_v(t)) * 6144;
#pragma unroll
    for (int j = 0; j < 4; ++j) {
      const int c = (lane + 64 * j) * 4;
      float4 g = *(const float4*)(gn + c);
      float4 sc = *(const float4*)(mb + scale_idx * 1024 + c);
      float4 sh = *(const float4*)(mb + shift_idx * 1024 + c);
      float y0 = v[j].x * rstd * g.x * (1.f + sc.x) + sh.x;
      float y1 = v[j].y * rstd * g.y * (1.f + sc.y) + sh.y;
      float y2 = v[j].z * rstd * g.z * (1.f + sc.z) + sh.z;
      float y3 = v[j].w * rstd * g.w * (1.f + sc.w) + sh.w;
      *(uint2*)(H + (size_t)t * 1024 + c) = make_uint2(pack2(y0, y1), pack2(y2, y3));
    }
  }
}

DI void gemm_in_phase(const Params& p, int l, u16* sm) {
  const u16* H = (const u16*)(p.ws + B_H);
  const u16* Wt = (const u16*)(p.ws + B_W) + (size_t)l * W_LAYER + W_IN;
  for (int tile = blockIdx.x; tile < 192 * 26; tile += gridDim.x) {
    const int mt = tile / 26, nt = tile % 26;
    f32x4 acc[4][4];
    zero_acc<4>(acc);
    gemm_core<4>(acc, H + (size_t)mt * 128 * 1024, 1024, Wt + (size_t)nt * 128 * 1024, 1024, 1024, sm);
    if (nt < 25) {
      u16* dst; int ld, c0;
      if (nt < 12) { dst = (u16*)(p.ws + B_QKV); ld = 1536; c0 = nt * 128; }
      else if (nt < 16) { dst = (u16*)(p.ws + B_Z); ld = 512; c0 = (nt - 12) * 128; }
      else if (nt < 20) { dst = (u16*)(p.ws + B_US5); ld = 512; c0 = (nt - 16) * 128; }
      else if (nt < 23) { dst = (u16*)(p.ws + B_QA); ld = 384; c0 = (nt - 20) * 128; }
      else { dst = (u16*)(p.ws + B_KVA); ld = 256; c0 = (nt - 23) * 128; }
      EPI_LOOP(4) { *(uint2*)(dst + (size_t)(mt * 128 + EROW) * ld + c0 + ECOL4(4)) = pack4(acc[i][j]); }
    } else {
      float* misc = (float*)(p.ws + B_MISC);
      EPI_LOOP(4) {
        const int c = ECOL4(4);
        if (c < 48) *(float4*)(misc + (size_t)(mt * 128 + EROW) * 48 + c) = make_float4(acc[i][j][0], acc[i][j][1], acc[i][j][2], acc[i][j][3]);
      }
    }
  }
}

DI void delta_prep_tile(const Params& p, int l, int chunk, u16* sm) {
  const int tid = otid(), lane = tid & 63, w = tid >> 6;
  const int tb = chunk * 64;
  int pos0, L;
  if (tb < TP_) { pos0 = tb & 255; L = 256; } else { pos0 = (tb - TP_) & 2047; L = 2048; }
  const u16* qkv = (const u16*)(p.ws + B_QKV);
  const float* cw = p.in[14] + (size_t)l * 5 * 1536;
  u16* ksm = sm + w * (64 * 130);
  __syncthreads();
  for (int gi = w; gi < 12; gi += 4) {
    const int ch = gi * 128 + 2 * lane;
    float w0[5], w1[5];
#pragma unroll
    for (int i = 0; i < 5; ++i) { w0[i] = cw[i * 1536 + ch]; w1[i] = cw[i * 1536 + ch + 1]; }
    float a0[5], a1[5];
#pragma unroll
    for (int i = 0; i < 4; ++i) {
      int ps = pos0 - 2 + i;
      unsigned u = (ps >= 0 && ps < L) ? *(const unsigned*)(qkv + (size_t)(tb - 2 + i) * 1536 + ch) : 0u;
      a0[i + 1] = blo(u); a1[i + 1] = bhi(u);
    }
    u16* dst = (u16*)(p.ws + (gi < 4 ? B_QN : (gi < 8 ? B_KN : B_VV)));
    const int hh = gi & 3;
    for (int tt = 0; tt < 64; ++tt) {
#pragma unroll
      for (int i = 0; i < 4; ++i) { a0[i] = a0[i + 1]; a1[i] = a1[i + 1]; }
      {
        int ps = pos0 + tt + 2;
        unsigned u = (ps < L) ? *(const unsigned*)(qkv + (size_t)(tb + tt + 2) * 1536 + ch) : 0u;
        a0[4] = blo(u); a1[4] = bhi(u);
      }
      float y0 = 0.f, y1 = 0.f;
#pragma unroll
      for (int i = 0; i < 5; ++i) { y0 += w0[i] * a0[i]; y1 += w1[i] * a1[i]; }
      y0 = siluf_(y0); y1 = siluf_(y1);
      if (gi < 8) {
        float ss = wave_sum(y0 * y0 + y1 * y1);
        float sc = rsqrtf(ss + 1e-6f);
        if (gi < 4) sc *= 0.08838834764831845f;
        y0 *= sc; y1 *= sc;
      }
      const unsigned pk = pack2(y0, y1);
      *(unsigned*)(dst + (size_t)(tb + tt) * 512 + hh * 128 + 2 * lane) = pk;
      if (gi >= 4 && gi < 8) *(unsigned*)(ksm + tt * 130 + 2 * lane) = pk;
    }
    if (gi >= 4 && gi < 8) {
      u16* kt = (u16*)(p.ws + B_KT) + (size_t)(chunk * 4 + hh) * 128 * 64;
#pragma unroll
      for (int rr = 0; rr < 2; ++rr) {
        const int dk = lane + 64 * rr;
        unsigned pk[32];
#pragma unroll
        for (int t2 = 0; t2 < 32; ++t2) pk[t2] = (unsigned)ksm[(2 * t2) * 130 + dk] | ((unsigned)ksm[(2 * t2 + 1) * 130 + dk] << 16);
#pragma unroll
        for (int q = 0; q < 8; ++q) *(uint4*)(kt + dk * 64 + q * 8) = make_uint4(pk[4 * q], pk[4 * q + 1], pk[4 * q + 2], pk[4 * q + 3]);
      }
    }
  }
  const float* misc = (const float*)(p.ws + B_MISC);
  float* bg = (float*)(p.ws + B_BG);
  for (int i = tid; i < 512; i += 256) {
    const int tt = i >> 3, dh = i & 7;
    const size_t t = tb + tt;
    float bl = misc[t * 48 + dh], alp = misc[t * 48 + 8 + dh];
    float x = alp + p.in[16][l * 8 + dh];
    float sp = x > 20.f ? x : log1pf(__expf(x));
    bg[t * 16 + dh] = sigmoidf_(bl);
    bg[t * 16 + 8 + dh] = -__expf(p.in[15][l * 8 + dh]) * sp;
  }
}

DI size_t kb_off(int t, int head) {
  if (t < TP_) return ((size_t)((t >> 8) * 8 + head) * 256 + (t & 255)) * 96;
  const int s = (t - TP_) >> 11, pos = (t - TP_) & 2047;
  return KB_P + ((size_t)(s * 8 + head) * 2304 + 256 + pos) * 96;
}
DI void mla_prep_tile(const Params& p, int l, int tile) {
  const int lane = otid() & 63, w = otid() >> 6;
  const int t = tile * 4 + w;
  u16* qa = (u16*)(p.ws + B_QA) + (size_t)t * 384;
  u16* kva = (u16*)(p.ws + B_KVA) + (size_t)t * 256;
  const float* misc = (const float*)(p.ws + B_MISC) + (size_t)t * 48;
  {
    unsigned u[3]; float ss = 0.f;
#pragma unroll
    for (int j = 0; j < 3; ++j) { u[j] = *(const unsigned*)(qa + 2 * lane + 128 * j); float a = blo(u[j]), b = bhi(u[j]); ss += a * a + b * b; }
    ss = wave_sum(ss);
    const float rstd = rsqrtf(ss * (1.f / 384.f) + 1e-6f);
    const float* g = p.in[28] + l * 384;
#pragma unroll
    for (int j = 0; j < 3; ++j) {
      int c = 2 * lane + 128 * j;
      *(unsigned*)(qa + c) = pack2(blo(u[j]) * rstd * g[c], bhi(u[j]) * rstd * g[c + 1]);
    }
  }
  {
    unsigned u[2]; float ss = 0.f;
#pragma unroll
    for (int j = 0; j < 2; ++j) { u[j] = *(const unsigned*)(kva + 2 * lane + 128 * j); float a = blo(u[j]), b = bhi(u[j]); ss += a * a + b * b; }
    ss = wave_sum(ss);
    const float rstd = rsqrtf(ss * (1.f / 256.f) + 1e-6f);
    const float* g = p.in[30] + l * 256;
#pragma unroll
    for (int j = 0; j < 2; ++j) {
      int c = 2 * lane + 128 * j;
      float a = blo(u[j]) * rstd * g[c], b = bhi(u[j]) * rstd * g[c + 1];
      *(unsigned*)(kva + c) = pack2(a, b);
      if (t < TP_) {
        float* o = p.out + O_CKV + ((size_t)((t >> 8) * 4 + l) * 256 + (t & 255)) * 256 + c;
        *(float2*)o = make_float2(a, b);
      }
    }
  }
  {
    const int i = lane & 31;
    float kr = misc[16 + i];
    float val;
    if (t < TP_) {
      val = kr;
      if (lane < 32) p.out[O_KR + ((size_t)((t >> 8) * 4 + l) * 256 + (t & 255)) * 32 + i] = kr;
    } else {
      const int pos = (t - TP_) & 2047;
      const float* rp = (const float*)(p.ws + B_ROPE) + (size_t)pos * 32 + (i & 15) * 2;
      const float cs = rp[0], sn = rp[1];
      float other = __shfl_xor(kr, 16);
      val = (i < 16) ? (kr * cs - other * sn) : (kr * cs + other * sn);
    }
    u16* kb = (u16*)(p.ws + B_KB);
    const u16 bv = f2bf(val);
#pragma unroll
    for (int hh = 0; hh < 4; ++hh) {
      int head = hh * 2 + (lane >> 5);
      kb[kb_off(t, head) + 64 + i] = bv;
    }
  }
}
DI void cache_rope_tile(const Params& p, int l, int tile) {
  const int pr = tile * 8 + (otid() >> 5), i = otid() & 31;
  const int s = pr >> 8, pos = pr & 255;
  const float v = p.in[6][((size_t)(s * 4 + l) * 256 + pos) * 32 + i];
  u16* kb = (u16*)(p.ws + B_KB);
  const u16 bv = f2bf(v);
#pragma unroll
  for (int head = 0; head < 8; ++head) kb[KB_P + ((size_t)(s * 8 + head) * 2304 + pos) * 96 + 64 + i] = bv;
}

DI float gelu_tanh(float x) {
  const float k0 = 0.7978845608028654f, k1 = 0.044715f;
  float u = k0 * (x + k1 * x * x * x);
  float e = __expf(2.f * u);
  float th = 1.f - 2.f / (e + 1.f);
  return 0.5f * x * (1.f + th);
}
DI void s5_chunk_tile(const Params& p, int l, int chunk, int gp, int mode, u16* sm) {
  const int tid = otid(), lane = tid & 63, w = tid >> 6;
  const u16* us5 = (const u16*)(p.ws + B_US5);
  constexpr int RS = 136;
  __syncthreads();
  {
    const int gi = w >> 1, half = w & 1, g = gp * 2 + gi;
    const int n = lane & 31, h2 = lane >> 5;
    bf16x8 af[2];
#pragma unroll
    for (int mi = 0; mi < 2; ++mi) af[mi] = *(const bf16x8*)(us5 + (size_t)(chunk * 64 + mi * 32 + n) * 512 + g * 16 + 8 * h2);
#pragma unroll
    for (int dir = 0; dir < 2; ++dir) {
      const u16* bbt = (const u16*)(p.ws + B_BBT) + (size_t)((l * 2 + dir) * 32 + g) * 128 * 16;
#pragma unroll
      for (int nn = 0; nn < 2; ++nn) {
        const int nt = half * 2 + nn;
        bf16x8 bfr = *(const bf16x8*)(bbt + (nt * 32 + n) * 16 + 8 * h2);
#pragma unroll
        for (int mi = 0; mi < 2; ++mi) {
          f32x16 acc;
#pragma unroll
          for (int r = 0; r < 16; ++r) acc[r] = 0.f;
          acc = MFMA32(af[mi], bfr, acc);
          u16* d = sm + (size_t)((gi * 2 + dir) * 64 + mi * 32) * RS + nt * 32 + n;
#pragma unroll
          for (int r = 0; r < 16; ++r) d[crow(r, h2) * RS] = f2bf(acc[r]);
        }
      }
    }
  }
  __syncthreads();
  {
    const int gi = tid >> 7, dir = (tid >> 6) & 1, pp = tid & 63, g = gp * 2 + gi;
    const float2 lb = ((const float2*)(p.ws + B_LAMB))[((l * 2 + dir) * 32 + g) * 64 + pp];
    const size_t hidx = ((size_t)(chunk * 32 + g) * 2 + dir) * 64 + pp;
    float hr = 0.f, hi = 0.f;
    if (mode) { float2 h0 = ((const float2*)(p.ws + B_HIN))[hidx]; hr = h0.x; hi = h0.y; }
    u16* base = sm + (size_t)((gi * 2 + dir) * 64) * RS;
#pragma unroll 8
    for (int st = 0; st < 64; ++st) {
      const int tk = dir ? 63 - st : st;
      float br = bf2f(base[tk * RS + pp]), bi = bf2f(base[tk * RS + 64 + pp]);
      float nr = __builtin_fmaf(lb.x, hr, __builtin_fmaf(-lb.y, hi, br));
      float ni = __builtin_fmaf(lb.x, hi, __builtin_fmaf(lb.y, hr, bi));
      asm volatile("" : "+v"(nr));
      asm volatile("" : "+v"(ni));
      hr = nr; hi = ni;
      if (mode) { base[tk * RS + pp] = f2bf(hr); base[tk * RS + 64 + pp] = f2bf(hi); }
    }
    if (!mode) ((float2*)(p.ws + B_HEND))[hidx] = make_float2(hr, hi);
  }
  if (!mode) return;
  __syncthreads();
  {
    const int gi = w >> 1, g = gp * 2 + gi;
    const int fr = lane & 15, fq = lane >> 4;
    const u16* cmt = (const u16*)(p.ws + B_CMT) + (size_t)(l * 32 + g) * 16 * 128;
    f32x4 acc[2];
    acc[0] = f32x4{0.f, 0.f, 0.f, 0.f}; acc[1] = acc[0];
#pragma unroll
    for (int ks = 0; ks < 8; ++ks) {
      const int dir = ks >> 2, kk = (ks & 3) * 32;
      bf16x8 bfr = *(const bf16x8*)(cmt + fr * 128 + kk + fq * 8);
#pragma unroll
      for (int mm = 0; mm < 2; ++mm) {
        const int mi = (w & 1) * 2 + mm;
        bf16x8 af = *(const bf16x8*)(sm + (size_t)((gi * 2 + dir) * 64 + mi * 16 + fr) * RS + kk + fq * 8);
        acc[mm] = MFMA16(af, bfr, acc[mm]);
      }
    }
    const float dsk = p.in[25][l * 512 + g * 16 + fr];
    u16* y5 = (u16*)(p.ws + B_Y5);
#pragma unroll
    for (int mm = 0; mm < 2; ++mm)
#pragma unroll
      for (int r = 0; r < 4; ++r) {
        const size_t t = (size_t)chunk * 64 + ((w & 1) * 2 + mm) * 16 + fq * 4 + r;
        float u = bf2f(us5[t * 512 + g * 16 + fr]);
        float y = acc[mm][r] + dsk * u;
        y5[t * 512 + g * 16 + fr] = f2bf(gelu_tanh(y));
      }
  }
}
DI void s5_carry_tile(const Params& p, int l, int tile) {
  const int seq = tile >> 4, gp = tile & 15;
  const int tid = otid(), gi = tid >> 7, dir = (tid >> 6) & 1, pp = tid & 63, g = gp * 2 + gi;
  int c0, nc;
  if (seq < 32) { c0 = seq * 4; nc = 4; } else { c0 = 128 + (seq - 32) * 32; nc = 32; }
  const float2 l64 = ((const float2*)(p.ws + B_LAM64))[((l * 2 + dir) * 32 + g) * 64 + pp];
  float hr = 0.f, hi = 0.f;
  if (seq >= 32) {
    const size_t si = ((size_t)((seq - 32) * 4 + l) * 2 + dir) * 2048 + g * 64 + pp;
    hr = p.in[3][si]; hi = p.in[4][si];
  }
  const float2* hend = (const float2*)(p.ws + B_HEND);
  float2* hin = (float2*)(p.ws + B_HIN);
  for (int it = 0; it < nc; ++it) {
    const int ck = c0 + (dir ? nc - 1 - it : it);
    const size_t idx = ((size_t)(ck * 32 + g) * 2 + dir) * 64 + pp;
    hin[idx] = make_float2(hr, hi);
    float2 he = hend[idx];
    float nr = __builtin_fmaf(l64.x, hr, __builtin_fmaf(-l64.y, hi, he.x));
    float ni = __builtin_fmaf(l64.x, hi, __builtin_fmaf(l64.y, hr, he.y));
    asm volatile("" : "+v"(nr));
    asm volatile("" : "+v"(ni));
    hr = nr; hi = ni;
  }
  if (seq < 32) {
    const size_t so = ((size_t)(seq * 4 + l) * 2 + dir) * 2048 + g * 64 + pp;
    p.out[O_S5RE + so] = hr;
    p.out[O_S5IM + so] = hi;
  }
}

DI void delta_local_tile(const Params& p, int tile, float* smf) {
  const int chunk = tile >> 1, dir = tile & 1;
  const int tid = otid(), lane = tid & 63, h = tid >> 6;
  const int m = lane & 31, h2 = lane >> 5;
  const int tb = chunk * 64;
  const float* bg = (const float*)(p.ws + B_BG);
  const u16* kn = (const u16*)(p.ws + B_KN);
  const u16* qn = (const u16*)(p.ws + B_QN);
  float* Aw = smf + h * 4096;
  const size_t cidx = ((size_t)(chunk * 4 + h) * 2 + dir);
  const int tl = tb + (dir ? 63 - lane : lane);
  float gcs = bg[(size_t)tl * 16 + 8 + dir * 4 + h];
  const float beta = bg[(size_t)tl * 16 + dir * 4 + h];
#pragma unroll
  for (int o = 1; o < 64; o <<= 1) {
    float v = __shfl_up(gcs, o);
    if (lane >= o) gcs += v;
  }
  ((float*)(p.ws + B_GC))[cidx * 64 + lane] = gcs;
  ((float*)(p.ws + B_BC))[cidx * 64 + lane] = beta;
  __syncthreads();
  u16* qkm = (u16*)(p.ws + B_QKM) + cidx * 4096;
#pragma unroll 1
  for (int tt = 0; tt < 3; ++tt) {
    const int mi = tt == 0 ? 0 : 1, ni = tt == 2 ? 1 : 0;
    const int cm = 32 * mi + m, cn = 32 * ni + m;
    const u16* krm = kn + (size_t)(tb + (dir ? 63 - cm : cm)) * 512 + h * 128 + h2 * 8;
    const u16* qrm = qn + (size_t)(tb + (dir ? 63 - cm : cm)) * 512 + h * 128 + h2 * 8;
    const u16* krn = kn + (size_t)(tb + (dir ? 63 - cn : cn)) * 512 + h * 128 + h2 * 8;
    f32x16 ak, aq;
#pragma unroll
    for (int r = 0; r < 16; ++r) { ak[r] = 0.f; aq[r] = 0.f; }
#pragma unroll
    for (int ks = 0; ks < 8; ++ks) {
      const bf16x8 fkm = *(const bf16x8*)(krm + ks * 16), fqm = *(const bf16x8*)(qrm + ks * 16), fkn = *(const bf16x8*)(krn + ks * 16);
      ak = MFMA32(fkm, fkn, ak);
      aq = MFMA32(fqm, fkn, aq);
    }
    const int e = 32 * ni + m;
    const float gce = __shfl(gcs, e);
#pragma unroll
    for (int r = 0; r < 16; ++r) {
      const int c = 32 * mi + crow(r, h2);
      const float gcc = __shfl(gcs, c), bc = __shfl(beta, c);
      const float dec = (e <= c) ? __expf(gcc - gce) : 0.f;
      Aw[c * 64 + e] = (e < c) ? ak[r] * bc * dec : 0.f;
      qkm[c * 64 + e] = f2bf(aq[r] * dec);
    }
  }
  __syncthreads();
  u16* tm = (u16*)(p.ws + B_TM) + cidx * 4096;
  float x[64];
#pragma unroll
  for (int i = 0; i < 64; ++i) {
    float a = (i == lane) ? 1.f : 0.f;
#pragma unroll
    for (int j = 0; j < i; ++j) a -= Aw[i * 64 + j] * x[j];
    x[i] = a;
    tm[i * 64 + lane] = f2bf(a);
  }
}

template <int dir>
DI void delta_scan_body(const Params& p, int l, int seq, int h, u16* sm);
DI void delta_scan_tile(const Params& p, int l, int idx, u16* sm) {
  int seq, h, dir;
  if (idx < 64) { seq = 32 + (idx >> 3); h = (idx >> 1) & 3; dir = idx & 1; }
  else { const int i2 = idx - 64; seq = i2 >> 3; h = (i2 >> 1) & 3; dir = i2 & 1; }
  __builtin_amdgcn_s_setprio(3);
  if (dir) delta_scan_body<1>(p, l, seq, h, sm); else delta_scan_body<0>(p, l, seq, h, sm);
  __builtin_amdgcn_s_setprio(0);
}
template <int dir>
DI void delta_scan_body(const Params& p, int l, int seq, int h, u16* sm) {
  int chunk0, nch;
  if (seq < 32) { chunk0 = seq * 4; nch = 4; } else { chunk0 = 128 + (seq - 32) * 32; nch = 32; }
  const int lane = otid() & 63, w = otid() >> 6;
  const int n = lane & 31, h2 = lane >> 5;
  const int dvc = w * 32 + n;
  const u16* kn = (const u16*)(p.ws + B_KN);
  const u16* qn = (const u16*)(p.ws + B_QN);
  const u16* vv = (const u16*)(p.ws + B_VV);
  u16* od = (u16*)(p.ws + (dir ? B_OB : B_OF));
  f32x16 S[4];
  if (seq >= 32) {
    const float* s0 = p.in[2] + ((size_t)(((seq - 32) * 4 + l) * 2 + dir) * 4 + h) * 16384;
#pragma unroll
    for (int t = 0; t < 4; ++t)
#pragma unroll
      for (int r = 0; r < 16; ++r) S[t][r] = s0[(size_t)(32 * t + crow(r, h2)) * 128 + dvc];
  } else {
#pragma unroll
    for (int t = 0; t < 4; ++t)
#pragma unroll
      for (int r = 0; r < 16; ++r) S[t][r] = 0.f;
  }
  for (int it = 0; it < nch; ++it) {
    const int chunk = chunk0 + (dir ? nch - 1 - it : it);
    const int tb = chunk * 64;
    const size_t cidx = ((size_t)(chunk * 4 + h) * 2 + dir);
    const float* gcp = (const float*)(p.ws + B_GC) + cidx * 64;
    const float* bcp = (const float*)(p.ws + B_BC) + cidx * 64;
    const u16* tm = (const u16*)(p.ws + B_TM) + cidx * 4096;
    const u16* qkm = (const u16*)(p.ws + B_QKM) + cidx * 4096;
    const u16* ktp = (const u16*)(p.ws + B_KT) + (size_t)(chunk * 4 + h) * 8192;
    const float glast = gcp[63];
    size_t trow[2];
#pragma unroll
    for (int mi = 0; mi < 2; ++mi) { const int c = 32 * mi + n; trow[mi] = (size_t)(tb + (dir ? 63 - c : c)); }
#define SCHED_FENCE() asm volatile("" ::: "memory")
    u16* Ks = sm; u16* Qs = sm + 8704; u16* Vs = sm + 17408; u16* KTs = sm + 26112;
    float* GCs = (float*)(sm + 35328);
    const float* gcl = GCs; const float* bcl = GCs + 64;
    uint4 xm0, xm1, xq0, xq1;
    u16* vls = Vs + w * 32;
    __syncthreads();
    {
      const int tid_ = otid();
      const int r0 = tid_ >> 4, ck = tid_ & 15;
      uint4 tk[4], tq[4], tv[4], tt[4];
      xm0 = *(const uint4*)(tm + tid_ * 8); xm1 = *(const uint4*)(tm + 2048 + tid_ * 8);
      xq0 = *(const uint4*)(qkm + tid_ * 8); xq1 = *(const uint4*)(qkm + 2048 + tid_ * 8);
      float4 gcv = make_float4(0.f, 0.f, 0.f, 0.f);
      if (tid_ < 16) gcv = *(const float4*)(gcp + tid_ * 4); else if (tid_ < 32) gcv = *(const float4*)(bcp + (tid_ - 16) * 4);
#pragma unroll
      for (int j = 0; j < 4; ++j) {
        const size_t go = (size_t)(tb + r0 + 16 * j) * 512 + h * 128 + ck * 8;
        tk[j] = *(const uint4*)(kn + go); tq[j] = *(const uint4*)(qn + go); tv[j] = *(const uint4*)(vv + go);
        tt[j] = *(const uint4*)(ktp + ((tid_ >> 3) + 32 * j) * 64 + (tid_ & 7) * 8);
      }
#pragma unroll
      for (int j = 0; j < 4; ++j) {
        const int tau = r0 + 16 * j, c = dir ? 63 - tau : tau;
        *(uint4*)(Ks + c * 136 + ck * 8) = tk[j]; *(uint4*)(Qs + c * 136 + ck * 8) = tq[j]; *(uint4*)(Vs + c * 136 + ck * 8) = tv[j];
        *(uint4*)(KTs + ((tid_ >> 3) + 32 * j) * 72 + (tid_ & 7) * 8) = tt[j];
      }
      if (tid_ < 32) *(float4*)(GCs + tid_ * 4) = gcv;
    }
    __syncthreads();
    f32x16 X[2], QS[2];
    {
      bf16x8 Sb[4][2];
#pragma unroll
      for (int t = 0; t < 4; ++t)
#pragma unroll
        for (int s = 0; s < 2; ++s) Sb[t][s] = pack_acc(S[t], s);
#pragma unroll
      for (int mi = 0; mi < 2; ++mi)
#pragma unroll
        for (int r = 0; r < 16; ++r) { X[mi][r] = 0.f; QS[mi][r] = 0.f; }
#pragma unroll
      for (int t = 0; t < 4; ++t) {
#pragma unroll
        for (int mi = 0; mi < 2; ++mi) {
          const u16* krow_ = Ks + (32 * mi + n) * 136;
          const u16* qrow_ = Qs + (32 * mi + n) * 136;
#pragma unroll
          for (int s = 0; s < 2; ++s) {
            X[mi] = MFMA32(load_perm(krow_ + 32 * t, s, h2), Sb[t][s], X[mi]);
            QS[mi] = MFMA32(load_perm(qrow_ + 32 * t, s, h2), Sb[t][s], QS[mi]);
          }
        }
        SCHED_FENCE();
      }
    }
    __syncthreads();
    {
      const int tid_ = otid();
      const int r_ = tid_ >> 3, c_ = (tid_ & 7) * 8;
      *(uint4*)(Ks + r_ * 72 + c_) = xm0; *(uint4*)(Ks + (r_ + 32) * 72 + c_) = xm1;
      *(uint4*)(Qs + r_ * 72 + c_) = xq0; *(uint4*)(Qs + (r_ + 32) * 72 + c_) = xq1;
    }
    __syncthreads();
    bf16x8 Rb[2][2];
#pragma unroll
    for (int mi = 0; mi < 2; ++mi) {
#pragma unroll
      for (int a = 0; a < 4; ++a) {
        const int c4 = 32 * mi + 8 * a + 4 * h2;
        const float4 g4 = *(const float4*)(gcl + c4);
        const float4 b4 = *(const float4*)(bcl + c4);
        const float gg[4] = {g4.x, g4.y, g4.z, g4.w};
        const float bb[4] = {b4.x, b4.y, b4.z, b4.w};
#pragma unroll
        for (int q = 0; q < 4; ++q) {
          const int c = c4 + q;
          const float v = bf2f(vls[c * 136 + n]);
          const float eg = __expf(gg[q]);
          X[mi][4 * a + q] = bb[q] * (v - eg * X[mi][4 * a + q]);
          QS[mi][4 * a + q] *= eg;
        }
      }
      Rb[mi][0] = pack_acc(X[mi], 0);
      Rb[mi][1] = pack_acc(X[mi], 1);
    }
    SCHED_FENCE();
    f32x16 Vn[2];
#pragma unroll
    for (int mo = 0; mo < 2; ++mo) {
#pragma unroll
      for (int r = 0; r < 16; ++r) Vn[mo][r] = 0.f;
#pragma unroll
      for (int mi = 0; mi <= mo; ++mi)
#pragma unroll
        for (int s = 0; s < 2; ++s) Vn[mo] = MFMA32(load_perm(Ks + (32 * mo + n) * 72 + 32 * mi, s, h2), Rb[mi][s], Vn[mo]);
    }
    SCHED_FENCE();
    {
      bf16x8 Vb[2][2];
#pragma unroll
      for (int mi = 0; mi < 2; ++mi) { Vb[mi][0] = pack_acc(Vn[mi], 0); Vb[mi][1] = pack_acc(Vn[mi], 1); }
#pragma unroll
      for (int mo = 0; mo < 2; ++mo) {
#pragma unroll
        for (int mi = 0; mi <= mo; ++mi)
#pragma unroll
          for (int s = 0; s < 2; ++s) QS[mo] = MFMA32(load_perm(Qs + (32 * mo + n) * 72 + 32 * mi, s, h2), Vb[mi][s], QS[mo]);
      }
      __syncthreads();
#pragma unroll
      for (int mo = 0; mo < 2; ++mo)
#pragma unroll
        for (int r = 0; r < 16; ++r) vls[(32 * mo + crow(r, h2)) * 136 + n] = f2bf(QS[mo][r]);
      __syncthreads();
#pragma unroll
      for (int jv = 0; jv < 4; ++jv) {
        const int tau = (lane >> 2) + 16 * jv, cq = lane & 3;
        const uint4 oq = *(const uint4*)(vls + (dir ? 63 - tau : tau) * 136 + cq * 8);
        *(uint4*)(od + (size_t)(tb + tau) * 512 + h * 128 + w * 32 + cq * 8) = oq;
      }
    }
    SCHED_FENCE();
    bf16x8 Vsb[2][2];
#pragma unroll
    for (int mi = 0; mi < 2; ++mi) {
#pragma unroll
      for (int a = 0; a < 4; ++a) {
        const float4 g4 = *(const float4*)(gcl + 32 * mi + 8 * a + 4 * h2);
        Vn[mi][4 * a + 0] *= __expf(glast - g4.x); Vn[mi][4 * a + 1] *= __expf(glast - g4.y);
        Vn[mi][4 * a + 2] *= __expf(glast - g4.z); Vn[mi][4 * a + 3] *= __expf(glast - g4.w);
      }
      Vsb[mi][0] = pack_acc(Vn[mi], 0); Vsb[mi][1] = pack_acc(Vn[mi], 1);
    }
    const float eg = __expf(glast);
#pragma unroll
    for (int t = 0; t < 4; ++t) {
#pragma unroll
      for (int r = 0; r < 16; ++r) S[t][r] *= eg;
      const u16* ktrow = KTs + (32 * t + n) * 72;
#pragma unroll
      for (int mi = 0; mi < 2; ++mi)
#pragma unroll
        for (int s = 0; s < 2; ++s) {
          bf16x8 a = dir ? load_perm_rev(ktrow, 32 * mi, s, h2) : load_perm(ktrow + 32 * mi, s, h2);
          S[t] = MFMA32(a, Vsb[mi][s], S[t]);
        }
      SCHED_FENCE();
    }
  }
  if (seq < 32) {
    float* so = p.out + O_SD + ((size_t)((seq * 4 + l) * 2 + dir) * 4 + h) * 16384;
#pragma unroll
    for (int t = 0; t < 4; ++t)
#pragma unroll
      for (int r = 0; r < 16; ++r) so[(size_t)(32 * t + crow(r, h2)) * 128 + dvc] = S[t][r];
  }
}

DI void attn_tile(const Params& p, int seq, int head, int qb, u16* sm) {
  const int lane = otid() & 63, w = otid() >> 6;
  const int n = lane & 31, h2 = lane >> 5;
  int tq0, nkeys; size_t kbo, vto;
  if (seq < 32) { tq0 = seq * 256 + qb * 128 + w * 32; nkeys = 256; kbo = (size_t)(seq * 8 + head) * 256 * 96; vto = (size_t)(seq * 8 + head) * 64 * 256; }
  else { const int s = seq - 32; tq0 = TP_ + s * 2048 + qb * 128 + w * 32; nkeys = 2304; kbo = KB_P + (size_t)(s * 8 + head) * 2304 * 96; vto = VT_P + (size_t)(s * 8 + head) * 64 * 2304; }
  const u16* kb = (const u16*)(p.ws + B_KB) + kbo;
  const u16* vt = (const u16*)(p.ws + B_VT) + vto;
  const u16* qm = (const u16*)(p.ws + B_QM) + (size_t)(tq0 + n) * 768 + head * 96;
  bf16x8 qf[6];
#pragma unroll
  for (int ks = 0; ks < 6; ++ks) qf[ks] = *(const bf16x8*)(qm + ks * 16 + h2 * 8);
  f32x16 O[2];
#pragma unroll
  for (int r = 0; r < 16; ++r) { O[0][r] = 0.f; O[1][r] = 0.f; }
  float mrun = -1e30f, lsum = 0.f;
  const int nkt = nkeys >> 6;
  constexpr int KST = 104, VST = 72, STG = 64 * KST + 64 * VST;
  const int tid_ = otid();
  uint4 rk0, rk1, rk2, rv0, rv1;
  const int kc0 = tid_, kc1 = tid_ + 256, kc2 = tid_ + 512;
  const u16* kg0 = kb + (size_t)(kc0 / 12) * 96 + (kc0 % 12) * 8;
  const u16* kg1 = kb + (size_t)(kc1 / 12) * 96 + (kc1 % 12) * 8;
  const u16* kg2 = kb + (size_t)(kc2 / 12) * 96 + (kc2 % 12) * 8;
  const u16* vg0 = vt + (size_t)(tid_ >> 3) * nkeys + (tid_ & 7) * 8;
  const u16* vg1 = vt + (size_t)((tid_ + 256) >> 3) * nkeys + (tid_ & 7) * 8;
  const int kl0 = (kc0 / 12) * KST + (kc0 % 12) * 8, kl1 = (kc1 / 12) * KST + (kc1 % 12) * 8, kl2 = (kc2 / 12) * KST + (kc2 % 12) * 8;
  const int vl0 = (tid_ >> 3) * VST + (tid_ & 7) * 8, vl1 = ((tid_ + 256) >> 3) * VST + (tid_ & 7) * 8;
#define AT_GLOAD(kt_) do { rk0 = *(const uint4*)(kg0 + (size_t)(kt_) * 6144); rk1 = *(const uint4*)(kg1 + (size_t)(kt_) * 6144); \
    rk2 = *(const uint4*)(kg2 + (size_t)(kt_) * 6144); rv0 = *(const uint4*)(vg0 + (kt_) * 64); rv1 = *(const uint4*)(vg1 + (kt_) * 64); } while (0)
#define AT_SSTORE(st_) do { u16* ks2_ = sm + (st_) * STG; u16* vs2_ = ks2_ + 64 * KST; \
    *(uint4*)(ks2_ + kl0) = rk0; *(uint4*)(ks2_ + kl1) = rk1; *(uint4*)(ks2_ + kl2) = rk2; *(uint4*)(vs2_ + vl0) = rv0; *(uint4*)(vs2_ + vl1) = rv1; } while (0)
  __syncthreads();
  AT_GLOAD(0); AT_SSTORE(0);
  __syncthreads();
  for (int kt = 0; kt < nkt; ++kt) {
    const bool more = kt + 1 < nkt;
    if (more) AT_GLOAD(kt + 1);
    const u16* ks_ = sm + (kt & 1) * STG;
    const u16* vs_ = ks_ + 64 * KST;
    f32x16 St[2];
#pragma unroll
    for (int sub = 0; sub < 2; ++sub) {
#pragma unroll
      for (int r = 0; r < 16; ++r) St[sub][r] = 0.f;
      const u16* kr = ks_ + (sub * 32 + n) * KST + h2 * 8;
#pragma unroll
      for (int ks = 0; ks < 6; ++ks) St[sub] = MFMA32(*(const bf16x8*)(kr + ks * 16), qf[ks], St[sub]);
    }
    float mx = St[0][0];
#pragma unroll
    for (int r = 0; r < 16; ++r) { mx = fmaxf(mx, St[0][r]); mx = fmaxf(mx, St[1][r]); }
    mx = fmaxf(mx, __shfl_xor(mx, 32));
    const float mnew = fmaxf(mrun, mx);
    const float alpha = exp2f(mrun - mnew);
    mrun = mnew;
    float ps = 0.f;
#pragma unroll
    for (int sub = 0; sub < 2; ++sub)
#pragma unroll
      for (int r = 0; r < 16; ++r) { float e = exp2f(St[sub][r] - mnew); St[sub][r] = e; ps += e; }
    lsum = lsum * alpha + ps;
#pragma unroll
    for (int r = 0; r < 16; ++r) { O[0][r] *= alpha; O[1][r] *= alpha; }
#pragma unroll
    for (int sub = 0; sub < 2; ++sub)
#pragma unroll
      for (int s = 0; s < 2; ++s) {
        const bf16x8 pb = pack_acc(St[sub], s);
#pragma unroll
        for (int dt = 0; dt < 2; ++dt)
          O[dt] = MFMA32(load_perm(vs_ + (dt * 32 + n) * VST + sub * 32, s, h2), pb, O[dt]);
      }
    if (more) AT_SSTORE((kt + 1) & 1);
    __syncthreads();
  }
  lsum += __shfl_xor(lsum, 32);
  const float inv = 1.f / lsum;
  u16* oc = (u16*)(p.ws + B_OC) + (size_t)(tq0 + n) * 512 + head * 64;
#pragma unroll
  for (int dt = 0; dt < 2; ++dt)
#pragma unroll
    for (int a = 0; a < 4; ++a) {
      const int dv = dt * 32 + 8 * a + 4 * h2;
      *(uint2*)(oc + dv) = make_uint2(pack2(O[dt][4 * a] * inv, O[dt][4 * a + 1] * inv), pack2(O[dt][4 * a + 2] * inv, O[dt][4 * a + 3] * inv));
    }
}

DI void delta_out_tile(const Params& p, int l, int tile) {
  const int lane = otid() & 63, w = otid() >> 6;
  const u16* of = (const u16*)(p.ws + B_OF);
  const u16* ob = (const u16*)(p.ws + B_OB);
  const u16* z = (const u16*)(p.ws + B_Z);
  u16* oa = (u16*)(p.ws + B_OA);
  const float g0 = p.in[17][l * 128 + 2 * lane], g1 = p.in[17][l * 128 + 2 * lane + 1];
#pragma unroll 1
  for (int q = 0; q < 16; ++q) {
    const size_t t = (size_t)tile * 16 + w * 4 + (q >> 2);
    const int hh = q & 3;
    const size_t off = t * 512 + hh * 128 + 2 * lane;
    unsigned a = *(const unsigned*)(of + off), b = *(const unsigned*)(ob + off), zz = *(const unsigned*)(z + off);
    float o0 = blo(a) + blo(b), o1 = bhi(a) + bhi(b);
    float ss = wave_sum(o0 * o0 + o1 * o1);
    float rstd = rsqrtf(ss * (1.f / 128.f) + 1e-6f);
    float y0 = o0 * rstd * g0 * siluf_(blo(zz)), y1 = o1 * rstd * g1 * siluf_(bhi(zz));
    *(unsigned*)(oa + off) = pack2(y0, y1);
  }
}

DI void grid_barrier(unsigned* bar, unsigned target) {
  asm volatile("s_waitcnt vmcnt(0) lgkmcnt(0)" ::: "memory");
  __syncthreads();
  if (otid() == 0) {
    __builtin_amdgcn_fence(__ATOMIC_RELEASE, "agent");
    asm volatile("s_waitcnt vmcnt(0)" ::: "memory");
    __hip_atomic_fetch_add(bar, 1u, __ATOMIC_RELAXED, __HIP_MEMORY_SCOPE_AGENT);
    while (__hip_atomic_load(bar, __ATOMIC_RELAXED, __HIP_MEMORY_SCOPE_AGENT) < target) __builtin_amdgcn_s_sleep(1);
    __builtin_amdgcn_fence(__ATOMIC_ACQUIRE, "agent");
    asm volatile("s_waitcnt vmcnt(0)" ::: "memory");
  }
  __syncthreads();
}
#define GSYNC() do { bar_target += gridDim.x; grid_barrier(p.bar, bar_target); } while (0)
#ifndef ONLY
#define PH(n) 1
#else
#define PH(n) ((n) == ONLY || (n) / 100 == ONLY || (n) == ONLY / 100)
#endif
__global__ void __launch_bounds__(256, 2) mega(Params p) {
  cg::grid_group grid = cg::this_grid();
  __shared__ __attribute__((aligned(16))) char smem_raw[73728];
  u16* sm = (u16*)smem_raw;
  float* smf = (float*)smem_raw;
  const int nb = gridDim.x, bid = blockIdx.x;
  unsigned bar_target = 0;
  grid.sync();

  if (PH(0)) {
    const int tid = otid();
    for (int j = bid; j < 4 * CJ8; j += nb) conv_job(p, j / CJ8, j % CJ8, smf);
    for (int j = bid; j < 4 * 96; j += nb) mods_tile(p, j / 96, j % 96, smf);
    for (int j = bid; j < 64; j += nb) s5pre_tile(p, j);
    {
      const float4* xp = (const float4*)p.in[0];
      const float4* xs = (const float4*)p.in[1];
      float4* o = (float4*)p.out;
      const size_t nP = (size_t)TP_ * 256, nT = (size_t)T_ * 256;
      for (size_t i = (size_t)bid * 256 + tid; i < nT; i += (size_t)nb * 256) o[i] = i < nP ? xp[i] : xs[i - nP];
    }
    {
      float* rope = (float*)(p.ws + B_ROPE);
      for (int i = bid * 256 + tid; i < 2048 * 16; i += nb * 256) {
        const int pos = i >> 4, f = i & 15;
        const float invf = 1.f / powf(10000.f, (float)(f & 7) * 0.125f);
        const float ang = (f < 8 ? (float)(pos >> 6) : (float)(pos & 63)) * invf;
        float sn, cs;
        sincosf(ang, &sn, &cs);
        rope[i * 2] = cs; rope[i * 2 + 1] = sn;
      }
    }
    {
      u16* cc = (u16*)(p.ws + B_CKVC);
      for (int i = bid * 256 + tid; i < 8 * 4 * 256 * 256 / 2; i += nb * 256) {
        const int e = i * 2;
        const int c = e & 255, pos = (e >> 8) & 255, l = (e >> 16) & 3, b = e >> 18;
        float2 v = *(const float2*)(p.in[5] + e);
        *(unsigned*)(cc + ((size_t)(l * 2048 + b * 256 + pos)) * 256 + c) = pack2(v.x, v.y);
      }
    }
  }
  GSYNC();

  for (int l = 0; l < 4; ++l) {
    const u16* WL = (const u16*)(p.ws + B_W) + (size_t)l * W_LAYER;
    const float* mods = (const float*)(p.ws + B_MODS);
    if (PH(1)) norm_phase(p, l, 0, 1, p.in[11] + l * 1024);
    GSYNC();
    if (PH(2)) gemm_in_phase(p, l, sm);
    GSYNC();
    if (PH(3)) {
      for (int j = bid; j < NCH; j += nb) delta_prep_tile(p, l, j, sm);
      for (int j = bid; j < T_ / 4; j += nb) mla_prep_tile(p, l, j);
      for (int j = bid; j < 256; j += nb) cache_rope_tile(p, l, j);
      for (int j = bid; j < NCH * 16; j += nb) s5_chunk_tile(p, l, j >> 4, j & 15, 0, sm);
    }
    GSYNC();
    if (PH(4)) {
      const int tid = otid();
      if (PH(400)) for (int j = bid; j < NCH * 2; j += nb) delta_local_tile(p, j, smf);
      if (PH(410)) for (int j = bid; j < 192 * 6; j += nb) {
          const int q = j, mt = q / 6, nt = q % 6;
          f32x4 acc[4][4];
          zero_acc<4>(acc);
          gemm_core<4>(acc, (const u16*)(p.ws + B_QA) + (size_t)mt * 128 * 384, 384, WL + W_QB + (size_t)nt * 128 * 384, 384, 384, sm);
          u16* qm = (u16*)(p.ws + B_QM);
          const float qs = 0.10206207261596575f * 1.4426950408889634f;
          const float* rope = (const float*)(p.ws + B_ROPE);
          const int e_lane = tid & 63, e_w = tid >> 6, e_wr = e_w >> 1, e_wc = e_w & 1, e_fr = e_lane & 15, e_fq = e_lane >> 4;
          const bool is_s = (mt * 128 >= TP_);
#pragma unroll
          for (int i = 0; i < 4; ++i) {
            const int row = mt * 128 + e_wr * 64 + i * 16 + e_fr;
            f32x4 vals[4];
#pragma unroll
            for (int jj = 0; jj < 4; ++jj) vals[jj] = acc[i][jj];
            if (is_s) {
              const int pos = (row - TP_) & 2047;
              const float4 cs0 = *(const float4*)(rope + (size_t)(pos * 16 + e_fq * 4) * 2);
              const float4 cs1 = *(const float4*)(rope + (size_t)(pos * 16 + e_fq * 4) * 2 + 4);
              const float cs[4] = {cs0.x, cs0.z, cs1.x, cs1.z}, sn[4] = {cs0.y, cs0.w, cs1.y, cs1.w};
#pragma unroll
              for (int jj = 0; jj < 4; jj += 2) {
                const int gt = (nt * 128 + e_wc * 64) / 16 + jj;
                if (gt % 6 == 4) {
#pragma unroll
                  for (int r = 0; r < 4; ++r) {
                    const float x1 = vals[jj][r], x2 = vals[jj + 1][r];
                    vals[jj][r] = x1 * cs[r] - x2 * sn[r];
                    vals[jj + 1][r] = x2 * cs[r] + x1 * sn[r];
                  }
                }
              }
            }
#pragma unroll
            for (int jj = 0; jj < 4; ++jj) {
              f32x4 o; o[0] = vals[jj][0] * qs; o[1] = vals[jj][1] * qs; o[2] = vals[jj][2] * qs; o[3] = vals[jj][3] * qs;
              *(uint2*)(qm + (size_t)row * 768 + nt * 128 + e_wc * 64 + jj * 16 + e_fq * 4) = pack4(o);
            }
          }
      }
      if (PH(420)) for (int j = bid; j < 208 * 8; j += nb) {
          const int q = j, mt = q >> 3, head = q & 7;
          f32x4 acc[4][4];
          zero_acc<4>(acc);
          const u16* A = mt < 192 ? (const u16*)(p.ws + B_KVA) + (size_t)mt * 128 * 256
                                  : (const u16*)(p.ws + B_CKVC) + ((size_t)l * 2048 + (size_t)(mt - 192) * 128) * 256;
          gemm_core<4, false>(acc, A, 256, WL + W_KVB + (size_t)head * 128 * 256, 256, 256, sm);
          int key0, nkeys; size_t kbo, vto;
          if (mt < 64) { const int seq = mt >> 1; key0 = (mt & 1) * 128; nkeys = 256; kbo = (size_t)(seq * 8 + head) * 256 * 96; vto = (size_t)(seq * 8 + head) * 64 * 256; }
          else if (mt < 192) { const int s = (mt - 64) >> 4; key0 = 256 + ((mt - 64) & 15) * 128; nkeys = 2304; kbo = KB_P + (size_t)(s * 8 + head) * 2304 * 96; vto = VT_P + (size_t)(s * 8 + head) * 64 * 2304; }
          else { const int s = (mt - 192) >> 1; key0 = ((mt - 192) & 1) * 128; nkeys = 2304; kbo = KB_P + (size_t)(s * 8 + head) * 2304 * 96; vto = VT_P + (size_t)(s * 8 + head) * 64 * 2304; }
          u16* kb = (u16*)(p.ws + B_KB) + kbo;
          u16* vt = (u16*)(p.ws + B_VT) + vto;
          const int e_lane = tid & 63, e_w = tid >> 6, e_wr = e_w >> 1, e_wc = e_w & 1, e_fr = e_lane & 15, e_fq = e_lane >> 4;
#pragma unroll
          for (int i = 0; i < 4; ++i)
#pragma unroll
            for (int jj = 0; jj < 4; ++jj) {
              const int key = key0 + e_wr * 64 + i * 16 + e_fq * 4;
              const int c = jj * 16 + e_fr;
              if (e_wc == 0) {
#pragma unroll
                for (int r = 0; r < 4; ++r) kb[(size_t)(key + r) * 96 + c] = f2bf(acc[i][jj][r]);
              } else {
                *(uint2*)(vt + (size_t)c * nkeys + key) = make_uint2(pack2(acc[i][jj][0], acc[i][jj][1]), pack2(acc[i][jj][2], acc[i][jj][3]));
              }
            }
      }
      if (PH(430)) for (int j = bid; j < 640; j += nb) s5_carry_tile(p, l, j);
    }
    GSYNC();
    if (PH(5)) {
      if (PH(500)) for (int j = bid; j < 320; j += nb) delta_scan_tile(p, l, j, sm);
      if (PH(510)) for (int j = bid; j < 1536; j += nb) {
        if (j < 1024) attn_tile(p, 32 + (j >> 7), (j >> 4) & 7, j & 15, sm);
        else { const int q = j - 1024; attn_tile(p, q >> 4, (q >> 1) & 7, q & 1, sm); }
      }
      if (PH(530)) for (int j = bid; j < NCH * 8; j += nb) {
        s5_chunk_tile(p, l, j >> 3, (j & 7) * 2, 1, sm);
        s5_chunk_tile(p, l, j >> 3, (j & 7) * 2 + 1, 1, sm);
      }
    }
    GSYNC();
    if (PH(6)) {
      for (int j = bid; j < T_ / 16; j += nb) delta_out_tile(p, l, j);
      for (int j = bid; j < 192 * 4; j += nb) {
        {
          const int q = j, mt = q >> 2, nt = q & 3;
          f32x4 acc[4][4];
          zero_acc<4>(acc);
          const u16* y5 = (const u16*)(p.ws + B_Y5);
          gemm_core<4>(acc, y5 + (size_t)mt * 128 * 512, 512, WL + W_GLU + (size_t)nt * 128 * 512, 512, 512, sm);
          u16* ob5 = (u16*)(p.ws + B_OB5);
          const float* bgl = p.in[27] + l * 512;
          EPI_LOOP(4) {
            const size_t row = mt * 128 + EROW; const int col = nt * 128 + ECOL4(4);
            const uint2 yy = *(const uint2*)(y5 + row * 512 + col);
            const float4 bb = *(const float4*)(bgl + col);
            f32x4 o;
            o[0] = blo(yy.x) * sigmoidf_(acc[i][j][0] + bb.x); o[1] = bhi(yy.x) * sigmoidf_(acc[i][j][1] + bb.y);
            o[2] = blo(yy.y) * sigmoidf_(acc[i][j][2] + bb.z); o[3] = bhi(yy.y) * sigmoidf_(acc[i][j][3] + bb.w);
            *(uint2*)(ob5 + row * 512 + col) = pack4(o);
          }
        }
      }
    }
    GSYNC();
    if (PH(7)) {
      const u16* H = (const u16*)(p.ws + B_H);
      u16* mg = (u16*)(p.ws + B_MG);
      for (int j = bid; j < 192 * 16; j += nb) {
        const int mt = j >> 4, nt = j & 15;
        f32x4 mer[4][2];
        zero_acc<2>(mer);
#pragma unroll 1
        for (int n = 0; n < 3; ++n) {
          f32x4 ag[4][2], ab[4][2];
          zero_acc<2>(ag);
          gemm_core<2>(ag, H + (size_t)mt * 128 * 1024, 1024, WL + W_G + (size_t)(n * 1024 + nt * 64) * 1024, 1024, 1024, sm);
          zero_acc<2>(ab);
          const u16* on = (const u16*)(p.ws + (n == 0 ? B_OA : (n == 1 ? B_OB5 : B_OC)));
          gemm_core<2>(ab, on + (size_t)mt * 128 * 512, 512, WL + W_BR + (size_t)(nt * 64) * 1536 + n * 512, 1536, 512, sm);
#pragma unroll
          for (int i = 0; i < 4; ++i)
#pragma unroll
            for (int jj = 0; jj < 2; ++jj)
#pragma unroll
              for (int r = 0; r < 4; ++r) mer[i][jj][r] += sigmoidf_(ag[i][jj][r]) * ab[i][jj][r];
        }
        EPI_LOOP(2) { *(uint2*)(mg + (size_t)(mt * 128 + EROW) * 1024 + nt * 64 + ECOL4(2)) = pack4(mer[i][j]); }
      }
    }
    GSYNC();
    if (PH(8)) {
      const u16* mg = (const u16*)(p.ws + B_MG);
      for (int j = bid; j < 192 * 8; j += nb) {
        const int mt = j >> 3, nt = j & 7;
        f32x4 acc[4][4];
        zero_acc<4>(acc);
        gemm_core<4>(acc, mg + (size_t)mt * 128 * 1024, 1024, WL + W_OUT + (size_t)nt * 128 * 1024, 1024, 1024, sm);
        const float* gm = mods + (size_t)(l * 9 + tok_v(mt * 128)) * 6144 + 2 * 1024;
        EPI_LOOP(4) {
          const size_t row = mt * 128 + EROW; const int col = nt * 128 + ECOL4(4);
          float4* xp_ = (float4*)(p.out + row * 1024 + col);
          float4 xv = *xp_; const float4 gg = *(const float4*)(gm + col);
          xv.x += gg.x * acc[i][j][0]; xv.y += gg.y * acc[i][j][1]; xv.z += gg.z * acc[i][j][2]; xv.w += gg.w * acc[i][j][3];
          *xp_ = xv;
        }
      }
    }
    GSYNC();
    if (PH(9)) norm_phase(p, l, 3, 4, p.in[12] + l * 1024);
    GSYNC();
    if (PH(10)) {
      const u16* H = (const u16*)(p.ws + B_H);
      u16* up = (u16*)(p.ws + B_UP);
      for (int j = bid; j < 192 * 44; j += nb) {
        const int mt = j / 44, nt = j % 44;
        f32x4 acc[4][4];
        zero_acc<4>(acc);
        gemm_core<4>(acc, H + (size_t)mt * 128 * 1024, 1024, WL + W_UP + (size_t)nt * 128 * 1024, 1024, 1024, sm);
        EPI_LOOP(4) { *(uint2*)(up + (size_t)(mt * 128 + EROW) * 5632 + nt * 128 + ECOL4(4)) = pack4(acc[i][j]); }
      }
    }
    GSYNC();
    if (PH(11)) {
      const int tid = otid();
      const u16* up = (const u16*)(p.ws + B_UP);
      u16* act = (u16*)(p.ws + B_ACT);
      const float* cw = p.in[35] + (size_t)l * 3 * 5632;
      const float* cb = p.in[36] + (size_t)l * 5632;
      for (int it = bid * 256 + tid; it < (T_ / 2) * 352; it += nb * 256) {
        const int t = (it / 352) * 2, c8 = (it % 352) * 8;
        int pos, L;
        if (t < TP_) { pos = t & 255; L = 256; } else { pos = (t - TP_) & 2047; L = 2048; }
        float wg[3][8], wv[3][8], bgv[8], bvv[8];
#pragma unroll
        for (int d = 0; d < 3; ++d) {
          const float4 g0 = *(const float4*)(cw + d * 5632 + c8), g1 = *(const float4*)(cw + d * 5632 + c8 + 4);
          const float4 v0 = *(const float4*)(cw + d * 5632 + 2816 + c8), v1 = *(const float4*)(cw + d * 5632 + 2816 + c8 + 4);
          wg[d][0] = g0.x; wg[d][1] = g0.y; wg[d][2] = g0.z; wg[d][3] = g0.w; wg[d][4] = g1.x; wg[d][5] = g1.y; wg[d][6] = g1.z; wg[d][7] = g1.w;
          wv[d][0] = v0.x; wv[d][1] = v0.y; wv[d][2] = v0.z; wv[d][3] = v0.w; wv[d][4] = v1.x; wv[d][5] = v1.y; wv[d][6] = v1.z; wv[d][7] = v1.w;
        }
        {
          const float4 g0 = *(const float4*)(cb + c8), g1 = *(const float4*)(cb + c8 + 4);
          const float4 v0 = *(const float4*)(cb + 2816 + c8), v1 = *(const float4*)(cb + 2816 + c8 + 4);
          bgv[0] = g0.x; bgv[1] = g0.y; bgv[2] = g0.z; bgv[3] = g0.w; bgv[4] = g1.x; bgv[5] = g1.y; bgv[6] = g1.z; bgv[7] = g1.w;
          bvv[0] = v0.x; bvv[1] = v0.y; bvv[2] = v0.z; bvv[3] = v0.w; bvv[4] = v1.x; bvv[5] = v1.y; bvv[6] = v1.z; bvv[7] = v1.w;
        }
        float rg[4][8], rv[4][8];
#pragma unroll
        for (int q = 0; q < 4; ++q) {
          const int ps = pos + q - 1;
          uint4 ug = make_uint4(0, 0, 0, 0), uv = ug;
          if (ps >= 0 && ps < L) {
            const u16* rowp = up + (size_t)(t + q - 1) * 5632;
            ug = *(const uint4*)(rowp + c8); uv = *(const uint4*)(rowp + 2816 + c8);
          }
          rg[q][0] = blo(ug.x); rg[q][1] = bhi(ug.x); rg[q][2] = blo(ug.y); rg[q][3] = bhi(ug.y); rg[q][4] = blo(ug.z); rg[q][5] = bhi(ug.z); rg[q][6] = blo(ug.w); rg[q][7] = bhi(ug.w);
          rv[q][0] = blo(uv.x); rv[q][1] = bhi(uv.x); rv[q][2] = blo(uv.y); rv[q][3] = bhi(uv.y); rv[q][4] = blo(uv.z); rv[q][5] = bhi(uv.z); rv[q][6] = blo(uv.w); rv[q][7] = bhi(uv.w);
        }
#pragma unroll
        for (int o = 0; o < 2; ++o) {
          float res[8];
#pragma unroll
          for (int e = 0; e < 8; ++e) {
            float g = bgv[e], v = bvv[e];
#pragma unroll
            for (int d = 0; d < 3; ++d) { g += wg[d][e] * rg[o + d][e]; v += wv[d][e] * rv[o + d][e]; }
            res[e] = siluf_(g) * v;
          }
          *(uint4*)(act + (size_t)(t + o) * 2816 + c8) = make_uint4(pack2(res[0], res[1]), pack2(res[2], res[3]), pack2(res[4], res[5]), pack2(res[6], res[7]));
        }
      }
    }
    GSYNC();
    if (PH(12)) {
      const u16* act = (const u16*)(p.ws + B_ACT);
      for (int j = bid; j < 192 * 8; j += nb) {
        const int mt = j >> 3, nt = j & 7;
        f32x4 acc[4][4];
        zero_acc<4>(acc);
        gemm_core<4>(acc, act + (size_t)mt * 128 * 2816, 2816, WL + W_DN + (size_t)nt * 128 * 2816, 2816, 2816, sm);
        const float* gf = mods + (size_t)(l * 9 + tok_v(mt * 128)) * 6144 + 5 * 1024;
        EPI_LOOP(4) {
          const size_t row = mt * 128 + EROW; const int col = nt * 128 + ECOL4(4);
          float4* xp_ = (float4*)(p.out + row * 1024 + col);
          float4 xv = *xp_; const float4 gg = *(const float4*)(gf + col);
          xv.x += gg.x * acc[i][j][0]; xv.y += gg.y * acc[i][j][1]; xv.z += gg.z * acc[i][j][2]; xv.w += gg.w * acc[i][j][3];
          *xp_ = xv;
        }
      }
    }
    GSYNC();
  }
  if (PH(13)) {
    const int tid = otid();
    const int lane = tid & 63, w = tid >> 6;
    const float* gfin = p.in[38];
    for (int tile = bid; tile < T_ / 4; tile += nb) {
      const int t = tile * 4 + w;
      float4* xr = (float4*)(p.out + (size_t)t * 1024);
      float4 v[4];
      float ss = 0.f;
#pragma unroll
      for (int j = 0; j < 4; ++j) { v[j] = xr[lane + 64 * j]; ss += v[j].x * v[j].x + v[j].y * v[j].y + v[j].z * v[j].z + v[j].w * v[j].w; }
      ss = wave_sum(ss);
      const float rstd = rsqrtf(ss * (1.f / 1024.f) + 1e-6f);
#pragma unroll
      for (int j = 0; j < 4; ++j) {
        float4 g = *(const float4*)(gfin + (lane + 64 * j) * 4);
        xr[lane + 64 * j] = make_float4(v[j].x * rstd * g.x, v[j].y * rstd * g.y, v[j].z * rstd * g.z, v[j].w * rstd * g.w);
      }
    }
  }
}

extern "C" void kernel_launch(void* const* d_in, const int* in_sizes, int n_in, void* d_out, int out_size,
                              void* d_ws, size_t ws_size, hipStream_t stream) {
  static int grid_blocks = 0;
  if (!grid_blocks) {
    int dev = 0, cus = 0, per_cu = 0;
    (void)hipGetDevice(&dev);
    (void)hipDeviceGetAttribute(&cus, hipDeviceAttributeMultiprocessorCount, dev);
    (void)hipOccupancyMaxActiveBlocksPerMultiprocessor(&per_cu, mega, 256, 0);
    if (per_cu > 2) per_cu = 2;
    if (per_cu < 1) per_cu = 1;
    grid_blocks = cus * per_cu;
  }
  if (ws_size < B_TOTAL || n_in < 39) {
    fprintf(stderr, "workspace too small: %zu < %zu\n", ws_size, (size_t)B_END);
    return;
  }
  Params p{};
  for (int i = 0; i < 39; ++i) p.in[i] = (const float*)d_in[i];
  p.out = (float*)d_out;
  p.ws = (char*)d_ws;
  p.bar = (unsigned*)((char*)d_ws + B_BAR);
  (void)hipMemsetAsync(p.bar, 0, 256, stream);
  void* args[] = {&p};
  hipError_t e = hipLaunchCooperativeKernel((void*)mega, dim3(grid_blocks), dim3(256), args, 0, stream);
  if (e != hipSuccess) fprintf(stderr, "cooperative launch failed: %s (grid %d)\n", hipGetErrorString(e), grid_blocks);
}
```

```cpp
#include <hip/hip_runtime.h>
#include <hip/hip_cooperative_groups.h>
#include <cstdio>
namespace cg = cooperative_groups;

#define DI __device__ __forceinline__
typedef __bf16 bf16;
using bf16x8 = __attribute__((ext_vector_type(8))) short;
using f32x4 = __attribute__((ext_vector_type(4))) float;
using f32x16 = __attribute__((ext_vector_type(16))) float;
typedef unsigned short u16;

constexpr int T_ = 24576, TP_ = 8192;
constexpr int NCH = 384;
constexpr long long O_SD = 25165824LL, O_S5RE = 41943040LL, O_S5IM = 42467328LL, O_CKV = 42991616LL, O_KR = 51380224LL;

constexpr size_t W_IN = 0;
constexpr size_t W_G = W_IN + 3328ull * 1024;
constexpr size_t W_QB = W_G + 3072ull * 1024;
constexpr size_t W_KVB = W_QB + 768ull * 384;
constexpr size_t W_GLU = W_KVB + 1024ull * 256;
constexpr size_t W_BR = W_GLU + 512ull * 512;
constexpr size_t W_OUT = W_BR + 1024ull * 1536;
constexpr size_t W_UP = W_OUT + 1024ull * 1024;
constexpr size_t W_DN = W_UP + 5632ull * 1024;
constexpr size_t W_LAYER = W_DN + 1024ull * 2816;

constexpr size_t al(size_t x) { return (x + 255) & ~(size_t)255; }
constexpr size_t B_W = 0;
constexpr size_t B_MODS = al(B_W + 4 * W_LAYER * 2);
constexpr size_t B_ROPE = al(B_MODS + 4ull * 9 * 6144 * 4);
constexpr size_t B_LAMB = al(B_ROPE + 2048ull * 32 * 4);
constexpr size_t B_LAM64 = al(B_LAMB + 4ull * 2 * 32 * 64 * 8);
constexpr size_t B_BBT = al(B_LAM64 + 4ull * 2 * 32 * 64 * 8);
constexpr size_t B_CMT = al(B_BBT + 4ull * 2 * 32 * 128 * 16 * 2);
constexpr size_t B_CKVC = al(B_CMT + 4ull * 32 * 16 * 128 * 2);
constexpr size_t B_H = al(B_CKVC + 4ull * 2048 * 256 * 2);
constexpr size_t B_QKV = al(B_H + (size_t)T_ * 1024 * 2);
constexpr size_t B_Z = al(B_QKV + (size_t)T_ * 1536 * 2);
constexpr size_t B_US5 = al(B_Z + (size_t)T_ * 512 * 2);
constexpr size_t B_QA = al(B_US5 + (size_t)T_ * 512 * 2);
constexpr size_t B_KVA = al(B_QA + (size_t)T_ * 384 * 2);
constexpr size_t B_MISC = al(B_KVA + (size_t)T_ * 256 * 2);
constexpr size_t B_QN = al(B_MISC + (size_t)T_ * 48 * 4);
constexpr size_t B_KN = al(B_QN + (size_t)T_ * 512 * 2);
constexpr size_t B_VV = al(B_KN + (size_t)T_ * 512 * 2);
constexpr size_t B_KT = al(B_VV + (size_t)T_ * 512 * 2);
constexpr size_t B_BG = al(B_KT + (size_t)T_ * 512 * 2);
constexpr size_t B_TM = al(B_BG + (size_t)T_ * 16 * 4);
constexpr size_t B_QKM = al(B_TM + (size_t)T_ * 512 * 2);
constexpr size_t B_GC = al(B_QKM + (size_t)T_ * 512 * 2);
constexpr size_t B_BC = al(B_GC + (size_t)NCH * 4 * 2 * 64 * 4);
constexpr size_t KB_P = 32ull * 8 * 256 * 96, KB_S = 8ull * 8 * 2304 * 96;
constexpr size_t VT_P = 32ull * 8 * 64 * 256, VT_S = 8ull * 8 * 64 * 2304;
constexpr size_t B_KB = al(B_BC + (size_t)NCH * 4 * 2 * 64 * 4);
constexpr size_t B_VT = al(B_KB + (KB_P + KB_S) * 2);
constexpr size_t B_QM = al(B_VT + (VT_P + VT_S) * 2);
constexpr size_t B_HEND = al(B_QM + (size_t)T_ * 768 * 2);
constexpr size_t B_HIN = al(B_HEND + (size_t)NCH * 32 * 2 * 64 * 8);
constexpr size_t B_Y5 = al(B_HIN + (size_t)NCH * 32 * 2 * 64 * 8);
constexpr size_t B_OC = al(B_Y5 + (size_t)T_ * 512 * 2);
constexpr size_t B_END = al(B_OC + (size_t)T_ * 512 * 2);
constexpr size_t B_OF = B_QKV;
constexpr size_t B_OB = B_QKV + (size_t)T_ * 512 * 2;
constexpr size_t B_MG = B_QKV;
constexpr size_t B_OA = B_QN;
constexpr size_t B_OB5 = B_KN;
constexpr size_t B_UP = B_QKV;
constexpr size_t B_ACT = B_KB;
static_assert(B_UP + (size_t)T_ * 5632 * 2 <= B_KB, "UP overlaps ACT");
static_assert(B_ACT + (size_t)T_ * 2816 * 2 <= B_END, "ACT too big");
constexpr size_t B_BAR = B_END;
constexpr size_t B_TOTAL = B_BAR + 256;
static_assert(B_TOTAL <= 768ull * 1024 * 1024, "workspace too big");

struct Params {
  const float* in[39];
  float* out;
  char* ws;
  unsigned* bar;
};

DI int otid() { int t = (int)__builtin_amdgcn_workitem_id_x(); asm volatile("" : "+v"(t)); return t; }
DI unsigned pack2(float a, float b) {
  typedef __attribute__((ext_vector_type(2))) __bf16 bf2;
  bf2 v; v[0] = (__bf16)a; v[1] = (__bf16)b;
  return __builtin_bit_cast(unsigned, v);
}
DI u16 f2bf(float a) { return (u16)(pack2(a, 0.f) & 0xffffu); }
DI float bf2f(u16 u) { return __uint_as_float(((unsigned)u) << 16); }
DI float blo(unsigned u) { return __uint_as_float(u << 16); }
DI float bhi(unsigned u) { return __uint_as_float(u & 0xffff0000u); }
DI float wave_sum(float v) {
#pragma unroll
  for (int o = 32; o > 0; o >>= 1) v += __shfl_xor(v, o);
  return v;
}
DI float sigmoidf_(float x) { return 1.f / (1.f + __expf(-x)); }
DI float siluf_(float x) { return x / (1.f + __expf(-x)); }
DI int tok_v(int t) { return t < TP_ ? 0 : 1 + ((t - TP_) >> 11); }
DI int crow(int r, int h2) { return (r & 3) + 8 * (r >> 2) + 4 * h2; }
DI bf16x8 mk8(unsigned a, unsigned b, unsigned c, unsigned d) {
  uint4 p = make_uint4(a, b, c, d);
  return __builtin_bit_cast(bf16x8, p);
}
DI bf16x8 pack_acc(const f32x16& x, int s) {
  return mk8(pack2(x[8 * s], x[8 * s + 1]), pack2(x[8 * s + 2], x[8 * s + 3]), pack2(x[8 * s + 4], x[8 * s + 5]),
             pack2(x[8 * s + 6], x[8 * s + 7]));
}
DI bf16x8 load_perm(const u16* rowptr, int s, int h2) {
  uint2 a = *(const uint2*)(rowptr + 16 * s + 4 * h2);
  uint2 b = *(const uint2*)(rowptr + 16 * s + 8 + 4 * h2);
  return mk8(a.x, a.y, b.x, b.y);
}
DI unsigned swap16(unsigned u) { return (u >> 16) | (u << 16); }
DI bf16x8 load_perm_rev(const u16* rowptr, int base, int s, int h2) {
  uint2 a = *(const uint2*)(rowptr + 60 - base - 16 * s - 4 * h2);
  uint2 b = *(const uint2*)(rowptr + 52 - base - 16 * s - 4 * h2);
  return mk8(swap16(a.y), swap16(a.x), swap16(b.y), swap16(b.x));
}
#define MFMA16(a, b, c) __builtin_amdgcn_mfma_f32_16x16x32_bf16((a), (b), (c), 0, 0, 0)
#define MFMA32(a, b, c) __builtin_amdgcn_mfma_f32_32x32x16_bf16((a), (b), (c), 0, 0, 0)

template <int NJ, bool SWAP = true>
DI void gemm_core(f32x4 (&acc)[4][NJ], const u16* __restrict__ A, int lda, const u16* __restrict__ B, int ldb, int K,
                  u16* sm) {
  const int tid = otid(), lane = tid & 63, w = tid >> 6, wr = w >> 1, wc = w & 1;
  const int fr = lane & 15, fq = lane >> 4;
  constexpr int RS = 136;
  const int lrow = tid >> 4, lkc = tid & 15;
  uint4 a0, a1, a2, a3, a4, a5, a6, a7, b0, b1, b2, b3, b4, b5, b6, b7;
  b4 = b5 = b6 = b7 = make_uint4(0, 0, 0, 0);
  const u16* ap = A + (size_t)lrow * lda + lkc * 8;
  const u16* bp = B + (size_t)lrow * ldb + lkc * 8;
  const int nk = K >> 7;
  u16* as = sm;
  u16* bs = sm + 128 * RS;
  {
    const int k0 = 0;
    a0 = *(const uint4*)(ap + (size_t)(0 * 16) * lda + k0);
    a1 = *(const uint4*)(ap + (size_t)(1 * 16) * lda + k0);
    a2 = *(const uint4*)(ap + (size_t)(2 * 16) * lda + k0);
    a3 = *(const uint4*)(ap + (size_t)(3 * 16) * lda + k0);
    a4 = *(const uint4*)(ap + (size_t)(4 * 16) * lda + k0);
    a5 = *(const uint4*)(ap + (size_t)(5 * 16) * lda + k0);
    a6 = *(const uint4*)(ap + (size_t)(6 * 16) * lda + k0);
    a7 = *(const uint4*)(ap + (size_t)(7 * 16) * lda + k0);
    b0 = *(const uint4*)(bp + (size_t)(0 * 16) * ldb + k0);
    b1 = *(const uint4*)(bp + (size_t)(1 * 16) * ldb + k0);
    b2 = *(const uint4*)(bp + (size_t)(2 * 16) * ldb + k0);
    b3 = *(const uint4*)(bp + (size_t)(3 * 16) * ldb + k0);
    if (NJ == 4) b4 = *(const uint4*)(bp + (size_t)(4 * 16) * ldb + k0);
    if (NJ == 4) b5 = *(const uint4*)(bp + (size_t)(5 * 16) * ldb + k0);
    if (NJ == 4) b6 = *(const uint4*)(bp + (size_t)(6 * 16) * ldb + k0);
    if (NJ == 4) b7 = *(const uint4*)(bp + (size_t)(7 * 16) * ldb + k0);
  }
  for (int kt = 0; kt < nk; ++kt) {
    __syncthreads();
    *(uint4*)(as + (lrow + 0 * 16) * RS + lkc * 8) = a0;
    *(uint4*)(as + (lrow + 1 * 16) * RS + lkc * 8) = a1;
    *(uint4*)(as + (lrow + 2 * 16) * RS + lkc * 8) = a2;
    *(uint4*)(as + (lrow + 3 * 16) * RS + lkc * 8) = a3;
    *(uint4*)(as + (lrow + 4 * 16) * RS + lkc * 8) = a4;
    *(uint4*)(as + (lrow + 5 * 16) * RS + lkc * 8) = a5;
    *(uint4*)(as + (lrow + 6 * 16) * RS + lkc * 8) = a6;
    *(uint4*)(as + (lrow + 7 * 16) * RS + lkc * 8) = a7;
    *(uint4*)(bs + (lrow + 0 * 16) * RS + lkc * 8) = b0;
    *(uint4*)(bs + (lrow + 1 * 16) * RS + lkc * 8) = b1;
    *(uint4*)(bs + (lrow + 2 * 16) * RS + lkc * 8) = b2;
    *(uint4*)(bs + (lrow + 3 * 16) * RS + lkc * 8) = b3;
    if (NJ == 4) *(uint4*)(bs + (lrow + 4 * 16) * RS + lkc * 8) = b4;
    if (NJ == 4) *(uint4*)(bs + (lrow + 5 * 16) * RS + lkc * 8) = b5;
    if (NJ == 4) *(uint4*)(bs + (lrow + 6 * 16) * RS + lkc * 8) = b6;
    if (NJ == 4) *(uint4*)(bs + (lrow + 7 * 16) * RS + lkc * 8) = b7;
    __syncthreads();
    {
      const int k0 = (kt + 1 < nk ? kt + 1 : kt) * 128;
    a0 = *(const uint4*)(ap + (size_t)(0 * 16) * lda + k0);
    a1 = *(const uint4*)(ap + (size_t)(1 * 16) * lda + k0);
    a2 = *(const uint4*)(ap + (size_t)(2 * 16) * lda + k0);
    a3 = *(const uint4*)(ap + (size_t)(3 * 16) * lda + k0);
    a4 = *(const uint4*)(ap + (size_t)(4 * 16) * lda + k0);
    a5 = *(const uint4*)(ap + (size_t)(5 * 16) * lda + k0);
    a6 = *(const uint4*)(ap + (size_t)(6 * 16) * lda + k0);
    a7 = *(const uint4*)(ap + (size_t)(7 * 16) * lda + k0);
    b0 = *(const uint4*)(bp + (size_t)(0 * 16) * ldb + k0);
    b1 = *(const uint4*)(bp + (size_t)(1 * 16) * ldb + k0);
    b2 = *(const uint4*)(bp + (size_t)(2 * 16) * ldb + k0);
    b3 = *(const uint4*)(bp + (size_t)(3 * 16) * ldb + k0);
    if (NJ == 4) b4 = *(const uint4*)(bp + (size_t)(4 * 16) * ldb + k0);
    if (NJ == 4) b5 = *(const uint4*)(bp + (size_t)(5 * 16) * ldb + k0);
    if (NJ == 4) b6 = *(const uint4*)(bp + (size_t)(6 * 16) * ldb + k0);
    if (NJ == 4) b7 = *(const uint4*)(bp + (size_t)(7 * 16) * ldb + k0);
    }
    __builtin_amdgcn_s_setprio(1);
#pragma unroll
    for (int ks = 0; ks < 4; ++ks) {
      bf16x8 af[4], bfr[NJ];
#pragma unroll
      for (int i = 0; i < 4; ++i) af[i] = *(const bf16x8*)(as + (wr * 64 + i * 16 + fr) * RS + ks * 32 + fq * 8);
#pragma unroll
      for (int j = 0; j < NJ; ++j) bfr[j] = *(const bf16x8*)(bs + (wc * NJ * 16 + j * 16 + fr) * RS + ks * 32 + fq * 8);
#pragma unroll
      for (int i = 0; i < 4; ++i)
#pragma unroll
        for (int j = 0; j < NJ; ++j) acc[i][j] = SWAP ? MFMA16(bfr[j], af[i], acc[i][j]) : MFMA16(af[i], bfr[j], acc[i][j]);
    }
    __builtin_amdgcn_s_setprio(0);
  }
}
template <int NJ>
DI void zero_acc(f32x4 (&acc)[4][NJ]) {
#pragma unroll
  for (int i = 0; i < 4; ++i)
#pragma unroll
    for (int j = 0; j < NJ; ++j) acc[i][j] = f32x4{0.f, 0.f, 0.f, 0.f};
}
#define EPI_LOOP(NJ_)                                                              \
  const int e_lane = otid() & 63, e_w = otid() >> 6;                               \
  const int e_wr = e_w >> 1, e_wc = e_w & 1, e_fr = e_lane & 15, e_fq = e_lane >> 4; \
  _Pragma("unroll") for (int i = 0; i < 4; ++i)                                    \
  _Pragma("unroll") for (int j = 0; j < NJ_; ++j)
#define EROW (e_wr * 64 + i * 16 + e_fr)
#define ECOL4(NJ_) (e_wc * NJ_ * 16 + j * 16 + e_fq * 4)
DI uint2 pack4(const f32x4& v) { return make_uint2(pack2(v[0], v[1]), pack2(v[2], v[3])); }

DI int colmap(int kind, int n) {
  if (kind == 0) {
    if (n < 2048) return n;
    if (n < 2560) return 2064 + (n - 2048);
    if (n < 2944) return 2576 + (n - 2560);
    if (n < 3200) return 2960 + (n - 2944);
    int j = n - 3200;
    if (j < 16) return 2048 + j;
    if (j < 48) return 3216 + (j - 16);
    return -1;
  }
  if (kind == 1) return 3248 + n;
  return n;
}
DI void convT_tile(const float* __restrict__ src, int lds, int K, u16* __restrict__ dst, int kind, int kt, int nt,
                   float* sm) {
  const int tid = otid();
  const int c = tid & 63;
  const int sc = colmap(kind, nt * 64 + c);
  __syncthreads();
#pragma unroll 4
  for (int i = 0; i < 16; ++i) {
    int r = (tid >> 6) + i * 4;
    float v = sc >= 0 ? src[(size_t)(kt * 64 + r) * lds + sc] : 0.f;
    sm[r * 65 + c] = v;
  }
  __syncthreads();
  const int n = tid >> 2, kq = tid & 3;
  unsigned pk[8];
#pragma unroll
  for (int j = 0; j < 8; ++j) pk[j] = pack2(sm[(kq * 16 + 2 * j) * 65 + n], sm[(kq * 16 + 2 * j + 1) * 65 + n]);
  u16* d = dst + (size_t)(nt * 64 + n) * K + kt * 64 + kq * 16;
  *(uint4*)d = make_uint4(pk[0], pk[1], pk[2], pk[3]);
  *(uint4*)(d + 8) = make_uint4(pk[4], pk[5], pk[6], pk[7]);
}
constexpr int CJ0 = 16 * 52, CJ1 = CJ0 + 16 * 48, CJ2 = CJ1 + 6 * 12, CJ3 = CJ2 + 4 * 16, CJ4 = CJ3 + 8 * 8,
              CJ5 = CJ4 + 24 * 16, CJ6 = CJ5 + 16 * 16, CJ7 = CJ6 + 16 * 88, CJ8 = CJ7 + 44 * 16;
DI void conv_job(const Params& p, int l, int j, float* sm) {
  u16* wl = (u16*)(p.ws + B_W) + (size_t)l * W_LAYER;
  if (j < CJ0) { convT_tile(p.in[13] + (size_t)l * 1024 * 6320, 6320, 1024, wl + W_IN, 0, j / 52, j % 52, sm); return; }
  if (j < CJ1) { j -= CJ0; convT_tile(p.in[13] + (size_t)l * 1024 * 6320, 6320, 1024, wl + W_G, 1, j / 48, j % 48, sm); return; }
  if (j < CJ2) { j -= CJ1; convT_tile(p.in[29] + (size_t)l * 384 * 768, 768, 384, wl + W_QB, 2, j / 12, j % 12, sm); return; }
  if (j < CJ3) { j -= CJ2; convT_tile(p.in[31] + (size_t)l * 256 * 1024, 1024, 256, wl + W_KVB, 2, j / 16, j % 16, sm); return; }
  if (j < CJ4) { j -= CJ3; convT_tile(p.in[26] + (size_t)l * 512 * 512, 512, 512, wl + W_GLU, 2, j / 8, j % 8, sm); return; }
  if (j < CJ5) { j -= CJ4; convT_tile(p.in[32] + (size_t)l * 1536 * 1024, 1024, 1536, wl + W_BR, 2, j / 16, j % 16, sm); return; }
  if (j < CJ6) { j -= CJ5; convT_tile(p.in[33] + (size_t)l * 1024 * 1024, 1024, 1024, wl + W_OUT, 2, j / 16, j % 16, sm); return; }
  if (j < CJ7) { j -= CJ6; convT_tile(p.in[34] + (size_t)l * 1024 * 5632, 5632, 1024, wl + W_UP, 2, j / 88, j % 88, sm); return; }
  j -= CJ7; convT_tile(p.in[37] + (size_t)l * 2816 * 1024, 1024, 2816, wl + W_DN, 2, j / 16, j % 16, sm);
}
DI void mods_tile(const Params& p, int l, int jg, float* sm) {
  const int tid = otid();
  __syncthreads();
  for (int i = tid; i < 9 * 1024; i += 256) {
    int v = i >> 10, k = i & 1023;
    float cv = v == 0 ? p.in[8][k] : p.in[7][(v - 1) * 1024 + k];
    sm[i] = cv / (1.f + __expf(-cv));
  }
  __syncthreads();
  const int col = jg * 64 + (tid & 63), kq = tid >> 6;
  float acc[9];
#pragma unroll
  for (int v = 0; v < 9; ++v) acc[v] = 0.f;
  const float* wp = p.in[9] + (size_t)l * 1024 * 6144 + col;
#pragma unroll 4
  for (int k = kq * 256; k < kq * 256 + 256; ++k) {
    float wv = wp[(size_t)k * 6144];
#pragma unroll
    for (int v = 0; v < 9; ++v) acc[v] += sm[v * 1024 + k] * wv;
  }
  float* red = sm + 9 * 1024;
#pragma unroll
  for (int v = 0; v < 9; ++v) red[(kq * 9 + v) * 64 + (tid & 63)] = acc[v];
  __syncthreads();
  if (kq == 0) {
    float* mods = (float*)(p.ws + B_MODS);
    float b = p.in[10][l * 6144 + col];
#pragma unroll
    for (int v = 0; v < 9; ++v) {
      float s = red[(0 * 9 + v) * 64 + tid] + red[(1 * 9 + v) * 64 + tid] + red[(2 * 9 + v) * 64 + tid] + red[(3 * 9 + v) * 64 + tid];
      mods[(size_t)(l * 9 + v) * 6144 + col] = s + b;
    }
  }
}
DI void s5pre_tile(const Params& p, int tile) {
  const int id = tile * 256 + otid();
  const int pp = id & 63, g = (id >> 6) & 31, dir = (id >> 11) & 1, l = id >> 12;
  const float lre = p.in[18][((l * 2 + dir) * 32 + g) * 64 + pp];
  const float lim = p.in[19][((l * 2 + dir) * 32 + g) * 64 + pp];
  const float dt = expf(p.in[20][(l * 2 + dir) * 32 + g]);
  float er = expf(lre * dt), sn, cs;
  sincosf(lim * dt, &sn, &cs);
  const float lbr = er * cs, lbi = er * sn;
  float e64 = expf(64.f * lre * dt), s64, c64;
  sincosf(64.f * lim * dt, &s64, &c64);
  float2* lamb = (float2*)(p.ws + B_LAMB);
  float2* lam64 = (float2*)(p.ws + B_LAM64);
  const int li = ((l * 2 + dir) * 32 + g) * 64 + pp;
  lamb[li] = make_float2(lbr, lbi);
  lam64[li] = make_float2(e64 * c64, e64 * s64);
  const float nr = lbr - 1.f, ni = lbi, den = lre * lre + lim * lim;
  const float cr = (nr * lre + ni * lim) / den, ci = (ni * lre - nr * lim) / den;
  u16* bbt = (u16*)(p.ws + B_BBT) + (size_t)((l * 2 + dir) * 32 + g) * 128 * 16;
  const float* bre = p.in[21] + (size_t)((l * 32 + g) * 64 + pp) * 16;
  const float* bim = p.in[22] + (size_t)((l * 32 + g) * 64 + pp) * 16;
#pragma unroll
  for (int c = 0; c < 16; ++c) {
    float br = bre[c], bi = bim[c];
    bbt[pp * 16 + c] = f2bf(cr * br - ci * bi);
    bbt[(64 + pp) * 16 + c] = f2bf(cr * bi + ci * br);
  }
  if (dir == 0) {
    u16* cmt = (u16*)(p.ws + B_CMT) + (size_t)(l * 32 + g) * 16 * 128;
    const float* cre = p.in[23] + (size_t)(l * 32 + g) * 16 * 64;
    const float* cim = p.in[24] + (size_t)(l * 32 + g) * 16 * 64;
#pragma unroll
    for (int c = 0; c < 16; ++c) {
      cmt[c * 128 + pp] = f2bf(cre[c * 64 + pp]);
      cmt[c * 128 + 64 + pp] = f2bf(-cim[c * 64 + pp]);
    }
  }
}

DI void norm_phase(const Params& p, int l, int shift_idx, int scale_idx, const float* gn) {
  const float* x = p.out;
  u16* H = (u16*)(p.ws + B_H);
  const float* mods = (const float*)(p.ws + B_MODS);
  const int lane = otid() & 63, w = otid() >> 6;
  for (int tile = blockIdx.x; tile < T_ / 4; tile += gridDim.x) {
    const int t = tile * 4 + w;
    const float4* xr = (const float4*)(x + (size_t)t * 1024);
    float4 v[4];
    float ss = 0.f;
#pragma unroll
    for (int j = 0; j < 4; ++j) {
      v[j] = xr[lane + 64 * j];
      ss += v[j].x * v[j].x + v[j].y * v[j].y + v[j].z * v[j].z + v[j].w * v[j].w;
    }
    ss = wave_sum(ss);
    const float rstd = rsqrtf(ss * (1.f / 1024.f) + 1e-6f);
    const float* mb = mods + (size_t)(l * 9 + tok_v(t)) * 6144;
#pragma unroll
    for (int j = 0; j < 4; ++j) {
      const int c = (lane + 64 * j) * 4;
      float4 g = *(const float4*)(gn + c);
      float4 sc = *(const float4*)(mb + scale_idx * 1024 + c);
      float4 sh = *(const float4*)(mb + shift_idx * 1024 + c);
      float y0 = v[j].x * rstd * g.x * (1.f + sc.x) + sh.x;
      float y1 = v[j].y * rstd * g.y * (1.f + sc.y) + sh.y;
      float y2 = v[j].z * rstd * g.z * (1.f + sc.z) + sh.z;
      float y3 = v[j].w * rstd * g.w * (1.f + sc.w) + sh.w;
      *(uint2*)(H + (size_t)t * 1024 + c) = make_uint2(pack2(y0, y1), pack2(y2, y3));
    }
  }
}

DI void gemm_in_phase(const Params& p, int l, u16* sm) {
  const u16* H = (const u16*)(p.ws + B_H);
  const u16* Wt = (const u16*)(p.ws + B_W) + (size_t)l * W_LAYER + W_IN;
  for (int tile = blockIdx.x; tile < 192 * 26; tile += gridDim.x) {
    const int mt = tile / 26, nt = tile % 26;
    f32x4 acc[4][4];
    zero_acc<4>(acc);
    gemm_core<4>(acc, H + (size_t)mt * 128 * 1024, 1024, Wt + (size_t)nt * 128 * 1024, 1024, 1024, sm);
    if (nt < 25) {
      u16* dst; int ld, c0;
      if (nt < 12) { dst = (u16*)(p.ws + B_QKV); ld = 1536; c0 = nt * 128; }
      else if (nt < 16) { dst = (u16*)(p.ws + B_Z); ld = 512; c0 = (nt - 12) * 128; }
      else if (nt < 20) { dst = (u16*)(p.ws + B_US5); ld = 512; c0 = (nt - 16) * 128; }
      else if (nt < 23) { dst = (u16*)(p.ws + B_QA); ld = 384; c0 = (nt - 20) * 128; }
      else { dst = (u16*)(p.ws + B_KVA); ld = 256; c0 = (nt - 23) * 128; }
      EPI_LOOP(4) { *(uint2*)(dst + (size_t)(mt * 128 + EROW) * ld + c0 + ECOL4(4)) = pack4(acc[i][j]); }
    } else {
      float* misc = (float*)(p.ws + B_MISC);
      EPI_LOOP(4) {
        const int c = ECOL4(4);
        if (c < 48) *(float4*)(misc + (size_t)(mt * 128 + EROW) * 48 + c) = make_float4(acc[i][j][0], acc[i][j][1], acc[i][j][2], acc[i][j][3]);
      }
    }
  }
}

DI void delta_prep_tile(const Params& p, int l, int chunk, u16* sm) {
  const int tid = otid(), lane = tid & 63, w = tid >> 6;
  const int tb = chunk * 64;
  int pos0, L;
  if (tb < TP_) { pos0 = tb & 255; L = 256; } else { pos0 = (tb - TP_) & 2047; L = 2048; }
  const u16* qkv = (const u16*)(p.ws + B_QKV);
  const float* cw = p.in[14] + (size_t)l * 5 * 1536;
  u16* ksm = sm + w * (64 * 130);
  __syncthreads();
  for (int gi = w; gi < 12; gi += 4) {
    const int ch = gi * 128 + 2 * lane;
    float w0[5], w1[5];
#pragma unroll
    for (int i = 0; i < 5; ++i) { w0[i] = cw[i * 1536 + ch]; w1[i] = cw[i * 1536 + ch + 1]; }
    float a0[5], a1[5];
#pragma unroll
    for (int i = 0; i < 4; ++i) {
      int ps = pos0 - 2 + i;
      unsigned u = (ps >= 0 && ps < L) ? *(const unsigned*)(qkv + (size_t)(tb - 2 + i) * 1536 + ch) : 0u;
      a0[i + 1] = blo(u); a1[i + 1] = bhi(u);
    }
    u16* dst = (u16*)(p.ws + (gi < 4 ? B_QN : (gi < 8 ? B_KN : B_VV)));
    const int hh = gi & 3;
    for (int tt = 0; tt < 64; ++tt) {
#pragma unroll
      for (int i = 0; i < 4; ++i) { a0[i] = a0[i + 1]; a1[i] = a1[i + 1]; }
      {
        int ps = pos0 + tt + 2;
        unsigned u = (ps < L) ? *(const unsigned*)(qkv + (size_t)(tb + tt + 2) * 1536 + ch) : 0u;
        a0[4] = blo(u); a1[4] = bhi(u);
      }
      float y0 = 0.f, y1 = 0.f;
#pragma unroll
      for (int i = 0; i < 5; ++i) { y0 += w0[i] * a0[i]; y1 += w1[i] * a1[i]; }
      y0 = siluf_(y0); y1 = siluf_(y1);
      if (gi < 8) {
        float ss = wave_sum(y0 * y0 + y1 * y1);
        float sc = rsqrtf(ss + 1e-6f);
        if (gi < 4) sc *= 0.08838834764831845f;
        y0 *= sc; y1 *= sc;
      }
      const unsigned pk = pack2(y0, y1);
      *(unsigned*)(dst + (size_t)(tb + tt) * 512 + hh * 128 + 2 * lane) = pk;
      if (gi >= 4 && gi < 8) *(unsigned*)(ksm + tt * 130 + 2 * lane) = pk;
    }
    if (gi >= 4 && gi < 8) {
      u16* kt = (u16*)(p.ws + B_KT) + (size_t)(chunk * 4 + hh) * 128 * 64;
#pragma unroll
      for (int rr = 0; rr < 2; ++rr) {
        const int dk = lane + 64 * rr;
        unsigned pk[32];
#pragma unroll
        for (int t2 = 0; t2 < 32; ++t2) pk[t2] = (unsigned)ksm[(2 * t2) * 130 + dk] | ((unsigned)ksm[(2 * t2 + 1) * 130 + dk] << 16);
#pragma unroll
        for (int q = 0; q < 8; ++q) *(uint4*)(kt + dk * 64 + q * 8) = make_uint4(pk[4 * q], pk[4 * q + 1], pk[4 * q + 2], pk[4 * q + 3]);
      }
    }
  }
  const float* misc = (const float*)(p.ws + B_MISC);
  float* bg = (float*)(p.ws + B_BG);
  for (int i = tid; i < 512; i += 256) {
    const int tt = i >> 3, dh = i & 7;
    const size_t t = tb + tt;
    float bl = misc[t * 48 + dh], alp = misc[t * 48 + 8 + dh];
    float x = alp + p.in[16][l * 8 + dh];
    float sp = x > 20.f ? x : log1pf(__expf(x));
    bg[t * 16 + dh] = sigmoidf_(bl);
    bg[t * 16 + 8 + dh] = -__expf(p.in[15][l * 8 + dh]) * sp;
  }
}

DI size_t kb_off(int t, int head) {
  if (t < TP_) return ((size_t)((t >> 8) * 8 + head) * 256 + (t & 255)) * 96;
  const int s = (t - TP_) >> 11, pos = (t - TP_) & 2047;
  return KB_P + ((size_t)(s * 8 + head) * 2304 + 256 + pos) * 96;
}
DI void mla_prep_tile(const Params& p, int l, int tile) {
  const int lane = otid() & 63, w = otid() >> 6;
  const int t = tile * 4 + w;
  u16* qa = (u16*)(p.ws + B_QA) + (size_t)t * 384;
  u16* kva = (u16*)(p.ws + B_KVA) + (size_t)t * 256;
  const float* misc = (const float*)(p.ws + B_MISC) + (size_t)t * 48;
  {
    unsigned u[3]; float ss = 0.f;
#pragma unroll
    for (int j = 0; j < 3; ++j) { u[j] = *(const unsigned*)(qa + 2 * lane + 128 * j); float a = blo(u[j]), b = bhi(u[j]); ss += a * a + b * b; }
    ss = wave_sum(ss);
    const float rstd = rsqrtf(ss * (1.f / 384.f) + 1e-6f);
    const float* g = p.in[28] + l * 384;
#pragma unroll
    for (int j = 0; j < 3; ++j) {
      int c = 2 * lane + 128 * j;
      *(unsigned*)(qa + c) = pack2(blo(u[j]) * rstd * g[c], bhi(u[j]) * rstd * g[c + 1]);
    }
  }
  {
    unsigned u[2]; float ss = 0.f;
#pragma unroll
    for (int j = 0; j < 2; ++j) { u[j] = *(const unsigned*)(kva + 2 * lane + 128 * j); float a = blo(u[j]), b = bhi(u[j]); ss += a * a + b * b; }
    ss = wave_sum(ss);
    const float rstd = rsqrtf(ss * (1.f / 256.f) + 1e-6f);
    const float* g = p.in[30] + l * 256;
#pragma unroll
    for (int j = 0; j < 2; ++j) {
      int c = 2 * lane + 128 * j;
      float a = blo(u[j]) * rstd * g[c], b = bhi(u[j]) * rstd * g[c + 1];
      *(unsigned*)(kva + c) = pack2(a, b);
      if (t < TP_) {
        float* o = p.out + O_CKV + ((size_t)((t >> 8) * 4 + l) * 256 + (t & 255)) * 256 + c;
        *(float2*)o = make_float2(a, b);
      }
    }
  }
  {
    const int i = lane & 31;
    float kr = misc[16 + i];
    float val;
    if (t < TP_) {
      val = kr;
      if (lane < 32) p.out[O_KR + ((size_t)((t >> 8) * 4 + l) * 256 + (t & 255)) * 32 + i] = kr;
    } else {
      const int pos = (t - TP_) & 2047;
      const float* rp = (const float*)(p.ws + B_ROPE) + (size_t)pos * 32 + (i & 15) * 2;
      const float cs = rp[0], sn = rp[1];
      float other = __shfl_xor(kr, 16);
      val = (i < 16) ? (kr * cs - other * sn) : (kr * cs + other * sn);
    }
    u16* kb = (u16*)(p.ws + B_KB);
    const u16 bv = f2bf(val);
#pragma unroll
    for (int hh = 0; hh < 4; ++hh) {
      int head = hh * 2 + (lane >> 5);
      kb[kb_off(t, head) + 64 + i] = bv;
    }
  }
}
DI void cache_rope_tile(const Params& p, int l, int tile) {
  const int pr = tile * 8 + (otid() >> 5), i = otid() & 31;
  const int s = pr >> 8, pos = pr & 255;
  const float v = p.in[6][((size_t)(s * 4 + l) * 256 + pos) * 32 + i];
  u16* kb = (u16*)(p.ws + B_KB);
  const u16 bv = f2bf(v);
#pragma unroll
  for (int head = 0; head < 8; ++head) kb[KB_P + ((size_t)(s * 8 + head) * 2304 + pos) * 96 + 64 + i] = bv;
}

DI float gelu_tanh(float x) {
  const float k0 = 0.7978845608028654f, k1 = 0.044715f;
  float u = k0 * (x + k1 * x * x * x);
  float e = __expf(2.f * u);
  float th = 1.f - 2.f / (e + 1.f);
  return 0.5f * x * (1.f + th);
}
DI void s5_chunk_tile(const Params& p, int l, int chunk, int gp, int mode, u16* sm) {
  const int tid = otid(), lane = tid & 63, w = tid >> 6;
  const u16* us5 = (const u16*)(p.ws + B_US5);
  constexpr int RS = 136;
  const int gi_w = w >> 1, half = w & 1, g_w = gp * 2 + gi_w;
  const int n = lane & 31, h2 = lane >> 5;
  bf16x8 af[2], bq[2][2];
#pragma unroll
  for (int mi = 0; mi < 2; ++mi) af[mi] = *(const bf16x8*)(us5 + (size_t)(chunk * 64 + mi * 32 + n) * 512 + g_w * 16 + 8 * h2);
#pragma unroll
  for (int dir = 0; dir < 2; ++dir) {
    const u16* bbt = (const u16*)(p.ws + B_BBT) + (size_t)((l * 2 + dir) * 32 + g_w) * 128 * 16;
#pragma unroll
    for (int nn = 0; nn < 2; ++nn) bq[dir][nn] = *(const bf16x8*)(bbt + ((half * 2 + nn) * 32 + n) * 16 + 8 * h2);
  }
  const int gi_t = tid >> 7, dir_t = (tid >> 6) & 1, pp = tid & 63, g_t = gp * 2 + gi_t;
  const float2 lb = ((const float2*)(p.ws + B_LAMB))[((l * 2 + dir_t) * 32 + g_t) * 64 + pp];
  const size_t hidx = ((size_t)(chunk * 32 + g_t) * 2 + dir_t) * 64 + pp;
  float hr = 0.f, hi = 0.f;
  if (mode) { float2 h0 = ((const float2*)(p.ws + B_HIN))[hidx]; hr = h0.x; hi = h0.y; }
  const int fr = lane & 15, fq = lane >> 4;
  bf16x8 cq[4];
  u16 uu[2][4];
  float dsk = 0.f;
  if (mode) {
    const u16* cmt = (const u16*)(p.ws + B_CMT) + (size_t)(l * 32 + g_w) * 16 * 128;
#pragma unroll
    for (int k4 = 0; k4 < 4; ++k4) cq[k4] = *(const bf16x8*)(cmt + fr * 128 + k4 * 32 + fq * 8);
#pragma unroll
    for (int mm = 0; mm < 2; ++mm)
#pragma unroll
      for (int r = 0; r < 4; ++r) uu[mm][r] = us5[((size_t)chunk * 64 + ((w & 1) * 2 + mm) * 16 + fq * 4 + r) * 512 + g_w * 16 + fr];
    dsk = p.in[25][l * 512 + g_w * 16 + fr];
  }
  __syncthreads();
  {
#pragma unroll
    for (int dir = 0; dir < 2; ++dir) {
#pragma unroll
      for (int nn = 0; nn < 2; ++nn) {
        const int nt = half * 2 + nn;
#pragma unroll
        for (int mi = 0; mi < 2; ++mi) {
          f32x16 acc;
#pragma unroll
          for (int r = 0; r < 16; ++r) acc[r] = 0.f;
          acc = MFMA32(af[mi], bq[dir][nn], acc);
          u16* d = sm + (size_t)((gi_w * 2 + dir) * 64 + mi * 32) * RS + nt * 32 + n;
#pragma unroll
          for (int r = 0; r < 16; ++r) d[crow(r, h2) * RS] = f2bf(acc[r]);
        }
      }
    }
  }
  __syncthreads();
  {
    u16* base = sm + (size_t)((gi_t * 2 + dir_t) * 64) * RS;
#pragma unroll 8
    for (int st = 0; st < 64; ++st) {
      const int tk = dir_t ? 63 - st : st;
      float br = bf2f(base[tk * RS + pp]), bi = bf2f(base[tk * RS + 64 + pp]);
      float nr = __builtin_fmaf(lb.x, hr, __builtin_fmaf(-lb.y, hi, br));
      float ni = __builtin_fmaf(lb.x, hi, __builtin_fmaf(lb.y, hr, bi));
      asm volatile("" : "+v"(nr));
      asm volatile("" : "+v"(ni));
      hr = nr; hi = ni;
      if (mode) { base[tk * RS + pp] = f2bf(hr); base[tk * RS + 64 + pp] = f2bf(hi); }
    }
    if (!mode) ((float2*)(p.ws + B_HEND))[hidx] = make_float2(hr, hi);
  }
  if (!mode) return;
  __syncthreads();
  {
    f32x4 acc[2];
    acc[0] = f32x4{0.f, 0.f, 0.f, 0.f}; acc[1] = acc[0];
#pragma unroll
    for (int ks = 0; ks < 8; ++ks) {
      const int dir = ks >> 2, kk = (ks & 3) * 32;
#pragma unroll
      for (int mm = 0; mm < 2; ++mm) {
        const int mi = (w & 1) * 2 + mm;
        bf16x8 a2 = *(const bf16x8*)(sm + (size_t)((gi_w * 2 + dir) * 64 + mi * 16 + fr) * RS + kk + fq * 8);
        acc[mm] = MFMA16(a2, cq[ks & 3], acc[mm]);
      }
    }
    u16* y5 = (u16*)(p.ws + B_Y5);
#pragma unroll
    for (int mm = 0; mm < 2; ++mm)
#pragma unroll
      for (int r = 0; r < 4; ++r) {
        const size_t t = (size_t)chunk * 64 + ((w & 1) * 2 + mm) * 16 + fq * 4 + r;
        float y = acc[mm][r] + dsk * bf2f(uu[mm][r]);
        y5[t * 512 + g_w * 16 + fr] = f2bf(gelu_tanh(y));
      }
  }
}
DI void s5_carry_tile(const Params& p, int l, int tile) {
  const int seq = tile >> 4, gp = tile & 15;
  const int tid = otid(), gi = tid >> 7, dir = (tid >> 6) & 1, pp = tid & 63, g = gp * 2 + gi;
  int c0, nc;
  if (seq < 32) { c0 = seq * 4; nc = 4; } else { c0 = 128 + (seq - 32) * 32; nc = 32; }
  const float2 l64 = ((const float2*)(p.ws + B_LAM64))[((l * 2 + dir) * 32 + g) * 64 + pp];
  float hr = 0.f, hi = 0.f;
  if (seq >= 32) {
    const size_t si = ((size_t)((seq - 32) * 4 + l) * 2 + dir) * 2048 + g * 64 + pp;
    hr = p.in[3][si]; hi = p.in[4][si];
  }
  const float2* hend = (const float2*)(p.ws + B_HEND);
  float2* hin = (float2*)(p.ws + B_HIN);
  for (int it = 0; it < nc; ++it) {
    const int ck = c0 + (dir ? nc - 1 - it : it);
    const size_t idx = ((size_t)(ck * 32 + g) * 2 + dir) * 64 + pp;
    hin[idx] = make_float2(hr, hi);
    float2 he = hend[idx];
    float nr = __builtin_fmaf(l64.x, hr, __builtin_fmaf(-l64.y, hi, he.x));
    float ni = __builtin_fmaf(l64.x, hi, __builtin_fmaf(l64.y, hr, he.y));
    asm volatile("" : "+v"(nr));
    asm volatile("" : "+v"(ni));
    hr = nr; hi = ni;
  }
  if (seq < 32) {
    const size_t so = ((size_t)(seq * 4 + l) * 2 + dir) * 2048 + g * 64 + pp;
    p.out[O_S5RE + so] = hr;
    p.out[O_S5IM + so] = hi;
  }
}

DI void delta_local_tile(const Params& p, int tile, float* smf) {
  const int chunk = tile >> 1, dir = tile & 1;
  const int tid = otid(), lane = tid & 63, h = tid >> 6;
  const int m = lane & 31, h2 = lane >> 5;
  const int tb = chunk * 64;
  const float* bg = (const float*)(p.ws + B_BG);
  const u16* kn = (const u16*)(p.ws + B_KN);
  const u16* qn = (const u16*)(p.ws + B_QN);
  float* Aw = smf + h * 4096;
  const size_t cidx = ((size_t)(chunk * 4 + h) * 2 + dir);
  const int tl = tb + (dir ? 63 - lane : lane);
  float gcs = bg[(size_t)tl * 16 + 8 + dir * 4 + h];
  const float beta = bg[(size_t)tl * 16 + dir * 4 + h];
#pragma unroll
  for (int o = 1; o < 64; o <<= 1) {
    float v = __shfl_up(gcs, o);
    if (lane >= o) gcs += v;
  }
  ((float*)(p.ws + B_GC))[cidx * 64 + lane] = gcs;
  ((float*)(p.ws + B_BC))[cidx * 64 + lane] = beta;
  __syncthreads();
  u16* qkm = (u16*)(p.ws + B_QKM) + cidx * 4096;
#pragma unroll 1
  for (int tt = 0; tt < 3; ++tt) {
    const int mi = tt == 0 ? 0 : 1, ni = tt == 2 ? 1 : 0;
    const int cm = 32 * mi + m, cn = 32 * ni + m;
    const u16* krm = kn + (size_t)(tb + (dir ? 63 - cm : cm)) * 512 + h * 128 + h2 * 8;
    const u16* qrm = qn + (size_t)(tb + (dir ? 63 - cm : cm)) * 512 + h * 128 + h2 * 8;
    const u16* krn = kn + (size_t)(tb + (dir ? 63 - cn : cn)) * 512 + h * 128 + h2 * 8;
    f32x16 ak, aq;
#pragma unroll
    for (int r = 0; r < 16; ++r) { ak[r] = 0.f; aq[r] = 0.f; }
#pragma unroll
    for (int ks = 0; ks < 8; ++ks) {
      const bf16x8 fkm = *(const bf16x8*)(krm + ks * 16), fqm = *(const bf16x8*)(qrm + ks * 16), fkn = *(const bf16x8*)(krn + ks * 16);
      ak = MFMA32(fkm, fkn, ak);
      aq = MFMA32(fqm, fkn, aq);
    }
    const int e = 32 * ni + m;
    const float gce = __shfl(gcs, e);
#pragma unroll
    for (int r = 0; r < 16; ++r) {
      const int c = 32 * mi + crow(r, h2);
      const float gcc = __shfl(gcs, c), bc = __shfl(beta, c);
      const float dec = (e <= c) ? __expf(gcc - gce) : 0.f;
      Aw[c * 64 + e] = (e < c) ? ak[r] * bc * dec : 0.f;
      qkm[c * 64 + e] = f2bf(aq[r] * dec);
    }
  }
  __syncthreads();
  u16* tm = (u16*)(p.ws + B_TM) + cidx * 4096;
  float x[64];
#pragma unroll
  for (int i = 0; i < 64; ++i) {
    float a = (i == lane) ? 1.f : 0.f;
#pragma unroll
    for (int j = 0; j < i; ++j) a -= Aw[i * 64 + j] * x[j];
    x[i] = a;
    tm[i * 64 + lane] = f2bf(a);
  }
}

template <int dir>
DI void delta_scan_body(const Params& p, int l, int seq, int h, u16* sm);
DI void delta_scan_tile(const Params& p, int l, int idx, u16* sm) {
  int seq, h, dir;
  if (idx < 64) { seq = 32 + (idx >> 3); h = (idx >> 1) & 3; dir = idx & 1; }
  else { const int i2 = idx - 64; seq = i2 >> 3; h = (i2 >> 1) & 3; dir = i2 & 1; }
  __builtin_amdgcn_s_setprio(3);
  if (dir) delta_scan_body<1>(p, l, seq, h, sm); else delta_scan_body<0>(p, l, seq, h, sm);
  __builtin_amdgcn_s_setprio(0);
}
template <int dir>
DI void delta_scan_body(const Params& p, int l, int seq, int h, u16* sm) {
  int chunk0, nch;
  if (seq < 32) { chunk0 = seq * 4; nch = 4; } else { chunk0 = 128 + (seq - 32) * 32; nch = 32; }
  const int lane = otid() & 63, w = otid() >> 6;
  const int n = lane & 31, h2 = lane >> 5;
  const int dvc = w * 32 + n;
  const u16* kn = (const u16*)(p.ws + B_KN);
  const u16* qn = (const u16*)(p.ws + B_QN);
  const u16* vv = (const u16*)(p.ws + B_VV);
  u16* od = (u16*)(p.ws + (dir ? B_OB : B_OF));
  f32x16 S[4];
  if (seq >= 32) {
    const float* s0 = p.in[2] + ((size_t)(((seq - 32) * 4 + l) * 2 + dir) * 4 + h) * 16384;
#pragma unroll
    for (int t = 0; t < 4; ++t)
#pragma unroll
      for (int r = 0; r < 16; ++r) S[t][r] = s0[(size_t)(32 * t + crow(r, h2)) * 128 + dvc];
  } else {
#pragma unroll
    for (int t = 0; t < 4; ++t)
#pragma unroll
      for (int r = 0; r < 16; ++r) S[t][r] = 0.f;
  }
  for (int it = 0; it < nch; ++it) {
    const int chunk = chunk0 + (dir ? nch - 1 - it : it);
    const int tb = chunk * 64;
    const size_t cidx = ((size_t)(chunk * 4 + h) * 2 + dir);
    const float* gcp = (const float*)(p.ws + B_GC) + cidx * 64;
    const float* bcp = (const float*)(p.ws + B_BC) + cidx * 64;
    const u16* tm = (const u16*)(p.ws + B_TM) + cidx * 4096;
    const u16* qkm = (const u16*)(p.ws + B_QKM) + cidx * 4096;
    const u16* ktp = (const u16*)(p.ws + B_KT) + (size_t)(chunk * 4 + h) * 8192;
    const float glast = gcp[63];
    size_t trow[2];
#pragma unroll
    for (int mi = 0; mi < 2; ++mi) { const int c = 32 * mi + n; trow[mi] = (size_t)(tb + (dir ? 63 - c : c)); }
#define SCHED_FENCE() asm volatile("" ::: "memory")
    u16* Ks = sm; u16* Qs = sm + 8704; u16* Vs = sm + 17408; u16* KTs = sm + 26112;
    float* GCs = (float*)(sm + 35328);
    const float* gcl = GCs; const float* bcl = GCs + 64;
    uint4 xm0, xm1, xq0, xq1;
    u16* vls = Vs + w * 32;
    __syncthreads();
    {
      const int tid_ = otid();
      const int r0 = tid_ >> 4, ck = tid_ & 15;
      uint4 tk[4], tq[4], tv[4], tt[4];
      xm0 = *(const uint4*)(tm + tid_ * 8); xm1 = *(const uint4*)(tm + 2048 + tid_ * 8);
      xq0 = *(const uint4*)(qkm + tid_ * 8); xq1 = *(const uint4*)(qkm + 2048 + tid_ * 8);
      float4 gcv = make_float4(0.f, 0.f, 0.f, 0.f);
      if (tid_ < 16) gcv = *(const float4*)(gcp + tid_ * 4); else if (tid_ < 32) gcv = *(const float4*)(bcp + (tid_ - 16) * 4);
#pragma unroll
      for (int j = 0; j < 4; ++j) {
        const size_t go = (size_t)(tb + r0 + 16 * j) * 512 + h * 128 + ck * 8;
        tk[j] = *(const uint4*)(kn + go); tq[j] = *(const uint4*)(qn + go); tv[j] = *(const uint4*)(vv + go);
        tt[j] = *(const uint4*)(ktp + ((tid_ >> 3) + 32 * j) * 64 + (tid_ & 7) * 8);
      }
#pragma unroll
      for (int j = 0; j < 4; ++j) {
        const int tau = r0 + 16 * j, c = dir ? 63 - tau : tau;
        *(uint4*)(Ks + c * 136 + ck * 8) = tk[j]; *(uint4*)(Qs + c * 136 + ck * 8) = tq[j]; *(uint4*)(Vs + c * 136 + ck * 8) = tv[j];
        *(uint4*)(KTs + ((tid_ >> 3) + 32 * j) * 72 + (tid_ & 7) * 8) = tt[j];
      }
      if (tid_ < 32) *(float4*)(GCs + tid_ * 4) = gcv;
    }
    __syncthreads();
    f32x16 X[2], QS[2];
    {
      bf16x8 Sb[4][2];
#pragma unroll
      for (int t = 0; t < 4; ++t)
#pragma unroll
        for (int s = 0; s < 2; ++s) Sb[t][s] = pack_acc(S[t], s);
#pragma unroll
      for (int mi = 0; mi < 2; ++mi)
#pragma unroll
        for (int r = 0; r < 16; ++r) { X[mi][r] = 0.f; QS[mi][r] = 0.f; }
#pragma unroll
      for (int t = 0; t < 4; ++t) {
#pragma unroll
        for (int mi = 0; mi < 2; ++mi) {
          const u16* krow_ = Ks + (32 * mi + n) * 136;
          const u16* qrow_ = Qs + (32 * mi + n) * 136;
#pragma unroll
          for (int s = 0; s < 2; ++s) {
            X[mi] = MFMA32(load_perm(krow_ + 32 * t, s, h2), Sb[t][s], X[mi]);
            QS[mi] = MFMA32(load_perm(qrow_ + 32 * t, s, h2), Sb[t][s], QS[mi]);
          }
        }
        SCHED_FENCE();
      }
    }
    __syncthreads();
    {
      const int tid_ = otid();
      const int r_ = tid_ >> 3, c_ = (tid_ & 7) * 8;
      *(uint4*)(Ks + r_ * 72 + c_) = xm0; *(uint4*)(Ks + (r_ + 32) * 72 + c_) = xm1;
      *(uint4*)(Qs + r_ * 72 + c_) = xq0; *(uint4*)(Qs + (r_ + 32) * 72 + c_) = xq1;
    }
    __syncthreads();
    bf16x8 Rb[2][2];
#pragma unroll
    for (int mi = 0; mi < 2; ++mi) {
#pragma unroll
      for (int a = 0; a < 4; ++a) {
        const int c4 = 32 * mi + 8 * a + 4 * h2;
        const float4 g4 = *(const float4*)(gcl + c4);
        const float4 b4 = *(const float4*)(bcl + c4);
        const float gg[4] = {g4.x, g4.y, g4.z, g4.w};
        const float bb[4] = {b4.x, b4.y, b4.z, b4.w};
#pragma unroll
        for (int q = 0; q < 4; ++q) {
          const int c = c4 + q;
          const float v = bf2f(vls[c * 136 + n]);
          const float eg = __expf(gg[q]);
          X[mi][4 * a + q] = bb[q] * (v - eg * X[mi][4 * a + q]);
          QS[mi][4 * a + q] *= eg;
        }
      }
      Rb[mi][0] = pack_acc(X[mi], 0);
      Rb[mi][1] = pack_acc(X[mi], 1);
    }
    SCHED_FENCE();
    f32x16 Vn[2];
#pragma unroll
    for (int mo = 0; mo < 2; ++mo) {
#pragma unroll
      for (int r = 0; r < 16; ++r) Vn[mo][r] = 0.f;
#pragma unroll
      for (int mi = 0; mi <= mo; ++mi)
#pragma unroll
        for (int s = 0; s < 2; ++s) Vn[mo] = MFMA32(load_perm(Ks + (32 * mo + n) * 72 + 32 * mi, s, h2), Rb[mi][s], Vn[mo]);
    }
    SCHED_FENCE();
    {
      bf16x8 Vb[2][2];
#pragma unroll
      for (int mi = 0; mi < 2; ++mi) { Vb[mi][0] = pack_acc(Vn[mi], 0); Vb[mi][1] = pack_acc(Vn[mi], 1); }
#pragma unroll
      for (int mo = 0; mo < 2; ++mo) {
#pragma unroll
        for (int mi = 0; mi <= mo; ++mi)
#pragma unroll
          for (int s = 0; s < 2; ++s) QS[mo] = MFMA32(load_perm(Qs + (32 * mo + n) * 72 + 32 * mi, s, h2), Vb[mi][s], QS[mo]);
      }
      __syncthreads();
#pragma unroll
      for (int mo = 0; mo < 2; ++mo)
#pragma unroll
        for (int r = 0; r < 16; ++r) vls[(32 * mo + crow(r, h2)) * 136 + n] = f2bf(QS[mo][r]);
      __syncthreads();
#pragma unroll
      for (int jv = 0; jv < 4; ++jv) {
        const int tau = (lane >> 2) + 16 * jv, cq = lane & 3;
        const uint4 oq = *(const uint4*)(vls + (dir ? 63 - tau : tau) * 136 + cq * 8);
        *(uint4*)(od + (size_t)(tb + tau) * 512 + h * 128 + w * 32 + cq * 8) = oq;
      }
    }
    SCHED_FENCE();
    bf16x8 Vsb[2][2];
#pragma unroll
    for (int mi = 0; mi < 2; ++mi) {
#pragma unroll
      for (int a = 0; a < 4; ++a) {
        const float4 g4 = *(const float4*)(gcl + 32 * mi + 8 * a + 4 * h2);
        Vn[mi][4 * a + 0] *= __expf(glast - g4.x); Vn[mi][4 * a + 1] *= __expf(glast - g4.y);
        Vn[mi][4 * a + 2] *= __expf(glast - g4.z); Vn[mi][4 * a + 3] *= __expf(glast - g4.w);
      }
      Vsb[mi][0] = pack_acc(Vn[mi], 0); Vsb[mi][1] = pack_acc(Vn[mi], 1);
    }
    const float eg = __expf(glast);
#pragma unroll
    for (int t = 0; t < 4; ++t) {
#pragma unroll
      for (int r = 0; r < 16; ++r) S[t][r] *= eg;
      const u16* ktrow = KTs + (32 * t + n) * 72;
#pragma unroll
      for (int mi = 0; mi < 2; ++mi)
#pragma unroll
        for (int s = 0; s < 2; ++s) {
          bf16x8 a = dir ? load_perm_rev(ktrow, 32 * mi, s, h2) : load_perm(ktrow + 32 * mi, s, h2);
          S[t] = MFMA32(a, Vsb[mi][s], S[t]);
        }
      SCHED_FENCE();
    }
  }
  if (seq < 32) {
    float* so = p.out + O_SD + ((size_t)((seq * 4 + l) * 2 + dir) * 4 + h) * 16384;
#pragma unroll
    for (int t = 0; t < 4; ++t)
#pragma unroll
      for (int r = 0; r < 16; ++r) so[(size_t)(32 * t + crow(r, h2)) * 128 + dvc] = S[t][r];
  }
}

DI void attn_tile(const Params& p, int seq, int head, int qb, u16* sm) {
  const int lane = otid() & 63, w = otid() >> 6;
  const int n = lane & 31, h2 = lane >> 5;
  int tq0, nkeys; size_t kbo, vto;
  if (seq < 32) { tq0 = seq * 256 + qb * 128 + w * 32; nkeys = 256; kbo = (size_t)(seq * 8 + head) * 256 * 96; vto = (size_t)(seq * 8 + head) * 64 * 256; }
  else { const int s = seq - 32; tq0 = TP_ + s * 2048 + qb * 128 + w * 32; nkeys = 2304; kbo = KB_P + (size_t)(s * 8 + head) * 2304 * 96; vto = VT_P + (size_t)(s * 8 + head) * 64 * 2304; }
  const u16* kb = (const u16*)(p.ws + B_KB) + kbo;
  const u16* vt = (const u16*)(p.ws + B_VT) + vto;
  const u16* qm = (const u16*)(p.ws + B_QM) + (size_t)(tq0 + n) * 768 + head * 96;
  bf16x8 qf[6];
#pragma unroll
  for (int ks = 0; ks < 6; ++ks) qf[ks] = *(const bf16x8*)(qm + ks * 16 + h2 * 8);
  f32x16 O[2];
#pragma unroll
  for (int r = 0; r < 16; ++r) { O[0][r] = 0.f; O[1][r] = 0.f; }
  float mrun = -1e30f, lsum = 0.f;
  const int nkt = nkeys >> 6;
  constexpr int KST = 104, VST = 72, STG = 64 * KST + 64 * VST;
  const int tid_ = otid();
  uint4 rk0, rk1, rk2, rv0, rv1;
  const int kc0 = tid_, kc1 = tid_ + 256, kc2 = tid_ + 512;
  const u16* kg0 = kb + (size_t)(kc0 / 12) * 96 + (kc0 % 12) * 8;
  const u16* kg1 = kb + (size_t)(kc1 / 12) * 96 + (kc1 % 12) * 8;
  const u16* kg2 = kb + (size_t)(kc2 / 12) * 96 + (kc2 % 12) * 8;
  const u16* vg0 = vt + (size_t)(tid_ >> 3) * nkeys + (tid_ & 7) * 8;
  const u16* vg1 = vt + (size_t)((tid_ + 256) >> 3) * nkeys + (tid_ & 7) * 8;
  const int kl0 = (kc0 / 12) * KST + (kc0 % 12) * 8, kl1 = (kc1 / 12) * KST + (kc1 % 12) * 8, kl2 = (kc2 / 12) * KST + (kc2 % 12) * 8;
  const int vl0 = (tid_ >> 3) * VST + (tid_ & 7) * 8, vl1 = ((tid_ + 256) >> 3) * VST + (tid_ & 7) * 8;
#define AT_GLOAD(kt_) do { rk0 = *(const uint4*)(kg0 + (size_t)(kt_) * 6144); rk1 = *(const uint4*)(kg1 + (size_t)(kt_) * 6144); \
    rk2 = *(const uint4*)(kg2 + (size_t)(kt_) * 6144); rv0 = *(const uint4*)(vg0 + (kt_) * 64); rv1 = *(const uint4*)(vg1 + (kt_) * 64); } while (0)
#define AT_SSTORE(st_) do { u16* ks2_ = sm + (st_) * STG; u16* vs2_ = ks2_ + 64 * KST; \
    *(uint4*)(ks2_ + kl0) = rk0; *(uint4*)(ks2_ + kl1) = rk1; *(uint4*)(ks2_ + kl2) = rk2; *(uint4*)(vs2_ + vl0) = rv0; *(uint4*)(vs2_ + vl1) = rv1; } while (0)
  __syncthreads();
  AT_GLOAD(0); AT_SSTORE(0);
  __syncthreads();
  for (int kt = 0; kt < nkt; ++kt) {
    const bool more = kt + 1 < nkt;
    if (more) AT_GLOAD(kt + 1);
    const u16* ks_ = sm + (kt & 1) * STG;
    const u16* vs_ = ks_ + 64 * KST;
    f32x16 St[2];
#pragma unroll
    for (int sub = 0; sub < 2; ++sub) {
#pragma unroll
      for (int r = 0; r < 16; ++r) St[sub][r] = 0.f;
      const u16* kr = ks_ + (sub * 32 + n) * KST + h2 * 8;
#pragma unroll
      for (int ks = 0; ks < 6; ++ks) St[sub] = MFMA32(*(const bf16x8*)(kr + ks * 16), qf[ks], St[sub]);
    }
    float mx = St[0][0];
#pragma unroll
    for (int r = 0; r < 16; ++r) { mx = fmaxf(mx, St[0][r]); mx = fmaxf(mx, St[1][r]); }
    mx = fmaxf(mx, __shfl_xor(mx, 32));
    const float mnew = fmaxf(mrun, mx);
    const float alpha = exp2f(mrun - mnew);
    mrun = mnew;
    float ps = 0.f;
#pragma unroll
    for (int sub = 0; sub < 2; ++sub)
#pragma unroll
      for (int r = 0; r < 16; ++r) { float e = exp2f(St[sub][r] - mnew); St[sub][r] = e; ps += e; }
    lsum = lsum * alpha + ps;
#pragma unroll
    for (int r = 0; r < 16; ++r) { O[0][r] *= alpha; O[1][r] *= alpha; }
#pragma unroll
    for (int sub = 0; sub < 2; ++sub)
#pragma unroll
      for (int s = 0; s < 2; ++s) {
        const bf16x8 pb = pack_acc(St[sub], s);
#pragma unroll
        for (int dt = 0; dt < 2; ++dt)
          O[dt] = MFMA32(load_perm(vs_ + (dt * 32 + n) * VST + sub * 32, s, h2), pb, O[dt]);
      }
    if (more) AT_SSTORE((kt + 1) & 1);
    __syncthreads();
  }
  lsum += __shfl_xor(lsum, 32);
  const float inv = 1.f / lsum;
  u16* oc = (u16*)(p.ws + B_OC) + (size_t)(tq0 + n) * 512 + head * 64;
#pragma unroll
  for (int dt = 0; dt < 2; ++dt)
#pragma unroll
    for (int a = 0; a < 4; ++a) {
      const int dv = dt * 32 + 8 * a + 4 * h2;
      *(uint2*)(oc + dv) = make_uint2(pack2(O[dt][4 * a] * inv, O[dt][4 * a + 1] * inv), pack2(O[dt][4 * a + 2] * inv, O[dt][4 * a + 3] * inv));
    }
}

DI void delta_out_tile(const Params& p, int l, int tile) {
  const int lane = otid() & 63, w = otid() >> 6;
  const u16* of = (const u16*)(p.ws + B_OF);
  const u16* ob = (const u16*)(p.ws + B_OB);
  const u16* z = (const u16*)(p.ws + B_Z);
  u16* oa = (u16*)(p.ws + B_OA);
  const float g0 = p.in[17][l * 128 + 2 * lane], g1 = p.in[17][l * 128 + 2 * lane + 1];
#pragma unroll 1
  for (int q = 0; q < 16; ++q) {
    const size_t t = (size_t)tile * 16 + w * 4 + (q >> 2);
    const int hh = q & 3;
    const size_t off = t * 512 + hh * 128 + 2 * lane;
    unsigned a = *(const unsigned*)(of + off), b = *(const unsigned*)(ob + off), zz = *(const unsigned*)(z + off);
    float o0 = blo(a) + blo(b), o1 = bhi(a) + bhi(b);
    float ss = wave_sum(o0 * o0 + o1 * o1);
    float rstd = rsqrtf(ss * (1.f / 128.f) + 1e-6f);
    float y0 = o0 * rstd * g0 * siluf_(blo(zz)), y1 = o1 * rstd * g1 * siluf_(bhi(zz));
    *(unsigned*)(oa + off) = pack2(y0, y1);
  }
}

DI void grid_barrier(unsigned* bar, unsigned target) {
  asm volatile("s_waitcnt vmcnt(0) lgkmcnt(0)" ::: "memory");
  __syncthreads();
  if (otid() == 0) {
    __builtin_amdgcn_fence(__ATOMIC_RELEASE, "agent");
    asm volatile("s_waitcnt vmcnt(0)" ::: "memory");
    __hip_atomic_fetch_add(bar, 1u, __ATOMIC_RELAXED, __HIP_MEMORY_SCOPE_AGENT);
    while (__hip_atomic_load(bar, __ATOMIC_RELAXED, __HIP_MEMORY_SCOPE_AGENT) < target) __builtin_amdgcn_s_sleep(5);
    __builtin_amdgcn_fence(__ATOMIC_ACQUIRE, "agent");
    asm volatile("s_waitcnt vmcnt(0)" ::: "memory");
  }
  __syncthreads();
}
#define GSYNC() do { bar_target += gridDim.x; grid_barrier(p.bar, bar_target); } while (0)
#ifndef ONLY
#define PH(n) 1
#else
#define PH(n) ((n) == ONLY || (n) / 100 == ONLY || (n) == ONLY / 100)
#endif
__global__ void __launch_bounds__(256, 2) mega(Params p) {
  cg::grid_group grid = cg::this_grid();
  __shared__ __attribute__((aligned(16))) char smem_raw[73728];
  u16* sm = (u16*)smem_raw;
  float* smf = (float*)smem_raw;
  const int nb = gridDim.x, bid = blockIdx.x;
  unsigned bar_target = 0;
  grid.sync();

  if (PH(0)) {
    const int tid = otid();
    for (int j = bid; j < 4 * CJ8; j += nb) conv_job(p, j / CJ8, j % CJ8, smf);
    for (int j = bid; j < 4 * 96; j += nb) mods_tile(p, j / 96, j % 96, smf);
    for (int j = bid; j < 64; j += nb) s5pre_tile(p, j);
    {
      const float4* xp = (const float4*)p.in[0];
      const float4* xs = (const float4*)p.in[1];
      float4* o = (float4*)p.out;
      const size_t nP = (size_t)TP_ * 256, nT = (size_t)T_ * 256;
      for (size_t i = (size_t)bid * 256 + tid; i < nT; i += (size_t)nb * 256) o[i] = i < nP ? xp[i] : xs[i - nP];
    }
    {
      float* rope = (float*)(p.ws + B_ROPE);
      for (int i = bid * 256 + tid; i < 2048 * 16; i += nb * 256) {
        const int pos = i >> 4, f = i & 15;
        const float invf = 1.f / powf(10000.f, (float)(f & 7) * 0.125f);
        const float ang = (f < 8 ? (float)(pos >> 6) : (float)(pos & 63)) * invf;
        float sn, cs;
        sincosf(ang, &sn, &cs);
        rope[i * 2] = cs; rope[i * 2 + 1] = sn;
      }
    }
    {
      u16* cc = (u16*)(p.ws + B_CKVC);
      for (int i = bid * 256 + tid; i < 8 * 4 * 256 * 256 / 2; i += nb * 256) {
        const int e = i * 2;
        const int c = e & 255, pos = (e >> 8) & 255, l = (e >> 16) & 3, b = e >> 18;
        float2 v = *(const float2*)(p.in[5] + e);
        *(unsigned*)(cc + ((size_t)(l * 2048 + b * 256 + pos)) * 256 + c) = pack2(v.x, v.y);
      }
    }
  }
  GSYNC();

  for (int l = 0; l < 4; ++l) {
    const u16* WL = (const u16*)(p.ws + B_W) + (size_t)l * W_LAYER;
    const float* mods = (const float*)(p.ws + B_MODS);
    if (PH(1)) norm_phase(p, l, 0, 1, p.in[11] + l * 1024);
    GSYNC();
    if (PH(2)) gemm_in_phase(p, l, sm);
    GSYNC();
    if (PH(3)) {
      for (int j = bid; j < NCH; j += nb) delta_prep_tile(p, l, j, sm);
      for (int j = bid; j < T_ / 4; j += nb) mla_prep_tile(p, l, j);
      for (int j = bid; j < 256; j += nb) cache_rope_tile(p, l, j);
      for (int j = bid; j < NCH * 16; j += nb) s5_chunk_tile(p, l, j >> 4, j & 15, 0, sm);
    }
    GSYNC();
    if (PH(4)) {
      const int tid = otid();
      if (PH(400)) for (int j = bid; j < NCH * 2; j += nb) delta_local_tile(p, j, smf);
      if (PH(410)) for (int j = bid; j < 192 * 6; j += nb) {
          const int q = j, mt = q / 6, nt = q % 6;
          f32x4 acc[4][4];
          zero_acc<4>(acc);
          gemm_core<4>(acc, (const u16*)(p.ws + B_QA) + (size_t)mt * 128 * 384, 384, WL + W_QB + (size_t)nt * 128 * 384, 384, 384, sm);
          u16* qm = (u16*)(p.ws + B_QM);
          const float qs = 0.10206207261596575f * 1.4426950408889634f;
          const float* rope = (const float*)(p.ws + B_ROPE);
          const int e_lane = tid & 63, e_w = tid >> 6, e_wr = e_w >> 1, e_wc = e_w & 1, e_fr = e_lane & 15, e_fq = e_lane >> 4;
          const bool is_s = (mt * 128 >= TP_);
#pragma unroll
          for (int i = 0; i < 4; ++i) {
            const int row = mt * 128 + e_wr * 64 + i * 16 + e_fr;
            f32x4 vals[4];
#pragma unroll
            for (int jj = 0; jj < 4; ++jj) vals[jj] = acc[i][jj];
            if (is_s) {
              const int pos = (row - TP_) & 2047;
              const float4 cs0 = *(const float4*)(rope + (size_t)(pos * 16 + e_fq * 4) * 2);
              const float4 cs1 = *(const float4*)(rope + (size_t)(pos * 16 + e_fq * 4) * 2 + 4);
              const float cs[4] = {cs0.x, cs0.z, cs1.x, cs1.z}, sn[4] = {cs0.y, cs0.w, cs1.y, cs1.w};
#pragma unroll
              for (int jj = 0; jj < 4; jj += 2) {
                const int gt = (nt * 128 + e_wc * 64) / 16 + jj;
                if (gt % 6 == 4) {
#pragma unroll
                  for (int r = 0; r < 4; ++r) {
                    const float x1 = vals[jj][r], x2 = vals[jj + 1][r];
                    vals[jj][r] = x1 * cs[r] - x2 * sn[r];
                    vals[jj + 1][r] = x2 * cs[r] + x1 * sn[r];
                  }
                }
              }
            }
#pragma unroll
            for (int jj = 0; jj < 4; ++jj) {
              f32x4 o; o[0] = vals[jj][0] * qs; o[1] = vals[jj][1] * qs; o[2] = vals[jj][2] * qs; o[3] = vals[jj][3] * qs;
              *(uint2*)(qm + (size_t)row * 768 + nt * 128 + e_wc * 64 + jj * 16 + e_fq * 4) = pack4(o);
            }
          }
      }
      if (PH(420)) for (int j = bid; j < 208 * 8; j += nb) {
          const int q = j, mt = q >> 3, head = q & 7;
          f32x4 acc[4][4];
          zero_acc<4>(acc);
          const u16* A = mt < 192 ? (const u16*)(p.ws + B_KVA) + (size_t)mt * 128 * 256
                                  : (const u16*)(p.ws + B_CKVC) + ((size_t)l * 2048 + (size_t)(mt - 192) * 128) * 256;
          gemm_core<4, false>(acc, A, 256, WL + W_KVB + (size_t)head * 128 * 256, 256, 256, sm);
          int key0, nkeys; size_t kbo, vto;
          if (mt < 64) { const int seq = mt >> 1; key0 = (mt & 1) * 128; nkeys = 256; kbo = (size_t)(seq * 8 + head) * 256 * 96; vto = (size_t)(seq * 8 + head) * 64 * 256; }
          else if (mt < 192) { const int s = (mt - 64) >> 4; key0 = 256 + ((mt - 64) & 15) * 128; nkeys = 2304; kbo = KB_P + (size_t)(s * 8 + head) * 2304 * 96; vto = VT_P + (size_t)(s * 8 + head) * 64 * 2304; }
          else { const int s = (mt - 192) >> 1; key0 = ((mt - 192) & 1) * 128; nkeys = 2304; kbo = KB_P + (size_t)(s * 8 + head) * 2304 * 96; vto = VT_P + (size_t)(s * 8 + head) * 64 * 2304; }
          u16* kb = (u16*)(p.ws + B_KB) + kbo;
          u16* vt = (u16*)(p.ws + B_VT) + vto;
          const int e_lane = tid & 63, e_w = tid >> 6, e_wr = e_w >> 1, e_wc = e_w & 1, e_fr = e_lane & 15, e_fq = e_lane >> 4;
#pragma unroll
          for (int i = 0; i < 4; ++i)
#pragma unroll
            for (int jj = 0; jj < 4; ++jj) {
              const int key = key0 + e_wr * 64 + i * 16 + e_fq * 4;
              const int c = jj * 16 + e_fr;
              if (e_wc == 0) {
#pragma unroll
                for (int r = 0; r < 4; ++r) kb[(size_t)(key + r) * 96 + c] = f2bf(acc[i][jj][r]);
              } else {
                *(uint2*)(vt + (size_t)c * nkeys + key) = make_uint2(pack2(acc[i][jj][0], acc[i][jj][1]), pack2(acc[i][jj][2], acc[i][jj][3]));
              }
            }
      }
      if (PH(430)) for (int j = bid; j < 640; j += nb) s5_carry_tile(p, l, j);
    }
    GSYNC();
    if (PH(5)) {
      if (PH(500)) for (int j = bid; j < 320; j += nb) delta_scan_tile(p, l, j, sm);
      if (PH(510)) for (int j = bid; j < 1536; j += nb) {
        if (j < 1024) attn_tile(p, 32 + (j >> 7), (j >> 4) & 7, j & 15, sm);
        else { const int q = j - 1024; attn_tile(p, q >> 4, (q >> 1) & 7, q & 1, sm); }
      }
      if (PH(530)) for (int j = bid; j < NCH * 8; j += nb) {
        s5_chunk_tile(p, l, j >> 3, (j & 7) * 2, 1, sm);
        s5_chunk_tile(p, l, j >> 3, (j & 7) * 2 + 1, 1, sm);
      }
    }
    GSYNC();
    if (PH(6)) {
      for (int j = bid; j < T_ / 16; j += nb) delta_out_tile(p, l, j);
      for (int j = bid; j < 192 * 4; j += nb) {
        {
          const int q = j, mt = q >> 2, nt = q & 3;
          f32x4 acc[4][4];
          zero_acc<4>(acc);
          const u16* y5 = (const u16*)(p.ws + B_Y5);
          gemm_core<4>(acc, y5 + (size_t)mt * 128 * 512, 512, WL + W_GLU + (size_t)nt * 128 * 512, 512, 512, sm);
          u16* ob5 = (u16*)(p.ws + B_OB5);
          const float* bgl = p.in[27] + l * 512;
          EPI_LOOP(4) {
            const size_t row = mt * 128 + EROW; const int col = nt * 128 + ECOL4(4);
            const uint2 yy = *(const uint2*)(y5 + row * 512 + col);
            const float4 bb = *(const float4*)(bgl + col);
            f32x4 o;
            o[0] = blo(yy.x) * sigmoidf_(acc[i][j][0] + bb.x); o[1] = bhi(yy.x) * sigmoidf_(acc[i][j][1] + bb.y);
            o[2] = blo(yy.y) * sigmoidf_(acc[i][j][2] + bb.z); o[3] = bhi(yy.y) * sigmoidf_(acc[i][j][3] + bb.w);
            *(uint2*)(ob5 + row * 512 + col) = pack4(o);
          }
        }
      }
    }
    GSYNC();
    if (PH(7)) {
      const u16* H = (const u16*)(p.ws + B_H);
      u16* mg = (u16*)(p.ws + B_MG);
      for (int j = bid; j < 192 * 16; j += nb) {
        const int mt = j >> 4, nt = j & 15;
        f32x4 mer[4][2];
        zero_acc<2>(mer);
#pragma unroll 1
        for (int n = 0; n < 3; ++n) {
          f32x4 ag[4][2], ab[4][2];
          zero_acc<2>(ag);
          gemm_core<2>(ag, H + (size_t)mt * 128 * 1024, 1024, WL + W_G + (size_t)(n * 1024 + nt * 64) * 1024, 1024, 1024, sm);
          zero_acc<2>(ab);
          const u16* on = (const u16*)(p.ws + (n == 0 ? B_OA : (n == 1 ? B_OB5 : B_OC)));
          gemm_core<2>(ab, on + (size_t)mt * 128 * 512, 512, WL + W_BR + (size_t)(nt * 64) * 1536 + n * 512, 1536, 512, sm);
#pragma unroll
          for (int i = 0; i < 4; ++i)
#pragma unroll
            for (int jj = 0; jj < 2; ++jj)
#pragma unroll
              for (int r = 0; r < 4; ++r) mer[i][jj][r] += sigmoidf_(ag[i][jj][r]) * ab[i][jj][r];
        }
        EPI_LOOP(2) { *(uint2*)(mg + (size_t)(mt * 128 + EROW) * 1024 + nt * 64 + ECOL4(2)) = pack4(mer[i][j]); }
      }
    }
    GSYNC();
    if (PH(8)) {
      const u16* mg = (const u16*)(p.ws + B_MG);
      for (int j = bid; j < 192 * 8; j += nb) {
        const int mt = j >> 3, nt = j & 7;
        f32x4 acc[4][4];
        zero_acc<4>(acc);
        gemm_core<4>(acc, mg + (size_t)mt * 128 * 1024, 1024, WL + W_OUT + (size_t)nt * 128 * 1024, 1024, 1024, sm);
        const float* gm = mods + (size_t)(l * 9 + tok_v(mt * 128)) * 6144 + 2 * 1024;
        EPI_LOOP(4) {
          const size_t row = mt * 128 + EROW; const int col = nt * 128 + ECOL4(4);
          float4* xp_ = (float4*)(p.out + row * 1024 + col);
          float4 xv = *xp_; const float4 gg = *(const float4*)(gm + col);
          xv.x += gg.x * acc[i][j][0]; xv.y += gg.y * acc[i][j][1]; xv.z += gg.z * acc[i][j][2]; xv.w += gg.w * acc[i][j][3];
          *xp_ = xv;
        }
      }
    }
    GSYNC();
    if (PH(9)) norm_phase(p, l, 3, 4, p.in[12] + l * 1024);
    GSYNC();
    if (PH(10)) {
      const u16* H = (const u16*)(p.ws + B_H);
      u16* up = (u16*)(p.ws + B_UP);
      for (int j = bid; j < 192 * 44; j += nb) {
        const int mt = j / 44, nt = j % 44;
        f32x4 acc[4][4];
        zero_acc<4>(acc);
        gemm_core<4>(acc, H + (size_t)mt * 128 * 1024, 1024, WL + W_UP + (size_t)nt * 128 * 1024, 1024, 1024, sm);
        EPI_LOOP(4) { *(uint2*)(up + (size_t)(mt * 128 + EROW) * 5632 + nt * 128 + ECOL4(4)) = pack4(acc[i][j]); }
      }
    }
    GSYNC();
    if (PH(11)) {
      const int tid = otid();
      const u16* up = (const u16*)(p.ws + B_UP);
      u16* act = (u16*)(p.ws + B_ACT);
      const float* cw = p.in[35] + (size_t)l * 3 * 5632;
      const float* cb = p.in[36] + (size_t)l * 5632;
      for (int it = bid * 256 + tid; it < (T_ / 2) * 352; it += nb * 256) {
        const int t = (it / 352) * 2, c8 = (it % 352) * 8;
        int pos, L;
        if (t < TP_) { pos = t & 255; L = 256; } else { pos = (t - TP_) & 2047; L = 2048; }
        float wg[3][8], wv[3][8], bgv[8], bvv[8];
#pragma unroll
        for (int d = 0; d < 3; ++d) {
          const float4 g0 = *(const float4*)(cw + d * 5632 + c8), g1 = *(const float4*)(cw + d * 5632 + c8 + 4);
          const float4 v0 = *(const float4*)(cw + d * 5632 + 2816 + c8), v1 = *(const float4*)(cw + d * 5632 + 2816 + c8 + 4);
          wg[d][0] = g0.x; wg[d][1] = g0.y; wg[d][2] = g0.z; wg[d][3] = g0.w; wg[d][4] = g1.x; wg[d][5] = g1.y; wg[d][6] = g1.z; wg[d][7] = g1.w;
          wv[d][0] = v0.x; wv[d][1] = v0.y; wv[d][2] = v0.z; wv[d][3] = v0.w; wv[d][4] = v1.x; wv[d][5] = v1.y; wv[d][6] = v1.z; wv[d][7] = v1.w;
        }
        {
          const float4 g0 = *(const float4*)(cb + c8), g1 = *(const float4*)(cb + c8 + 4);
          const float4 v0 = *(const float4*)(cb + 2816 + c8), v1 = *(const float4*)(cb + 2816 + c8 + 4);
          bgv[0] = g0.x; bgv[1] = g0.y; bgv[2] = g0.z; bgv[3] = g0.w; bgv[4] = g1.x; bgv[5] = g1.y; bgv[6] = g1.z; bgv[7] = g1.w;
          bvv[0] = v0.x; bvv[1] = v0.y; bvv[2] = v0.z; bvv[3] = v0.w; bvv[4] = v1.x; bvv[5] = v1.y; bvv[6] = v1.z; bvv[7] = v1.w;
        }
        float rg[4][8], rv[4][8];
#pragma unroll
        for (int q = 0; q < 4; ++q) {
          const int ps = pos + q - 1;
          uint4 ug = make_uint4(0, 0, 0, 0), uv = ug;
          if (ps >= 0 && ps < L) {
            const u16* rowp = up + (size_t)(t + q - 1) * 5632;
            ug = *(const uint4*)(rowp + c8); uv = *(const uint4*)(rowp + 2816 + c8);
          }
          rg[q][0] = blo(ug.x); rg[q][1] = bhi(ug.x); rg[q][2] = blo(ug.y); rg[q][3] = bhi(ug.y); rg[q][4] = blo(ug.z); rg[q][5] = bhi(ug.z); rg[q][6] = blo(ug.w); rg[q][7] = bhi(ug.w);
          rv[q][0] = blo(uv.x); rv[q][1] = bhi(uv.x); rv[q][2] = blo(uv.y); rv[q][3] = bhi(uv.y); rv[q][4] = blo(uv.z); rv[q][5] = bhi(uv.z); rv[q][6] = blo(uv.w); rv[q][7] = bhi(uv.w);
        }
#pragma unroll
        for (int o = 0; o < 2; ++o) {
          float res[8];
#pragma unroll
          for (int e = 0; e < 8; ++e) {
            float g = bgv[e], v = bvv[e];
#pragma unroll
            for (int d = 0; d < 3; ++d) { g += wg[d][e] * rg[o + d][e]; v += wv[d][e] * rv[o + d][e]; }
            res[e] = siluf_(g) * v;
          }
          *(uint4*)(act + (size_t)(t + o) * 2816 + c8) = make_uint4(pack2(res[0], res[1]), pack2(res[2], res[3]), pack2(res[4], res[5]), pack2(res[6], res[7]));
        }
      }
    }
    GSYNC();
    if (PH(12)) {
      const u16* act = (const u16*)(p.ws + B_ACT);
      for (int j = bid; j < 192 * 8; j += nb) {
        const int mt = j >> 3, nt = j & 7;
        f32x4 acc[4][4];
        zero_acc<4>(acc);
        gemm_core<4>(acc, act + (size_t)mt * 128 * 2816, 2816, WL + W_DN + (size_t)nt * 128 * 2816, 2816, 2816, sm);
        const float* gf = mods + (size_t)(l * 9 + tok_v(mt * 128)) * 6144 + 5 * 1024;
        EPI_LOOP(4) {
          const size_t row = mt * 128 + EROW; const int col = nt * 128 + ECOL4(4);
          float4* xp_ = (float4*)(p.out + row * 1024 + col);
          float4 xv = *xp_; const float4 gg = *(const float4*)(gf + col);
          xv.x += gg.x * acc[i][j][0]; xv.y += gg.y * acc[i][j][1]; xv.z += gg.z * acc[i][j][2]; xv.w += gg.w * acc[i][j][3];
          *xp_ = xv;
        }
      }
    }
    GSYNC();
  }
  if (PH(13)) {
    const int tid = otid();
    const int lane = tid & 63, w = tid >> 6;
    const float* gfin = p.in[38];
    for (int tile = bid; tile < T_ / 4; tile += nb) {
      const int t = tile * 4 + w;
      float4* xr = (float4*)(p.out + (size_t)t * 1024);
      float4 v[4];
      float ss = 0.f;
#pragma unroll
      for (int j = 0; j < 4; ++j) { v[j] = xr[lane + 64 * j]; ss += v[j].x * v[j].x + v[j].y * v[j].y + v[j].z * v[j].z + v[j].w * v[j].w; }
      ss = wave_sum(ss);
      const float rstd = rsqrtf(ss * (1.f / 1024.f) + 1e-6f);
#pragma unroll
      for (int j = 0; j < 4; ++j) {
        float4 g = *(const float4*)(gfin + (lane + 64 * j) * 4);
        xr[lane + 64 * j] = make_float4(v[j].x * rstd * g.x, v[j].y * rstd * g.y, v[j].z * rstd * g.z, v[j].w * rstd * g.w);
      }
    }
  }
}

extern "C" void kernel_launch(void* const* d_in, const int* in_sizes, int n_in, void* d_out, int out_size,
                              void* d_ws, size_t ws_size, hipStream_t stream) {
  static int grid_blocks = 0;
  if (!grid_blocks) {
    int dev = 0, cus = 0, per_cu = 0;
    (void)hipGetDevice(&dev);
    (void)hipDeviceGetAttribute(&cus, hipDeviceAttributeMultiprocessorCount, dev);
    (void)hipOccupancyMaxActiveBlocksPerMultiprocessor(&per_cu, mega, 256, 0);
    if (per_cu > 2) per_cu = 2;
    if (per_cu < 1) per_cu = 1;
    grid_blocks = cus * per_cu;
  }
  if (ws_size < B_TOTAL || n_in < 39) {
    fprintf(stderr, "workspace too small: %zu < %zu\n", ws_size, (size_t)B_END);
    return;
  }
  Params p{};
  for (int i = 0; i < 39; ++i) p.in[i] = (const float*)d_in[i];
  p.out = (float*)d_out;
  p.ws = (char*)d_ws;
  p.bar = (unsigned*)((char*)d_ws + B_BAR);
  (void)hipMemsetAsync(p.bar, 0, 256, stream);
  void* args[] = {&p};
  hipError_t e = hipLaunchCooperativeKernel((void*)mega, dim3(grid_blocks), dim3(256), args, 0, stream);
  if (e != hipSuccess) fprintf(stderr, "cooperative launch failed: %s (grid %d)\n", hipGetErrorString(e), grid_blocks);
}
```

```cpp
#include <hip/hip_runtime.h>
#include <hip/hip_cooperative_groups.h>
#include <cstdio>
namespace cg = cooperative_groups;

#define DI __device__ __forceinline__
typedef __bf16 bf16;
using bf16x8 = __attribute__((ext_vector_type(8))) short;
using f32x4 = __attribute__((ext_vector_type(4))) float;
using f32x16 = __attribute__((ext_vector_type(16))) float;
typedef unsigned short u16;

constexpr int T_ = 24576, TP_ = 8192;
constexpr int NCH = 384;
constexpr long long O_SD = 25165824LL, O_S5RE = 41943040LL, O_S5IM = 42467328LL, O_CKV = 42991616LL, O_KR = 51380224LL;

constexpr size_t W_IN = 0;
constexpr size_t W_G = W_IN + 3328ull * 1024;
constexpr size_t W_QB = W_G + 3072ull * 1024;
constexpr size_t W_KVB = W_QB + 768ull * 384;
constexpr size_t W_GLU = W_KVB + 1024ull * 256;
constexpr size_t W_BR = W_GLU + 512ull * 512;
constexpr size_t W_OUT = W_BR + 1024ull * 1536;
constexpr size_t W_UP = W_OUT + 1024ull * 1024;
constexpr size_t W_DN = W_UP + 5632ull * 1024;
constexpr size_t W_LAYER = W_DN + 1024ull * 2816;

constexpr size_t al(size_t x) { return (x + 255) & ~(size_t)255; }
constexpr size_t B_W = 0;
constexpr size_t B_MODS = al(B_W + 4 * W_LAYER * 2);
constexpr size_t B_ROPE = al(B_MODS + 4ull * 9 * 6144 * 4);
constexpr size_t B_LAMB = al(B_ROPE + 2048ull * 32 * 4);
constexpr size_t B_LAM64 = al(B_LAMB + 4ull * 2 * 32 * 64 * 8);
constexpr size_t B_BBT = al(B_LAM64 + 4ull * 2 * 32 * 64 * 8);
constexpr size_t B_CMT = al(B_BBT + 4ull * 2 * 32 * 128 * 16 * 2);
constexpr size_t B_CKVC = al(B_CMT + 4ull * 32 * 16 * 128 * 2);
constexpr size_t B_H = al(B_CKVC + 4ull * 2048 * 256 * 2);
constexpr size_t B_QKV = al(B_H + (size_t)T_ * 1024 * 2);
constexpr size_t B_Z = al(B_QKV + (size_t)T_ * 1536 * 2);
constexpr size_t B_US5 = al(B_Z + (size_t)T_ * 512 * 2);
constexpr size_t B_QA = al(B_US5 + (size_t)T_ * 512 * 2);
constexpr size_t B_KVA = al(B_QA + (size_t)T_ * 384 * 2);
constexpr size_t B_MISC = al(B_KVA + (size_t)T_ * 256 * 2);
constexpr size_t B_QN = al(B_MISC + (size_t)T_ * 48 * 4);
constexpr size_t B_KN = al(B_QN + (size_t)T_ * 512 * 2);
constexpr size_t B_VV = al(B_KN + (size_t)T_ * 512 * 2);
constexpr size_t B_KT = al(B_VV + (size_t)T_ * 512 * 2);
constexpr size_t B_BG = al(B_KT + (size_t)T_ * 512 * 2);
constexpr size_t B_TM = al(B_BG + (size_t)T_ * 16 * 4);
constexpr size_t B_QKM = al(B_TM + (size_t)T_ * 512 * 2);
constexpr size_t B_GC = al(B_QKM + (size_t)T_ * 512 * 2);
constexpr size_t B_BC = al(B_GC + (size_t)NCH * 4 * 2 * 64 * 4);
constexpr size_t KB_P = 32ull * 8 * 256 * 96, KB_S = 8ull * 8 * 2304 * 96;
constexpr size_t VT_P = 32ull * 8 * 64 * 256, VT_S = 8ull * 8 * 64 * 2304;
constexpr size_t B_KB = al(B_BC + (size_t)NCH * 4 * 2 * 64 * 4);
constexpr size_t B_VT = al(B_KB + (KB_P + KB_S) * 2);
constexpr size_t B_QM = al(B_VT + (VT_P + VT_S) * 2);
constexpr size_t B_HEND = al(B_QM + (size_t)T_ * 768 * 2);
constexpr size_t B_HIN = al(B_HEND + (size_t)NCH * 32 * 2 * 64 * 8);
constexpr size_t B_Y5 = al(B_HIN + (size_t)NCH * 32 * 2 * 64 * 8);
constexpr size_t B_OC = al(B_Y5 + (size_t)T_ * 512 * 2);
constexpr size_t B_END = al(B_OC + (size_t)T_ * 512 * 2);
constexpr size_t B_OF = B_QKV;
constexpr size_t B_OB = B_QKV + (size_t)T_ * 512 * 2;
constexpr size_t B_MG = B_QKV;
constexpr size_t B_OA = B_QN;
constexpr size_t B_OB5 = B_KN;
constexpr size_t B_UP = B_QKV;
constexpr size_t B_ACT = B_KB;
static_assert(B_UP + (size_t)T_ * 5632 * 2 <= B_KB, "UP overlaps ACT");
static_assert(B_ACT + (size_t)T_ * 2816 * 2 <= B_END, "ACT too big");
constexpr size_t B_BAR = B_END;
constexpr size_t B_TOTAL = B_BAR + 256;
static_assert(B_TOTAL <= 768ull * 1024 * 1024, "workspace too big");

struct Params {
  const float* in[39];
  float* out;
  char* ws;
  unsigned* bar;
};

DI int otid() { int t = (int)__builtin_amdgcn_workitem_id_x(); asm volatile("" : "+v"(t)); return t; }
DI unsigned pack2(float a, float b) {
  typedef __attribute__((ext_vector_type(2))) __bf16 bf2;
  bf2 v; v[0] = (__bf16)a; v[1] = (__bf16)b;
  return __builtin_bit_cast(unsigned, v);
}
DI u16 f2bf(float a) { return (u16)(pack2(a, 0.f) & 0xffffu); }
DI float bf2f(u16 u) { return __uint_as_float(((unsigned)u) << 16); }
DI float blo(unsigned u) { return __uint_as_float(u << 16); }
DI float bhi(unsigned u) { return __uint_as_float(u & 0xffff0000u); }
DI float wave_sum(float v) {
#pragma unroll
  for (int o = 32; o > 0; o >>= 1) v += __shfl_xor(v, o);
  return v;
}
DI float sigmoidf_(float x) { return 1.f / (1.f + __expf(-x)); }
DI float siluf_(float x) { return x / (1.f + __expf(-x)); }
DI int tok_v(int t) { return t < TP_ ? 0 : 1 + ((t - TP_) >> 11); }
DI int crow(int r, int h2) { return (r & 3) + 8 * (r >> 2) + 4 * h2; }
DI bf16x8 mk8(unsigned a, unsigned b, unsigned c, unsigned d) {
  uint4 p = make_uint4(a, b, c, d);
  return __builtin_bit_cast(bf16x8, p);
}
DI bf16x8 pack_acc(const f32x16& x, int s) {
  return mk8(pack2(x[8 * s], x[8 * s + 1]), pack2(x[8 * s + 2], x[8 * s + 3]), pack2(x[8 * s + 4], x[8 * s + 5]),
             pack2(x[8 * s + 6], x[8 * s + 7]));
}
DI bf16x8 load_perm(const u16* rowptr, int s, int h2) {
  uint2 a = *(const uint2*)(rowptr + 16 * s + 4 * h2);
  uint2 b = *(const uint2*)(rowptr + 16 * s + 8 + 4 * h2);
  return mk8(a.x, a.y, b.x, b.y);
}
DI unsigned swap16(unsigned u) { return (u >> 16) | (u << 16); }
DI bf16x8 load_perm_rev(const u16* rowptr, int base, int s, int h2) {
  uint2 a = *(const uint2*)(rowptr + 60 - base - 16 * s - 4 * h2);
  uint2 b = *(const uint2*)(rowptr + 52 - base - 16 * s - 4 * h2);
  return mk8(swap16(a.y), swap16(a.x), swap16(b.y), swap16(b.x));
}
#define MFMA16(a, b, c) __builtin_amdgcn_mfma_f32_16x16x32_bf16((a), (b), (c), 0, 0, 0)
#define MFMA32(a, b, c) __builtin_amdgcn_mfma_f32_32x32x16_bf16((a), (b), (c), 0, 0, 0)

template <int NJ, bool SWAP = true>
DI void gemm_core(f32x4 (&acc)[4][NJ], const u16* __restrict__ A, int lda, const u16* __restrict__ B, int ldb, int K,
                  u16* sm) {
  const int tid = otid(), lane = tid & 63, w = tid >> 6, wr = w >> 1, wc = w & 1;
  const int fr = lane & 15, fq = lane >> 4;
  constexpr int RS = 136;
  const int lrow = tid >> 4, lkc = tid & 15;
  uint4 a0, a1, a2, a3, a4, a5, a6, a7, b0, b1, b2, b3, b4, b5, b6, b7;
  b4 = b5 = b6 = b7 = make_uint4(0, 0, 0, 0);
  const u16* ap = A + (size_t)lrow * lda + lkc * 8;
  const u16* bp = B + (size_t)lrow * ldb + lkc * 8;
  const int nk = K >> 7;
  u16* as = sm;
  u16* bs = sm + 128 * RS;
  {
    const int k0 = 0;
    a0 = *(const uint4*)(ap + (size_t)(0 * 16) * lda + k0);
    a1 = *(const uint4*)(ap + (size_t)(1 * 16) * lda + k0);
    a2 = *(const uint4*)(ap + (size_t)(2 * 16) * lda + k0);
    a3 = *(const uint4*)(ap + (size_t)(3 * 16) * lda + k0);
    a4 = *(const uint4*)(ap + (size_t)(4 * 16) * lda + k0);
    a5 = *(const uint4*)(ap + (size_t)(5 * 16) * lda + k0);
    a6 = *(const uint4*)(ap + (size_t)(6 * 16) * lda + k0);
    a7 = *(const uint4*)(ap + (size_t)(7 * 16) * lda + k0);
    b0 = *(const uint4*)(bp + (size_t)(0 * 16) * ldb + k0);
    b1 = *(const uint4*)(bp + (size_t)(1 * 16) * ldb + k0);
    b2 = *(const uint4*)(bp + (size_t)(2 * 16) * ldb + k0);
    b3 = *(const uint4*)(bp + (size_t)(3 * 16) * ldb + k0);
    if (NJ == 4) b4 = *(const uint4*)(bp + (size_t)(4 * 16) * ldb + k0);
    if (NJ == 4) b5 = *(const uint4*)(bp + (size_t)(5 * 16) * ldb + k0);
    if (NJ == 4) b6 = *(const uint4*)(bp + (size_t)(6 * 16) * ldb + k0);
    if (NJ == 4) b7 = *(const uint4*)(bp + (size_t)(7 * 16) * ldb + k0);
  }
  for (int kt = 0; kt < nk; ++kt) {
    __syncthreads();
    *(uint4*)(as + (lrow + 0 * 16) * RS + lkc * 8) = a0;
    *(uint4*)(as + (lrow + 1 * 16) * RS + lkc * 8) = a1;
    *(uint4*)(as + (lrow + 2 * 16) * RS + lkc * 8) = a2;
    *(uint4*)(as + (lrow + 3 * 16) * RS + lkc * 8) = a3;
    *(uint4*)(as + (lrow + 4 * 16) * RS + lkc * 8) = a4;
    *(uint4*)(as + (lrow + 5 * 16) * RS + lkc * 8) = a5;
    *(uint4*)(as + (lrow + 6 * 16) * RS + lkc * 8) = a6;
    *(uint4*)(as + (lrow + 7 * 16) * RS + lkc * 8) = a7;
    *(uint4*)(bs + (lrow + 0 * 16) * RS + lkc * 8) = b0;
    *(uint4*)(bs + (lrow + 1 * 16) * RS + lkc * 8) = b1;
    *(uint4*)(bs + (lrow + 2 * 16) * RS + lkc * 8) = b2;
    *(uint4*)(bs + (lrow + 3 * 16) * RS + lkc * 8) = b3;
    if (NJ == 4) *(uint4*)(bs + (lrow + 4 * 16) * RS + lkc * 8) = b4;
    if (NJ == 4) *(uint4*)(bs + (lrow + 5 * 16) * RS + lkc * 8) = b5;
    if (NJ == 4) *(uint4*)(bs + (lrow + 6 * 16) * RS + lkc * 8) = b6;
    if (NJ == 4) *(uint4*)(bs + (lrow + 7 * 16) * RS + lkc * 8) = b7;
    __syncthreads();
    {
      const int k0 = (kt + 1 < nk ? kt + 1 : kt) * 128;
    a0 = *(const uint4*)(ap + (size_t)(0 * 16) * lda + k0);
    a1 = *(const uint4*)(ap + (size_t)(1 * 16) * lda + k0);
    a2 = *(const uint4*)(ap + (size_t)(2 * 16) * lda + k0);
    a3 = *(const uint4*)(ap + (size_t)(3 * 16) * lda + k0);
    a4 = *(const uint4*)(ap + (size_t)(4 * 16) * lda + k0);
    a5 = *(const uint4*)(ap + (size_t)(5 * 16) * lda + k0);
    a6 = *(const uint4*)(ap + (size_t)(6 * 16) * lda + k0);
    a7 = *(const uint4*)(ap + (size_t)(7 * 16) * lda + k0);
    b0 = *(const uint4*)(bp + (size_t)(0 * 16) * ldb + k0);
    b1 = *(const uint4*)(bp + (size_t)(1 * 16) * ldb + k0);
    b2 = *(const uint4*)(bp + (size_t)(2 * 16) * ldb + k0);
    b3 = *(const uint4*)(bp + (size_t)(3 * 16) * ldb + k0);
    if (NJ == 4) b4 = *(const uint4*)(bp + (size_t)(4 * 16) * ldb + k0);
    if (NJ == 4) b5 = *(const uint4*)(bp + (size_t)(5 * 16) * ldb + k0);
    if (NJ == 4) b6 = *(const uint4*)(bp + (size_t)(6 * 16) * ldb + k0);
    if (NJ == 4) b7 = *(const uint4*)(bp + (size_t)(7 * 16) * ldb + k0);
    }
    __builtin_amdgcn_s_setprio(1);
#pragma unroll
    for (int ks = 0; ks < 4; ++ks) {
      bf16x8 af[4], bfr[NJ];
#pragma unroll
      for (int i = 0; i < 4; ++i) af[i] = *(const bf16x8*)(as + (wr * 64 + i * 16 + fr) * RS + ks * 32 + fq * 8);
#pragma unroll
      for (int j = 0; j < NJ; ++j) bfr[j] = *(const bf16x8*)(bs + (wc * NJ * 16 + j * 16 + fr) * RS + ks * 32 + fq * 8);
#pragma unroll
      for (int i = 0; i < 4; ++i)
#pragma unroll
        for (int j = 0; j < NJ; ++j) acc[i][j] = SWAP ? MFMA16(bfr[j], af[i], acc[i][j]) : MFMA16(af[i], bfr[j], acc[i][j]);
    }
    __builtin_amdgcn_s_setprio(0);
  }
}
template <int NJ>
DI void zero_acc(f32x4 (&acc)[4][NJ]) {
#pragma unroll
  for (int i = 0; i < 4; ++i)
#pragma unroll
    for (int j = 0; j < NJ; ++j) acc[i][j] = f32x4{0.f, 0.f, 0.f, 0.f};
}
#define EPI_LOOP(NJ_)                                                              \
  const int e_lane = otid() & 63, e_w = otid() >> 6;                               \
  const int e_wr = e_w >> 1, e_wc = e_w & 1, e_fr = e_lane & 15, e_fq = e_lane >> 4; \
  _Pragma("unroll") for (int i = 0; i < 4; ++i)                                    \
  _Pragma("unroll") for (int j = 0; j < NJ_; ++j)
#define EROW (e_wr * 64 + i * 16 + e_fr)
#define ECOL4(NJ_) (e_wc * NJ_ * 16 + j * 16 + e_fq * 4)
DI uint2 pack4(const f32x4& v) { return make_uint2(pack2(v[0], v[1]), pack2(v[2], v[3])); }

DI int colmap(int kind, int n) {
  if (kind == 0) {
    if (n < 2048) return n;
    if (n < 2560) return 2064 + (n - 2048);
    if (n < 2944) return 2576 + (n - 2560);
    if (n < 3200) return 2960 + (n - 2944);
    int j = n - 3200;
    if (j < 16) return 2048 + j;
    if (j < 48) return 3216 + (j - 16);
    return -1;
  }
  if (kind == 1) return 3248 + n;
  return n;
}
DI void convT_tile(const float* __restrict__ src, int lds, int K, u16* __restrict__ dst, int kind, int kt, int nt,
                   float* sm) {
  const int tid = otid();
  const int c = tid & 63;
  const int sc = colmap(kind, nt * 64 + c);
  __syncthreads();
#pragma unroll 4
  for (int i = 0; i < 16; ++i) {
    int r = (tid >> 6) + i * 4;
    float v = sc >= 0 ? src[(size_t)(kt * 64 + r) * lds + sc] : 0.f;
    sm[r * 65 + c] = v;
  }
  __syncthreads();
  const int n = tid >> 2, kq = tid & 3;
  unsigned pk[8];
#pragma unroll
  for (int j = 0; j < 8; ++j) pk[j] = pack2(sm[(kq * 16 + 2 * j) * 65 + n], sm[(kq * 16 + 2 * j + 1) * 65 + n]);
  u16* d = dst + (size_t)(nt * 64 + n) * K + kt * 64 + kq * 16;
  *(uint4*)d = make_uint4(pk[0], pk[1], pk[2], pk[3]);
  *(uint4*)(d + 8) = make_uint4(pk[4], pk[5], pk[6], pk[7]);
}
constexpr int CJ0 = 16 * 52, CJ1 = CJ0 + 16 * 48, CJ2 = CJ1 + 6 * 12, CJ3 = CJ2 + 4 * 16, CJ4 = CJ3 + 8 * 8,
              CJ5 = CJ4 + 24 * 16, CJ6 = CJ5 + 16 * 16, CJ7 = CJ6 + 16 * 88, CJ8 = CJ7 + 44 * 16;
DI void conv_job(const Params& p, int l, int j, float* sm) {
  u16* wl = (u16*)(p.ws + B_W) + (size_t)l * W_LAYER;
  if (j < CJ0) { convT_tile(p.in[13] + (size_t)l * 1024 * 6320, 6320, 1024, wl + W_IN, 0, j / 52, j % 52, sm); return; }
  if (j < CJ1) { j -= CJ0; convT_tile(p.in[13] + (size_t)l * 1024 * 6320, 6320, 1024, wl + W_G, 1, j / 48, j % 48, sm); return; }
  if (j < CJ2) { j -= CJ1; convT_tile(p.in[29] + (size_t)l * 384 * 768, 768, 384, wl + W_QB, 2, j / 12, j % 12, sm); return; }
  if (j < CJ3) { j -= CJ2; convT_tile(p.in[31] + (size_t)l * 256 * 1024, 1024, 256, wl + W_KVB, 2, j / 16, j % 16, sm); return; }
  if (j < CJ4) { j -= CJ3; convT_tile(p.in[26] + (size_t)l * 512 * 512, 512, 512, wl + W_GLU, 2, j / 8, j % 8, sm); return; }
  if (j < CJ5) { j -= CJ4; convT_tile(p.in[32] + (size_t)l * 1536 * 1024, 1024, 1536, wl + W_BR, 2, j / 16, j % 16, sm); return; }
  if (j < CJ6) { j -= CJ5; convT_tile(p.in[33] + (size_t)l * 1024 * 1024, 1024, 1024, wl + W_OUT, 2, j / 16, j % 16, sm); return; }
  if (j < CJ7) { j -= CJ6; convT_tile(p.in[34] + (size_t)l * 1024 * 5632, 5632, 1024, wl + W_UP, 2, j / 88, j % 88, sm); return; }
  j -= CJ7; convT_tile(p.in[37] + (size_t)l * 2816 * 1024, 1024, 2816, wl + W_DN, 2, j / 16, j % 16, sm);
}
DI void mods_tile(const Params& p, int l, int jg, float* sm) {
  const int tid = otid();
  __syncthreads();
  for (int i = tid; i < 9 * 1024; i += 256) {
    int v = i >> 10, k = i & 1023;
    float cv = v == 0 ? p.in[8][k] : p.in[7][(v - 1) * 1024 + k];
    sm[i] = cv / (1.f + __expf(-cv));
  }
  __syncthreads();
  const int col = jg * 64 + (tid & 63), kq = tid >> 6;
  float acc[9];
#pragma unroll
  for (int v = 0; v < 9; ++v) acc[v] = 0.f;
  const float* wp = p.in[9] + (size_t)l * 1024 * 6144 + col;
#pragma unroll 4
  for (int k = kq * 256; k < kq * 256 + 256; ++k) {
    float wv = wp[(size_t)k * 6144];
#pragma unroll
    for (int v = 0; v < 9; ++v) acc[v] += sm[v * 1024 + k] * wv;
  }
  float* red = sm + 9 * 1024;
#pragma unroll
  for (int v = 0; v < 9; ++v) red[(kq * 9 + v) * 64 + (tid & 63)] = acc[v];
  __syncthreads();
  if (kq == 0) {
    float* mods = (float*)(p.ws + B_MODS);
    float b = p.in[10][l * 6144 + col];
#pragma unroll
    for (int v = 0; v < 9; ++v) {
      float s = red[(0 * 9 + v) * 64 + tid] + red[(1 * 9 + v) * 64 + tid] + red[(2 * 9 + v) * 64 + tid] + red[(3 * 9 + v) * 64 + tid];
      mods[(size_t)(l * 9 + v) * 6144 + col] = s + b;
    }
  }
}
DI void s5pre_tile(const Params& p, int tile) {
  const int id = tile * 256 + otid();
  const int pp = id & 63, g = (id >> 6) & 31, dir = (id >> 11) & 1, l = id >> 12;
  const float lre = p.in[18][((l * 2 + dir) * 32 + g) * 64 + pp];
  const float lim = p.in[19][((l * 2 + dir) * 32 + g) * 64 + pp];
  const float dt = expf(p.in[20][(l * 2 + dir) * 32 + g]);
  float er = expf(lre * dt), sn, cs;
  sincosf(lim * dt, &sn, &cs);
  const float lbr = er * cs, lbi = er * sn;
  float e64 = expf(64.f * lre * dt), s64, c64;
  sincosf(64.f * lim * dt, &s64, &c64);
  float2* lamb = (float2*)(p.ws + B_LAMB);
  float2* lam64 = (float2*)(p.ws + B_LAM64);
  const int li = ((l * 2 + dir) * 32 + g) * 64 + pp;
  lamb[li] = make_float2(lbr, lbi);
  lam64[li] = make_float2(e64 * c64, e64 * s64);
  const float nr = lbr - 1.f, ni = lbi, den = lre * lre + lim * lim;
  const float cr = (nr * lre + ni * lim) / den, ci = (ni * lre - nr * lim) / den;
  u16* bbt = (u16*)(p.ws + B_BBT) + (size_t)((l * 2 + dir) * 32 + g) * 128 * 16;
  const float* bre = p.in[21] + (size_t)((l * 32 + g) * 64 + pp) * 16;
  const float* bim = p.in[22] + (size_t)((l * 32 + g) * 64 + pp) * 16;
#pragma unroll
  for (int c = 0; c < 16; ++c) {
    float br = bre[c], bi = bim[c];
    bbt[pp * 16 + c] = f2bf(cr * br - ci * bi);
    bbt[(64 + pp) * 16 + c] = f2bf(cr * bi + ci * br);
  }
  if (dir == 0) {
    u16* cmt = (u16*)(p.ws + B_CMT) + (size_t)(l * 32 + g) * 16 * 128;
    const float* cre = p.in[23] + (size_t)(l * 32 + g) * 16 * 64;
    const float* cim = p.in[24] + (size_t)(l * 32 + g) * 16 * 64;
#pragma unroll
    for (int c = 0; c < 16; ++c) {
      cmt[c * 128 + pp] = f2bf(cre[c * 64 + pp]);
      cmt[c * 128 + 64 + pp] = f2bf(-cim[c * 64 + pp]);
    }
  }
}

DI void norm_phase(const Params& p, int l, int shift_idx, int scale_idx, const float* gn) {
  const float* x = p.out;
  u16* H = (u16*)(p.ws + B_H);
  const float* mods = (const float*)(p.ws + B_MODS);
  const int lane = otid() & 63, w = otid() >> 6;
  for (int tile = blockIdx.x; tile < T_ / 4; tile += gridDim.x) {
    const int t = tile * 4 + w;
    const float4* xr = (const float4*)(x + (size_t)t * 1024);
    float4 v[4];
    float ss = 0.f;
#pragma unroll
    for (int j = 0; j < 4; ++j) {
      v[j] = xr[lane + 64 * j];
      ss += v[j].x * v[j].x + v[j].y * v[j].y + v[j].z * v[j].z + v[j].w * v[j].w;
    }
    ss = wave_sum(ss);
    const float rstd = rsqrtf(ss * (1.f / 1024.f) + 1e-6f);
    const float* mb = mods + (size_t)(l * 9 + tok_v(t)) * 6144;
#pragma unroll
    for (int j = 0; j < 4; ++j) {
      const int c = (lane + 64 * j) * 4;
      float4 g = *(const float4*)(gn + c);
      float4 sc = *(const float4*)(mb + scale_idx * 1024 + c);
      float4 sh = *(const float4*)(mb + shift_idx * 1024 + c);
      float y0 = v[j].x * rstd * g.x * (1.f + sc.x) + sh.x;
      float y1 = v[j].y * rstd * g.y * (1.f + sc.y) + sh.y;
      float y2 = v[j].z * rstd * g.z * (1.f + sc.z) + sh.z;
      float y3 = v[j].w * rstd * g.w * (1.f + sc.w) + sh.w;
      *(uint2*)(H + (size_t)t * 1024 + c) = make_uint2(pack2(y0, y1), pack2(y2, y3));
    }
  }
}

DI void gemm_in_phase(const Params& p, int l, u16* sm) {
  const u16* H = (const u16*)(p.ws + B_H);
  const u16* Wt = (const u16*)(p.ws + B_W) + (size_t)l * W_LAYER + W_IN;
  for (int tile = blockIdx.x; tile < 192 * 26; tile += gridDim.x) {
    const int mt = tile / 26, nt = tile % 26;
    f32x4 acc[4][4];
    zero_acc<4>(acc);
    gemm_core<4>(acc, H + (size_t)mt * 128 * 1024, 1024, Wt + (size_t)nt * 128 * 1024, 1024, 1024, sm);
    if (nt < 25) {
      u16* dst; int ld, c0;
      if (nt < 12) { dst = (u16*)(p.ws + B_QKV); ld = 1536; c0 = nt * 128; }
      else if (nt < 16) { dst = (u16*)(p.ws + B_Z); ld = 512; c0 = (nt - 12) * 128; }
      else if (nt < 20) { dst = (u16*)(p.ws + B_US5); ld = 512; c0 = (nt - 16) * 128; }
      else if (nt < 23) { dst = (u16*)(p.ws + B_QA); ld = 384; c0 = (nt - 20) * 128; }
      else { dst = (u16*)(p.ws + B_KVA); ld = 256; c0 = (nt - 23) * 128; }
      EPI_LOOP(4) { *(uint2*)(dst + (size_t)(mt * 128 + EROW) * ld + c0 + ECOL4(4)) = pack4(acc[i][j]); }
    } else {
      float* misc = (float*)(p.ws + B_MISC);
      EPI_LOOP(4) {
        const int c = ECOL4(4);
        if (c < 48) *(float4*)(misc + (size_t)(mt * 128 + EROW) * 48 + c) = make_float4(acc[i][j][0], acc[i][j][1], acc[i][j][2], acc[i][j][3]);
      }
    }
  }
}

DI void delta_prep_tile(const Params& p, int l, int chunk, u16* sm) {
  const int tid = otid(), lane = tid & 63, w = tid >> 6;
  const int tb = chunk * 64;
  int pos0, L;
  if (tb < TP_) { pos0 = tb & 255; L = 256; } else { pos0 = (tb - TP_) & 2047; L = 2048; }
  const u16* qkv = (const u16*)(p.ws + B_QKV);
  const float* cw = p.in[14] + (size_t)l * 5 * 1536;
  u16* ksm = sm + w * (64 * 130);
  __syncthreads();
  for (int gi = w; gi < 12; gi += 4) {
    const int ch = gi * 128 + 2 * lane;
    float w0[5], w1[5];
#pragma unroll
    for (int i = 0; i < 5; ++i) { w0[i] = cw[i * 1536 + ch]; w1[i] = cw[i * 1536 + ch + 1]; }
    float a0[5], a1[5];
#pragma unroll
    for (int i = 0; i < 4; ++i) {
      int ps = pos0 - 2 + i;
      unsigned u = (ps >= 0 && ps < L) ? *(const unsigned*)(qkv + (size_t)(tb - 2 + i) * 1536 + ch) : 0u;
      a0[i + 1] = blo(u); a1[i + 1] = bhi(u);
    }
    u16* dst = (u16*)(p.ws + (gi < 4 ? B_QN : (gi < 8 ? B_KN : B_VV)));
    const int hh = gi & 3;
    for (int tt = 0; tt < 64; ++tt) {
#pragma unroll
      for (int i = 0; i < 4; ++i) { a0[i] = a0[i + 1]; a1[i] = a1[i + 1]; }
      {
        int ps = pos0 + tt + 2;
        unsigned u = (ps < L) ? *(const unsigned*)(qkv + (size_t)(tb + tt + 2) * 1536 + ch) : 0u;
        a0[4] = blo(u); a1[4] = bhi(u);
      }
      float y0 = 0.f, y1 = 0.f;
#pragma unroll
      for (int i = 0; i < 5; ++i) { y0 += w0[i] * a0[i]; y1 += w1[i] * a1[i]; }
      y0 = siluf_(y0); y1 = siluf_(y1);
      if (gi < 8) {
        float ss = wave_sum(y0 * y0 + y1 * y1);
        float sc = rsqrtf(ss + 1e-6f);
        if (gi < 4) sc *= 0.08838834764831845f;
        y0 *= sc; y1 *= sc;
      }
      const unsigned pk = pack2(y0, y1);
      *(unsigned*)(dst + (size_t)(tb + tt) * 512 + hh * 128 + 2 * lane) = pk;
      if (gi >= 4 && gi < 8) *(unsigned*)(ksm + tt * 130 + 2 * lane) = pk;
    }
    if (gi >= 4 && gi < 8) {
      u16* kt = (u16*)(p.ws + B_KT) + (size_t)(chunk * 4 + hh) * 128 * 64;
#pragma unroll
      for (int rr = 0; rr < 2; ++rr) {
        const int dk = lane + 64 * rr;
        unsigned pk[32];
#pragma unroll
        for (int t2 = 0; t2 < 32; ++t2) pk[t2] = (unsigned)ksm[(2 * t2) * 130 + dk] | ((unsigned)ksm[(2 * t2 + 1) * 130 + dk] << 16);
#pragma unroll
        for (int q = 0; q < 8; ++q) *(uint4*)(kt + dk * 64 + q * 8) = make_uint4(pk[4 * q], pk[4 * q + 1], pk[4 * q + 2], pk[4 * q + 3]);
      }
    }
  }
  const float* misc = (const float*)(p.ws + B_MISC);
  float* bg = (float*)(p.ws + B_BG);
  for (int i = tid; i < 512; i += 256) {
    const int tt = i >> 3, dh = i & 7;
    const size_t t = tb + tt;
    float bl = misc[t * 48 + dh], alp = misc[t * 48 + 8 + dh];
    float x = alp + p.in[16][l * 8 + dh];
    float sp = x > 20.f ? x : log1pf(__expf(x));
    bg[t * 16 + dh] = sigmoidf_(bl);
    bg[t * 16 + 8 + dh] = -__expf(p.in[15][l * 8 + dh]) * sp;
  }
}

DI size_t kb_off(int t, int head) {
  if (t < TP_) return ((size_t)((t >> 8) * 8 + head) * 256 + (t & 255)) * 96;
  const int s = (t - TP_) >> 11, pos = (t - TP_) & 2047;
  return KB_P + ((size_t)(s * 8 + head) * 2304 + 256 + pos) * 96;
}
DI void mla_prep_tile(const Params& p, int l, int tile) {
  const int lane = otid() & 63, w = otid() >> 6;
  const int t = tile * 4 + w;
  u16* qa = (u16*)(p.ws + B_QA) + (size_t)t * 384;
  u16* kva = (u16*)(p.ws + B_KVA) + (size_t)t * 256;
  const float* misc = (const float*)(p.ws + B_MISC) + (size_t)t * 48;
  {
    unsigned u[3]; float ss = 0.f;
#pragma unroll
    for (int j = 0; j < 3; ++j) { u[j] = *(const unsigned*)(qa + 2 * lane + 128 * j); float a = blo(u[j]), b = bhi(u[j]); ss += a * a + b * b; }
    ss = wave_sum(ss);
    const float rstd = rsqrtf(ss * (1.f / 384.f) + 1e-6f);
    const float* g = p.in[28] + l * 384;
#pragma unroll
    for (int j = 0; j < 3; ++j) {
      int c = 2 * lane + 128 * j;
      *(unsigned*)(qa + c) = pack2(blo(u[j]) * rstd * g[c], bhi(u[j]) * rstd * g[c + 1]);
    }
  }
  {
    unsigned u[2]; float ss = 0.f;
#pragma unroll
    for (int j = 0; j < 2; ++j) { u[j] = *(const unsigned*)(kva + 2 * lane + 128 * j); float a = blo(u[j]), b = bhi(u[j]); ss += a * a + b * b; }
    ss = wave_sum(ss);
    const float rstd = rsqrtf(ss * (1.f / 256.f) + 1e-6f);
    const float* g = p.in[30] + l * 256;
#pragma unroll
    for (int j = 0; j < 2; ++j) {
      int c = 2 * lane + 128 * j;
      float a = blo(u[j]) * rstd * g[c], b = bhi(u[j]) * rstd * g[c + 1];
      *(unsigned*)(kva + c) = pack2(a, b);
      if (t < TP_) {
        float* o = p.out + O_CKV + ((size_t)((t >> 8) * 4 + l) * 256 + (t & 255)) * 256 + c;
        *(float2*)o = make_float2(a, b);
      }
    }
  }
  {
    const int i = lane & 31;
    float kr = misc[16 + i];
    float val;
    if (t < TP_) {
      val = kr;
      if (lane < 32) p.out[O_KR + ((size_t)((t >> 8) * 4 + l) * 256 + (t & 255)) * 32 + i] = kr;
    } else {
      const int pos = (t - TP_) & 2047;
      const float* rp = (const float*)(p.ws + B_ROPE) + (size_t)pos * 32 + (i & 15) * 2;
      const float cs = rp[0], sn = rp[1];
      float other = __shfl_xor(kr, 16);
      val = (i < 16) ? (kr * cs - other * sn) : (kr * cs + other * sn);
    }
    u16* kb = (u16*)(p.ws + B_KB);
    const u16 bv = f2bf(val);
#pragma unroll
    for (int hh = 0; hh < 4; ++hh) {
      int head = hh * 2 + (lane >> 5);
      kb[kb_off(t, head) + 64 + i] = bv;
    }
  }
}
DI void cache_rope_tile(const Params& p, int l, int tile) {
  const int pr = tile * 8 + (otid() >> 5), i = otid() & 31;
  const int s = pr >> 8, pos = pr & 255;
  const float v = p.in[6][((size_t)(s * 4 + l) * 256 + pos) * 32 + i];
  u16* kb = (u16*)(p.ws + B_KB);
  const u16 bv = f2bf(v);
#pragma unroll
  for (int head = 0; head < 8; ++head) kb[KB_P + ((size_t)(s * 8 + head) * 2304 + pos) * 96 + 64 + i] = bv;
}

DI float gelu_tanh(float x) {
  const float k0 = 0.7978845608028654f, k1 = 0.044715f;
  float u = k0 * (x + k1 * x * x * x);
  float e = __expf(2.f * u);
  float th = 1.f - 2.f / (e + 1.f);
  return 0.5f * x * (1.f + th);
}
DI void s5_chunk_tile(const Params& p, int l, int chunk, int gp, int mode, u16* sm) {
  const int tid = otid(), lane = tid & 63, w = tid >> 6;
  const u16* us5 = (const u16*)(p.ws + B_US5);
  constexpr int RS = 136;
  const int gi_w = w >> 1, half = w & 1, g_w = gp * 2 + gi_w;
  const int n = lane & 31, h2 = lane >> 5;
  bf16x8 af[2], bq[2][2];
#pragma unroll
  for (int mi = 0; mi < 2; ++mi) af[mi] = *(const bf16x8*)(us5 + (size_t)(chunk * 64 + mi * 32 + n) * 512 + g_w * 16 + 8 * h2);
#pragma unroll
  for (int dir = 0; dir < 2; ++dir) {
    const u16* bbt = (const u16*)(p.ws + B_BBT) + (size_t)((l * 2 + dir) * 32 + g_w) * 128 * 16;
#pragma unroll
    for (int nn = 0; nn < 2; ++nn) bq[dir][nn] = *(const bf16x8*)(bbt + ((half * 2 + nn) * 32 + n) * 16 + 8 * h2);
  }
  const int gi_t = tid >> 7, dir_t = (tid >> 6) & 1, pp = tid & 63, g_t = gp * 2 + gi_t;
  const float2 lb = ((const float2*)(p.ws + B_LAMB))[((l * 2 + dir_t) * 32 + g_t) * 64 + pp];
  const size_t hidx = ((size_t)(chunk * 32 + g_t) * 2 + dir_t) * 64 + pp;
  float hr = 0.f, hi = 0.f;
  if (mode) { float2 h0 = ((const float2*)(p.ws + B_HIN))[hidx]; hr = h0.x; hi = h0.y; }
  const int fr = lane & 15, fq = lane >> 4;
  bf16x8 cq[4];
  u16 uu[2][4];
  float dsk = 0.f;
  if (mode) {
    const u16* cmt = (const u16*)(p.ws + B_CMT) + (size_t)(l * 32 + g_w) * 16 * 128;
#pragma unroll
    for (int k4 = 0; k4 < 4; ++k4) cq[k4] = *(const bf16x8*)(cmt + fr * 128 + k4 * 32 + fq * 8);
#pragma unroll
    for (int mm = 0; mm < 2; ++mm)
#pragma unroll
      for (int r = 0; r < 4; ++r) uu[mm][r] = us5[((size_t)chunk * 64 + ((w & 1) * 2 + mm) * 16 + fq * 4 + r) * 512 + g_w * 16 + fr];
    dsk = p.in[25][l * 512 + g_w * 16 + fr];
  }
  __syncthreads();
  {
#pragma unroll
    for (int dir = 0; dir < 2; ++dir) {
#pragma unroll
      for (int nn = 0; nn < 2; ++nn) {
        const int nt = half * 2 + nn;
#pragma unroll
        for (int mi = 0; mi < 2; ++mi) {
          f32x16 acc;
#pragma unroll
          for (int r = 0; r < 16; ++r) acc[r] = 0.f;
          acc = MFMA32(af[mi], bq[dir][nn], acc);
          u16* d = sm + (size_t)((gi_w * 2 + dir) * 64 + mi * 32) * RS + nt * 32 + n;
#pragma unroll
          for (int r = 0; r < 16; ++r) d[crow(r, h2) * RS] = f2bf(acc[r]);
        }
      }
    }
  }
  __syncthreads();
  {
    u16* base = sm + (size_t)((gi_t * 2 + dir_t) * 64) * RS;
#pragma unroll 8
    for (int st = 0; st < 64; ++st) {
      const int tk = dir_t ? 63 - st : st;
      float br = bf2f(base[tk * RS + pp]), bi = bf2f(base[tk * RS + 64 + pp]);
      float nr = __builtin_fmaf(lb.x, hr, __builtin_fmaf(-lb.y, hi, br));
      float ni = __builtin_fmaf(lb.x, hi, __builtin_fmaf(lb.y, hr, bi));
      asm volatile("" : "+v"(nr));
      asm volatile("" : "+v"(ni));
      hr = nr; hi = ni;
      if (mode) { base[tk * RS + pp] = f2bf(hr); base[tk * RS + 64 + pp] = f2bf(hi); }
    }
    if (!mode) ((float2*)(p.ws + B_HEND))[hidx] = make_float2(hr, hi);
  }
  if (!mode) return;
  __syncthreads();
  {
    f32x4 acc[2];
    acc[0] = f32x4{0.f, 0.f, 0.f, 0.f}; acc[1] = acc[0];
#pragma unroll
    for (int ks = 0; ks < 8; ++ks) {
      const int dir = ks >> 2, kk = (ks & 3) * 32;
#pragma unroll
      for (int mm = 0; mm < 2; ++mm) {
        const int mi = (w & 1) * 2 + mm;
        bf16x8 a2 = *(const bf16x8*)(sm + (size_t)((gi_w * 2 + dir) * 64 + mi * 16 + fr) * RS + kk + fq * 8);
        acc[mm] = MFMA16(a2, cq[ks & 3], acc[mm]);
      }
    }
    u16* y5 = (u16*)(p.ws + B_Y5);
#pragma unroll
    for (int mm = 0; mm < 2; ++mm)
#pragma unroll
      for (int r = 0; r < 4; ++r) {
        const size_t t = (size_t)chunk * 64 + ((w & 1) * 2 + mm) * 16 + fq * 4 + r;
        float y = acc[mm][r] + dsk * bf2f(uu[mm][r]);
        y5[t * 512 + g_w * 16 + fr] = f2bf(gelu_tanh(y));
      }
  }
}
DI void s5_carry_tile(const Params& p, int l, int tile) {
  const int seq = tile >> 4, gp = tile & 15;
  const int tid = otid(), gi = tid >> 7, dir = (tid >> 6) & 1, pp = tid & 63, g = gp * 2 + gi;
  int c0, nc;
  if (seq < 32) { c0 = seq * 4; nc = 4; } else { c0 = 128 + (seq - 32) * 32; nc = 32; }
  const float2 l64 = ((const float2*)(p.ws + B_LAM64))[((l * 2 + dir) * 32 + g) * 64 + pp];
  float hr = 0.f, hi = 0.f;
  if (seq >= 32) {
    const size_t si = ((size_t)((seq - 32) * 4 + l) * 2 + dir) * 2048 + g * 64 + pp;
    hr = p.in[3][si]; hi = p.in[4][si];
  }
  const float2* hend = (const float2*)(p.ws + B_HEND);
  float2* hin = (float2*)(p.ws + B_HIN);
  for (int it = 0; it < nc; ++it) {
    const int ck = c0 + (dir ? nc - 1 - it : it);
    const size_t idx = ((size_t)(ck * 32 + g) * 2 + dir) * 64 + pp;
    hin[idx] = make_float2(hr, hi);
    float2 he = hend[idx];
    float nr = __builtin_fmaf(l64.x, hr, __builtin_fmaf(-l64.y, hi, he.x));
    float ni = __builtin_fmaf(l64.x, hi, __builtin_fmaf(l64.y, hr, he.y));
    asm volatile("" : "+v"(nr));
    asm volatile("" : "+v"(ni));
    hr = nr; hi = ni;
  }
  if (seq < 32) {
    const size_t so = ((size_t)(seq * 4 + l) * 2 + dir) * 2048 + g * 64 + pp;
    p.out[O_S5RE + so] = hr;
    p.out[O_S5IM + so] = hi;
  }
}

DI void delta_local_tile(const Params& p, int tile, float* smf) {
  const int chunk = tile >> 1, dir = tile & 1;
  const int tid = otid(), lane = tid & 63, h = tid >> 6;
  const int m = lane & 31, h2 = lane >> 5;
  const int tb = chunk * 64;
  const float* bg = (const float*)(p.ws + B_BG);
  const u16* kn = (const u16*)(p.ws + B_KN);
  const u16* qn = (const u16*)(p.ws + B_QN);
  float* Aw = smf + h * 4096;
  const size_t cidx = ((size_t)(chunk * 4 + h) * 2 + dir);
  const int tl = tb + (dir ? 63 - lane : lane);
  float gcs = bg[(size_t)tl * 16 + 8 + dir * 4 + h];
  const float beta = bg[(size_t)tl * 16 + dir * 4 + h];
#pragma unroll
  for (int o = 1; o < 64; o <<= 1) {
    float v = __shfl_up(gcs, o);
    if (lane >= o) gcs += v;
  }
  ((float*)(p.ws + B_GC))[cidx * 64 + lane] = gcs;
  ((float*)(p.ws + B_BC))[cidx * 64 + lane] = beta;
  __syncthreads();
  u16* qkm = (u16*)(p.ws + B_QKM) + cidx * 4096;
#pragma unroll 1
  for (int tt = 0; tt < 3; ++tt) {
    const int mi = tt == 0 ? 0 : 1, ni = tt == 2 ? 1 : 0;
    const int cm = 32 * mi + m, cn = 32 * ni + m;
    const u16* krm = kn + (size_t)(tb + (dir ? 63 - cm : cm)) * 512 + h * 128 + h2 * 8;
    const u16* qrm = qn + (size_t)(tb + (dir ? 63 - cm : cm)) * 512 + h * 128 + h2 * 8;
    const u16* krn = kn + (size_t)(tb + (dir ? 63 - cn : cn)) * 512 + h * 128 + h2 * 8;
    f32x16 ak, aq;
#pragma unroll
    for (int r = 0; r < 16; ++r) { ak[r] = 0.f; aq[r] = 0.f; }
#pragma unroll
    for (int ks = 0; ks < 8; ++ks) {
      const bf16x8 fkm = *(const bf16x8*)(krm + ks * 16), fqm = *(const bf16x8*)(qrm + ks * 16), fkn = *(const bf16x8*)(krn + ks * 16);
      ak = MFMA32(fkm, fkn, ak);
      aq = MFMA32(fqm, fkn, aq);
    }
    const int e = 32 * ni + m;
    const float gce = __shfl(gcs, e);
#pragma unroll
    for (int r = 0; r < 16; ++r) {
      const int c = 32 * mi + crow(r, h2);
      const float gcc = __shfl(gcs, c), bc = __shfl(beta, c);
      const float dec = (e <= c) ? __expf(gcc - gce) : 0.f;
      Aw[c * 64 + e] = (e < c) ? ak[r] * bc * dec : 0.f;
      qkm[c * 64 + e] = f2bf(aq[r] * dec);
    }
  }
  __syncthreads();
  u16* tm = (u16*)(p.ws + B_TM) + cidx * 4096;
  float x[64];
#pragma unroll
  for (int i = 0; i < 64; ++i) {
    float a = (i == lane) ? 1.f : 0.f;
#pragma unroll
    for (int j = 0; j < i; ++j) a -= Aw[i * 64 + j] * x[j];
    x[i] = a;
    tm[i * 64 + lane] = f2bf(a);
  }
}

template <int dir>
DI void delta_scan_body(const Params& p, int l, int seq, int h, u16* sm);
DI void delta_scan_tile(const Params& p, int l, int idx, u16* sm) {
  int seq, h, dir;
  if (idx < 64) { seq = 32 + (idx >> 3); h = (idx >> 1) & 3; dir = idx & 1; }
  else { const int i2 = idx - 64; seq = i2 >> 3; h = (i2 >> 1) & 3; dir = i2 & 1; }
  __builtin_amdgcn_s_setprio(3);
  if (dir) delta_scan_body<1>(p, l, seq, h, sm); else delta_scan_body<0>(p, l, seq, h, sm);
  __builtin_amdgcn_s_setprio(0);
}
template <int dir>
DI void delta_scan_body(const Params& p, int l, int seq, int h, u16* sm) {
  int chunk0, nch;
  if (seq < 32) { chunk0 = seq * 4; nch = 4; } else { chunk0 = 128 + (seq - 32) * 32; nch = 32; }
  const int lane = otid() & 63, w = otid() >> 6;
  const int n = lane & 31, h2 = lane >> 5;
  const int dvc = w * 32 + n;
  const u16* kn = (const u16*)(p.ws + B_KN);
  const u16* qn = (const u16*)(p.ws + B_QN);
  const u16* vv = (const u16*)(p.ws + B_VV);
  u16* od = (u16*)(p.ws + (dir ? B_OB : B_OF));
  f32x16 S[4];
  if (seq >= 32) {
    const float* s0 = p.in[2] + ((size_t)(((seq - 32) * 4 + l) * 2 + dir) * 4 + h) * 16384;
#pragma unroll
    for (int t = 0; t < 4; ++t)
#pragma unroll
      for (int r = 0; r < 16; ++r) S[t][r] = s0[(size_t)(32 * t + crow(r, h2)) * 128 + dvc];
  } else {
#pragma unroll
    for (int t = 0; t < 4; ++t)
#pragma unroll
      for (int r = 0; r < 16; ++r) S[t][r] = 0.f;
  }
  for (int it = 0; it < nch; ++it) {
    const int chunk = chunk0 + (dir ? nch - 1 - it : it);
    const int tb = chunk * 64;
    const size_t cidx = ((size_t)(chunk * 4 + h) * 2 + dir);
    const float* gcp = (const float*)(p.ws + B_GC) + cidx * 64;
    const float* bcp = (const float*)(p.ws + B_BC) + cidx * 64;
    const u16* tm = (const u16*)(p.ws + B_TM) + cidx * 4096;
    const u16* qkm = (const u16*)(p.ws + B_QKM) + cidx * 4096;
    const u16* ktp = (const u16*)(p.ws + B_KT) + (size_t)(chunk * 4 + h) * 8192;
    const float glast = gcp[63];
    size_t trow[2];
#pragma unroll
    for (int mi = 0; mi < 2; ++mi) { const int c = 32 * mi + n; trow[mi] = (size_t)(tb + (dir ? 63 - c : c)); }
#define SCHED_FENCE() asm volatile("" ::: "memory")
    u16* Ks = sm; u16* Qs = sm + 8704; u16* Vs = sm + 17408; u16* KTs = sm + 26112;
    float* GCs = (float*)(sm + 35328);
    const float* gcl = GCs; const float* bcl = GCs + 64;
    uint4 xm0, xm1, xq0, xq1;
    u16* vls = Vs + w * 32;
    __syncthreads();
    {
      const int tid_ = otid();
      const int r0 = tid_ >> 4, ck = tid_ & 15;
      uint4 tk[4], tq[4], tv[4], tt[4];
      xm0 = *(const uint4*)(tm + tid_ * 8); xm1 = *(const uint4*)(tm + 2048 + tid_ * 8);
      xq0 = *(const uint4*)(qkm + tid_ * 8); xq1 = *(const uint4*)(qkm + 2048 + tid_ * 8);
      float4 gcv = make_float4(0.f, 0.f, 0.f, 0.f);
      if (tid_ < 16) gcv = *(const float4*)(gcp + tid_ * 4); else if (tid_ < 32) gcv = *(const float4*)(bcp + (tid_ - 16) * 4);
#pragma unroll
      for (int j = 0; j < 4; ++j) {
        const size_t go = (size_t)(tb + r0 + 16 * j) * 512 + h * 128 + ck * 8;
        tk[j] = *(const uint4*)(kn + go); tq[j] = *(const uint4*)(qn + go); tv[j] = *(const uint4*)(vv + go);
        tt[j] = *(const uint4*)(ktp + ((tid_ >> 3) + 32 * j) * 64 + (tid_ & 7) * 8);
      }
#pragma unroll
      for (int j = 0; j < 4; ++j) {
        const int tau = r0 + 16 * j, c = dir ? 63 - tau : tau;
        *(uint4*)(Ks + c * 136 + ck * 8) = tk[j]; *(uint4*)(Qs + c * 136 + ck * 8) = tq[j]; *(uint4*)(Vs + c * 136 + ck * 8) = tv[j];
        *(uint4*)(KTs + ((tid_ >> 3) + 32 * j) * 72 + (tid_ & 7) * 8) = tt[j];
      }
      if (tid_ < 32) *(float4*)(GCs + tid_ * 4) = gcv;
    }
    __syncthreads();
    f32x16 X[2], QS[2];
    {
      bf16x8 Sb[4][2];
#pragma unroll
      for (int t = 0; t < 4; ++t)
#pragma unroll
        for (int s = 0; s < 2; ++s) Sb[t][s] = pack_acc(S[t], s);
#pragma unroll
      for (int mi = 0; mi < 2; ++mi)
#pragma unroll
        for (int r = 0; r < 16; ++r) { X[mi][r] = 0.f; QS[mi][r] = 0.f; }
#pragma unroll
      for (int t = 0; t < 4; ++t) {
#pragma unroll
        for (int mi = 0; mi < 2; ++mi) {
          const u16* krow_ = Ks + (32 * mi + n) * 136;
          const u16* qrow_ = Qs + (32 * mi + n) * 136;
#pragma unroll
          for (int s = 0; s < 2; ++s) {
            X[mi] = MFMA32(load_perm(krow_ + 32 * t, s, h2), Sb[t][s], X[mi]);
            QS[mi] = MFMA32(load_perm(qrow_ + 32 * t, s, h2), Sb[t][s], QS[mi]);
          }
        }
        SCHED_FENCE();
      }
    }
    __syncthreads();
    {
      const int tid_ = otid();
      const int r_ = tid_ >> 3, c_ = (tid_ & 7) * 8;
      *(uint4*)(Ks + r_ * 72 + c_) = xm0; *(uint4*)(Ks + (r_ + 32) * 72 + c_) = xm1;
      *(uint4*)(Qs + r_ * 72 + c_) = xq0; *(uint4*)(Qs + (r_ + 32) * 72 + c_) = xq1;
    }
    __syncthreads();
    bf16x8 Rb[2][2];
#pragma unroll
    for (int mi = 0; mi < 2; ++mi) {
#pragma unroll
      for (int a = 0; a < 4; ++a) {
        const int c4 = 32 * mi + 8 * a + 4 * h2;
        const float4 g4 = *(const float4*)(gcl + c4);
        const float4 b4 = *(const float4*)(bcl + c4);
        const float gg[4] = {g4.x, g4.y, g4.z, g4.w};
        const float bb[4] = {b4.x, b4.y, b4.z, b4.w};
#pragma unroll
        for (int q = 0; q < 4; ++q) {
          const int c = c4 + q;
          const float v = bf2f(vls[c * 136 + n]);
          const float eg = __expf(gg[q]);
          X[mi][4 * a + q] = bb[q] * (v - eg * X[mi][4 * a + q]);
          QS[mi][4 * a + q] *= eg;
        }
      }
      Rb[mi][0] = pack_acc(X[mi], 0);
      Rb[mi][1] = pack_acc(X[mi], 1);
    }
    SCHED_FENCE();
    f32x16 Vn[2];
#pragma unroll
    for (int mo = 0; mo < 2; ++mo) {
#pragma unroll
      for (int r = 0; r < 16; ++r) Vn[mo][r] = 0.f;
#pragma unroll
      for (int mi = 0; mi <= mo; ++mi)
#pragma unroll
        for (int s = 0; s < 2; ++s) Vn[mo] = MFMA32(load_perm(Ks + (32 * mo + n) * 72 + 32 * mi, s, h2), Rb[mi][s], Vn[mo]);
    }
    SCHED_FENCE();
    {
      bf16x8 Vb[2][2];
#pragma unroll
      for (int mi = 0; mi < 2; ++mi) { Vb[mi][0] = pack_acc(Vn[mi], 0); Vb[mi][1] = pack_acc(Vn[mi], 1); }
#pragma unroll
      for (int mo = 0; mo < 2; ++mo) {
#pragma unroll
        for (int mi = 0; mi <= mo; ++mi)
#pragma unroll
          for (int s = 0; s < 2; ++s) QS[mo] = MFMA32(load_perm(Qs + (32 * mo + n) * 72 + 32 * mi, s, h2), Vb[mi][s], QS[mo]);
      }
      __syncthreads();
#pragma unroll
      for (int mo = 0; mo < 2; ++mo)
#pragma unroll
        for (int r = 0; r < 16; ++r) vls[(32 * mo + crow(r, h2)) * 136 + n] = f2bf(QS[mo][r]);
      __syncthreads();
#pragma unroll
      for (int jv = 0; jv < 4; ++jv) {
        const int tau = (lane >> 2) + 16 * jv, cq = lane & 3;
        const uint4 oq = *(const uint4*)(vls + (dir ? 63 - tau : tau) * 136 + cq * 8);
        *(uint4*)(od + (size_t)(tb + tau) * 512 + h * 128 + w * 32 + cq * 8) = oq;
      }
    }
    SCHED_FENCE();
    bf16x8 Vsb[2][2];
#pragma unroll
    for (int mi = 0; mi < 2; ++mi) {
#pragma unroll
      for (int a = 0; a < 4; ++a) {
        const float4 g4 = *(const float4*)(gcl + 32 * mi + 8 * a + 4 * h2);
        Vn[mi][4 * a + 0] *= __expf(glast - g4.x); Vn[mi][4 * a + 1] *= __expf(glast - g4.y);
        Vn[mi][4 * a + 2] *= __expf(glast - g4.z); Vn[mi][4 * a + 3] *= __expf(glast - g4.w);
      }
      Vsb[mi][0] = pack_acc(Vn[mi], 0); Vsb[mi][1] = pack_acc(Vn[mi], 1);
    }
    const float eg = __expf(glast);
#pragma unroll
    for (int t = 0; t < 4; ++t) {
#pragma unroll
      for (int r = 0; r < 16; ++r) S[t][r] *= eg;
      const u16* ktrow = KTs + (32 * t + n) * 72;
#pragma unroll
      for (int mi = 0; mi < 2; ++mi)
#pragma unroll
        for (int s = 0; s < 2; ++s) {
          bf16x8 a = dir ? load_perm_rev(ktrow, 32 * mi, s, h2) : load_perm(ktrow + 32 * mi, s, h2);
          S[t] = MFMA32(a, Vsb[mi][s], S[t]);
        }
      SCHED_FENCE();
    }
  }
  if (seq < 32) {
    float* so = p.out + O_SD + ((size_t)((seq * 4 + l) * 2 + dir) * 4 + h) * 16384;
#pragma unroll
    for (int t = 0; t < 4; ++t)
#pragma unroll
      for (int r = 0; r < 16; ++r) so[(size_t)(32 * t + crow(r, h2)) * 128 + dvc] = S[t][r];
  }
}

DI void attn_tile(const Params& p, int seq, int head, int qb, u16* sm) {
  const int lane = otid() & 63, w = otid() >> 6;
  const int n = lane & 31, h2 = lane >> 5;
  int tq0, nkeys; size_t kbo, vto;
  if (seq < 32) { tq0 = seq * 256 + qb * 128 + w * 32; nkeys = 256; kbo = (size_t)(seq * 8 + head) * 256 * 96; vto = (size_t)(seq * 8 + head) * 64 * 256; }
  else { const int s = seq - 32; tq0 = TP_ + s * 2048 + qb * 128 + w * 32; nkeys = 2304; kbo = KB_P + (size_t)(s * 8 + head) * 2304 * 96; vto = VT_P + (size_t)(s * 8 + head) * 64 * 2304; }
  const u16* kb = (const u16*)(p.ws + B_KB) + kbo;
  const u16* vt = (const u16*)(p.ws + B_VT) + vto;
  const u16* qm = (const u16*)(p.ws + B_QM) + (size_t)(tq0 + n) * 768 + head * 96;
  bf16x8 qf[6];
#pragma unroll
  for (int ks = 0; ks < 6; ++ks) qf[ks] = *(const bf16x8*)(qm + ks * 16 + h2 * 8);
  f32x16 O[2];
#pragma unroll
  for (int r = 0; r < 16; ++r) { O[0][r] = 0.f; O[1][r] = 0.f; }
  float mrun = -1e30f, lsum = 0.f;
  const int nkt = nkeys >> 6;
  constexpr int KST = 104, VST = 72, STG = 64 * KST + 64 * VST;
  const int tid_ = otid();
  uint4 rk0, rk1, rk2, rv0, rv1;
  const int kc0 = tid_, kc1 = tid_ + 256, kc2 = tid_ + 512;
  const u16* kg0 = kb + (size_t)(kc0 / 12) * 96 + (kc0 % 12) * 8;
  const u16* kg1 = kb + (size_t)(kc1 / 12) * 96 + (kc1 % 12) * 8;
  const u16* kg2 = kb + (size_t)(kc2 / 12) * 96 + (kc2 % 12) * 8;
  const u16* vg0 = vt + (size_t)(tid_ >> 3) * nkeys + (tid_ & 7) * 8;
  const u16* vg1 = vt + (size_t)((tid_ + 256) >> 3) * nkeys + (tid_ & 7) * 8;
  const int kl0 = (kc0 / 12) * KST + (kc0 % 12) * 8, kl1 = (kc1 / 12) * KST + (kc1 % 12) * 8, kl2 = (kc2 / 12) * KST + (kc2 % 12) * 8;
  const int vl0 = (tid_ >> 3) * VST + (tid_ & 7) * 8, vl1 = ((tid_ + 256) >> 3) * VST + (tid_ & 7) * 8;
#define AT_GLOAD(kt_) do { rk0 = *(const uint4*)(kg0 + (size_t)(kt_) * 6144); rk1 = *(const uint4*)(kg1 + (size_t)(kt_) * 6144); \
    rk2 = *(const uint4*)(kg2 + (size_t)(kt_) * 6144); rv0 = *(const uint4*)(vg0 + (kt_) * 64); rv1 = *(const uint4*)(vg1 + (kt_) * 64); } while (0)
#define AT_SSTORE(st_) do { u16* ks2_ = sm + (st_) * STG; u16* vs2_ = ks2_ + 64 * KST; \
    *(uint4*)(ks2_ + kl0) = rk0; *(uint4*)(ks2_ + kl1) = rk1; *(uint4*)(ks2_ + kl2) = rk2; *(uint4*)(vs2_ + vl0) = rv0; *(uint4*)(vs2_ + vl1) = rv1; } while (0)
  __syncthreads();
  AT_GLOAD(0); AT_SSTORE(0);
  __syncthreads();
  for (int kt = 0; kt < nkt; ++kt) {
    const bool more = kt + 1 < nkt;
    if (more) AT_GLOAD(kt + 1);
    const u16* ks_ = sm + (kt & 1) * STG;
    const u16* vs_ = ks_ + 64 * KST;
    f32x16 St[2];
#pragma unroll
    for (int sub = 0; sub < 2; ++sub) {
#pragma unroll
      for (int r = 0; r < 16; ++r) St[sub][r] = 0.f;
      const u16* kr = ks_ + (sub * 32 + n) * KST + h2 * 8;
#pragma unroll
      for (int ks = 0; ks < 6; ++ks) St[sub] = MFMA32(*(const bf16x8*)(kr + ks * 16), qf[ks], St[sub]);
    }
    float mx = St[0][0];
#pragma unroll
    for (int r = 0; r < 16; ++r) { mx = fmaxf(mx, St[0][r]); mx = fmaxf(mx, St[1][r]); }
    mx = fmaxf(mx, __shfl_xor(mx, 32));
    const float mnew = fmaxf(mrun, mx);
    const float alpha = exp2f(mrun - mnew);
    mrun = mnew;
    float ps = 0.f;
#pragma unroll
    for (int sub = 0; sub < 2; ++sub)
#pragma unroll
      for (int r = 0; r < 16; ++r) { float e = exp2f(St[sub][r] - mnew); St[sub][r] = e; ps += e; }
    lsum = lsum * alpha + ps;
#pragma unroll
    for (int r = 0; r < 16; ++r) { O[0][r] *= alpha; O[1][r] *= alpha; }
#pragma unroll
    for (int sub = 0; sub < 2; ++sub)
#pragma unroll
      for (int s = 0; s < 2; ++s) {
        const bf16x8 pb = pack_acc(St[sub], s);
#pragma unroll
        for (int dt = 0; dt < 2; ++dt)
          O[dt] = MFMA32(load_perm(vs_ + (dt * 32 + n) * VST + sub * 32, s, h2), pb, O[dt]);
      }
    if (more) AT_SSTORE((kt + 1) & 1);
    __syncthreads();
  }
  lsum += __shfl_xor(lsum, 32);
  const float inv = 1.f / lsum;
  u16* oc = (u16*)(p.ws + B_OC) + (size_t)(tq0 + n) * 512 + head * 64;
#pragma unroll
  for (int dt = 0; dt < 2; ++dt)
#pragma unroll
    for (int a = 0; a < 4; ++a) {
      const int dv = dt * 32 + 8 * a + 4 * h2;
      *(uint2*)(oc + dv) = make_uint2(pack2(O[dt][4 * a] * inv, O[dt][4 * a + 1] * inv), pack2(O[dt][4 * a + 2] * inv, O[dt][4 * a + 3] * inv));
    }
}

DI void delta_out_tile(const Params& p, int l, int tile) {
  const int lane = otid() & 63, w = otid() >> 6;
  const u16* of = (const u16*)(p.ws + B_OF);
  const u16* ob = (const u16*)(p.ws + B_OB);
  const u16* z = (const u16*)(p.ws + B_Z);
  u16* oa = (u16*)(p.ws + B_OA);
  const float g0 = p.in[17][l * 128 + 2 * lane], g1 = p.in[17][l * 128 + 2 * lane + 1];
#pragma unroll 1
  for (int q = 0; q < 16; ++q) {
    const size_t t = (size_t)tile * 16 + w * 4 + (q >> 2);
    const int hh = q & 3;
    const size_t off = t * 512 + hh * 128 + 2 * lane;
    unsigned a = *(const unsigned*)(of + off), b = *(const unsigned*)(ob + off), zz = *(const unsigned*)(z + off);
    float o0 = blo(a) + blo(b), o1 = bhi(a) + bhi(b);
    float ss = wave_sum(o0 * o0 + o1 * o1);
    float rstd = rsqrtf(ss * (1.f / 128.f) + 1e-6f);
    float y0 = o0 * rstd * g0 * siluf_(blo(zz)), y1 = o1 * rstd * g1 * siluf_(bhi(zz));
    *(unsigned*)(oa + off) = pack2(y0, y1);
  }
}

DI void grid_barrier(unsigned* bar, unsigned target) {
  asm volatile("s_waitcnt vmcnt(0) lgkmcnt(0)" ::: "memory");
  __syncthreads();
  if (otid() == 0) {
    __builtin_amdgcn_fence(__ATOMIC_RELEASE, "agent");
    asm volatile("s_waitcnt vmcnt(0)" ::: "memory");
    __hip_atomic_fetch_add(bar, 1u, __ATOMIC_RELAXED, __HIP_MEMORY_SCOPE_AGENT);
    while (__hip_atomic_load(bar, __ATOMIC_RELAXED, __HIP_MEMORY_SCOPE_AGENT) < target) __builtin_amdgcn_s_sleep(5);
    __builtin_amdgcn_fence(__ATOMIC_ACQUIRE, "agent");
    asm volatile("s_waitcnt vmcnt(0)" ::: "memory");
  }
  __syncthreads();
}
#define GSYNC() do { bar_target += gridDim.x; grid_barrier(p.bar, bar_target); } while (0)
#ifndef ONLY
#define PH(n) 1
#else
#define PH(n) ((n) == ONLY || (n) / 100 == ONLY || (n) == ONLY / 100)
#endif
__global__ void __launch_bounds__(256, 2) mega(Params p) {
  cg::grid_group grid = cg::this_grid();
  __shared__ __attribute__((aligned(16))) char smem_raw[73728];
  u16* sm = (u16*)smem_raw;
  float* smf = (float*)smem_raw;
  const int nb = gridDim.x, bid = blockIdx.x;
  unsigned bar_target = 0;
  grid.sync();

  if (PH(0)) {
    const int tid = otid();
    for (int j = bid; j < 4 * CJ8; j += nb) conv_job(p, j / CJ8, j % CJ8, smf);
    for (int j = bid; j < 4 * 96; j += nb) mods_tile(p, j / 96, j % 96, smf);
    for (int j = bid; j < 64; j += nb) s5pre_tile(p, j);
    {
      const float4* xp = (const float4*)p.in[0];
      const float4* xs = (const float4*)p.in[1];
      float4* o = (float4*)p.out;
      const size_t nP = (size_t)TP_ * 256, nT = (size_t)T_ * 256;
      for (size_t i = (size_t)bid * 256 + tid; i < nT; i += (size_t)nb * 256) o[i] = i < nP ? xp[i] : xs[i - nP];
    }
    {
      float* rope = (float*)(p.ws + B_ROPE);
      for (int i = bid * 256 + tid; i < 2048 * 16; i += nb * 256) {
        const int pos = i >> 4, f = i & 15;
        const float invf = 1.f / powf(10000.f, (float)(f & 7) * 0.125f);
        const float ang = (f < 8 ? (float)(pos >> 6) : (float)(pos & 63)) * invf;
        float sn, cs;
        sincosf(ang, &sn, &cs);
        rope[i * 2] = cs; rope[i * 2 + 1] = sn;
      }
    }
    {
      u16* cc = (u16*)(p.ws + B_CKVC);
      for (int i = bid * 256 + tid; i < 8 * 4 * 256 * 256 / 2; i += nb * 256) {
        const int e = i * 2;
        const int c = e & 255, pos = (e >> 8) & 255, l = (e >> 16) & 3, b = e >> 18;
        float2 v = *(const float2*)(p.in[5] + e);
        *(unsigned*)(cc + ((size_t)(l * 2048 + b * 256 + pos)) * 256 + c) = pack2(v.x, v.y);
      }
    }
  }
  GSYNC();

  for (int l = 0; l < 4; ++l) {
    const u16* WL = (const u16*)(p.ws + B_W) + (size_t)l * W_LAYER;
    const float* mods = (const float*)(p.ws + B_MODS);
    if (PH(1)) norm_phase(p, l, 0, 1, p.in[11] + l * 1024);
    GSYNC();
    if (PH(2)) gemm_in_phase(p, l, sm);
    GSYNC();
    if (PH(3)) {
      for (int j = bid; j < NCH; j += nb) delta_prep_tile(p, l, j, sm);
      for (int j = bid; j < T_ / 4; j += nb) mla_prep_tile(p, l, j);
      for (int j = bid; j < 256; j += nb) cache_rope_tile(p, l, j);
      for (int j = bid; j < NCH * 16; j += nb) s5_chunk_tile(p, l, j >> 4, j & 15, 0, sm);
    }
    GSYNC();
    if (PH(4)) {
      const int tid = otid();
      if (PH(400)) for (int j = bid; j < NCH * 2; j += nb) delta_local_tile(p, j, smf);
      if (PH(410)) for (int j = bid; j < 192 * 6; j += nb) {
          const int q = j, mt = q / 6, nt = q % 6;
          f32x4 acc[4][4];
          zero_acc<4>(acc);
          gemm_core<4>(acc, (const u16*)(p.ws + B_QA) + (size_t)mt * 128 * 384, 384, WL + W_QB + (size_t)nt * 128 * 384, 384, 384, sm);
          u16* qm = (u16*)(p.ws + B_QM);
          const float qs = 0.10206207261596575f * 1.4426950408889634f;
          const float* rope = (const float*)(p.ws + B_ROPE);
          const int e_lane = tid & 63, e_w = tid >> 6, e_wr = e_w >> 1, e_wc = e_w & 1, e_fr = e_lane & 15, e_fq = e_lane >> 4;
          const bool is_s = (mt * 128 >= TP_);
#pragma unroll
          for (int i = 0; i < 4; ++i) {
            const int row = mt * 128 + e_wr * 64 + i * 16 + e_fr;
            f32x4 vals[4];
#pragma unroll
            for (int jj = 0; jj < 4; ++jj) vals[jj] = acc[i][jj];
            if (is_s) {
              const int pos = (row - TP_) & 2047;
              const float4 cs0 = *(const float4*)(rope + (size_t)(pos * 16 + e_fq * 4) * 2);
              const float4 cs1 = *(const float4*)(rope + (size_t)(pos * 16 + e_fq * 4) * 2 + 4);
              const float cs[4] = {cs0.x, cs0.z, cs1.x, cs1.z}, sn[4] = {cs0.y, cs0.w, cs1.y, cs1.w};
#pragma unroll
              for (int jj = 0; jj < 4; jj += 2) {
                const int gt = (nt * 128 + e_wc * 64) / 16 + jj;
                if (gt % 6 == 4) {
#pragma unroll
                  for (int r = 0; r < 4; ++r) {
                    const float x1 = vals[jj][r], x2 = vals[jj + 1][r];
                    vals[jj][r] = x1 * cs[r] - x2 * sn[r];
                    vals[jj + 1][r] = x2 * cs[r] + x1 * sn[r];
                  }
                }
              }
            }
#pragma unroll
            for (int jj = 0; jj < 4; ++jj) {
              f32x4 o; o[0] = vals[jj][0] * qs; o[1] = vals[jj][1] * qs; o[2] = vals[jj][2] * qs; o[3] = vals[jj][3] * qs;
              *(uint2*)(qm + (size_t)row * 768 + nt * 128 + e_wc * 64 + jj * 16 + e_fq * 4) = pack4(o);
            }
          }
      }
      if (PH(420)) for (int j = bid; j < 208 * 8; j += nb) {
          const int q = j, mt = q >> 3, head = q & 7;
          f32x4 acc[4][4];
          zero_acc<4>(acc);
          const u16* A = mt < 192 ? (const u16*)(p.ws + B_KVA) + (size_t)mt * 128 * 256
                                  : (const u16*)(p.ws + B_CKVC) + ((size_t)l * 2048 + (size_t)(mt - 192) * 128) * 256;
          gemm_core<4, false>(acc, A, 256, WL + W_KVB + (size_t)head * 128 * 256, 256, 256, sm);
          int key0, nkeys; size_t kbo, vto;
          if (mt < 64) { const int seq = mt >> 1; key0 = (mt & 1) * 128; nkeys = 256; kbo = (size_t)(seq * 8 + head) * 256 * 96; vto = (size_t)(seq * 8 + head) * 64 * 256; }
          else if (mt < 192) { const int s = (mt - 64) >> 4; key0 = 256 + ((mt - 64) & 15) * 128; nkeys = 2304; kbo = KB_P + (size_t)(s * 8 + head) * 2304 * 96; vto = VT_P + (size_t)(s * 8 + head) * 64 * 2304; }
          else { const int s = (mt - 192) >> 1; key0 = ((mt - 192) & 1) * 128; nkeys = 2304; kbo = KB_P + (size_t)(s * 8 + head) * 2304 * 96; vto = VT_P + (size_t)(s * 8 + head) * 64 * 2304; }
          u16* kb = (u16*)(p.ws + B_KB) + kbo;
          u16* vt = (u16*)(p.ws + B_VT) + vto;
          const int e_lane = tid & 63, e_w = tid >> 6, e_wr = e_w >> 1, e_wc = e_w & 1, e_fr = e_lane & 15, e_fq = e_lane >> 4;
#pragma unroll
          for (int i = 0; i < 4; ++i)
#pragma unroll
            for (int jj = 0; jj < 4; ++jj) {
              const int key = key0 + e_wr * 64 + i * 16 + e_fq * 4;
              const int c = jj * 16 + e_fr;
              if (e_wc == 0) {
#pragma unroll
                for (int r = 0; r < 4; ++r) kb[(size_t)(key + r) * 96 + c] = f2bf(acc[i][jj][r]);
              } else {
                *(uint2*)(vt + (size_t)c * nkeys + key) = make_uint2(pack2(acc[i][jj][0], acc[i][jj][1]), pack2(acc[i][jj][2], acc[i][jj][3]));
              }
            }
      }
      if (PH(430)) for (int j = bid; j < 640; j += nb) s5_carry_tile(p, l, j);
    }
    GSYNC();
    if (PH(5)) {
      if (PH(500)) for (int j = bid; j < 320; j += nb) delta_scan_tile(p, l, j, sm);
      if (PH(510)) for (int j = bid; j < 1536; j += nb) {
        if (j < 1024) attn_tile(p, 32 + (j >> 7), (j >> 4) & 7, j & 15, sm);
        else { const int q = j - 1024; attn_tile(p, q >> 4, (q >> 1) & 7, q & 1, sm); }
      }
      if (PH(530)) for (int j = bid; j < NCH * 8; j += nb) {
        s5_chunk_tile(p, l, j >> 3, (j & 7) * 2, 1, sm);
        s5_chunk_tile(p, l, j >> 3, (j & 7) * 2 + 1, 1, sm);
      }
    }
    GSYNC();
    if (PH(6)) {
      for (int j = bid; j < T_ / 16; j += nb) delta_out_tile(p, l, j);
      for (int j = bid; j < 192 * 4; j += nb) {
        {
          const int q = j, mt = q >> 2, nt = q & 3;
          f32x4 acc[4][4];
          zero_acc<4>(acc);
          const u16* y5 = (const u16*)(p.ws + B_Y5);
          gemm_core<4>(acc, y5 + (size_t)mt * 128 * 512, 512, WL + W_GLU + (size_t)nt * 128 * 512, 512, 512, sm);
          u16* ob5 = (u16*)(p.ws + B_OB5);
          const float* bgl = p.in[27] + l * 512;
          EPI_LOOP(4) {
            const size_t row = mt * 128 + EROW; const int col = nt * 128 + ECOL4(4);
            const uint2 yy = *(const uint2*)(y5 + row * 512 + col);
            const float4 bb = *(const float4*)(bgl + col);
            f32x4 o;
            o[0] = blo(yy.x) * sigmoidf_(acc[i][j][0] + bb.x); o[1] = bhi(yy.x) * sigmoidf_(acc[i][j][1] + bb.y);
            o[2] = blo(yy.y) * sigmoidf_(acc[i][j][2] + bb.z); o[3] = bhi(yy.y) * sigmoidf_(acc[i][j][3] + bb.w);
            *(uint2*)(ob5 + row * 512 + col) = pack4(o);
          }
        }
      }
    }
    GSYNC();
    if (PH(7)) {
      const u16* H = (const u16*)(p.ws + B_H);
      u16* mg = (u16*)(p.ws + B_MG);
      for (int j = bid; j < 192 * 16; j += nb) {
        const int mt = j >> 4, nt = j & 15;
        f32x4 mer[4][2];
        zero_acc<2>(mer);
#pragma unroll 1
        for (int n = 0; n < 3; ++n) {
          f32x4 ag[4][2], ab[4][2];
          zero_acc<2>(ag);
          gemm_core<2>(ag, H + (size_t)mt * 128 * 1024, 1024, WL + W_G + (size_t)(n * 1024 + nt * 64) * 1024, 1024, 1024, sm);
          zero_acc<2>(ab);
          const u16* on = (const u16*)(p.ws + (n == 0 ? B_OA : (n == 1 ? B_OB5 : B_OC)));
          gemm_core<2>(ab, on + (size_t)mt * 128 * 512, 512, WL + W_BR + (size_t)(nt * 64) * 1536 + n * 512, 1536, 512, sm);
#pragma unroll
          for (int i = 0; i < 4; ++i)
#pragma unroll
            for (int jj = 0; jj < 2; ++jj)
#pragma unroll
              for (int r = 0; r < 4; ++r) mer[i][jj][r] += sigmoidf_(ag[i][jj][r]) * ab[i][jj][r];
        }
        EPI_LOOP(2) { *(uint2*)(mg + (size_t)(mt * 128 + EROW) * 1024 + nt * 64 + ECOL4(2)) = pack4(mer[i][j]); }
      }
    }
    GSYNC();
    if (PH(8)) {
      const u16* mg = (const u16*)(p.ws + B_MG);
      for (int j = bid; j < 192 * 8; j += nb) {
        const int mt = j >> 3, nt = j & 7;
        f32x4 acc[4][4];
        zero_acc<4>(acc);
        gemm_core<4>(acc, mg + (size_t)mt * 128 * 1024, 1024, WL + W_OUT + (size_t)nt * 128 * 1024, 1024, 1024, sm);
        const float* gm = mods + (size_t)(l * 9 + tok_v(mt * 128)) * 6144 + 2 * 1024;
        EPI_LOOP(4) {
          const size_t row = mt * 128 + EROW; const int col = nt * 128 + ECOL4(4);
          float4* xp_ = (float4*)(p.out + row * 1024 + col);
          float4 xv = *xp_; const float4 gg = *(const float4*)(gm + col);
          xv.x += gg.x * acc[i][j][0]; xv.y += gg.y * acc[i][j][1]; xv.z += gg.z * acc[i][j][2]; xv.w += gg.w * acc[i][j][3];
          *xp_ = xv;
        }
      }
    }
    GSYNC();
    if (PH(9)) norm_phase(p, l, 3, 4, p.in[12] + l * 1024);
    GSYNC();
    if (PH(10)) {
      const u16* H = (const u16*)(p.ws + B_H);
      u16* up = (u16*)(p.ws + B_UP);
      for (int j = bid; j < 192 * 44; j += nb) {
        const int mt = j / 44, nt = j % 44;
        f32x4 acc[4][4];
        zero_acc<4>(acc);
        gemm_core<4>(acc, H + (size_t)mt * 128 * 1024, 1024, WL + W_UP + (size_t)nt * 128 * 1024, 1024, 1024, sm);
        EPI_LOOP(4) { *(uint2*)(up + (size_t)(mt * 128 + EROW) * 5632 + nt * 128 + ECOL4(4)) = pack4(acc[i][j]); }
      }
    }
    GSYNC();
    if (PH(11)) {
      const int tid = otid();
      const u16* up = (const u16*)(p.ws + B_UP);
      u16* act = (u16*)(p.ws + B_ACT);
      const float* cw = p.in[35] + (size_t)l * 3 * 5632;
      const float* cb = p.in[36] + (size_t)l * 5632;
      constexpr int TG = 16;
      for (int it = bid * 256 + tid; it < (T_ / TG) * 352; it += nb * 256) {
        const int t0 = (it / 352) * TG, c8 = (it % 352) * 8;
        int pos0, L;
        if (t0 < TP_) { pos0 = t0 & 255; L = 256; } else { pos0 = (t0 - TP_) & 2047; L = 2048; }
        float wg[3][8], wv[3][8], bgv[8], bvv[8];
#pragma unroll
        for (int d = 0; d < 3; ++d) {
          const float4 g0 = *(const float4*)(cw + d * 5632 + c8), g1 = *(const float4*)(cw + d * 5632 + c8 + 4);
          const float4 v0 = *(const float4*)(cw + d * 5632 + 2816 + c8), v1 = *(const float4*)(cw + d * 5632 + 2816 + c8 + 4);
          wg[d][0] = g0.x; wg[d][1] = g0.y; wg[d][2] = g0.z; wg[d][3] = g0.w; wg[d][4] = g1.x; wg[d][5] = g1.y; wg[d][6] = g1.z; wg[d][7] = g1.w;
          wv[d][0] = v0.x; wv[d][1] = v0.y; wv[d][2] = v0.z; wv[d][3] = v0.w; wv[d][4] = v1.x; wv[d][5] = v1.y; wv[d][6] = v1.z; wv[d][7] = v1.w;
        }
        {
          const float4 g0 = *(const float4*)(cb + c8), g1 = *(const float4*)(cb + c8 + 4);
          const float4 v0 = *(const float4*)(cb + 2816 + c8), v1 = *(const float4*)(cb + 2816 + c8 + 4);
          bgv[0] = g0.x; bgv[1] = g0.y; bgv[2] = g0.z; bgv[3] = g0.w; bgv[4] = g1.x; bgv[5] = g1.y; bgv[6] = g1.z; bgv[7] = g1.w;
          bvv[0] = v0.x; bvv[1] = v0.y; bvv[2] = v0.z; bvv[3] = v0.w; bvv[4] = v1.x; bvv[5] = v1.y; bvv[6] = v1.z; bvv[7] = v1.w;
        }
        uint4 g0r = make_uint4(0, 0, 0, 0), v0r = g0r, g1r, v1r, g2r, v2r;
        if (pos0 > 0) { const u16* rp = up + (size_t)(t0 - 1) * 5632; g0r = *(const uint4*)(rp + c8); v0r = *(const uint4*)(rp + 2816 + c8); }
        { const u16* rp = up + (size_t)t0 * 5632; g1r = *(const uint4*)(rp + c8); v1r = *(const uint4*)(rp + 2816 + c8); }
#pragma unroll 4
        for (int o = 0; o < TG; ++o) {
          g2r = make_uint4(0, 0, 0, 0); v2r = g2r;
          if (pos0 + o + 1 < L) { const u16* rp = up + (size_t)(t0 + o + 1) * 5632; g2r = *(const uint4*)(rp + c8); v2r = *(const uint4*)(rp + 2816 + c8); }
          const unsigned ga[3][4] = {{g0r.x, g0r.y, g0r.z, g0r.w}, {g1r.x, g1r.y, g1r.z, g1r.w}, {g2r.x, g2r.y, g2r.z, g2r.w}};
          const unsigned va[3][4] = {{v0r.x, v0r.y, v0r.z, v0r.w}, {v1r.x, v1r.y, v1r.z, v1r.w}, {v2r.x, v2r.y, v2r.z, v2r.w}};
          float res[8];
#pragma unroll
          for (int e = 0; e < 8; ++e) {
            float g = bgv[e], v = bvv[e];
#pragma unroll
            for (int d = 0; d < 3; ++d) {
              const float xg = (e & 1) ? bhi(ga[d][e >> 1]) : blo(ga[d][e >> 1]);
              const float xv = (e & 1) ? bhi(va[d][e >> 1]) : blo(va[d][e >> 1]);
              g += wg[d][e] * xg; v += wv[d][e] * xv;
            }
            res[e] = siluf_(g) * v;
          }
          *(uint4*)(act + (size_t)(t0 + o) * 2816 + c8) = make_uint4(pack2(res[0], res[1]), pack2(res[2], res[3]), pack2(res[4], res[5]), pack2(res[6], res[7]));
          g0r = g1r; v0r = v1r; g1r = g2r; v1r = v2r;
        }
      }
    }
    GSYNC();
    if (PH(12)) {
      const u16* act = (const u16*)(p.ws + B_ACT);
      for (int j = bid; j < 192 * 8; j += nb) {
        const int mt = j >> 3, nt = j & 7;
        f32x4 acc[4][4];
        zero_acc<4>(acc);
        gemm_core<4>(acc, act + (size_t)mt * 128 * 2816, 2816, WL + W_DN + (size_t)nt * 128 * 2816, 2816, 2816, sm);
        const float* gf = mods + (size_t)(l * 9 + tok_v(mt * 128)) * 6144 + 5 * 1024;
        EPI_LOOP(4) {
          const size_t row = mt * 128 + EROW; const int col = nt * 128 + ECOL4(4);
          float4* xp_ = (float4*)(p.out + row * 1024 + col);
          float4 xv = *xp_; const float4 gg = *(const float4*)(gf + col);
          xv.x += gg.x * acc[i][j][0]; xv.y += gg.y * acc[i][j][1]; xv.z += gg.z * acc[i][j][2]; xv.w += gg.w * acc[i][j][3];
          *xp_ = xv;
        }
      }
    }
    GSYNC();
  }
  if (PH(13)) {
    const int tid = otid();
    const int lane = tid & 63, w = tid >> 6;
    const float* gfin = p.in[38];
    for (int tile = bid; tile < T_ / 4; tile += nb) {
      const int t = tile * 4 + w;
      float4* xr = (float4*)(p.out + (size_t)t * 1024);
      float4 v[4];
      float ss = 0.f;
#pragma unroll
      for (int j = 0; j < 4; ++j) { v[j] = xr[lane + 64 * j]; ss += v[j].x * v[j].x + v[j].y * v[j].y + v[j].z * v[j].z + v[j].w * v[j].w; }
      ss = wave_sum(ss);
      const float rstd = rsqrtf(ss * (1.f / 1024.f) + 1e-6f);
#pragma unroll
      for (int j = 0; j < 4; ++j) {
        float4 g = *(const float4*)(gfin + (lane + 64 * j) * 4);
        xr[lane + 64 * j] = make_float4(v[j].x * rstd * g.x, v[j].y * rstd * g.y, v[j].z * rstd * g.z, v[j].w * rstd * g.w);
      }
    }
  }
}

extern "C" void kernel_launch(void* const* d_in, const int* in_sizes, int n_in, void* d_out, int out_size,
                              void* d_ws, size_t ws_size, hipStream_t stream) {
  static int grid_blocks = 0;
  if (!grid_blocks) {
    int dev = 0, cus = 0, per_cu = 0;
    (void)hipGetDevice(&dev);
    (void)hipDeviceGetAttribute(&cus, hipDeviceAttributeMultiprocessorCount, dev);
    (void)hipOccupancyMaxActiveBlocksPerMultiprocessor(&per_cu, mega, 256, 0);
    if (per_cu > 2) per_cu = 2;
    if (per_cu < 1) per_cu = 1;
    grid_blocks = cus * per_cu;
  }
  if (ws_size < B_TOTAL || n_in < 39) {
    fprintf(stderr, "workspace too small: %zu < %zu\n", ws_size, (size_t)B_END);
    return;
  }
  Params p{};
  for (int i = 0; i < 39; ++i) p.in[i] = (const float*)d_in[i];
  p.out = (float*)d_out;
  p.ws = (char*)d_ws;
  p.bar = (unsigned*)((char*)d_ws + B_BAR);
  (void)hipMemsetAsync(p.bar, 0, 256, stream);
  void* args[] = {&p};
  hipError_t e = hipLaunchCooperativeKernel((void*)mega, dim3(grid_blocks), dim3(256), args, 0, stream);
  if (e != hipSuccess) fprintf(stderr, "cooperative launch failed: %s (grid %d)\n", hipGetErrorString(e), grid_blocks);
}
```

```cpp
#include <hip/hip_runtime.h>
#include <hip/hip_cooperative_groups.h>
#include <cstdio>
namespace cg = cooperative_groups;

#define DI __device__ __forceinline__
typedef __bf16 bf16;
using bf16x8 = __attribute__((ext_vector_type(8))) short;
using f32x4 = __attribute__((ext_vector_type(4))) float;
using f32x16 = __attribute__((ext_vector_type(16))) float;
typedef unsigned short u16;

constexpr int T_ = 24576, TP_ = 8192;
constexpr int NCH = 384;
constexpr long long O_SD = 25165824LL, O_S5RE = 41943040LL, O_S5IM = 42467328LL, O_CKV = 42991616LL, O_KR = 51380224LL;

constexpr size_t W_IN = 0;
constexpr size_t W_G = W_IN + 3328ull * 1024;
constexpr size_t W_QB = W_G + 3072ull * 1024;
constexpr size_t W_KVB = W_QB + 768ull * 384;
constexpr size_t W_GLU = W_KVB + 1024ull * 256;
constexpr size_t W_BR = W_GLU + 512ull * 512;
constexpr size_t W_OUT = W_BR + 1024ull * 1536;
constexpr size_t W_UP = W_OUT + 1024ull * 1024;
constexpr size_t W_DN = W_UP + 5632ull * 1024;
constexpr size_t W_LAYER = W_DN + 1024ull * 2816;

constexpr size_t al(size_t x) { return (x + 255) & ~(size_t)255; }
constexpr size_t B_W = 0;
constexpr size_t B_MODS = al(B_W + 4 * W_LAYER * 2);
constexpr size_t B_ROPE = al(B_MODS + 4ull * 9 * 6144 * 4);
constexpr size_t B_LAMB = al(B_ROPE + 2048ull * 32 * 4);
constexpr size_t B_LAM64 = al(B_LAMB + 4ull * 2 * 32 * 64 * 8);
constexpr size_t B_BBT = al(B_LAM64 + 4ull * 2 * 32 * 64 * 8);
constexpr size_t B_CMT = al(B_BBT + 4ull * 2 * 32 * 128 * 16 * 2);
constexpr size_t B_CKVC = al(B_CMT + 4ull * 32 * 16 * 128 * 2);
constexpr size_t B_H = al(B_CKVC + 4ull * 2048 * 256 * 2);
constexpr size_t B_QKV = al(B_H + (size_t)T_ * 1024 * 2);
constexpr size_t B_Z = al(B_QKV + (size_t)T_ * 1536 * 2);
constexpr size_t B_US5 = al(B_Z + (size_t)T_ * 512 * 2);
constexpr size_t B_QA = al(B_US5 + (size_t)T_ * 512 * 2);
constexpr size_t B_KVA = al(B_QA + (size_t)T_ * 384 * 2);
constexpr size_t B_MISC = al(B_KVA + (size_t)T_ * 256 * 2);
constexpr size_t B_QN = al(B_MISC + (size_t)T_ * 48 * 4);
constexpr size_t B_KN = al(B_QN + (size_t)T_ * 512 * 2);
constexpr size_t B_VV = al(B_KN + (size_t)T_ * 512 * 2);
constexpr size_t B_KT = al(B_VV + (size_t)T_ * 512 * 2);
constexpr size_t B_BG = al(B_KT + (size_t)T_ * 512 * 2);
constexpr size_t B_TM = al(B_BG + (size_t)T_ * 16 * 4);
constexpr size_t B_QKM = al(B_TM + (size_t)T_ * 512 * 2);
constexpr size_t B_GC = al(B_QKM + (size_t)T_ * 512 * 2);
constexpr size_t B_BC = al(B_GC + (size_t)NCH * 4 * 2 * 64 * 4);
constexpr size_t KB_P = 32ull * 8 * 256 * 96, KB_S = 8ull * 8 * 2304 * 96;
constexpr size_t VT_P = 32ull * 8 * 64 * 256, VT_S = 8ull * 8 * 64 * 2304;
constexpr size_t B_KB = al(B_BC + (size_t)NCH * 4 * 2 * 64 * 4);
constexpr size_t B_VT = al(B_KB + (KB_P + KB_S) * 2);
constexpr size_t B_QM = al(B_VT + (VT_P + VT_S) * 2);
constexpr size_t B_HEND = al(B_QM + (size_t)T_ * 768 * 2);
constexpr size_t B_HIN = al(B_HEND + (size_t)NCH * 32 * 2 * 64 * 8);
constexpr size_t B_Y5 = al(B_HIN + (size_t)NCH * 32 * 2 * 64 * 8);
constexpr size_t B_OC = al(B_Y5 + (size_t)T_ * 512 * 2);
constexpr size_t B_END = al(B_OC + (size_t)T_ * 512 * 2);
constexpr size_t B_OF = B_QKV;
constexpr size_t B_OB = B_QKV + (size_t)T_ * 512 * 2;
constexpr size_t B_MG = B_QKV;
constexpr size_t B_OA = B_QN;
constexpr size_t B_OB5 = B_KN;
constexpr size_t B_UP = B_QKV;
constexpr size_t B_ACT = B_KB;
static_assert(B_UP + (size_t)T_ * 5632 * 2 <= B_KB, "UP overlaps ACT");
static_assert(B_ACT + (size_t)T_ * 2816 * 2 <= B_END, "ACT too big");
constexpr size_t B_BAR = B_END;
constexpr size_t B_TOTAL = B_BAR + 4096;
static_assert(B_TOTAL <= 768ull * 1024 * 1024, "workspace too big");

struct Params {
  const float* in[39];
  float* out;
  char* ws;
  unsigned* bar;
};

DI int otid() { int t = (int)__builtin_amdgcn_workitem_id_x(); asm volatile("" : "+v"(t)); return t; }
DI unsigned pack2(float a, float b) {
  typedef __attribute__((ext_vector_type(2))) __bf16 bf2;
  bf2 v; v[0] = (__bf16)a; v[1] = (__bf16)b;
  return __builtin_bit_cast(unsigned, v);
}
DI u16 f2bf(float a) { return (u16)(pack2(a, 0.f) & 0xffffu); }
DI float bf2f(u16 u) { return __uint_as_float(((unsigned)u) << 16); }
DI float blo(unsigned u) { return __uint_as_float(u << 16); }
DI float bhi(unsigned u) { return __uint_as_float(u & 0xffff0000u); }
DI float wave_sum(float v) {
#pragma unroll
  for (int o = 32; o > 0; o >>= 1) v += __shfl_xor(v, o);
  return v;
}
DI float sigmoidf_(float x) { return 1.f / (1.f + __expf(-x)); }
DI float siluf_(float x) { return x / (1.f + __expf(-x)); }
DI int tok_v(int t) { return t < TP_ ? 0 : 1 + ((t - TP_) >> 11); }
DI int crow(int r, int h2) { return (r & 3) + 8 * (r >> 2) + 4 * h2; }
DI bf16x8 mk8(unsigned a, unsigned b, unsigned c, unsigned d) {
  uint4 p = make_uint4(a, b, c, d);
  return __builtin_bit_cast(bf16x8, p);
}
DI bf16x8 pack_acc(const f32x16& x, int s) {
  return mk8(pack2(x[8 * s], x[8 * s + 1]), pack2(x[8 * s + 2], x[8 * s + 3]), pack2(x[8 * s + 4], x[8 * s + 5]),
             pack2(x[8 * s + 6], x[8 * s + 7]));
}
DI bf16x8 load_perm(const u16* rowptr, int s, int h2) {
  uint2 a = *(const uint2*)(rowptr + 16 * s + 4 * h2);
  uint2 b = *(const uint2*)(rowptr + 16 * s + 8 + 4 * h2);
  return mk8(a.x, a.y, b.x, b.y);
}
DI unsigned swap16(unsigned u) { return (u >> 16) | (u << 16); }
DI bf16x8 load_perm_rev(const u16* rowptr, int base, int s, int h2) {
  uint2 a = *(const uint2*)(rowptr + 60 - base - 16 * s - 4 * h2);
  uint2 b = *(const uint2*)(rowptr + 52 - base - 16 * s - 4 * h2);
  return mk8(swap16(a.y), swap16(a.x), swap16(b.y), swap16(b.x));
}
#define MFMA16(a, b, c) __builtin_amdgcn_mfma_f32_16x16x32_bf16((a), (b), (c), 0, 0, 0)
#define MFMA32(a, b, c) __builtin_amdgcn_mfma_f32_32x32x16_bf16((a), (b), (c), 0, 0, 0)

template <int NJ, bool SWAP = true>
DI void gemm_core(f32x4 (&acc)[4][NJ], const u16* __restrict__ A, int lda, const u16* __restrict__ B, int ldb, int K,
                  u16* sm) {
  const int tid = otid(), lane = tid & 63, w = tid >> 6, wr = w >> 1, wc = w & 1;
  const int fr = lane & 15, fq = lane >> 4;
  constexpr int RS = 136;
  const int lrow = tid >> 4, lkc = tid & 15;
  uint4 a0, a1, a2, a3, a4, a5, a6, a7, b0, b1, b2, b3, b4, b5, b6, b7;
  b4 = b5 = b6 = b7 = make_uint4(0, 0, 0, 0);
  const u16* ap = A + (size_t)lrow * lda + lkc * 8;
  const u16* bp = B + (size_t)lrow * ldb + lkc * 8;
  const int nk = K >> 7;
  u16* as = sm;
  u16* bs = sm + 128 * RS;
  {
    const int k0 = 0;
    a0 = *(const uint4*)(ap + (size_t)(0 * 16) * lda + k0);
    a1 = *(const uint4*)(ap + (size_t)(1 * 16) * lda + k0);
    a2 = *(const uint4*)(ap + (size_t)(2 * 16) * lda + k0);
    a3 = *(const uint4*)(ap + (size_t)(3 * 16) * lda + k0);
    a4 = *(const uint4*)(ap + (size_t)(4 * 16) * lda + k0);
    a5 = *(const uint4*)(ap + (size_t)(5 * 16) * lda + k0);
    a6 = *(const uint4*)(ap + (size_t)(6 * 16) * lda + k0);
    a7 = *(const uint4*)(ap + (size_t)(7 * 16) * lda + k0);
    b0 = *(const uint4*)(bp + (size_t)(0 * 16) * ldb + k0);
    b1 = *(const uint4*)(bp + (size_t)(1 * 16) * ldb + k0);
    b2 = *(const uint4*)(bp + (size_t)(2 * 16) * ldb + k0);
    b3 = *(const uint4*)(bp + (size_t)(3 * 16) * ldb + k0);
    if (NJ == 4) b4 = *(const uint4*)(bp + (size_t)(4 * 16) * ldb + k0);
    if (NJ == 4) b5 = *(const uint4*)(bp + (size_t)(5 * 16) * ldb + k0);
    if (NJ == 4) b6 = *(const uint4*)(bp + (size_t)(6 * 16) * ldb + k0);
    if (NJ == 4) b7 = *(const uint4*)(bp + (size_t)(7 * 16) * ldb + k0);
  }
  for (int kt = 0; kt < nk; ++kt) {
    __syncthreads();
    *(uint4*)(as + (lrow + 0 * 16) * RS + lkc * 8) = a0;
    *(uint4*)(as + (lrow + 1 * 16) * RS + lkc * 8) = a1;
    *(uint4*)(as + (lrow + 2 * 16) * RS + lkc * 8) = a2;
    *(uint4*)(as + (lrow + 3 * 16) * RS + lkc * 8) = a3;
    *(uint4*)(as + (lrow + 4 * 16) * RS + lkc * 8) = a4;
    *(uint4*)(as + (lrow + 5 * 16) * RS + lkc * 8) = a5;
    *(uint4*)(as + (lrow + 6 * 16) * RS + lkc * 8) = a6;
    *(uint4*)(as + (lrow + 7 * 16) * RS + lkc * 8) = a7;
    *(uint4*)(bs + (lrow + 0 * 16) * RS + lkc * 8) = b0;
    *(uint4*)(bs + (lrow + 1 * 16) * RS + lkc * 8) = b1;
    *(uint4*)(bs + (lrow + 2 * 16) * RS + lkc * 8) = b2;
    *(uint4*)(bs + (lrow + 3 * 16) * RS + lkc * 8) = b3;
    if (NJ == 4) *(uint4*)(bs + (lrow + 4 * 16) * RS + lkc * 8) = b4;
    if (NJ == 4) *(uint4*)(bs + (lrow + 5 * 16) * RS + lkc * 8) = b5;
    if (NJ == 4) *(uint4*)(bs + (lrow + 6 * 16) * RS + lkc * 8) = b6;
    if (NJ == 4) *(uint4*)(bs + (lrow + 7 * 16) * RS + lkc * 8) = b7;
    __syncthreads();
    {
      const int k0 = (kt + 1 < nk ? kt + 1 : kt) * 128;
    a0 = *(const uint4*)(ap + (size_t)(0 * 16) * lda + k0);
    a1 = *(const uint4*)(ap + (size_t)(1 * 16) * lda + k0);
    a2 = *(const uint4*)(ap + (size_t)(2 * 16) * lda + k0);
    a3 = *(const uint4*)(ap + (size_t)(3 * 16) * lda + k0);
    a4 = *(const uint4*)(ap + (size_t)(4 * 16) * lda + k0);
    a5 = *(const uint4*)(ap + (size_t)(5 * 16) * lda + k0);
    a6 = *(const uint4*)(ap + (size_t)(6 * 16) * lda + k0);
    a7 = *(const uint4*)(ap + (size_t)(7 * 16) * lda + k0);
    b0 = *(const uint4*)(bp + (size_t)(0 * 16) * ldb + k0);
    b1 = *(const uint4*)(bp + (size_t)(1 * 16) * ldb + k0);
    b2 = *(const uint4*)(bp + (size_t)(2 * 16) * ldb + k0);
    b3 = *(const uint4*)(bp + (size_t)(3 * 16) * ldb + k0);
    if (NJ == 4) b4 = *(const uint4*)(bp + (size_t)(4 * 16) * ldb + k0);
    if (NJ == 4) b5 = *(const uint4*)(bp + (size_t)(5 * 16) * ldb + k0);
    if (NJ == 4) b6 = *(const uint4*)(bp + (size_t)(6 * 16) * ldb + k0);
    if (NJ == 4) b7 = *(const uint4*)(bp + (size_t)(7 * 16) * ldb + k0);
    }
    __builtin_amdgcn_s_setprio(1);
#pragma unroll
    for (int ks = 0; ks < 4; ++ks) {
      bf16x8 af[4], bfr[NJ];
#pragma unroll
      for (int i = 0; i < 4; ++i) af[i] = *(const bf16x8*)(as + (wr * 64 + i * 16 + fr) * RS + ks * 32 + fq * 8);
#pragma unroll
      for (int j = 0; j < NJ; ++j) bfr[j] = *(const bf16x8*)(bs + (wc * NJ * 16 + j * 16 + fr) * RS + ks * 32 + fq * 8);
#pragma unroll
      for (int i = 0; i < 4; ++i)
#pragma unroll
        for (int j = 0; j < NJ; ++j) acc[i][j] = SWAP ? MFMA16(bfr[j], af[i], acc[i][j]) : MFMA16(af[i], bfr[j], acc[i][j]);
    }
    __builtin_amdgcn_s_setprio(0);
  }
}
template <int NJ>
DI void zero_acc(f32x4 (&acc)[4][NJ]) {
#pragma unroll
  for (int i = 0; i < 4; ++i)
#pragma unroll
    for (int j = 0; j < NJ; ++j) acc[i][j] = f32x4{0.f, 0.f, 0.f, 0.f};
}
#define EPI_LOOP(NJ_)                                                              \
  const int e_lane = otid() & 63, e_w = otid() >> 6;                               \
  const int e_wr = e_w >> 1, e_wc = e_w & 1, e_fr = e_lane & 15, e_fq = e_lane >> 4; \
  _Pragma("unroll") for (int i = 0; i < 4; ++i)                                    \
  _Pragma("unroll") for (int j = 0; j < NJ_; ++j)
#define EROW (e_wr * 64 + i * 16 + e_fr)
#define ECOL4(NJ_) (e_wc * NJ_ * 16 + j * 16 + e_fq * 4)
DI uint2 pack4(const f32x4& v) { return make_uint2(pack2(v[0], v[1]), pack2(v[2], v[3])); }

DI int colmap(int kind, int n) {
  if (kind == 0) {
    if (n < 2048) return n;
    if (n < 2560) return 2064 + (n - 2048);
    if (n < 2944) return 2576 + (n - 2560);
    if (n < 3200) return 2960 + (n - 2944);
    int j = n - 3200;
    if (j < 16) return 2048 + j;
    if (j < 48) return 3216 + (j - 16);
    return -1;
  }
  if (kind == 1) return 3248 + n;
  return n;
}
DI void convT_tile(const float* __restrict__ src, int lds, int K, u16* __restrict__ dst, int kind, int kt, int nt,
                   float* sm) {
  const int tid = otid();
  const int c = tid & 63;
  const int sc = colmap(kind, nt * 64 + c);
  __syncthreads();
#pragma unroll 4
  for (int i = 0; i < 16; ++i) {
    int r = (tid >> 6) + i * 4;
    float v = sc >= 0 ? src[(size_t)(kt * 64 + r) * lds + sc] : 0.f;
    sm[r * 65 + c] = v;
  }
  __syncthreads();
  const int n = tid >> 2, kq = tid & 3;
  unsigned pk[8];
#pragma unroll
  for (int j = 0; j < 8; ++j) pk[j] = pack2(sm[(kq * 16 + 2 * j) * 65 + n], sm[(kq * 16 + 2 * j + 1) * 65 + n]);
  u16* d = dst + (size_t)(nt * 64 + n) * K + kt * 64 + kq * 16;
  *(uint4*)d = make_uint4(pk[0], pk[1], pk[2], pk[3]);
  *(uint4*)(d + 8) = make_uint4(pk[4], pk[5], pk[6], pk[7]);
}
constexpr int CJ0 = 16 * 52, CJ1 = CJ0 + 16 * 48, CJ2 = CJ1 + 6 * 12, CJ3 = CJ2 + 4 * 16, CJ4 = CJ3 + 8 * 8,
              CJ5 = CJ4 + 24 * 16, CJ6 = CJ5 + 16 * 16, CJ7 = CJ6 + 16 * 88, CJ8 = CJ7 + 44 * 16;
DI void conv_job(const Params& p, int l, int j, float* sm) {
  u16* wl = (u16*)(p.ws + B_W) + (size_t)l * W_LAYER;
  if (j < CJ0) { convT_tile(p.in[13] + (size_t)l * 1024 * 6320, 6320, 1024, wl + W_IN, 0, j / 52, j % 52, sm); return; }
  if (j < CJ1) { j -= CJ0; convT_tile(p.in[13] + (size_t)l * 1024 * 6320, 6320, 1024, wl + W_G, 1, j / 48, j % 48, sm); return; }
  if (j < CJ2) { j -= CJ1; convT_tile(p.in[29] + (size_t)l * 384 * 768, 768, 384, wl + W_QB, 2, j / 12, j % 12, sm); return; }
  if (j < CJ3) { j -= CJ2; convT_tile(p.in[31] + (size_t)l * 256 * 1024, 1024, 256, wl + W_KVB, 2, j / 16, j % 16, sm); return; }
  if (j < CJ4) { j -= CJ3; convT_tile(p.in[26] + (size_t)l * 512 * 512, 512, 512, wl + W_GLU, 2, j / 8, j % 8, sm); return; }
  if (j < CJ5) { j -= CJ4; convT_tile(p.in[32] + (size_t)l * 1536 * 1024, 1024, 1536, wl + W_BR, 2, j / 16, j % 16, sm); return; }
  if (j < CJ6) { j -= CJ5; convT_tile(p.in[33] + (size_t)l * 1024 * 1024, 1024, 1024, wl + W_OUT, 2, j / 16, j % 16, sm); return; }
  if (j < CJ7) { j -= CJ6; convT_tile(p.in[34] + (size_t)l * 1024 * 5632, 5632, 1024, wl + W_UP, 2, j / 88, j % 88, sm); return; }
  j -= CJ7; convT_tile(p.in[37] + (size_t)l * 2816 * 1024, 1024, 2816, wl + W_DN, 2, j / 16, j % 16, sm);
}
DI void mods_tile(const Params& p, int l, int jg, float* sm) {
  const int tid = otid();
  __syncthreads();
  for (int i = tid; i < 9 * 1024; i += 256) {
    int v = i >> 10, k = i & 1023;
    float cv = v == 0 ? p.in[8][k] : p.in[7][(v - 1) * 1024 + k];
    sm[i] = cv / (1.f + __expf(-cv));
  }
  __syncthreads();
  const int col = jg * 64 + (tid & 63), kq = tid >> 6;
  float acc[9];
#pragma unroll
  for (int v = 0; v < 9; ++v) acc[v] = 0.f;
  const float* wp = p.in[9] + (size_t)l * 1024 * 6144 + col;
#pragma unroll 4
  for (int k = kq * 256; k < kq * 256 + 256; ++k) {
    float wv = wp[(size_t)k * 6144];
#pragma unroll
    for (int v = 0; v < 9; ++v) acc[v] += sm[v * 1024 + k] * wv;
  }
  float* red = sm + 9 * 1024;
#pragma unroll
  for (int v = 0; v < 9; ++v) red[(kq * 9 + v) * 64 + (tid & 63)] = acc[v];
  __syncthreads();
  if (kq == 0) {
    float* mods = (float*)(p.ws + B_MODS);
    float b = p.in[10][l * 6144 + col];
#pragma unroll
    for (int v = 0; v < 9; ++v) {
      float s = red[(0 * 9 + v) * 64 + tid] + red[(1 * 9 + v) * 64 + tid] + red[(2 * 9 + v) * 64 + tid] + red[(3 * 9 + v) * 64 + tid];
      mods[(size_t)(l * 9 + v) * 6144 + col] = s + b;
    }
  }
}
DI void s5pre_tile(const Params& p, int tile) {
  const int id = tile * 256 + otid();
  const int pp = id & 63, g = (id >> 6) & 31, dir = (id >> 11) & 1, l = id >> 12;
  const float lre = p.in[18][((l * 2 + dir) * 32 + g) * 64 + pp];
  const float lim = p.in[19][((l * 2 + dir) * 32 + g) * 64 + pp];
  const float dt = expf(p.in[20][(l * 2 + dir) * 32 + g]);
  float er = expf(lre * dt), sn, cs;
  sincosf(lim * dt, &sn, &cs);
  const float lbr = er * cs, lbi = er * sn;
  float e64 = expf(64.f * lre * dt), s64, c64;
  sincosf(64.f * lim * dt, &s64, &c64);
  float2* lamb = (float2*)(p.ws + B_LAMB);
  float2* lam64 = (float2*)(p.ws + B_LAM64);
  const int li = ((l * 2 + dir) * 32 + g) * 64 + pp;
  lamb[li] = make_float2(lbr, lbi);
  lam64[li] = make_float2(e64 * c64, e64 * s64);
  const float nr = lbr - 1.f, ni = lbi, den = lre * lre + lim * lim;
  const float cr = (nr * lre + ni * lim) / den, ci = (ni * lre - nr * lim) / den;
  u16* bbt = (u16*)(p.ws + B_BBT) + (size_t)((l * 2 + dir) * 32 + g) * 128 * 16;
  const float* bre = p.in[21] + (size_t)((l * 32 + g) * 64 + pp) * 16;
  const float* bim = p.in[22] + (size_t)((l * 32 + g) * 64 + pp) * 16;
#pragma unroll
  for (int c = 0; c < 16; ++c) {
    float br = bre[c], bi = bim[c];
    bbt[pp * 16 + c] = f2bf(cr * br - ci * bi);
    bbt[(64 + pp) * 16 + c] = f2bf(cr * bi + ci * br);
  }
  if (dir == 0) {
    u16* cmt = (u16*)(p.ws + B_CMT) + (size_t)(l * 32 + g) * 16 * 128;
    const float* cre = p.in[23] + (size_t)(l * 32 + g) * 16 * 64;
    const float* cim = p.in[24] + (size_t)(l * 32 + g) * 16 * 64;
#pragma unroll
    for (int c = 0; c < 16; ++c) {
      cmt[c * 128 + pp] = f2bf(cre[c * 64 + pp]);
      cmt[c * 128 + 64 + pp] = f2bf(-cim[c * 64 + pp]);
    }
  }
}

DI void norm_phase(const Params& p, int l, int shift_idx, int scale_idx, const float* gn) {
  const float* x = p.out;
  u16* H = (u16*)(p.ws + B_H);
  const float* mods = (const float*)(p.ws + B_MODS);
  const int lane = otid() & 63, w = otid() >> 6;
  for (int tile = blockIdx.x; tile < T_ / 4; tile += gridDim.x) {
    const int t = tile * 4 + w;
    const float4* xr = (const float4*)(x + (size_t)t * 1024);
    float4 v[4];
    float ss = 0.f;
#pragma unroll
    for (int j = 0; j < 4; ++j) {
      v[j] = xr[lane + 64 * j];
      ss += v[j].x * v[j].x + v[j].y * v[j].y + v[j].z * v[j].z + v[j].w * v[j].w;
    }
    ss = wave_sum(ss);
    const float rstd = rsqrtf(ss * (1.f / 1024.f) + 1e-6f);
    const float* mb = mods + (size_t)(l * 9 + tok_v(t)) * 6144;
#pragma unroll
    for (int j = 0; j < 4; ++j) {
      const int c = (lane + 64 * j) * 4;
      float4 g = *(const float4*)(gn + c);
      float4 sc = *(const float4*)(mb + scale_idx * 1024 + c);
      float4 sh = *(const float4*)(mb + shift_idx * 1024 + c);
      float y0 = v[j].x * rstd * g.x * (1.f + sc.x) + sh.x;
      float y1 = v[j].y * rstd * g.y * (1.f + sc.y) + sh.y;
      float y2 = v[j].z * rstd * g.z * (1.f + sc.z) + sh.z;
      float y3 = v[j].w * rstd * g.w * (1.f + sc.w) + sh.w;
      *(uint2*)(H + (size_t)t * 1024 + c) = make_uint2(pack2(y0, y1), pack2(y2, y3));
    }
  }
}

DI void gemm_in_phase(const Params& p, int l, u16* sm) {
  const u16* H = (const u16*)(p.ws + B_H);
  const u16* Wt = (const u16*)(p.ws + B_W) + (size_t)l * W_LAYER + W_IN;
  for (int tile = blockIdx.x; tile < 192 * 26; tile += gridDim.x) {
    const int mt = tile / 26, nt = tile % 26;
    f32x4 acc[4][4];
    zero_acc<4>(acc);
    gemm_core<4>(acc, H + (size_t)mt * 128 * 1024, 1024, Wt + (size_t)nt * 128 * 1024, 1024, 1024, sm);
    if (nt < 25) {
      u16* dst; int ld, c0;
      if (nt < 12) { dst = (u16*)(p.ws + B_QKV); ld = 1536; c0 = nt * 128; }
      else if (nt < 16) { dst = (u16*)(p.ws + B_Z); ld = 512; c0 = (nt - 12) * 128; }
      else if (nt < 20) { dst = (u16*)(p.ws + B_US5); ld = 512; c0 = (nt - 16) * 128; }
      else if (nt < 23) { dst = (u16*)(p.ws + B_QA); ld = 384; c0 = (nt - 20) * 128; }
      else { dst = (u16*)(p.ws + B_KVA); ld = 256; c0 = (nt - 23) * 128; }
      EPI_LOOP(4) { *(uint2*)(dst + (size_t)(mt * 128 + EROW) * ld + c0 + ECOL4(4)) = pack4(acc[i][j]); }
    } else {
      float* misc = (float*)(p.ws + B_MISC);
      EPI_LOOP(4) {
        const int c = ECOL4(4);
        if (c < 48) *(float4*)(misc + (size_t)(mt * 128 + EROW) * 48 + c) = make_float4(acc[i][j][0], acc[i][j][1], acc[i][j][2], acc[i][j][3]);
      }
    }
  }
}

DI void delta_prep_tile(const Params& p, int l, int chunk, u16* sm) {
  const int tid = otid(), lane = tid & 63, w = tid >> 6;
  const int tb = chunk * 64;
  int pos0, L;
  if (tb < TP_) { pos0 = tb & 255; L = 256; } else { pos0 = (tb - TP_) & 2047; L = 2048; }
  const u16* qkv = (const u16*)(p.ws + B_QKV);
  const float* cw = p.in[14] + (size_t)l * 5 * 1536;
  u16* ksm = sm + w * (64 * 130);
  __syncthreads();
  for (int gi = w; gi < 12; gi += 4) {
    const int ch = gi * 128 + 2 * lane;
    float w0[5], w1[5];
#pragma unroll
    for (int i = 0; i < 5; ++i) { w0[i] = cw[i * 1536 + ch]; w1[i] = cw[i * 1536 + ch + 1]; }
    float a0[5], a1[5];
#pragma unroll
    for (int i = 0; i < 4; ++i) {
      int ps = pos0 - 2 + i;
      unsigned u = (ps >= 0 && ps < L) ? *(const unsigned*)(qkv + (size_t)(tb - 2 + i) * 1536 + ch) : 0u;
      a0[i + 1] = blo(u); a1[i + 1] = bhi(u);
    }
    u16* dst = (u16*)(p.ws + (gi < 4 ? B_QN : (gi < 8 ? B_KN : B_VV)));
    const int hh = gi & 3;
    for (int tt = 0; tt < 64; ++tt) {
#pragma unroll
      for (int i = 0; i < 4; ++i) { a0[i] = a0[i + 1]; a1[i] = a1[i + 1]; }
      {
        int ps = pos0 + tt + 2;
        unsigned u = (ps < L) ? *(const unsigned*)(qkv + (size_t)(tb + tt + 2) * 1536 + ch) : 0u;
        a0[4] = blo(u); a1[4] = bhi(u);
      }
      float y0 = 0.f, y1 = 0.f;
#pragma unroll
      for (int i = 0; i < 5; ++i) { y0 += w0[i] * a0[i]; y1 += w1[i] * a1[i]; }
      y0 = siluf_(y0); y1 = siluf_(y1);
      if (gi < 8) {
        float ss = wave_sum(y0 * y0 + y1 * y1);
        float sc = rsqrtf(ss + 1e-6f);
        if (gi < 4) sc *= 0.08838834764831845f;
        y0 *= sc; y1 *= sc;
      }
      const unsigned pk = pack2(y0, y1);
      *(unsigned*)(dst + (size_t)(tb + tt) * 512 + hh * 128 + 2 * lane) = pk;
      if (gi >= 4 && gi < 8) *(unsigned*)(ksm + tt * 130 + 2 * lane) = pk;
    }
    if (gi >= 4 && gi < 8) {
      u16* kt = (u16*)(p.ws + B_KT) + (size_t)(chunk * 4 + hh) * 128 * 64;
#pragma unroll
      for (int rr = 0; rr < 2; ++rr) {
        const int dk = lane + 64 * rr;
        unsigned pk[32];
#pragma unroll
        for (int t2 = 0; t2 < 32; ++t2) pk[t2] = (unsigned)ksm[(2 * t2) * 130 + dk] | ((unsigned)ksm[(2 * t2 + 1) * 130 + dk] << 16);
#pragma unroll
        for (int q = 0; q < 8; ++q) *(uint4*)(kt + dk * 64 + q * 8) = make_uint4(pk[4 * q], pk[4 * q + 1], pk[4 * q + 2], pk[4 * q + 3]);
      }
    }
  }
  const float* misc = (const float*)(p.ws + B_MISC);
  float* bg = (float*)(p.ws + B_BG);
  for (int i = tid; i < 512; i += 256) {
    const int tt = i >> 3, dh = i & 7;
    const size_t t = tb + tt;
    float bl = misc[t * 48 + dh], alp = misc[t * 48 + 8 + dh];
    float x = alp + p.in[16][l * 8 + dh];
    float sp = x > 20.f ? x : log1pf(__expf(x));
    bg[t * 16 + dh] = sigmoidf_(bl);
    bg[t * 16 + 8 + dh] = -__expf(p.in[15][l * 8 + dh]) * sp;
  }
}

DI size_t kb_off(int t, int head) {
  if (t < TP_) return ((size_t)((t >> 8) * 8 + head) * 256 + (t & 255)) * 96;
  const int s = (t - TP_) >> 11, pos = (t - TP_) & 2047;
  return KB_P + ((size_t)(s * 8 + head) * 2304 + 256 + pos) * 96;
}
DI void mla_prep_tile(const Params& p, int l, int tile) {
  const int lane = otid() & 63, w = otid() >> 6;
  const int t = tile * 4 + w;
  u16* qa = (u16*)(p.ws + B_QA) + (size_t)t * 384;
  u16* kva = (u16*)(p.ws + B_KVA) + (size_t)t * 256;
  const float* misc = (const float*)(p.ws + B_MISC) + (size_t)t * 48;
  {
    unsigned u[3]; float ss = 0.f;
#pragma unroll
    for (int j = 0; j < 3; ++j) { u[j] = *(const unsigned*)(qa + 2 * lane + 128 * j); float a = blo(u[j]), b = bhi(u[j]); ss += a * a + b * b; }
    ss = wave_sum(ss);
    const float rstd = rsqrtf(ss * (1.f / 384.f) + 1e-6f);
    const float* g = p.in[28] + l * 384;
#pragma unroll
    for (int j = 0; j < 3; ++j) {
      int c = 2 * lane + 128 * j;
      *(unsigned*)(qa + c) = pack2(blo(u[j]) * rstd * g[c], bhi(u[j]) * rstd * g[c + 1]);
    }
  }
  {
    unsigned u[2]; float ss = 0.f;
#pragma unroll
    for (int j = 0; j < 2; ++j) { u[j] = *(const unsigned*)(kva + 2 * lane + 128 * j); float a = blo(u[j]), b = bhi(u[j]); ss += a * a + b * b; }
    ss = wave_sum(ss);
    const float rstd = rsqrtf(ss * (1.f / 256.f) + 1e-6f);
    const float* g = p.in[30] + l * 256;
#pragma unroll
    for (int j = 0; j < 2; ++j) {
      int c = 2 * lane + 128 * j;
      float a = blo(u[j]) * rstd * g[c], b = bhi(u[j]) * rstd * g[c + 1];
      *(unsigned*)(kva + c) = pack2(a, b);
      if (t < TP_) {
        float* o = p.out + O_CKV + ((size_t)((t >> 8) * 4 + l) * 256 + (t & 255)) * 256 + c;
        *(float2*)o = make_float2(a, b);
      }
    }
  }
  {
    const int i = lane & 31;
    float kr = misc[16 + i];
    float val;
    if (t < TP_) {
      val = kr;
      if (lane < 32) p.out[O_KR + ((size_t)((t >> 8) * 4 + l) * 256 + (t & 255)) * 32 + i] = kr;
    } else {
      const int pos = (t - TP_) & 2047;
      const float* rp = (const float*)(p.ws + B_ROPE) + (size_t)pos * 32 + (i & 15) * 2;
      const float cs = rp[0], sn = rp[1];
      float other = __shfl_xor(kr, 16);
      val = (i < 16) ? (kr * cs - other * sn) : (kr * cs + other * sn);
    }
    u16* kb = (u16*)(p.ws + B_KB);
    const u16 bv = f2bf(val);
#pragma unroll
    for (int hh = 0; hh < 4; ++hh) {
      int head = hh * 2 + (lane >> 5);
      kb[kb_off(t, head) + 64 + i] = bv;
    }
  }
}
DI void cache_rope_tile(const Params& p, int l, int tile) {
  const int pr = tile * 8 + (otid() >> 5), i = otid() & 31;
  const int s = pr >> 8, pos = pr & 255;
  const float v = p.in[6][((size_t)(s * 4 + l) * 256 + pos) * 32 + i];
  u16* kb = (u16*)(p.ws + B_KB);
  const u16 bv = f2bf(v);
#pragma unroll
  for (int head = 0; head < 8; ++head) kb[KB_P + ((size_t)(s * 8 + head) * 2304 + pos) * 96 + 64 + i] = bv;
}

DI float gelu_tanh(float x) {
  const float k0 = 0.7978845608028654f, k1 = 0.044715f;
  float u = k0 * (x + k1 * x * x * x);
  float e = __expf(2.f * u);
  float th = 1.f - 2.f / (e + 1.f);
  return 0.5f * x * (1.f + th);
}
DI void s5_chunk_tile(const Params& p, int l, int chunk, int gp, int mode, u16* sm) {
  const int tid = otid(), lane = tid & 63, w = tid >> 6;
  const u16* us5 = (const u16*)(p.ws + B_US5);
  constexpr int RS = 136;
  const int gi_w = w >> 1, half = w & 1, g_w = gp * 2 + gi_w;
  const int n = lane & 31, h2 = lane >> 5;
  bf16x8 af[2], bq[2][2];
#pragma unroll
  for (int mi = 0; mi < 2; ++mi) af[mi] = *(const bf16x8*)(us5 + (size_t)(chunk * 64 + mi * 32 + n) * 512 + g_w * 16 + 8 * h2);
#pragma unroll
  for (int dir = 0; dir < 2; ++dir) {
    const u16* bbt = (const u16*)(p.ws + B_BBT) + (size_t)((l * 2 + dir) * 32 + g_w) * 128 * 16;
#pragma unroll
    for (int nn = 0; nn < 2; ++nn) bq[dir][nn] = *(const bf16x8*)(bbt + ((half * 2 + nn) * 32 + n) * 16 + 8 * h2);
  }
  const int gi_t = tid >> 7, dir_t = (tid >> 6) & 1, pp = tid & 63, g_t = gp * 2 + gi_t;
  const float2 lb = ((const float2*)(p.ws + B_LAMB))[((l * 2 + dir_t) * 32 + g_t) * 64 + pp];
  const size_t hidx = ((size_t)(chunk * 32 + g_t) * 2 + dir_t) * 64 + pp;
  float hr = 0.f, hi = 0.f;
  if (mode) { float2 h0 = ((const float2*)(p.ws + B_HIN))[hidx]; hr = h0.x; hi = h0.y; }
  const int fr = lane & 15, fq = lane >> 4;
  bf16x8 cq[4];
  u16 uu[2][4];
  float dsk = 0.f;
  if (mode) {
    const u16* cmt = (const u16*)(p.ws + B_CMT) + (size_t)(l * 32 + g_w) * 16 * 128;
#pragma unroll
    for (int k4 = 0; k4 < 4; ++k4) cq[k4] = *(const bf16x8*)(cmt + fr * 128 + k4 * 32 + fq * 8);
#pragma unroll
    for (int mm = 0; mm < 2; ++mm)
#pragma unroll
      for (int r = 0; r < 4; ++r) uu[mm][r] = us5[((size_t)chunk * 64 + ((w & 1) * 2 + mm) * 16 + fq * 4 + r) * 512 + g_w * 16 + fr];
    dsk = p.in[25][l * 512 + g_w * 16 + fr];
  }
  __syncthreads();
  {
#pragma unroll
    for (int dir = 0; dir < 2; ++dir) {
#pragma unroll
      for (int nn = 0; nn < 2; ++nn) {
        const int nt = half * 2 + nn;
#pragma unroll
        for (int mi = 0; mi < 2; ++mi) {
          f32x16 acc;
#pragma unroll
          for (int r = 0; r < 16; ++r) acc[r] = 0.f;
          acc = MFMA32(af[mi], bq[dir][nn], acc);
          u16* d = sm + (size_t)((gi_w * 2 + dir) * 64 + mi * 32) * RS + nt * 32 + n;
#pragma unroll
          for (int r = 0; r < 16; ++r) d[crow(r, h2) * RS] = f2bf(acc[r]);
        }
      }
    }
  }
  __syncthreads();
  {
    u16* base = sm + (size_t)((gi_t * 2 + dir_t) * 64) * RS;
#pragma unroll 8
    for (int st = 0; st < 64; ++st) {
      const int tk = dir_t ? 63 - st : st;
      float br = bf2f(base[tk * RS + pp]), bi = bf2f(base[tk * RS + 64 + pp]);
      float nr = __builtin_fmaf(lb.x, hr, __builtin_fmaf(-lb.y, hi, br));
      float ni = __builtin_fmaf(lb.x, hi, __builtin_fmaf(lb.y, hr, bi));
      asm volatile("" : "+v"(nr));
      asm volatile("" : "+v"(ni));
      hr = nr; hi = ni;
      if (mode) { base[tk * RS + pp] = f2bf(hr); base[tk * RS + 64 + pp] = f2bf(hi); }
    }
    if (!mode) ((float2*)(p.ws + B_HEND))[hidx] = make_float2(hr, hi);
  }
  if (!mode) return;
  __syncthreads();
  {
    f32x4 acc[2];
    acc[0] = f32x4{0.f, 0.f, 0.f, 0.f}; acc[1] = acc[0];
#pragma unroll
    for (int ks = 0; ks < 8; ++ks) {
      const int dir = ks >> 2, kk = (ks & 3) * 32;
#pragma unroll
      for (int mm = 0; mm < 2; ++mm) {
        const int mi = (w & 1) * 2 + mm;
        bf16x8 a2 = *(const bf16x8*)(sm + (size_t)((gi_w * 2 + dir) * 64 + mi * 16 + fr) * RS + kk + fq * 8);
        acc[mm] = MFMA16(a2, cq[ks & 3], acc[mm]);
      }
    }
    u16* y5 = (u16*)(p.ws + B_Y5);
#pragma unroll
    for (int mm = 0; mm < 2; ++mm)
#pragma unroll
      for (int r = 0; r < 4; ++r) {
        const size_t t = (size_t)chunk * 64 + ((w & 1) * 2 + mm) * 16 + fq * 4 + r;
        float y = acc[mm][r] + dsk * bf2f(uu[mm][r]);
        y5[t * 512 + g_w * 16 + fr] = f2bf(gelu_tanh(y));
      }
  }
}
DI void s5_carry_tile(const Params& p, int l, int tile) {
  const int seq = tile >> 4, gp = tile & 15;
  const int tid = otid(), gi = tid >> 7, dir = (tid >> 6) & 1, pp = tid & 63, g = gp * 2 + gi;
  int c0, nc;
  if (seq < 32) { c0 = seq * 4; nc = 4; } else { c0 = 128 + (seq - 32) * 32; nc = 32; }
  const float2 l64 = ((const float2*)(p.ws + B_LAM64))[((l * 2 + dir) * 32 + g) * 64 + pp];
  float hr = 0.f, hi = 0.f;
  if (seq >= 32) {
    const size_t si = ((size_t)((seq - 32) * 4 + l) * 2 + dir) * 2048 + g * 64 + pp;
    hr = p.in[3][si]; hi = p.in[4][si];
  }
  const float2* hend = (const float2*)(p.ws + B_HEND);
  float2* hin = (float2*)(p.ws + B_HIN);
  for (int it = 0; it < nc; ++it) {
    const int ck = c0 + (dir ? nc - 1 - it : it);
    const size_t idx = ((size_t)(ck * 32 + g) * 2 + dir) * 64 + pp;
    hin[idx] = make_float2(hr, hi);
    float2 he = hend[idx];
    float nr = __builtin_fmaf(l64.x, hr, __builtin_fmaf(-l64.y, hi, he.x));
    float ni = __builtin_fmaf(l64.x, hi, __builtin_fmaf(l64.y, hr, he.y));
    asm volatile("" : "+v"(nr));
    asm volatile("" : "+v"(ni));
    hr = nr; hi = ni;
  }
  if (seq < 32) {
    const size_t so = ((size_t)(seq * 4 + l) * 2 + dir) * 2048 + g * 64 + pp;
    p.out[O_S5RE + so] = hr;
    p.out[O_S5IM + so] = hi;
  }
}

DI void delta_local_tile(const Params& p, int tile, float* smf) {
  const int chunk = tile >> 1, dir = tile & 1;
  const int tid = otid(), lane = tid & 63, h = tid >> 6;
  const int m = lane & 31, h2 = lane >> 5;
  const int tb = chunk * 64;
  const float* bg = (const float*)(p.ws + B_BG);
  const u16* kn = (const u16*)(p.ws + B_KN);
  const u16* qn = (const u16*)(p.ws + B_QN);
  float* Aw = smf + h * 4096;
  const size_t cidx = ((size_t)(chunk * 4 + h) * 2 + dir);
  const int tl = tb + (dir ? 63 - lane : lane);
  float gcs = bg[(size_t)tl * 16 + 8 + dir * 4 + h];
  const float beta = bg[(size_t)tl * 16 + dir * 4 + h];
#pragma unroll
  for (int o = 1; o < 64; o <<= 1) {
    float v = __shfl_up(gcs, o);
    if (lane >= o) gcs += v;
  }
  ((float*)(p.ws + B_GC))[cidx * 64 + lane] = gcs;
  ((float*)(p.ws + B_BC))[cidx * 64 + lane] = beta;
  __syncthreads();
  u16* qkm = (u16*)(p.ws + B_QKM) + cidx * 4096;
#pragma unroll 1
  for (int tt = 0; tt < 3; ++tt) {
    const int mi = tt == 0 ? 0 : 1, ni = tt == 2 ? 1 : 0;
    const int cm = 32 * mi + m, cn = 32 * ni + m;
    const u16* krm = kn + (size_t)(tb + (dir ? 63 - cm : cm)) * 512 + h * 128 + h2 * 8;
    const u16* qrm = qn + (size_t)(tb + (dir ? 63 - cm : cm)) * 512 + h * 128 + h2 * 8;
    const u16* krn = kn + (size_t)(tb + (dir ? 63 - cn : cn)) * 512 + h * 128 + h2 * 8;
    f32x16 ak, aq;
#pragma unroll
    for (int r = 0; r < 16; ++r) { ak[r] = 0.f; aq[r] = 0.f; }
#pragma unroll
    for (int ks = 0; ks < 8; ++ks) {
      const bf16x8 fkm = *(const bf16x8*)(krm + ks * 16), fqm = *(const bf16x8*)(qrm + ks * 16), fkn = *(const bf16x8*)(krn + ks * 16);
      ak = MFMA32(fkm, fkn, ak);
      aq = MFMA32(fqm, fkn, aq);
    }
    const int e = 32 * ni + m;
    const float gce = __shfl(gcs, e);
#pragma unroll
    for (int r = 0; r < 16; ++r) {
      const int c = 32 * mi + crow(r, h2);
      const float gcc = __shfl(gcs, c), bc = __shfl(beta, c);
      const float dec = (e <= c) ? __expf(gcc - gce) : 0.f;
      Aw[c * 64 + e] = (e < c) ? ak[r] * bc * dec : 0.f;
      qkm[c * 64 + e] = f2bf(aq[r] * dec);
    }
  }
  __syncthreads();
  u16* tm = (u16*)(p.ws + B_TM) + cidx * 4096;
  float x[64];
#pragma unroll
  for (int i = 0; i < 64; ++i) {
    float a = (i == lane) ? 1.f : 0.f;
#pragma unroll
    for (int j = 0; j < i; ++j) a -= Aw[i * 64 + j] * x[j];
    x[i] = a;
    tm[i * 64 + lane] = f2bf(a);
  }
}

template <int dir>
DI void delta_scan_body(const Params& p, int l, int seq, int h, u16* sm);
DI void delta_scan_tile(const Params& p, int l, int idx, u16* sm) {
  int seq, h, dir;
  if (idx < 64) { seq = 32 + (idx >> 3); h = (idx >> 1) & 3; dir = idx & 1; }
  else { const int i2 = idx - 64; seq = i2 >> 3; h = (i2 >> 1) & 3; dir = i2 & 1; }
  __builtin_amdgcn_s_setprio(3);
  if (dir) delta_scan_body<1>(p, l, seq, h, sm); else delta_scan_body<0>(p, l, seq, h, sm);
  __builtin_amdgcn_s_setprio(0);
}
template <int dir>
DI void delta_scan_body(const Params& p, int l, int seq, int h, u16* sm) {
  int chunk0, nch;
  if (seq < 32) { chunk0 = seq * 4; nch = 4; } else { chunk0 = 128 + (seq - 32) * 32; nch = 32; }
  const int lane = otid() & 63, w = otid() >> 6;
  const int n = lane & 31, h2 = lane >> 5;
  const int dvc = w * 32 + n;
  const u16* kn = (const u16*)(p.ws + B_KN);
  const u16* qn = (const u16*)(p.ws + B_QN);
  const u16* vv = (const u16*)(p.ws + B_VV);
  u16* od = (u16*)(p.ws + (dir ? B_OB : B_OF));
  f32x16 S[4];
  if (seq >= 32) {
    const float* s0 = p.in[2] + ((size_t)(((seq - 32) * 4 + l) * 2 + dir) * 4 + h) * 16384;
#pragma unroll
    for (int t = 0; t < 4; ++t)
#pragma unroll
      for (int r = 0; r < 16; ++r) S[t][r] = s0[(size_t)(32 * t + crow(r, h2)) * 128 + dvc];
  } else {
#pragma unroll
    for (int t = 0; t < 4; ++t)
#pragma unroll
      for (int r = 0; r < 16; ++r) S[t][r] = 0.f;
  }
  for (int it = 0; it < nch; ++it) {
    const int chunk = chunk0 + (dir ? nch - 1 - it : it);
    const int tb = chunk * 64;
    const size_t cidx = ((size_t)(chunk * 4 + h) * 2 + dir);
    const float* gcp = (const float*)(p.ws + B_GC) + cidx * 64;
    const float* bcp = (const float*)(p.ws + B_BC) + cidx * 64;
    const u16* tm = (const u16*)(p.ws + B_TM) + cidx * 4096;
    const u16* qkm = (const u16*)(p.ws + B_QKM) + cidx * 4096;
    const u16* ktp = (const u16*)(p.ws + B_KT) + (size_t)(chunk * 4 + h) * 8192;
    const float glast = gcp[63];
    size_t trow[2];
#pragma unroll
    for (int mi = 0; mi < 2; ++mi) { const int c = 32 * mi + n; trow[mi] = (size_t)(tb + (dir ? 63 - c : c)); }
#define SCHED_FENCE() asm volatile("" ::: "memory")
    u16* Ks = sm; u16* Qs = sm + 8704; u16* Vs = sm + 17408; u16* KTs = sm + 26112;
    float* GCs = (float*)(sm + 35328);
    const float* gcl = GCs; const float* bcl = GCs + 64;
    uint4 xm0, xm1, xq0, xq1;
    u16* vls = Vs + w * 32;
    __syncthreads();
    {
      const int tid_ = otid();
      const int r0 = tid_ >> 4, ck = tid_ & 15;
      uint4 tk[4], tq[4], tv[4], tt[4];
      xm0 = *(const uint4*)(tm + tid_ * 8); xm1 = *(const uint4*)(tm + 2048 + tid_ * 8);
      xq0 = *(const uint4*)(qkm + tid_ * 8); xq1 = *(const uint4*)(qkm + 2048 + tid_ * 8);
      float4 gcv = make_float4(0.f, 0.f, 0.f, 0.f);
      if (tid_ < 16) gcv = *(const float4*)(gcp + tid_ * 4); else if (tid_ < 32) gcv = *(const float4*)(bcp + (tid_ - 16) * 4);
#pragma unroll
      for (int j = 0; j < 4; ++j) {
        const size_t go = (size_t)(tb + r0 + 16 * j) * 512 + h * 128 + ck * 8;
        tk[j] = *(const uint4*)(kn + go); tq[j] = *(const uint4*)(qn + go); tv[j] = *(const uint4*)(vv + go);
        tt[j] = *(const uint4*)(ktp + ((tid_ >> 3) + 32 * j) * 64 + (tid_ & 7) * 8);
      }
#pragma unroll
      for (int j = 0; j < 4; ++j) {
        const int tau = r0 + 16 * j, c = dir ? 63 - tau : tau;
        *(uint4*)(Ks + c * 136 + ck * 8) = tk[j]; *(uint4*)(Qs + c * 136 + ck * 8) = tq[j]; *(uint4*)(Vs + c * 136 + ck * 8) = tv[j];
        *(uint4*)(KTs + ((tid_ >> 3) + 32 * j) * 72 + (tid_ & 7) * 8) = tt[j];
      }
      if (tid_ < 32) *(float4*)(GCs + tid_ * 4) = gcv;
    }
    __syncthreads();
    f32x16 X[2], QS[2];
    {
      bf16x8 Sb[4][2];
#pragma unroll
      for (int t = 0; t < 4; ++t)
#pragma unroll
        for (int s = 0; s < 2; ++s) Sb[t][s] = pack_acc(S[t], s);
#pragma unroll
      for (int mi = 0; mi < 2; ++mi)
#pragma unroll
        for (int r = 0; r < 16; ++r) { X[mi][r] = 0.f; QS[mi][r] = 0.f; }
#pragma unroll
      for (int t = 0; t < 4; ++t) {
#pragma unroll
        for (int mi = 0; mi < 2; ++mi) {
          const u16* krow_ = Ks + (32 * mi + n) * 136;
          const u16* qrow_ = Qs + (32 * mi + n) * 136;
#pragma unroll
          for (int s = 0; s < 2; ++s) {
            X[mi] = MFMA32(load_perm(krow_ + 32 * t, s, h2), Sb[t][s], X[mi]);
            QS[mi] = MFMA32(load_perm(qrow_ + 32 * t, s, h2), Sb[t][s], QS[mi]);
          }
        }
        SCHED_FENCE();
      }
    }
    __syncthreads();
    {
      const int tid_ = otid();
      const int r_ = tid_ >> 3, c_ = (tid_ & 7) * 8;
      *(uint4*)(Ks + r_ * 72 + c_) = xm0; *(uint4*)(Ks + (r_ + 32) * 72 + c_) = xm1;
      *(uint4*)(Qs + r_ * 72 + c_) = xq0; *(uint4*)(Qs + (r_ + 32) * 72 + c_) = xq1;
    }
    __syncthreads();
    bf16x8 Rb[2][2];
#pragma unroll
    for (int mi = 0; mi < 2; ++mi) {
#pragma unroll
      for (int a = 0; a < 4; ++a) {
        const int c4 = 32 * mi + 8 * a + 4 * h2;
        const float4 g4 = *(const float4*)(gcl + c4);
        const float4 b4 = *(const float4*)(bcl + c4);
        const float gg[4] = {g4.x, g4.y, g4.z, g4.w};
        const float bb[4] = {b4.x, b4.y, b4.z, b4.w};
#pragma unroll
        for (int q = 0; q < 4; ++q) {
          const int c = c4 + q;
          const float v = bf2f(vls[c * 136 + n]);
          const float eg = __expf(gg[q]);
          X[mi][4 * a + q] = bb[q] * (v - eg * X[mi][4 * a + q]);
          QS[mi][4 * a + q] *= eg;
        }
      }
      Rb[mi][0] = pack_acc(X[mi], 0);
      Rb[mi][1] = pack_acc(X[mi], 1);
    }
    SCHED_FENCE();
    f32x16 Vn[2];
#pragma unroll
    for (int mo = 0; mo < 2; ++mo) {
#pragma unroll
      for (int r = 0; r < 16; ++r) Vn[mo][r] = 0.f;
#pragma unroll
      for (int mi = 0; mi <= mo; ++mi)
#pragma unroll
        for (int s = 0; s < 2; ++s) Vn[mo] = MFMA32(load_perm(Ks + (32 * mo + n) * 72 + 32 * mi, s, h2), Rb[mi][s], Vn[mo]);
    }
    SCHED_FENCE();
    {
      bf16x8 Vb[2][2];
#pragma unroll
      for (int mi = 0; mi < 2; ++mi) { Vb[mi][0] = pack_acc(Vn[mi], 0); Vb[mi][1] = pack_acc(Vn[mi], 1); }
#pragma unroll
      for (int mo = 0; mo < 2; ++mo) {
#pragma unroll
        for (int mi = 0; mi <= mo; ++mi)
#pragma unroll
          for (int s = 0; s < 2; ++s) QS[mo] = MFMA32(load_perm(Qs + (32 * mo + n) * 72 + 32 * mi, s, h2), Vb[mi][s], QS[mo]);
      }
      __syncthreads();
#pragma unroll
      for (int mo = 0; mo < 2; ++mo)
#pragma unroll
        for (int r = 0; r < 16; ++r) vls[(32 * mo + crow(r, h2)) * 136 + n] = f2bf(QS[mo][r]);
      __syncthreads();
#pragma unroll
      for (int jv = 0; jv < 4; ++jv) {
        const int tau = (lane >> 2) + 16 * jv, cq = lane & 3;
        const uint4 oq = *(const uint4*)(vls + (dir ? 63 - tau : tau) * 136 + cq * 8);
        *(uint4*)(od + (size_t)(tb + tau) * 512 + h * 128 + w * 32 + cq * 8) = oq;
      }
    }
    SCHED_FENCE();
    bf16x8 Vsb[2][2];
#pragma unroll
    for (int mi = 0; mi < 2; ++mi) {
#pragma unroll
      for (int a = 0; a < 4; ++a) {
        const float4 g4 = *(const float4*)(gcl + 32 * mi + 8 * a + 4 * h2);
        Vn[mi][4 * a + 0] *= __expf(glast - g4.x); Vn[mi][4 * a + 1] *= __expf(glast - g4.y);
        Vn[mi][4 * a + 2] *= __expf(glast - g4.z); Vn[mi][4 * a + 3] *= __expf(glast - g4.w);
      }
      Vsb[mi][0] = pack_acc(Vn[mi], 0); Vsb[mi][1] = pack_acc(Vn[mi], 1);
    }
    const float eg = __expf(glast);
#pragma unroll
    for (int t = 0; t < 4; ++t) {
#pragma unroll
      for (int r = 0; r < 16; ++r) S[t][r] *= eg;
      const u16* ktrow = KTs + (32 * t + n) * 72;
#pragma unroll
      for (int mi = 0; mi < 2; ++mi)
#pragma unroll
        for (int s = 0; s < 2; ++s) {
          bf16x8 a = dir ? load_perm_rev(ktrow, 32 * mi, s, h2) : load_perm(ktrow + 32 * mi, s, h2);
          S[t] = MFMA32(a, Vsb[mi][s], S[t]);
        }
      SCHED_FENCE();
    }
  }
  if (seq < 32) {
    float* so = p.out + O_SD + ((size_t)((seq * 4 + l) * 2 + dir) * 4 + h) * 16384;
#pragma unroll
    for (int t = 0; t < 4; ++t)
#pragma unroll
      for (int r = 0; r < 16; ++r) so[(size_t)(32 * t + crow(r, h2)) * 128 + dvc] = S[t][r];
  }
}

DI void attn_tile(const Params& p, int seq, int head, int qb, u16* sm) {
  const int lane = otid() & 63, w = otid() >> 6;
  const int n = lane & 31, h2 = lane >> 5;
  int tq0, nkeys; size_t kbo, vto;
  if (seq < 32) { tq0 = seq * 256 + qb * 128 + w * 32; nkeys = 256; kbo = (size_t)(seq * 8 + head) * 256 * 96; vto = (size_t)(seq * 8 + head) * 64 * 256; }
  else { const int s = seq - 32; tq0 = TP_ + s * 2048 + qb * 128 + w * 32; nkeys = 2304; kbo = KB_P + (size_t)(s * 8 + head) * 2304 * 96; vto = VT_P + (size_t)(s * 8 + head) * 64 * 2304; }
  const u16* kb = (const u16*)(p.ws + B_KB) + kbo;
  const u16* vt = (const u16*)(p.ws + B_VT) + vto;
  const u16* qm = (const u16*)(p.ws + B_QM) + (size_t)(tq0 + n) * 768 + head * 96;
  bf16x8 qf[6];
#pragma unroll
  for (int ks = 0; ks < 6; ++ks) qf[ks] = *(const bf16x8*)(qm + ks * 16 + h2 * 8);
  f32x16 O[2];
#pragma unroll
  for (int r = 0; r < 16; ++r) { O[0][r] = 0.f; O[1][r] = 0.f; }
  float mrun = -1e30f, lsum = 0.f;
  const int nkt = nkeys >> 6;
  constexpr int KST = 104, VST = 72, STG = 64 * KST + 64 * VST;
  const int tid_ = otid();
  uint4 rk0, rk1, rk2, rv0, rv1;
  const int kc0 = tid_, kc1 = tid_ + 256, kc2 = tid_ + 512;
  const u16* kg0 = kb + (size_t)(kc0 / 12) * 96 + (kc0 % 12) * 8;
  const u16* kg1 = kb + (size_t)(kc1 / 12) * 96 + (kc1 % 12) * 8;
  const u16* kg2 = kb + (size_t)(kc2 / 12) * 96 + (kc2 % 12) * 8;
  const u16* vg0 = vt + (size_t)(tid_ >> 3) * nkeys + (tid_ & 7) * 8;
  const u16* vg1 = vt + (size_t)((tid_ + 256) >> 3) * nkeys + (tid_ & 7) * 8;
  const int kl0 = (kc0 / 12) * KST + (kc0 % 12) * 8, kl1 = (kc1 / 12) * KST + (kc1 % 12) * 8, kl2 = (kc2 / 12) * KST + (kc2 % 12) * 8;
  const int vl0 = (tid_ >> 3) * VST + (tid_ & 7) * 8, vl1 = ((tid_ + 256) >> 3) * VST + (tid_ & 7) * 8;
#define AT_GLOAD(kt_) do { rk0 = *(const uint4*)(kg0 + (size_t)(kt_) * 6144); rk1 = *(const uint4*)(kg1 + (size_t)(kt_) * 6144); \
    rk2 = *(const uint4*)(kg2 + (size_t)(kt_) * 6144); rv0 = *(const uint4*)(vg0 + (kt_) * 64); rv1 = *(const uint4*)(vg1 + (kt_) * 64); } while (0)
#define AT_SSTORE(st_) do { u16* ks2_ = sm + (st_) * STG; u16* vs2_ = ks2_ + 64 * KST; \
    *(uint4*)(ks2_ + kl0) = rk0; *(uint4*)(ks2_ + kl1) = rk1; *(uint4*)(ks2_ + kl2) = rk2; *(uint4*)(vs2_ + vl0) = rv0; *(uint4*)(vs2_ + vl1) = rv1; } while (0)
  __syncthreads();
  AT_GLOAD(0); AT_SSTORE(0);
  __syncthreads();
  for (int kt = 0; kt < nkt; ++kt) {
    const bool more = kt + 1 < nkt;
    if (more) AT_GLOAD(kt + 1);
    const u16* ks_ = sm + (kt & 1) * STG;
    const u16* vs_ = ks_ + 64 * KST;
    f32x16 St[2];
#pragma unroll
    for (int sub = 0; sub < 2; ++sub) {
#pragma unroll
      for (int r = 0; r < 16; ++r) St[sub][r] = 0.f;
      const u16* kr = ks_ + (sub * 32 + n) * KST + h2 * 8;
#pragma unroll
      for (int ks = 0; ks < 6; ++ks) St[sub] = MFMA32(*(const bf16x8*)(kr + ks * 16), qf[ks], St[sub]);
    }
    float mx = St[0][0];
#pragma unroll
    for (int r = 0; r < 16; ++r) { mx = fmaxf(mx, St[0][r]); mx = fmaxf(mx, St[1][r]); }
    mx = fmaxf(mx, __shfl_xor(mx, 32));
    const float mnew = fmaxf(mrun, mx);
    const float alpha = exp2f(mrun - mnew);
    mrun = mnew;
    float ps = 0.f;
#pragma unroll
    for (int sub = 0; sub < 2; ++sub)
#pragma unroll
      for (int r = 0; r < 16; ++r) { float e = exp2f(St[sub][r] - mnew); St[sub][r] = e; ps += e; }
    lsum = lsum * alpha + ps;
#pragma unroll
    for (int r = 0; r < 16; ++r) { O[0][r] *= alpha; O[1][r] *= alpha; }
#pragma unroll
    for (int sub = 0; sub < 2; ++sub)
#pragma unroll
      for (int s = 0; s < 2; ++s) {
        const bf16x8 pb = pack_acc(St[sub], s);
#pragma unroll
        for (int dt = 0; dt < 2; ++dt)
          O[dt] = MFMA32(load_perm(vs_ + (dt * 32 + n) * VST + sub * 32, s, h2), pb, O[dt]);
      }
    if (more) AT_SSTORE((kt + 1) & 1);
    __syncthreads();
  }
  lsum += __shfl_xor(lsum, 32);
  const float inv = 1.f / lsum;
  u16* oc = (u16*)(p.ws + B_OC) + (size_t)(tq0 + n) * 512 + head * 64;
#pragma unroll
  for (int dt = 0; dt < 2; ++dt)
#pragma unroll
    for (int a = 0; a < 4; ++a) {
      const int dv = dt * 32 + 8 * a + 4 * h2;
      *(uint2*)(oc + dv) = make_uint2(pack2(O[dt][4 * a] * inv, O[dt][4 * a + 1] * inv), pack2(O[dt][4 * a + 2] * inv, O[dt][4 * a + 3] * inv));
    }
}

DI void delta_out_tile(const Params& p, int l, int tile) {
  const int lane = otid() & 63, w = otid() >> 6;
  const u16* of = (const u16*)(p.ws + B_OF);
  const u16* ob = (const u16*)(p.ws + B_OB);
  const u16* z = (const u16*)(p.ws + B_Z);
  u16* oa = (u16*)(p.ws + B_OA);
  const float g0 = p.in[17][l * 128 + 2 * lane], g1 = p.in[17][l * 128 + 2 * lane + 1];
#pragma unroll 1
  for (int q = 0; q < 16; ++q) {
    const size_t t = (size_t)tile * 16 + w * 4 + (q >> 2);
    const int hh = q & 3;
    const size_t off = t * 512 + hh * 128 + 2 * lane;
    unsigned a = *(const unsigned*)(of + off), b = *(const unsigned*)(ob + off), zz = *(const unsigned*)(z + off);
    float o0 = blo(a) + blo(b), o1 = bhi(a) + bhi(b);
    float ss = wave_sum(o0 * o0 + o1 * o1);
    float rstd = rsqrtf(ss * (1.f / 128.f) + 1e-6f);
    float y0 = o0 * rstd * g0 * siluf_(blo(zz)), y1 = o1 * rstd * g1 * siluf_(bhi(zz));
    *(unsigned*)(oa + off) = pack2(y0, y1);
  }
}

DI void grid_barrier(unsigned* bar, unsigned target) {
  asm volatile("s_waitcnt vmcnt(0) lgkmcnt(0)" ::: "memory");
  __syncthreads();
  if (otid() == 0) {
    __builtin_amdgcn_fence(__ATOMIC_RELEASE, "agent");
    asm volatile("s_waitcnt vmcnt(0)" ::: "memory");
    __hip_atomic_fetch_add(bar, 1u, __ATOMIC_RELAXED, __HIP_MEMORY_SCOPE_AGENT);
    while (__hip_atomic_load(bar, __ATOMIC_RELAXED, __HIP_MEMORY_SCOPE_AGENT) < target) __builtin_amdgcn_s_sleep(5);
    __builtin_amdgcn_fence(__ATOMIC_ACQUIRE, "agent");
    asm volatile("s_waitcnt vmcnt(0)" ::: "memory");
  }
  __syncthreads();
}
#define GSYNC_FLAT() do { bar_target += gridDim.x; grid_barrier(p.bar, bar_target); } while (0)
DI unsigned xcc_id() { return (unsigned)__builtin_amdgcn_s_getreg((3 << 11) | 20) & 0xFu; }
DI void grid_barrier_xcd(unsigned* bar, unsigned xid, unsigned gen, unsigned xcnt, unsigned npres) {
  asm volatile("s_waitcnt vmcnt(0) lgkmcnt(0)" ::: "memory");
  __syncthreads();
  if (otid() == 0) {
    const unsigned old = __hip_atomic_fetch_add(bar + 64 + 32 * xid, 1u, __ATOMIC_RELAXED, __HIP_MEMORY_SCOPE_AGENT);
    if (old + 1 == gen * xcnt) {
      __builtin_amdgcn_fence(__ATOMIC_RELEASE, "agent");
      asm volatile("s_waitcnt vmcnt(0)" ::: "memory");
      __hip_atomic_fetch_add(bar + 32, 1u, __ATOMIC_RELAXED, __HIP_MEMORY_SCOPE_AGENT);
    }
    while (__hip_atomic_load(bar + 32, __ATOMIC_RELAXED, __HIP_MEMORY_SCOPE_AGENT) < gen * npres) __builtin_amdgcn_s_sleep(5);
    __builtin_amdgcn_fence(__ATOMIC_ACQUIRE, "agent");
    asm volatile("s_waitcnt vmcnt(0)" ::: "memory");
  }
  __syncthreads();
}
#define GSYNC() do { ++bar_gen; grid_barrier_xcd(p.bar, bx_id, bar_gen, bx_cnt, bx_np); } while (0)
#ifndef ONLY
#define PH(n) 1
#else
#define PH(n) ((n) == ONLY || (n) / 100 == ONLY || (n) == ONLY / 100)
#endif
__global__ void __launch_bounds__(256, 2) mega(Params p) {
  cg::grid_group grid = cg::this_grid();
  __shared__ __attribute__((aligned(16))) char smem_raw[73728];
  u16* sm = (u16*)smem_raw;
  float* smf = (float*)smem_raw;
  const int nb = gridDim.x, bid = blockIdx.x;
  unsigned bar_target = 0, bar_gen = 0;
  grid.sync();
  const unsigned bx_id = xcc_id() & 7u;
  unsigned bx_cnt = 1, bx_np = 1;
  {
    if (otid() == 0) __hip_atomic_fetch_add(p.bar + 16 + bx_id, 1u, __ATOMIC_RELAXED, __HIP_MEMORY_SCOPE_AGENT);
    GSYNC_FLAT();
    unsigned np = 0;
#pragma unroll
    for (unsigned x = 0; x < 8; ++x) {
      const unsigned c = __hip_atomic_load(p.bar + 16 + x, __ATOMIC_RELAXED, __HIP_MEMORY_SCOPE_AGENT);
      if (c > 0) ++np;
      if (x == bx_id) bx_cnt = c;
    }
    bx_np = np;
  }

  if (PH(0)) {
    const int tid = otid();
    for (int j = bid; j < 4 * CJ8; j += nb) conv_job(p, j / CJ8, j % CJ8, smf);
    for (int j = bid; j < 4 * 96; j += nb) mods_tile(p, j / 96, j % 96, smf);
    for (int j = bid; j < 64; j += nb) s5pre_tile(p, j);
    {
      const float4* xp = (const float4*)p.in[0];
      const float4* xs = (const float4*)p.in[1];
      float4* o = (float4*)p.out;
      const size_t nP = (size_t)TP_ * 256, nT = (size_t)T_ * 256;
      for (size_t i = (size_t)bid * 256 + tid; i < nT; i += (size_t)nb * 256) o[i] = i < nP ? xp[i] : xs[i - nP];
    }
    {
      float* rope = (float*)(p.ws + B_ROPE);
      for (int i = bid * 256 + tid; i < 2048 * 16; i += nb * 256) {
        const int pos = i >> 4, f = i & 15;
        const float invf = 1.f / powf(10000.f, (float)(f & 7) * 0.125f);
        const float ang = (f < 8 ? (float)(pos >> 6) : (float)(pos & 63)) * invf;
        float sn, cs;
        sincosf(ang, &sn, &cs);
        rope[i * 2] = cs; rope[i * 2 + 1] = sn;
      }
    }
    {
      u16* cc = (u16*)(p.ws + B_CKVC);
      for (int i = bid * 256 + tid; i < 8 * 4 * 256 * 256 / 2; i += nb * 256) {
        const int e = i * 2;
        const int c = e & 255, pos = (e >> 8) & 255, l = (e >> 16) & 3, b = e >> 18;
        float2 v = *(const float2*)(p.in[5] + e);
        *(unsigned*)(cc + ((size_t)(l * 2048 + b * 256 + pos)) * 256 + c) = pack2(v.x, v.y);
      }
    }
  }
  GSYNC();

  for (int l = 0; l < 4; ++l) {
    const u16* WL = (const u16*)(p.ws + B_W) + (size_t)l * W_LAYER;
    const float* mods = (const float*)(p.ws + B_MODS);
    if (PH(1)) norm_phase(p, l, 0, 1, p.in[11] + l * 1024);
    GSYNC();
    if (PH(2)) gemm_in_phase(p, l, sm);
    GSYNC();
    if (PH(3)) {
      for (int j = bid; j < NCH; j += nb) delta_prep_tile(p, l, j, sm);
      for (int j = bid; j < T_ / 4; j += nb) mla_prep_tile(p, l, j);
      for (int j = bid; j < 256; j += nb) cache_rope_tile(p, l, j);
      for (int j = bid; j < NCH * 16; j += nb) s5_chunk_tile(p, l, j >> 4, j & 15, 0, sm);
    }
    GSYNC();
    if (PH(4)) {
      const int tid = otid();
      if (PH(400)) for (int j = bid; j < NCH * 2; j += nb) delta_local_tile(p, j, smf);
      if (PH(410)) for (int j = bid; j < 192 * 6; j += nb) {
          const int q = j, mt = q / 6, nt = q % 6;
          f32x4 acc[4][4];
          zero_acc<4>(acc);
          gemm_core<4>(acc, (const u16*)(p.ws + B_QA) + (size_t)mt * 128 * 384, 384, WL + W_QB + (size_t)nt * 128 * 384, 384, 384, sm);
          u16* qm = (u16*)(p.ws + B_QM);
          const float qs = 0.10206207261596575f * 1.4426950408889634f;
          const float* rope = (const float*)(p.ws + B_ROPE);
          const int e_lane = tid & 63, e_w = tid >> 6, e_wr = e_w >> 1, e_wc = e_w & 1, e_fr = e_lane & 15, e_fq = e_lane >> 4;
          const bool is_s = (mt * 128 >= TP_);
#pragma unroll
          for (int i = 0; i < 4; ++i) {
            const int row = mt * 128 + e_wr * 64 + i * 16 + e_fr;
            f32x4 vals[4];
#pragma unroll
            for (int jj = 0; jj < 4; ++jj) vals[jj] = acc[i][jj];
            if (is_s) {
              const int pos = (row - TP_) & 2047;
              const float4 cs0 = *(const float4*)(rope + (size_t)(pos * 16 + e_fq * 4) * 2);
              const float4 cs1 = *(const float4*)(rope + (size_t)(pos * 16 + e_fq * 4) * 2 + 4);
              const float cs[4] = {cs0.x, cs0.z, cs1.x, cs1.z}, sn[4] = {cs0.y, cs0.w, cs1.y, cs1.w};
#pragma unroll
              for (int jj = 0; jj < 4; jj += 2) {
                const int gt = (nt * 128 + e_wc * 64) / 16 + jj;
                if (gt % 6 == 4) {
#pragma unroll
                  for (int r = 0; r < 4; ++r) {
                    const float x1 = vals[jj][r], x2 = vals[jj + 1][r];
                    vals[jj][r] = x1 * cs[r] - x2 * sn[r];
                    vals[jj + 1][r] = x2 * cs[r] + x1 * sn[r];
                  }
                }
              }
            }
#pragma unroll
            for (int jj = 0; jj < 4; ++jj) {
              f32x4 o; o[0] = vals[jj][0] * qs; o[1] = vals[jj][1] * qs; o[2] = vals[jj][2] * qs; o[3] = vals[jj][3] * qs;
              *(uint2*)(qm + (size_t)row * 768 + nt * 128 + e_wc * 64 + jj * 16 + e_fq * 4) = pack4(o);
            }
          }
      }
      if (PH(420)) for (int j = bid; j < 208 * 8; j += nb) {
          const int q = j, mt = q >> 3, head = q & 7;
          f32x4 acc[4][4];
          zero_acc<4>(acc);
          const u16* A = mt < 192 ? (const u16*)(p.ws + B_KVA) + (size_t)mt * 128 * 256
                                  : (const u16*)(p.ws + B_CKVC) + ((size_t)l * 2048 + (size_t)(mt - 192) * 128) * 256;
          gemm_core<4, false>(acc, A, 256, WL + W_KVB + (size_t)head * 128 * 256, 256, 256, sm);
          int key0, nkeys; size_t kbo, vto;
          if (mt < 64) { const int seq = mt >> 1; key0 = (mt & 1) * 128; nkeys = 256; kbo = (size_t)(seq * 8 + head) * 256 * 96; vto = (size_t)(seq * 8 + head) * 64 * 256; }
          else if (mt < 192) { const int s = (mt - 64) >> 4; key0 = 256 + ((mt - 64) & 15) * 128; nkeys = 2304; kbo = KB_P + (size_t)(s * 8 + head) * 2304 * 96; vto = VT_P + (size_t)(s * 8 + head) * 64 * 2304; }
          else { const int s = (mt - 192) >> 1; key0 = ((mt - 192) & 1) * 128; nkeys = 2304; kbo = KB_P + (size_t)(s * 8 + head) * 2304 * 96; vto = VT_P + (size_t)(s * 8 + head) * 64 * 2304; }
          u16* kb = (u16*)(p.ws + B_KB) + kbo;
          u16* vt = (u16*)(p.ws + B_VT) + vto;
          const int e_lane = tid & 63, e_w = tid >> 6, e_wr = e_w >> 1, e_wc = e_w & 1, e_fr = e_lane & 15, e_fq = e_lane >> 4;
#pragma unroll
          for (int i = 0; i < 4; ++i)
#pragma unroll
            for (int jj = 0; jj < 4; ++jj) {
              const int key = key0 + e_wr * 64 + i * 16 + e_fq * 4;
              const int c = jj * 16 + e_fr;
              if (e_wc == 0) {
#pragma unroll
                for (int r = 0; r < 4; ++r) kb[(size_t)(key + r) * 96 + c] = f2bf(acc[i][jj][r]);
              } else {
                *(uint2*)(vt + (size_t)c * nkeys + key) = make_uint2(pack2(acc[i][jj][0], acc[i][jj][1]), pack2(acc[i][jj][2], acc[i][jj][3]));
              }
            }
      }
      if (PH(430)) for (int j = bid; j < 640; j += nb) s5_carry_tile(p, l, j);
    }
    GSYNC();
    if (PH(5)) {
      if (PH(500)) for (int j = bid; j < 320; j += nb) delta_scan_tile(p, l, j, sm);
      if (PH(510)) for (int j = bid; j < 1536; j += nb) {
        if (j < 1024) attn_tile(p, 32 + (j >> 7), (j >> 4) & 7, j & 15, sm);
        else { const int q = j - 1024; attn_tile(p, q >> 4, (q >> 1) & 7, q & 1, sm); }
      }
      if (PH(530)) for (int j = bid; j < NCH * 8; j += nb) {
        s5_chunk_tile(p, l, j >> 3, (j & 7) * 2, 1, sm);
        s5_chunk_tile(p, l, j >> 3, (j & 7) * 2 + 1, 1, sm);
      }
    }
    GSYNC();
    if (PH(6)) {
      for (int j = bid; j < T_ / 16; j += nb) delta_out_tile(p, l, j);
      for (int j = bid; j < 192 * 4; j += nb) {
        {
          const int q = j, mt = q >> 2, nt = q & 3;
          f32x4 acc[4][4];
          zero_acc<4>(acc);
          const u16* y5 = (const u16*)(p.ws + B_Y5);
          gemm_core<4>(acc, y5 + (size_t)mt * 128 * 512, 512, WL + W_GLU + (size_t)nt * 128 * 512, 512, 512, sm);
          u16* ob5 = (u16*)(p.ws + B_OB5);
          const float* bgl = p.in[27] + l * 512;
          EPI_LOOP(4) {
            const size_t row = mt * 128 + EROW; const int col = nt * 128 + ECOL4(4);
            const uint2 yy = *(const uint2*)(y5 + row * 512 + col);
            const float4 bb = *(const float4*)(bgl + col);
            f32x4 o;
            o[0] = blo(yy.x) * sigmoidf_(acc[i][j][0] + bb.x); o[1] = bhi(yy.x) * sigmoidf_(acc[i][j][1] + bb.y);
            o[2] = blo(yy.y) * sigmoidf_(acc[i][j][2] + bb.z); o[3] = bhi(yy.y) * sigmoidf_(acc[i][j][3] + bb.w);
            *(uint2*)(ob5 + row * 512 + col) = pack4(o);
          }
        }
      }
    }
    GSYNC();
    if (PH(7)) {
      const u16* H = (const u16*)(p.ws + B_H);
      u16* mg = (u16*)(p.ws + B_MG);
      for (int j = bid; j < 192 * 16; j += nb) {
        const int mt = j >> 4, nt = j & 15;
        f32x4 mer[4][2];
        zero_acc<2>(mer);
#pragma unroll 1
        for (int n = 0; n < 3; ++n) {
          f32x4 ag[4][2], ab[4][2];
          zero_acc<2>(ag);
          gemm_core<2>(ag, H + (size_t)mt * 128 * 1024, 1024, WL + W_G + (size_t)(n * 1024 + nt * 64) * 1024, 1024, 1024, sm);
          zero_acc<2>(ab);
          const u16* on = (const u16*)(p.ws + (n == 0 ? B_OA : (n == 1 ? B_OB5 : B_OC)));
          gemm_core<2>(ab, on + (size_t)mt * 128 * 512, 512, WL + W_BR + (size_t)(nt * 64) * 1536 + n * 512, 1536, 512, sm);
#pragma unroll
          for (int i = 0; i < 4; ++i)
#pragma unroll
            for (int jj = 0; jj < 2; ++jj)
#pragma unroll
              for (int r = 0; r < 4; ++r) mer[i][jj][r] += sigmoidf_(ag[i][jj][r]) * ab[i][jj][r];
        }
        EPI_LOOP(2) { *(uint2*)(mg + (size_t)(mt * 128 + EROW) * 1024 + nt * 64 + ECOL4(2)) = pack4(mer[i][j]); }
      }
    }
    GSYNC();
    if (PH(8)) {
      const u16* mg = (const u16*)(p.ws + B_MG);
      for (int j = bid; j < 192 * 8; j += nb) {
        const int mt = j >> 3, nt = j & 7;
        f32x4 acc[4][4];
        zero_acc<4>(acc);
        gemm_core<4>(acc, mg + (size_t)mt * 128 * 1024, 1024, WL + W_OUT + (size_t)nt * 128 * 1024, 1024, 1024, sm);
        const float* gm = mods + (size_t)(l * 9 + tok_v(mt * 128)) * 6144 + 2 * 1024;
        EPI_LOOP(4) {
          const size_t row = mt * 128 + EROW; const int col = nt * 128 + ECOL4(4);
          float4* xp_ = (float4*)(p.out + row * 1024 + col);
          float4 xv = *xp_; const float4 gg = *(const float4*)(gm + col);
          xv.x += gg.x * acc[i][j][0]; xv.y += gg.y * acc[i][j][1]; xv.z += gg.z * acc[i][j][2]; xv.w += gg.w * acc[i][j][3];
          *xp_ = xv;
        }
      }
    }
    GSYNC();
    if (PH(9)) norm_phase(p, l, 3, 4, p.in[12] + l * 1024);
    GSYNC();
    if (PH(10)) {
      const u16* H = (const u16*)(p.ws + B_H);
      u16* up = (u16*)(p.ws + B_UP);
      for (int j = bid; j < 192 * 44; j += nb) {
        const int mt = j / 44, nt = j % 44;
        f32x4 acc[4][4];
        zero_acc<4>(acc);
        gemm_core<4>(acc, H + (size_t)mt * 128 * 1024, 1024, WL + W_UP + (size_t)nt * 128 * 1024, 1024, 1024, sm);
        EPI_LOOP(4) { *(uint2*)(up + (size_t)(mt * 128 + EROW) * 5632 + nt * 128 + ECOL4(4)) = pack4(acc[i][j]); }
      }
    }
    GSYNC();
    if (PH(11)) {
      const int tid = otid();
      const u16* up = (const u16*)(p.ws + B_UP);
      u16* act = (u16*)(p.ws + B_ACT);
      const float* cw = p.in[35] + (size_t)l * 3 * 5632;
      const float* cb = p.in[36] + (size_t)l * 5632;
      constexpr int TG = 16;
      for (int it = bid * 256 + tid; it < (T_ / TG) * 352; it += nb * 256) {
        const int t0 = (it / 352) * TG, c8 = (it % 352) * 8;
        int pos0, L;
        if (t0 < TP_) { pos0 = t0 & 255; L = 256; } else { pos0 = (t0 - TP_) & 2047; L = 2048; }
        float wg[3][8], wv[3][8], bgv[8], bvv[8];
#pragma unroll
        for (int d = 0; d < 3; ++d) {
          const float4 g0 = *(const float4*)(cw + d * 5632 + c8), g1 = *(const float4*)(cw + d * 5632 + c8 + 4);
          const float4 v0 = *(const float4*)(cw + d * 5632 + 2816 + c8), v1 = *(const float4*)(cw + d * 5632 + 2816 + c8 + 4);
          wg[d][0] = g0.x; wg[d][1] = g0.y; wg[d][2] = g0.z; wg[d][3] = g0.w; wg[d][4] = g1.x; wg[d][5] = g1.y; wg[d][6] = g1.z; wg[d][7] = g1.w;
          wv[d][0] = v0.x; wv[d][1] = v0.y; wv[d][2] = v0.z; wv[d][3] = v0.w; wv[d][4] = v1.x; wv[d][5] = v1.y; wv[d][6] = v1.z; wv[d][7] = v1.w;
        }
        {
          const float4 g0 = *(const float4*)(cb + c8), g1 = *(const float4*)(cb + c8 + 4);
          const float4 v0 = *(const float4*)(cb + 2816 + c8), v1 = *(const float4*)(cb + 2816 + c8 + 4);
          bgv[0] = g0.x; bgv[1] = g0.y; bgv[2] = g0.z; bgv[3] = g0.w; bgv[4] = g1.x; bgv[5] = g1.y; bgv[6] = g1.z; bgv[7] = g1.w;
          bvv[0] = v0.x; bvv[1] = v0.y; bvv[2] = v0.z; bvv[3] = v0.w; bvv[4] = v1.x; bvv[5] = v1.y; bvv[6] = v1.z; bvv[7] = v1.w;
        }
        uint4 g0r = make_uint4(0, 0, 0, 0), v0r = g0r, g1r, v1r, g2r, v2r;
        if (pos0 > 0) { const u16* rp = up + (size_t)(t0 - 1) * 5632; g0r = *(const uint4*)(rp + c8); v0r = *(const uint4*)(rp + 2816 + c8); }
        { const u16* rp = up + (size_t)t0 * 5632; g1r = *(const uint4*)(rp + c8); v1r = *(const uint4*)(rp + 2816 + c8); }
#pragma unroll 4
        for (int o = 0; o < TG; ++o) {
          g2r = make_uint4(0, 0, 0, 0); v2r = g2r;
          if (pos0 + o + 1 < L) { const u16* rp = up + (size_t)(t0 + o + 1) * 5632; g2r = *(const uint4*)(rp + c8); v2r = *(const uint4*)(rp + 2816 + c8); }
          const unsigned ga[3][4] = {{g0r.x, g0r.y, g0r.z, g0r.w}, {g1r.x, g1r.y, g1r.z, g1r.w}, {g2r.x, g2r.y, g2r.z, g2r.w}};
          const unsigned va[3][4] = {{v0r.x, v0r.y, v0r.z, v0r.w}, {v1r.x, v1r.y, v1r.z, v1r.w}, {v2r.x, v2r.y, v2r.z, v2r.w}};
          float res[8];
#pragma unroll
          for (int e = 0; e < 8; ++e) {
            float g = bgv[e], v = bvv[e];
#pragma unroll
            for (int d = 0; d < 3; ++d) {
              const float xg = (e & 1) ? bhi(ga[d][e >> 1]) : blo(ga[d][e >> 1]);
              const float xv = (e & 1) ? bhi(va[d][e >> 1]) : blo(va[d][e >> 1]);
              g += wg[d][e] * xg; v += wv[d][e] * xv;
            }
            res[e] = siluf_(g) * v;
          }
          *(uint4*)(act + (size_t)(t0 + o) * 2816 + c8) = make_uint4(pack2(res[0], res[1]), pack2(res[2], res[3]), pack2(res[4], res[5]), pack2(res[6], res[7]));
          g0r = g1r; v0r = v1r; g1r = g2r; v1r = v2r;
        }
      }
    }
    GSYNC();
    if (PH(12)) {
      const u16* act = (const u16*)(p.ws + B_ACT);
      for (int j = bid; j < 192 * 8; j += nb) {
        const int mt = j >> 3, nt = j & 7;
        f32x4 acc[4][4];
        zero_acc<4>(acc);
        gemm_core<4>(acc, act + (size_t)mt * 128 * 2816, 2816, WL + W_DN + (size_t)nt * 128 * 2816, 2816, 2816, sm);
        const float* gf = mods + (size_t)(l * 9 + tok_v(mt * 128)) * 6144 + 5 * 1024;
        EPI_LOOP(4) {
          const size_t row = mt * 128 + EROW; const int col = nt * 128 + ECOL4(4);
          float4* xp_ = (float4*)(p.out + row * 1024 + col);
          float4 xv = *xp_; const float4 gg = *(const float4*)(gf + col);
          xv.x += gg.x * acc[i][j][0]; xv.y += gg.y * acc[i][j][1]; xv.z += gg.z * acc[i][j][2]; xv.w += gg.w * acc[i][j][3];
          *xp_ = xv;
        }
      }
    }
    GSYNC();
  }
  if (PH(13)) {
    const int tid = otid();
    const int lane = tid & 63, w = tid >> 6;
    const float* gfin = p.in[38];
    for (int tile = bid; tile < T_ / 4; tile += nb) {
      const int t = tile * 4 + w;
      float4* xr = (float4*)(p.out + (size_t)t * 1024);
      float4 v[4];
      float ss = 0.f;
#pragma unroll
      for (int j = 0; j < 4; ++j) { v[j] = xr[lane + 64 * j]; ss += v[j].x * v[j].x + v[j].y * v[j].y + v[j].z * v[j].z + v[j].w * v[j].w; }
      ss = wave_sum(ss);
      const float rstd = rsqrtf(ss * (1.f / 1024.f) + 1e-6f);
#pragma unroll
      for (int j = 0; j < 4; ++j) {
        float4 g = *(const float4*)(gfin + (lane + 64 * j) * 4);
        xr[lane + 64 * j] = make_float4(v[j].x * rstd * g.x, v[j].y * rstd * g.y, v[j].z * rstd * g.z, v[j].w * rstd * g.w);
      }
    }
  }
}

extern "C" void kernel_launch(void* const* d_in, const int* in_sizes, int n_in, void* d_out, int out_size,
                              void* d_ws, size_t ws_size, hipStream_t stream) {
  static int grid_blocks = 0;
  if (!grid_blocks) {
    int dev = 0, cus = 0, per_cu = 0;
    (void)hipGetDevice(&dev);
    (void)hipDeviceGetAttribute(&cus, hipDeviceAttributeMultiprocessorCount, dev);
    (void)hipOccupancyMaxActiveBlocksPerMultiprocessor(&per_cu, mega, 256, 0);
    if (per_cu > 2) per_cu = 2;
    if (per_cu < 1) per_cu = 1;
    grid_blocks = cus * per_cu;
  }
  if (ws_size < B_TOTAL || n_in < 39) {
    fprintf(stderr, "workspace too small: %zu < %zu\n", ws_size, (size_t)B_END);
    return;
  }
  Params p{};
  for (int i = 0; i < 39; ++i) p.in[i] = (const float*)d_in[i];
  p.out = (float*)d_out;
  p.ws = (char*)d_ws;
  p.bar = (unsigned*)((char*)d_ws + B_BAR);
  (void)hipMemsetAsync(p.bar, 0, 4096, stream);
  void* args[] = {&p};
  hipError_t e = hipLaunchCooperativeKernel((void*)mega, dim3(grid_blocks), dim3(256), args, 0, stream);
  if (e != hipSuccess) fprintf(stderr, "cooperative launch failed: %s (grid %d)\n", hipGetErrorString(e), grid_blocks);
}
```

```cpp
#include <hip/hip_runtime.h>
#include <hip/hip_cooperative_groups.h>
#include <cstdio>
namespace cg = cooperative_groups;

#define DI __device__ __forceinline__
typedef __bf16 bf16;
using bf16x8 = __attribute__((ext_vector_type(8))) short;
using f32x4 = __attribute__((ext_vector_type(4))) float;
using f32x16 = __attribute__((ext_vector_type(16))) float;
typedef unsigned short u16;

constexpr int T_ = 24576, TP_ = 8192;
constexpr int NCH = 384;
constexpr long long O_SD = 25165824LL, O_S5RE = 41943040LL, O_S5IM = 42467328LL, O_CKV = 42991616LL, O_KR = 51380224LL;

constexpr size_t W_IN = 0;
constexpr size_t W_G = W_IN + 3328ull * 1024;
constexpr size_t W_QB = W_G + 3072ull * 1024;
constexpr size_t W_KVB = W_QB + 768ull * 384;
constexpr size_t W_GLU = W_KVB + 1024ull * 256;
constexpr size_t W_BR = W_GLU + 512ull * 512;
constexpr size_t W_OUT = W_BR + 1024ull * 1536;
constexpr size_t W_UP = W_OUT + 1024ull * 1024;
constexpr size_t W_DN = W_UP + 5632ull * 1024;
constexpr size_t W_LAYER = W_DN + 1024ull * 2816;

constexpr size_t al(size_t x) { return (x + 255) & ~(size_t)255; }
constexpr size_t B_W = 0;
constexpr size_t B_MODS = al(B_W + 4 * W_LAYER * 2);
constexpr size_t B_ROPE = al(B_MODS + 4ull * 9 * 6144 * 4);
constexpr size_t B_LAMB = al(B_ROPE + 2048ull * 32 * 4);
constexpr size_t B_LAM64 = al(B_LAMB + 4ull * 2 * 32 * 64 * 8);
constexpr size_t B_BBT = al(B_LAM64 + 4ull * 2 * 32 * 64 * 8);
constexpr size_t B_CMT = al(B_BBT + 4ull * 2 * 32 * 128 * 16 * 2);
constexpr size_t B_CKVC = al(B_CMT + 4ull * 32 * 16 * 128 * 2);
constexpr size_t B_H = al(B_CKVC + 4ull * 2048 * 256 * 2);
constexpr size_t B_QKV = al(B_H + (size_t)T_ * 1024 * 2);
constexpr size_t B_Z = al(B_QKV + (size_t)T_ * 1536 * 2);
constexpr size_t B_US5 = al(B_Z + (size_t)T_ * 512 * 2);
constexpr size_t B_QA = al(B_US5 + (size_t)T_ * 512 * 2);
constexpr size_t B_KVA = al(B_QA + (size_t)T_ * 384 * 2);
constexpr size_t B_MISC = al(B_KVA + (size_t)T_ * 256 * 2);
constexpr size_t B_QN = al(B_MISC + (size_t)T_ * 48 * 4);
constexpr size_t B_KN = al(B_QN + (size_t)T_ * 512 * 2);
constexpr size_t B_VV = al(B_KN + (size_t)T_ * 512 * 2);
constexpr size_t B_KT = al(B_VV + (size_t)T_ * 512 * 2);
constexpr size_t B_BG = al(B_KT + (size_t)T_ * 512 * 2);
constexpr size_t B_TM = al(B_BG + (size_t)T_ * 16 * 4);
constexpr size_t B_QKM = al(B_TM + (size_t)T_ * 512 * 2);
constexpr size_t B_GC = al(B_QKM + (size_t)T_ * 512 * 2);
constexpr size_t B_BC = al(B_GC + (size_t)NCH * 4 * 2 * 64 * 4);
constexpr size_t KB_P = 32ull * 8 * 256 * 96, KB_S = 8ull * 8 * 2304 * 96;
constexpr size_t VT_P = 32ull * 8 * 64 * 256, VT_S = 8ull * 8 * 64 * 2304;
constexpr size_t B_KB = al(B_BC + (size_t)NCH * 4 * 2 * 64 * 4);
constexpr size_t B_VT = al(B_KB + (KB_P + KB_S) * 2);
constexpr size_t B_QM = al(B_VT + (VT_P + VT_S) * 2);
constexpr size_t B_HEND = al(B_QM + (size_t)T_ * 768 * 2);
constexpr size_t B_HIN = al(B_HEND + (size_t)NCH * 32 * 2 * 64 * 8);
constexpr size_t B_Y5 = al(B_HIN + (size_t)NCH * 32 * 2 * 64 * 8);
constexpr size_t B_OC = al(B_Y5 + (size_t)T_ * 512 * 2);
constexpr size_t B_END = al(B_OC + (size_t)T_ * 512 * 2);
constexpr size_t B_OF = B_QKV;
constexpr size_t B_OB = B_QKV + (size_t)T_ * 512 * 2;
constexpr size_t B_MG = B_QKV;
constexpr size_t B_OA = B_QN;
constexpr size_t B_OB5 = B_KN;
constexpr size_t B_UP = B_QKV;
constexpr size_t B_ACT = B_KB;
static_assert(B_UP + (size_t)T_ * 5632 * 2 <= B_KB, "UP overlaps ACT");
static_assert(B_ACT + (size_t)T_ * 2816 * 2 <= B_END, "ACT too big");
constexpr size_t B_BAR = B_END;
constexpr size_t B_TOTAL = B_BAR + 4096;
static_assert(B_TOTAL <= 768ull * 1024 * 1024, "workspace too big");

struct Params {
  const float* in[39];
  float* out;
  char* ws;
  unsigned* bar;
};

DI int otid() { int t = (int)__builtin_amdgcn_workitem_id_x(); asm volatile("" : "+v"(t)); return t; }
DI unsigned pack2(float a, float b) {
  typedef __attribute__((ext_vector_type(2))) __bf16 bf2;
  bf2 v; v[0] = (__bf16)a; v[1] = (__bf16)b;
  return __builtin_bit_cast(unsigned, v);
}
DI u16 f2bf(float a) { return (u16)(pack2(a, 0.f) & 0xffffu); }
DI float bf2f(u16 u) { return __uint_as_float(((unsigned)u) << 16); }
DI float blo(unsigned u) { return __uint_as_float(u << 16); }
DI float bhi(unsigned u) { return __uint_as_float(u & 0xffff0000u); }
DI float wave_sum(float v) {
#pragma unroll
  for (int o = 32; o > 0; o >>= 1) v += __shfl_xor(v, o);
  return v;
}
DI float sigmoidf_(float x) { return 1.f / (1.f + __expf(-x)); }
DI float siluf_(float x) { return x / (1.f + __expf(-x)); }
DI int tok_v(int t) { return t < TP_ ? 0 : 1 + ((t - TP_) >> 11); }
DI int crow(int r, int h2) { return (r & 3) + 8 * (r >> 2) + 4 * h2; }
DI bf16x8 mk8(unsigned a, unsigned b, unsigned c, unsigned d) {
  uint4 p = make_uint4(a, b, c, d);
  return __builtin_bit_cast(bf16x8, p);
}
DI bf16x8 pack_acc(const f32x16& x, int s) {
  return mk8(pack2(x[8 * s], x[8 * s + 1]), pack2(x[8 * s + 2], x[8 * s + 3]), pack2(x[8 * s + 4], x[8 * s + 5]),
             pack2(x[8 * s + 6], x[8 * s + 7]));
}
DI bf16x8 load_perm(const u16* rowptr, int s, int h2) {
  uint2 a = *(const uint2*)(rowptr + 16 * s + 4 * h2);
  uint2 b = *(const uint2*)(rowptr + 16 * s + 8 + 4 * h2);
  return mk8(a.x, a.y, b.x, b.y);
}
DI unsigned swap16(unsigned u) { return (u >> 16) | (u << 16); }
DI bf16x8 load_perm_rev(const u16* rowptr, int base, int s, int h2) {
  uint2 a = *(const uint2*)(rowptr + 60 - base - 16 * s - 4 * h2);
  uint2 b = *(const uint2*)(rowptr + 52 - base - 16 * s - 4 * h2);
  return mk8(swap16(a.y), swap16(a.x), swap16(b.y), swap16(b.x));
}
#define MFMA16(a, b, c) __builtin_amdgcn_mfma_f32_16x16x32_bf16((a), (b), (c), 0, 0, 0)
#define MFMA32(a, b, c) __builtin_amdgcn_mfma_f32_32x32x16_bf16((a), (b), (c), 0, 0, 0)

template <int NJ, bool SWAP = true>
DI void gemm_core(f32x4 (&acc)[4][NJ], const u16* __restrict__ A, int lda, const u16* __restrict__ B, int ldb, int K,
                  u16* sm) {
  const int tid = otid(), lane = tid & 63, w = tid >> 6, wr = w >> 1, wc = w & 1;
  const int fr = lane & 15, fq = lane >> 4;
  constexpr int RS = 136;
  const int lrow = tid >> 4, lkc = tid & 15;
  uint4 a0, a1, a2, a3, a4, a5, a6, a7, b0, b1, b2, b3, b4, b5, b6, b7;
  b4 = b5 = b6 = b7 = make_uint4(0, 0, 0, 0);
  const u16* ap = A + (size_t)lrow * lda + lkc * 8;
  const u16* bp = B + (size_t)lrow * ldb + lkc * 8;
  const int nk = K >> 7;
  u16* as = sm;
  u16* bs = sm + 128 * RS;
  {
    const int k0 = 0;
    a0 = *(const uint4*)(ap + (size_t)(0 * 16) * lda + k0);
    a1 = *(const uint4*)(ap + (size_t)(1 * 16) * lda + k0);
    a2 = *(const uint4*)(ap + (size_t)(2 * 16) * lda + k0);
    a3 = *(const uint4*)(ap + (size_t)(3 * 16) * lda + k0);
    a4 = *(const uint4*)(ap + (size_t)(4 * 16) * lda + k0);
    a5 = *(const uint4*)(ap + (size_t)(5 * 16) * lda + k0);
    a6 = *(const uint4*)(ap + (size_t)(6 * 16) * lda + k0);
    a7 = *(const uint4*)(ap + (size_t)(7 * 16) * lda + k0);
    b0 = *(const uint4*)(bp + (size_t)(0 * 16) * ldb + k0);
    b1 = *(const uint4*)(bp + (size_t)(1 * 16) * ldb + k0);
    b2 = *(const uint4*)(bp + (size_t)(2 * 16) * ldb + k0);
    b3 = *(const uint4*)(bp + (size_t)(3 * 16) * ldb + k0);
    if (NJ == 4) b4 = *(const uint4*)(bp + (size_t)(4 * 16) * ldb + k0);
    if (NJ == 4) b5 = *(const uint4*)(bp + (size_t)(5 * 16) * ldb + k0);
    if (NJ == 4) b6 = *(const uint4*)(bp + (size_t)(6 * 16) * ldb + k0);
    if (NJ == 4) b7 = *(const uint4*)(bp + (size_t)(7 * 16) * ldb + k0);
  }
  for (int kt = 0; kt < nk; ++kt) {
    __syncthreads();
    *(uint4*)(as + (lrow + 0 * 16) * RS + lkc * 8) = a0;
    *(uint4*)(as + (lrow + 1 * 16) * RS + lkc * 8) = a1;
    *(uint4*)(as + (lrow + 2 * 16) * RS + lkc * 8) = a2;
    *(uint4*)(as + (lrow + 3 * 16) * RS + lkc * 8) = a3;
    *(uint4*)(as + (lrow + 4 * 16) * RS + lkc * 8) = a4;
    *(uint4*)(as + (lrow + 5 * 16) * RS + lkc * 8) = a5;
    *(uint4*)(as + (lrow + 6 * 16) * RS + lkc * 8) = a6;
    *(uint4*)(as + (lrow + 7 * 16) * RS + lkc * 8) = a7;
    *(uint4*)(bs + (lrow + 0 * 16) * RS + lkc * 8) = b0;
    *(uint4*)(bs + (lrow + 1 * 16) * RS + lkc * 8) = b1;
    *(uint4*)(bs + (lrow + 2 * 16) * RS + lkc * 8) = b2;
    *(uint4*)(bs + (lrow + 3 * 16) * RS + lkc * 8) = b3;
    if (NJ == 4) *(uint4*)(bs + (lrow + 4 * 16) * RS + lkc * 8) = b4;
    if (NJ == 4) *(uint4*)(bs + (lrow + 5 * 16) * RS + lkc * 8) = b5;
    if (NJ == 4) *(uint4*)(bs + (lrow + 6 * 16) * RS + lkc * 8) = b6;
    if (NJ == 4) *(uint4*)(bs + (lrow + 7 * 16) * RS + lkc * 8) = b7;
    __syncthreads();
    {
      const int k0 = (kt + 1 < nk ? kt + 1 : kt) * 128;
    a0 = *(const uint4*)(ap + (size_t)(0 * 16) * lda + k0);
    a1 = *(const uint4*)(ap + (size_t)(1 * 16) * lda + k0);
    a2 = *(const uint4*)(ap + (size_t)(2 * 16) * lda + k0);
    a3 = *(const uint4*)(ap + (size_t)(3 * 16) * lda + k0);
    a4 = *(const uint4*)(ap + (size_t)(4 * 16) * lda + k0);
    a5 = *(const uint4*)(ap + (size_t)(5 * 16) * lda + k0);
    a6 = *(const uint4*)(ap + (size_t)(6 * 16) * lda + k0);
    a7 = *(const uint4*)(ap + (size_t)(7 * 16) * lda + k0);
    b0 = *(const uint4*)(bp + (size_t)(0 * 16) * ldb + k0);
    b1 = *(const uint4*)(bp + (size_t)(1 * 16) * ldb + k0);
    b2 = *(const uint4*)(bp + (size_t)(2 * 16) * ldb + k0);
    b3 = *(const uint4*)(bp + (size_t)(3 * 16) * ldb + k0);
    if (NJ == 4) b4 = *(const uint4*)(bp + (size_t)(4 * 16) * ldb + k0);
    if (NJ == 4) b5 = *(const uint4*)(bp + (size_t)(5 * 16) * ldb + k0);
    if (NJ == 4) b6 = *(const uint4*)(bp + (size_t)(6 * 16) * ldb + k0);
    if (NJ == 4) b7 = *(const uint4*)(bp + (size_t)(7 * 16) * ldb + k0);
    }
    __builtin_amdgcn_s_setprio(1);
#pragma unroll
    for (int ks = 0; ks < 4; ++ks) {
      bf16x8 af[4], bfr[NJ];
#pragma unroll
      for (int i = 0; i < 4; ++i) af[i] = *(const bf16x8*)(as + (wr * 64 + i * 16 + fr) * RS + ks * 32 + fq * 8);
#pragma unroll
      for (int j = 0; j < NJ; ++j) bfr[j] = *(const bf16x8*)(bs + (wc * NJ * 16 + j * 16 + fr) * RS + ks * 32 + fq * 8);
#pragma unroll
      for (int i = 0; i < 4; ++i)
#pragma unroll
        for (int j = 0; j < NJ; ++j) acc[i][j] = SWAP ? MFMA16(bfr[j], af[i], acc[i][j]) : MFMA16(af[i], bfr[j], acc[i][j]);
    }
    __builtin_amdgcn_s_setprio(0);
  }
}
template <int NJ>
DI void zero_acc(f32x4 (&acc)[4][NJ]) {
#pragma unroll
  for (int i = 0; i < 4; ++i)
#pragma unroll
    for (int j = 0; j < NJ; ++j) acc[i][j] = f32x4{0.f, 0.f, 0.f, 0.f};
}
#define EPI_LOOP(NJ_)                                                              \
  const int e_lane = otid() & 63, e_w = otid() >> 6;                               \
  const int e_wr = e_w >> 1, e_wc = e_w & 1, e_fr = e_lane & 15, e_fq = e_lane >> 4; \
  _Pragma("unroll") for (int i = 0; i < 4; ++i)                                    \
  _Pragma("unroll") for (int j = 0; j < NJ_; ++j)
#define EROW (e_wr * 64 + i * 16 + e_fr)
#define ECOL4(NJ_) (e_wc * NJ_ * 16 + j * 16 + e_fq * 4)
DI uint2 pack4(const f32x4& v) { return make_uint2(pack2(v[0], v[1]), pack2(v[2], v[3])); }

DI int colmap(int kind, int n) {
  if (kind == 0) {
    if (n < 2048) return n;
    if (n < 2560) return 2064 + (n - 2048);
    if (n < 2944) return 2576 + (n - 2560);
    if (n < 3200) return 2960 + (n - 2944);
    int j = n - 3200;
    if (j < 16) return 2048 + j;
    if (j < 48) return 3216 + (j - 16);
    return -1;
  }
  if (kind == 1) return 3248 + n;
  return n;
}
DI void convT_tile(const float* __restrict__ src, int lds, int K, u16* __restrict__ dst, int kind, int kt, int nt,
                   float* sm) {
  const int tid = otid();
  const int c = tid & 63;
  const int sc = colmap(kind, nt * 64 + c);
  __syncthreads();
#pragma unroll 4
  for (int i = 0; i < 16; ++i) {
    int r = (tid >> 6) + i * 4;
    float v = sc >= 0 ? src[(size_t)(kt * 64 + r) * lds + sc] : 0.f;
    sm[r * 65 + c] = v;
  }
  __syncthreads();
  const int n = tid >> 2, kq = tid & 3;
  unsigned pk[8];
#pragma unroll
  for (int j = 0; j < 8; ++j) pk[j] = pack2(sm[(kq * 16 + 2 * j) * 65 + n], sm[(kq * 16 + 2 * j + 1) * 65 + n]);
  u16* d = dst + (size_t)(nt * 64 + n) * K + kt * 64 + kq * 16;
  *(uint4*)d = make_uint4(pk[0], pk[1], pk[2], pk[3]);
  *(uint4*)(d + 8) = make_uint4(pk[4], pk[5], pk[6], pk[7]);
}
constexpr int CJ0 = 16 * 52, CJ1 = CJ0 + 16 * 48, CJ2 = CJ1 + 6 * 12, CJ3 = CJ2 + 4 * 16, CJ4 = CJ3 + 8 * 8,
              CJ5 = CJ4 + 24 * 16, CJ6 = CJ5 + 16 * 16, CJ7 = CJ6 + 16 * 88, CJ8 = CJ7 + 44 * 16;
DI void conv_job(const Params& p, int l, int j, float* sm) {
  u16* wl = (u16*)(p.ws + B_W) + (size_t)l * W_LAYER;
  if (j < CJ0) { convT_tile(p.in[13] + (size_t)l * 1024 * 6320, 6320, 1024, wl + W_IN, 0, j / 52, j % 52, sm); return; }
  if (j < CJ1) { j -= CJ0; convT_tile(p.in[13] + (size_t)l * 1024 * 6320, 6320, 1024, wl + W_G, 1, j / 48, j % 48, sm); return; }
  if (j < CJ2) { j -= CJ1; convT_tile(p.in[29] + (size_t)l * 384 * 768, 768, 384, wl + W_QB, 2, j / 12, j % 12, sm); return; }
  if (j < CJ3) { j -= CJ2; convT_tile(p.in[31] + (size_t)l * 256 * 1024, 1024, 256, wl + W_KVB, 2, j / 16, j % 16, sm); return; }
  if (j < CJ4) { j -= CJ3; convT_tile(p.in[26] + (size_t)l * 512 * 512, 512, 512, wl + W_GLU, 2, j / 8, j % 8, sm); return; }
  if (j < CJ5) { j -= CJ4; convT_tile(p.in[32] + (size_t)l * 1536 * 1024, 1024, 1536, wl + W_BR, 2, j / 16, j % 16, sm); return; }
  if (j < CJ6) { j -= CJ5; convT_tile(p.in[33] + (size_t)l * 1024 * 1024, 1024, 1024, wl + W_OUT, 2, j / 16, j % 16, sm); return; }
  if (j < CJ7) { j -= CJ6; convT_tile(p.in[34] + (size_t)l * 1024 * 5632, 5632, 1024, wl + W_UP, 2, j / 88, j % 88, sm); return; }
  j -= CJ7; convT_tile(p.in[37] + (size_t)l * 2816 * 1024, 1024, 2816, wl + W_DN, 2, j / 16, j % 16, sm);
}
DI void mods_tile(const Params& p, int l, int jg, float* sm) {
  const int tid = otid();
  __syncthreads();
  for (int i = tid; i < 9 * 1024; i += 256) {
    int v = i >> 10, k = i & 1023;
    float cv = v == 0 ? p.in[8][k] : p.in[7][(v - 1) * 1024 + k];
    sm[i] = cv / (1.f + __expf(-cv));
  }
  __syncthreads();
  const int col = jg * 64 + (tid & 63), kq = tid >> 6;
  float acc[9];
#pragma unroll
  for (int v = 0; v < 9; ++v) acc[v] = 0.f;
  const float* wp = p.in[9] + (size_t)l * 1024 * 6144 + col;
#pragma unroll 4
  for (int k = kq * 256; k < kq * 256 + 256; ++k) {
    float wv = wp[(size_t)k * 6144];
#pragma unroll
    for (int v = 0; v < 9; ++v) acc[v] += sm[v * 1024 + k] * wv;
  }
  float* red = sm + 9 * 1024;
#pragma unroll
  for (int v = 0; v < 9; ++v) red[(kq * 9 + v) * 64 + (tid & 63)] = acc[v];
  __syncthreads();
  if (kq == 0) {
    float* mods = (float*)(p.ws + B_MODS);
    float b = p.in[10][l * 6144 + col];
#pragma unroll
    for (int v = 0; v < 9; ++v) {
      float s = red[(0 * 9 + v) * 64 + tid] + red[(1 * 9 + v) * 64 + tid] + red[(2 * 9 + v) * 64 + tid] + red[(3 * 9 + v) * 64 + tid];
      mods[(size_t)(l * 9 + v) * 6144 + col] = s + b;
    }
  }
}
DI void s5pre_tile(const Params& p, int tile) {
  const int id = tile * 256 + otid();
  const int pp = id & 63, g = (id >> 6) & 31, dir = (id >> 11) & 1, l = id >> 12;
  const float lre = p.in[18][((l * 2 + dir) * 32 + g) * 64 + pp];
  const float lim = p.in[19][((l * 2 + dir) * 32 + g) * 64 + pp];
  const float dt = expf(p.in[20][(l * 2 + dir) * 32 + g]);
  float er = expf(lre * dt), sn, cs;
  sincosf(lim * dt, &sn, &cs);
  const float lbr = er * cs, lbi = er * sn;
  float e64 = expf(64.f * lre * dt), s64, c64;
  sincosf(64.f * lim * dt, &s64, &c64);
  float2* lamb = (float2*)(p.ws + B_LAMB);
  float2* lam64 = (float2*)(p.ws + B_LAM64);
  const int li = ((l * 2 + dir) * 32 + g) * 64 + pp;
  lamb[li] = make_float2(lbr, lbi);
  lam64[li] = make_float2(e64 * c64, e64 * s64);
  const float nr = lbr - 1.f, ni = lbi, den = lre * lre + lim * lim;
  const float cr = (nr * lre + ni * lim) / den, ci = (ni * lre - nr * lim) / den;
  u16* bbt = (u16*)(p.ws + B_BBT) + (size_t)((l * 2 + dir) * 32 + g) * 128 * 16;
  const float* bre = p.in[21] + (size_t)((l * 32 + g) * 64 + pp) * 16;
  const float* bim = p.in[22] + (size_t)((l * 32 + g) * 64 + pp) * 16;
#pragma unroll
  for (int c = 0; c < 16; ++c) {
    float br = bre[c], bi = bim[c];
    bbt[pp * 16 + c] = f2bf(cr * br - ci * bi);
    bbt[(64 + pp) * 16 + c] = f2bf(cr * bi + ci * br);
  }
  if (dir == 0) {
    u16* cmt = (u16*)(p.ws + B_CMT) + (size_t)(l * 32 + g) * 16 * 128;
    const float* cre = p.in[23] + (size_t)(l * 32 + g) * 16 * 64;
    const float* cim = p.in[24] + (size_t)(l * 32 + g) * 16 * 64;
#pragma unroll
    for (int c = 0; c < 16; ++c) {
      cmt[c * 128 + pp] = f2bf(cre[c * 64 + pp]);
      cmt[c * 128 + 64 + pp] = f2bf(-cim[c * 64 + pp]);
    }
  }
}

DI void norm_phase(const Params& p, int l, int shift_idx, int scale_idx, const float* gn) {
  const float* x = p.out;
  u16* H = (u16*)(p.ws + B_H);
  const float* mods = (const float*)(p.ws + B_MODS);
  const int lane = otid() & 63, w = otid() >> 6;
  for (int tile = blockIdx.x; tile < T_ / 4; tile += gridDim.x) {
    const int t = tile * 4 + w;
    const float4* xr = (const float4*)(x + (size_t)t * 1024);
    float4 v[4];
    float ss = 0.f;
#pragma unroll
    for (int j = 0; j < 4; ++j) {
      v[j] = xr[lane + 64 * j];
      ss += v[j].x * v[j].x + v[j].y * v[j].y + v[j].z * v[j].z + v[j].w * v[j].w;
    }
    ss = wave_sum(ss);
    const float rstd = rsqrtf(ss * (1.f / 1024.f) + 1e-6f);
    const float* mb = mods + (size_t)(l * 9 + tok_v(t)) * 6144;
#pragma unroll
    for (int j = 0; j < 4; ++j) {
      const int c = (lane + 64 * j) * 4;
      float4 g = *(const float4*)(gn + c);
      float4 sc = *(const float4*)(mb + scale_idx * 1024 + c);
      float4 sh = *(const float4*)(mb + shift_idx * 1024 + c);
      float y0 = v[j].x * rstd * g.x * (1.f + sc.x) + sh.x;
      float y1 = v[j].y * rstd * g.y * (1.f + sc.y) + sh.y;
      float y2 = v[j].z * rstd * g.z * (1.f + sc.z) + sh.z;
      float y3 = v[j].w * rstd * g.w * (1.f + sc.w) + sh.w;
      *(uint2*)(H + (size_t)t * 1024 + c) = make_uint2(pack2(y0, y1), pack2(y2, y3));
    }
  }
}

DI void gemm_in_phase(const Params& p, int l, u16* sm) {
  const u16* H = (const u16*)(p.ws + B_H);
  const u16* Wt = (const u16*)(p.ws + B_W) + (size_t)l * W_LAYER + W_IN;
  for (int tile = blockIdx.x; tile < 192 * 26; tile += gridDim.x) {
    const int mt = tile / 26, nt = tile % 26;
    f32x4 acc[4][4];
    zero_acc<4>(acc);
    gemm_core<4>(acc, H + (size_t)mt * 128 * 1024, 1024, Wt + (size_t)nt * 128 * 1024, 1024, 1024, sm);
    if (nt < 25) {
      u16* dst; int ld, c0;
      if (nt < 12) { dst = (u16*)(p.ws + B_QKV); ld = 1536; c0 = nt * 128; }
      else if (nt < 16) { dst = (u16*)(p.ws + B_Z); ld = 512; c0 = (nt - 12) * 128; }
      else if (nt < 20) { dst = (u16*)(p.ws + B_US5); ld = 512; c0 = (nt - 16) * 128; }
      else if (nt < 23) { dst = (u16*)(p.ws + B_QA); ld = 384; c0 = (nt - 20) * 128; }
      else { dst = (u16*)(p.ws + B_KVA); ld = 256; c0 = (nt - 23) * 128; }
      EPI_LOOP(4) { *(uint2*)(dst + (size_t)(mt * 128 + EROW) * ld + c0 + ECOL4(4)) = pack4(acc[i][j]); }
    } else {
      float* misc = (float*)(p.ws + B_MISC);
      EPI_LOOP(4) {
        const int c = ECOL4(4);
        if (c < 48) *(float4*)(misc + (size_t)(mt * 128 + EROW) * 48 + c) = make_float4(acc[i][j][0], acc[i][j][1], acc[i][j][2], acc[i][j][3]);
      }
    }
  }
}

DI void delta_prep_tile(const Params& p, int l, int chunk, u16* sm) {
  const int tid = otid(), lane = tid & 63, w = tid >> 6;
  const int tb = chunk * 64;
  int pos0, L;
  if (tb < TP_) { pos0 = tb & 255; L = 256; } else { pos0 = (tb - TP_) & 2047; L = 2048; }
  const u16* qkv = (const u16*)(p.ws + B_QKV);
  const float* cw = p.in[14] + (size_t)l * 5 * 1536;
  u16* ksm = sm + w * (64 * 130);
  __syncthreads();
  for (int gi = w; gi < 12; gi += 4) {
    const int ch = gi * 128 + 2 * lane;
    float w0[5], w1[5];
#pragma unroll
    for (int i = 0; i < 5; ++i) { w0[i] = cw[i * 1536 + ch]; w1[i] = cw[i * 1536 + ch + 1]; }
    float a0[5], a1[5];
#pragma unroll
    for (int i = 0; i < 4; ++i) {
      int ps = pos0 - 2 + i;
      unsigned u = (ps >= 0 && ps < L) ? *(const unsigned*)(qkv + (size_t)(tb - 2 + i) * 1536 + ch) : 0u;
      a0[i + 1] = blo(u); a1[i + 1] = bhi(u);
    }
    u16* dst = (u16*)(p.ws + (gi < 4 ? B_QN : (gi < 8 ? B_KN : B_VV)));
    const int hh = gi & 3;
    for (int tt = 0; tt < 64; ++tt) {
#pragma unroll
      for (int i = 0; i < 4; ++i) { a0[i] = a0[i + 1]; a1[i] = a1[i + 1]; }
      {
        int ps = pos0 + tt + 2;
        unsigned u = (ps < L) ? *(const unsigned*)(qkv + (size_t)(tb + tt + 2) * 1536 + ch) : 0u;
        a0[4] = blo(u); a1[4] = bhi(u);
      }
      float y0 = 0.f, y1 = 0.f;
#pragma unroll
      for (int i = 0; i < 5; ++i) { y0 += w0[i] * a0[i]; y1 += w1[i] * a1[i]; }
      y0 = siluf_(y0); y1 = siluf_(y1);
      if (gi < 8) {
        float ss = wave_sum(y0 * y0 + y1 * y1);
        float sc = rsqrtf(ss + 1e-6f);
        if (gi < 4) sc *= 0.08838834764831845f;
        y0 *= sc; y1 *= sc;
      }
      const unsigned pk = pack2(y0, y1);
      *(unsigned*)(dst + (size_t)(tb + tt) * 512 + hh * 128 + 2 * lane) = pk;
      if (gi >= 4 && gi < 8) *(unsigned*)(ksm + tt * 130 + 2 * lane) = pk;
    }
    if (gi >= 4 && gi < 8) {
      u16* kt = (u16*)(p.ws + B_KT) + (size_t)(chunk * 4 + hh) * 128 * 64;
#pragma unroll
      for (int rr = 0; rr < 2; ++rr) {
        const int dk = lane + 64 * rr;
        unsigned pk[32];
#pragma unroll
        for (int t2 = 0; t2 < 32; ++t2) pk[t2] = (unsigned)ksm[(2 * t2) * 130 + dk] | ((unsigned)ksm[(2 * t2 + 1) * 130 + dk] << 16);
#pragma unroll
        for (int q = 0; q < 8; ++q) *(uint4*)(kt + dk * 64 + q * 8) = make_uint4(pk[4 * q], pk[4 * q + 1], pk[4 * q + 2], pk[4 * q + 3]);
      }
    }
  }
  const float* misc = (const float*)(p.ws + B_MISC);
  float* bg = (float*)(p.ws + B_BG);
  for (int i = tid; i < 512; i += 256) {
    const int tt = i >> 3, dh = i & 7;
    const size_t t = tb + tt;
    float bl = misc[t * 48 + dh], alp = misc[t * 48 + 8 + dh];
    float x = alp + p.in[16][l * 8 + dh];
    float sp = x > 20.f ? x : log1pf(__expf(x));
    bg[t * 16 + dh] = sigmoidf_(bl);
    bg[t * 16 + 8 + dh] = -__expf(p.in[15][l * 8 + dh]) * sp;
  }
}

DI size_t kb_off(int t, int head) {
  if (t < TP_) return ((size_t)((t >> 8) * 8 + head) * 256 + (t & 255)) * 96;
  const int s = (t - TP_) >> 11, pos = (t - TP_) & 2047;
  return KB_P + ((size_t)(s * 8 + head) * 2304 + 256 + pos) * 96;
}
DI void mla_prep_tile(const Params& p, int l, int tile) {
  const int lane = otid() & 63, w = otid() >> 6;
  const int t = tile * 4 + w;
  u16* qa = (u16*)(p.ws + B_QA) + (size_t)t * 384;
  u16* kva = (u16*)(p.ws + B_KVA) + (size_t)t * 256;
  const float* misc = (const float*)(p.ws + B_MISC) + (size_t)t * 48;
  {
    unsigned u[3]; float ss = 0.f;
#pragma unroll
    for (int j = 0; j < 3; ++j) { u[j] = *(const unsigned*)(qa + 2 * lane + 128 * j); float a = blo(u[j]), b = bhi(u[j]); ss += a * a + b * b; }
    ss = wave_sum(ss);
    const float rstd = rsqrtf(ss * (1.f / 384.f) + 1e-6f);
    const float* g = p.in[28] + l * 384;
#pragma unroll
    for (int j = 0; j < 3; ++j) {
      int c = 2 * lane + 128 * j;
      *(unsigned*)(qa + c) = pack2(blo(u[j]) * rstd * g[c], bhi(u[j]) * rstd * g[c + 1]);
    }
  }
  {
    unsigned u[2]; float ss = 0.f;
#pragma unroll
    for (int j = 0; j < 2; ++j) { u[j] = *(const unsigned*)(kva + 2 * lane + 128 * j); float a = blo(u[j]), b = bhi(u[j]); ss += a * a + b * b; }
    ss = wave_sum(ss);
    const float rstd = rsqrtf(ss * (1.f / 256.f) + 1e-6f);
    const float* g = p.in[30] + l * 256;
#pragma unroll
    for (int j = 0; j < 2; ++j) {
      int c = 2 * lane + 128 * j;
      float a = blo(u[j]) * rstd * g[c], b = bhi(u[j]) * rstd * g[c + 1];
      *(unsigned*)(kva + c) = pack2(a, b);
      if (t < TP_) {
        float* o = p.out + O_CKV + ((size_t)((t >> 8) * 4 + l) * 256 + (t & 255)) * 256 + c;
        *(float2*)o = make_float2(a, b);
      }
    }
  }
  {
    const int i = lane & 31;
    float kr = misc[16 + i];
    float val;
    if (t < TP_) {
      val = kr;
      if (lane < 32) p.out[O_KR + ((size_t)((t >> 8) * 4 + l) * 256 + (t & 255)) * 32 + i] = kr;
    } else {
      const int pos = (t - TP_) & 2047;
      const float* rp = (const float*)(p.ws + B_ROPE) + (size_t)pos * 32 + (i & 15) * 2;
      const float cs = rp[0], sn = rp[1];
      float other = __shfl_xor(kr, 16);
      val = (i < 16) ? (kr * cs - other * sn) : (kr * cs + other * sn);
    }
    u16* kb = (u16*)(p.ws + B_KB);
    const u16 bv = f2bf(val);
#pragma unroll
    for (int hh = 0; hh < 4; ++hh) {
      int head = hh * 2 + (lane >> 5);
      kb[kb_off(t, head) + 64 + i] = bv;
    }
  }
}
DI void cache_rope_tile(const Params& p, int l, int tile) {
  const int pr = tile * 8 + (otid() >> 5), i = otid() & 31;
  const int s = pr >> 8, pos = pr & 255;
  const float v = p.in[6][((size_t)(s * 4 + l) * 256 + pos) * 32 + i];
  u16* kb = (u16*)(p.ws + B_KB);
  const u16 bv = f2bf(v);
#pragma unroll
  for (int head = 0; head < 8; ++head) kb[KB_P + ((size_t)(s * 8 + head) * 2304 + pos) * 96 + 64 + i] = bv;
}

DI float gelu_tanh(float x) {
  const float k0 = 0.7978845608028654f, k1 = 0.044715f;
  float u = k0 * (x + k1 * x * x * x);
  float e = __expf(2.f * u);
  float th = 1.f - 2.f / (e + 1.f);
  return 0.5f * x * (1.f + th);
}
DI void s5_chunk_tile(const Params& p, int l, int chunk, int gp, int mode, u16* sm) {
  const int tid = otid(), lane = tid & 63, w = tid >> 6;
  const u16* us5 = (const u16*)(p.ws + B_US5);
  constexpr int RS = 136;
  const int gi_w = w >> 1, half = w & 1, g_w = gp * 2 + gi_w;
  const int n = lane & 31, h2 = lane >> 5;
  bf16x8 af[2], bq[2][2];
#pragma unroll
  for (int mi = 0; mi < 2; ++mi) af[mi] = *(const bf16x8*)(us5 + (size_t)(chunk * 64 + mi * 32 + n) * 512 + g_w * 16 + 8 * h2);
#pragma unroll
  for (int dir = 0; dir < 2; ++dir) {
    const u16* bbt = (const u16*)(p.ws + B_BBT) + (size_t)((l * 2 + dir) * 32 + g_w) * 128 * 16;
#pragma unroll
    for (int nn = 0; nn < 2; ++nn) bq[dir][nn] = *(const bf16x8*)(bbt + ((half * 2 + nn) * 32 + n) * 16 + 8 * h2);
  }
  const int gi_t = tid >> 7, dir_t = (tid >> 6) & 1, pp = tid & 63, g_t = gp * 2 + gi_t;
  const float2 lb = ((const float2*)(p.ws + B_LAMB))[((l * 2 + dir_t) * 32 + g_t) * 64 + pp];
  const size_t hidx = ((size_t)(chunk * 32 + g_t) * 2 + dir_t) * 64 + pp;
  float hr = 0.f, hi = 0.f;
  if (mode) { float2 h0 = ((const float2*)(p.ws + B_HIN))[hidx]; hr = h0.x; hi = h0.y; }
  const int fr = lane & 15, fq = lane >> 4;
  bf16x8 cq[4];
  u16 uu[2][4];
  float dsk = 0.f;
  if (mode) {
    const u16* cmt = (const u16*)(p.ws + B_CMT) + (size_t)(l * 32 + g_w) * 16 * 128;
#pragma unroll
    for (int k4 = 0; k4 < 4; ++k4) cq[k4] = *(const bf16x8*)(cmt + fr * 128 + k4 * 32 + fq * 8);
#pragma unroll
    for (int mm = 0; mm < 2; ++mm)
#pragma unroll
      for (int r = 0; r < 4; ++r) uu[mm][r] = us5[((size_t)chunk * 64 + ((w & 1) * 2 + mm) * 16 + fq * 4 + r) * 512 + g_w * 16 + fr];
    dsk = p.in[25][l * 512 + g_w * 16 + fr];
  }
  __syncthreads();
  {
#pragma unroll
    for (int dir = 0; dir < 2; ++dir) {
#pragma unroll
      for (int nn = 0; nn < 2; ++nn) {
        const int nt = half * 2 + nn;
#pragma unroll
        for (int mi = 0; mi < 2; ++mi) {
          f32x16 acc;
#pragma unroll
          for (int r = 0; r < 16; ++r) acc[r] = 0.f;
          acc = MFMA32(af[mi], bq[dir][nn], acc);
          u16* d = sm + (size_t)((gi_w * 2 + dir) * 64 + mi * 32) * RS + nt * 32 + n;
#pragma unroll
          for (int r = 0; r < 16; ++r) d[crow(r, h2) * RS] = f2bf(acc[r]);
        }
      }
    }
  }
  __syncthreads();
  {
    u16* base = sm + (size_t)((gi_t * 2 + dir_t) * 64) * RS;
#pragma unroll 8
    for (int st = 0; st < 64; ++st) {
      const int tk = dir_t ? 63 - st : st;
      float br = bf2f(base[tk * RS + pp]), bi = bf2f(base[tk * RS + 64 + pp]);
      float nr = __builtin_fmaf(lb.x, hr, __builtin_fmaf(-lb.y, hi, br));
      float ni = __builtin_fmaf(lb.x, hi, __builtin_fmaf(lb.y, hr, bi));
      asm volatile("" : "+v"(nr));
      asm volatile("" : "+v"(ni));
      hr = nr; hi = ni;
      if (mode) { base[tk * RS + pp] = f2bf(hr); base[tk * RS + 64 + pp] = f2bf(hi); }
    }
    if (!mode) ((float2*)(p.ws + B_HEND))[hidx] = make_float2(hr, hi);
  }
  if (!mode) return;
  __syncthreads();
  {
    f32x4 acc[2];
    acc[0] = f32x4{0.f, 0.f, 0.f, 0.f}; acc[1] = acc[0];
#pragma unroll
    for (int ks = 0; ks < 8; ++ks) {
      const int dir = ks >> 2, kk = (ks & 3) * 32;
#pragma unroll
      for (int mm = 0; mm < 2; ++mm) {
        const int mi = (w & 1) * 2 + mm;
        bf16x8 a2 = *(const bf16x8*)(sm + (size_t)((gi_w * 2 + dir) * 64 + mi * 16 + fr) * RS + kk + fq * 8);
        acc[mm] = MFMA16(a2, cq[ks & 3], acc[mm]);
      }
    }
    u16* y5 = (u16*)(p.ws + B_Y5);
#pragma unroll
    for (int mm = 0; mm < 2; ++mm)
#pragma unroll
      for (int r = 0; r < 4; ++r) {
        const size_t t = (size_t)chunk * 64 + ((w & 1) * 2 + mm) * 16 + fq * 4 + r;
        float y = acc[mm][r] + dsk * bf2f(uu[mm][r]);
        y5[t * 512 + g_w * 16 + fr] = f2bf(gelu_tanh(y));
      }
  }
}
DI void s5_carry_tile(const Params& p, int l, int tile) {
  const int seq = tile >> 4, gp = tile & 15;
  const int tid = otid(), gi = tid >> 7, dir = (tid >> 6) & 1, pp = tid & 63, g = gp * 2 + gi;
  int c0, nc;
  if (seq < 32) { c0 = seq * 4; nc = 4; } else { c0 = 128 + (seq - 32) * 32; nc = 32; }
  const float2 l64 = ((const float2*)(p.ws + B_LAM64))[((l * 2 + dir) * 32 + g) * 64 + pp];
  float hr = 0.f, hi = 0.f;
  if (seq >= 32) {
    const size_t si = ((size_t)((seq - 32) * 4 + l) * 2 + dir) * 2048 + g * 64 + pp;
    hr = p.in[3][si]; hi = p.in[4][si];
  }
  const float2* hend = (const float2*)(p.ws + B_HEND);
  float2* hin = (float2*)(p.ws + B_HIN);
  for (int it = 0; it < nc; ++it) {
    const int ck = c0 + (dir ? nc - 1 - it : it);
    const size_t idx = ((size_t)(ck * 32 + g) * 2 + dir) * 64 + pp;
    hin[idx] = make_float2(hr, hi);
    float2 he = hend[idx];
    float nr = __builtin_fmaf(l64.x, hr, __builtin_fmaf(-l64.y, hi, he.x));
    float ni = __builtin_fmaf(l64.x, hi, __builtin_fmaf(l64.y, hr, he.y));
    asm volatile("" : "+v"(nr));
    asm volatile("" : "+v"(ni));
    hr = nr; hi = ni;
  }
  if (seq < 32) {
    const size_t so = ((size_t)(seq * 4 + l) * 2 + dir) * 2048 + g * 64 + pp;
    p.out[O_S5RE + so] = hr;
    p.out[O_S5IM + so] = hi;
  }
}

DI void delta_local_tile(const Params& p, int tile, float* smf) {
  const int chunk = tile >> 1, dir = tile & 1;
  const int tid = otid(), lane = tid & 63, h = tid >> 6;
  const int m = lane & 31, h2 = lane >> 5;
  const int tb = chunk * 64;
  const float* bg = (const float*)(p.ws + B_BG);
  const u16* kn = (const u16*)(p.ws + B_KN);
  const u16* qn = (const u16*)(p.ws + B_QN);
  float* Aw = smf + h * 4096;
  const size_t cidx = ((size_t)(chunk * 4 + h) * 2 + dir);
  const int tl = tb + (dir ? 63 - lane : lane);
  float gcs = bg[(size_t)tl * 16 + 8 + dir * 4 + h];
  const float beta = bg[(size_t)tl * 16 + dir * 4 + h];
#pragma unroll
  for (int o = 1; o < 64; o <<= 1) {
    float v = __shfl_up(gcs, o);
    if (lane >= o) gcs += v;
  }
  ((float*)(p.ws + B_GC))[cidx * 64 + lane] = gcs;
  ((float*)(p.ws + B_BC))[cidx * 64 + lane] = beta;
  __syncthreads();
  u16* qkm = (u16*)(p.ws + B_QKM) + cidx * 4096;
#pragma unroll 1
  for (int tt = 0; tt < 3; ++tt) {
    const int mi = tt == 0 ? 0 : 1, ni = tt == 2 ? 1 : 0;
    const int cm = 32 * mi + m, cn = 32 * ni + m;
    const u16* krm = kn + (size_t)(tb + (dir ? 63 - cm : cm)) * 512 + h * 128 + h2 * 8;
    const u16* qrm = qn + (size_t)(tb + (dir ? 63 - cm : cm)) * 512 + h * 128 + h2 * 8;
    const u16* krn = kn + (size_t)(tb + (dir ? 63 - cn : cn)) * 512 + h * 128 + h2 * 8;
    f32x16 ak, aq;
#pragma unroll
    for (int r = 0; r < 16; ++r) { ak[r] = 0.f; aq[r] = 0.f; }
#pragma unroll
    for (int ks = 0; ks < 8; ++ks) {
      const bf16x8 fkm = *(const bf16x8*)(krm + ks * 16), fqm = *(const bf16x8*)(qrm + ks * 16), fkn = *(const bf16x8*)(krn + ks * 16);
      ak = MFMA32(fkm, fkn, ak);
      aq = MFMA32(fqm, fkn, aq);
    }
    const int e = 32 * ni + m;
    const float gce = __shfl(gcs, e);
#pragma unroll
    for (int r = 0; r < 16; ++r) {
      const int c = 32 * mi + crow(r, h2);
      const float gcc = __shfl(gcs, c), bc = __shfl(beta, c);
      const float dec = (e <= c) ? __expf(gcc - gce) : 0.f;
      Aw[c * 64 + e] = (e < c) ? ak[r] * bc * dec : 0.f;
      qkm[c * 64 + e] = f2bf(aq[r] * dec);
    }
  }
  __syncthreads();
  u16* tm = (u16*)(p.ws + B_TM) + cidx * 4096;
  float x[64];
#pragma unroll
  for (int i = 0; i < 64; ++i) {
    float a = (i == lane) ? 1.f : 0.f;
#pragma unroll
    for (int j = 0; j < i; ++j) a -= Aw[i * 64 + j] * x[j];
    x[i] = a;
    tm[i * 64 + lane] = f2bf(a);
  }
}

template <int dir>
DI void delta_scan_body(const Params& p, int l, int seq, int h, u16* sm);
DI void delta_scan_tile(const Params& p, int l, int idx, u16* sm) {
  int seq, h, dir;
  if (idx < 64) { seq = 32 + (idx >> 3); h = (idx >> 1) & 3; dir = idx & 1; }
  else { const int i2 = idx - 64; seq = i2 >> 3; h = (i2 >> 1) & 3; dir = i2 & 1; }
  __builtin_amdgcn_s_setprio(3);
  if (dir) delta_scan_body<1>(p, l, seq, h, sm); else delta_scan_body<0>(p, l, seq, h, sm);
  __builtin_amdgcn_s_setprio(0);
}
template <int dir>
DI void delta_scan_body(const Params& p, int l, int seq, int h, u16* sm) {
  int chunk0, nch;
  if (seq < 32) { chunk0 = seq * 4; nch = 4; } else { chunk0 = 128 + (seq - 32) * 32; nch = 32; }
  const int lane = otid() & 63, w = otid() >> 6;
  const int n = lane & 31, h2 = lane >> 5;
  const int dvc = w * 32 + n;
  const u16* kn = (const u16*)(p.ws + B_KN);
  const u16* qn = (const u16*)(p.ws + B_QN);
  const u16* vv = (const u16*)(p.ws + B_VV);
  u16* od = (u16*)(p.ws + (dir ? B_OB : B_OF));
  f32x16 S[4];
  if (seq >= 32) {
    const float* s0 = p.in[2] + ((size_t)(((seq - 32) * 4 + l) * 2 + dir) * 4 + h) * 16384;
#pragma unroll
    for (int t = 0; t < 4; ++t)
#pragma unroll
      for (int r = 0; r < 16; ++r) S[t][r] = s0[(size_t)(32 * t + crow(r, h2)) * 128 + dvc];
  } else {
#pragma unroll
    for (int t = 0; t < 4; ++t)
#pragma unroll
      for (int r = 0; r < 16; ++r) S[t][r] = 0.f;
  }
  for (int it = 0; it < nch; ++it) {
    const int chunk = chunk0 + (dir ? nch - 1 - it : it);
    const int tb = chunk * 64;
    const size_t cidx = ((size_t)(chunk * 4 + h) * 2 + dir);
    const float* gcp = (const float*)(p.ws + B_GC) + cidx * 64;
    const float* bcp = (const float*)(p.ws + B_BC) + cidx * 64;
    const u16* tm = (const u16*)(p.ws + B_TM) + cidx * 4096;
    const u16* qkm = (const u16*)(p.ws + B_QKM) + cidx * 4096;
    const u16* ktp = (const u16*)(p.ws + B_KT) + (size_t)(chunk * 4 + h) * 8192;
    const float glast = gcp[63];
    size_t trow[2];
#pragma unroll
    for (int mi = 0; mi < 2; ++mi) { const int c = 32 * mi + n; trow[mi] = (size_t)(tb + (dir ? 63 - c : c)); }
#define SCHED_FENCE() asm volatile("" ::: "memory")
    u16* Ks = sm; u16* Qs = sm + 8704; u16* Vs = sm + 17408; u16* KTs = sm + 26112;
    float* GCs = (float*)(sm + 35328);
    const float* gcl = GCs; const float* bcl = GCs + 64;
    uint4 xm0, xm1, xq0, xq1;
    u16* vls = Vs + w * 32;
    __syncthreads();
    {
      const int tid_ = otid();
      const int r0 = tid_ >> 4, ck = tid_ & 15;
      uint4 tk[4], tq[4], tv[4], tt[4];
      xm0 = *(const uint4*)(tm + tid_ * 8); xm1 = *(const uint4*)(tm + 2048 + tid_ * 8);
      xq0 = *(const uint4*)(qkm + tid_ * 8); xq1 = *(const uint4*)(qkm + 2048 + tid_ * 8);
      float4 gcv = make_float4(0.f, 0.f, 0.f, 0.f);
      if (tid_ < 16) gcv = *(const float4*)(gcp + tid_ * 4); else if (tid_ < 32) gcv = *(const float4*)(bcp + (tid_ - 16) * 4);
#pragma unroll
      for (int j = 0; j < 4; ++j) {
        const size_t go = (size_t)(tb + r0 + 16 * j) * 512 + h * 128 + ck * 8;
        tk[j] = *(const uint4*)(kn + go); tq[j] = *(const uint4*)(qn + go); tv[j] = *(const uint4*)(vv + go);
        tt[j] = *(const uint4*)(ktp + ((tid_ >> 3) + 32 * j) * 64 + (tid_ & 7) * 8);
      }
#pragma unroll
      for (int j = 0; j < 4; ++j) {
        const int tau = r0 + 16 * j, c = dir ? 63 - tau : tau;
        *(uint4*)(Ks + c * 136 + ck * 8) = tk[j]; *(uint4*)(Qs + c * 136 + ck * 8) = tq[j]; *(uint4*)(Vs + c * 136 + ck * 8) = tv[j];
        *(uint4*)(KTs + ((tid_ >> 3) + 32 * j) * 72 + (tid_ & 7) * 8) = tt[j];
      }
      if (tid_ < 32) *(float4*)(GCs + tid_ * 4) = gcv;
    }
    __syncthreads();
    f32x16 X[2], QS[2];
    {
      bf16x8 Sb[4][2];
#pragma unroll
      for (int t = 0; t < 4; ++t)
#pragma unroll
        for (int s = 0; s < 2; ++s) Sb[t][s] = pack_acc(S[t], s);
#pragma unroll
      for (int mi = 0; mi < 2; ++mi)
#pragma unroll
        for (int r = 0; r < 16; ++r) { X[mi][r] = 0.f; QS[mi][r] = 0.f; }
#pragma unroll
      for (int t = 0; t < 4; ++t) {
#pragma unroll
        for (int mi = 0; mi < 2; ++mi) {
          const u16* krow_ = Ks + (32 * mi + n) * 136;
          const u16* qrow_ = Qs + (32 * mi + n) * 136;
#pragma unroll
          for (int s = 0; s < 2; ++s) {
            X[mi] = MFMA32(load_perm(krow_ + 32 * t, s, h2), Sb[t][s], X[mi]);
            QS[mi] = MFMA32(load_perm(qrow_ + 32 * t, s, h2), Sb[t][s], QS[mi]);
          }
        }
        SCHED_FENCE();
      }
    }
    __syncthreads();
    {
      const int tid_ = otid();
      const int r_ = tid_ >> 3, c_ = (tid_ & 7) * 8;
      *(uint4*)(Ks + r_ * 72 + c_) = xm0; *(uint4*)(Ks + (r_ + 32) * 72 + c_) = xm1;
      *(uint4*)(Qs + r_ * 72 + c_) = xq0; *(uint4*)(Qs + (r_ + 32) * 72 + c_) = xq1;
    }
    __syncthreads();
    bf16x8 Rb[2][2];
#pragma unroll
    for (int mi = 0; mi < 2; ++mi) {
#pragma unroll
      for (int a = 0; a < 4; ++a) {
        const int c4 = 32 * mi + 8 * a + 4 * h2;
        const float4 g4 = *(const float4*)(gcl + c4);
        const float4 b4 = *(const float4*)(bcl + c4);
        const float gg[4] = {g4.x, g4.y, g4.z, g4.w};
        const float bb[4] = {b4.x, b4.y, b4.z, b4.w};
#pragma unroll
        for (int q = 0; q < 4; ++q) {
          const int c = c4 + q;
          const float v = bf2f(vls[c * 136 + n]);
          const float eg = __expf(gg[q]);
          X[mi][4 * a + q] = bb[q] * (v - eg * X[mi][4 * a + q]);
          QS[mi][4 * a + q] *= eg;
        }
      }
      Rb[mi][0] = pack_acc(X[mi], 0);
      Rb[mi][1] = pack_acc(X[mi], 1);
    }
    SCHED_FENCE();
    f32x16 Vn[2];
#pragma unroll
    for (int mo = 0; mo < 2; ++mo) {
#pragma unroll
      for (int r = 0; r < 16; ++r) Vn[mo][r] = 0.f;
#pragma unroll
      for (int mi = 0; mi <= mo; ++mi)
#pragma unroll
        for (int s = 0; s < 2; ++s) Vn[mo] = MFMA32(load_perm(Ks + (32 * mo + n) * 72 + 32 * mi, s, h2), Rb[mi][s], Vn[mo]);
    }
    SCHED_FENCE();
    {
      bf16x8 Vb[2][2];
#pragma unroll
      for (int mi = 0; mi < 2; ++mi) { Vb[mi][0] = pack_acc(Vn[mi], 0); Vb[mi][1] = pack_acc(Vn[mi], 1); }
#pragma unroll
      for (int mo = 0; mo < 2; ++mo) {
#pragma unroll
        for (int mi = 0; mi <= mo; ++mi)
#pragma unroll
          for (int s = 0; s < 2; ++s) QS[mo] = MFMA32(load_perm(Qs + (32 * mo + n) * 72 + 32 * mi, s, h2), Vb[mi][s], QS[mo]);
      }
      __syncthreads();
#pragma unroll
      for (int mo = 0; mo < 2; ++mo)
#pragma unroll
        for (int r = 0; r < 16; ++r) vls[(32 * mo + crow(r, h2)) * 136 + n] = f2bf(QS[mo][r]);
      __syncthreads();
#pragma unroll
      for (int jv = 0; jv < 4; ++jv) {
        const int tau = (lane >> 2) + 16 * jv, cq = lane & 3;
        const uint4 oq = *(const uint4*)(vls + (dir ? 63 - tau : tau) * 136 + cq * 8);
        *(uint4*)(od + (size_t)(tb + tau) * 512 + h * 128 + w * 32 + cq * 8) = oq;
      }
    }
    SCHED_FENCE();
    bf16x8 Vsb[2][2];
#pragma unroll
    for (int mi = 0; mi < 2; ++mi) {
#pragma unroll
      for (int a = 0; a < 4; ++a) {
        const float4 g4 = *(const float4*)(gcl + 32 * mi + 8 * a + 4 * h2);
        Vn[mi][4 * a + 0] *= __expf(glast - g4.x); Vn[mi][4 * a + 1] *= __expf(glast - g4.y);
        Vn[mi][4 * a + 2] *= __expf(glast - g4.z); Vn[mi][4 * a + 3] *= __expf(glast - g4.w);
      }
      Vsb[mi][0] = pack_acc(Vn[mi], 0); Vsb[mi][1] = pack_acc(Vn[mi], 1);
    }
    const float eg = __expf(glast);
#pragma unroll
    for (int t = 0; t < 4; ++t) {
#pragma unroll
      for (int r = 0; r < 16; ++r) S[t][r] *= eg;
      const u16* ktrow = KTs + (32 * t + n) * 72;
#pragma unroll
      for (int mi = 0; mi < 2; ++mi)
#pragma unroll
        for (int s = 0; s < 2; ++s) {
          bf16x8 a = dir ? load_perm_rev(ktrow, 32 * mi, s, h2) : load_perm(ktrow + 32 * mi, s, h2);
          S[t] = MFMA32(a, Vsb[mi][s], S[t]);
        }
      SCHED_FENCE();
    }
  }
  if (seq < 32) {
    float* so = p.out + O_SD + ((size_t)((seq * 4 + l) * 2 + dir) * 4 + h) * 16384;
#pragma unroll
    for (int t = 0; t < 4; ++t)
#pragma unroll
      for (int r = 0; r < 16; ++r) so[(size_t)(32 * t + crow(r, h2)) * 128 + dvc] = S[t][r];
  }
}

DI void attn_tile(const Params& p, int seq, int head, int qb, u16* sm) {
  const int lane = otid() & 63, w = otid() >> 6;
  const int n = lane & 31, h2 = lane >> 5;
  int tq0, nkeys; size_t kbo, vto;
  if (seq < 32) { tq0 = seq * 256 + qb * 128 + w * 32; nkeys = 256; kbo = (size_t)(seq * 8 + head) * 256 * 96; vto = (size_t)(seq * 8 + head) * 64 * 256; }
  else { const int s = seq - 32; tq0 = TP_ + s * 2048 + qb * 128 + w * 32; nkeys = 2304; kbo = KB_P + (size_t)(s * 8 + head) * 2304 * 96; vto = VT_P + (size_t)(s * 8 + head) * 64 * 2304; }
  const u16* kb = (const u16*)(p.ws + B_KB) + kbo;
  const u16* vt = (const u16*)(p.ws + B_VT) + vto;
  const u16* qm = (const u16*)(p.ws + B_QM) + (size_t)(tq0 + n) * 768 + head * 96;
  bf16x8 qf[6];
#pragma unroll
  for (int ks = 0; ks < 6; ++ks) qf[ks] = *(const bf16x8*)(qm + ks * 16 + h2 * 8);
  f32x16 O[2];
#pragma unroll
  for (int r = 0; r < 16; ++r) { O[0][r] = 0.f; O[1][r] = 0.f; }
  float mrun = -1e30f, lsum = 0.f;
  const int nkt = nkeys >> 6;
  constexpr int KST = 104, VST = 72, STG = 64 * KST + 64 * VST;
  const int tid_ = otid();
  uint4 rk0, rk1, rk2, rv0, rv1;
  const int kc0 = tid_, kc1 = tid_ + 256, kc2 = tid_ + 512;
  const u16* kg0 = kb + (size_t)(kc0 / 12) * 96 + (kc0 % 12) * 8;
  const u16* kg1 = kb + (size_t)(kc1 / 12) * 96 + (kc1 % 12) * 8;
  const u16* kg2 = kb + (size_t)(kc2 / 12) * 96 + (kc2 % 12) * 8;
  const u16* vg0 = vt + (size_t)(tid_ >> 3) * nkeys + (tid_ & 7) * 8;
  const u16* vg1 = vt + (size_t)((tid_ + 256) >> 3) * nkeys + (tid_ & 7) * 8;
  const int kl0 = (kc0 / 12) * KST + (kc0 % 12) * 8, kl1 = (kc1 / 12) * KST + (kc1 % 12) * 8, kl2 = (kc2 / 12) * KST + (kc2 % 12) * 8;
  const int vl0 = (tid_ >> 3) * VST + (tid_ & 7) * 8, vl1 = ((tid_ + 256) >> 3) * VST + (tid_ & 7) * 8;
#define AT_GLOAD(kt_) do { rk0 = *(const uint4*)(kg0 + (size_t)(kt_) * 6144); rk1 = *(const uint4*)(kg1 + (size_t)(kt_) * 6144); \
    rk2 = *(const uint4*)(kg2 + (size_t)(kt_) * 6144); rv0 = *(const uint4*)(vg0 + (kt_) * 64); rv1 = *(const uint4*)(vg1 + (kt_) * 64); } while (0)
#define AT_SSTORE(st_) do { u16* ks2_ = sm + (st_) * STG; u16* vs2_ = ks2_ + 64 * KST; \
    *(uint4*)(ks2_ + kl0) = rk0; *(uint4*)(ks2_ + kl1) = rk1; *(uint4*)(ks2_ + kl2) = rk2; *(uint4*)(vs2_ + vl0) = rv0; *(uint4*)(vs2_ + vl1) = rv1; } while (0)
  __syncthreads();
  AT_GLOAD(0); AT_SSTORE(0);
  __syncthreads();
  for (int kt = 0; kt < nkt; ++kt) {
    const bool more = kt + 1 < nkt;
    if (more) AT_GLOAD(kt + 1);
    const u16* ks_ = sm + (kt & 1) * STG;
    const u16* vs_ = ks_ + 64 * KST;
    f32x16 St[2];
#pragma unroll
    for (int sub = 0; sub < 2; ++sub) {
#pragma unroll
      for (int r = 0; r < 16; ++r) St[sub][r] = 0.f;
      const u16* kr = ks_ + (sub * 32 + n) * KST + h2 * 8;
#pragma unroll
      for (int ks = 0; ks < 6; ++ks) St[sub] = MFMA32(*(const bf16x8*)(kr + ks * 16), qf[ks], St[sub]);
    }
    float mx = St[0][0];
#pragma unroll
    for (int r = 0; r < 16; ++r) { mx = fmaxf(mx, St[0][r]); mx = fmaxf(mx, St[1][r]); }
    mx = fmaxf(mx, __shfl_xor(mx, 32));
    const float mnew = fmaxf(mrun, mx);
    const float alpha = __builtin_amdgcn_exp2f(mrun - mnew);
    mrun = mnew;
    float ps = 0.f;
#pragma unroll
    for (int sub = 0; sub < 2; ++sub)
#pragma unroll
      for (int r = 0; r < 16; ++r) { float e = __builtin_amdgcn_exp2f(St[sub][r] - mnew); St[sub][r] = e; ps += e; }
    lsum = lsum * alpha + ps;
#pragma unroll
    for (int r = 0; r < 16; ++r) { O[0][r] *= alpha; O[1][r] *= alpha; }
#pragma unroll
    for (int sub = 0; sub < 2; ++sub)
#pragma unroll
      for (int s = 0; s < 2; ++s) {
        const bf16x8 pb = pack_acc(St[sub], s);
#pragma unroll
        for (int dt = 0; dt < 2; ++dt)
          O[dt] = MFMA32(load_perm(vs_ + (dt * 32 + n) * VST + sub * 32, s, h2), pb, O[dt]);
      }
    if (more) AT_SSTORE((kt + 1) & 1);
    __syncthreads();
  }
  lsum += __shfl_xor(lsum, 32);
  const float inv = 1.f / lsum;
  u16* oc = (u16*)(p.ws + B_OC) + (size_t)(tq0 + n) * 512 + head * 64;
#pragma unroll
  for (int dt = 0; dt < 2; ++dt)
#pragma unroll
    for (int a = 0; a < 4; ++a) {
      const int dv = dt * 32 + 8 * a + 4 * h2;
      *(uint2*)(oc + dv) = make_uint2(pack2(O[dt][4 * a] * inv, O[dt][4 * a + 1] * inv), pack2(O[dt][4 * a + 2] * inv, O[dt][4 * a + 3] * inv));
    }
}

DI void delta_out_tile(const Params& p, int l, int tile) {
  const int lane = otid() & 63, w = otid() >> 6;
  const u16* of = (const u16*)(p.ws + B_OF);
  const u16* ob = (const u16*)(p.ws + B_OB);
  const u16* z = (const u16*)(p.ws + B_Z);
  u16* oa = (u16*)(p.ws + B_OA);
  const float g0 = p.in[17][l * 128 + 2 * lane], g1 = p.in[17][l * 128 + 2 * lane + 1];
#pragma unroll 1
  for (int q = 0; q < 16; ++q) {
    const size_t t = (size_t)tile * 16 + w * 4 + (q >> 2);
    const int hh = q & 3;
    const size_t off = t * 512 + hh * 128 + 2 * lane;
    unsigned a = *(const unsigned*)(of + off), b = *(const unsigned*)(ob + off), zz = *(const unsigned*)(z + off);
    float o0 = blo(a) + blo(b), o1 = bhi(a) + bhi(b);
    float ss = wave_sum(o0 * o0 + o1 * o1);
    float rstd = rsqrtf(ss * (1.f / 128.f) + 1e-6f);
    float y0 = o0 * rstd * g0 * siluf_(blo(zz)), y1 = o1 * rstd * g1 * siluf_(bhi(zz));
    *(unsigned*)(oa + off) = pack2(y0, y1);
  }
}

DI void grid_barrier(unsigned* bar, unsigned target) {
  asm volatile("s_waitcnt vmcnt(0) lgkmcnt(0)" ::: "memory");
  __syncthreads();
  if (otid() == 0) {
    __builtin_amdgcn_fence(__ATOMIC_RELEASE, "agent");
    asm volatile("s_waitcnt vmcnt(0)" ::: "memory");
    __hip_atomic_fetch_add(bar, 1u, __ATOMIC_RELAXED, __HIP_MEMORY_SCOPE_AGENT);
    while (__hip_atomic_load(bar, __ATOMIC_RELAXED, __HIP_MEMORY_SCOPE_AGENT) < target) __builtin_amdgcn_s_sleep(5);
    __builtin_amdgcn_fence(__ATOMIC_ACQUIRE, "agent");
    asm volatile("s_waitcnt vmcnt(0)" ::: "memory");
  }
  __syncthreads();
}
#define GSYNC_FLAT() do { bar_target += gridDim.x; grid_barrier(p.bar, bar_target); } while (0)
DI unsigned xcc_id() { return (unsigned)__builtin_amdgcn_s_getreg((3 << 11) | 20) & 0xFu; }
DI void grid_barrier_xcd(unsigned* bar, unsigned xid, unsigned gen, unsigned xcnt, unsigned npres) {
  asm volatile("s_waitcnt vmcnt(0) lgkmcnt(0)" ::: "memory");
  __syncthreads();
  if (otid() == 0) {
    const unsigned old = __hip_atomic_fetch_add(bar + 64 + 32 * xid, 1u, __ATOMIC_RELAXED, __HIP_MEMORY_SCOPE_AGENT);
    if (old + 1 == gen * xcnt) {
      __builtin_amdgcn_fence(__ATOMIC_RELEASE, "agent");
      asm volatile("s_waitcnt vmcnt(0)" ::: "memory");
      __hip_atomic_fetch_add(bar + 32, 1u, __ATOMIC_RELAXED, __HIP_MEMORY_SCOPE_AGENT);
    }
    while (__hip_atomic_load(bar + 32, __ATOMIC_RELAXED, __HIP_MEMORY_SCOPE_AGENT) < gen * npres) __builtin_amdgcn_s_sleep(5);
    __builtin_amdgcn_fence(__ATOMIC_ACQUIRE, "agent");
    asm volatile("s_waitcnt vmcnt(0)" ::: "memory");
  }
  __syncthreads();
}
#define GSYNC() do { ++bar_gen; grid_barrier_xcd(p.bar, bx_id, bar_gen, bx_cnt, bx_np); } while (0)
#ifndef ONLY
#define PH(n) 1
#else
#define PH(n) ((n) == ONLY || (n) / 100 == ONLY || (n) == ONLY / 100)
#endif
__global__ void __launch_bounds__(256, 2) mega(Params p) {
  cg::grid_group grid = cg::this_grid();
  __shared__ __attribute__((aligned(16))) char smem_raw[73728];
  u16* sm = (u16*)smem_raw;
  float* smf = (float*)smem_raw;
  const int nb = gridDim.x, bid = blockIdx.x;
  unsigned bar_target = 0, bar_gen = 0;
  grid.sync();
  const unsigned bx_id = xcc_id() & 7u;
  unsigned bx_cnt = 1, bx_np = 1;
  {
    if (otid() == 0) __hip_atomic_fetch_add(p.bar + 16 + bx_id, 1u, __ATOMIC_RELAXED, __HIP_MEMORY_SCOPE_AGENT);
    GSYNC_FLAT();
    unsigned np = 0;
#pragma unroll
    for (unsigned x = 0; x < 8; ++x) {
      const unsigned c = __hip_atomic_load(p.bar + 16 + x, __ATOMIC_RELAXED, __HIP_MEMORY_SCOPE_AGENT);
      if (c > 0) ++np;
      if (x == bx_id) bx_cnt = c;
    }
    bx_np = np;
  }

  if (PH(0)) {
    const int tid = otid();
    for (int j = bid; j < 4 * CJ8; j += nb) conv_job(p, j / CJ8, j % CJ8, smf);
    for (int j = bid; j < 4 * 96; j += nb) mods_tile(p, j / 96, j % 96, smf);
    for (int j = bid; j < 64; j += nb) s5pre_tile(p, j);
    {
      const float4* xp = (const float4*)p.in[0];
      const float4* xs = (const float4*)p.in[1];
      float4* o = (float4*)p.out;
      const size_t nP = (size_t)TP_ * 256, nT = (size_t)T_ * 256;
      for (size_t i = (size_t)bid * 256 + tid; i < nT; i += (size_t)nb * 256) o[i] = i < nP ? xp[i] : xs[i - nP];
    }
    {
      float* rope = (float*)(p.ws + B_ROPE);
      for (int i = bid * 256 + tid; i < 2048 * 16; i += nb * 256) {
        const int pos = i >> 4, f = i & 15;
        const float invf = 1.f / powf(10000.f, (float)(f & 7) * 0.125f);
        const float ang = (f < 8 ? (float)(pos >> 6) : (float)(pos & 63)) * invf;
        float sn, cs;
        sincosf(ang, &sn, &cs);
        rope[i * 2] = cs; rope[i * 2 + 1] = sn;
      }
    }
    {
      u16* cc = (u16*)(p.ws + B_CKVC);
      for (int i = bid * 256 + tid; i < 8 * 4 * 256 * 256 / 2; i += nb * 256) {
        const int e = i * 2;
        const int c = e & 255, pos = (e >> 8) & 255, l = (e >> 16) & 3, b = e >> 18;
        float2 v = *(const float2*)(p.in[5] + e);
        *(unsigned*)(cc + ((size_t)(l * 2048 + b * 256 + pos)) * 256 + c) = pack2(v.x, v.y);
      }
    }
  }
  GSYNC();

  for (int l = 0; l < 4; ++l) {
    const u16* WL = (const u16*)(p.ws + B_W) + (size_t)l * W_LAYER;
    const float* mods = (const float*)(p.ws + B_MODS);
    if (PH(1)) norm_phase(p, l, 0, 1, p.in[11] + l * 1024);
    GSYNC();
    if (PH(2)) gemm_in_phase(p, l, sm);
    GSYNC();
    if (PH(3)) {
      for (int j = bid; j < NCH; j += nb) delta_prep_tile(p, l, j, sm);
      for (int j = bid; j < T_ / 4; j += nb) mla_prep_tile(p, l, j);
      for (int j = bid; j < 256; j += nb) cache_rope_tile(p, l, j);
      for (int j = bid; j < NCH * 16; j += nb) s5_chunk_tile(p, l, j >> 4, j & 15, 0, sm);
    }
    GSYNC();
    if (PH(4)) {
      const int tid = otid();
      if (PH(400)) for (int j = bid; j < NCH * 2; j += nb) delta_local_tile(p, j, smf);
      if (PH(410)) for (int j = (bid + (nb >> 1)) % nb; j < 192 * 6; j += nb) {
          const int q = j, mt = q / 6, nt = q % 6;
          f32x4 acc[4][4];
          zero_acc<4>(acc);
          gemm_core<4>(acc, (const u16*)(p.ws + B_QA) + (size_t)mt * 128 * 384, 384, WL + W_QB + (size_t)nt * 128 * 384, 384, 384, sm);
          u16* qm = (u16*)(p.ws + B_QM);
          const float qs = 0.10206207261596575f * 1.4426950408889634f;
          const float* rope = (const float*)(p.ws + B_ROPE);
          const int e_lane = tid & 63, e_w = tid >> 6, e_wr = e_w >> 1, e_wc = e_w & 1, e_fr = e_lane & 15, e_fq = e_lane >> 4;
          const bool is_s = (mt * 128 >= TP_);
#pragma unroll
          for (int i = 0; i < 4; ++i) {
            const int row = mt * 128 + e_wr * 64 + i * 16 + e_fr;
            f32x4 vals[4];
#pragma unroll
            for (int jj = 0; jj < 4; ++jj) vals[jj] = acc[i][jj];
            if (is_s) {
              const int pos = (row - TP_) & 2047;
              const float4 cs0 = *(const float4*)(rope + (size_t)(pos * 16 + e_fq * 4) * 2);
              const float4 cs1 = *(const float4*)(rope + (size_t)(pos * 16 + e_fq * 4) * 2 + 4);
              const float cs[4] = {cs0.x, cs0.z, cs1.x, cs1.z}, sn[4] = {cs0.y, cs0.w, cs1.y, cs1.w};
#pragma unroll
              for (int jj = 0; jj < 4; jj += 2) {
                const int gt = (nt * 128 + e_wc * 64) / 16 + jj;
                if (gt % 6 == 4) {
#pragma unroll
                  for (int r = 0; r < 4; ++r) {
                    const float x1 = vals[jj][r], x2 = vals[jj + 1][r];
                    vals[jj][r] = x1 * cs[r] - x2 * sn[r];
                    vals[jj + 1][r] = x2 * cs[r] + x1 * sn[r];
                  }
                }
              }
            }
#pragma unroll
            for (int jj = 0; jj < 4; ++jj) {
              f32x4 o; o[0] = vals[jj][0] * qs; o[1] = vals[jj][1] * qs; o[2] = vals[jj][2] * qs; o[3] = vals[jj][3] * qs;
              *(uint2*)(qm + (size_t)row * 768 + nt * 128 + e_wc * 64 + jj * 16 + e_fq * 4) = pack4(o);
            }
          }
      }
      if (PH(420)) for (int j = (bid + (nb >> 1) + (nb >> 2)) % nb; j < 208 * 8; j += nb) {
          const int q = j, mt = q >> 3, head = q & 7;
          f32x4 acc[4][4];
          zero_acc<4>(acc);
          const u16* A = mt < 192 ? (const u16*)(p.ws + B_KVA) + (size_t)mt * 128 * 256
                                  : (const u16*)(p.ws + B_CKVC) + ((size_t)l * 2048 + (size_t)(mt - 192) * 128) * 256;
          gemm_core<4, false>(acc, A, 256, WL + W_KVB + (size_t)head * 128 * 256, 256, 256, sm);
          int key0, nkeys; size_t kbo, vto;
          if (mt < 64) { const int seq = mt >> 1; key0 = (mt & 1) * 128; nkeys = 256; kbo = (size_t)(seq * 8 + head) * 256 * 96; vto = (size_t)(seq * 8 + head) * 64 * 256; }
          else if (mt < 192) { const int s = (mt - 64) >> 4; key0 = 256 + ((mt - 64) & 15) * 128; nkeys = 2304; kbo = KB_P + (size_t)(s * 8 + head) * 2304 * 96; vto = VT_P + (size_t)(s * 8 + head) * 64 * 2304; }
          else { const int s = (mt - 192) >> 1; key0 = ((mt - 192) & 1) * 128; nkeys = 2304; kbo = KB_P + (size_t)(s * 8 + head) * 2304 * 96; vto = VT_P + (size_t)(s * 8 + head) * 64 * 2304; }
          u16* kb = (u16*)(p.ws + B_KB) + kbo;
          u16* vt = (u16*)(p.ws + B_VT) + vto;
          const int e_lane = tid & 63, e_w = tid >> 6, e_wr = e_w >> 1, e_wc = e_w & 1, e_fr = e_lane & 15, e_fq = e_lane >> 4;
#pragma unroll
          for (int i = 0; i < 4; ++i)
#pragma unroll
            for (int jj = 0; jj < 4; ++jj) {
              const int key = key0 + e_wr * 64 + i * 16 + e_fq * 4;
              const int c = jj * 16 + e_fr;
              if (e_wc == 0) {
#pragma unroll
                for (int r = 0; r < 4; ++r) kb[(size_t)(key + r) * 96 + c] = f2bf(acc[i][jj][r]);
              } else {
                *(uint2*)(vt + (size_t)c * nkeys + key) = make_uint2(pack2(acc[i][jj][0], acc[i][jj][1]), pack2(acc[i][jj][2], acc[i][jj][3]));
              }
            }
      }
      if (PH(430)) for (int j = bid; j < 640; j += nb) s5_carry_tile(p, l, j);
    }
    GSYNC();
    if (PH(5)) {
      if (PH(500)) for (int j = bid; j < 320; j += nb) delta_scan_tile(p, l, j, sm);
      if (PH(510)) if (bid >= 64) for (int j = bid - 64; j < 1536; j += nb - 64) {
        if (j < 1024) attn_tile(p, 32 + (j >> 7), (j >> 4) & 7, j & 15, sm);
        else { const int q = j - 1024; attn_tile(p, q >> 4, (q >> 1) & 7, q & 1, sm); }
      }
      if (PH(530)) if (bid >= 64) for (int j = bid - 64; j < NCH * 8; j += nb - 64) {
        s5_chunk_tile(p, l, j >> 3, (j & 7) * 2, 1, sm);
        s5_chunk_tile(p, l, j >> 3, (j & 7) * 2 + 1, 1, sm);
      }
    }
    GSYNC();
    if (PH(6)) {
      for (int j = bid; j < T_ / 16; j += nb) delta_out_tile(p, l, j);
      for (int j = bid; j < 192 * 4; j += nb) {
        {
          const int q = j, mt = q >> 2, nt = q & 3;
          f32x4 acc[4][4];
          zero_acc<4>(acc);
          const u16* y5 = (const u16*)(p.ws + B_Y5);
          gemm_core<4>(acc, y5 + (size_t)mt * 128 * 512, 512, WL + W_GLU + (size_t)nt * 128 * 512, 512, 512, sm);
          u16* ob5 = (u16*)(p.ws + B_OB5);
          const float* bgl = p.in[27] + l * 512;
          EPI_LOOP(4) {
            const size_t row = mt * 128 + EROW; const int col = nt * 128 + ECOL4(4);
            const uint2 yy = *(const uint2*)(y5 + row * 512 + col);
            const float4 bb = *(const float4*)(bgl + col);
            f32x4 o;
            o[0] = blo(yy.x) * sigmoidf_(acc[i][j][0] + bb.x); o[1] = bhi(yy.x) * sigmoidf_(acc[i][j][1] + bb.y);
            o[2] = blo(yy.y) * sigmoidf_(acc[i][j][2] + bb.z); o[3] = bhi(yy.y) * sigmoidf_(acc[i][j][3] + bb.w);
            *(uint2*)(ob5 + row * 512 + col) = pack4(o);
          }
        }
      }
    }
    GSYNC();
    if (PH(7)) {
      const u16* H = (const u16*)(p.ws + B_H);
      u16* mg = (u16*)(p.ws + B_MG);
      for (int j = bid; j < 192 * 16; j += nb) {
        const int mt = j >> 4, nt = j & 15;
        f32x4 mer[4][2];
        zero_acc<2>(mer);
#pragma unroll 1
        for (int n = 0; n < 3; ++n) {
          f32x4 ag[4][2], ab[4][2];
          zero_acc<2>(ag);
          gemm_core<2>(ag, H + (size_t)mt * 128 * 1024, 1024, WL + W_G + (size_t)(n * 1024 + nt * 64) * 1024, 1024, 1024, sm);
          zero_acc<2>(ab);
          const u16* on = (const u16*)(p.ws + (n == 0 ? B_OA : (n == 1 ? B_OB5 : B_OC)));
          gemm_core<2>(ab, on + (size_t)mt * 128 * 512, 512, WL + W_BR + (size_t)(nt * 64) * 1536 + n * 512, 1536, 512, sm);
#pragma unroll
          for (int i = 0; i < 4; ++i)
#pragma unroll
            for (int jj = 0; jj < 2; ++jj)
#pragma unroll
              for (int r = 0; r < 4; ++r) mer[i][jj][r] += sigmoidf_(ag[i][jj][r]) * ab[i][jj][r];
        }
        EPI_LOOP(2) { *(uint2*)(mg + (size_t)(mt * 128 + EROW) * 1024 + nt * 64 + ECOL4(2)) = pack4(mer[i][j]); }
      }
    }
    GSYNC();
    if (PH(8)) {
      const u16* mg = (const u16*)(p.ws + B_MG);
      for (int j = bid; j < 192 * 8; j += nb) {
        const int mt = j >> 3, nt = j & 7;
        f32x4 acc[4][4];
        zero_acc<4>(acc);
        gemm_core<4>(acc, mg + (size_t)mt * 128 * 1024, 1024, WL + W_OUT + (size_t)nt * 128 * 1024, 1024, 1024, sm);
        const float* gm = mods + (size_t)(l * 9 + tok_v(mt * 128)) * 6144 + 2 * 1024;
        EPI_LOOP(4) {
          const size_t row = mt * 128 + EROW; const int col = nt * 128 + ECOL4(4);
          float4* xp_ = (float4*)(p.out + row * 1024 + col);
          float4 xv = *xp_; const float4 gg = *(const float4*)(gm + col);
          xv.x += gg.x * acc[i][j][0]; xv.y += gg.y * acc[i][j][1]; xv.z += gg.z * acc[i][j][2]; xv.w += gg.w * acc[i][j][3];
          *xp_ = xv;
        }
      }
    }
    GSYNC();
    if (PH(9)) norm_phase(p, l, 3, 4, p.in[12] + l * 1024);
    GSYNC();
    if (PH(10)) {
      const u16* H = (const u16*)(p.ws + B_H);
      u16* up = (u16*)(p.ws + B_UP);
      for (int j = bid; j < 192 * 44; j += nb) {
        const int mt = j / 44, nt = j % 44;
        f32x4 acc[4][4];
        zero_acc<4>(acc);
        gemm_core<4>(acc, H + (size_t)mt * 128 * 1024, 1024, WL + W_UP + (size_t)nt * 128 * 1024, 1024, 1024, sm);
        EPI_LOOP(4) { *(uint2*)(up + (size_t)(mt * 128 + EROW) * 5632 + nt * 128 + ECOL4(4)) = pack4(acc[i][j]); }
      }
    }
    GSYNC();
    if (PH(11)) {
      const int tid = otid();
      const u16* up = (const u16*)(p.ws + B_UP);
      u16* act = (u16*)(p.ws + B_ACT);
      const float* cw = p.in[35] + (size_t)l * 3 * 5632;
      const float* cb = p.in[36] + (size_t)l * 5632;
      constexpr int TG = 16;
      for (int it = bid * 256 + tid; it < (T_ / TG) * 352; it += nb * 256) {
        const int t0 = (it / 352) * TG, c8 = (it % 352) * 8;
        int pos0, L;
        if (t0 < TP_) { pos0 = t0 & 255; L = 256; } else { pos0 = (t0 - TP_) & 2047; L = 2048; }
        float wg[3][8], wv[3][8], bgv[8], bvv[8];
#pragma unroll
        for (int d = 0; d < 3; ++d) {
          const float4 g0 = *(const float4*)(cw + d * 5632 + c8), g1 = *(const float4*)(cw + d * 5632 + c8 + 4);
          const float4 v0 = *(const float4*)(cw + d * 5632 + 2816 + c8), v1 = *(const float4*)(cw + d * 5632 + 2816 + c8 + 4);
          wg[d][0] = g0.x; wg[d][1] = g0.y; wg[d][2] = g0.z; wg[d][3] = g0.w; wg[d][4] = g1.x; wg[d][5] = g1.y; wg[d][6] = g1.z; wg[d][7] = g1.w;
          wv[d][0] = v0.x; wv[d][1] = v0.y; wv[d][2] = v0.z; wv[d][3] = v0.w; wv[d][4] = v1.x; wv[d][5] = v1.y; wv[d][6] = v1.z; wv[d][7] = v1.w;
        }
        {
          const float4 g0 = *(const float4*)(cb + c8), g1 = *(const float4*)(cb + c8 + 4);
          const float4 v0 = *(const float4*)(cb + 2816 + c8), v1 = *(const float4*)(cb + 2816 + c8 + 4);
          bgv[0] = g0.x; bgv[1] = g0.y; bgv[2] = g0.z; bgv[3] = g0.w; bgv[4] = g1.x; bgv[5] = g1.y; bgv[6] = g1.z; bgv[7] = g1.w;
          bvv[0] = v0.x; bvv[1] = v0.y; bvv[2] = v0.z; bvv[3] = v0.w; bvv[4] = v1.x; bvv[5] = v1.y; bvv[6] = v1.z; bvv[7] = v1.w;
        }
        uint4 g0r = make_uint4(0, 0, 0, 0), v0r = g0r, g1r, v1r, g2r, v2r;
        if (pos0 > 0) { const u16* rp = up + (size_t)(t0 - 1) * 5632; g0r = *(const uint4*)(rp + c8); v0r = *(const uint4*)(rp + 2816 + c8); }
        { const u16* rp = up + (size_t)t0 * 5632; g1r = *(const uint4*)(rp + c8); v1r = *(const uint4*)(rp + 2816 + c8); }
#pragma unroll 4
        for (int o = 0; o < TG; ++o) {
          g2r = make_uint4(0, 0, 0, 0); v2r = g2r;
          if (pos0 + o + 1 < L) { const u16* rp = up + (size_t)(t0 + o + 1) * 5632; g2r = *(const uint4*)(rp + c8); v2r = *(const uint4*)(rp + 2816 + c8); }
          const unsigned ga[3][4] = {{g0r.x, g0r.y, g0r.z, g0r.w}, {g1r.x, g1r.y, g1r.z, g1r.w}, {g2r.x, g2r.y, g2r.z, g2r.w}};
          const unsigned va[3][4] = {{v0r.x, v0r.y, v0r.z, v0r.w}, {v1r.x, v1r.y, v1r.z, v1r.w}, {v2r.x, v2r.y, v2r.z, v2r.w}};
          float res[8];
#pragma unroll
          for (int e = 0; e < 8; ++e) {
            float g = bgv[e], v = bvv[e];
#pragma unroll
            for (int d = 0; d < 3; ++d) {
              const float xg = (e & 1) ? bhi(ga[d][e >> 1]) : blo(ga[d][e >> 1]);
              const float xv = (e & 1) ? bhi(va[d][e >> 1]) : blo(va[d][e >> 1]);
              g += wg[d][e] * xg; v += wv[d][e] * xv;
            }
            res[e] = siluf_(g) * v;
          }
          *(uint4*)(act + (size_t)(t0 + o) * 2816 + c8) = make_uint4(pack2(res[0], res[1]), pack2(res[2], res[3]), pack2(res[4], res[5]), pack2(res[6], res[7]));
          g0r = g1r; v0r = v1r; g1r = g2r; v1r = v2r;
        }
      }
    }
    GSYNC();
    if (PH(12)) {
      const u16* act = (const u16*)(p.ws + B_ACT);
      for (int j = bid; j < 192 * 8; j += nb) {
        const int mt = j >> 3, nt = j & 7;
        f32x4 acc[4][4];
        zero_acc<4>(acc);
        gemm_core<4>(acc, act + (size_t)mt * 128 * 2816, 2816, WL + W_DN + (size_t)nt * 128 * 2816, 2816, 2816, sm);
        const float* gf = mods + (size_t)(l * 9 + tok_v(mt * 128)) * 6144 + 5 * 1024;
        EPI_LOOP(4) {
          const size_t row = mt * 128 + EROW; const int col = nt * 128 + ECOL4(4);
          float4* xp_ = (float4*)(p.out + row * 1024 + col);
          float4 xv = *xp_; const float4 gg = *(const float4*)(gf + col);
          xv.x += gg.x * acc[i][j][0]; xv.y += gg.y * acc[i][j][1]; xv.z += gg.z * acc[i][j][2]; xv.w += gg.w * acc[i][j][3];
          *xp_ = xv;
        }
      }
    }
    GSYNC();
  }
  if (PH(13)) {
    const int tid = otid();
    const int lane = tid & 63, w = tid >> 6;
    const float* gfin = p.in[38];
    for (int tile = bid; tile < T_ / 4; tile += nb) {
      const int t = tile * 4 + w;
      float4* xr = (float4*)(p.out + (size_t)t * 1024);
      float4 v[4];
      float ss = 0.f;
#pragma unroll
      for (int j = 0; j < 4; ++j) { v[j] = xr[lane + 64 * j]; ss += v[j].x * v[j].x + v[j].y * v[j].y + v[j].z * v[j].z + v[j].w * v[j].w; }
      ss = wave_sum(ss);
      const float rstd = rsqrtf(ss * (1.f / 1024.f) + 1e-6f);
#pragma unroll
      for (int j = 0; j < 4; ++j) {
        float4 g = *(const float4*)(gfin + (lane + 64 * j) * 4);
        xr[lane + 64 * j] = make_float4(v[j].x * rstd * g.x, v[j].y * rstd * g.y, v[j].z * rstd * g.z, v[j].w * rstd * g.w);
      }
    }
  }
}

extern "C" void kernel_launch(void* const* d_in, const int* in_sizes, int n_in, void* d_out, int out_size,
                              void* d_ws, size_t ws_size, hipStream_t stream) {
  static int grid_blocks = 0;
  if (!grid_blocks) {
    int dev = 0, cus = 0, per_cu = 0;
    (void)hipGetDevice(&dev);
    (void)hipDeviceGetAttribute(&cus, hipDeviceAttributeMultiprocessorCount, dev);
    (void)hipOccupancyMaxActiveBlocksPerMultiprocessor(&per_cu, mega, 256, 0);
    if (per_cu > 2) per_cu = 2;
    if (per_cu < 1) per_cu = 1;
    grid_blocks = cus * per_cu;
  }
  if (ws_size < B_TOTAL || n_in < 39) {
    fprintf(stderr, "workspace too small: %zu < %zu\n", ws_size, (size_t)B_END);
    return;
  }
  Params p{};
  for (int i = 0; i < 39; ++i) p.in[i] = (const float*)d_in[i];
  p.out = (float*)d_out;
  p.ws = (char*)d_ws;
  p.bar = (unsigned*)((char*)d_ws + B_BAR);
  (void)hipMemsetAsync(p.bar, 0, 4096, stream);
  void* args[] = {&p};
  hipError_t e = hipLaunchCooperativeKernel((void*)mega, dim3(grid_blocks), dim3(256), args, 0, stream);
  if (e != hipSuccess) fprintf(stderr, "cooperative launch failed: %s (grid %d)\n", hipGetErrorString(e), grid_blocks);
}
```

```cpp
#include <hip/hip_runtime.h>
#include <hip/hip_cooperative_groups.h>
#include <cstdio>
namespace cg = cooperative_groups;

#define DI __device__ __forceinline__
typedef __bf16 bf16;
using bf16x8 = __attribute__((ext_vector_type(8))) short;
using f32x4 = __attribute__((ext_vector_type(4))) float;
using f32x16 = __attribute__((ext_vector_type(16))) float;
typedef unsigned short u16;

constexpr int T_ = 24576, TP_ = 8192;
constexpr int NCH = 384;
constexpr long long O_SD = 25165824LL, O_S5RE = 41943040LL, O_S5IM = 42467328LL, O_CKV = 42991616LL, O_KR = 51380224LL;

constexpr size_t W_IN = 0;
constexpr size_t W_G = W_IN + 3328ull * 1024;
constexpr size_t W_QB = W_G + 3072ull * 1024;
constexpr size_t W_KVB = W_QB + 768ull * 384;
constexpr size_t W_GLU = W_KVB + 1024ull * 256;
constexpr size_t W_BR = W_GLU + 512ull * 512;
constexpr size_t W_OUT = W_BR + 1024ull * 1536;
constexpr size_t W_UP = W_OUT + 1024ull * 1024;
constexpr size_t W_DN = W_UP + 5632ull * 1024;
constexpr size_t W_LAYER = W_DN + 1024ull * 2816;

constexpr size_t al(size_t x) { return (x + 255) & ~(size_t)255; }
constexpr size_t B_W = 0;
constexpr size_t B_MODS = al(B_W + 4 * W_LAYER * 2);
constexpr size_t B_ROPE = al(B_MODS + 4ull * 9 * 6144 * 4);
constexpr size_t B_LAMB = al(B_ROPE + 2048ull * 32 * 4);
constexpr size_t B_LAM64 = al(B_LAMB + 4ull * 2 * 32 * 64 * 8);
constexpr size_t B_BBT = al(B_LAM64 + 4ull * 2 * 32 * 64 * 8);
constexpr size_t B_CMT = al(B_BBT + 4ull * 2 * 32 * 128 * 16 * 2);
constexpr size_t B_CKVC = al(B_CMT + 4ull * 32 * 16 * 128 * 2);
constexpr size_t B_H = al(B_CKVC + 4ull * 2048 * 256 * 2);
constexpr size_t B_QKV = al(B_H + (size_t)T_ * 1024 * 2);
constexpr size_t B_Z = al(B_QKV + (size_t)T_ * 1536 * 2);
constexpr size_t B_US5 = al(B_Z + (size_t)T_ * 512 * 2);
constexpr size_t B_QA = al(B_US5 + (size_t)T_ * 512 * 2);
constexpr size_t B_KVA = al(B_QA + (size_t)T_ * 384 * 2);
constexpr size_t B_MISC = al(B_KVA + (size_t)T_ * 256 * 2);
constexpr size_t B_QN = al(B_MISC + (size_t)T_ * 48 * 4);
constexpr size_t B_KN = al(B_QN + (size_t)T_ * 512 * 2);
constexpr size_t B_VV = al(B_KN + (size_t)T_ * 512 * 2);
constexpr size_t B_KT = al(B_VV + (size_t)T_ * 512 * 2);
constexpr size_t B_BG = al(B_KT + (size_t)T_ * 512 * 2);
constexpr size_t B_TM = al(B_BG + (size_t)T_ * 16 * 4);
constexpr size_t B_QKM = al(B_TM + (size_t)T_ * 512 * 2);
constexpr size_t B_GC = al(B_QKM + (size_t)T_ * 512 * 2);
constexpr size_t B_BC = al(B_GC + (size_t)NCH * 4 * 2 * 64 * 4);
constexpr size_t KB_P = 32ull * 8 * 256 * 96, KB_S = 8ull * 8 * 2304 * 96;
constexpr size_t VT_P = 32ull * 8 * 64 * 256, VT_S = 8ull * 8 * 64 * 2304;
constexpr size_t B_KB = al(B_BC + (size_t)NCH * 4 * 2 * 64 * 4);
constexpr size_t B_VT = al(B_KB + (KB_P + KB_S) * 2);
constexpr size_t B_QM = al(B_VT + (VT_P + VT_S) * 2);
constexpr size_t B_HEND = al(B_QM + (size_t)T_ * 768 * 2);
constexpr size_t B_HIN = al(B_HEND + (size_t)NCH * 32 * 2 * 64 * 8);
constexpr size_t B_Y5 = al(B_HIN + (size_t)NCH * 32 * 2 * 64 * 8);
constexpr size_t B_OC = al(B_Y5 + (size_t)T_ * 512 * 2);
constexpr size_t B_END = al(B_OC + (size_t)T_ * 512 * 2);
constexpr size_t B_OF = B_QKV;
constexpr size_t B_OB = B_QKV + (size_t)T_ * 512 * 2;
constexpr size_t B_MG = B_QKV;
constexpr size_t B_OA = B_QN;
constexpr size_t B_OB5 = B_KN;
constexpr size_t B_UP = B_QKV;
constexpr size_t B_ACT = B_KB;
static_assert(B_UP + (size_t)T_ * 5632 * 2 <= B_KB, "UP overlaps ACT");
static_assert(B_ACT + (size_t)T_ * 2816 * 2 <= B_END, "ACT too big");
constexpr size_t B_BAR = B_END;
constexpr size_t B_TOTAL = B_BAR + 4096;
static_assert(B_TOTAL <= 768ull * 1024 * 1024, "workspace too big");

struct Params {
  const float* in[39];
  float* out;
  char* ws;
  unsigned* bar;
};

DI int otid() { int t = (int)__builtin_amdgcn_workitem_id_x(); asm volatile("" : "+v"(t)); return t; }
DI unsigned pack2(float a, float b) {
  typedef __attribute__((ext_vector_type(2))) __bf16 bf2;
  bf2 v; v[0] = (__bf16)a; v[1] = (__bf16)b;
  return __builtin_bit_cast(unsigned, v);
}
DI u16 f2bf(float a) { return (u16)(pack2(a, 0.f) & 0xffffu); }
DI float bf2f(u16 u) { return __uint_as_float(((unsigned)u) << 16); }
DI float blo(unsigned u) { return __uint_as_float(u << 16); }
DI float bhi(unsigned u) { return __uint_as_float(u & 0xffff0000u); }
DI float wave_sum(float v) {
#pragma unroll
  for (int o = 32; o > 0; o >>= 1) v += __shfl_xor(v, o);
  return v;
}
DI float sigmoidf_(float x) { return 1.f / (1.f + __expf(-x)); }
DI float siluf_(float x) { return x / (1.f + __expf(-x)); }
DI int tok_v(int t) { return t < TP_ ? 0 : 1 + ((t - TP_) >> 11); }
DI int crow(int r, int h2) { return (r & 3) + 8 * (r >> 2) + 4 * h2; }
DI bf16x8 mk8(unsigned a, unsigned b, unsigned c, unsigned d) {
  uint4 p = make_uint4(a, b, c, d);
  return __builtin_bit_cast(bf16x8, p);
}
DI bf16x8 pack_acc(const f32x16& x, int s) {
  return mk8(pack2(x[8 * s], x[8 * s + 1]), pack2(x[8 * s + 2], x[8 * s + 3]), pack2(x[8 * s + 4], x[8 * s + 5]),
             pack2(x[8 * s + 6], x[8 * s + 7]));
}
DI bf16x8 load_perm(const u16* rowptr, int s, int h2) {
  uint2 a = *(const uint2*)(rowptr + 16 * s + 4 * h2);
  uint2 b = *(const uint2*)(rowptr + 16 * s + 8 + 4 * h2);
  return mk8(a.x, a.y, b.x, b.y);
}
DI unsigned swap16(unsigned u) { return (u >> 16) | (u << 16); }
DI bf16x8 load_perm_rev(const u16* rowptr, int base, int s, int h2) {
  uint2 a = *(const uint2*)(rowptr + 60 - base - 16 * s - 4 * h2);
  uint2 b = *(const uint2*)(rowptr + 52 - base - 16 * s - 4 * h2);
  return mk8(swap16(a.y), swap16(a.x), swap16(b.y), swap16(b.x));
}
#define MFMA16(a, b, c) __builtin_amdgcn_mfma_f32_16x16x32_bf16((a), (b), (c), 0, 0, 0)
#define MFMA32(a, b, c) __builtin_amdgcn_mfma_f32_32x32x16_bf16((a), (b), (c), 0, 0, 0)

template <int NJ, bool SWAP = true>
DI void gemm_core(f32x4 (&acc)[4][NJ], const u16* __restrict__ A, int lda, const u16* __restrict__ B, int ldb, int K,
                  u16* sm) {
  const int tid = otid(), lane = tid & 63, w = tid >> 6, wr = w >> 1, wc = w & 1;
  const int fr = lane & 15, fq = lane >> 4;
  constexpr int RS = 136;
  const int lrow = tid >> 4, lkc = tid & 15;
  uint4 a0, a1, a2, a3, a4, a5, a6, a7, b0, b1, b2, b3, b4, b5, b6, b7;
  b4 = b5 = b6 = b7 = make_uint4(0, 0, 0, 0);
  const u16* ap = A + (size_t)lrow * lda + lkc * 8;
  const u16* bp = B + (size_t)lrow * ldb + lkc * 8;
  const int nk = K >> 7;
  u16* as = sm;
  u16* bs = sm + 128 * RS;
  {
    const int k0 = 0;
    a0 = *(const uint4*)(ap + (size_t)(0 * 16) * lda + k0);
    a1 = *(const uint4*)(ap + (size_t)(1 * 16) * lda + k0);
    a2 = *(const uint4*)(ap + (size_t)(2 * 16) * lda + k0);
    a3 = *(const uint4*)(ap + (size_t)(3 * 16) * lda + k0);
    a4 = *(const uint4*)(ap + (size_t)(4 * 16) * lda + k0);
    a5 = *(const uint4*)(ap + (size_t)(5 * 16) * lda + k0);
    a6 = *(const uint4*)(ap + (size_t)(6 * 16) * lda + k0);
    a7 = *(const uint4*)(ap + (size_t)(7 * 16) * lda + k0);
    b0 = *(const uint4*)(bp + (size_t)(0 * 16) * ldb + k0);
    b1 = *(const uint4*)(bp + (size_t)(1 * 16) * ldb + k0);
    b2 = *(const uint4*)(bp + (size_t)(2 * 16) * ldb + k0);
    b3 = *(const uint4*)(bp + (size_t)(3 * 16) * ldb + k0);
    if (NJ == 4) b4 = *(const uint4*)(bp + (size_t)(4 * 16) * ldb + k0);
    if (NJ == 4) b5 = *(const uint4*)(bp + (size_t)(5 * 16) * ldb + k0);
    if (NJ == 4) b6 = *(const uint4*)(bp + (size_t)(6 * 16) * ldb + k0);
    if (NJ == 4) b7 = *(const uint4*)(bp + (size_t)(7 * 16) * ldb + k0);
  }
  for (int kt = 0; kt < nk; ++kt) {
    __syncthreads();
    *(uint4*)(as + (lrow + 0 * 16) * RS + lkc * 8) = a0;
    *(uint4*)(as + (lrow + 1 * 16) * RS + lkc * 8) = a1;
    *(uint4*)(as + (lrow + 2 * 16) * RS + lkc * 8) = a2;
    *(uint4*)(as + (lrow + 3 * 16) * RS + lkc * 8) = a3;
    *(uint4*)(as + (lrow + 4 * 16) * RS + lkc * 8) = a4;
    *(uint4*)(as + (lrow + 5 * 16) * RS + lkc * 8) = a5;
    *(uint4*)(as + (lrow + 6 * 16) * RS + lkc * 8) = a6;
    *(uint4*)(as + (lrow + 7 * 16) * RS + lkc * 8) = a7;
    *(uint4*)(bs + (lrow + 0 * 16) * RS + lkc * 8) = b0;
    *(uint4*)(bs + (lrow + 1 * 16) * RS + lkc * 8) = b1;
    *(uint4*)(bs + (lrow + 2 * 16) * RS + lkc * 8) = b2;
    *(uint4*)(bs + (lrow + 3 * 16) * RS + lkc * 8) = b3;
    if (NJ == 4) *(uint4*)(bs + (lrow + 4 * 16) * RS + lkc * 8) = b4;
    if (NJ == 4) *(uint4*)(bs + (lrow + 5 * 16) * RS + lkc * 8) = b5;
    if (NJ == 4) *(uint4*)(bs + (lrow + 6 * 16) * RS + lkc * 8) = b6;
    if (NJ == 4) *(uint4*)(bs + (lrow + 7 * 16) * RS + lkc * 8) = b7;
    __syncthreads();
    {
      const int k0 = (kt + 1 < nk ? kt + 1 : kt) * 128;
    a0 = *(const uint4*)(ap + (size_t)(0 * 16) * lda + k0);
    a1 = *(const uint4*)(ap + (size_t)(1 * 16) * lda + k0);
    a2 = *(const uint4*)(ap + (size_t)(2 * 16) * lda + k0);
    a3 = *(const uint4*)(ap + (size_t)(3 * 16) * lda + k0);
    a4 = *(const uint4*)(ap + (size_t)(4 * 16) * lda + k0);
    a5 = *(const uint4*)(ap + (size_t)(5 * 16) * lda + k0);
    a6 = *(const uint4*)(ap + (size_t)(6 * 16) * lda + k0);
    a7 = *(const uint4*)(ap + (size_t)(7 * 16) * lda + k0);
    b0 = *(const uint4*)(bp + (size_t)(0 * 16) * ldb + k0);
    b1 = *(const uint4*)(bp + (size_t)(1 * 16) * ldb + k0);
    b2 = *(const uint4*)(bp + (size_t)(2 * 16) * ldb + k0);
    b3 = *(const uint4*)(bp + (size_t)(3 * 16) * ldb + k0);
    if (NJ == 4) b4 = *(const uint4*)(bp + (size_t)(4 * 16) * ldb + k0);
    if (NJ == 4) b5 = *(const uint4*)(bp + (size_t)(5 * 16) * ldb + k0);
    if (NJ == 4) b6 = *(const uint4*)(bp + (size_t)(6 * 16) * ldb + k0);
    if (NJ == 4) b7 = *(const uint4*)(bp + (size_t)(7 * 16) * ldb + k0);
    }
    __builtin_amdgcn_s_setprio(1);
    __builtin_amdgcn_iglp_opt(0);
#pragma unroll
    for (int ks = 0; ks < 4; ++ks) {
      bf16x8 af[4], bfr[NJ];
#pragma unroll
      for (int i = 0; i < 4; ++i) af[i] = *(const bf16x8*)(as + (wr * 64 + i * 16 + fr) * RS + ks * 32 + fq * 8);
#pragma unroll
      for (int j = 0; j < NJ; ++j) bfr[j] = *(const bf16x8*)(bs + (wc * NJ * 16 + j * 16 + fr) * RS + ks * 32 + fq * 8);
#pragma unroll
      for (int i = 0; i < 4; ++i)
#pragma unroll
        for (int j = 0; j < NJ; ++j) acc[i][j] = SWAP ? MFMA16(bfr[j], af[i], acc[i][j]) : MFMA16(af[i], bfr[j], acc[i][j]);
    }
    __builtin_amdgcn_s_setprio(0);
  }
}
template <int NJ>
DI void zero_acc(f32x4 (&acc)[4][NJ]) {
#pragma unroll
  for (int i = 0; i < 4; ++i)
#pragma unroll
    for (int j = 0; j < NJ; ++j) acc[i][j] = f32x4{0.f, 0.f, 0.f, 0.f};
}
#define EPI_LOOP(NJ_)                                                              \
  const int e_lane = otid() & 63, e_w = otid() >> 6;                               \
  const int e_wr = e_w >> 1, e_wc = e_w & 1, e_fr = e_lane & 15, e_fq = e_lane >> 4; \
  _Pragma("unroll") for (int i = 0; i < 4; ++i)                                    \
  _Pragma("unroll") for (int j = 0; j < NJ_; ++j)
#define EROW (e_wr * 64 + i * 16 + e_fr)
#define ECOL4(NJ_) (e_wc * NJ_ * 16 + j * 16 + e_fq * 4)
DI uint2 pack4(const f32x4& v) { return make_uint2(pack2(v[0], v[1]), pack2(v[2], v[3])); }

DI int colmap(int kind, int n) {
  if (kind == 0) {
    if (n < 2048) return n;
    if (n < 2560) return 2064 + (n - 2048);
    if (n < 2944) return 2576 + (n - 2560);
    if (n < 3200) return 2960 + (n - 2944);
    int j = n - 3200;
    if (j < 16) return 2048 + j;
    if (j < 48) return 3216 + (j - 16);
    return -1;
  }
  if (kind == 1) return 3248 + n;
  return n;
}
DI void convT_tile(const float* __restrict__ src, int lds, int K, u16* __restrict__ dst, int kind, int kt, int nt,
                   float* sm) {
  const int tid = otid();
  const int c = tid & 63;
  const int sc = colmap(kind, nt * 64 + c);
  __syncthreads();
#pragma unroll 4
  for (int i = 0; i < 16; ++i) {
    int r = (tid >> 6) + i * 4;
    float v = sc >= 0 ? src[(size_t)(kt * 64 + r) * lds + sc] : 0.f;
    sm[r * 65 + c] = v;
  }
  __syncthreads();
  const int n = tid >> 2, kq = tid & 3;
  unsigned pk[8];
#pragma unroll
  for (int j = 0; j < 8; ++j) pk[j] = pack2(sm[(kq * 16 + 2 * j) * 65 + n], sm[(kq * 16 + 2 * j + 1) * 65 + n]);
  u16* d = dst + (size_t)(nt * 64 + n) * K + kt * 64 + kq * 16;
  *(uint4*)d = make_uint4(pk[0], pk[1], pk[2], pk[3]);
  *(uint4*)(d + 8) = make_uint4(pk[4], pk[5], pk[6], pk[7]);
}
constexpr int CJ0 = 16 * 52, CJ1 = CJ0 + 16 * 48, CJ2 = CJ1 + 6 * 12, CJ3 = CJ2 + 4 * 16, CJ4 = CJ3 + 8 * 8,
              CJ5 = CJ4 + 24 * 16, CJ6 = CJ5 + 16 * 16, CJ7 = CJ6 + 16 * 88, CJ8 = CJ7 + 44 * 16;
DI void conv_job(const Params& p, int l, int j, float* sm) {
  u16* wl = (u16*)(p.ws + B_W) + (size_t)l * W_LAYER;
  if (j < CJ0) { convT_tile(p.in[13] + (size_t)l * 1024 * 6320, 6320, 1024, wl + W_IN, 0, j / 52, j % 52, sm); return; }
  if (j < CJ1) { j -= CJ0; convT_tile(p.in[13] + (size_t)l * 1024 * 6320, 6320, 1024, wl + W_G, 1, j / 48, j % 48, sm); return; }
  if (j < CJ2) { j -= CJ1; convT_tile(p.in[29] + (size_t)l * 384 * 768, 768, 384, wl + W_QB, 2, j / 12, j % 12, sm); return; }
  if (j < CJ3) { j -= CJ2; convT_tile(p.in[31] + (size_t)l * 256 * 1024, 1024, 256, wl + W_KVB, 2, j / 16, j % 16, sm); return; }
  if (j < CJ4) { j -= CJ3; convT_tile(p.in[26] + (size_t)l * 512 * 512, 512, 512, wl + W_GLU, 2, j / 8, j % 8, sm); return; }
  if (j < CJ5) { j -= CJ4; convT_tile(p.in[32] + (size_t)l * 1536 * 1024, 1024, 1536, wl + W_BR, 2, j / 16, j % 16, sm); return; }
  if (j < CJ6) { j -= CJ5; convT_tile(p.in[33] + (size_t)l * 1024 * 1024, 1024, 1024, wl + W_OUT, 2, j / 16, j % 16, sm); return; }
  if (j < CJ7) { j -= CJ6; convT_tile(p.in[34] + (size_t)l * 1024 * 5632, 5632, 1024, wl + W_UP, 2, j / 88, j % 88, sm); return; }
  j -= CJ7; convT_tile(p.in[37] + (size_t)l * 2816 * 1024, 1024, 2816, wl + W_DN, 2, j / 16, j % 16, sm);
}
DI void mods_tile(const Params& p, int l, int jg, float* sm) {
  const int tid = otid();
  __syncthreads();
  for (int i = tid; i < 9 * 1024; i += 256) {
    int v = i >> 10, k = i & 1023;
    float cv = v == 0 ? p.in[8][k] : p.in[7][(v - 1) * 1024 + k];
    sm[i] = cv / (1.f + __expf(-cv));
  }
  __syncthreads();
  const int col = jg * 64 + (tid & 63), kq = tid >> 6;
  float acc[9];
#pragma unroll
  for (int v = 0; v < 9; ++v) acc[v] = 0.f;
  const float* wp = p.in[9] + (size_t)l * 1024 * 6144 + col;
#pragma unroll 4
  for (int k = kq * 256; k < kq * 256 + 256; ++k) {
    float wv = wp[(size_t)k * 6144];
#pragma unroll
    for (int v = 0; v < 9; ++v) acc[v] += sm[v * 1024 + k] * wv;
  }
  float* red = sm + 9 * 1024;
#pragma unroll
  for (int v = 0; v < 9; ++v) red[(kq * 9 + v) * 64 + (tid & 63)] = acc[v];
  __syncthreads();
  if (kq == 0) {
    float* mods = (float*)(p.ws + B_MODS);
    float b = p.in[10][l * 6144 + col];
#pragma unroll
    for (int v = 0; v < 9; ++v) {
      float s = red[(0 * 9 + v) * 64 + tid] + red[(1 * 9 + v) * 64 + tid] + red[(2 * 9 + v) * 64 + tid] + red[(3 * 9 + v) * 64 + tid];
      mods[(size_t)(l * 9 + v) * 6144 + col] = s + b;
    }
  }
}
DI void s5pre_tile(const Params& p, int tile) {
  const int id = tile * 256 + otid();
  const int pp = id & 63, g = (id >> 6) & 31, dir = (id >> 11) & 1, l = id >> 12;
  const float lre = p.in[18][((l * 2 + dir) * 32 + g) * 64 + pp];
  const float lim = p.in[19][((l * 2 + dir) * 32 + g) * 64 + pp];
  const float dt = expf(p.in[20][(l * 2 + dir) * 32 + g]);
  float er = expf(lre * dt), sn, cs;
  sincosf(lim * dt, &sn, &cs);
  const float lbr = er * cs, lbi = er * sn;
  float e64 = expf(64.f * lre * dt), s64, c64;
  sincosf(64.f * lim * dt, &s64, &c64);
  float2* lamb = (float2*)(p.ws + B_LAMB);
  float2* lam64 = (float2*)(p.ws + B_LAM64);
  const int li = ((l * 2 + dir) * 32 + g) * 64 + pp;
  lamb[li] = make_float2(lbr, lbi);
  lam64[li] = make_float2(e64 * c64, e64 * s64);
  const float nr = lbr - 1.f, ni = lbi, den = lre * lre + lim * lim;
  const float cr = (nr * lre + ni * lim) / den, ci = (ni * lre - nr * lim) / den;
  u16* bbt = (u16*)(p.ws + B_BBT) + (size_t)((l * 2 + dir) * 32 + g) * 128 * 16;
  const float* bre = p.in[21] + (size_t)((l * 32 + g) * 64 + pp) * 16;
  const float* bim = p.in[22] + (size_t)((l * 32 + g) * 64 + pp) * 16;
#pragma unroll
  for (int c = 0; c < 16; ++c) {
    float br = bre[c], bi = bim[c];
    bbt[pp * 16 + c] = f2bf(cr * br - ci * bi);
    bbt[(64 + pp) * 16 + c] = f2bf(cr * bi + ci * br);
  }
  if (dir == 0) {
    u16* cmt = (u16*)(p.ws + B_CMT) + (size_t)(l * 32 + g) * 16 * 128;
    const float* cre = p.in[23] + (size_t)(l * 32 + g) * 16 * 64;
    const float* cim = p.in[24] + (size_t)(l * 32 + g) * 16 * 64;
#pragma unroll
    for (int c = 0; c < 16; ++c) {
      cmt[c * 128 + pp] = f2bf(cre[c * 64 + pp]);
      cmt[c * 128 + 64 + pp] = f2bf(-cim[c * 64 + pp]);
    }
  }
}

DI void norm_phase(const Params& p, int l, int shift_idx, int scale_idx, const float* gn) {
  const float* x = p.out;
  u16* H = (u16*)(p.ws + B_H);
  const float* mods = (const float*)(p.ws + B_MODS);
  const int lane = otid() & 63, w = otid() >> 6;
  for (int tile = blockIdx.x; tile < T_ / 4; tile += gridDim.x) {
    const int t = tile * 4 + w;
    const float4* xr = (const float4*)(x + (size_t)t * 1024);
    float4 v[4];
    float ss = 0.f;
#pragma unroll
    for (int j = 0; j < 4; ++j) {
      v[j] = xr[lane + 64 * j];
      ss += v[j].x * v[j].x + v[j].y * v[j].y + v[j].z * v[j].z + v[j].w * v[j].w;
    }
    ss = wave_sum(ss);
    const float rstd = rsqrtf(ss * (1.f / 1024.f) + 1e-6f);
    const float* mb = mods + (size_t)(l * 9 + tok_v(t)) * 6144;
#pragma unroll
    for (int j = 0; j < 4; ++j) {
      const int c = (lane + 64 * j) * 4;
      float4 g = *(const float4*)(gn + c);
      float4 sc = *(const float4*)(mb + scale_idx * 1024 + c);
      float4 sh = *(const float4*)(mb + shift_idx * 1024 + c);
      float y0 = v[j].x * rstd * g.x * (1.f + sc.x) + sh.x;
      float y1 = v[j].y * rstd * g.y * (1.f + sc.y) + sh.y;
      float y2 = v[j].z * rstd * g.z * (1.f + sc.z) + sh.z;
      float y3 = v[j].w * rstd * g.w * (1.f + sc.w) + sh.w;
      *(uint2*)(H + (size_t)t * 1024 + c) = make_uint2(pack2(y0, y1), pack2(y2, y3));
    }
  }
}

DI void gemm_in_phase(const Params& p, int l, u16* sm) {
  const u16* H = (const u16*)(p.ws + B_H);
  const u16* Wt = (const u16*)(p.ws + B_W) + (size_t)l * W_LAYER + W_IN;
  for (int tile = blockIdx.x; tile < 192 * 26; tile += gridDim.x) {
    const int mt = tile / 26, nt = tile % 26;
    f32x4 acc[4][4];
    zero_acc<4>(acc);
    gemm_core<4>(acc, H + (size_t)mt * 128 * 1024, 1024, Wt + (size_t)nt * 128 * 1024, 1024, 1024, sm);
    if (nt < 25) {
      u16* dst; int ld, c0;
      if (nt < 12) { dst = (u16*)(p.ws + B_QKV); ld = 1536; c0 = nt * 128; }
      else if (nt < 16) { dst = (u16*)(p.ws + B_Z); ld = 512; c0 = (nt - 12) * 128; }
      else if (nt < 20) { dst = (u16*)(p.ws + B_US5); ld = 512; c0 = (nt - 16) * 128; }
      else if (nt < 23) { dst = (u16*)(p.ws + B_QA); ld = 384; c0 = (nt - 20) * 128; }
      else { dst = (u16*)(p.ws + B_KVA); ld = 256; c0 = (nt - 23) * 128; }
      EPI_LOOP(4) { *(uint2*)(dst + (size_t)(mt * 128 + EROW) * ld + c0 + ECOL4(4)) = pack4(acc[i][j]); }
    } else {
      float* misc = (float*)(p.ws + B_MISC);
      EPI_LOOP(4) {
        const int c = ECOL4(4);
        if (c < 48) *(float4*)(misc + (size_t)(mt * 128 + EROW) * 48 + c) = make_float4(acc[i][j][0], acc[i][j][1], acc[i][j][2], acc[i][j][3]);
      }
    }
  }
}

DI void delta_prep_tile(const Params& p, int l, int chunk, u16* sm) {
  const int tid = otid(), lane = tid & 63, w = tid >> 6;
  const int tb = chunk * 64;
  int pos0, L;
  if (tb < TP_) { pos0 = tb & 255; L = 256; } else { pos0 = (tb - TP_) & 2047; L = 2048; }
  const u16* qkv = (const u16*)(p.ws + B_QKV);
  const float* cw = p.in[14] + (size_t)l * 5 * 1536;
  u16* ksm = sm + w * (64 * 130);
  __syncthreads();
  for (int gi = w; gi < 12; gi += 4) {
    const int ch = gi * 128 + 2 * lane;
    float w0[5], w1[5];
#pragma unroll
    for (int i = 0; i < 5; ++i) { w0[i] = cw[i * 1536 + ch]; w1[i] = cw[i * 1536 + ch + 1]; }
    float a0[5], a1[5];
#pragma unroll
    for (int i = 0; i < 4; ++i) {
      int ps = pos0 - 2 + i;
      unsigned u = (ps >= 0 && ps < L) ? *(const unsigned*)(qkv + (size_t)(tb - 2 + i) * 1536 + ch) : 0u;
      a0[i + 1] = blo(u); a1[i + 1] = bhi(u);
    }
    u16* dst = (u16*)(p.ws + (gi < 4 ? B_QN : (gi < 8 ? B_KN : B_VV)));
    const int hh = gi & 3;
    for (int tt = 0; tt < 64; ++tt) {
#pragma unroll
      for (int i = 0; i < 4; ++i) { a0[i] = a0[i + 1]; a1[i] = a1[i + 1]; }
      {
        int ps = pos0 + tt + 2;
        unsigned u = (ps < L) ? *(const unsigned*)(qkv + (size_t)(tb + tt + 2) * 1536 + ch) : 0u;
        a0[4] = blo(u); a1[4] = bhi(u);
      }
      float y0 = 0.f, y1 = 0.f;
#pragma unroll
      for (int i = 0; i < 5; ++i) { y0 += w0[i] * a0[i]; y1 += w1[i] * a1[i]; }
      y0 = siluf_(y0); y1 = siluf_(y1);
      if (gi < 8) {
        float ss = wave_sum(y0 * y0 + y1 * y1);
        float sc = rsqrtf(ss + 1e-6f);
        if (gi < 4) sc *= 0.08838834764831845f;
        y0 *= sc; y1 *= sc;
      }
      const unsigned pk = pack2(y0, y1);
      *(unsigned*)(dst + (size_t)(tb + tt) * 512 + hh * 128 + 2 * lane) = pk;
      if (gi >= 4 && gi < 8) *(unsigned*)(ksm + tt * 130 + 2 * lane) = pk;
    }
    if (gi >= 4 && gi < 8) {
      u16* kt = (u16*)(p.ws + B_KT) + (size_t)(chunk * 4 + hh) * 128 * 64;
#pragma unroll
      for (int rr = 0; rr < 2; ++rr) {
        const int dk = lane + 64 * rr;
        unsigned pk[32];
#pragma unroll
        for (int t2 = 0; t2 < 32; ++t2) pk[t2] = (unsigned)ksm[(2 * t2) * 130 + dk] | ((unsigned)ksm[(2 * t2 + 1) * 130 + dk] << 16);
#pragma unroll
        for (int q = 0; q < 8; ++q) *(uint4*)(kt + dk * 64 + q * 8) = make_uint4(pk[4 * q], pk[4 * q + 1], pk[4 * q + 2], pk[4 * q + 3]);
      }
    }
  }
  const float* misc = (const float*)(p.ws + B_MISC);
  float* bg = (float*)(p.ws + B_BG);
  for (int i = tid; i < 512; i += 256) {
    const int tt = i >> 3, dh = i & 7;
    const size_t t = tb + tt;
    float bl = misc[t * 48 + dh], alp = misc[t * 48 + 8 + dh];
    float x = alp + p.in[16][l * 8 + dh];
    float sp = x > 20.f ? x : log1pf(__expf(x));
    bg[t * 16 + dh] = sigmoidf_(bl);
    bg[t * 16 + 8 + dh] = -__expf(p.in[15][l * 8 + dh]) * sp;
  }
}

DI size_t kb_off(int t, int head) {
  if (t < TP_) return ((size_t)((t >> 8) * 8 + head) * 256 + (t & 255)) * 96;
  const int s = (t - TP_) >> 11, pos = (t - TP_) & 2047;
  return KB_P + ((size_t)(s * 8 + head) * 2304 + 256 + pos) * 96;
}
DI void mla_prep_tile(const Params& p, int l, int tile) {
  const int lane = otid() & 63, w = otid() >> 6;
  const int t = tile * 4 + w;
  u16* qa = (u16*)(p.ws + B_QA) + (size_t)t * 384;
  u16* kva = (u16*)(p.ws + B_KVA) + (size_t)t * 256;
  const float* misc = (const float*)(p.ws + B_MISC) + (size_t)t * 48;
  {
    unsigned u[3]; float ss = 0.f;
#pragma unroll
    for (int j = 0; j < 3; ++j) { u[j] = *(const unsigned*)(qa + 2 * lane + 128 * j); float a = blo(u[j]), b = bhi(u[j]); ss += a * a + b * b; }
    ss = wave_sum(ss);
    const float rstd = rsqrtf(ss * (1.f / 384.f) + 1e-6f);
    const float* g = p.in[28] + l * 384;
#pragma unroll
    for (int j = 0; j < 3; ++j) {
      int c = 2 * lane + 128 * j;
      *(unsigned*)(qa + c) = pack2(blo(u[j]) * rstd * g[c], bhi(u[j]) * rstd * g[c + 1]);
    }
  }
  {
    unsigned u[2]; float ss = 0.f;
#pragma unroll
    for (int j = 0; j < 2; ++j) { u[j] = *(const unsigned*)(kva + 2 * lane + 128 * j); float a = blo(u[j]), b = bhi(u[j]); ss += a * a + b * b; }
    ss = wave_sum(ss);
    const float rstd = rsqrtf(ss * (1.f / 256.f) + 1e-6f);
    const float* g = p.in[30] + l * 256;
#pragma unroll
    for (int j = 0; j < 2; ++j) {
      int c = 2 * lane + 128 * j;
      float a = blo(u[j]) * rstd * g[c], b = bhi(u[j]) * rstd * g[c + 1];
      *(unsigned*)(kva + c) = pack2(a, b);
      if (t < TP_) {
        float* o = p.out + O_CKV + ((size_t)((t >> 8) * 4 + l) * 256 + (t & 255)) * 256 + c;
        *(float2*)o = make_float2(a, b);
      }
    }
  }
  {
    const int i = lane & 31;
    float kr = misc[16 + i];
    float val;
    if (t < TP_) {
      val = kr;
      if (lane < 32) p.out[O_KR + ((size_t)((t >> 8) * 4 + l) * 256 + (t & 255)) * 32 + i] = kr;
    } else {
      const int pos = (t - TP_) & 2047;
      const float* rp = (const float*)(p.ws + B_ROPE) + (size_t)pos * 32 + (i & 15) * 2;
      const float cs = rp[0], sn = rp[1];
      float other = __shfl_xor(kr, 16);
      val = (i < 16) ? (kr * cs - other * sn) : (kr * cs + other * sn);
    }
    u16* kb = (u16*)(p.ws + B_KB);
    const u16 bv = f2bf(val);
#pragma unroll
    for (int hh = 0; hh < 4; ++hh) {
      int head = hh * 2 + (lane >> 5);
      kb[kb_off(t, head) + 64 + i] = bv;
    }
  }
}
DI void cache_rope_tile(const Params& p, int l, int tile) {
  const int pr = tile * 8 + (otid() >> 5), i = otid() & 31;
  const int s = pr >> 8, pos = pr & 255;
  const float v = p.in[6][((size_t)(s * 4 + l) * 256 + pos) * 32 + i];
  u16* kb = (u16*)(p.ws + B_KB);
  const u16 bv = f2bf(v);
#pragma unroll
  for (int head = 0; head < 8; ++head) kb[KB_P + ((size_t)(s * 8 + head) * 2304 + pos) * 96 + 64 + i] = bv;
}

DI float gelu_tanh(float x) {
  const float k0 = 0.7978845608028654f, k1 = 0.044715f;
  float u = k0 * (x + k1 * x * x * x);
  float e = __expf(2.f * u);
  float th = 1.f - 2.f / (e + 1.f);
  return 0.5f * x * (1.f + th);
}
DI void s5_chunk_tile(const Params& p, int l, int chunk, int gp, int mode, u16* sm) {
  const int tid = otid(), lane = tid & 63, w = tid >> 6;
  const u16* us5 = (const u16*)(p.ws + B_US5);
  constexpr int RS = 136;
  const int gi_w = w >> 1, half = w & 1, g_w = gp * 2 + gi_w;
  const int n = lane & 31, h2 = lane >> 5;
  bf16x8 af[2], bq[2][2];
#pragma unroll
  for (int mi = 0; mi < 2; ++mi) af[mi] = *(const bf16x8*)(us5 + (size_t)(chunk * 64 + mi * 32 + n) * 512 + g_w * 16 + 8 * h2);
#pragma unroll
  for (int dir = 0; dir < 2; ++dir) {
    const u16* bbt = (const u16*)(p.ws + B_BBT) + (size_t)((l * 2 + dir) * 32 + g_w) * 128 * 16;
#pragma unroll
    for (int nn = 0; nn < 2; ++nn) bq[dir][nn] = *(const bf16x8*)(bbt + ((half * 2 + nn) * 32 + n) * 16 + 8 * h2);
  }
  const int gi_t = tid >> 7, dir_t = (tid >> 6) & 1, pp = tid & 63, g_t = gp * 2 + gi_t;
  const float2 lb = ((const float2*)(p.ws + B_LAMB))[((l * 2 + dir_t) * 32 + g_t) * 64 + pp];
  const size_t hidx = ((size_t)(chunk * 32 + g_t) * 2 + dir_t) * 64 + pp;
  float hr = 0.f, hi = 0.f;
  if (mode) { float2 h0 = ((const float2*)(p.ws + B_HIN))[hidx]; hr = h0.x; hi = h0.y; }
  const int fr = lane & 15, fq = lane >> 4;
  bf16x8 cq[4];
  u16 uu[2][4];
  float dsk = 0.f;
  if (mode) {
    const u16* cmt = (const u16*)(p.ws + B_CMT) + (size_t)(l * 32 + g_w) * 16 * 128;
#pragma unroll
    for (int k4 = 0; k4 < 4; ++k4) cq[k4] = *(const bf16x8*)(cmt + fr * 128 + k4 * 32 + fq * 8);
#pragma unroll
    for (int mm = 0; mm < 2; ++mm)
#pragma unroll
      for (int r = 0; r < 4; ++r) uu[mm][r] = us5[((size_t)chunk * 64 + ((w & 1) * 2 + mm) * 16 + fq * 4 + r) * 512 + g_w * 16 + fr];
    dsk = p.in[25][l * 512 + g_w * 16 + fr];
  }
  __syncthreads();
  {
#pragma unroll
    for (int dir = 0; dir < 2; ++dir) {
#pragma unroll
      for (int nn = 0; nn < 2; ++nn) {
        const int nt = half * 2 + nn;
#pragma unroll
        for (int mi = 0; mi < 2; ++mi) {
          f32x16 acc;
#pragma unroll
          for (int r = 0; r < 16; ++r) acc[r] = 0.f;
          acc = MFMA32(af[mi], bq[dir][nn], acc);
          u16* d = sm + (size_t)((gi_w * 2 + dir) * 64 + mi * 32) * RS + nt * 32 + n;
#pragma unroll
          for (int r = 0; r < 16; ++r) d[crow(r, h2) * RS] = f2bf(acc[r]);
        }
      }
    }
  }
  __syncthreads();
  {
    u16* base = sm + (size_t)((gi_t * 2 + dir_t) * 64) * RS;
#pragma unroll 8
    for (int st = 0; st < 64; ++st) {
      const int tk = dir_t ? 63 - st : st;
      float br = bf2f(base[tk * RS + pp]), bi = bf2f(base[tk * RS + 64 + pp]);
      float nr = __builtin_fmaf(lb.x, hr, __builtin_fmaf(-lb.y, hi, br));
      float ni = __builtin_fmaf(lb.x, hi, __builtin_fmaf(lb.y, hr, bi));
      asm volatile("" : "+v"(nr));
      asm volatile("" : "+v"(ni));
      hr = nr; hi = ni;
      if (mode) { base[tk * RS + pp] = f2bf(hr); base[tk * RS + 64 + pp] = f2bf(hi); }
    }
    if (!mode) ((float2*)(p.ws + B_HEND))[hidx] = make_float2(hr, hi);
  }
  if (!mode) return;
  __syncthreads();
  {
    f32x4 acc[2];
    acc[0] = f32x4{0.f, 0.f, 0.f, 0.f}; acc[1] = acc[0];
#pragma unroll
    for (int ks = 0; ks < 8; ++ks) {
      const int dir = ks >> 2, kk = (ks & 3) * 32;
#pragma unroll
      for (int mm = 0; mm < 2; ++mm) {
        const int mi = (w & 1) * 2 + mm;
        bf16x8 a2 = *(const bf16x8*)(sm + (size_t)((gi_w * 2 + dir) * 64 + mi * 16 + fr) * RS + kk + fq * 8);
        acc[mm] = MFMA16(a2, cq[ks & 3], acc[mm]);
      }
    }
    u16* y5 = (u16*)(p.ws + B_Y5);
#pragma unroll
    for (int mm = 0; mm < 2; ++mm)
#pragma unroll
      for (int r = 0; r < 4; ++r) {
        const size_t t = (size_t)chunk * 64 + ((w & 1) * 2 + mm) * 16 + fq * 4 + r;
        float y = acc[mm][r] + dsk * bf2f(uu[mm][r]);
        y5[t * 512 + g_w * 16 + fr] = f2bf(gelu_tanh(y));
      }
  }
}
DI void s5_carry_tile(const Params& p, int l, int tile) {
  const int seq = tile >> 4, gp = tile & 15;
  const int tid = otid(), gi = tid >> 7, dir = (tid >> 6) & 1, pp = tid & 63, g = gp * 2 + gi;
  int c0, nc;
  if (seq < 32) { c0 = seq * 4; nc = 4; } else { c0 = 128 + (seq - 32) * 32; nc = 32; }
  const float2 l64 = ((const float2*)(p.ws + B_LAM64))[((l * 2 + dir) * 32 + g) * 64 + pp];
  float hr = 0.f, hi = 0.f;
  if (seq >= 32) {
    const size_t si = ((size_t)((seq - 32) * 4 + l) * 2 + dir) * 2048 + g * 64 + pp;
    hr = p.in[3][si]; hi = p.in[4][si];
  }
  const float2* hend = (const float2*)(p.ws + B_HEND);
  float2* hin = (float2*)(p.ws + B_HIN);
  for (int it = 0; it < nc; ++it) {
    const int ck = c0 + (dir ? nc - 1 - it : it);
    const size_t idx = ((size_t)(ck * 32 + g) * 2 + dir) * 64 + pp;
    hin[idx] = make_float2(hr, hi);
    float2 he = hend[idx];
    float nr = __builtin_fmaf(l64.x, hr, __builtin_fmaf(-l64.y, hi, he.x));
    float ni = __builtin_fmaf(l64.x, hi, __builtin_fmaf(l64.y, hr, he.y));
    asm volatile("" : "+v"(nr));
    asm volatile("" : "+v"(ni));
    hr = nr; hi = ni;
  }
  if (seq < 32) {
    const size_t so = ((size_t)(seq * 4 + l) * 2 + dir) * 2048 + g * 64 + pp;
    p.out[O_S5RE + so] = hr;
    p.out[O_S5IM + so] = hi;
  }
}

DI void delta_local_tile(const Params& p, int tile, float* smf) {
  const int chunk = tile >> 1, dir = tile & 1;
  const int tid = otid(), lane = tid & 63, h = tid >> 6;
  const int m = lane & 31, h2 = lane >> 5;
  const int tb = chunk * 64;
  const float* bg = (const float*)(p.ws + B_BG);
  const u16* kn = (const u16*)(p.ws + B_KN);
  const u16* qn = (const u16*)(p.ws + B_QN);
  float* Aw = smf + h * 4096;
  const size_t cidx = ((size_t)(chunk * 4 + h) * 2 + dir);
  const int tl = tb + (dir ? 63 - lane : lane);
  float gcs = bg[(size_t)tl * 16 + 8 + dir * 4 + h];
  const float beta = bg[(size_t)tl * 16 + dir * 4 + h];
#pragma unroll
  for (int o = 1; o < 64; o <<= 1) {
    float v = __shfl_up(gcs, o);
    if (lane >= o) gcs += v;
  }
  ((float*)(p.ws + B_GC))[cidx * 64 + lane] = gcs;
  ((float*)(p.ws + B_BC))[cidx * 64 + lane] = beta;
  __syncthreads();
  u16* qkm = (u16*)(p.ws + B_QKM) + cidx * 4096;
#pragma unroll 1
  for (int tt = 0; tt < 3; ++tt) {
    const int mi = tt == 0 ? 0 : 1, ni = tt == 2 ? 1 : 0;
    const int cm = 32 * mi + m, cn = 32 * ni + m;
    const u16* krm = kn + (size_t)(tb + (dir ? 63 - cm : cm)) * 512 + h * 128 + h2 * 8;
    const u16* qrm = qn + (size_t)(tb + (dir ? 63 - cm : cm)) * 512 + h * 128 + h2 * 8;
    const u16* krn = kn + (size_t)(tb + (dir ? 63 - cn : cn)) * 512 + h * 128 + h2 * 8;
    f32x16 ak, aq;
#pragma unroll
    for (int r = 0; r < 16; ++r) { ak[r] = 0.f; aq[r] = 0.f; }
#pragma unroll
    for (int ks = 0; ks < 8; ++ks) {
      const bf16x8 fkm = *(const bf16x8*)(krm + ks * 16), fqm = *(const bf16x8*)(qrm + ks * 16), fkn = *(const bf16x8*)(krn + ks * 16);
      ak = MFMA32(fkm, fkn, ak);
      aq = MFMA32(fqm, fkn, aq);
    }
    const int e = 32 * ni + m;
    const float gce = __shfl(gcs, e);
#pragma unroll
    for (int r = 0; r < 16; ++r) {
      const int c = 32 * mi + crow(r, h2);
      const float gcc = __shfl(gcs, c), bc = __shfl(beta, c);
      const float dec = (e <= c) ? __expf(gcc - gce) : 0.f;
      Aw[c * 64 + e] = (e < c) ? ak[r] * bc * dec : 0.f;
      qkm[c * 64 + e] = f2bf(aq[r] * dec);
    }
  }
  __syncthreads();
  u16* tm = (u16*)(p.ws + B_TM) + cidx * 4096;
  float x[64];
#pragma unroll
  for (int i = 0; i < 64; ++i) {
    float a = (i == lane) ? 1.f : 0.f;
#pragma unroll
    for (int j = 0; j < i; ++j) a -= Aw[i * 64 + j] * x[j];
    x[i] = a;
    tm[i * 64 + lane] = f2bf(a);
  }
}

template <int dir>
DI void delta_scan_body(const Params& p, int l, int seq, int h, u16* sm);
DI void delta_scan_tile(const Params& p, int l, int idx, u16* sm) {
  int seq, h, dir;
  if (idx < 64) { seq = 32 + (idx >> 3); h = (idx >> 1) & 3; dir = idx & 1; }
  else { const int i2 = idx - 64; seq = i2 >> 3; h = (i2 >> 1) & 3; dir = i2 & 1; }
  __builtin_amdgcn_s_setprio(3);
  if (dir) delta_scan_body<1>(p, l, seq, h, sm); else delta_scan_body<0>(p, l, seq, h, sm);
  __builtin_amdgcn_s_setprio(0);
}
template <int dir>
DI void delta_scan_body(const Params& p, int l, int seq, int h, u16* sm) {
  int chunk0, nch;
  if (seq < 32) { chunk0 = seq * 4; nch = 4; } else { chunk0 = 128 + (seq - 32) * 32; nch = 32; }
  const int lane = otid() & 63, w = otid() >> 6;
  const int n = lane & 31, h2 = lane >> 5;
  const int dvc = w * 32 + n;
  const u16* kn = (const u16*)(p.ws + B_KN);
  const u16* qn = (const u16*)(p.ws + B_QN);
  const u16* vv = (const u16*)(p.ws + B_VV);
  u16* od = (u16*)(p.ws + (dir ? B_OB : B_OF));
  f32x16 S[4];
  if (seq >= 32) {
    const float* s0 = p.in[2] + ((size_t)(((seq - 32) * 4 + l) * 2 + dir) * 4 + h) * 16384;
#pragma unroll
    for (int t = 0; t < 4; ++t)
#pragma unroll
      for (int r = 0; r < 16; ++r) S[t][r] = s0[(size_t)(32 * t + crow(r, h2)) * 128 + dvc];
  } else {
#pragma unroll
    for (int t = 0; t < 4; ++t)
#pragma unroll
      for (int r = 0; r < 16; ++r) S[t][r] = 0.f;
  }
  for (int it = 0; it < nch; ++it) {
    const int chunk = chunk0 + (dir ? nch - 1 - it : it);
    const int tb = chunk * 64;
    const size_t cidx = ((size_t)(chunk * 4 + h) * 2 + dir);
    const float* gcp = (const float*)(p.ws + B_GC) + cidx * 64;
    const float* bcp = (const float*)(p.ws + B_BC) + cidx * 64;
    const u16* tm = (const u16*)(p.ws + B_TM) + cidx * 4096;
    const u16* qkm = (const u16*)(p.ws + B_QKM) + cidx * 4096;
    const u16* ktp = (const u16*)(p.ws + B_KT) + (size_t)(chunk * 4 + h) * 8192;
    const float glast = gcp[63];
    size_t trow[2];
#pragma unroll
    for (int mi = 0; mi < 2; ++mi) { const int c = 32 * mi + n; trow[mi] = (size_t)(tb + (dir ? 63 - c : c)); }
#define SCHED_FENCE() asm volatile("" ::: "memory")
    u16* Ks = sm; u16* Qs = sm + 8704; u16* Vs = sm + 17408; u16* KTs = sm + 26112;
    float* GCs = (float*)(sm + 35328);
    const float* gcl = GCs; const float* bcl = GCs + 64;
    uint4 xm0, xm1, xq0, xq1;
    u16* vls = Vs + w * 32;
    __syncthreads();
    {
      const int tid_ = otid();
      const int r0 = tid_ >> 4, ck = tid_ & 15;
      uint4 tk[4], tq[4], tv[4], tt[4];
      xm0 = *(const uint4*)(tm + tid_ * 8); xm1 = *(const uint4*)(tm + 2048 + tid_ * 8);
      xq0 = *(const uint4*)(qkm + tid_ * 8); xq1 = *(const uint4*)(qkm + 2048 + tid_ * 8);
      float4 gcv = make_float4(0.f, 0.f, 0.f, 0.f);
      if (tid_ < 16) gcv = *(const float4*)(gcp + tid_ * 4); else if (tid_ < 32) gcv = *(const float4*)(bcp + (tid_ - 16) * 4);
#pragma unroll
      for (int j = 0; j < 4; ++j) {
        const size_t go = (size_t)(tb + r0 + 16 * j) * 512 + h * 128 + ck * 8;
        tk[j] = *(const uint4*)(kn + go); tq[j] = *(const uint4*)(qn + go); tv[j] = *(const uint4*)(vv + go);
        tt[j] = *(const uint4*)(ktp + ((tid_ >> 3) + 32 * j) * 64 + (tid_ & 7) * 8);
      }
#pragma unroll
      for (int j = 0; j < 4; ++j) {
        const int tau = r0 + 16 * j, c = dir ? 63 - tau : tau;
        *(uint4*)(Ks + c * 136 + ck * 8) = tk[j]; *(uint4*)(Qs + c * 136 + ck * 8) = tq[j]; *(uint4*)(Vs + c * 136 + ck * 8) = tv[j];
        *(uint4*)(KTs + ((tid_ >> 3) + 32 * j) * 72 + (tid_ & 7) * 8) = tt[j];
      }
      if (tid_ < 32) *(float4*)(GCs + tid_ * 4) = gcv;
    }
    __syncthreads();
    f32x16 X[2], QS[2];
    {
      bf16x8 Sb[4][2];
#pragma unroll
      for (int t = 0; t < 4; ++t)
#pragma unroll
        for (int s = 0; s < 2; ++s) Sb[t][s] = pack_acc(S[t], s);
#pragma unroll
      for (int mi = 0; mi < 2; ++mi)
#pragma unroll
        for (int r = 0; r < 16; ++r) { X[mi][r] = 0.f; QS[mi][r] = 0.f; }
#pragma unroll
      for (int t = 0; t < 4; ++t) {
#pragma unroll
        for (int mi = 0; mi < 2; ++mi) {
          const u16* krow_ = Ks + (32 * mi + n) * 136;
          const u16* qrow_ = Qs + (32 * mi + n) * 136;
#pragma unroll
          for (int s = 0; s < 2; ++s) {
            X[mi] = MFMA32(load_perm(krow_ + 32 * t, s, h2), Sb[t][s], X[mi]);
            QS[mi] = MFMA32(load_perm(qrow_ + 32 * t, s, h2), Sb[t][s], QS[mi]);
          }
        }
        SCHED_FENCE();
      }
    }
    __syncthreads();
    {
      const int tid_ = otid();
      const int r_ = tid_ >> 3, c_ = (tid_ & 7) * 8;
      *(uint4*)(Ks + r_ * 72 + c_) = xm0; *(uint4*)(Ks + (r_ + 32) * 72 + c_) = xm1;
      *(uint4*)(Qs + r_ * 72 + c_) = xq0; *(uint4*)(Qs + (r_ + 32) * 72 + c_) = xq1;
    }
    __syncthreads();
    bf16x8 Rb[2][2];
#pragma unroll
    for (int mi = 0; mi < 2; ++mi) {
#pragma unroll
      for (int a = 0; a < 4; ++a) {
        const int c4 = 32 * mi + 8 * a + 4 * h2;
        const float4 g4 = *(const float4*)(gcl + c4);
        const float4 b4 = *(const float4*)(bcl + c4);
        const float gg[4] = {g4.x, g4.y, g4.z, g4.w};
        const float bb[4] = {b4.x, b4.y, b4.z, b4.w};
#pragma unroll
        for (int q = 0; q < 4; ++q) {
          const int c = c4 + q;
          const float v = bf2f(vls[c * 136 + n]);
          const float eg = __expf(gg[q]);
          X[mi][4 * a + q] = bb[q] * (v - eg * X[mi][4 * a + q]);
          QS[mi][4 * a + q] *= eg;
        }
      }
      Rb[mi][0] = pack_acc(X[mi], 0);
      Rb[mi][1] = pack_acc(X[mi], 1);
    }
    SCHED_FENCE();
    f32x16 Vn[2];
#pragma unroll
    for (int mo = 0; mo < 2; ++mo) {
#pragma unroll
      for (int r = 0; r < 16; ++r) Vn[mo][r] = 0.f;
#pragma unroll
      for (int mi = 0; mi <= mo; ++mi)
#pragma unroll
        for (int s = 0; s < 2; ++s) Vn[mo] = MFMA32(load_perm(Ks + (32 * mo + n) * 72 + 32 * mi, s, h2), Rb[mi][s], Vn[mo]);
    }
    SCHED_FENCE();
    {
      bf16x8 Vb[2][2];
#pragma unroll
      for (int mi = 0; mi < 2; ++mi) { Vb[mi][0] = pack_acc(Vn[mi], 0); Vb[mi][1] = pack_acc(Vn[mi], 1); }
#pragma unroll
      for (int mo = 0; mo < 2; ++mo) {
#pragma unroll
        for (int mi = 0; mi <= mo; ++mi)
#pragma unroll
          for (int s = 0; s < 2; ++s) QS[mo] = MFMA32(load_perm(Qs + (32 * mo + n) * 72 + 32 * mi, s, h2), Vb[mi][s], QS[mo]);
      }
      __syncthreads();
#pragma unroll
      for (int mo = 0; mo < 2; ++mo)
#pragma unroll
        for (int r = 0; r < 16; ++r) vls[(32 * mo + crow(r, h2)) * 136 + n] = f2bf(QS[mo][r]);
      __syncthreads();
#pragma unroll
      for (int jv = 0; jv < 4; ++jv) {
        const int tau = (lane >> 2) + 16 * jv, cq = lane & 3;
        const uint4 oq = *(const uint4*)(vls + (dir ? 63 - tau : tau) * 136 + cq * 8);
        *(uint4*)(od + (size_t)(tb + tau) * 512 + h * 128 + w * 32 + cq * 8) = oq;
      }
    }
    SCHED_FENCE();
    bf16x8 Vsb[2][2];
#pragma unroll
    for (int mi = 0; mi < 2; ++mi) {
#pragma unroll
      for (int a = 0; a < 4; ++a) {
        const float4 g4 = *(const float4*)(gcl + 32 * mi + 8 * a + 4 * h2);
        Vn[mi][4 * a + 0] *= __expf(glast - g4.x); Vn[mi][4 * a + 1] *= __expf(glast - g4.y);
        Vn[mi][4 * a + 2] *= __expf(glast - g4.z); Vn[mi][4 * a + 3] *= __expf(glast - g4.w);
      }
      Vsb[mi][0] = pack_acc(Vn[mi], 0); Vsb[mi][1] = pack_acc(Vn[mi], 1);
    }
    const float eg = __expf(glast);
#pragma unroll
    for (int t = 0; t < 4; ++t) {
#pragma unroll
      for (int r = 0; r < 16; ++r) S[t][r] *= eg;
      const u16* ktrow = KTs + (32 * t + n) * 72;
#pragma unroll
      for (int mi = 0; mi < 2; ++mi)
#pragma unroll
        for (int s = 0; s < 2; ++s) {
          bf16x8 a = dir ? load_perm_rev(ktrow, 32 * mi, s, h2) : load_perm(ktrow + 32 * mi, s, h2);
          S[t] = MFMA32(a, Vsb[mi][s], S[t]);
        }
      SCHED_FENCE();
    }
  }
  if (seq < 32) {
    float* so = p.out + O_SD + ((size_t)((seq * 4 + l) * 2 + dir) * 4 + h) * 16384;
#pragma unroll
    for (int t = 0; t < 4; ++t)
#pragma unroll
      for (int r = 0; r < 16; ++r) so[(size_t)(32 * t + crow(r, h2)) * 128 + dvc] = S[t][r];
  }
}

DI void attn_tile(const Params& p, int seq, int head, int qb, u16* sm) {
  const int lane = otid() & 63, w = otid() >> 6;
  const int n = lane & 31, h2 = lane >> 5;
  int tq0, nkeys; size_t kbo, vto;
  if (seq < 32) { tq0 = seq * 256 + qb * 128 + w * 32; nkeys = 256; kbo = (size_t)(seq * 8 + head) * 256 * 96; vto = (size_t)(seq * 8 + head) * 64 * 256; }
  else { const int s = seq - 32; tq0 = TP_ + s * 2048 + qb * 128 + w * 32; nkeys = 2304; kbo = KB_P + (size_t)(s * 8 + head) * 2304 * 96; vto = VT_P + (size_t)(s * 8 + head) * 64 * 2304; }
  const u16* kb = (const u16*)(p.ws + B_KB) + kbo;
  const u16* vt = (const u16*)(p.ws + B_VT) + vto;
  const u16* qm = (const u16*)(p.ws + B_QM) + (size_t)(tq0 + n) * 768 + head * 96;
  bf16x8 qf[6];
#pragma unroll
  for (int ks = 0; ks < 6; ++ks) qf[ks] = *(const bf16x8*)(qm + ks * 16 + h2 * 8);
  f32x16 O[2];
#pragma unroll
  for (int r = 0; r < 16; ++r) { O[0][r] = 0.f; O[1][r] = 0.f; }
  float mrun = -1e30f, lsum = 0.f;
  const int nkt = nkeys >> 6;
  constexpr int KST = 104, VST = 72, STG = 64 * KST + 64 * VST;
  const int tid_ = otid();
  uint4 rk0, rk1, rk2, rv0, rv1;
  const int kc0 = tid_, kc1 = tid_ + 256, kc2 = tid_ + 512;
  const u16* kg0 = kb + (size_t)(kc0 / 12) * 96 + (kc0 % 12) * 8;
  const u16* kg1 = kb + (size_t)(kc1 / 12) * 96 + (kc1 % 12) * 8;
  const u16* kg2 = kb + (size_t)(kc2 / 12) * 96 + (kc2 % 12) * 8;
  const u16* vg0 = vt + (size_t)(tid_ >> 3) * nkeys + (tid_ & 7) * 8;
  const u16* vg1 = vt + (size_t)((tid_ + 256) >> 3) * nkeys + (tid_ & 7) * 8;
  const int kl0 = (kc0 / 12) * KST + (kc0 % 12) * 8, kl1 = (kc1 / 12) * KST + (kc1 % 12) * 8, kl2 = (kc2 / 12) * KST + (kc2 % 12) * 8;
  const int vl0 = (tid_ >> 3) * VST + (tid_ & 7) * 8, vl1 = ((tid_ + 256) >> 3) * VST + (tid_ & 7) * 8;
#define AT_GLOAD(kt_) do { rk0 = *(const uint4*)(kg0 + (size_t)(kt_) * 6144); rk1 = *(const uint4*)(kg1 + (size_t)(kt_) * 6144); \
    rk2 = *(const uint4*)(kg2 + (size_t)(kt_) * 6144); rv0 = *(const uint4*)(vg0 + (kt_) * 64); rv1 = *(const uint4*)(vg1 + (kt_) * 64); } while (0)
#define AT_SSTORE(st_) do { u16* ks2_ = sm + (st_) * STG; u16* vs2_ = ks2_ + 64 * KST; \
    *(uint4*)(ks2_ + kl0) = rk0; *(uint4*)(ks2_ + kl1) = rk1; *(uint4*)(ks2_ + kl2) = rk2; *(uint4*)(vs2_ + vl0) = rv0; *(uint4*)(vs2_ + vl1) = rv1; } while (0)
  __syncthreads();
  AT_GLOAD(0); AT_SSTORE(0);
  __syncthreads();
  for (int kt = 0; kt < nkt; ++kt) {
    const bool more = kt + 1 < nkt;
    if (more) AT_GLOAD(kt + 1);
    const u16* ks_ = sm + (kt & 1) * STG;
    const u16* vs_ = ks_ + 64 * KST;
    f32x16 St[2];
#pragma unroll
    for (int sub = 0; sub < 2; ++sub) {
#pragma unroll
      for (int r = 0; r < 16; ++r) St[sub][r] = 0.f;
      const u16* kr = ks_ + (sub * 32 + n) * KST + h2 * 8;
#pragma unroll
      for (int ks = 0; ks < 6; ++ks) St[sub] = MFMA32(*(const bf16x8*)(kr + ks * 16), qf[ks], St[sub]);
    }
    float mx = St[0][0];
#pragma unroll
    for (int r = 0; r < 16; ++r) { mx = fmaxf(mx, St[0][r]); mx = fmaxf(mx, St[1][r]); }
    mx = fmaxf(mx, __shfl_xor(mx, 32));
    const float mnew = fmaxf(mrun, mx);
    const float alpha = __builtin_amdgcn_exp2f(mrun - mnew);
    mrun = mnew;
    float ps = 0.f;
#pragma unroll
    for (int sub = 0; sub < 2; ++sub)
#pragma unroll
      for (int r = 0; r < 16; ++r) { float e = __builtin_amdgcn_exp2f(St[sub][r] - mnew); St[sub][r] = e; ps += e; }
    lsum = lsum * alpha + ps;
#pragma unroll
    for (int r = 0; r < 16; ++r) { O[0][r] *= alpha; O[1][r] *= alpha; }
#pragma unroll
    for (int sub = 0; sub < 2; ++sub)
#pragma unroll
      for (int s = 0; s < 2; ++s) {
        const bf16x8 pb = pack_acc(St[sub], s);
#pragma unroll
        for (int dt = 0; dt < 2; ++dt)
          O[dt] = MFMA32(load_perm(vs_ + (dt * 32 + n) * VST + sub * 32, s, h2), pb, O[dt]);
      }
    if (more) AT_SSTORE((kt + 1) & 1);
    __syncthreads();
  }
  lsum += __shfl_xor(lsum, 32);
  const float inv = 1.f / lsum;
  u16* oc = (u16*)(p.ws + B_OC) + (size_t)(tq0 + n) * 512 + head * 64;
#pragma unroll
  for (int dt = 0; dt < 2; ++dt)
#pragma unroll
    for (int a = 0; a < 4; ++a) {
      const int dv = dt * 32 + 8 * a + 4 * h2;
      *(uint2*)(oc + dv) = make_uint2(pack2(O[dt][4 * a] * inv, O[dt][4 * a + 1] * inv), pack2(O[dt][4 * a + 2] * inv, O[dt][4 * a + 3] * inv));
    }
}

DI void delta_out_tile(const Params& p, int l, int tile) {
  const int lane = otid() & 63, w = otid() >> 6;
  const u16* of = (const u16*)(p.ws + B_OF);
  const u16* ob = (const u16*)(p.ws + B_OB);
  const u16* z = (const u16*)(p.ws + B_Z);
  u16* oa = (u16*)(p.ws + B_OA);
  const float g0 = p.in[17][l * 128 + 2 * lane], g1 = p.in[17][l * 128 + 2 * lane + 1];
#pragma unroll 1
  for (int q = 0; q < 16; ++q) {
    const size_t t = (size_t)tile * 16 + w * 4 + (q >> 2);
    const int hh = q & 3;
    const size_t off = t * 512 + hh * 128 + 2 * lane;
    unsigned a = *(const unsigned*)(of + off), b = *(const unsigned*)(ob + off), zz = *(const unsigned*)(z + off);
    float o0 = blo(a) + blo(b), o1 = bhi(a) + bhi(b);
    float ss = wave_sum(o0 * o0 + o1 * o1);
    float rstd = rsqrtf(ss * (1.f / 128.f) + 1e-6f);
    float y0 = o0 * rstd * g0 * siluf_(blo(zz)), y1 = o1 * rstd * g1 * siluf_(bhi(zz));
    *(unsigned*)(oa + off) = pack2(y0, y1);
  }
}

DI void grid_barrier(unsigned* bar, unsigned target) {
  asm volatile("s_waitcnt vmcnt(0) lgkmcnt(0)" ::: "memory");
  __syncthreads();
  if (otid() == 0) {
    __builtin_amdgcn_fence(__ATOMIC_RELEASE, "agent");
    asm volatile("s_waitcnt vmcnt(0)" ::: "memory");
    __hip_atomic_fetch_add(bar, 1u, __ATOMIC_RELAXED, __HIP_MEMORY_SCOPE_AGENT);
    while (__hip_atomic_load(bar, __ATOMIC_RELAXED, __HIP_MEMORY_SCOPE_AGENT) < target) __builtin_amdgcn_s_sleep(5);
    __builtin_amdgcn_fence(__ATOMIC_ACQUIRE, "agent");
    asm volatile("s_waitcnt vmcnt(0)" ::: "memory");
  }
  __syncthreads();
}
#define GSYNC_FLAT() do { bar_target += gridDim.x; grid_barrier(p.bar, bar_target); } while (0)
DI unsigned xcc_id() { return (unsigned)__builtin_amdgcn_s_getreg((3 << 11) | 20) & 0xFu; }
DI void grid_barrier_xcd(unsigned* bar, unsigned xid, unsigned gen, unsigned xcnt, unsigned npres) {
  asm volatile("s_waitcnt vmcnt(0) lgkmcnt(0)" ::: "memory");
  __syncthreads();
  if (otid() == 0) {
    const unsigned old = __hip_atomic_fetch_add(bar + 64 + 32 * xid, 1u, __ATOMIC_RELAXED, __HIP_MEMORY_SCOPE_AGENT);
    if (old + 1 == gen * xcnt) {
      __builtin_amdgcn_fence(__ATOMIC_RELEASE, "agent");
      asm volatile("s_waitcnt vmcnt(0)" ::: "memory");
      __hip_atomic_fetch_add(bar + 32, 1u, __ATOMIC_RELAXED, __HIP_MEMORY_SCOPE_AGENT);
    }
    while (__hip_atomic_load(bar + 32, __ATOMIC_RELAXED, __HIP_MEMORY_SCOPE_AGENT) < gen * npres) __builtin_amdgcn_s_sleep(5);
    __builtin_amdgcn_fence(__ATOMIC_ACQUIRE, "agent");
    asm volatile("s_waitcnt vmcnt(0)" ::: "memory");
  }
  __syncthreads();
}
#define GSYNC() do { ++bar_gen; grid_barrier_xcd(p.bar, bx_id, bar_gen, bx_cnt, bx_np); } while (0)
#ifndef ONLY
#define PH(n) 1
#else
#define PH(n) ((n) == ONLY || (n) / 100 == ONLY || (n) == ONLY / 100)
#endif
__global__ void __launch_bounds__(256, 2) mega(Params p) {
  cg::grid_group grid = cg::this_grid();
  __shared__ __attribute__((aligned(16))) char smem_raw[73728];
  u16* sm = (u16*)smem_raw;
  float* smf = (float*)smem_raw;
  const int nb = gridDim.x, bid = blockIdx.x;
  unsigned bar_target = 0, bar_gen = 0;
  grid.sync();
  const unsigned bx_id = xcc_id() & 7u;
  unsigned bx_cnt = 1, bx_np = 1;
  {
    if (otid() == 0) __hip_atomic_fetch_add(p.bar + 16 + bx_id, 1u, __ATOMIC_RELAXED, __HIP_MEMORY_SCOPE_AGENT);
    GSYNC_FLAT();
    unsigned np = 0;
#pragma unroll
    for (unsigned x = 0; x < 8; ++x) {
      const unsigned c = __hip_atomic_load(p.bar + 16 + x, __ATOMIC_RELAXED, __HIP_MEMORY_SCOPE_AGENT);
      if (c > 0) ++np;
      if (x == bx_id) bx_cnt = c;
    }
    bx_np = np;
  }

  if (PH(0)) {
    const int tid = otid();
    for (int j = bid; j < 4 * CJ8; j += nb) conv_job(p, j / CJ8, j % CJ8, smf);
    for (int j = bid; j < 4 * 96; j += nb) mods_tile(p, j / 96, j % 96, smf);
    for (int j = bid; j < 64; j += nb) s5pre_tile(p, j);
    {
      const float4* xp = (const float4*)p.in[0];
      const float4* xs = (const float4*)p.in[1];
      float4* o = (float4*)p.out;
      const size_t nP = (size_t)TP_ * 256, nT = (size_t)T_ * 256;
      for (size_t i = (size_t)bid * 256 + tid; i < nT; i += (size_t)nb * 256) o[i] = i < nP ? xp[i] : xs[i - nP];
    }
    {
      float* rope = (float*)(p.ws + B_ROPE);
      for (int i = bid * 256 + tid; i < 2048 * 16; i += nb * 256) {
        const int pos = i >> 4, f = i & 15;
        const float invf = 1.f / powf(10000.f, (float)(f & 7) * 0.125f);
        const float ang = (f < 8 ? (float)(pos >> 6) : (float)(pos & 63)) * invf;
        float sn, cs;
        sincosf(ang, &sn, &cs);
        rope[i * 2] = cs; rope[i * 2 + 1] = sn;
      }
    }
    {
      u16* cc = (u16*)(p.ws + B_CKVC);
      for (int i = bid * 256 + tid; i < 8 * 4 * 256 * 256 / 2; i += nb * 256) {
        const int e = i * 2;
        const int c = e & 255, pos = (e >> 8) & 255, l = (e >> 16) & 3, b = e >> 18;
        float2 v = *(const float2*)(p.in[5] + e);
        *(unsigned*)(cc + ((size_t)(l * 2048 + b * 256 + pos)) * 256 + c) = pack2(v.x, v.y);
      }
    }
  }
  GSYNC();

  for (int l = 0; l < 4; ++l) {
    const u16* WL = (const u16*)(p.ws + B_W) + (size_t)l * W_LAYER;
    const float* mods = (const float*)(p.ws + B_MODS);
    if (PH(1)) norm_phase(p, l, 0, 1, p.in[11] + l * 1024);
    GSYNC();
    if (PH(2)) gemm_in_phase(p, l, sm);
    GSYNC();
    if (PH(3)) {
      for (int j = bid; j < NCH; j += nb) delta_prep_tile(p, l, j, sm);
      for (int j = bid; j < T_ / 4; j += nb) mla_prep_tile(p, l, j);
      for (int j = bid; j < 256; j += nb) cache_rope_tile(p, l, j);
      for (int j = bid; j < NCH * 16; j += nb) s5_chunk_tile(p, l, j >> 4, j & 15, 0, sm);
    }
    GSYNC();
    if (PH(4)) {
      const int tid = otid();
      if (PH(400)) for (int j = bid; j < NCH * 2; j += nb) delta_local_tile(p, j, smf);
      if (PH(410)) for (int j = (bid + (nb >> 1)) % nb; j < 192 * 6; j += nb) {
          const int q = j, mt = q / 6, nt = q % 6;
          f32x4 acc[4][4];
          zero_acc<4>(acc);
          gemm_core<4>(acc, (const u16*)(p.ws + B_QA) + (size_t)mt * 128 * 384, 384, WL + W_QB + (size_t)nt * 128 * 384, 384, 384, sm);
          u16* qm = (u16*)(p.ws + B_QM);
          const float qs = 0.10206207261596575f * 1.4426950408889634f;
          const float* rope = (const float*)(p.ws + B_ROPE);
          const int e_lane = tid & 63, e_w = tid >> 6, e_wr = e_w >> 1, e_wc = e_w & 1, e_fr = e_lane & 15, e_fq = e_lane >> 4;
          const bool is_s = (mt * 128 >= TP_);
#pragma unroll
          for (int i = 0; i < 4; ++i) {
            const int row = mt * 128 + e_wr * 64 + i * 16 + e_fr;
            f32x4 vals[4];
#pragma unroll
            for (int jj = 0; jj < 4; ++jj) vals[jj] = acc[i][jj];
            if (is_s) {
              const int pos = (row - TP_) & 2047;
              const float4 cs0 = *(const float4*)(rope + (size_t)(pos * 16 + e_fq * 4) * 2);
              const float4 cs1 = *(const float4*)(rope + (size_t)(pos * 16 + e_fq * 4) * 2 + 4);
              const float cs[4] = {cs0.x, cs0.z, cs1.x, cs1.z}, sn[4] = {cs0.y, cs0.w, cs1.y, cs1.w};
#pragma unroll
              for (int jj = 0; jj < 4; jj += 2) {
                const int gt = (nt * 128 + e_wc * 64) / 16 + jj;
                if (gt % 6 == 4) {
#pragma unroll
                  for (int r = 0; r < 4; ++r) {
                    const float x1 = vals[jj][r], x2 = vals[jj + 1][r];
                    vals[jj][r] = x1 * cs[r] - x2 * sn[r];
                    vals[jj + 1][r] = x2 * cs[r] + x1 * sn[r];
                  }
                }
              }
            }
#pragma unroll
            for (int jj = 0; jj < 4; ++jj) {
              f32x4 o; o[0] = vals[jj][0] * qs; o[1] = vals[jj][1] * qs; o[2] = vals[jj][2] * qs; o[3] = vals[jj][3] * qs;
              *(uint2*)(qm + (size_t)row * 768 + nt * 128 + e_wc * 64 + jj * 16 + e_fq * 4) = pack4(o);
            }
          }
      }
      if (PH(420)) for (int j = (bid + (nb >> 1) + (nb >> 2)) % nb; j < 208 * 8; j += nb) {
          const int q = j, mt = q >> 3, head = q & 7;
          f32x4 acc[4][4];
          zero_acc<4>(acc);
          const u16* A = mt < 192 ? (const u16*)(p.ws + B_KVA) + (size_t)mt * 128 * 256
                                  : (const u16*)(p.ws + B_CKVC) + ((size_t)l * 2048 + (size_t)(mt - 192) * 128) * 256;
          gemm_core<4, false>(acc, A, 256, WL + W_KVB + (size_t)head * 128 * 256, 256, 256, sm);
          int key0, nkeys; size_t kbo, vto;
          if (mt < 64) { const int seq = mt >> 1; key0 = (mt & 1) * 128; nkeys = 256; kbo = (size_t)(seq * 8 + head) * 256 * 96; vto = (size_t)(seq * 8 + head) * 64 * 256; }
          else if (mt < 192) { const int s = (mt - 64) >> 4; key0 = 256 + ((mt - 64) & 15) * 128; nkeys = 2304; kbo = KB_P + (size_t)(s * 8 + head) * 2304 * 96; vto = VT_P + (size_t)(s * 8 + head) * 64 * 2304; }
          else { const int s = (mt - 192) >> 1; key0 = ((mt - 192) & 1) * 128; nkeys = 2304; kbo = KB_P + (size_t)(s * 8 + head) * 2304 * 96; vto = VT_P + (size_t)(s * 8 + head) * 64 * 2304; }
          u16* kb = (u16*)(p.ws + B_KB) + kbo;
          u16* vt = (u16*)(p.ws + B_VT) + vto;
          const int e_lane = tid & 63, e_w = tid >> 6, e_wr = e_w >> 1, e_wc = e_w & 1, e_fr = e_lane & 15, e_fq = e_lane >> 4;
#pragma unroll
          for (int i = 0; i < 4; ++i)
#pragma unroll
            for (int jj = 0; jj < 4; ++jj) {
              const int key = key0 + e_wr * 64 + i * 16 + e_fq * 4;
              const int c = jj * 16 + e_fr;
              if (e_wc == 0) {
#pragma unroll
                for (int r = 0; r < 4; ++r) kb[(size_t)(key + r) * 96 + c] = f2bf(acc[i][jj][r]);
              } else {
                *(uint2*)(vt + (size_t)c * nkeys + key) = make_uint2(pack2(acc[i][jj][0], acc[i][jj][1]), pack2(acc[i][jj][2], acc[i][jj][3]));
              }
            }
      }
      if (PH(430)) for (int j = bid; j < 640; j += nb) s5_carry_tile(p, l, j);
    }
    GSYNC();
    if (PH(5)) {
      if (PH(500)) for (int j = bid; j < 320; j += nb) delta_scan_tile(p, l, j, sm);
      if (PH(510)) if (bid >= 64) for (int j = bid - 64; j < 1536; j += nb - 64) {
        if (j < 1024) attn_tile(p, 32 + (j >> 7), (j >> 4) & 7, j & 15, sm);
        else { const int q = j - 1024; attn_tile(p, q >> 4, (q >> 1) & 7, q & 1, sm); }
      }
      if (PH(530)) if (bid >= 64) for (int j = bid - 64; j < NCH * 8; j += nb - 64) {
        s5_chunk_tile(p, l, j >> 3, (j & 7) * 2, 1, sm);
        s5_chunk_tile(p, l, j >> 3, (j & 7) * 2 + 1, 1, sm);
      }
    }
    GSYNC();
    if (PH(6)) {
      for (int j = bid; j < T_ / 16; j += nb) delta_out_tile(p, l, j);
      for (int j = bid; j < 192 * 4; j += nb) {
        {
          const int q = j, mt = q >> 2, nt = q & 3;
          f32x4 acc[4][4];
          zero_acc<4>(acc);
          const u16* y5 = (const u16*)(p.ws + B_Y5);
          gemm_core<4>(acc, y5 + (size_t)mt * 128 * 512, 512, WL + W_GLU + (size_t)nt * 128 * 512, 512, 512, sm);
          u16* ob5 = (u16*)(p.ws + B_OB5);
          const float* bgl = p.in[27] + l * 512;
          EPI_LOOP(4) {
            const size_t row = mt * 128 + EROW; const int col = nt * 128 + ECOL4(4);
            const uint2 yy = *(const uint2*)(y5 + row * 512 + col);
            const float4 bb = *(const float4*)(bgl + col);
            f32x4 o;
            o[0] = blo(yy.x) * sigmoidf_(acc[i][j][0] + bb.x); o[1] = bhi(yy.x) * sigmoidf_(acc[i][j][1] + bb.y);
            o[2] = blo(yy.y) * sigmoidf_(acc[i][j][2] + bb.z); o[3] = bhi(yy.y) * sigmoidf_(acc[i][j][3] + bb.w);
            *(uint2*)(ob5 + row * 512 + col) = pack4(o);
          }
        }
      }
    }
    GSYNC();
    if (PH(7)) {
      const u16* H = (const u16*)(p.ws + B_H);
      u16* mg = (u16*)(p.ws + B_MG);
      for (int j = bid; j < 192 * 16; j += nb) {
        const int mt = j >> 4, nt = j & 15;
        f32x4 mer[4][2];
        zero_acc<2>(mer);
#pragma unroll 1
        for (int n = 0; n < 3; ++n) {
          f32x4 ag[4][2], ab[4][2];
          zero_acc<2>(ag);
          gemm_core<2>(ag, H + (size_t)mt * 128 * 1024, 1024, WL + W_G + (size_t)(n * 1024 + nt * 64) * 1024, 1024, 1024, sm);
          zero_acc<2>(ab);
          const u16* on = (const u16*)(p.ws + (n == 0 ? B_OA : (n == 1 ? B_OB5 : B_OC)));
          gemm_core<2>(ab, on + (size_t)mt * 128 * 512, 512, WL + W_BR + (size_t)(nt * 64) * 1536 + n * 512, 1536, 512, sm);
#pragma unroll
          for (int i = 0; i < 4; ++i)
#pragma unroll
            for (int jj = 0; jj < 2; ++jj)
#pragma unroll
              for (int r = 0; r < 4; ++r) mer[i][jj][r] += sigmoidf_(ag[i][jj][r]) * ab[i][jj][r];
        }
        EPI_LOOP(2) { *(uint2*)(mg + (size_t)(mt * 128 + EROW) * 1024 + nt * 64 + ECOL4(2)) = pack4(mer[i][j]); }
      }
    }
    GSYNC();
    if (PH(8)) {
      const u16* mg = (const u16*)(p.ws + B_MG);
      for (int j = bid; j < 192 * 8; j += nb) {
        const int mt = j >> 3, nt = j & 7;
        f32x4 acc[4][4];
        zero_acc<4>(acc);
        gemm_core<4>(acc, mg + (size_t)mt * 128 * 1024, 1024, WL + W_OUT + (size_t)nt * 128 * 1024, 1024, 1024, sm);
        const float* gm = mods + (size_t)(l * 9 + tok_v(mt * 128)) * 6144 + 2 * 1024;
        EPI_LOOP(4) {
          const size_t row = mt * 128 + EROW; const int col = nt * 128 + ECOL4(4);
          float4* xp_ = (float4*)(p.out + row * 1024 + col);
          float4 xv = *xp_; const float4 gg = *(const float4*)(gm + col);
          xv.x += gg.x * acc[i][j][0]; xv.y += gg.y * acc[i][j][1]; xv.z += gg.z * acc[i][j][2]; xv.w += gg.w * acc[i][j][3];
          *xp_ = xv;
        }
      }
    }
    GSYNC();
    if (PH(9)) norm_phase(p, l, 3, 4, p.in[12] + l * 1024);
    GSYNC();
    if (PH(10)) {
      const u16* H = (const u16*)(p.ws + B_H);
      u16* up = (u16*)(p.ws + B_UP);
      for (int j = bid; j < 192 * 44; j += nb) {
        const int mt = j / 44, nt = j % 44;
        f32x4 acc[4][4];
        zero_acc<4>(acc);
        gemm_core<4>(acc, H + (size_t)mt * 128 * 1024, 1024, WL + W_UP + (size_t)nt * 128 * 1024, 1024, 1024, sm);
        EPI_LOOP(4) { *(uint2*)(up + (size_t)(mt * 128 + EROW) * 5632 + nt * 128 + ECOL4(4)) = pack4(acc[i][j]); }
      }
    }
    GSYNC();
    if (PH(11)) {
      const int tid = otid();
      const u16* up = (const u16*)(p.ws + B_UP);
      u16* act = (u16*)(p.ws + B_ACT);
      const float* cw = p.in[35] + (size_t)l * 3 * 5632;
      const float* cb = p.in[36] + (size_t)l * 5632;
      constexpr int TG = 16;
      for (int it = bid * 256 + tid; it < (T_ / TG) * 352; it += nb * 256) {
        const int t0 = (it / 352) * TG, c8 = (it % 352) * 8;
        int pos0, L;
        if (t0 < TP_) { pos0 = t0 & 255; L = 256; } else { pos0 = (t0 - TP_) & 2047; L = 2048; }
        float wg[3][8], wv[3][8], bgv[8], bvv[8];
#pragma unroll
        for (int d = 0; d < 3; ++d) {
          const float4 g0 = *(const float4*)(cw + d * 5632 + c8), g1 = *(const float4*)(cw + d * 5632 + c8 + 4);
          const float4 v0 = *(const float4*)(cw + d * 5632 + 2816 + c8), v1 = *(const float4*)(cw + d * 5632 + 2816 + c8 + 4);
          wg[d][0] = g0.x; wg[d][1] = g0.y; wg[d][2] = g0.z; wg[d][3] = g0.w; wg[d][4] = g1.x; wg[d][5] = g1.y; wg[d][6] = g1.z; wg[d][7] = g1.w;
          wv[d][0] = v0.x; wv[d][1] = v0.y; wv[d][2] = v0.z; wv[d][3] = v0.w; wv[d][4] = v1.x; wv[d][5] = v1.y; wv[d][6] = v1.z; wv[d][7] = v1.w;
        }
        {
          const float4 g0 = *(const float4*)(cb + c8), g1 = *(const float4*)(cb + c8 + 4);
          const float4 v0 = *(const float4*)(cb + 2816 + c8), v1 = *(const float4*)(cb + 2816 + c8 + 4);
          bgv[0] = g0.x; bgv[1] = g0.y; bgv[2] = g0.z; bgv[3] = g0.w; bgv[4] = g1.x; bgv[5] = g1.y; bgv[6] = g1.z; bgv[7] = g1.w;
          bvv[0] = v0.x; bvv[1] = v0.y; bvv[2] = v0.z; bvv[3] = v0.w; bvv[4] = v1.x; bvv[5] = v1.y; bvv[6] = v1.z; bvv[7] = v1.w;
        }
        uint4 g0r = make_uint4(0, 0, 0, 0), v0r = g0r, g1r, v1r, g2r, v2r;
        if (pos0 > 0) { const u16* rp = up + (size_t)(t0 - 1) * 5632; g0r = *(const uint4*)(rp + c8); v0r = *(const uint4*)(rp + 2816 + c8); }
        { const u16* rp = up + (size_t)t0 * 5632; g1r = *(const uint4*)(rp + c8); v1r = *(const uint4*)(rp + 2816 + c8); }
#pragma unroll 4
        for (int o = 0; o < TG; ++o) {
          g2r = make_uint4(0, 0, 0, 0); v2r = g2r;
          if (pos0 + o + 1 < L) { const u16* rp = up + (size_t)(t0 + o + 1) * 5632; g2r = *(const uint4*)(rp + c8); v2r = *(const uint4*)(rp + 2816 + c8); }
          const unsigned ga[3][4] = {{g0r.x, g0r.y, g0r.z, g0r.w}, {g1r.x, g1r.y, g1r.z, g1r.w}, {g2r.x, g2r.y, g2r.z, g2r.w}};
          const unsigned va[3][4] = {{v0r.x, v0r.y, v0r.z, v0r.w}, {v1r.x, v1r.y, v1r.z, v1r.w}, {v2r.x, v2r.y, v2r.z, v2r.w}};
          float res[8];
#pragma unroll
          for (int e = 0; e < 8; ++e) {
            float g = bgv[e], v = bvv[e];
#pragma unroll
            for (int d = 0; d < 3; ++d) {
              const float xg = (e & 1) ? bhi(ga[d][e >> 1]) : blo(ga[d][e >> 1]);
              const float xv = (e & 1) ? bhi(va[d][e >> 1]) : blo(va[d][e >> 1]);
              g += wg[d][e] * xg; v += wv[d][e] * xv;
            }
            res[e] = siluf_(g) * v;
          }
          *(uint4*)(act + (size_t)(t0 + o) * 2816 + c8) = make_uint4(pack2(res[0], res[1]), pack2(res[2], res[3]), pack2(res[4], res[5]), pack2(res[6], res[7]));
          g0r = g1r; v0r = v1r; g1r = g2r; v1r = v2r;
        }
      }
    }
    GSYNC();
    if (PH(12)) {
      const u16* act = (const u16*)(p.ws + B_ACT);
      for (int j = bid; j < 192 * 8; j += nb) {
        const int mt = j >> 3, nt = j & 7;
        f32x4 acc[4][4];
        zero_acc<4>(acc);
        gemm_core<4>(acc, act + (size_t)mt * 128 * 2816, 2816, WL + W_DN + (size_t)nt * 128 * 2816, 2816, 2816, sm);
        const float* gf = mods + (size_t)(l * 9 + tok_v(mt * 128)) * 6144 + 5 * 1024;
        EPI_LOOP(4) {
          const size_t row = mt * 128 + EROW; const int col = nt * 128 + ECOL4(4);
          float4* xp_ = (float4*)(p.out + row * 1024 + col);
          float4 xv = *xp_; const float4 gg = *(const float4*)(gf + col);
          xv.x += gg.x * acc[i][j][0]; xv.y += gg.y * acc[i][j][1]; xv.z += gg.z * acc[i][j][2]; xv.w += gg.w * acc[i][j][3];
          *xp_ = xv;
        }
      }
    }
    GSYNC();
  }
  if (PH(13)) {
    const int tid = otid();
    const int lane = tid & 63, w = tid >> 6;
    const float* gfin = p.in[38];
    for (int tile = bid; tile < T_ / 4; tile += nb) {
      const int t = tile * 4 + w;
      float4* xr = (float4*)(p.out + (size_t)t * 1024);
      float4 v[4];
      float ss = 0.f;
#pragma unroll
      for (int j = 0; j < 4; ++j) { v[j] = xr[lane + 64 * j]; ss += v[j].x * v[j].x + v[j].y * v[j].y + v[j].z * v[j].z + v[j].w * v[j].w; }
      ss = wave_sum(ss);
      const float rstd = rsqrtf(ss * (1.f / 1024.f) + 1e-6f);
#pragma unroll
      for (int j = 0; j < 4; ++j) {
        float4 g = *(const float4*)(gfin + (lane + 64 * j) * 4);
        xr[lane + 64 * j] = make_float4(v[j].x * rstd * g.x, v[j].y * rstd * g.y, v[j].z * rstd * g.z, v[j].w * rstd * g.w);
      }
    }
  }
}

extern "C" void kernel_launch(void* const* d_in, const int* in_sizes, int n_in, void* d_out, int out_size,
                              void* d_ws, size_t ws_size, hipStream_t stream) {
  static int grid_blocks = 0;
  if (!grid_blocks) {
    int dev = 0, cus = 0, per_cu = 0;
    (void)hipGetDevice(&dev);
    (void)hipDeviceGetAttribute(&cus, hipDeviceAttributeMultiprocessorCount, dev);
    (void)hipOccupancyMaxActiveBlocksPerMultiprocessor(&per_cu, mega, 256, 0);
    if (per_cu > 2) per_cu = 2;
    if (per_cu < 1) per_cu = 1;
    grid_blocks = cus * per_cu;
  }
  if (ws_size < B_TOTAL || n_in < 39) {
    fprintf(stderr, "workspace too small: %zu < %zu\n", ws_size, (size_t)B_END);
    return;
  }
  Params p{};
  for (int i = 0; i < 39; ++i) p.in[i] = (const float*)d_in[i];
  p.out = (float*)d_out;
  p.ws = (char*)d_ws;
  p.bar = (unsigned*)((char*)d_ws + B_BAR);
  (void)hipMemsetAsync(p.bar, 0, 4096, stream);
  void* args[] = {&p};
  hipError_t e = hipLaunchCooperativeKernel((void*)mega, dim3(grid_blocks), dim3(256), args, 0, stream);
  if (e != hipSuccess) fprintf(stderr, "cooperative launch failed: %s (grid %d)\n", hipGetErrorString(e), grid_blocks);
}
```

```cpp
#include <hip/hip_runtime.h>
#include <hip/hip_cooperative_groups.h>
#include <cstdio>
namespace cg = cooperative_groups;

#define DI __device__ __forceinline__
typedef __bf16 bf16;
using bf16x8 = __attribute__((ext_vector_type(8))) short;
using f32x4 = __attribute__((ext_vector_type(4))) float;
using f32x16 = __attribute__((ext_vector_type(16))) float;
typedef unsigned short u16;

constexpr int T_ = 24576, TP_ = 8192;
constexpr int NCH = 384;
constexpr long long O_SD = 25165824LL, O_S5RE = 41943040LL, O_S5IM = 42467328LL, O_CKV = 42991616LL, O_KR = 51380224LL;

constexpr size_t W_IN = 0;
constexpr size_t W_G = W_IN + 3328ull * 1024;
constexpr size_t W_QB = W_G + 3072ull * 1024;
constexpr size_t W_KVB = W_QB + 768ull * 384;
constexpr size_t W_GLU = W_KVB + 1024ull * 256;
constexpr size_t W_BR = W_GLU + 512ull * 512;
constexpr size_t W_OUT = W_BR + 1024ull * 1536;
constexpr size_t W_UP = W_OUT + 1024ull * 1024;
constexpr size_t W_DN = W_UP + 5632ull * 1024;
constexpr size_t W_LAYER = W_DN + 1024ull * 2816;

constexpr size_t al(size_t x) { return (x + 255) & ~(size_t)255; }
constexpr size_t B_W = 0;
constexpr size_t B_MODS = al(B_W + 4 * W_LAYER * 2);
constexpr size_t B_ROPE = al(B_MODS + 4ull * 9 * 6144 * 4);
constexpr size_t B_LAMB = al(B_ROPE + 2048ull * 32 * 4);
constexpr size_t B_LAM64 = al(B_LAMB + 4ull * 2 * 32 * 64 * 8);
constexpr size_t B_BBT = al(B_LAM64 + 4ull * 2 * 32 * 64 * 8);
constexpr size_t B_CMT = al(B_BBT + 4ull * 2 * 32 * 128 * 16 * 2);
constexpr size_t B_CKVC = al(B_CMT + 4ull * 32 * 16 * 128 * 2);
constexpr size_t B_H = al(B_CKVC + 4ull * 2048 * 256 * 2);
constexpr size_t B_QKV = al(B_H + (size_t)T_ * 1024 * 2);
constexpr size_t B_Z = al(B_QKV + (size_t)T_ * 1536 * 2);
constexpr size_t B_US5 = al(B_Z + (size_t)T_ * 512 * 2);
constexpr size_t B_QA = al(B_US5 + (size_t)T_ * 512 * 2);
constexpr size_t B_KVA = al(B_QA + (size_t)T_ * 384 * 2);
constexpr size_t B_MISC = al(B_KVA + (size_t)T_ * 256 * 2);
constexpr size_t B_QN = al(B_MISC + (size_t)T_ * 48 * 4);
constexpr size_t B_KN = al(B_QN + (size_t)T_ * 512 * 2);
constexpr size_t B_VV = al(B_KN + (size_t)T_ * 512 * 2);
constexpr size_t B_KT = al(B_VV + (size_t)T_ * 512 * 2);
constexpr size_t B_BG = al(B_KT + (size_t)T_ * 512 * 2);
constexpr size_t B_TM = al(B_BG + (size_t)T_ * 16 * 4);
constexpr size_t B_QKM = al(B_TM + (size_t)T_ * 512 * 2);
constexpr size_t B_GC = al(B_QKM + (size_t)T_ * 512 * 2);
constexpr size_t B_BC = al(B_GC + (size_t)NCH * 4 * 2 * 64 * 4);
constexpr size_t KB_P = 32ull * 8 * 256 * 96, KB_S = 8ull * 8 * 2304 * 96;
constexpr size_t VT_P = 32ull * 8 * 64 * 256, VT_S = 8ull * 8 * 64 * 2304;
constexpr size_t B_KB = al(B_BC + (size_t)NCH * 4 * 2 * 64 * 4);
constexpr size_t B_VT = al(B_KB + (KB_P + KB_S) * 2);
constexpr size_t B_QM = al(B_VT + (VT_P + VT_S) * 2);
constexpr size_t B_HEND = al(B_QM + (size_t)T_ * 768 * 2);
constexpr size_t B_HIN = al(B_HEND + (size_t)NCH * 32 * 2 * 64 * 8);
constexpr size_t B_Y5 = al(B_HIN + (size_t)NCH * 32 * 2 * 64 * 8);
constexpr size_t B_OC = al(B_Y5 + (size_t)T_ * 512 * 2);
constexpr size_t B_END = al(B_OC + (size_t)T_ * 512 * 2);
constexpr size_t B_OF = B_QKV;
constexpr size_t B_OB = B_QKV + (size_t)T_ * 512 * 2;
constexpr size_t B_MG = B_QKV;
constexpr size_t B_OA = B_QN;
constexpr size_t B_OB5 = B_KN;
constexpr size_t B_UP = B_QKV;
constexpr size_t B_ACT = B_KB;
static_assert(B_UP + (size_t)T_ * 5632 * 2 <= B_KB, "UP overlaps ACT");
static_assert(B_ACT + (size_t)T_ * 2816 * 2 <= B_END, "ACT too big");
constexpr size_t B_BAR = B_END;
constexpr size_t B_TOTAL = B_BAR + 4096;
static_assert(B_TOTAL <= 768ull * 1024 * 1024, "workspace too big");

struct Params {
  const float* in[39];
  float* out;
  char* ws;
  unsigned* bar;
};

DI int otid() { int t = (int)__builtin_amdgcn_workitem_id_x(); asm volatile("" : "+v"(t)); return t; }
DI unsigned pack2(float a, float b) {
  typedef __attribute__((ext_vector_type(2))) __bf16 bf2;
  bf2 v; v[0] = (__bf16)a; v[1] = (__bf16)b;
  return __builtin_bit_cast(unsigned, v);
}
DI u16 f2bf(float a) { return (u16)(pack2(a, 0.f) & 0xffffu); }
DI float bf2f(u16 u) { return __uint_as_float(((unsigned)u) << 16); }
DI float blo(unsigned u) { return __uint_as_float(u << 16); }
DI float bhi(unsigned u) { return __uint_as_float(u & 0xffff0000u); }
DI float wave_sum(float v) {
#pragma unroll
  for (int o = 32; o > 0; o >>= 1) v += __shfl_xor(v, o);
  return v;
}
DI float sigmoidf_(float x) { return 1.f / (1.f + __expf(-x)); }
DI float siluf_(float x) { return x / (1.f + __expf(-x)); }
DI int tok_v(int t) { return t < TP_ ? 0 : 1 + ((t - TP_) >> 11); }
DI int crow(int r, int h2) { return (r & 3) + 8 * (r >> 2) + 4 * h2; }
DI bf16x8 mk8(unsigned a, unsigned b, unsigned c, unsigned d) {
  uint4 p = make_uint4(a, b, c, d);
  return __builtin_bit_cast(bf16x8, p);
}
DI bf16x8 pack_acc(const f32x16& x, int s) {
  return mk8(pack2(x[8 * s], x[8 * s + 1]), pack2(x[8 * s + 2], x[8 * s + 3]), pack2(x[8 * s + 4], x[8 * s + 5]),
             pack2(x[8 * s + 6], x[8 * s + 7]));
}
DI bf16x8 load_perm(const u16* rowptr, int s, int h2) {
  uint2 a = *(const uint2*)(rowptr + 16 * s + 4 * h2);
  uint2 b = *(const uint2*)(rowptr + 16 * s + 8 + 4 * h2);
  return mk8(a.x, a.y, b.x, b.y);
}
DI unsigned swap16(unsigned u) { return (u >> 16) | (u << 16); }
DI bf16x8 load_perm_rev(const u16* rowptr, int base, int s, int h2) {
  uint2 a = *(const uint2*)(rowptr + 60 - base - 16 * s - 4 * h2);
  uint2 b = *(const uint2*)(rowptr + 52 - base - 16 * s - 4 * h2);
  return mk8(swap16(a.y), swap16(a.x), swap16(b.y), swap16(b.x));
}
#define MFMA16(a, b, c) __builtin_amdgcn_mfma_f32_16x16x32_bf16((a), (b), (c), 0, 0, 0)
#define MFMA32(a, b, c) __builtin_amdgcn_mfma_f32_32x32x16_bf16((a), (b), (c), 0, 0, 0)

template <int NJ, bool SWAP = true>
DI void gemm_core(f32x4 (&acc)[4][NJ], const u16* __restrict__ A, int lda, const u16* __restrict__ B, int ldb, int K,
                  u16* sm) {
  const int tid = otid(), lane = tid & 63, w = tid >> 6, wr = w >> 1, wc = w & 1;
  const int fr = lane & 15, fq = lane >> 4;
  constexpr int RS = 136;
  const int lrow = tid >> 4, lkc = tid & 15;
  uint4 a0, a1, a2, a3, a4, a5, a6, a7, b0, b1, b2, b3, b4, b5, b6, b7;
  b4 = b5 = b6 = b7 = make_uint4(0, 0, 0, 0);
  const u16* ap = A + (size_t)lrow * lda + lkc * 8;
  const u16* bp = B + (size_t)lrow * ldb + lkc * 8;
  const int nk = K >> 7;
  u16* as = sm;
  u16* bs = sm + 128 * RS;
  {
    const int k0 = 0;
    a0 = *(const uint4*)(ap + (size_t)(0 * 16) * lda + k0);
    a1 = *(const uint4*)(ap + (size_t)(1 * 16) * lda + k0);
    a2 = *(const uint4*)(ap + (size_t)(2 * 16) * lda + k0);
    a3 = *(const uint4*)(ap + (size_t)(3 * 16) * lda + k0);
    a4 = *(const uint4*)(ap + (size_t)(4 * 16) * lda + k0);
    a5 = *(const uint4*)(ap + (size_t)(5 * 16) * lda + k0);
    a6 = *(const uint4*)(ap + (size_t)(6 * 16) * lda + k0);
    a7 = *(const uint4*)(ap + (size_t)(7 * 16) * lda + k0);
    b0 = *(const uint4*)(bp + (size_t)(0 * 16) * ldb + k0);
    b1 = *(const uint4*)(bp + (size_t)(1 * 16) * ldb + k0);
    b2 = *(const uint4*)(bp + (size_t)(2 * 16) * ldb + k0);
    b3 = *(const uint4*)(bp + (size_t)(3 * 16) * ldb + k0);
    if (NJ == 4) b4 = *(const uint4*)(bp + (size_t)(4 * 16) * ldb + k0);
    if (NJ == 4) b5 = *(const uint4*)(bp + (size_t)(5 * 16) * ldb + k0);
    if (NJ == 4) b6 = *(const uint4*)(bp + (size_t)(6 * 16) * ldb + k0);
    if (NJ == 4) b7 = *(const uint4*)(bp + (size_t)(7 * 16) * ldb + k0);
  }
  for (int kt = 0; kt < nk; ++kt) {
    __syncthreads();
    *(uint4*)(as + (lrow + 0 * 16) * RS + lkc * 8) = a0;
    *(uint4*)(as + (lrow + 1 * 16) * RS + lkc * 8) = a1;
    *(uint4*)(as + (lrow + 2 * 16) * RS + lkc * 8) = a2;
    *(uint4*)(as + (lrow + 3 * 16) * RS + lkc * 8) = a3;
    *(uint4*)(as + (lrow + 4 * 16) * RS + lkc * 8) = a4;
    *(uint4*)(as + (lrow + 5 * 16) * RS + lkc * 8) = a5;
    *(uint4*)(as + (lrow + 6 * 16) * RS + lkc * 8) = a6;
    *(uint4*)(as + (lrow + 7 * 16) * RS + lkc * 8) = a7;
    *(uint4*)(bs + (lrow + 0 * 16) * RS + lkc * 8) = b0;
    *(uint4*)(bs + (lrow + 1 * 16) * RS + lkc * 8) = b1;
    *(uint4*)(bs + (lrow + 2 * 16) * RS + lkc * 8) = b2;
    *(uint4*)(bs + (lrow + 3 * 16) * RS + lkc * 8) = b3;
    if (NJ == 4) *(uint4*)(bs + (lrow + 4 * 16) * RS + lkc * 8) = b4;
    if (NJ == 4) *(uint4*)(bs + (lrow + 5 * 16) * RS + lkc * 8) = b5;
    if (NJ == 4) *(uint4*)(bs + (lrow + 6 * 16) * RS + lkc * 8) = b6;
    if (NJ == 4) *(uint4*)(bs + (lrow + 7 * 16) * RS + lkc * 8) = b7;
    __syncthreads();
    {
      const int k0 = (kt + 1 < nk ? kt + 1 : kt) * 128;
    a0 = *(const uint4*)(ap + (size_t)(0 * 16) * lda + k0);
    a1 = *(const uint4*)(ap + (size_t)(1 * 16) * lda + k0);
    a2 = *(const uint4*)(ap + (size_t)(2 * 16) * lda + k0);
    a3 = *(const uint4*)(ap + (size_t)(3 * 16) * lda + k0);
    a4 = *(const uint4*)(ap + (size_t)(4 * 16) * lda + k0);
    a5 = *(const uint4*)(ap + (size_t)(5 * 16) * lda + k0);
    a6 = *(const uint4*)(ap + (size_t)(6 * 16) * lda + k0);
    a7 = *(const uint4*)(ap + (size_t)(7 * 16) * lda + k0);
    b0 = *(const uint4*)(bp + (size_t)(0 * 16) * ldb + k0);
    b1 = *(const uint4*)(bp + (size_t)(1 * 16) * ldb + k0);
    b2 = *(const uint4*)(bp + (size_t)(2 * 16) * ldb + k0);
    b3 = *(const uint4*)(bp + (size_t)(3 * 16) * ldb + k0);
    if (NJ == 4) b4 = *(const uint4*)(bp + (size_t)(4 * 16) * ldb + k0);
    if (NJ == 4) b5 = *(const uint4*)(bp + (size_t)(5 * 16) * ldb + k0);
    if (NJ == 4) b6 = *(const uint4*)(bp + (size_t)(6 * 16) * ldb + k0);
    if (NJ == 4) b7 = *(const uint4*)(bp + (size_t)(7 * 16) * ldb + k0);
    }
    __builtin_amdgcn_s_setprio(1);
    __builtin_amdgcn_iglp_opt(0);
#pragma unroll
    for (int ks = 0; ks < 4; ++ks) {
      bf16x8 af[4], bfr[NJ];
#pragma unroll
      for (int i = 0; i < 4; ++i) af[i] = *(const bf16x8*)(as + (wr * 64 + i * 16 + fr) * RS + ks * 32 + fq * 8);
#pragma unroll
      for (int j = 0; j < NJ; ++j) bfr[j] = *(const bf16x8*)(bs + (wc * NJ * 16 + j * 16 + fr) * RS + ks * 32 + fq * 8);
#pragma unroll
      for (int i = 0; i < 4; ++i)
#pragma unroll
        for (int j = 0; j < NJ; ++j) acc[i][j] = SWAP ? MFMA16(bfr[j], af[i], acc[i][j]) : MFMA16(af[i], bfr[j], acc[i][j]);
    }
    __builtin_amdgcn_s_setprio(0);
  }
}
template <int NJ>
DI void zero_acc(f32x4 (&acc)[4][NJ]) {
#pragma unroll
  for (int i = 0; i < 4; ++i)
#pragma unroll
    for (int j = 0; j < NJ; ++j) acc[i][j] = f32x4{0.f, 0.f, 0.f, 0.f};
}
#define EPI_LOOP(NJ_)                                                              \
  const int e_lane = otid() & 63, e_w = otid() >> 6;                               \
  const int e_wr = e_w >> 1, e_wc = e_w & 1, e_fr = e_lane & 15, e_fq = e_lane >> 4; \
  _Pragma("unroll") for (int i = 0; i < 4; ++i)                                    \
  _Pragma("unroll") for (int j = 0; j < NJ_; ++j)
#define EROW (e_wr * 64 + i * 16 + e_fr)
#define ECOL4(NJ_) (e_wc * NJ_ * 16 + j * 16 + e_fq * 4)
DI uint2 pack4(const f32x4& v) { return make_uint2(pack2(v[0], v[1]), pack2(v[2], v[3])); }

DI int colmap(int kind, int n) {
  if (kind == 0) {
    if (n < 2048) return n;
    if (n < 2560) return 2064 + (n - 2048);
    if (n < 2944) return 2576 + (n - 2560);
    if (n < 3200) return 2960 + (n - 2944);
    int j = n - 3200;
    if (j < 16) return 2048 + j;
    if (j < 48) return 3216 + (j - 16);
    return -1;
  }
  if (kind == 1) return 3248 + n;
  return n;
}
DI void convT_tile(const float* __restrict__ src, int lds, int K, u16* __restrict__ dst, int kind, int kt, int nt,
                   float* sm) {
  const int tid = otid();
  const int c = tid & 63;
  const int sc = colmap(kind, nt * 64 + c);
  __syncthreads();
#pragma unroll 4
  for (int i = 0; i < 16; ++i) {
    int r = (tid >> 6) + i * 4;
    float v = sc >= 0 ? src[(size_t)(kt * 64 + r) * lds + sc] : 0.f;
    sm[r * 65 + c] = v;
  }
  __syncthreads();
  const int n = tid >> 2, kq = tid & 3;
  unsigned pk[8];
#pragma unroll
  for (int j = 0; j < 8; ++j) pk[j] = pack2(sm[(kq * 16 + 2 * j) * 65 + n], sm[(kq * 16 + 2 * j + 1) * 65 + n]);
  u16* d = dst + (size_t)(nt * 64 + n) * K + kt * 64 + kq * 16;
  *(uint4*)d = make_uint4(pk[0], pk[1], pk[2], pk[3]);
  *(uint4*)(d + 8) = make_uint4(pk[4], pk[5], pk[6], pk[7]);
}
constexpr int CJ0 = 16 * 52, CJ1 = CJ0 + 16 * 48, CJ2 = CJ1 + 6 * 12, CJ3 = CJ2 + 4 * 16, CJ4 = CJ3 + 8 * 8,
              CJ5 = CJ4 + 24 * 16, CJ6 = CJ5 + 16 * 16, CJ7 = CJ6 + 16 * 88, CJ8 = CJ7 + 44 * 16;
DI void conv_job(const Params& p, int l, int j, float* sm) {
  u16* wl = (u16*)(p.ws + B_W) + (size_t)l * W_LAYER;
  if (j < CJ0) { convT_tile(p.in[13] + (size_t)l * 1024 * 6320, 6320, 1024, wl + W_IN, 0, j / 52, j % 52, sm); return; }
  if (j < CJ1) { j -= CJ0; convT_tile(p.in[13] + (size_t)l * 1024 * 6320, 6320, 1024, wl + W_G, 1, j / 48, j % 48, sm); return; }
  if (j < CJ2) { j -= CJ1; convT_tile(p.in[29] + (size_t)l * 384 * 768, 768, 384, wl + W_QB, 2, j / 12, j % 12, sm); return; }
  if (j < CJ3) { j -= CJ2; convT_tile(p.in[31] + (size_t)l * 256 * 1024, 1024, 256, wl + W_KVB, 2, j / 16, j % 16, sm); return; }
  if (j < CJ4) { j -= CJ3; convT_tile(p.in[26] + (size_t)l * 512 * 512, 512, 512, wl + W_GLU, 2, j / 8, j % 8, sm); return; }
  if (j < CJ5) { j -= CJ4; convT_tile(p.in[32] + (size_t)l * 1536 * 1024, 1024, 1536, wl + W_BR, 2, j / 16, j % 16, sm); return; }
  if (j < CJ6) { j -= CJ5; convT_tile(p.in[33] + (size_t)l * 1024 * 1024, 1024, 1024, wl + W_OUT, 2, j / 16, j % 16, sm); return; }
  if (j < CJ7) { j -= CJ6; convT_tile(p.in[34] + (size_t)l * 1024 * 5632, 5632, 1024, wl + W_UP, 2, j / 88, j % 88, sm); return; }
  j -= CJ7; convT_tile(p.in[37] + (size_t)l * 2816 * 1024, 1024, 2816, wl + W_DN, 2, j / 16, j % 16, sm);
}
DI void mods_tile(const Params& p, int l, int jg, float* sm) {
  const int tid = otid();
  __syncthreads();
  for (int i = tid; i < 9 * 1024; i += 256) {
    int v = i >> 10, k = i & 1023;
    float cv = v == 0 ? p.in[8][k] : p.in[7][(v - 1) * 1024 + k];
    sm[i] = cv / (1.f + __expf(-cv));
  }
  __syncthreads();
  const int col = jg * 64 + (tid & 63), kq = tid >> 6;
  float acc[9];
#pragma unroll
  for (int v = 0; v < 9; ++v) acc[v] = 0.f;
  const float* wp = p.in[9] + (size_t)l * 1024 * 6144 + col;
#pragma unroll 4
  for (int k = kq * 256; k < kq * 256 + 256; ++k) {
    float wv = wp[(size_t)k * 6144];
#pragma unroll
    for (int v = 0; v < 9; ++v) acc[v] += sm[v * 1024 + k] * wv;
  }
  float* red = sm + 9 * 1024;
#pragma unroll
  for (int v = 0; v < 9; ++v) red[(kq * 9 + v) * 64 + (tid & 63)] = acc[v];
  __syncthreads();
  if (kq == 0) {
    float* mods = (float*)(p.ws + B_MODS);
    float b = p.in[10][l * 6144 + col];
#pragma unroll
    for (int v = 0; v < 9; ++v) {
      float s = red[(0 * 9 + v) * 64 + tid] + red[(1 * 9 + v) * 64 + tid] + red[(2 * 9 + v) * 64 + tid] + red[(3 * 9 + v) * 64 + tid];
      mods[(size_t)(l * 9 + v) * 6144 + col] = s + b;
    }
  }
}
DI void s5pre_tile(const Params& p, int tile) {
  const int id = tile * 256 + otid();
  const int pp = id & 63, g = (id >> 6) & 31, dir = (id >> 11) & 1, l = id >> 12;
  const float lre = p.in[18][((l * 2 + dir) * 32 + g) * 64 + pp];
  const float lim = p.in[19][((l * 2 + dir) * 32 + g) * 64 + pp];
  const float dt = expf(p.in[20][(l * 2 + dir) * 32 + g]);
  float er = expf(lre * dt), sn, cs;
  sincosf(lim * dt, &sn, &cs);
  const float lbr = er * cs, lbi = er * sn;
  float e64 = expf(64.f * lre * dt), s64, c64;
  sincosf(64.f * lim * dt, &s64, &c64);
  float2* lamb = (float2*)(p.ws + B_LAMB);
  float2* lam64 = (float2*)(p.ws + B_LAM64);
  const int li = ((l * 2 + dir) * 32 + g) * 64 + pp;
  lamb[li] = make_float2(lbr, lbi);
  lam64[li] = make_float2(e64 * c64, e64 * s64);
  const float nr = lbr - 1.f, ni = lbi, den = lre * lre + lim * lim;
  const float cr = (nr * lre + ni * lim) / den, ci = (ni * lre - nr * lim) / den;
  u16* bbt = (u16*)(p.ws + B_BBT) + (size_t)((l * 2 + dir) * 32 + g) * 128 * 16;
  const float* bre = p.in[21] + (size_t)((l * 32 + g) * 64 + pp) * 16;
  const float* bim = p.in[22] + (size_t)((l * 32 + g) * 64 + pp) * 16;
#pragma unroll
  for (int c = 0; c < 16; ++c) {
    float br = bre[c], bi = bim[c];
    bbt[pp * 16 + c] = f2bf(cr * br - ci * bi);
    bbt[(64 + pp) * 16 + c] = f2bf(cr * bi + ci * br);
  }
  if (dir == 0) {
    u16* cmt = (u16*)(p.ws + B_CMT) + (size_t)(l * 32 + g) * 16 * 128;
    const float* cre = p.in[23] + (size_t)(l * 32 + g) * 16 * 64;
    const float* cim = p.in[24] + (size_t)(l * 32 + g) * 16 * 64;
#pragma unroll
    for (int c = 0; c < 16; ++c) {
      cmt[c * 128 + pp] = f2bf(cre[c * 64 + pp]);
      cmt[c * 128 + 64 + pp] = f2bf(-cim[c * 64 + pp]);
    }
  }
}

DI void norm_phase(const Params& p, int l, int shift_idx, int scale_idx, const float* gn, bool from_inputs) {
  const float* x = p.out;
  u16* H = (u16*)(p.ws + B_H);
  const float* mods = (const float*)(p.ws + B_MODS);
  const int lane = otid() & 63, w = otid() >> 6;
  for (int tile = blockIdx.x; tile < T_ / 4; tile += gridDim.x) {
    const int t = tile * 4 + w;
    const float4* xr = from_inputs ? (const float4*)(t < TP_ ? p.in[0] + (size_t)t * 1024 : p.in[1] + (size_t)(t - TP_) * 1024)
                                   : (const float4*)(x + (size_t)t * 1024);
    float4 v[4];
    float ss = 0.f;
#pragma unroll
    for (int j = 0; j < 4; ++j) {
      v[j] = xr[lane + 64 * j];
      ss += v[j].x * v[j].x + v[j].y * v[j].y + v[j].z * v[j].z + v[j].w * v[j].w;
    }
    ss = wave_sum(ss);
    const float rstd = rsqrtf(ss * (1.f / 1024.f) + 1e-6f);
    const float* mb = mods + (size_t)(l * 9 + tok_v(t)) * 6144;
#pragma unroll
    for (int j = 0; j < 4; ++j) {
      const int c = (lane + 64 * j) * 4;
      float4 g = *(const float4*)(gn + c);
      float4 sc = *(const float4*)(mb + scale_idx * 1024 + c);
      float4 sh = *(const float4*)(mb + shift_idx * 1024 + c);
      float y0 = v[j].x * rstd * g.x * (1.f + sc.x) + sh.x;
      float y1 = v[j].y * rstd * g.y * (1.f + sc.y) + sh.y;
      float y2 = v[j].z * rstd * g.z * (1.f + sc.z) + sh.z;
      float y3 = v[j].w * rstd * g.w * (1.f + sc.w) + sh.w;
      *(uint2*)(H + (size_t)t * 1024 + c) = make_uint2(pack2(y0, y1), pack2(y2, y3));
    }
  }
}

DI void gemm_in_phase(const Params& p, int l, u16* sm) {
  const u16* H = (const u16*)(p.ws + B_H);
  const u16* Wt = (const u16*)(p.ws + B_W) + (size_t)l * W_LAYER + W_IN;
  for (int tile = blockIdx.x; tile < 192 * 26; tile += gridDim.x) {
    const int mt = tile / 26, nt = tile % 26;
    f32x4 acc[4][4];
    zero_acc<4>(acc);
    gemm_core<4>(acc, H + (size_t)mt * 128 * 1024, 1024, Wt + (size_t)nt * 128 * 1024, 1024, 1024, sm);
    if (nt < 25) {
      u16* dst; int ld, c0;
      if (nt < 12) { dst = (u16*)(p.ws + B_QKV); ld = 1536; c0 = nt * 128; }
      else if (nt < 16) { dst = (u16*)(p.ws + B_Z); ld = 512; c0 = (nt - 12) * 128; }
      else if (nt < 20) { dst = (u16*)(p.ws + B_US5); ld = 512; c0 = (nt - 16) * 128; }
      else if (nt < 23) { dst = (u16*)(p.ws + B_QA); ld = 384; c0 = (nt - 20) * 128; }
      else { dst = (u16*)(p.ws + B_KVA); ld = 256; c0 = (nt - 23) * 128; }
      EPI_LOOP(4) { *(uint2*)(dst + (size_t)(mt * 128 + EROW) * ld + c0 + ECOL4(4)) = pack4(acc[i][j]); }
    } else {
      float* misc = (float*)(p.ws + B_MISC);
      EPI_LOOP(4) {
        const int c = ECOL4(4);
        if (c < 48) *(float4*)(misc + (size_t)(mt * 128 + EROW) * 48 + c) = make_float4(acc[i][j][0], acc[i][j][1], acc[i][j][2], acc[i][j][3]);
      }
    }
  }
}

DI void delta_prep_tile(const Params& p, int l, int chunk, u16* sm) {
  const int tid = otid(), lane = tid & 63, w = tid >> 6;
  const int tb = chunk * 64;
  int pos0, L;
  if (tb < TP_) { pos0 = tb & 255; L = 256; } else { pos0 = (tb - TP_) & 2047; L = 2048; }
  const u16* qkv = (const u16*)(p.ws + B_QKV);
  const float* cw = p.in[14] + (size_t)l * 5 * 1536;
  u16* ksm = sm + w * (64 * 130);
  __syncthreads();
  for (int gi = w; gi < 12; gi += 4) {
    const int ch = gi * 128 + 2 * lane;
    float w0[5], w1[5];
#pragma unroll
    for (int i = 0; i < 5; ++i) { w0[i] = cw[i * 1536 + ch]; w1[i] = cw[i * 1536 + ch + 1]; }
    float a0[5], a1[5];
#pragma unroll
    for (int i = 0; i < 4; ++i) {
      int ps = pos0 - 2 + i;
      unsigned u = (ps >= 0 && ps < L) ? *(const unsigned*)(qkv + (size_t)(tb - 2 + i) * 1536 + ch) : 0u;
      a0[i + 1] = blo(u); a1[i + 1] = bhi(u);
    }
    u16* dst = (u16*)(p.ws + (gi < 4 ? B_QN : (gi < 8 ? B_KN : B_VV)));
    const int hh = gi & 3;
    for (int tt = 0; tt < 64; ++tt) {
#pragma unroll
      for (int i = 0; i < 4; ++i) { a0[i] = a0[i + 1]; a1[i] = a1[i + 1]; }
      {
        int ps = pos0 + tt + 2;
        unsigned u = (ps < L) ? *(const unsigned*)(qkv + (size_t)(tb + tt + 2) * 1536 + ch) : 0u;
        a0[4] = blo(u); a1[4] = bhi(u);
      }
      float y0 = 0.f, y1 = 0.f;
#pragma unroll
      for (int i = 0; i < 5; ++i) { y0 += w0[i] * a0[i]; y1 += w1[i] * a1[i]; }
      y0 = siluf_(y0); y1 = siluf_(y1);
      if (gi < 8) {
        float ss = wave_sum(y0 * y0 + y1 * y1);
        float sc = rsqrtf(ss + 1e-6f);
        if (gi < 4) sc *= 0.08838834764831845f;
        y0 *= sc; y1 *= sc;
      }
      const unsigned pk = pack2(y0, y1);
      *(unsigned*)(dst + (size_t)(tb + tt) * 512 + hh * 128 + 2 * lane) = pk;
      if (gi >= 4 && gi < 8) *(unsigned*)(ksm + tt * 130 + 2 * lane) = pk;
    }
    if (gi >= 4 && gi < 8) {
      u16* kt = (u16*)(p.ws + B_KT) + (size_t)(chunk * 4 + hh) * 128 * 64;
#pragma unroll
      for (int rr = 0; rr < 2; ++rr) {
        const int dk = lane + 64 * rr;
        unsigned pk[32];
#pragma unroll
        for (int t2 = 0; t2 < 32; ++t2) pk[t2] = (unsigned)ksm[(2 * t2) * 130 + dk] | ((unsigned)ksm[(2 * t2 + 1) * 130 + dk] << 16);
#pragma unroll
        for (int q = 0; q < 8; ++q) *(uint4*)(kt + dk * 64 + q * 8) = make_uint4(pk[4 * q], pk[4 * q + 1], pk[4 * q + 2], pk[4 * q + 3]);
      }
    }
  }
  const float* misc = (const float*)(p.ws + B_MISC);
  float* bg = (float*)(p.ws + B_BG);
  for (int i = tid; i < 512; i += 256) {
    const int tt = i >> 3, dh = i & 7;
    const size_t t = tb + tt;
    float bl = misc[t * 48 + dh], alp = misc[t * 48 + 8 + dh];
    float x = alp + p.in[16][l * 8 + dh];
    float sp = x > 20.f ? x : log1pf(__expf(x));
    bg[t * 16 + dh] = sigmoidf_(bl);
    bg[t * 16 + 8 + dh] = -__expf(p.in[15][l * 8 + dh]) * sp;
  }
}

DI size_t kb_off(int t, int head) {
  if (t < TP_) return ((size_t)((t >> 8) * 8 + head) * 256 + (t & 255)) * 96;
  const int s = (t - TP_) >> 11, pos = (t - TP_) & 2047;
  return KB_P + ((size_t)(s * 8 + head) * 2304 + 256 + pos) * 96;
}
DI void mla_prep_tile(const Params& p, int l, int tile) {
  const int lane = otid() & 63, w = otid() >> 6;
  const int t = tile * 4 + w;
  u16* qa = (u16*)(p.ws + B_QA) + (size_t)t * 384;
  u16* kva = (u16*)(p.ws + B_KVA) + (size_t)t * 256;
  const float* misc = (const float*)(p.ws + B_MISC) + (size_t)t * 48;
  {
    unsigned u[3]; float ss = 0.f;
#pragma unroll
    for (int j = 0; j < 3; ++j) { u[j] = *(const unsigned*)(qa + 2 * lane + 128 * j); float a = blo(u[j]), b = bhi(u[j]); ss += a * a + b * b; }
    ss = wave_sum(ss);
    const float rstd = rsqrtf(ss * (1.f / 384.f) + 1e-6f);
    const float* g = p.in[28] + l * 384;
#pragma unroll
    for (int j = 0; j < 3; ++j) {
      int c = 2 * lane + 128 * j;
      *(unsigned*)(qa + c) = pack2(blo(u[j]) * rstd * g[c], bhi(u[j]) * rstd * g[c + 1]);
    }
  }
  {
    unsigned u[2]; float ss = 0.f;
#pragma unroll
    for (int j = 0; j < 2; ++j) { u[j] = *(const unsigned*)(kva + 2 * lane + 128 * j); float a = blo(u[j]), b = bhi(u[j]); ss += a * a + b * b; }
    ss = wave_sum(ss);
    const float rstd = rsqrtf(ss * (1.f / 256.f) + 1e-6f);
    const float* g = p.in[30] + l * 256;
#pragma unroll
    for (int j = 0; j < 2; ++j) {
      int c = 2 * lane + 128 * j;
      float a = blo(u[j]) * rstd * g[c], b = bhi(u[j]) * rstd * g[c + 1];
      *(unsigned*)(kva + c) = pack2(a, b);
      if (t < TP_) {
        float* o = p.out + O_CKV + ((size_t)((t >> 8) * 4 + l) * 256 + (t & 255)) * 256 + c;
        *(float2*)o = make_float2(a, b);
      }
    }
  }
  {
    const int i = lane & 31;
    float kr = misc[16 + i];
    float val;
    if (t < TP_) {
      val = kr;
      if (lane < 32) p.out[O_KR + ((size_t)((t >> 8) * 4 + l) * 256 + (t & 255)) * 32 + i] = kr;
    } else {
      const int pos = (t - TP_) & 2047;
      const float* rp = (const float*)(p.ws + B_ROPE) + (size_t)pos * 32 + (i & 15) * 2;
      const float cs = rp[0], sn = rp[1];
      float other = __shfl_xor(kr, 16);
      val = (i < 16) ? (kr * cs - other * sn) : (kr * cs + other * sn);
    }
    u16* kb = (u16*)(p.ws + B_KB);
    const u16 bv = f2bf(val);
#pragma unroll
    for (int hh = 0; hh < 4; ++hh) {
      int head = hh * 2 + (lane >> 5);
      kb[kb_off(t, head) + 64 + i] = bv;
    }
  }
}
DI void cache_rope_tile(const Params& p, int l, int tile) {
  const int pr = tile * 8 + (otid() >> 5), i = otid() & 31;
  const int s = pr >> 8, pos = pr & 255;
  const float v = p.in[6][((size_t)(s * 4 + l) * 256 + pos) * 32 + i];
  u16* kb = (u16*)(p.ws + B_KB);
  const u16 bv = f2bf(v);
#pragma unroll
  for (int head = 0; head < 8; ++head) kb[KB_P + ((size_t)(s * 8 + head) * 2304 + pos) * 96 + 64 + i] = bv;
}

DI float gelu_tanh(float x) {
  const float k0 = 0.7978845608028654f, k1 = 0.044715f;
  float u = k0 * (x + k1 * x * x * x);
  float e = __expf(2.f * u);
  float th = 1.f - 2.f / (e + 1.f);
  return 0.5f * x * (1.f + th);
}
DI void s5_chunk_tile(const Params& p, int l, int chunk, int gp, int mode, u16* sm) {
  const int tid = otid(), lane = tid & 63, w = tid >> 6;
  const u16* us5 = (const u16*)(p.ws + B_US5);
  constexpr int RS = 136;
  const int gi_w = w >> 1, half = w & 1, g_w = gp * 2 + gi_w;
  const int n = lane & 31, h2 = lane >> 5;
  bf16x8 af[2], bq[2][2];
#pragma unroll
  for (int mi = 0; mi < 2; ++mi) af[mi] = *(const bf16x8*)(us5 + (size_t)(chunk * 64 + mi * 32 + n) * 512 + g_w * 16 + 8 * h2);
#pragma unroll
  for (int dir = 0; dir < 2; ++dir) {
    const u16* bbt = (const u16*)(p.ws + B_BBT) + (size_t)((l * 2 + dir) * 32 + g_w) * 128 * 16;
#pragma unroll
    for (int nn = 0; nn < 2; ++nn) bq[dir][nn] = *(const bf16x8*)(bbt + ((half * 2 + nn) * 32 + n) * 16 + 8 * h2);
  }
  const int gi_t = tid >> 7, dir_t = (tid >> 6) & 1, pp = tid & 63, g_t = gp * 2 + gi_t;
  const float2 lb = ((const float2*)(p.ws + B_LAMB))[((l * 2 + dir_t) * 32 + g_t) * 64 + pp];
  const size_t hidx = ((size_t)(chunk * 32 + g_t) * 2 + dir_t) * 64 + pp;
  float hr = 0.f, hi = 0.f;
  if (mode) { float2 h0 = ((const float2*)(p.ws + B_HIN))[hidx]; hr = h0.x; hi = h0.y; }
  const int fr = lane & 15, fq = lane >> 4;
  bf16x8 cq[4];
  u16 uu[2][4];
  float dsk = 0.f;
  if (mode) {
    const u16* cmt = (const u16*)(p.ws + B_CMT) + (size_t)(l * 32 + g_w) * 16 * 128;
#pragma unroll
    for (int k4 = 0; k4 < 4; ++k4) cq[k4] = *(const bf16x8*)(cmt + fr * 128 + k4 * 32 + fq * 8);
#pragma unroll
    for (int mm = 0; mm < 2; ++mm)
#pragma unroll
      for (int r = 0; r < 4; ++r) uu[mm][r] = us5[((size_t)chunk * 64 + ((w & 1) * 2 + mm) * 16 + fq * 4 + r) * 512 + g_w * 16 + fr];
    dsk = p.in[25][l * 512 + g_w * 16 + fr];
  }
  __syncthreads();
  {
#pragma unroll
    for (int dir = 0; dir < 2; ++dir) {
#pragma unroll
      for (int nn = 0; nn < 2; ++nn) {
        const int nt = half * 2 + nn;
#pragma unroll
        for (int mi = 0; mi < 2; ++mi) {
          f32x16 acc;
#pragma unroll
          for (int r = 0; r < 16; ++r) acc[r] = 0.f;
          acc = MFMA32(af[mi], bq[dir][nn], acc);
          u16* d = sm + (size_t)((gi_w * 2 + dir) * 64 + mi * 32) * RS + nt * 32 + n;
#pragma unroll
          for (int r = 0; r < 16; ++r) d[crow(r, h2) * RS] = f2bf(acc[r]);
        }
      }
    }
  }
  __syncthreads();
  {
    u16* base = sm + (size_t)((gi_t * 2 + dir_t) * 64) * RS;
#pragma unroll 8
    for (int st = 0; st < 64; ++st) {
      const int tk = dir_t ? 63 - st : st;
      float br = bf2f(base[tk * RS + pp]), bi = bf2f(base[tk * RS + 64 + pp]);
      float nr = __builtin_fmaf(lb.x, hr, __builtin_fmaf(-lb.y, hi, br));
      float ni = __builtin_fmaf(lb.x, hi, __builtin_fmaf(lb.y, hr, bi));
      asm volatile("" : "+v"(nr));
      asm volatile("" : "+v"(ni));
      hr = nr; hi = ni;
      if (mode) { base[tk * RS + pp] = f2bf(hr); base[tk * RS + 64 + pp] = f2bf(hi); }
    }
    if (!mode) ((float2*)(p.ws + B_HEND))[hidx] = make_float2(hr, hi);
  }
  if (!mode) return;
  __syncthreads();
  {
    f32x4 acc[2];
    acc[0] = f32x4{0.f, 0.f, 0.f, 0.f}; acc[1] = acc[0];
#pragma unroll
    for (int ks = 0; ks < 8; ++ks) {
      const int dir = ks >> 2, kk = (ks & 3) * 32;
#pragma unroll
      for (int mm = 0; mm < 2; ++mm) {
        const int mi = (w & 1) * 2 + mm;
        bf16x8 a2 = *(const bf16x8*)(sm + (size_t)((gi_w * 2 + dir) * 64 + mi * 16 + fr) * RS + kk + fq * 8);
        acc[mm] = MFMA16(a2, cq[ks & 3], acc[mm]);
      }
    }
    u16* y5 = (u16*)(p.ws + B_Y5);
#pragma unroll
    for (int mm = 0; mm < 2; ++mm)
#pragma unroll
      for (int r = 0; r < 4; ++r) {
        const size_t t = (size_t)chunk * 64 + ((w & 1) * 2 + mm) * 16 + fq * 4 + r;
        float y = acc[mm][r] + dsk * bf2f(uu[mm][r]);
        y5[t * 512 + g_w * 16 + fr] = f2bf(gelu_tanh(y));
      }
  }
}
DI void s5_carry_tile(const Params& p, int l, int tile) {
  const int seq = tile >> 4, gp = tile & 15;
  const int tid = otid(), gi = tid >> 7, dir = (tid >> 6) & 1, pp = tid & 63, g = gp * 2 + gi;
  int c0, nc;
  if (seq < 32) { c0 = seq * 4; nc = 4; } else { c0 = 128 + (seq - 32) * 32; nc = 32; }
  const float2 l64 = ((const float2*)(p.ws + B_LAM64))[((l * 2 + dir) * 32 + g) * 64 + pp];
  float hr = 0.f, hi = 0.f;
  if (seq >= 32) {
    const size_t si = ((size_t)((seq - 32) * 4 + l) * 2 + dir) * 2048 + g * 64 + pp;
    hr = p.in[3][si]; hi = p.in[4][si];
  }
  const float2* hend = (const float2*)(p.ws + B_HEND);
  float2* hin = (float2*)(p.ws + B_HIN);
  for (int it = 0; it < nc; ++it) {
    const int ck = c0 + (dir ? nc - 1 - it : it);
    const size_t idx = ((size_t)(ck * 32 + g) * 2 + dir) * 64 + pp;
    hin[idx] = make_float2(hr, hi);
    float2 he = hend[idx];
    float nr = __builtin_fmaf(l64.x, hr, __builtin_fmaf(-l64.y, hi, he.x));
    float ni = __builtin_fmaf(l64.x, hi, __builtin_fmaf(l64.y, hr, he.y));
    asm volatile("" : "+v"(nr));
    asm volatile("" : "+v"(ni));
    hr = nr; hi = ni;
  }
  if (seq < 32) {
    const size_t so = ((size_t)(seq * 4 + l) * 2 + dir) * 2048 + g * 64 + pp;
    p.out[O_S5RE + so] = hr;
    p.out[O_S5IM + so] = hi;
  }
}

DI void delta_local_tile(const Params& p, int tile, float* smf) {
  const int chunk = tile >> 1, dir = tile & 1;
  const int tid = otid(), lane = tid & 63, h = tid >> 6;
  const int m = lane & 31, h2 = lane >> 5;
  const int tb = chunk * 64;
  const float* bg = (const float*)(p.ws + B_BG);
  const u16* kn = (const u16*)(p.ws + B_KN);
  const u16* qn = (const u16*)(p.ws + B_QN);
  float* Aw = smf + h * 4096;
  const size_t cidx = ((size_t)(chunk * 4 + h) * 2 + dir);
  const int tl = tb + (dir ? 63 - lane : lane);
  float gcs = bg[(size_t)tl * 16 + 8 + dir * 4 + h];
  const float beta = bg[(size_t)tl * 16 + dir * 4 + h];
#pragma unroll
  for (int o = 1; o < 64; o <<= 1) {
    float v = __shfl_up(gcs, o);
    if (lane >= o) gcs += v;
  }
  ((float*)(p.ws + B_GC))[cidx * 64 + lane] = gcs;
  ((float*)(p.ws + B_BC))[cidx * 64 + lane] = beta;
  __syncthreads();
  u16* qkm = (u16*)(p.ws + B_QKM) + cidx * 4096;
#pragma unroll 1
  for (int tt = 0; tt < 3; ++tt) {
    const int mi = tt == 0 ? 0 : 1, ni = tt == 2 ? 1 : 0;
    const int cm = 32 * mi + m, cn = 32 * ni + m;
    const u16* krm = kn + (size_t)(tb + (dir ? 63 - cm : cm)) * 512 + h * 128 + h2 * 8;
    const u16* qrm = qn + (size_t)(tb + (dir ? 63 - cm : cm)) * 512 + h * 128 + h2 * 8;
    const u16* krn = kn + (size_t)(tb + (dir ? 63 - cn : cn)) * 512 + h * 128 + h2 * 8;
    f32x16 ak, aq;
#pragma unroll
    for (int r = 0; r < 16; ++r) { ak[r] = 0.f; aq[r] = 0.f; }
#pragma unroll
    for (int ks = 0; ks < 8; ++ks) {
      const bf16x8 fkm = *(const bf16x8*)(krm + ks * 16), fqm = *(const bf16x8*)(qrm + ks * 16), fkn = *(const bf16x8*)(krn + ks * 16);
      ak = MFMA32(fkm, fkn, ak);
      aq = MFMA32(fqm, fkn, aq);
    }
    const int e = 32 * ni + m;
    const float gce = __shfl(gcs, e);
#pragma unroll
    for (int r = 0; r < 16; ++r) {
      const int c = 32 * mi + crow(r, h2);
      const float gcc = __shfl(gcs, c), bc = __shfl(beta, c);
      const float dec = (e <= c) ? __expf(gcc - gce) : 0.f;
      Aw[c * 64 + e] = (e < c) ? ak[r] * bc * dec : 0.f;
      qkm[c * 64 + e] = f2bf(aq[r] * dec);
    }
  }
  __syncthreads();
  u16* tm = (u16*)(p.ws + B_TM) + cidx * 4096;
  float x[64];
#pragma unroll
  for (int i = 0; i < 64; ++i) {
    float a = (i == lane) ? 1.f : 0.f;
#pragma unroll
    for (int j = 0; j < i; ++j) a -= Aw[i * 64 + j] * x[j];
    x[i] = a;
    tm[i * 64 + lane] = f2bf(a);
  }
}

template <int dir>
DI void delta_scan_body(const Params& p, int l, int seq, int h, u16* sm);
DI void delta_scan_tile(const Params& p, int l, int idx, u16* sm) {
  int seq, h, dir;
  if (idx < 64) { seq = 32 + (idx >> 3); h = (idx >> 1) & 3; dir = idx & 1; }
  else { const int i2 = idx - 64; seq = i2 >> 3; h = (i2 >> 1) & 3; dir = i2 & 1; }
  __builtin_amdgcn_s_setprio(3);
  if (dir) delta_scan_body<1>(p, l, seq, h, sm); else delta_scan_body<0>(p, l, seq, h, sm);
  __builtin_amdgcn_s_setprio(0);
}
template <int dir>
DI void delta_scan_body(const Params& p, int l, int seq, int h, u16* sm) {
  int chunk0, nch;
  if (seq < 32) { chunk0 = seq * 4; nch = 4; } else { chunk0 = 128 + (seq - 32) * 32; nch = 32; }
  const int lane = otid() & 63, w = otid() >> 6;
  const int n = lane & 31, h2 = lane >> 5;
  const int dvc = w * 32 + n;
  const u16* kn = (const u16*)(p.ws + B_KN);
  const u16* qn = (const u16*)(p.ws + B_QN);
  const u16* vv = (const u16*)(p.ws + B_VV);
  u16* od = (u16*)(p.ws + (dir ? B_OB : B_OF));
  f32x16 S[4];
  if (seq >= 32) {
    const float* s0 = p.in[2] + ((size_t)(((seq - 32) * 4 + l) * 2 + dir) * 4 + h) * 16384;
#pragma unroll
    for (int t = 0; t < 4; ++t)
#pragma unroll
      for (int r = 0; r < 16; ++r) S[t][r] = s0[(size_t)(32 * t + crow(r, h2)) * 128 + dvc];
  } else {
#pragma unroll
    for (int t = 0; t < 4; ++t)
#pragma unroll
      for (int r = 0; r < 16; ++r) S[t][r] = 0.f;
  }
  for (int it = 0; it < nch; ++it) {
    const int chunk = chunk0 + (dir ? nch - 1 - it : it);
    const int tb = chunk * 64;
    const size_t cidx = ((size_t)(chunk * 4 + h) * 2 + dir);
    const float* gcp = (const float*)(p.ws + B_GC) + cidx * 64;
    const float* bcp = (const float*)(p.ws + B_BC) + cidx * 64;
    const u16* tm = (const u16*)(p.ws + B_TM) + cidx * 4096;
    const u16* qkm = (const u16*)(p.ws + B_QKM) + cidx * 4096;
    const u16* ktp = (const u16*)(p.ws + B_KT) + (size_t)(chunk * 4 + h) * 8192;
    const float glast = gcp[63];
    size_t trow[2];
#pragma unroll
    for (int mi = 0; mi < 2; ++mi) { const int c = 32 * mi + n; trow[mi] = (size_t)(tb + (dir ? 63 - c : c)); }
#define SCHED_FENCE() asm volatile("" ::: "memory")
    u16* Ks = sm; u16* Qs = sm + 8704; u16* Vs = sm + 17408; u16* KTs = sm + 26112;
    float* GCs = (float*)(sm + 35328);
    const float* gcl = GCs; const float* bcl = GCs + 64;
    uint4 xm0, xm1, xq0, xq1;
    u16* vls = Vs + w * 32;
    __syncthreads();
    {
      const int tid_ = otid();
      const int r0 = tid_ >> 4, ck = tid_ & 15;
      uint4 tk[4], tq[4], tv[4], tt[4];
      xm0 = *(const uint4*)(tm + tid_ * 8); xm1 = *(const uint4*)(tm + 2048 + tid_ * 8);
      xq0 = *(const uint4*)(qkm + tid_ * 8); xq1 = *(const uint4*)(qkm + 2048 + tid_ * 8);
      float4 gcv = make_float4(0.f, 0.f, 0.f, 0.f);
      if (tid_ < 16) gcv = *(const float4*)(gcp + tid_ * 4); else if (tid_ < 32) gcv = *(const float4*)(bcp + (tid_ - 16) * 4);
#pragma unroll
      for (int j = 0; j < 4; ++j) {
        const size_t go = (size_t)(tb + r0 + 16 * j) * 512 + h * 128 + ck * 8;
        tk[j] = *(const uint4*)(kn + go); tq[j] = *(const uint4*)(qn + go); tv[j] = *(const uint4*)(vv + go);
        tt[j] = *(const uint4*)(ktp + ((tid_ >> 3) + 32 * j) * 64 + (tid_ & 7) * 8);
      }
#pragma unroll
      for (int j = 0; j < 4; ++j) {
        const int tau = r0 + 16 * j, c = dir ? 63 - tau : tau;
        *(uint4*)(Ks + c * 136 + ck * 8) = tk[j]; *(uint4*)(Qs + c * 136 + ck * 8) = tq[j]; *(uint4*)(Vs + c * 136 + ck * 8) = tv[j];
        *(uint4*)(KTs + ((tid_ >> 3) + 32 * j) * 72 + (tid_ & 7) * 8) = tt[j];
      }
      if (tid_ < 32) *(float4*)(GCs + tid_ * 4) = gcv;
    }
    __syncthreads();
    f32x16 X[2], QS[2];
    {
      bf16x8 Sb[4][2];
#pragma unroll
      for (int t = 0; t < 4; ++t)
#pragma unroll
        for (int s = 0; s < 2; ++s) Sb[t][s] = pack_acc(S[t], s);
#pragma unroll
      for (int mi = 0; mi < 2; ++mi)
#pragma unroll
        for (int r = 0; r < 16; ++r) { X[mi][r] = 0.f; QS[mi][r] = 0.f; }
#pragma unroll
      for (int t = 0; t < 4; ++t) {
#pragma unroll
        for (int mi = 0; mi < 2; ++mi) {
          const u16* krow_ = Ks + (32 * mi + n) * 136;
          const u16* qrow_ = Qs + (32 * mi + n) * 136;
#pragma unroll
          for (int s = 0; s < 2; ++s) {
            X[mi] = MFMA32(load_perm(krow_ + 32 * t, s, h2), Sb[t][s], X[mi]);
            QS[mi] = MFMA32(load_perm(qrow_ + 32 * t, s, h2), Sb[t][s], QS[mi]);
          }
        }
        SCHED_FENCE();
      }
    }
    __syncthreads();
    {
      const int tid_ = otid();
      const int r_ = tid_ >> 3, c_ = (tid_ & 7) * 8;
      *(uint4*)(Ks + r_ * 72 + c_) = xm0; *(uint4*)(Ks + (r_ + 32) * 72 + c_) = xm1;
      *(uint4*)(Qs + r_ * 72 + c_) = xq0; *(uint4*)(Qs + (r_ + 32) * 72 + c_) = xq1;
    }
    __syncthreads();
    bf16x8 Rb[2][2];
#pragma unroll
    for (int mi = 0; mi < 2; ++mi) {
#pragma unroll
      for (int a = 0; a < 4; ++a) {
        const int c4 = 32 * mi + 8 * a + 4 * h2;
        const float4 g4 = *(const float4*)(gcl + c4);
        const float4 b4 = *(const float4*)(bcl + c4);
        const float gg[4] = {g4.x, g4.y, g4.z, g4.w};
        const float bb[4] = {b4.x, b4.y, b4.z, b4.w};
#pragma unroll
        for (int q = 0; q < 4; ++q) {
          const int c = c4 + q;
          const float v = bf2f(vls[c * 136 + n]);
          const float eg = __expf(gg[q]);
          X[mi][4 * a + q] = bb[q] * (v - eg * X[mi][4 * a + q]);
          QS[mi][4 * a + q] *= eg;
        }
      }
      Rb[mi][0] = pack_acc(X[mi], 0);
      Rb[mi][1] = pack_acc(X[mi], 1);
    }
    SCHED_FENCE();
    f32x16 Vn[2];
#pragma unroll
    for (int mo = 0; mo < 2; ++mo) {
#pragma unroll
      for (int r = 0; r < 16; ++r) Vn[mo][r] = 0.f;
#pragma unroll
      for (int mi = 0; mi <= mo; ++mi)
#pragma unroll
        for (int s = 0; s < 2; ++s) Vn[mo] = MFMA32(load_perm(Ks + (32 * mo + n) * 72 + 32 * mi, s, h2), Rb[mi][s], Vn[mo]);
    }
    SCHED_FENCE();
    {
      bf16x8 Vb[2][2];
#pragma unroll
      for (int mi = 0; mi < 2; ++mi) { Vb[mi][0] = pack_acc(Vn[mi], 0); Vb[mi][1] = pack_acc(Vn[mi], 1); }
#pragma unroll
      for (int mo = 0; mo < 2; ++mo) {
#pragma unroll
        for (int mi = 0; mi <= mo; ++mi)
#pragma unroll
          for (int s = 0; s < 2; ++s) QS[mo] = MFMA32(load_perm(Qs + (32 * mo + n) * 72 + 32 * mi, s, h2), Vb[mi][s], QS[mo]);
      }
      __syncthreads();
#pragma unroll
      for (int mo = 0; mo < 2; ++mo)
#pragma unroll
        for (int r = 0; r < 16; ++r) vls[(32 * mo + crow(r, h2)) * 136 + n] = f2bf(QS[mo][r]);
      __syncthreads();
#pragma unroll
      for (int jv = 0; jv < 4; ++jv) {
        const int tau = (lane >> 2) + 16 * jv, cq = lane & 3;
        const uint4 oq = *(const uint4*)(vls + (dir ? 63 - tau : tau) * 136 + cq * 8);
        *(uint4*)(od + (size_t)(tb + tau) * 512 + h * 128 + w * 32 + cq * 8) = oq;
      }
    }
    SCHED_FENCE();
    bf16x8 Vsb[2][2];
#pragma unroll
    for (int mi = 0; mi < 2; ++mi) {
#pragma unroll
      for (int a = 0; a < 4; ++a) {
        const float4 g4 = *(const float4*)(gcl + 32 * mi + 8 * a + 4 * h2);
        Vn[mi][4 * a + 0] *= __expf(glast - g4.x); Vn[mi][4 * a + 1] *= __expf(glast - g4.y);
        Vn[mi][4 * a + 2] *= __expf(glast - g4.z); Vn[mi][4 * a + 3] *= __expf(glast - g4.w);
      }
      Vsb[mi][0] = pack_acc(Vn[mi], 0); Vsb[mi][1] = pack_acc(Vn[mi], 1);
    }
    const float eg = __expf(glast);
#pragma unroll
    for (int t = 0; t < 4; ++t) {
#pragma unroll
      for (int r = 0; r < 16; ++r) S[t][r] *= eg;
      const u16* ktrow = KTs + (32 * t + n) * 72;
#pragma unroll
      for (int mi = 0; mi < 2; ++mi)
#pragma unroll
        for (int s = 0; s < 2; ++s) {
          bf16x8 a = dir ? load_perm_rev(ktrow, 32 * mi, s, h2) : load_perm(ktrow + 32 * mi, s, h2);
          S[t] = MFMA32(a, Vsb[mi][s], S[t]);
        }
      SCHED_FENCE();
    }
  }
  if (seq < 32) {
    float* so = p.out + O_SD + ((size_t)((seq * 4 + l) * 2 + dir) * 4 + h) * 16384;
#pragma unroll
    for (int t = 0; t < 4; ++t)
#pragma unroll
      for (int r = 0; r < 16; ++r) so[(size_t)(32 * t + crow(r, h2)) * 128 + dvc] = S[t][r];
  }
}

DI void attn_tile(const Params& p, int seq, int head, int qb, u16* sm) {
  const int lane = otid() & 63, w = otid() >> 6;
  const int n = lane & 31, h2 = lane >> 5;
  int tq0, nkeys; size_t kbo, vto;
  if (seq < 32) { tq0 = seq * 256 + qb * 128 + w * 32; nkeys = 256; kbo = (size_t)(seq * 8 + head) * 256 * 96; vto = (size_t)(seq * 8 + head) * 64 * 256; }
  else { const int s = seq - 32; tq0 = TP_ + s * 2048 + qb * 128 + w * 32; nkeys = 2304; kbo = KB_P + (size_t)(s * 8 + head) * 2304 * 96; vto = VT_P + (size_t)(s * 8 + head) * 64 * 2304; }
  const u16* kb = (const u16*)(p.ws + B_KB) + kbo;
  const u16* vt = (const u16*)(p.ws + B_VT) + vto;
  const u16* qm = (const u16*)(p.ws + B_QM) + (size_t)(tq0 + n) * 768 + head * 96;
  bf16x8 qf[6];
#pragma unroll
  for (int ks = 0; ks < 6; ++ks) qf[ks] = *(const bf16x8*)(qm + ks * 16 + h2 * 8);
  f32x16 O[2];
#pragma unroll
  for (int r = 0; r < 16; ++r) { O[0][r] = 0.f; O[1][r] = 0.f; }
  float mrun = -1e30f, lsum = 0.f;
  const int nkt = nkeys >> 6;
  constexpr int KST = 104, VST = 72, STG = 64 * KST + 64 * VST;
  const int tid_ = otid();
  uint4 rk0, rk1, rk2, rv0, rv1;
  const int kc0 = tid_, kc1 = tid_ + 256, kc2 = tid_ + 512;
  const u16* kg0 = kb + (size_t)(kc0 / 12) * 96 + (kc0 % 12) * 8;
  const u16* kg1 = kb + (size_t)(kc1 / 12) * 96 + (kc1 % 12) * 8;
  const u16* kg2 = kb + (size_t)(kc2 / 12) * 96 + (kc2 % 12) * 8;
  const u16* vg0 = vt + (size_t)(tid_ >> 3) * nkeys + (tid_ & 7) * 8;
  const u16* vg1 = vt + (size_t)((tid_ + 256) >> 3) * nkeys + (tid_ & 7) * 8;
  const int kl0 = (kc0 / 12) * KST + (kc0 % 12) * 8, kl1 = (kc1 / 12) * KST + (kc1 % 12) * 8, kl2 = (kc2 / 12) * KST + (kc2 % 12) * 8;
  const int vl0 = (tid_ >> 3) * VST + (tid_ & 7) * 8, vl1 = ((tid_ + 256) >> 3) * VST + (tid_ & 7) * 8;
#define AT_GLOAD(kt_) do { rk0 = *(const uint4*)(kg0 + (size_t)(kt_) * 6144); rk1 = *(const uint4*)(kg1 + (size_t)(kt_) * 6144); \
    rk2 = *(const uint4*)(kg2 + (size_t)(kt_) * 6144); rv0 = *(const uint4*)(vg0 + (kt_) * 64); rv1 = *(const uint4*)(vg1 + (kt_) * 64); } while (0)
#define AT_SSTORE(st_) do { u16* ks2_ = sm + (st_) * STG; u16* vs2_ = ks2_ + 64 * KST; \
    *(uint4*)(ks2_ + kl0) = rk0; *(uint4*)(ks2_ + kl1) = rk1; *(uint4*)(ks2_ + kl2) = rk2; *(uint4*)(vs2_ + vl0) = rv0; *(uint4*)(vs2_ + vl1) = rv1; } while (0)
  __syncthreads();
  AT_GLOAD(0); AT_SSTORE(0);
  __syncthreads();
  for (int kt = 0; kt < nkt; ++kt) {
    const bool more = kt + 1 < nkt;
    if (more) AT_GLOAD(kt + 1);
    const u16* ks_ = sm + (kt & 1) * STG;
    const u16* vs_ = ks_ + 64 * KST;
    f32x16 St[2];
#pragma unroll
    for (int sub = 0; sub < 2; ++sub) {
#pragma unroll
      for (int r = 0; r < 16; ++r) St[sub][r] = 0.f;
      const u16* kr = ks_ + (sub * 32 + n) * KST + h2 * 8;
#pragma unroll
      for (int ks = 0; ks < 6; ++ks) St[sub] = MFMA32(*(const bf16x8*)(kr + ks * 16), qf[ks], St[sub]);
    }
    float mx = St[0][0];
#pragma unroll
    for (int r = 0; r < 16; ++r) { mx = fmaxf(mx, St[0][r]); mx = fmaxf(mx, St[1][r]); }
    mx = fmaxf(mx, __shfl_xor(mx, 32));
    const float mnew = fmaxf(mrun, mx);
    const float alpha = __builtin_amdgcn_exp2f(mrun - mnew);
    mrun = mnew;
    float ps = 0.f;
#pragma unroll
    for (int sub = 0; sub < 2; ++sub)
#pragma unroll
      for (int r = 0; r < 16; ++r) { float e = __builtin_amdgcn_exp2f(St[sub][r] - mnew); St[sub][r] = e; ps += e; }
    lsum = lsum * alpha + ps;
#pragma unroll
    for (int r = 0; r < 16; ++r) { O[0][r] *= alpha; O[1][r] *= alpha; }
#pragma unroll
    for (int sub = 0; sub < 2; ++sub)
#pragma unroll
      for (int s = 0; s < 2; ++s) {
        const bf16x8 pb = pack_acc(St[sub], s);
#pragma unroll
        for (int dt = 0; dt < 2; ++dt)
          O[dt] = MFMA32(load_perm(vs_ + (dt * 32 + n) * VST + sub * 32, s, h2), pb, O[dt]);
      }
    if (more) AT_SSTORE((kt + 1) & 1);
    __syncthreads();
  }
  lsum += __shfl_xor(lsum, 32);
  const float inv = 1.f / lsum;
  u16* oc = (u16*)(p.ws + B_OC) + (size_t)(tq0 + n) * 512 + head * 64;
#pragma unroll
  for (int dt = 0; dt < 2; ++dt)
#pragma unroll
    for (int a = 0; a < 4; ++a) {
      const int dv = dt * 32 + 8 * a + 4 * h2;
      *(uint2*)(oc + dv) = make_uint2(pack2(O[dt][4 * a] * inv, O[dt][4 * a + 1] * inv), pack2(O[dt][4 * a + 2] * inv, O[dt][4 * a + 3] * inv));
    }
}

DI void delta_out_tile(const Params& p, int l, int tile) {
  const int lane = otid() & 63, w = otid() >> 6;
  const u16* of = (const u16*)(p.ws + B_OF);
  const u16* ob = (const u16*)(p.ws + B_OB);
  const u16* z = (const u16*)(p.ws + B_Z);
  u16* oa = (u16*)(p.ws + B_OA);
  const float g0 = p.in[17][l * 128 + 2 * lane], g1 = p.in[17][l * 128 + 2 * lane + 1];
#pragma unroll 1
  for (int q = 0; q < 16; ++q) {
    const size_t t = (size_t)tile * 16 + w * 4 + (q >> 2);
    const int hh = q & 3;
    const size_t off = t * 512 + hh * 128 + 2 * lane;
    unsigned a = *(const unsigned*)(of + off), b = *(const unsigned*)(ob + off), zz = *(const unsigned*)(z + off);
    float o0 = blo(a) + blo(b), o1 = bhi(a) + bhi(b);
    float ss = wave_sum(o0 * o0 + o1 * o1);
    float rstd = rsqrtf(ss * (1.f / 128.f) + 1e-6f);
    float y0 = o0 * rstd * g0 * siluf_(blo(zz)), y1 = o1 * rstd * g1 * siluf_(bhi(zz));
    *(unsigned*)(oa + off) = pack2(y0, y1);
  }
}

DI void grid_barrier(unsigned* bar, unsigned target) {
  asm volatile("s_waitcnt vmcnt(0) lgkmcnt(0)" ::: "memory");
  __syncthreads();
  if (otid() == 0) {
    __builtin_amdgcn_fence(__ATOMIC_RELEASE, "agent");
    asm volatile("s_waitcnt vmcnt(0)" ::: "memory");
    __hip_atomic_fetch_add(bar, 1u, __ATOMIC_RELAXED, __HIP_MEMORY_SCOPE_AGENT);
    while (__hip_atomic_load(bar, __ATOMIC_RELAXED, __HIP_MEMORY_SCOPE_AGENT) < target) __builtin_amdgcn_s_sleep(5);
    __builtin_amdgcn_fence(__ATOMIC_ACQUIRE, "agent");
    asm volatile("s_waitcnt vmcnt(0)" ::: "memory");
  }
  __syncthreads();
}
#define GSYNC_FLAT() do { bar_target += gridDim.x; grid_barrier(p.bar, bar_target); } while (0)
DI unsigned xcc_id() { return (unsigned)__builtin_amdgcn_s_getreg((3 << 11) | 20) & 0xFu; }
DI void grid_barrier_xcd(unsigned* bar, unsigned xid, unsigned gen, unsigned xcnt, unsigned npres) {
  asm volatile("s_waitcnt vmcnt(0) lgkmcnt(0)" ::: "memory");
  __syncthreads();
  if (otid() == 0) {
    const unsigned old = __hip_atomic_fetch_add(bar + 64 + 32 * xid, 1u, __ATOMIC_RELAXED, __HIP_MEMORY_SCOPE_AGENT);
    if (old + 1 == gen * xcnt) {
      __builtin_amdgcn_fence(__ATOMIC_RELEASE, "agent");
      asm volatile("s_waitcnt vmcnt(0)" ::: "memory");
      __hip_atomic_fetch_add(bar + 32, 1u, __ATOMIC_RELAXED, __HIP_MEMORY_SCOPE_AGENT);
    }
    while (__hip_atomic_load(bar + 32, __ATOMIC_RELAXED, __HIP_MEMORY_SCOPE_AGENT) < gen * npres) __builtin_amdgcn_s_sleep(5);
    __builtin_amdgcn_fence(__ATOMIC_ACQUIRE, "agent");
    asm volatile("s_waitcnt vmcnt(0)" ::: "memory");
  }
  __syncthreads();
}
#define GSYNC() do { ++bar_gen; grid_barrier_xcd(p.bar, bx_id, bar_gen, bx_cnt, bx_np); } while (0)
#ifndef ONLY
#define PH(n) 1
#else
#define PH(n) ((n) == ONLY || (n) / 100 == ONLY || (n) == ONLY / 100)
#endif
__global__ void __launch_bounds__(256, 2) mega(Params p) {
  cg::grid_group grid = cg::this_grid();
  __shared__ __attribute__((aligned(16))) char smem_raw[73728];
  u16* sm = (u16*)smem_raw;
  float* smf = (float*)smem_raw;
  const int nb = gridDim.x, bid = blockIdx.x;
  unsigned bar_target = 0, bar_gen = 0;
  grid.sync();
  const unsigned bx_id = xcc_id() & 7u;
  unsigned bx_cnt = 1, bx_np = 1;
  {
    if (otid() == 0) __hip_atomic_fetch_add(p.bar + 16 + bx_id, 1u, __ATOMIC_RELAXED, __HIP_MEMORY_SCOPE_AGENT);
    GSYNC_FLAT();
    unsigned np = 0;
#pragma unroll
    for (unsigned x = 0; x < 8; ++x) {
      const unsigned c = __hip_atomic_load(p.bar + 16 + x, __ATOMIC_RELAXED, __HIP_MEMORY_SCOPE_AGENT);
      if (c > 0) ++np;
      if (x == bx_id) bx_cnt = c;
    }
    bx_np = np;
  }

  if (PH(0)) {
    const int tid = otid();
    for (int j = bid; j < 4 * CJ8; j += nb) conv_job(p, j / CJ8, j % CJ8, smf);
    for (int j = bid; j < 4 * 96; j += nb) mods_tile(p, j / 96, j % 96, smf);
    for (int j = bid; j < 64; j += nb) s5pre_tile(p, j);
    {
      float* rope = (float*)(p.ws + B_ROPE);
      for (int i = bid * 256 + tid; i < 2048 * 16; i += nb * 256) {
        const int pos = i >> 4, f = i & 15;
        const float invf = 1.f / powf(10000.f, (float)(f & 7) * 0.125f);
        const float ang = (f < 8 ? (float)(pos >> 6) : (float)(pos & 63)) * invf;
        float sn, cs;
        sincosf(ang, &sn, &cs);
        rope[i * 2] = cs; rope[i * 2 + 1] = sn;
      }
    }
    {
      u16* cc = (u16*)(p.ws + B_CKVC);
      for (int i = bid * 256 + tid; i < 8 * 4 * 256 * 256 / 2; i += nb * 256) {
        const int e = i * 2;
        const int c = e & 255, pos = (e >> 8) & 255, l = (e >> 16) & 3, b = e >> 18;
        float2 v = *(const float2*)(p.in[5] + e);
        *(unsigned*)(cc + ((size_t)(l * 2048 + b * 256 + pos)) * 256 + c) = pack2(v.x, v.y);
      }
    }
  }
  GSYNC();

  for (int l = 0; l < 4; ++l) {
    const u16* WL = (const u16*)(p.ws + B_W) + (size_t)l * W_LAYER;
    const float* mods = (const float*)(p.ws + B_MODS);
    if (PH(1)) norm_phase(p, l, 0, 1, p.in[11] + l * 1024, l == 0);
    GSYNC();
    if (PH(2)) gemm_in_phase(p, l, sm);
    GSYNC();
    if (PH(3)) {
      for (int j = bid; j < NCH; j += nb) delta_prep_tile(p, l, j, sm);
      for (int j = bid; j < T_ / 4; j += nb) mla_prep_tile(p, l, j);
      for (int j = bid; j < 256; j += nb) cache_rope_tile(p, l, j);
      for (int j = bid; j < NCH * 16; j += nb) s5_chunk_tile(p, l, j >> 4, j & 15, 0, sm);
    }
    GSYNC();
    if (PH(4)) {
      const int tid = otid();
      if (PH(400)) for (int j = bid; j < NCH * 2; j += nb) delta_local_tile(p, j, smf);
      if (PH(410)) for (int j = (bid + (nb >> 1)) % nb; j < 192 * 6; j += nb) {
          const int q = j, mt = q / 6, nt = q % 6;
          f32x4 acc[4][4];
          zero_acc<4>(acc);
          gemm_core<4>(acc, (const u16*)(p.ws + B_QA) + (size_t)mt * 128 * 384, 384, WL + W_QB + (size_t)nt * 128 * 384, 384, 384, sm);
          u16* qm = (u16*)(p.ws + B_QM);
          const float qs = 0.10206207261596575f * 1.4426950408889634f;
          const float* rope = (const float*)(p.ws + B_ROPE);
          const int e_lane = tid & 63, e_w = tid >> 6, e_wr = e_w >> 1, e_wc = e_w & 1, e_fr = e_lane & 15, e_fq = e_lane >> 4;
          const bool is_s = (mt * 128 >= TP_);
#pragma unroll
          for (int i = 0; i < 4; ++i) {
            const int row = mt * 128 + e_wr * 64 + i * 16 + e_fr;
            f32x4 vals[4];
#pragma unroll
            for (int jj = 0; jj < 4; ++jj) vals[jj] = acc[i][jj];
            if (is_s) {
              const int pos = (row - TP_) & 2047;
              const float4 cs0 = *(const float4*)(rope + (size_t)(pos * 16 + e_fq * 4) * 2);
              const float4 cs1 = *(const float4*)(rope + (size_t)(pos * 16 + e_fq * 4) * 2 + 4);
              const float cs[4] = {cs0.x, cs0.z, cs1.x, cs1.z}, sn[4] = {cs0.y, cs0.w, cs1.y, cs1.w};
#pragma unroll
              for (int jj = 0; jj < 4; jj += 2) {
                const int gt = (nt * 128 + e_wc * 64) / 16 + jj;
                if (gt % 6 == 4) {
#pragma unroll
                  for (int r = 0; r < 4; ++r) {
                    const float x1 = vals[jj][r], x2 = vals[jj + 1][r];
                    vals[jj][r] = x1 * cs[r] - x2 * sn[r];
                    vals[jj + 1][r] = x2 * cs[r] + x1 * sn[r];
                  }
                }
              }
            }
#pragma unroll
            for (int jj = 0; jj < 4; ++jj) {
              f32x4 o; o[0] = vals[jj][0] * qs; o[1] = vals[jj][1] * qs; o[2] = vals[jj][2] * qs; o[3] = vals[jj][3] * qs;
              *(uint2*)(qm + (size_t)row * 768 + nt * 128 + e_wc * 64 + jj * 16 + e_fq * 4) = pack4(o);
            }
          }
      }
      if (PH(420)) for (int j = (bid + (nb >> 1) + (nb >> 2)) % nb; j < 208 * 8; j += nb) {
          const int q = j, mt = q >> 3, head = q & 7;
          f32x4 acc[4][4];
          zero_acc<4>(acc);
          const u16* A = mt < 192 ? (const u16*)(p.ws + B_KVA) + (size_t)mt * 128 * 256
                                  : (const u16*)(p.ws + B_CKVC) + ((size_t)l * 2048 + (size_t)(mt - 192) * 128) * 256;
          gemm_core<4, false>(acc, A, 256, WL + W_KVB + (size_t)head * 128 * 256, 256, 256, sm);
          int key0, nkeys; size_t kbo, vto;
          if (mt < 64) { const int seq = mt >> 1; key0 = (mt & 1) * 128; nkeys = 256; kbo = (size_t)(seq * 8 + head) * 256 * 96; vto = (size_t)(seq * 8 + head) * 64 * 256; }
          else if (mt < 192) { const int s = (mt - 64) >> 4; key0 = 256 + ((mt - 64) & 15) * 128; nkeys = 2304; kbo = KB_P + (size_t)(s * 8 + head) * 2304 * 96; vto = VT_P + (size_t)(s * 8 + head) * 64 * 2304; }
          else { const int s = (mt - 192) >> 1; key0 = ((mt - 192) & 1) * 128; nkeys = 2304; kbo = KB_P + (size_t)(s * 8 + head) * 2304 * 96; vto = VT_P + (size_t)(s * 8 + head) * 64 * 2304; }
          u16* kb = (u16*)(p.ws + B_KB) + kbo;
          u16* vt = (u16*)(p.ws + B_VT) + vto;
          const int e_lane = tid & 63, e_w = tid >> 6, e_wr = e_w >> 1, e_wc = e_w & 1, e_fr = e_lane & 15, e_fq = e_lane >> 4;
#pragma unroll
          for (int i = 0; i < 4; ++i)
#pragma unroll
            for (int jj = 0; jj < 4; ++jj) {
              const int key = key0 + e_wr * 64 + i * 16 + e_fq * 4;
              const int c = jj * 16 + e_fr;
              if (e_wc == 0) {
#pragma unroll
                for (int r = 0; r < 4; ++r) kb[(size_t)(key + r) * 96 + c] = f2bf(acc[i][jj][r]);
              } else {
                *(uint2*)(vt + (size_t)c * nkeys + key) = make_uint2(pack2(acc[i][jj][0], acc[i][jj][1]), pack2(acc[i][jj][2], acc[i][jj][3]));
              }
            }
      }
      if (PH(430)) for (int j = bid; j < 640; j += nb) s5_carry_tile(p, l, j);
    }
    GSYNC();
    if (PH(5)) {
      if (PH(500)) for (int j = bid; j < 320; j += nb) delta_scan_tile(p, l, j, sm);
      if (PH(510)) if (bid >= 64) for (int j = bid - 64; j < 1536; j += nb - 64) {
        if (j < 1024) attn_tile(p, 32 + (j >> 7), (j >> 4) & 7, j & 15, sm);
        else { const int q = j - 1024; attn_tile(p, q >> 4, (q >> 1) & 7, q & 1, sm); }
      }
      if (PH(530)) if (bid >= 64) for (int j = bid - 64; j < NCH * 8; j += nb - 64) {
        s5_chunk_tile(p, l, j >> 3, (j & 7) * 2, 1, sm);
        s5_chunk_tile(p, l, j >> 3, (j & 7) * 2 + 1, 1, sm);
      }
    }
    GSYNC();
    if (PH(6)) {
      for (int j = bid; j < T_ / 16; j += nb) delta_out_tile(p, l, j);
      for (int j = bid; j < 192 * 4; j += nb) {
        {
          const int q = j, mt = q >> 2, nt = q & 3;
          f32x4 acc[4][4];
          zero_acc<4>(acc);
          const u16* y5 = (const u16*)(p.ws + B_Y5);
          gemm_core<4>(acc, y5 + (size_t)mt * 128 * 512, 512, WL + W_GLU + (size_t)nt * 128 * 512, 512, 512, sm);
          u16* ob5 = (u16*)(p.ws + B_OB5);
          const float* bgl = p.in[27] + l * 512;
          EPI_LOOP(4) {
            const size_t row = mt * 128 + EROW; const int col = nt * 128 + ECOL4(4);
            const uint2 yy = *(const uint2*)(y5 + row * 512 + col);
            const float4 bb = *(const float4*)(bgl + col);
            f32x4 o;
            o[0] = blo(yy.x) * sigmoidf_(acc[i][j][0] + bb.x); o[1] = bhi(yy.x) * sigmoidf_(acc[i][j][1] + bb.y);
            o[2] = blo(yy.y) * sigmoidf_(acc[i][j][2] + bb.z); o[3] = bhi(yy.y) * sigmoidf_(acc[i][j][3] + bb.w);
            *(uint2*)(ob5 + row * 512 + col) = pack4(o);
          }
        }
      }
    }
    GSYNC();
    if (PH(7)) {
      const u16* H = (const u16*)(p.ws + B_H);
      u16* mg = (u16*)(p.ws + B_MG);
      for (int j = bid; j < 192 * 16; j += nb) {
        const int mt = j >> 4, nt = j & 15;
        f32x4 mer[4][2];
        zero_acc<2>(mer);
#pragma unroll 1
        for (int n = 0; n < 3; ++n) {
          f32x4 ag[4][2], ab[4][2];
          zero_acc<2>(ag);
          gemm_core<2>(ag, H + (size_t)mt * 128 * 1024, 1024, WL + W_G + (size_t)(n * 1024 + nt * 64) * 1024, 1024, 1024, sm);
          zero_acc<2>(ab);
          const u16* on = (const u16*)(p.ws + (n == 0 ? B_OA : (n == 1 ? B_OB5 : B_OC)));
          gemm_core<2>(ab, on + (size_t)mt * 128 * 512, 512, WL + W_BR + (size_t)(nt * 64) * 1536 + n * 512, 1536, 512, sm);
#pragma unroll
          for (int i = 0; i < 4; ++i)
#pragma unroll
            for (int jj = 0; jj < 2; ++jj)
#pragma unroll
              for (int r = 0; r < 4; ++r) mer[i][jj][r] += sigmoidf_(ag[i][jj][r]) * ab[i][jj][r];
        }
        EPI_LOOP(2) { *(uint2*)(mg + (size_t)(mt * 128 + EROW) * 1024 + nt * 64 + ECOL4(2)) = pack4(mer[i][j]); }
      }
    }
    GSYNC();
    if (PH(8)) {
      const u16* mg = (const u16*)(p.ws + B_MG);
      for (int j = bid; j < 192 * 8; j += nb) {
        const int mt = j >> 3, nt = j & 7;
        f32x4 acc[4][4];
        zero_acc<4>(acc);
        gemm_core<4>(acc, mg + (size_t)mt * 128 * 1024, 1024, WL + W_OUT + (size_t)nt * 128 * 1024, 1024, 1024, sm);
        const float* gm = mods + (size_t)(l * 9 + tok_v(mt * 128)) * 6144 + 2 * 1024;
        EPI_LOOP(4) {
          const size_t row = mt * 128 + EROW; const int col = nt * 128 + ECOL4(4);
          float4* xp_ = (float4*)(p.out + row * 1024 + col);
          const float4* xin_ = l == 0 ? (const float4*)((row < (size_t)TP_ ? p.in[0] + row * 1024 : p.in[1] + (row - TP_) * 1024) + col) : (const float4*)xp_;
          float4 xv = *xin_; const float4 gg = *(const float4*)(gm + col);
          xv.x += gg.x * acc[i][j][0]; xv.y += gg.y * acc[i][j][1]; xv.z += gg.z * acc[i][j][2]; xv.w += gg.w * acc[i][j][3];
          *xp_ = xv;
        }
      }
    }
    GSYNC();
    if (PH(9)) norm_phase(p, l, 3, 4, p.in[12] + l * 1024, false);
    GSYNC();
    if (PH(10)) {
      const u16* H = (const u16*)(p.ws + B_H);
      u16* up = (u16*)(p.ws + B_UP);
      for (int j = bid; j < 192 * 44; j += nb) {
        const int mt = j / 44, nt = j % 44;
        f32x4 acc[4][4];
        zero_acc<4>(acc);
        gemm_core<4>(acc, H + (size_t)mt * 128 * 1024, 1024, WL + W_UP + (size_t)nt * 128 * 1024, 1024, 1024, sm);
        EPI_LOOP(4) { *(uint2*)(up + (size_t)(mt * 128 + EROW) * 5632 + nt * 128 + ECOL4(4)) = pack4(acc[i][j]); }
      }
    }
    GSYNC();
    if (PH(11)) {
      const int tid = otid();
      const u16* up = (const u16*)(p.ws + B_UP);
      u16* act = (u16*)(p.ws + B_ACT);
      const float* cw = p.in[35] + (size_t)l * 3 * 5632;
      const float* cb = p.in[36] + (size_t)l * 5632;
      constexpr int TG = 16;
      for (int it = bid * 256 + tid; it < (T_ / TG) * 352; it += nb * 256) {
        const int t0 = (it / 352) * TG, c8 = (it % 352) * 8;
        int pos0, L;
        if (t0 < TP_) { pos0 = t0 & 255; L = 256; } else { pos0 = (t0 - TP_) & 2047; L = 2048; }
        float wg[3][8], wv[3][8], bgv[8], bvv[8];
#pragma unroll
        for (int d = 0; d < 3; ++d) {
          const float4 g0 = *(const float4*)(cw + d * 5632 + c8), g1 = *(const float4*)(cw + d * 5632 + c8 + 4);
          const float4 v0 = *(const float4*)(cw + d * 5632 + 2816 + c8), v1 = *(const float4*)(cw + d * 5632 + 2816 + c8 + 4);
          wg[d][0] = g0.x; wg[d][1] = g0.y; wg[d][2] = g0.z; wg[d][3] = g0.w; wg[d][4] = g1.x; wg[d][5] = g1.y; wg[d][6] = g1.z; wg[d][7] = g1.w;
          wv[d][0] = v0.x; wv[d][1] = v0.y; wv[d][2] = v0.z; wv[d][3] = v0.w; wv[d][4] = v1.x; wv[d][5] = v1.y; wv[d][6] = v1.z; wv[d][7] = v1.w;
        }
        {
          const float4 g0 = *(const float4*)(cb + c8), g1 = *(const float4*)(cb + c8 + 4);
          const float4 v0 = *(const float4*)(cb + 2816 + c8), v1 = *(const float4*)(cb + 2816 + c8 + 4);
          bgv[0] = g0.x; bgv[1] = g0.y; bgv[2] = g0.z; bgv[3] = g0.w; bgv[4] = g1.x; bgv[5] = g1.y; bgv[6] = g1.z; bgv[7] = g1.w;
          bvv[0] = v0.x; bvv[1] = v0.y; bvv[2] = v0.z; bvv[3] = v0.w; bvv[4] = v1.x; bvv[5] = v1.y; bvv[6] = v1.z; bvv[7] = v1.w;
        }
        uint4 g0r = make_uint4(0, 0, 0, 0), v0r = g0r, g1r, v1r, g2r, v2r;
        if (pos0 > 0) { const u16* rp = up + (size_t)(t0 - 1) * 5632; g0r = *(const uint4*)(rp + c8); v0r = *(const uint4*)(rp + 2816 + c8); }
        { const u16* rp = up + (size_t)t0 * 5632; g1r = *(const uint4*)(rp + c8); v1r = *(const uint4*)(rp + 2816 + c8); }
#pragma unroll 4
        for (int o = 0; o < TG; ++o) {
          g2r = make_uint4(0, 0, 0, 0); v2r = g2r;
          if (pos0 + o + 1 < L) { const u16* rp = up + (size_t)(t0 + o + 1) * 5632; g2r = *(const uint4*)(rp + c8); v2r = *(const uint4*)(rp + 2816 + c8); }
          const unsigned ga[3][4] = {{g0r.x, g0r.y, g0r.z, g0r.w}, {g1r.x, g1r.y, g1r.z, g1r.w}, {g2r.x, g2r.y, g2r.z, g2r.w}};
          const unsigned va[3][4] = {{v0r.x, v0r.y, v0r.z, v0r.w}, {v1r.x, v1r.y, v1r.z, v1r.w}, {v2r.x, v2r.y, v2r.z, v2r.w}};
          float res[8];
#pragma unroll
          for (int e = 0; e < 8; ++e) {
            float g = bgv[e], v = bvv[e];
#pragma unroll
            for (int d = 0; d < 3; ++d) {
              const float xg = (e & 1) ? bhi(ga[d][e >> 1]) : blo(ga[d][e >> 1]);
              const float xv = (e & 1) ? bhi(va[d][e >> 1]) : blo(va[d][e >> 1]);
              g += wg[d][e] * xg; v += wv[d][e] * xv;
            }
            res[e] = siluf_(g) * v;
          }
          *(uint4*)(act + (size_t)(t0 + o) * 2816 + c8) = make_uint4(pack2(res[0], res[1]), pack2(res[2], res[3]), pack2(res[4], res[5]), pack2(res[6], res[7]));
          g0r = g1r; v0r = v1r; g1r = g2r; v1r = v2r;
        }
      }
    }
    GSYNC();
    if (PH(12)) {
      const u16* act = (const u16*)(p.ws + B_ACT);
      for (int j = bid; j < 192 * 8; j += nb) {
        const int mt = j >> 3, nt = j & 7;
        f32x4 acc[4][4];
        zero_acc<4>(acc);
        gemm_core<4>(acc, act + (size_t)mt * 128 * 2816, 2816, WL + W_DN + (size_t)nt * 128 * 2816, 2816, 2816, sm);
        const float* gf = mods + (size_t)(l * 9 + tok_v(mt * 128)) * 6144 + 5 * 1024;
        EPI_LOOP(4) {
          const size_t row = mt * 128 + EROW; const int col = nt * 128 + ECOL4(4);
          float4* xp_ = (float4*)(p.out + row * 1024 + col);
          float4 xv = *xp_; const float4 gg = *(const float4*)(gf + col);
          xv.x += gg.x * acc[i][j][0]; xv.y += gg.y * acc[i][j][1]; xv.z += gg.z * acc[i][j][2]; xv.w += gg.w * acc[i][j][3];
          *xp_ = xv;
        }
      }
    }
    GSYNC();
  }
  if (PH(13)) {
    const int tid = otid();
    const int lane = tid & 63, w = tid >> 6;
    const float* gfin = p.in[38];
    for (int tile = bid; tile < T_ / 4; tile += nb) {
      const int t = tile * 4 + w;
      float4* xr = (float4*)(p.out + (size_t)t * 1024);
      float4 v[4];
      float ss = 0.f;
#pragma unroll
      for (int j = 0; j < 4; ++j) { v[j] = xr[lane + 64 * j]; ss += v[j].x * v[j].x + v[j].y * v[j].y + v[j].z * v[j].z + v[j].w * v[j].w; }
      ss = wave_sum(ss);
      const float rstd = rsqrtf(ss * (1.f / 1024.f) + 1e-6f);
#pragma unroll
      for (int j = 0; j < 4; ++j) {
        float4 g = *(const float4*)(gfin + (lane + 64 * j) * 4);
        xr[lane + 64 * j] = make_float4(v[j].x * rstd * g.x, v[j].y * rstd * g.y, v[j].z * rstd * g.z, v[j].w * rstd * g.w);
      }
    }
  }
}

extern "C" void kernel_launch(void* const* d_in, const int* in_sizes, int n_in, void* d_out, int out_size,
                              void* d_ws, size_t ws_size, hipStream_t stream) {
  static int grid_blocks = 0;
  if (!grid_blocks) {
    int dev = 0, cus = 0, per_cu = 0;
    (void)hipGetDevice(&dev);
    (void)hipDeviceGetAttribute(&cus, hipDeviceAttributeMultiprocessorCount, dev);
    (void)hipOccupancyMaxActiveBlocksPerMultiprocessor(&per_cu, mega, 256, 0);
    if (per_cu > 2) per_cu = 2;
    if (per_cu < 1) per_cu = 1;
    grid_blocks = cus * per_cu;
  }
  if (ws_size < B_TOTAL || n_in < 39) {
    fprintf(stderr, "workspace too small: %zu < %zu\n", ws_size, (size_t)B_END);
    return;
  }
  Params p{};
  for (int i = 0; i < 39; ++i) p.in[i] = (const float*)d_in[i];
  p.out = (float*)d_out;
  p.ws = (char*)d_ws;
  p.bar = (unsigned*)((char*)d_ws + B_BAR);
  (void)hipMemsetAsync(p.bar, 0, 4096, stream);
  void* args[] = {&p};
  hipError_t e = hipLaunchCooperativeKernel((void*)mega, dim3(grid_blocks), dim3(256), args, 0, stream);
  if (e != hipSuccess) fprintf(stderr, "cooperative launch failed: %s (grid %d)\n", hipGetErrorString(e), grid_blocks);
}
```
